# Optimizing an MI355X kernel written in HIP

```python
import math
import jax
import jax.numpy as jnp
from jax import lax
import numpy as np

D_MODEL = 1024
BATCH = 4
SEQ = 8192
DEPTH = 2

N_A = DEPTH // 2
N_B = DEPTH - N_A
N_DENSE = (DEPTH + 1) // 2
N_MOE = DEPTH // 2
N_MOD = 6

MLA_HEADS = 16
MLA_Q_RANK = 384
MLA_KV_RANK = 256
MLA_NOPE = 64
MLA_ROPE = 32
MLA_V = 64
MLA_QK = MLA_NOPE + MLA_ROPE
MLA_IN = MLA_Q_RANK + MLA_KV_RANK + MLA_ROPE
ROPE_THETA = 10000.0
Q_BLOCK = 128

DIL_PATTERNS = ((128, 1), (512, 4), (2048, 16))
DIL_GROUPS = len(DIL_PATTERNS)
DIL_HEADS = 8
DIL_HEAD_DIM = 64
DIL_BLOCK = 128
DIL_Q = DIL_GROUPS * DIL_HEADS * DIL_HEAD_DIM
DIL_KV = 2 * DIL_Q
DIL_OUT = DIL_HEADS * DIL_HEAD_DIM

RPB_BUCKETS = 32
RPB_MAX_DIST = 2048

D_FF = 2816
N_EXPERTS = 8
TOP_K = 2
EPS = 1e-6

kernel_name = "yoco_mla_dilated_moe_hybrid"


def rmsnorm(x, g):
    xf = x.astype(jnp.float32)
    y = xf * lax.rsqrt(jnp.mean(xf * xf, axis=-1, keepdims=True) + EPS)
    return (y * g.astype(jnp.float32)).astype(x.dtype)


def modulate(h, shift, scale):
    return h * (1 + scale[:, None, :]) + shift[:, None, :]


def apply_rope(x, cos, sin):
    xf = x.astype(jnp.float32)
    x1, x2 = jnp.split(xf, 2, axis=-1)
    return jnp.concatenate([x1 * cos - x2 * sin, x1 * sin + x2 * cos], axis=-1).astype(x.dtype)


def swiglu(h, w_gu, w_down):
    gate, up = jnp.split(h @ w_gu, 2, axis=-1)
    return (jax.nn.silu(gate) * up) @ w_down


def causal_attention(q, k, v, scale):
    B, S, H, Dk = q.shape
    nb = S // Q_BLOCK
    qb = q.reshape(B, nb, Q_BLOCK, H, Dk).transpose(1, 0, 2, 3, 4)
    k_pos = jnp.arange(S)

    def one_block(args):
        i, qi = args
        s = jnp.einsum('bqhd,bkhd->bhqk', qi, k, preferred_element_type=jnp.float32) * scale
        q_pos = i * Q_BLOCK + jnp.arange(Q_BLOCK)
        s = jnp.where(k_pos[None, :] <= q_pos[:, None], s, -jnp.inf)
        p = jax.nn.softmax(s, axis=-1)
        return jnp.einsum('bhqk,bkhd->bqhd', p.astype(v.dtype), v)

    o = lax.map(one_block, (jnp.arange(nb), qb))
    return o.transpose(1, 0, 2, 3, 4).reshape(B, S, H, v.shape[-1])


def mla(hn, positions, w_in, g_q, w_q_up, g_kv, w_kv_up, w_out):
    B, S, _ = hn.shape
    q_lat, kv_lat, k_rope = jnp.split(hn @ w_in, [MLA_Q_RANK, MLA_Q_RANK + MLA_KV_RANK], axis=-1)
    q = (rmsnorm(q_lat, g_q) @ w_q_up).reshape(B, S, MLA_HEADS, MLA_QK)
    kv = (rmsnorm(kv_lat, g_kv) @ w_kv_up).reshape(B, S, MLA_HEADS, MLA_NOPE + MLA_V)
    q_nope, q_rope = jnp.split(q, [MLA_NOPE], axis=-1)
    k_nope, v = jnp.split(kv, [MLA_NOPE], axis=-1)
    inv_freq = ROPE_THETA ** (-jnp.arange(0, MLA_ROPE, 2, dtype=jnp.float32) / MLA_ROPE)
    ang = positions.astype(jnp.float32)[..., None] * inv_freq
    cos, sin = jnp.cos(ang), jnp.sin(ang)
    q_rope = apply_rope(q_rope, cos[:, :, None], sin[:, :, None])
    k_rope = apply_rope(k_rope, cos, sin)
    q = jnp.concatenate([q_nope, q_rope], axis=-1)
    k = jnp.concatenate([k_nope, jnp.broadcast_to(k_rope[:, :, None], (B, S, MLA_HEADS, MLA_ROPE))], axis=-1)
    o = causal_attention(q, k, v, MLA_QK ** -0.5)
    return o.reshape(B, S, MLA_HEADS * MLA_V) @ w_out


def rpb_bucket(dist):
    exact = RPB_BUCKETS // 2
    d = jnp.maximum(dist, 0)
    d_f = jnp.maximum(d, 1).astype(jnp.float32)
    large = exact + (jnp.log(d_f / exact) / math.log(RPB_MAX_DIST / exact)
                     * (RPB_BUCKETS - exact)).astype(jnp.int32)
    return jnp.where(d < exact, d, jnp.minimum(large, RPB_BUCKETS - 1))


def dilated_group(q, k, v, table, span, dil):
    B, S, H, Dh = q.shape
    n = S // dil
    nb = -(-n // DIL_BLOCK)
    n_pad = nb * DIL_BLOCK

    def to_sub(t):
        t = t.reshape(B, n, dil, H, Dh).transpose(0, 2, 1, 3, 4)
        return jnp.pad(t, ((0, 0), (0, 0), (0, n_pad - n), (0, 0), (0, 0)))

    def band(t):
        t = jnp.pad(t, ((0, 0), (0, 0), (DIL_BLOCK, 0), (0, 0), (0, 0)))
        prev = t[:, :, :n_pad].reshape(B, dil, nb, DIL_BLOCK, H, Dh)
        cur = t[:, :, DIL_BLOCK:].reshape(B, dil, nb, DIL_BLOCK, H, Dh)
        return jnp.concatenate([prev, cur], axis=3)

    qs = to_sub(q).reshape(B, dil, nb, DIL_BLOCK, H, Dh)
    ks = band(to_sub(k))
    vs = band(to_sub(v))

    dist = jnp.arange(DIL_BLOCK)[:, None] + DIL_BLOCK - jnp.arange(2 * DIL_BLOCK)[None, :]
    key_idx = (jnp.arange(nb)[:, None] - 1) * DIL_BLOCK + jnp.arange(2 * DIL_BLOCK)[None, :]
    mask = ((dist >= 0) & (dist <= span))[None] & (key_idx >= 0)[:, None, :]
    bias = jnp.transpose(table[rpb_bucket(dist * dil)], (2, 0, 1)).astype(jnp.float32)

    s = jnp.einsum('brnqhd,brnkhd->brnhqk', qs, ks, preferred_element_type=jnp.float32)
    s = s * (DIL_HEAD_DIM ** -0.5) + bias
    s = jnp.where(mask[None, None, :, None], s, -jnp.inf)
    m = jnp.max(s, axis=-1, keepdims=True)
    p = jnp.exp(s - m)
    l = jnp.sum(p, axis=-1, keepdims=True)
    o = jnp.einsum('brnhqk,brnkhd->brnqhd', p.astype(v.dtype), vs, preferred_element_type=jnp.float32)
    o = o / jnp.transpose(l, (0, 1, 2, 4, 3, 5))
    lse = jnp.transpose((m + jnp.log(l))[..., 0], (0, 1, 2, 4, 3))

    def from_sub(t):
        t = t.reshape((B, dil, n_pad) + t.shape[4:])[:, :, :n]
        t = jnp.swapaxes(t, 1, 2)
        return t.reshape((B, S) + t.shape[3:])

    return from_sub(o), from_sub(lse)


def shared_kv(h, c_act, g, w_ada_kv, b_ada_kv, w_kv):
    B, S, _ = h.shape
    shift, scale = jnp.split(c_act @ w_ada_kv + b_ada_kv, 2, axis=-1)
    hn = modulate(rmsnorm(h, g), shift, scale)
    return (hn @ w_kv).reshape(B, S, DIL_GROUPS, 2, DIL_HEADS, DIL_HEAD_DIM)


def dilated_attention(hn, kv_b, w_q, w_o, rpb_table):
    B, S, _ = hn.shape
    q = (hn @ w_q).reshape(B, S, DIL_GROUPS, DIL_HEADS, DIL_HEAD_DIM)
    outs, lses = [], []
    for g, (window, dil) in enumerate(DIL_PATTERNS):
        table = rpb_table[:, g * DIL_HEADS:(g + 1) * DIL_HEADS]
        o, lse = dilated_group(q[:, :, g], kv_b[:, :, g, 0], kv_b[:, :, g, 1], table, window // dil, dil)
        outs.append(o)
        lses.append(lse)
    wts = jax.nn.softmax(jnp.stack(lses, axis=0), axis=0)
    o = jnp.sum(jnp.stack(outs, axis=0) * wts[..., None], axis=0)
    return o.reshape(B, S, DIL_OUT).astype(hn.dtype) @ w_o


def moe(h, w_router, w_gu, w_down):
    logits = (h @ w_router).astype(jnp.float32)
    top_val, top_idx = lax.top_k(logits, TOP_K)
    gates = jax.nn.softmax(top_val, axis=-1)
    dense_gates = jnp.sum(jax.nn.one_hot(top_idx, N_EXPERTS, dtype=jnp.float32) * gates[..., None], axis=-2)
    out = jnp.zeros_like(h)
    for e in range(N_EXPERTS):
        out = out + dense_gates[..., e:e + 1].astype(h.dtype) * swiglu(h, w_gu[e], w_down[e])
    return out


def setup_inputs(seed: int = 0) -> dict:
    key = jax.random.key(seed)
    kit = iter(jax.random.split(key, 40))

    def w(shape, fan_in, scale=1.0):
        return (scale * fan_in ** -0.5) * jax.random.normal(next(kit), shape, jnp.float32)

    def gain(shape):
        return 1.0 + 0.05 * jax.random.normal(next(kit), shape, jnp.float32)

    def small(shape, s=0.02):
        return s * jax.random.normal(next(kit), shape, jnp.float32)

    D = D_MODEL
    x = jax.random.normal(next(kit), (BATCH, SEQ, D), jnp.float32)
    c = jax.random.normal(next(kit), (BATCH, D), jnp.float32)
    positions = (jax.random.randint(next(kit), (BATCH, 1), 0, 4096, dtype=jnp.int32)
                 + jnp.arange(SEQ, dtype=jnp.int32)[None, :])
    return {
        "x": x,
        "c": c,
        "positions": positions,
        "g_mix": gain((DEPTH, D)),
        "g_ffn": gain((DEPTH, D)),
        "w_ada": w((DEPTH, D, N_MOD * D), D, 0.5),
        "b_ada": small((DEPTH, N_MOD * D)),
        "w_mla_in": w((N_A, D, MLA_IN), D),
        "g_mla_q": gain((N_A, MLA_Q_RANK)),
        "w_mla_q_up": w((N_A, MLA_Q_RANK, MLA_HEADS * MLA_QK), MLA_Q_RANK),
        "g_mla_kv": gain((N_A, MLA_KV_RANK)),
        "w_mla_kv_up": w((N_A, MLA_KV_RANK, MLA_HEADS * (MLA_NOPE + MLA_V)), MLA_KV_RANK),
        "w_mla_out": w((N_A, MLA_HEADS * MLA_V, D), MLA_HEADS * MLA_V),
        "g_kv_b": gain((D,)),
        "w_ada_kv": w((D, 2 * D), D, 0.5),
        "b_ada_kv": small((2 * D,)),
        "w_kv_b": w((D, DIL_KV), D),
        "rpb_table": small((RPB_BUCKETS, DIL_GROUPS * DIL_HEADS), 0.2),
        "w_q_b": w((N_B, D, DIL_Q), D),
        "w_o_b": w((N_B, DIL_OUT, D), DIL_OUT),
        "w_ffn_gu": w((N_DENSE, D, 2 * D_FF), D),
        "w_ffn_down": w((N_DENSE, D_FF, D), D_FF),
        "w_router": w((N_MOE, D, N_EXPERTS), D),
        "w_exp_gu": w((N_MOE, N_EXPERTS, D, 2 * D_FF), D),
        "w_exp_down": w((N_MOE, N_EXPERTS, D_FF, D), D_FF),
        "g_final": gain((D,)),
    }


def reference(x, c, positions, g_mix, g_ffn, w_ada, b_ada,
              w_mla_in, g_mla_q, w_mla_q_up, g_mla_kv, w_mla_kv_up, w_mla_out,
              g_kv_b, w_ada_kv, b_ada_kv, w_kv_b, rpb_table, w_q_b, w_o_b,
              w_ffn_gu, w_ffn_down, w_router, w_exp_gu, w_exp_down, g_final):
    c_act = jax.nn.silu(c)
    h = x
    kv_b = None
    for layer in range(DEPTH):
        if layer == N_A:
            kv_b = shared_kv(h, c_act, g_kv_b, w_ada_kv, b_ada_kv, w_kv_b)
        mod = c_act @ w_ada[layer] + b_ada[layer]
        sh_m, sc_m, gt_m, sh_f, sc_f, gt_f = jnp.split(mod, N_MOD, axis=-1)
        hn = modulate(rmsnorm(h, g_mix[layer]), sh_m, sc_m)
        if layer < N_A:
            y = mla(hn, positions, w_mla_in[layer], g_mla_q[layer], w_mla_q_up[layer],
                    g_mla_kv[layer], w_mla_kv_up[layer], w_mla_out[layer])
        else:
            j = layer - N_A
            y = dilated_attention(hn, kv_b, w_q_b[j], w_o_b[j], rpb_table)
        h = h + gt_m[:, None, :] * y
        hn = modulate(rmsnorm(h, g_ffn[layer]), sh_f, sc_f)
        if layer % 2 == 0:
            y = swiglu(hn, w_ffn_gu[layer // 2], w_ffn_down[layer // 2])
        else:
            y = moe(hn, w_router[layer // 2], w_exp_gu[layer // 2], w_exp_down[layer // 2])
        h = h + gt_f[:, None, :] * y
    return rmsnorm(h, g_final)
```

```cpp
#include <hip/hip_runtime.h>
#include <hip/hip_bf16.h>
#include <cstdio>
#include <cstdint>
#include <cmath>
#ifndef MK_ONE_LAUNCH
#define MK_ONE_LAUNCH 0
#endif
namespace pg8 {
#define PG8_LAS __attribute__((address_space(3)))
typedef unsigned short bf16_t;
typedef short bf16x8 __attribute__((ext_vector_type(8)));
typedef float f32x4 __attribute__((ext_vector_type(4)));
typedef float f32x2 __attribute__((ext_vector_type(2)));
typedef unsigned u32x4 __attribute__((ext_vector_type(4)));
constexpr int BM = 256, BK = 64, HALF = 128, HTB = HALF * BK * 2  , STAGE_BYTES = 8 * HTB, NXCD = 8, WGM = 8;

__host__ __device__ __forceinline__ int lds_byte(int r, int c) { const int st = (r >> 4) * 2 + (c >> 5), rr = r & 15, cc = c & 31, ob = rr * 64 + cc * 2; return st * 1024 + (ob ^ (((ob >> 9) & 1) << 5)); }
__host__ __device__ __forceinline__ void stage_rc(int b, int& R, int& C) { const int st = b / 1024, sb = b % 1024, swz = sb ^ (((sb >> 9) & 1) << 5); R = (st >> 1) * 16 + swz / 64; C = (st & 1) * 32 + (swz % 64) / 2; }
__host__ __device__ __forceinline__ int perm32(int rho) { const int n = rho >> 4, i = rho & 15; return 8 * (i >> 2) + 4 * n + (i & 3); }

struct Unit { int pm, pn; };
struct Gemm { const bf16_t* A; const bf16_t* Bt; int M, N, K; };
struct MoeInfo { const int* list; const int* tile_expert; size_t bstride; };

struct StaticOrder {
    int nM, nN, nwg, G, c;
    __host__ __device__ void init(int M, int N, int G_, int c_) { nM = M / BM; nN = N / BM; nwg = nM * nN; G = G_; c = c_; }
    __host__ __device__ bool next(int i, Unit& u) const {
        const long L = (long)i * G + c; if (L >= nwg) return false;
        int wgid = (int)L; { const int q = nwg / NXCD, r = nwg % NXCD, xcd = wgid % NXCD, off = wgid / NXCD; wgid = (xcd < r ? xcd * (q + 1) : r * (q + 1) + (xcd - r) * q) + off; }
        const int nig = WGM * nN, gid = wgid / nig, fm = gid * WGM, gsz = (nM - fm) < WGM ? (nM - fm) : WGM;
        u.pm = fm + ((wgid % nig) % gsz); u.pn = (wgid % nig) / gsz; return true;
    }
    __device__ __forceinline__ void a_ready(const Unit&) const {}
    __device__ __forceinline__ void done(const Unit&) const {}
};

__device__ __forceinline__ unsigned cvt_pk_bf16(float lo, float hi) { unsigned r; asm volatile("v_cvt_pk_bf16_f32 %0, %1, %2" : "=v"(r) : "v"(lo), "v"(hi)); return r; }


template <class Epi, class Sched, bool ALIGN_EPI, bool SP2, int MODE>
__device__ __forceinline__ void gemm_phase(PG8_LAS unsigned char* lds, const Gemm g, const Sched& S, const Epi& E, const MoeInfo mi) {
    const int tid = threadIdx.x, wid = __builtin_amdgcn_readfirstlane(tid >> 6), lane = tid & 63, wr = wid >> 2, wc = wid & 3, fr = lane & 15, fq = lane >> 4;
    int K_ = g.K; asm volatile("" : "+s"(K_));
    const int K = K_, nt = K / BK;
    unsigned voffB[2]; int Rr[2], Cc[2];
#pragma unroll
    for (int i = 0; i < 2; ++i) { int R, C; stage_rc(tid * 16 + i * 8192, R, C); const int Rb = Epi::PERM ? ((R & ~31) + perm32(R & 31)) : R;
        Rr[i] = R; Cc[i] = C; voffB[i] = (unsigned)(Rb * K + C) * 2u; }
    const size_t kstep = (size_t)(BK * 2);
    const size_t hstep = (size_t)HALF * K * 2;
    const size_t tstep = 2 * hstep;
    const unsigned ldsw = (unsigned)wid * 1024u;
    const int aoff = lds_byte(wr * 64 + fr, fq * 8), boff = lds_byte(wc * 32 + fr, fq * 8);
    const unsigned rowb = (unsigned)K * 2u;
#define PG8_SA(b, h) (((b) * 2 + (h)) * HTB)
#define PG8_SB(b, h) ((4 + (b) * 2 + (h)) * HTB)
#define PG8_STAGE(bufoff, gbase, voff) do { _Pragma("unroll") for (int _i = 0; _i < 2; ++_i) \
        __builtin_amdgcn_global_load_lds((const unsigned*)((const char*)(gbase) + (voff)[_i]), (PG8_LAS unsigned*)(lds + (bufoff) + ldsw + _i * 8192), 16, 0, 0); } while (0)
#define PG8_LDA(dst, b, h) do { _Pragma("unroll") for (int m = 0; m < 4; ++m) _Pragma("unroll") for (int k = 0; k < 2; ++k) dst[m][k] = *(const PG8_LAS bf16x8*)(lds + PG8_SA(b, h) + aoff + m * 2048 + k * 1024); } while (0)
#define PG8_LDB(dst, b, h) do { _Pragma("unroll") for (int n = 0; n < 2; ++n) _Pragma("unroll") for (int k = 0; k < 2; ++k) dst[n][k] = *(const PG8_LAS bf16x8*)(lds + PG8_SB(b, h) + boff + n * 2048 + k * 1024); } while (0)
#define PG8_MMA(ai, bj, At, Bt) do { __builtin_amdgcn_s_setprio(1); _Pragma("unroll") for (int m = 0; m < 4; ++m) _Pragma("unroll") for (int n = 0; n < 2; ++n) _Pragma("unroll") for (int k = 0; k < 2; ++k) \
        acc[ai][bj][m][n] = __builtin_amdgcn_mfma_f32_16x16x32_bf16(Bt[n][k], At[m][k], acc[ai][bj][m][n], 0, 0, 0); __builtin_amdgcn_s_setprio(0); } while (0)
#define PG8_WAIT_V(n) asm volatile("s_waitcnt vmcnt(" #n ")" ::: "memory")
#define PG8_WAIT_L(n) asm volatile("s_waitcnt lgkmcnt(" #n ")" ::: "memory")
#define PG8_BAR __builtin_amdgcn_s_barrier()
#define PG8_SCHED __builtin_amdgcn_sched_barrier(0)
#define PG8_MKOFF(u, o) do { _Pragma("unroll") for (int _h = 0; _h < 2; ++_h) _Pragma("unroll") for (int _i = 0; _i < 2; ++_i) { \
        int _row = (u).pm * BM + _h * HALF + Rr[_i]; if (MODE == 1) _row = mi.list[_row]; (o)[_h][_i] = (unsigned)_row * rowb + (unsigned)Cc[_i] * 2u; } } while (0)
#define PG8_BBASE(u) ((const char*)g.Bt + (size_t)(u).pn * tstep + (MODE != 0 ? (size_t)mi.tile_expert[(u).pm] * mi.bstride : (size_t)0))
    Unit cur, nxt; int ui = 0;
    if (!S.next(0, cur)) return;
    f32x4 acc[2][2][4][2];
#pragma unroll
    for (int a = 0; a < 2; ++a)
#pragma unroll
        for (int b = 0; b < 2; ++b)
#pragma unroll
            for (int m = 0; m < 4; ++m)
#pragma unroll
                for (int n = 0; n < 2; ++n) acc[a][b][m][n] = (f32x4){0.f, 0.f, 0.f, 0.f};
    bf16x8 At[4][2], B0[2][2], B1[2][2];
    unsigned oc[2][2], on[2][2];
    PG8_MKOFF(cur, oc);
    const char* const Ab = (const char*)g.A;
    const char* cB = PG8_BBASE(cur);
    S.a_ready(cur);
    static_assert(SP2, "only the SP2 loop is kept");
    {
        PG8_STAGE(PG8_SB(0, 0), cB, voffB); PG8_STAGE(PG8_SB(0, 1), cB + hstep, voffB); PG8_STAGE(PG8_SA(0, 0), Ab, oc[0]); PG8_STAGE(PG8_SA(0, 1), Ab, oc[1]);
        if (wr == 1) PG8_BAR;
        PG8_WAIT_V(2); PG8_BAR;
        PG8_STAGE(PG8_SB(1, 0), cB + kstep, voffB); PG8_STAGE(PG8_SA(1, 0), Ab + kstep, oc[0]); PG8_STAGE(PG8_SB(1, 1), cB + hstep + kstep, voffB);
        PG8_WAIT_V(6); PG8_BAR;
    }
    for (;;) {
        const bool has_next = S.next(ui + 1, nxt);
        const char* nB = cB;
        if (has_next) { PG8_MKOFF(nxt, on); nB = PG8_BBASE(nxt); }
        else {
#pragma unroll
            for (int _h = 0; _h < 2; ++_h)
#pragma unroll
                for (int _i = 0; _i < 2; ++_i) on[_h][_i] = oc[_h][_i];
        }
        for (int t = 0; t < nt; t += 2) {
            const bool last = (t == nt - 2);
            const char* a1 = Ab + (size_t)(t + 1) * kstep;
            const char* a2 = last ? Ab : Ab + (size_t)(t + 2) * kstep; const char* b2 = last ? nB : cB + (size_t)(t + 2) * kstep;
            const char* a3 = a2 + kstep; const char* b3 = b2 + kstep;
            unsigned o2[2][2];
#pragma unroll
            for (int _h = 0; _h < 2; ++_h)
#pragma unroll
                for (int _i = 0; _i < 2; ++_i) o2[_h][_i] = last ? on[_h][_i] : oc[_h][_i];
            if (last && has_next) S.a_ready(nxt);
            PG8_LDB(B0, 0, 0); PG8_LDB(B1, 0, 1); PG8_SCHED; PG8_LDA(At, 0, 0); PG8_STAGE(PG8_SA(1, 1), a1, oc[1]);
            PG8_WAIT_V(8); PG8_WAIT_L(0); PG8_BAR; PG8_MMA(0, 0, At, B0); PG8_MMA(0, 1, At, B1); PG8_BAR; PG8_SCHED;
            PG8_LDA(At, 0, 1); PG8_STAGE(PG8_SB(0, 0), b2, voffB); PG8_STAGE(PG8_SB(0, 1), b2 + hstep, voffB); PG8_STAGE(PG8_SA(0, 0), a2, o2[0]);
            PG8_WAIT_V(8); PG8_WAIT_L(0); PG8_BAR; PG8_MMA(1, 0, At, B0); PG8_MMA(1, 1, At, B1); PG8_BAR; PG8_SCHED;
            PG8_LDB(B0, 1, 0); PG8_LDB(B1, 1, 1); PG8_SCHED; PG8_LDA(At, 1, 0); PG8_STAGE(PG8_SA(0, 1), a2, o2[1]);
            PG8_WAIT_V(8); PG8_WAIT_L(0); PG8_BAR; PG8_MMA(0, 0, At, B0); PG8_MMA(0, 1, At, B1); PG8_BAR; PG8_SCHED;
            PG8_LDA(At, 1, 1); PG8_STAGE(PG8_SB(1, 0), b3, voffB); PG8_STAGE(PG8_SB(1, 1), b3 + hstep, voffB); PG8_STAGE(PG8_SA(1, 0), a3, o2[0]);
            PG8_WAIT_V(8); PG8_WAIT_L(0); PG8_BAR; PG8_MMA(1, 0, At, B0); PG8_MMA(1, 1, At, B1); PG8_BAR; PG8_SCHED;
        }
        if constexpr (ALIGN_EPI) { if (wr == 0) PG8_BAR; }
        E(acc, cur, wr, wc, fr, fq); S.done(cur);
        if (!has_next) break;
#pragma unroll
        for (int a = 0; a < 2; ++a)
#pragma unroll
            for (int b = 0; b < 2; ++b)
#pragma unroll
                for (int m = 0; m < 4; ++m)
#pragma unroll
                    for (int n = 0; n < 2; ++n) acc[a][b][m][n] = (f32x4){0.f, 0.f, 0.f, 0.f};
        cur = nxt; cB = nB; ++ui;
#pragma unroll
        for (int _h = 0; _h < 2; ++_h)
#pragma unroll
            for (int _i = 0; _i < 2; ++_i) oc[_h][_i] = on[_h][_i];
        if constexpr (ALIGN_EPI) { if (wr == 1) PG8_BAR; }
    }
    PG8_WAIT_V(0);
    if constexpr (!ALIGN_EPI) { if (wr == 0) PG8_BAR; }
    PG8_BAR;
#undef PG8_SA
#undef PG8_SB
#undef PG8_STAGE
#undef PG8_LDA
#undef PG8_LDB
#undef PG8_MMA
#undef PG8_WAIT_V
#undef PG8_WAIT_L
#undef PG8_BAR
#undef PG8_SCHED
#undef PG8_MKOFF
#undef PG8_BBASE
}
}
namespace pg8 {
constexpr float LOG2E = 1.4426950408889634f;
struct EpiBf16 {
    static constexpr bool PERM = true;
    bf16_t* O; int ldc; float scale;
    __device__ __forceinline__ void operator()(const f32x4 (&acc)[2][2][4][2], const Unit& u, int wr, int wc, int fr, int fq) const {
        const int row0 = u.pm * BM + wr * 64 + fr; const int col0 = u.pn * BM + wc * 32 + 8 * fq;
#pragma unroll
        for (int ai = 0; ai < 2; ++ai)
#pragma unroll
            for (int m = 0; m < 4; ++m) { bf16_t* rowp = O + (size_t)(row0 + ai * HALF + m * 16) * ldc + col0;
#pragma unroll
                for (int bj = 0; bj < 2; ++bj) { const f32x4 v0 = acc[ai][bj][m][0] * scale, v1 = acc[ai][bj][m][1] * scale;
                    u32x4 w; w.x = cvt_pk_bf16(v0[0], v0[1]); w.y = cvt_pk_bf16(v0[2], v0[3]); w.z = cvt_pk_bf16(v1[0], v1[1]); w.w = cvt_pk_bf16(v1[2], v1[3]);
                    *(u32x4*)(rowp + bj * HALF) = w; } }
    }
};
struct EpiQ {
    static constexpr bool PERM = true;
    bf16_t* O; int ldc; float scale; const float* cs;
    __device__ __forceinline__ void operator()(const f32x4 (&acc)[2][2][4][2], const Unit& u, int wr, int wc, int fr, int fq) const {
        const int row0 = u.pm * BM + wr * 64 + fr; const int col0 = u.pn * BM + wc * 32 + 8 * fq;
        const int grp = u.pn * 8 + wc;
#pragma unroll
        for (int bj = 0; bj < 2; ++bj) { const bool rope = ((grp + 4 * bj) % 3) == 2;
#pragma unroll
            for (int ai = 0; ai < 2; ++ai)
#pragma unroll
                for (int m = 0; m < 4; ++m) { const int row = row0 + ai * HALF + m * 16; bf16_t* rowp = O + (size_t)row * ldc + col0 + bj * HALF;
                    f32x4 v0 = acc[ai][bj][m][0] * scale, v1 = acc[ai][bj][m][1] * scale;
                    if (rope) { const f32x4* cp = (const f32x4*)(cs + (size_t)row * 32 + 8 * fq); const f32x4 c0 = cp[0], c1 = cp[1];
                        f32x4 r0, r1;
                        r0[0] = v0[0] * c0[0] - v0[1] * c0[1]; r0[1] = v0[0] * c0[1] + v0[1] * c0[0];
                        r0[2] = v0[2] * c0[2] - v0[3] * c0[3]; r0[3] = v0[2] * c0[3] + v0[3] * c0[2];
                        r1[0] = v1[0] * c1[0] - v1[1] * c1[1]; r1[1] = v1[0] * c1[1] + v1[1] * c1[0];
                        r1[2] = v1[2] * c1[2] - v1[3] * c1[3]; r1[3] = v1[2] * c1[3] + v1[3] * c1[2];
                        v0 = r0; v1 = r1; }
                    u32x4 w; w.x = cvt_pk_bf16(v0[0], v0[1]); w.y = cvt_pk_bf16(v0[2], v0[3]); w.z = cvt_pk_bf16(v1[0], v1[1]); w.w = cvt_pk_bf16(v1[2], v1[3]);
                    *(u32x4*)rowp = w;
                    if (m & 1) asm volatile("" ::: "memory"); } }
    }
};
struct EpiKV {
    static constexpr bool PERM = true;
    bf16_t* Kb; bf16_t* Vb;
    __device__ __forceinline__ void operator()(const f32x4 (&acc)[2][2][4][2], const Unit& u, int wr, int wc, int fr, int fq) const {
        const int row0 = u.pm * BM + wr * 64 + fr;
        const bool isk = wc < 2;
        bf16_t* const base = isk ? Kb : Vb; const int pitch = isk ? 1536 : 1024, hs = isk ? 96 : 64, j0 = (isk ? wc : wc - 2) * 32 + 8 * fq;
#pragma unroll
        for (int ai = 0; ai < 2; ++ai)
#pragma unroll
            for (int m = 0; m < 4; ++m) { bf16_t* rowp = base + (size_t)(row0 + ai * HALF + m * 16) * pitch + j0;
#pragma unroll
                for (int bj = 0; bj < 2; ++bj) { const f32x4 v0 = acc[ai][bj][m][0], v1 = acc[ai][bj][m][1];
                    u32x4 w; w.x = cvt_pk_bf16(v0[0], v0[1]); w.y = cvt_pk_bf16(v0[2], v0[3]); w.z = cvt_pk_bf16(v1[0], v1[1]); w.w = cvt_pk_bf16(v1[2], v1[3]);
                    *(u32x4*)(rowp + (2 * u.pn + bj) * hs) = w; } }
    }
};
struct EpiResid {
    static constexpr bool PERM = false;
    const float* base; float* out; const float* gate;
    __device__ __forceinline__ void operator()(const f32x4 (&acc)[2][2][4][2], const Unit& u, int wr, int wc, int fr, int fq) const {
        const int row0 = u.pm * BM + wr * 64 + fr; const int col0 = u.pn * BM + wc * 32 + 4 * fq;
        const float* gp = gate + (size_t)((u.pm * BM) >> 13) * 1024 + col0;
        f32x4 gv[2][2];
#pragma unroll
        for (int bj = 0; bj < 2; ++bj)
#pragma unroll
            for (int n = 0; n < 2; ++n) gv[bj][n] = *(const f32x4*)(gp + bj * HALF + n * 16);
#pragma unroll
        for (int ai = 0; ai < 2; ++ai)
#pragma unroll
            for (int m = 0; m < 4; ++m) { const size_t off = (size_t)(row0 + ai * HALF + m * 16) * 1024 + col0;
#pragma unroll
                for (int bj = 0; bj < 2; ++bj)
#pragma unroll
                    for (int n = 0; n < 2; ++n) { const f32x4 bs = *(const f32x4*)(base + off + bj * HALF + n * 16);
                        *(f32x4*)(out + off + bj * HALF + n * 16) = bs + gv[bj][n] * acc[ai][bj][m][n]; }
                if (m & 1) asm volatile("" ::: "memory"); }
    }
};
__device__ __forceinline__ float silu_mul(float g, float u) { return g * u * __builtin_amdgcn_rcpf(1.0f + __builtin_amdgcn_exp2f(-g * LOG2E)); }
struct EpiSwiGLU {
    static constexpr bool PERM = true;
    bf16_t* O; int ldc;
    __device__ __forceinline__ void operator()(const f32x4 (&acc)[2][2][4][2], const Unit& u, int wr, int wc, int fr, int fq) const {
        const int row0 = u.pm * BM + wr * 64 + fr; const int col0 = u.pn * HALF + wc * 32 + 8 * fq;
#pragma unroll
        for (int ai = 0; ai < 2; ++ai)
#pragma unroll
            for (int m = 0; m < 4; ++m) { bf16_t* rowp = O + (size_t)(row0 + ai * HALF + m * 16) * ldc + col0;
                const f32x4 g0 = acc[ai][0][m][0], g1 = acc[ai][0][m][1], u0 = acc[ai][1][m][0], u1 = acc[ai][1][m][1];
                u32x4 w; w.x = cvt_pk_bf16(silu_mul(g0[0], u0[0]), silu_mul(g0[1], u0[1])); w.y = cvt_pk_bf16(silu_mul(g0[2], u0[2]), silu_mul(g0[3], u0[3]));
                w.z = cvt_pk_bf16(silu_mul(g1[0], u1[0]), silu_mul(g1[1], u1[1])); w.w = cvt_pk_bf16(silu_mul(g1[2], u1[2]), silu_mul(g1[3], u1[3]));
                *(u32x4*)rowp = w; }
    }
};
struct EpiMoeDown {
    static constexpr bool PERM = true;
    bf16_t* O; const float* sg;
    __device__ __forceinline__ void operator()(const f32x4 (&acc)[2][2][4][2], const Unit& u, int wr, int wc, int fr, int fq) const {
        const int row0 = u.pm * BM + wr * 64 + fr; const int col0 = u.pn * BM + wc * 32 + 8 * fq;
#pragma unroll
        for (int ai = 0; ai < 2; ++ai)
#pragma unroll
            for (int m = 0; m < 4; ++m) { const int row = row0 + ai * HALF + m * 16; const float s = sg[row]; bf16_t* rowp = O + (size_t)row * 1024 + col0;
#pragma unroll
                for (int bj = 0; bj < 2; ++bj) { const f32x4 v0 = acc[ai][bj][m][0] * s, v1 = acc[ai][bj][m][1] * s;
                    u32x4 w; w.x = cvt_pk_bf16(v0[0], v0[1]); w.y = cvt_pk_bf16(v0[2], v0[3]); w.z = cvt_pk_bf16(v1[0], v1[1]); w.w = cvt_pk_bf16(v1[2], v1[3]);
                    *(u32x4*)(rowp + bj * HALF) = w; } }
    }
};
}
namespace att {
using bf16 = unsigned short;
using bf16x8 = __attribute__((ext_vector_type(8))) short;
using s16x4 = __attribute__((ext_vector_type(4))) short;
using f32x16 = __attribute__((ext_vector_type(16))) float;
using u32x4 = __attribute__((ext_vector_type(4))) unsigned;
constexpr int NW = 8;
constexpr float THR = 8.0f;
__device__ __forceinline__ int crow(int r, int hi) { return (r & 3) + 8 * (r >> 2) + 4 * hi; }
__device__ __forceinline__ void glds16(const void* gsrc, unsigned lds_dst) { unsigned keep;
    asm volatile("s_mov_b32 %0, m0\n\ts_mov_b32 m0, %2\n\ts_nop 0\n\tglobal_load_lds_dwordx4 %1, off\n\ts_mov_b32 m0, %0" : "=&s"(keep) : "v"(gsrc), "s"(lds_dst) : "memory"); }
typedef float f32x2_t __attribute__((ext_vector_type(2))); typedef __bf16 bf16x2_t __attribute__((ext_vector_type(2)));
__device__ __forceinline__ unsigned cvtpk_s(float lo, float hi) { f32x2_t v = {lo, hi}; bf16x2_t b = __builtin_convertvector(v, bf16x2_t); return __builtin_bit_cast(unsigned, b); }
#define ATT_SBAR() __builtin_amdgcn_sched_barrier(0)
#define ATT_WAIT_BAR(N) asm volatile("s_waitcnt vmcnt(" #N ") lgkmcnt(0)\n\ts_barrier" ::: "memory")

template <int DQK> struct Lay {
    static constexpr int NKC = DQK / 8, KSLOT = NKC * 1024, ND0 = DQK / 16;
    static constexpr int LK = 0, LV = 3 * KSLOT, LWS = LV + 3 * 8192, LOST = LWS + NW * 256, LBIAS = LOST + NW * 4096, LEND = LBIAS + 1024;
};
static_assert(Lay<96>::LEND <= 131072 && Lay<64>::LEND <= 131072, "attention LDS");

__device__ __forceinline__ float rowmax32(const f32x16& p0, const f32x16& p1) {
    float a = __builtin_fmaxf(__builtin_fmaxf(p0[0], p0[1]), p1[0]), b = __builtin_fmaxf(__builtin_fmaxf(p0[2], p0[3]), p1[1]); a = __builtin_fmaxf(__builtin_fmaxf(a, p1[2]), p1[3]);
#pragma unroll
    for (int r = 4; r < 16; r += 4) { a = __builtin_fmaxf(__builtin_fmaxf(a, p0[r]), p0[r + 1]); b = __builtin_fmaxf(__builtin_fmaxf(b, p0[r + 2]), p0[r + 3]); a = __builtin_fmaxf(__builtin_fmaxf(a, p1[r]), p1[r + 1]); b = __builtin_fmaxf(__builtin_fmaxf(b, p1[r + 2]), p1[r + 3]); }
    float m = __builtin_fmaxf(a, b);
    auto rr = __builtin_amdgcn_permlane32_swap(__float_as_uint(m), __float_as_uint(m), false, false);
    return __builtin_fmaxf(__uint_as_float(rr[0]), __uint_as_float(rr[1]));
}
__device__ __forceinline__ void pv(f32x16* o, int vb, bf16x8 pa0, bf16x8 pa1, bf16x8 pa2, bf16x8 pa3) {
#pragma unroll
    for (int d0 = 0; d0 < 2; ++d0) { s16x4 lo[4], hi[4];
#pragma unroll
        for (int ks = 0; ks < 4; ++ks) {
            asm volatile("ds_read_b64_tr_b16 %0,%1 offset:%c2" : "=&v"(lo[ks]) : "v"(vb), "i"(d0 * 4096 + ks * 1024) : "memory");
            asm volatile("ds_read_b64_tr_b16 %0,%1 offset:%c2" : "=&v"(hi[ks]) : "v"(vb), "i"(d0 * 4096 + ks * 1024 + 512) : "memory"); }
        asm volatile("s_waitcnt lgkmcnt(0)" ::: "memory"); ATT_SBAR();
#define ATT_PK(k) (bf16x8){lo[k][0], lo[k][1], lo[k][2], lo[k][3], hi[k][0], hi[k][1], hi[k][2], hi[k][3]}
        o[d0] = __builtin_amdgcn_mfma_f32_32x32x16_bf16(pa0, ATT_PK(0), o[d0], 0, 0, 0);
        o[d0] = __builtin_amdgcn_mfma_f32_32x32x16_bf16(pa1, ATT_PK(1), o[d0], 0, 0, 0);
        o[d0] = __builtin_amdgcn_mfma_f32_32x32x16_bf16(pa2, ATT_PK(2), o[d0], 0, 0, 0);
        o[d0] = __builtin_amdgcn_mfma_f32_32x32x16_bf16(pa3, ATT_PK(3), o[d0], 0, 0, 0);
#undef ATT_PK
    }
}

template <int DQK, bool DIL>
__device__ __forceinline__ void attn_unit(const bf16* Qb, int pq, const bf16* __restrict__ Kb, int pk, const bf16* __restrict__ Vb, int pvp, bf16* Ob, int po, float* lse, const float* biasg,
                                          long rowbase, int dil, int q0, char* shm) {
    typedef Lay<DQK> L;
    const int tid = threadIdx.x, lane = tid & 63, r32 = lane & 31, hi = lane >> 5; const int wid = __builtin_amdgcn_readfirstlane(tid >> 6);
    const unsigned lds0 = (unsigned)(uintptr_t)shm;
    float* wsf = (float*)(shm + L::LWS) + wid * 64;
    const int kpos0 = DIL ? q0 - 128 : 0;
    const int t_begin = DIL ? (q0 == 0 ? 2 : 0) : 0;
    const int t_end = DIL ? 6 : (q0 + 256) / 64;
    const int wt0 = DIL ? (wid >> 1) : 0;
    const int wt1 = DIL ? 2 + (wid >> 1) : (q0 + 32 * wid + 31) / 64;
    const bool two_k = (L::NKC > 8) && (wid + 8 < L::NKC);
#define ATT_GROW(pos) (rowbase + (long)(pos) * dil)
#define ATT_ISSUE(t, s) do { const int kp_ = kpos0 + 64 * (t); \
        glds16(Kb + ATT_GROW(kp_ + lane) * pk + wid * 8, (unsigned)__builtin_amdgcn_readfirstlane(lds0 + L::LK + (s) * L::KSLOT + wid * 1024)); \
        if (two_k) glds16(Kb + ATT_GROW(kp_ + lane) * pk + (wid + 8) * 8, (unsigned)__builtin_amdgcn_readfirstlane(lds0 + L::LK + (s) * L::KSLOT + (wid + 8) * 1024)); \
        glds16(Vb + ATT_GROW(kp_ + 16 * (wid & 3) + (lane >> 2)) * pvp + (wid >> 2) * 32 + (lane & 3) * 8, (unsigned)__builtin_amdgcn_readfirstlane(lds0 + L::LV + (s) * 8192 + wid * 1024)); } while (0)
    if (DIL) { if (tid < 129) ((float*)(shm + L::LBIAS))[tid] = biasg[tid]; }
    ATT_ISSUE(t_begin, 0);
    if (t_begin + 1 < t_end) ATT_ISSUE(t_begin + 1, 1);
    bf16x8 qr[L::ND0];
    { const bf16* Qw = Qb + ATT_GROW(q0 + wid * 32 + r32) * pq + hi * 8;
#pragma unroll
      for (int d0 = 0; d0 < L::ND0; ++d0) qr[d0] = *reinterpret_cast<const bf16x8*>(Qw + d0 * 16); }
    float mhat = 0.f, l_reg = 0.f; f32x16 o[2]; o[0] = f32x16{}; o[1] = f32x16{}; f32x16 negm = f32x16{};
    bool first = true;
    const int qrel = (DIL ? 128 : q0) + wid * 32 + r32;
    const int vbl = (int)(lds0 + L::LV) + ((lane >> 4) & 1) * 32 + (lane & 3) * 8 + (4 * hi + ((lane & 15) >> 2)) * 64;
    int slot = 0;
    for (int t = t_begin; t < t_end; ++t) {
        if (t + 1 < t_end) { if (two_k) ATT_WAIT_BAR(3); else ATT_WAIT_BAR(2); } else ATT_WAIT_BAR(0);
        if (t + 2 < t_end) { const int s2 = slot >= 1 ? slot - 1 : 2; ATT_ISSUE(t + 2, s2); }
        if (t >= wt0 && t <= wt1) {
            f32x16 p0, p1;
            { const char* kb = shm + L::LK + slot * L::KSLOT + hi * 1024 + r32 * 16;
#pragma unroll
              for (int d0 = 0; d0 < L::ND0; ++d0) {
                const bf16x8 b0 = *reinterpret_cast<const bf16x8*>(kb + d0 * 2048);
                const bf16x8 b1 = *reinterpret_cast<const bf16x8*>(kb + d0 * 2048 + 512);
                if (d0 == 0) { p0 = __builtin_amdgcn_mfma_f32_32x32x16_bf16(b0, qr[0], negm, 0, 0, 0); p1 = __builtin_amdgcn_mfma_f32_32x32x16_bf16(b1, qr[0], negm, 0, 0, 0); }
                else { p0 = __builtin_amdgcn_mfma_f32_32x32x16_bf16(b0, qr[d0], p0, 0, 0, 0); p1 = __builtin_amdgcn_mfma_f32_32x32x16_bf16(b1, qr[d0], p1, 0, 0, 0); } } }
            if (DIL) { const float* bl = (const float*)(shm + L::LBIAS); const int jb = qrel - 64 * t - 4 * hi;
#pragma unroll
                for (int r = 0; r < 16; ++r) { const int j0 = jb - ((r & 3) + 8 * (r >> 2)), j1 = j0 - 32;
                    const int c0 = j0 < 0 ? 0 : (j0 > 128 ? 128 : j0), c1 = j1 < 0 ? 0 : (j1 > 128 ? 128 : j1);
                    const float b0 = bl[c0], b1 = bl[c1];
                    p0[r] = (j0 >= 0 && j0 <= 128) ? p0[r] + b0 : -INFINITY; p1[r] = (j1 >= 0 && j1 <= 128) ? p1[r] + b1 : -INFINITY; }
            } else if (64 * t + 63 > q0 + 32 * wid) { const int jb = qrel - 64 * t - 4 * hi;
#pragma unroll
                for (int r = 0; r < 16; ++r) { const int j0 = jb - ((r & 3) + 8 * (r >> 2)); if (j0 < 0) p0[r] = -INFINITY; if (j0 - 32 < 0) p1[r] = -INFINITY; } }
            const float rm = rowmax32(p0, p1);
            if (first) { first = false; const float dl = rm; mhat += dl;
#pragma unroll
                for (int r = 0; r < 16; ++r) { p0[r] -= dl; p1[r] -= dl; }
#pragma unroll
                for (int r = 0; r < 16; ++r) negm[r] = -mhat;
            } else if (__any(rm > THR)) { const float dl = __builtin_fmaxf(rm, 0.f); mhat += dl;
#pragma unroll
                for (int r = 0; r < 16; ++r) { p0[r] -= dl; p1[r] -= dl; }
#pragma unroll
                for (int r = 0; r < 16; ++r) negm[r] = -mhat;
                const float f = __builtin_amdgcn_exp2f(-dl); l_reg *= f; if (hi == 0) wsf[r32] = f;
                asm volatile("s_waitcnt lgkmcnt(0)" ::: "memory");
#pragma unroll
                for (int d_ = 0; d_ < 2; ++d_)
#pragma unroll
                    for (int r = 0; r < 16; ++r) o[d_][r] *= wsf[crow(r, hi)];
                asm volatile("s_waitcnt lgkmcnt(0)" ::: "memory");
            }
            float sacc = 0.f;
#pragma unroll
            for (int r = 0; r < 16; ++r) { p0[r] = __builtin_amdgcn_exp2f(p0[r]); p1[r] = __builtin_amdgcn_exp2f(p1[r]); sacc += p0[r] + p1[r]; }
            l_reg += sacc;
            u32x4 pw0, pw1, pw2, pw3;
#define ATT_PKW(P, B) cvtpk_s(P[B], P[B + 1])
            pw0 = (u32x4){ATT_PKW(p0, 0), ATT_PKW(p0, 2), ATT_PKW(p0, 4), ATT_PKW(p0, 6)}; pw1 = (u32x4){ATT_PKW(p0, 8), ATT_PKW(p0, 10), ATT_PKW(p0, 12), ATT_PKW(p0, 14)};
            pw2 = (u32x4){ATT_PKW(p1, 0), ATT_PKW(p1, 2), ATT_PKW(p1, 4), ATT_PKW(p1, 6)}; pw3 = (u32x4){ATT_PKW(p1, 8), ATT_PKW(p1, 10), ATT_PKW(p1, 12), ATT_PKW(p1, 14)};
#undef ATT_PKW
            ATT_SBAR();
            pv(o, vbl + slot * 8192, __builtin_bit_cast(bf16x8, pw0), __builtin_bit_cast(bf16x8, pw1), __builtin_bit_cast(bf16x8, pw2), __builtin_bit_cast(bf16x8, pw3));
        }
        slot = slot == 2 ? 0 : slot + 1;
    }
    { auto rr = __builtin_amdgcn_permlane32_swap(__float_as_uint(l_reg), __float_as_uint(l_reg), false, false); l_reg = __uint_as_float(rr[0]) + __uint_as_float(rr[1]); }
    if (hi == 0) wsf[32 + r32] = l_reg;
    asm volatile("s_waitcnt lgkmcnt(0)" ::: "memory");
    float rli[16];
#pragma unroll
    for (int r = 0; r < 16; ++r) rli[r] = __builtin_amdgcn_rcpf(wsf[32 + crow(r, hi)]);
    if (DIL) { if (hi == 0) lse[ATT_GROW(q0 + wid * 32 + r32) * 8] = mhat + __builtin_amdgcn_logf(l_reg); }
    { bf16* stg = (bf16*)(shm + L::LOST) + wid * 2048;
#pragma unroll
      for (int r = 0; r < 16; ++r) { const int orow = crow(r, hi);
#pragma unroll
        for (int d0 = 0; d0 < 2; ++d0) stg[orow * 64 + d0 * 32 + r32] = (bf16)(cvtpk_s(o[d0][r] * rli[r], 0.f) & 0xffffu); }
      asm volatile("s_waitcnt lgkmcnt(0)" ::: "memory");
#pragma unroll
      for (int i = 0; i < 4; ++i) { const int row = i * 8 + (lane >> 3), ch = lane & 7; const u32x4 v = *(const u32x4*)(stg + row * 64 + ch * 8);
        *(u32x4*)(Ob + ATT_GROW(q0 + wid * 32 + row) * po + ch * 8) = v; } }
    asm volatile("s_waitcnt lgkmcnt(0)\n\ts_barrier" ::: "memory");
#undef ATT_GROW
#undef ATT_ISSUE
}
#undef ATT_SBAR
#undef ATT_WAIT_BAR
}
constexpr int NWAVES = 8;
constexpr int BATCH = 4, SEQ = 8192, D = 1024, M = BATCH * SEQ;
constexpr int MLA_H = 16, QRANK = 384, KVRANK = 256, LATN = 672, LATP = 768, QUP = 1536, KVUP = 2048;
constexpr int DFF = 2816, NEXP = 8, DILQ = 1536, DILKV = 3072, DILOUT = 512;
constexpr int MAXSLOT = 67584;
constexpr float EPS = 1e-6f;
constexpr float C2_MLA = 0.1472444460259031f;
constexpr float C2_DIL = 0.18033688011112042f;
constexpr float LOG2E_F = 1.4426950408889634f;

constexpr size_t MiB = 1u << 20;
constexpr size_t WS_CTL = 0, CTL_ZERO_BYTES = 64 * 1024;
constexpr size_t WS_MODV = 1 * MiB;
constexpr size_t WS_BIAS = 1 * MiB + 256 * 1024;
constexpr size_t WS_ROUTE = 1 * MiB + 512 * 1024;
constexpr size_t WS_CNT = 2 * MiB;
constexpr size_t WS_LIST = 2 * MiB + 256 * 1024;
constexpr size_t WS_SLOTG = 2 * MiB + 768 * 1024;
constexpr size_t WS_TOKSLOT = 3 * MiB + 256 * 1024;
constexpr size_t WS_TILEEXP = 3 * MiB + 768 * 1024;
constexpr size_t WS_CS = 4 * MiB;
constexpr size_t WS_LSE = 8 * MiB;
constexpr size_t WS_WEGU = 12 * MiB, WS_WEDN = 100 * MiB, WS_WFGU = 144 * MiB, WS_WFDN = 155 * MiB, WS_WKVB = 161 * MiB, WS_WQB = 167 * MiB, WS_WOUT = 170 * MiB,
                 WS_WOB = 172 * MiB, WS_WMLAIN = 173 * MiB, WS_WQUP = 175 * MiB, WS_WKVUP = 177 * MiB;
constexpr size_t WS_ARENA = 180 * MiB;
constexpr size_t A_XN = WS_ARENA, A_LAT = WS_ARENA + 64 * MiB, A_QN = WS_ARENA + 112 * MiB, A_KVN = WS_ARENA + 136 * MiB, A_Q = WS_ARENA + 152 * MiB, A_K = WS_ARENA + 248 * MiB,
                 A_V = WS_ARENA + 344 * MiB, A_O = WS_ARENA + 408 * MiB, A_HID = WS_ARENA + 64 * MiB, A_XNKV = WS_ARENA + 64 * MiB, A_KVB = WS_ARENA + 128 * MiB, A_QB = WS_ARENA + 320 * MiB,
                 A_OG = WS_ARENA, A_OD = WS_ARENA + 128 * MiB, A_HIDS = WS_ARENA + 160 * MiB, A_Y = WS_ARENA;
constexpr size_t WS_END = WS_ARENA + 523 * MiB;
static_assert(A_HIDS + (size_t)MAXSLOT * DFF * 2 <= WS_END && A_Y + (size_t)MAXSLOT * D * 2 <= A_HIDS && A_O + (size_t)M * D * 2 <= WS_END, "arena map");
static_assert(WS_WEGU + (size_t)NEXP * 2 * DFF * D * 2 <= WS_WEDN && WS_WEDN + (size_t)NEXP * D * DFF * 2 <= WS_WFGU && WS_WFGU + (size_t)2 * DFF * D * 2 <= WS_WFDN && WS_WFDN + (size_t)D * DFF * 2 <= WS_WKVB, "weight map");
enum ModKind { MK_A_MIX0 = 0, MK_B_MIX0, MK_G_MIX0, MK_A_FFN0, MK_B_FFN0, MK_G_FFN0, MK_A_MIX1, MK_B_MIX1, MK_G_MIX1, MK_A_FFN1, MK_B_FFN1, MK_G_FFN1, MK_A_KV, MK_B_KV };
constexpr int CW_BAR = 4096;

constexpr int RING_BYTES = 131072;
constexpr int LDSCTL_OFF = RING_BYTES, MISC_OFF = LDSCTL_OFF + 320;
constexpr int LDS_BYTES = 147456;

#define GAS __attribute__((address_space(1)))
#define LAS __attribute__((address_space(3)))
typedef unsigned short bf16;
typedef unsigned v4u __attribute__((ext_vector_type(4)));
typedef unsigned v2u __attribute__((ext_vector_type(2)));
typedef float f32x4 __attribute__((ext_vector_type(4)));
typedef GAS unsigned gu32;
#define RLX_AGENT __ATOMIC_RELAXED, __HIP_MEMORY_SCOPE_AGENT
#define LDS_WAIT() asm volatile("s_waitcnt lgkmcnt(0)" ::: "memory")
#define VM_WAIT() asm volatile("s_waitcnt vmcnt(0)" ::: "memory")
__device__ __forceinline__ unsigned f2bf(float f) { unsigned u = __builtin_bit_cast(unsigned, f); return (u + 0x7fffu + ((u >> 16) & 1u)) >> 16; }
__device__ __forceinline__ unsigned pk2(float lo, float hi) { return f2bf(lo) | (f2bf(hi) << 16); }
__device__ __forceinline__ float bf_lo(unsigned w) { return __builtin_bit_cast(float, w << 16); }
__device__ __forceinline__ float bf_hi(unsigned w) { return __builtin_bit_cast(float, w & 0xffff0000u); }
__device__ __forceinline__ float wave_sum(float v) {
#pragma unroll
    for (int o = 1; o < 64; o <<= 1) v += __shfl_xor(v, o);
    return v;
}

#define XB_TMO      128
#define XB_XCNT(j)  (256  + 64 * (j))
#define XB_XSUB(j)  (1280 + 64 * (j))
#define XB_XGEN(j)  (2304 + 64 * (j))
#define XB_TOP      3328
#define XB_TOPGEN   3392
#define XCD_BAR_WORDS 3456
#define XB_SPIN_CAP (1u << 18)
__device__ __forceinline__ unsigned xb_ld(unsigned* p)              { return __hip_atomic_load(p, __ATOMIC_RELAXED, __HIP_MEMORY_SCOPE_AGENT); }
__device__ __forceinline__ unsigned xb_add(unsigned* p, unsigned v) { return __hip_atomic_fetch_add(p, v, __ATOMIC_RELAXED, __HIP_MEMORY_SCOPE_AGENT); }
__device__ __forceinline__ unsigned xb_xcc_id() { return (unsigned)__builtin_amdgcn_s_getreg((3 << 11) | 20) & 0xFu; }
#define XB_SPIN(cond, bar) do { unsigned _sp = 0; while (cond) { __builtin_amdgcn_s_sleep(1); \
    if ((++_sp & 255u) == 0u) { if (xb_ld(&(bar)[XB_TMO])) break; if (_sp > XB_SPIN_CAP) { atomicAdd(&(bar)[XB_TMO], 1u); break; } } } } while (0)
struct XcdBarrier { unsigned* bar; unsigned x; volatile LAS unsigned* st; };
__device__ __forceinline__ XcdBarrier xcd_barrier_post(unsigned* bar, volatile LAS unsigned* st) {
    XcdBarrier b; b.bar = bar; b.x = xb_xcc_id(); b.st = st;
    if (threadIdx.x == 0) (void)xb_add(&bar[XB_XCNT(b.x)], 1u);
    return b;
}
__device__ __forceinline__ void xcd_barrier_complete(unsigned* bar, unsigned x, unsigned& nloc, unsigned& nx) {
    const unsigned G = gridDim.x * gridDim.y * gridDim.z;
    unsigned sum, cnt, mine, sp = 0u;
    for (;;) {
        sum = 0u; cnt = 0u; mine = 0u;
#pragma unroll
        for (unsigned j = 0; j < 16; ++j) { const unsigned c = xb_ld(&bar[XB_XCNT(j)]); sum += c; cnt += (c > 0u) ? 1u : 0u; mine = (j == x) ? c : mine; }
        if (sum == G) break;
        __builtin_amdgcn_s_sleep(1);
        if ((++sp & 255u) == 0u) { if (xb_ld(&bar[XB_TMO])) break; if (sp > XB_SPIN_CAP) { atomicAdd(&bar[XB_TMO], 1u); break; } }
    }
    nloc = mine > 0u ? mine : 1u; nx = cnt > 0u ? cnt : 1u;
}
__device__ __forceinline__ void xcd_barrier(const XcdBarrier& b) {
    asm volatile("s_waitcnt vmcnt(0)" ::: "memory");
    __syncthreads();
    if (threadIdx.x == 0) {
        unsigned* bar = b.bar;
        __builtin_amdgcn_s_waitcnt(0);
        unsigned nloc = b.st[0], nx = b.st[1];
        if (nloc == 0u) { xcd_barrier_complete(bar, b.x, nloc, nx); b.st[0] = nloc; b.st[1] = nx; }
        const unsigned old = xb_add(&bar[XB_XSUB(b.x)], 1u);
        const unsigned gen = old / nloc;
        if (old + 1u == (gen + 1u) * nloc) {
            __builtin_amdgcn_fence(__ATOMIC_RELEASE, "agent");
            asm volatile("s_waitcnt vmcnt(0)" ::: "memory");
            const unsigned og = xb_add(&bar[XB_TOP], 1u);
            const unsigned tg = og / nx;
            if (og + 1u == (tg + 1u) * nx) xb_add(&bar[XB_TOPGEN], 1u);
            else XB_SPIN(xb_ld(&bar[XB_TOPGEN]) == tg, bar);
            __builtin_amdgcn_fence(__ATOMIC_ACQUIRE, "agent");
            xb_add(&bar[XB_XGEN(b.x)], 1u);
            asm volatile("s_waitcnt vmcnt(0)" ::: "memory");
        } else {
            XB_SPIN(xb_ld(&bar[XB_XGEN(b.x)]) == gen, bar);
            __builtin_amdgcn_fence(__ATOMIC_ACQUIRE, "agent");
            asm volatile("s_waitcnt vmcnt(0)" ::: "memory");
        }
    }
    __syncthreads();
}

struct Frame {
    LAS unsigned char* lds;
    volatile LAS unsigned* MISC;
    int tid, lane, wave;
    int vcu, G;
    unsigned char* ws;
    const float* in[26];
    float* out;
};
enum { MAP_PLAIN = 0, MAP_MLAIN = 1, MAP_QUP = 2, MAP_GU = 3 };
template <int MAP> __device__ __forceinline__ int dmap(int n) {
    if (MAP == MAP_MLAIN) { if (n < 640) return n; if (n < 656) return 640 + 2 * (n - 640); return 640 + 2 * (n - 656) + 1; }
    if (MAP == MAP_QUP) { const int h = n / 96, j = n % 96; if (j < 64) return n; if (j < 80) return h * 96 + 64 + 2 * (j - 64); return h * 96 + 64 + 2 * (j - 80) + 1; }
    if (MAP == MAP_GU) { const int up = n >= DFF ? 1 : 0; const int c = up ? n - DFF : n; return (c >> 7) * 256 + up * 128 + (c & 127); }
    return n;
}
template <int MAP> __device__ __forceinline__ void transpose_item(const float* W, int K, int N, bf16* WT, const float* ks, LAS float* scr, int item, int lane) {
    const int nblk = N / 32, kb = item / nblk, nb = item % nblk, k0 = 64 * kb, n0 = 32 * nb;
#pragma unroll 8
    for (int i = 0; i < 32; ++i) { const int kk = 2 * i + (lane >> 5); float v = W[(size_t)(k0 + kk) * N + n0 + (lane & 31)]; if (ks) v *= ks[k0 + kk]; scr[kk * 33 + (lane & 31)] = v; }
    LDS_WAIT(); asm volatile("" ::: "memory");
    const int c = lane & 7;
#pragma unroll
    for (int j = 0; j < 4; ++j) { const int n = (lane >> 3) + 8 * j; const LAS float* s = scr + (8 * c) * 33 + n;
        v4u o; o.x = pk2(s[0 * 33], s[1 * 33]); o.y = pk2(s[2 * 33], s[3 * 33]); o.z = pk2(s[4 * 33], s[5 * 33]); o.w = pk2(s[6 * 33], s[7 * 33]);
        *(GAS v4u*)(WT + (size_t)dmap<MAP>(n0 + n) * K + k0 + 8 * c) = o; }
    LDS_WAIT(); asm volatile("" ::: "memory");
}
__device__ __constant__ double INVF_D[16] = {1.0, 0.5623413251903491, 0.31622776601683794, 0.1778279410038923, 0.09999999999999999, 0.056234132519034905, 0.03162277660168379, 0.01778279410038923,
    0.01, 0.005623413251903491, 0.0031622776601683794, 0.0017782794100389228, 0.001, 0.000562341325190349, 0.00031622776601683794, 0.0001778279410038923};
__device__ __constant__ int RPB_TH[15] = {22, 30, 40, 54, 73, 99, 134, 182, 246, 332, 450, 609, 825, 1117, 1513};

__device__ __forceinline__ void p0_prologue(Frame& F) {
    const int gw = F.vcu * NWAVES + F.wave, NGW = F.G * NWAVES;
    const int gtid = F.vcu * (NWAVES * 64) + F.tid, NGT = F.G * NWAVES * 64;
    float* MODV = (float*)(F.ws + WS_MODV);
    {
        LAS float* cact = (LAS float*)F.lds;
        LAS float* red = (LAS float*)(F.lds + 16384);
        const float* cin = F.in[1];
        for (int i = F.tid; i < 4096; i += NWAVES * 64) { const int b = i >> 10, k = i & 1023; const float x = cin[i]; cact[k * 4 + b] = x / (1.0f + expf(-x)); }
        __syncthreads();
        constexpr int NTASK = (6 * D * 2 + 2 * D) / 64;
        for (int task = F.vcu; task < NTASK; task += F.G) {
            const int gc = task * 64 + F.lane;
            const float* W; int ldw, cc; const float* bias;
            if (gc < 6 * D) { W = F.in[5]; ldw = 6 * D; cc = gc; bias = F.in[6]; }
            else if (gc < 12 * D) { W = F.in[5] + (size_t)D * 6 * D; ldw = 6 * D; cc = gc - 6 * D; bias = F.in[6] + 6 * D; }
            else { W = F.in[14]; ldw = 2 * D; cc = gc - 12 * D; bias = F.in[15]; }
            float a0 = 0.f, a1 = 0.f, a2 = 0.f, a3 = 0.f;
            const int kbeg = F.wave * 128;
#pragma unroll 16
            for (int k = 0; k < 128; ++k) { const float w = W[(size_t)(kbeg + k) * ldw + cc]; const f32x4 ca = *(const LAS f32x4*)(cact + (kbeg + k) * 4);
                a0 += w * ca[0]; a1 += w * ca[1]; a2 += w * ca[2]; a3 += w * ca[3]; }
            red[(F.wave * 4 + 0) * 64 + F.lane] = a0; red[(F.wave * 4 + 1) * 64 + F.lane] = a1; red[(F.wave * 4 + 2) * 64 + F.lane] = a2; red[(F.wave * 4 + 3) * 64 + F.lane] = a3;
            __syncthreads();
            if (F.wave < 4) { const int b = F.wave; float s = 0.f;
#pragma unroll
                for (int w = 0; w < 8; ++w) s += red[(w * 4 + b) * 64 + F.lane];
                s += bias[cc];
                int kind; float val = s; const int j = cc & 1023, ch = cc >> 10;
                if (gc < 12 * D) { const int Lr = gc < 6 * D ? 0 : 1;
                    if (ch == 0) kind = 6 * Lr + 1; else if (ch == 1) { kind = 6 * Lr + 0; val = F.in[3][Lr * D + j] * (1.0f + s); } else if (ch == 2) kind = 6 * Lr + 2;
                    else if (ch == 3) kind = 6 * Lr + 4; else if (ch == 4) { kind = 6 * Lr + 3; val = F.in[4][Lr * D + j] * (1.0f + s); } else kind = 6 * Lr + 5;
                } else { if (ch == 0) kind = MK_B_KV; else { kind = MK_A_KV; val = F.in[13][j] * (1.0f + s); } }
                MODV[((size_t)kind * 4 + b) * D + j] = val; }
            __syncthreads();
        }
        __syncthreads();
    }
    {
        LAS float* scr = (LAS float*)(F.lds + F.wave * 8704);
        constexpr int I_MLAIN = (D / 64) * (LATN / 32), I_QUP = (QRANK / 64) * (QUP / 32), I_KVUP = (KVRANK / 64) * (KVUP / 32), I_OUT = (D / 64) * (D / 32), I_FGU = (D / 64) * (2 * DFF / 32),
                      I_FDN = (DFF / 64) * (D / 32), I_KVB = (D / 64) * (DILKV / 32), I_QB = (D / 64) * (DILQ / 32), I_OB = (DILOUT / 64) * (D / 32);
        constexpr int NSMALL = I_MLAIN + I_QUP + I_KVUP + I_OUT + I_FGU + I_FDN + I_KVB + I_QB + I_OB;
        constexpr int NITEMS = NSMALL + NEXP * (I_FGU + I_FDN);
        bf16* const ws16 = (bf16*)F.ws;
        for (int it = gw; it < NITEMS; it += NGW) {
            int r = it;
            if (r >= NSMALL) { r -= NSMALL;
                if (r < NEXP * I_FGU) { const int e = r / I_FGU; transpose_item<MAP_GU>(F.in[23] + (size_t)e * D * 2 * DFF, D, 2 * DFF, (bf16*)(F.ws + WS_WEGU) + (size_t)e * 2 * DFF * D, nullptr, scr, r % I_FGU, F.lane); continue; }
                r -= NEXP * I_FGU; { const int e = r / I_FDN; transpose_item<MAP_PLAIN>(F.in[24] + (size_t)e * DFF * D, DFF, D, (bf16*)(F.ws + WS_WEDN) + (size_t)e * D * DFF, nullptr, scr, r % I_FDN, F.lane); continue; } }
            if (r < I_MLAIN) { transpose_item<MAP_MLAIN>(F.in[7], D, LATN, (bf16*)(F.ws + WS_WMLAIN), nullptr, scr, r, F.lane); continue; } r -= I_MLAIN;
            if (r < I_QUP) { transpose_item<MAP_QUP>(F.in[9], QRANK, QUP, (bf16*)(F.ws + WS_WQUP), F.in[8], scr, r, F.lane); continue; } r -= I_QUP;
            if (r < I_KVUP) { transpose_item<MAP_PLAIN>(F.in[11], KVRANK, KVUP, (bf16*)(F.ws + WS_WKVUP), F.in[10], scr, r, F.lane); continue; } r -= I_KVUP;
            if (r < I_OUT) { transpose_item<MAP_PLAIN>(F.in[12], D, D, (bf16*)(F.ws + WS_WOUT), nullptr, scr, r, F.lane); continue; } r -= I_OUT;
            if (r < I_FGU) { transpose_item<MAP_GU>(F.in[20], D, 2 * DFF, (bf16*)(F.ws + WS_WFGU), nullptr, scr, r, F.lane); continue; } r -= I_FGU;
            if (r < I_FDN) { transpose_item<MAP_PLAIN>(F.in[21], DFF, D, (bf16*)(F.ws + WS_WFDN), nullptr, scr, r, F.lane); continue; } r -= I_FDN;
            if (r < I_KVB) { transpose_item<MAP_PLAIN>(F.in[16], D, DILKV, (bf16*)(F.ws + WS_WKVB), nullptr, scr, r, F.lane); continue; } r -= I_KVB;
            if (r < I_QB) { transpose_item<MAP_PLAIN>(F.in[18], D, DILQ, (bf16*)(F.ws + WS_WQB), nullptr, scr, r, F.lane); continue; } r -= I_QB;
            transpose_item<MAP_PLAIN>(F.in[19], DILOUT, D, (bf16*)(F.ws + WS_WOB), nullptr, scr, r, F.lane);
        }
        (void)ws16;
    }
    {
        v4u* padz = (v4u*)(F.ws + WS_WMLAIN + (size_t)LATN * D * 2);
        for (int i = gtid; i < (LATP - LATN) * D * 2 / 16; i += NGT) padz[i] = (v4u){0u, 0u, 0u, 0u};
        const int* pos = (const int*)F.in[2];
        float* cs = (float*)(F.ws + WS_CS);
        for (int i = gtid; i < M * 16; i += NGT) { const int row = i >> 4, k = i & 15;
            const double x = (double)pos[row] * INVF_D[k]; const double rev = x * 0.15915494309189535; const float fr = (float)(rev - __builtin_rint(rev));
            cs[(size_t)i * 2] = __builtin_amdgcn_cosf(fr); cs[(size_t)i * 2 + 1] = __builtin_amdgcn_sinf(fr); }
        const float* rpb = F.in[17];
        float* bt = (float*)(F.ws + WS_BIAS);
        for (int i = gtid; i < 24 * 129; i += NGT) { const int gh = i / 129, j = i % 129, g = gh >> 3; const int d = j * (g == 0 ? 1 : (g == 1 ? 4 : 16));
            int bk; if (d < 16) bk = d; else { bk = 16;
#pragma unroll
                for (int q = 0; q < 15; ++q) bk += (d >= RPB_TH[q]) ? 1 : 0; }
            bt[gh * 132 + j] = rpb[bk * 24 + gh] * LOG2E_F; }
    }
}

template <bool DUAL>
__device__ __forceinline__ void norm_phase(Frame& F, const float* H, const float* A0, const float* B0, bf16* O0, const float* A1, const float* B1, bf16* O1) {
    const int gw = F.vcu * NWAVES + F.wave, NGW = F.G * NWAVES;
    for (int c = gw; c < M / 16; c += NGW) {
        const int row0 = c * 16, b = row0 / SEQ;
        f32x4 a0[4], b0[4], a1[4], b1[4];
#pragma unroll
        for (int j = 0; j < 4; ++j) { a0[j] = *(const f32x4*)(A0 + b * D + 4 * F.lane + 256 * j); b0[j] = *(const f32x4*)(B0 + b * D + 4 * F.lane + 256 * j);
            if (DUAL) { a1[j] = *(const f32x4*)(A1 + b * D + 4 * F.lane + 256 * j); b1[j] = *(const f32x4*)(B1 + b * D + 4 * F.lane + 256 * j); } }
#pragma unroll 2
        for (int i = 0; i < 16; ++i) { const size_t row = (size_t)(row0 + i);
            const GAS f32x4* xr = (const GAS f32x4*)(H + row * D) + F.lane;
            f32x4 v[4]; float s = 0.f;
#pragma unroll
            for (int j = 0; j < 4; ++j) { v[j] = xr[64 * j]; s += (v[j].x * v[j].x + v[j].y * v[j].y) + (v[j].z * v[j].z + v[j].w * v[j].w); }
            const float rstd = 1.0f / sqrtf(wave_sum(s) * (1.f / D) + EPS);
            GAS v2u* o0 = (GAS v2u*)(O0 + row * D) + F.lane;
#pragma unroll
            for (int j = 0; j < 4; ++j) { const f32x4 y = v[j] * rstd * a0[j] + b0[j]; o0[64 * j] = (v2u){pk2(y.x, y.y), pk2(y.z, y.w)}; }
            if (DUAL) { GAS v2u* o1 = (GAS v2u*)(O1 + row * D) + F.lane;
#pragma unroll
                for (int j = 0; j < 4; ++j) { const f32x4 y = v[j] * rstd * a1[j] + b1[j]; o1[64 * j] = (v2u){pk2(y.x, y.y), pk2(y.z, y.w)}; } }
        }
    }
}

__device__ __forceinline__ void latnorm_phase(Frame& F) {
    const int gw = F.vcu * NWAVES + F.wave, NGW = F.G * NWAVES;
    const bf16* LAT = (const bf16*)(F.ws + A_LAT); bf16* QN = (bf16*)(F.ws + A_QN); bf16* KVN = (bf16*)(F.ws + A_KVN); bf16* KB = (bf16*)(F.ws + A_K);
    const float* cs = (const float*)(F.ws + WS_CS);
    for (int row = gw; row < M; row += NGW) {
        const unsigned* lr = (const unsigned*)(LAT + (size_t)row * LATP);
        unsigned q[3], kv[2];
#pragma unroll
        for (int j = 0; j < 3; ++j) q[j] = lr[F.lane + 64 * j];
#pragma unroll
        for (int j = 0; j < 2; ++j) kv[j] = lr[192 + F.lane + 64 * j];
        const unsigned kr = lr[320 + (F.lane & 15)];
        float sq = 0.f, sk = 0.f;
#pragma unroll
        for (int j = 0; j < 3; ++j) { const float a = bf_lo(q[j]), b = bf_hi(q[j]); sq += a * a + b * b; }
#pragma unroll
        for (int j = 0; j < 2; ++j) { const float a = bf_lo(kv[j]), b = bf_hi(kv[j]); sk += a * a + b * b; }
        const float rq = 1.0f / sqrtf(wave_sum(sq) * (1.f / QRANK) + EPS), rk = 1.0f / sqrtf(wave_sum(sk) * (1.f / KVRANK) + EPS);
        unsigned* qo = (unsigned*)(QN + (size_t)row * QRANK); unsigned* ko = (unsigned*)(KVN + (size_t)row * KVRANK);
#pragma unroll
        for (int j = 0; j < 3; ++j) qo[F.lane + 64 * j] = pk2(bf_lo(q[j]) * rq, bf_hi(q[j]) * rq);
#pragma unroll
        for (int j = 0; j < 2; ++j) ko[F.lane + 64 * j] = pk2(bf_lo(kv[j]) * rk, bf_hi(kv[j]) * rk);
        { const int i = F.lane & 15; const float c = cs[(size_t)row * 32 + 2 * i], s = cs[(size_t)row * 32 + 2 * i + 1]; const float x1 = bf_lo(kr), x2 = bf_hi(kr);
          const unsigned w = pk2(x1 * c - x2 * s, x1 * s + x2 * c);
          unsigned* kb = (unsigned*)(KB + (size_t)row * QUP);
#pragma unroll
          for (int hh = 0; hh < 4; ++hh) { const int h = (F.lane >> 4) * 4 + hh; kb[(h * 96 + 64) / 2 + i] = w; } }
    }
}

__device__ __forceinline__ void merge_phase(Frame& F) {
    const int gw = F.vcu * NWAVES + F.wave, NGW = F.G * NWAVES;
    const bf16* OG = (const bf16*)(F.ws + A_OG); const float* LSE = (const float*)(F.ws + WS_LSE); bf16* OD = (bf16*)(F.ws + A_OD);
    for (int row = gw; row < M; row += NGW) {
        const int h = F.lane >> 3;
        float l0 = LSE[((size_t)0 * M + row) * 8 + h], l1 = LSE[((size_t)1 * M + row) * 8 + h], l2 = LSE[((size_t)2 * M + row) * 8 + h];
        const float mx = fmaxf(l0, fmaxf(l1, l2)); float w0 = __builtin_amdgcn_exp2f(l0 - mx), w1 = __builtin_amdgcn_exp2f(l1 - mx), w2 = __builtin_amdgcn_exp2f(l2 - mx);
        const float inv = 1.0f / (w0 + w1 + w2); w0 *= inv; w1 *= inv; w2 *= inv;
        const v4u a = *(const v4u*)(OG + ((size_t)0 * M + row) * DILOUT + 8 * F.lane), b = *(const v4u*)(OG + ((size_t)1 * M + row) * DILOUT + 8 * F.lane), c = *(const v4u*)(OG + ((size_t)2 * M + row) * DILOUT + 8 * F.lane);
        v4u o;
#pragma unroll
        for (int k = 0; k < 4; ++k) o[k] = pk2(w0 * bf_lo(a[k]) + w1 * bf_lo(b[k]) + w2 * bf_lo(c[k]), w0 * bf_hi(a[k]) + w1 * bf_hi(b[k]) + w2 * bf_hi(c[k]));
        *(v4u*)(OD + (size_t)row * DILOUT + 8 * F.lane) = o;
    }
}

__device__ __forceinline__ void router_phase(Frame& F, const float* H, const float* A0, const float* B0, bf16* O0) {
    const int gw = F.vcu * NWAVES + F.wave, NGW = F.G * NWAVES;
    LAS float* wrt = (LAS float*)F.lds;
    { const float* wr = F.in[22]; for (int i = F.tid; i < 8192; i += NWAVES * 64) { const int col = i >> 3, e = i & 7; wrt[e * 1024 + col] = wr[i]; } }
    __syncthreads();
    v4u* ROUTE = (v4u*)(F.ws + WS_ROUTE); unsigned* CNT = (unsigned*)(F.ws + WS_CNT);
    for (int c = gw; c < M / 16; c += NGW) {
        const int row0 = c * 16, b = row0 / SEQ;
        f32x4 a0[4], b0[4];
#pragma unroll
        for (int j = 0; j < 4; ++j) { a0[j] = *(const f32x4*)(A0 + b * D + 4 * F.lane + 256 * j); b0[j] = *(const f32x4*)(B0 + b * D + 4 * F.lane + 256 * j); }
        unsigned cnt = 0u;
        for (int i = 0; i < 16; ++i) { const size_t row = (size_t)(row0 + i);
            const GAS f32x4* xr = (const GAS f32x4*)(H + row * D) + F.lane;
            f32x4 v[4]; float s = 0.f;
#pragma unroll
            for (int j = 0; j < 4; ++j) { v[j] = xr[64 * j]; s += (v[j].x * v[j].x + v[j].y * v[j].y) + (v[j].z * v[j].z + v[j].w * v[j].w); }
            const float rstd = 1.0f / sqrtf(wave_sum(s) * (1.f / D) + EPS);
            GAS v2u* o0 = (GAS v2u*)(O0 + row * D) + F.lane;
            float lg[8];
#pragma unroll
            for (int e = 0; e < 8; ++e) lg[e] = 0.f;
#pragma unroll
            for (int j = 0; j < 4; ++j) { const f32x4 y = v[j] * rstd * a0[j] + b0[j]; o0[64 * j] = (v2u){pk2(y.x, y.y), pk2(y.z, y.w)};
#pragma unroll
                for (int e = 0; e < 8; ++e) { const f32x4 w = *(const LAS f32x4*)(wrt + e * 1024 + 4 * F.lane + 256 * j); lg[e] += (y.x * w.x + y.y * w.y) + (y.z * w.z + y.w * w.w); } }
#pragma unroll
            for (int e = 0; e < 8; ++e) lg[e] = wave_sum(lg[e]);
            int e1 = 0; float v1 = lg[0];
#pragma unroll
            for (int e = 1; e < 8; ++e) if (lg[e] > v1) { v1 = lg[e]; e1 = e; }
            int e2 = -1; float v2 = -INFINITY;
#pragma unroll
            for (int e = 0; e < 8; ++e) if (e != e1 && lg[e] > v2) { v2 = lg[e]; e2 = e; }
            const float ex = expf(v2 - v1); const float g1 = 1.0f / (1.0f + ex), g2 = ex / (1.0f + ex);
            cnt += (F.lane == e1 ? 1u : 0u) + (F.lane == e2 ? 1u : 0u);
            if (F.lane == 0) ROUTE[row] = (v4u){(unsigned)e1 | ((unsigned)e2 << 8), __float_as_uint(g1), __float_as_uint(g2), 0u};
        }
        if (F.lane < 8) CNT[c * 8 + F.lane] = cnt;
    }
}

__device__ __forceinline__ void lists_phase(Frame& F) {
    const int gw = F.vcu * NWAVES + F.wave, NGW = F.G * NWAVES;
    const v4u* ROUTE = (const v4u*)(F.ws + WS_ROUTE); const unsigned* CNT = (const unsigned*)(F.ws + WS_CNT);
    int* LIST = (int*)(F.ws + WS_LIST); float* SLOTG = (float*)(F.ws + WS_SLOTG); int* TOKSLOT = (int*)(F.ws + WS_TOKSLOT); int* TILEEXP = (int*)(F.ws + WS_TILEEXP);
    for (int c = gw; c < M / 16; c += NGW) {
        unsigned lt[8], al[8];
#pragma unroll
        for (int e = 0; e < 8; ++e) { lt[e] = 0u; al[e] = 0u; }
        for (int cc = F.lane; cc < M / 16; cc += 64) { const v4u x = *(const v4u*)(CNT + cc * 8), y = *(const v4u*)(CNT + cc * 8 + 4); const bool bl = cc < c;
            al[0] += x.x; al[1] += x.y; al[2] += x.z; al[3] += x.w; al[4] += y.x; al[5] += y.y; al[6] += y.z; al[7] += y.w;
            if (bl) { lt[0] += x.x; lt[1] += x.y; lt[2] += x.z; lt[3] += x.w; lt[4] += y.x; lt[5] += y.y; lt[6] += y.z; lt[7] += y.w; } }
#pragma unroll
        for (int e = 0; e < 8; ++e) {
#pragma unroll
            for (int o = 1; o < 64; o <<= 1) { lt[e] += __shfl_xor(lt[e], o); al[e] += __shfl_xor(al[e], o); } }
        unsigned base[8]; unsigned run = 0u;
#pragma unroll
        for (int e = 0; e < 8; ++e) { base[e] = run; run += (al[e] + 255u) & ~255u; }
        const int row = c * 16 + (F.lane & 15);
        const v4u r = ROUTE[row]; const int e1 = (int)(r.x & 0xffu), e2 = (int)((r.x >> 8) & 0xffu);
        int s1 = 0, s2 = 0;
#pragma unroll
        for (int e = 0; e < 8; ++e) { const bool has = (F.lane < 16) && (e1 == e || e2 == e); const unsigned long long mk = __ballot(has);
            const int rank = __popcll(mk & ((1ull << F.lane) - 1ull)); const int sl = (int)(base[e] + lt[e]) + rank;
            if (e1 == e) s1 = sl; if (e2 == e) s2 = sl; }
        if (F.lane < 16) { LIST[s1] = row; LIST[s2] = row; SLOTG[s1] = __uint_as_float(r.y); SLOTG[s2] = __uint_as_float(r.z); TOKSLOT[row * 2] = s1; TOKSLOT[row * 2 + 1] = s2; }
        if (c == 0) {
#pragma unroll
            for (int e = 0; e < 8; ++e) { const unsigned pe = (al[e] + 255u) & ~255u;
                for (unsigned s = base[e] + al[e] + F.lane; s < base[e] + pe; s += 64) { LIST[s] = 0; SLOTG[s] = 0.f; }
                for (unsigned t = base[e] / 256u + F.lane; t < (base[e] + pe) / 256u; t += 64) TILEEXP[t] = e; }
            if (F.lane == 0) TILEEXP[300] = (int)(run / 256u);
        }
    }
}

__device__ __forceinline__ void final_phase(Frame& F, float* H, const float* gate, const float* gfin) {
    const int gw = F.vcu * NWAVES + F.wave, NGW = F.G * NWAVES;
    const bf16* Y = (const bf16*)(F.ws + A_Y); const int* TOKSLOT = (const int*)(F.ws + WS_TOKSLOT);
    for (int c = gw; c < M / 16; c += NGW) {
        const int row0 = c * 16, b = row0 / SEQ;
        f32x4 gt[4], gf[4];
#pragma unroll
        for (int j = 0; j < 4; ++j) { gt[j] = *(const f32x4*)(gate + b * D + 4 * F.lane + 256 * j); gf[j] = *(const f32x4*)(gfin + 4 * F.lane + 256 * j); }
#pragma unroll 2
        for (int i = 0; i < 16; ++i) { const size_t row = (size_t)(row0 + i);
            const int s1 = TOKSLOT[row * 2], s2 = TOKSLOT[row * 2 + 1];
            GAS f32x4* xr = (GAS f32x4*)(H + row * D) + F.lane;
            const GAS v2u* y1 = (const GAS v2u*)(Y + (size_t)s1 * D) + F.lane; const GAS v2u* y2 = (const GAS v2u*)(Y + (size_t)s2 * D) + F.lane;
            f32x4 v[4]; float s = 0.f;
#pragma unroll
            for (int j = 0; j < 4; ++j) { const f32x4 h = xr[64 * j]; const v2u p = y1[64 * j], q = y2[64 * j];
                f32x4 yy; yy.x = bf_lo(p.x) + bf_lo(q.x); yy.y = bf_hi(p.x) + bf_hi(q.x); yy.z = bf_lo(p.y) + bf_lo(q.y); yy.w = bf_hi(p.y) + bf_hi(q.y);
                v[j] = h + gt[j] * yy; s += (v[j].x * v[j].x + v[j].y * v[j].y) + (v[j].z * v[j].z + v[j].w * v[j].w); }
            const float rstd = 1.0f / sqrtf(wave_sum(s) * (1.f / D) + EPS);
#pragma unroll
            for (int j = 0; j < 4; ++j) xr[64 * j] = v[j] * rstd * gf[j];
        }
    }
}
#ifndef MK_ONE_LAUNCH
#define MK_ONE_LAUNCH 1
#endif
constexpr int N_PHASES = 20;
struct Args { const float* in[26]; float* out; unsigned char* ws; int ph_lo, ph_hi; };
static_assert(sizeof(Args) == 26 * 8 + 8 + 8 + 8, "Args has no padding");

__global__ void __launch_bounds__(NWAVES * 64, 2) mk_fwd(Args args) {
    extern __shared__ __attribute__((aligned(16))) unsigned char lds[];
    Frame F;
    F.lds = (LAS unsigned char*)lds;
    F.MISC = (volatile LAS unsigned*)(F.lds + MISC_OFF);
    F.tid = threadIdx.x; F.lane = F.tid & 63; F.wave = __builtin_amdgcn_readfirstlane(F.tid >> 6);
    F.G = gridDim.x; { const int bx = blockIdx.x; F.vcu = (F.G % 8 == 0) ? (bx % 8) * (F.G / 8) + bx / 8 : bx; }
    F.ws = args.ws; F.out = args.out;
#pragma unroll
    for (int i = 0; i < 26; ++i) F.in[i] = args.in[i];
    unsigned char* const ws = args.ws;
    for (int u = F.tid; u < (LDS_BYTES - LDSCTL_OFF) / 4; u += NWAVES * 64) ((LAS unsigned*)(F.lds + LDSCTL_OFF))[u] = 0u;
    __syncthreads();
    const int lo = args.ph_lo, hi = args.ph_hi;
    XcdBarrier bar; bar.bar = (unsigned*)(ws + WS_CTL) + CW_BAR; bar.x = 0; bar.st = nullptr;
    if (hi - lo > 1) bar = xcd_barrier_post((unsigned*)(ws + WS_CTL) + CW_BAR, F.MISC + 8);
#ifndef PHASE_MASK
#define PHASE_MASK 0xFFFFFu
#endif
#define IN(k) (((PHASE_MASK >> (k)) & 1u) && lo <= (k) && (k) < hi)
#define SEAM(k) do { if (IN(k) && IN((k) + 1)) xcd_barrier(bar); } while (0)
    const float* MODV = (const float*)(ws + WS_MODV);
#define MV(kind) (MODV + (size_t)(kind) * 4 * D)
    float* const H = args.out;
    bf16* const XN = (bf16*)(ws + A_XN);
    const pg8::MoeInfo mi0{nullptr, nullptr, 0};

    if (IN(0)) { p0_prologue(F); } SEAM(0);
    if (IN(1)) { norm_phase<false>(F, F.in[0], MV(MK_A_MIX0), MV(MK_B_MIX0), XN, nullptr, nullptr, nullptr); } SEAM(1);
    if (IN(2)) { pg8::Gemm g{XN, (const bf16*)(ws + WS_WMLAIN), M, LATP, D}; pg8::StaticOrder S; S.init(M, LATP, F.G, (int)blockIdx.x);
        pg8::EpiBf16 E{(bf16*)(ws + A_LAT), LATP, 1.0f};
        pg8::gemm_phase<pg8::EpiBf16, pg8::StaticOrder, true, true, 0>(F.lds, g, S, E, mi0); } SEAM(2);
    if (IN(3)) { latnorm_phase(F); } SEAM(3);
    if (IN(4)) {
#ifndef P4_SKIP_Q
        { pg8::Gemm g{(const bf16*)(ws + A_QN), (const bf16*)(ws + WS_WQUP), M, QUP, QRANK}; pg8::StaticOrder S; S.init(M, QUP, F.G, (int)blockIdx.x);
          pg8::EpiQ E{(bf16*)(ws + A_Q), QUP, C2_MLA, (const float*)(ws + WS_CS)};
          pg8::gemm_phase<pg8::EpiQ, pg8::StaticOrder, true, true, 0>(F.lds, g, S, E, mi0); }
#endif
#ifndef P4_SKIP_KV
        { pg8::Gemm g{(const bf16*)(ws + A_KVN), (const bf16*)(ws + WS_WKVUP), M, KVUP, KVRANK}; pg8::StaticOrder S; S.init(M, KVUP, F.G, (int)blockIdx.x);
          pg8::EpiKV E{(bf16*)(ws + A_K), (bf16*)(ws + A_V)};
          pg8::gemm_phase<pg8::EpiKV, pg8::StaticOrder, true, true, 0>(F.lds, g, S, E, mi0); }
#endif
    } SEAM(4);
    if (IN(5)) {
        const bf16* Qp = (const bf16*)(ws + A_Q); const bf16* Kp = (const bf16*)(ws + A_K); const bf16* Vp = (const bf16*)(ws + A_V); bf16* Op = (bf16*)(ws + A_O);
        if (F.G == 256) {
            for (int i = 0; i < 8; ++i) { const int bh = (F.vcu >> 3) + 32 * (i >> 2), s = F.vcu & 7, k = i & 3; const int qb = (k == 0) ? s : (k == 1) ? 15 - s : (k == 2) ? 16 + s : 31 - s;
                const int b = bh >> 4, h = bh & 15;
                att::attn_unit<96, false>(Qp + h * 96, QUP, Kp + h * 96, QUP, Vp + h * 64, D, Op + h * 64, D, nullptr, nullptr, (long)b * SEQ, 1, qb * 256, (char*)lds); }
        } else {
            for (int u = (int)blockIdx.x; u < BATCH * MLA_H * 32; u += F.G) { const int bh = u >> 5, qb = 31 - (u & 31); const int b = bh >> 4, h = bh & 15;
                att::attn_unit<96, false>(Qp + h * 96, QUP, Kp + h * 96, QUP, Vp + h * 64, D, Op + h * 64, D, nullptr, nullptr, (long)b * SEQ, 1, qb * 256, (char*)lds); }
        }
    } SEAM(5);
    if (IN(6)) { pg8::Gemm g{(const bf16*)(ws + A_O), (const bf16*)(ws + WS_WOUT), M, D, D}; pg8::StaticOrder S; S.init(M, D, F.G, (int)blockIdx.x);
        pg8::EpiResid E{F.in[0], H, MV(MK_G_MIX0)};
        pg8::gemm_phase<pg8::EpiResid, pg8::StaticOrder, true, true, 0>(F.lds, g, S, E, mi0); } SEAM(6);
    if (IN(7)) { norm_phase<false>(F, H, MV(MK_A_FFN0), MV(MK_B_FFN0), XN, nullptr, nullptr, nullptr); } SEAM(7);
    if (IN(8)) { pg8::Gemm g{XN, (const bf16*)(ws + WS_WFGU), M, 2 * DFF, D}; pg8::StaticOrder S; S.init(M, 2 * DFF, F.G, (int)blockIdx.x);
        pg8::EpiSwiGLU E{(bf16*)(ws + A_HID), DFF};
        pg8::gemm_phase<pg8::EpiSwiGLU, pg8::StaticOrder, true, true, 0>(F.lds, g, S, E, mi0); } SEAM(8);
    if (IN(9)) { pg8::Gemm g{(const bf16*)(ws + A_HID), (const bf16*)(ws + WS_WFDN), M, D, DFF}; pg8::StaticOrder S; S.init(M, D, F.G, (int)blockIdx.x);
        pg8::EpiResid E{H, H, MV(MK_G_FFN0)};
        pg8::gemm_phase<pg8::EpiResid, pg8::StaticOrder, true, true, 0>(F.lds, g, S, E, mi0); } SEAM(9);
    if (IN(10)) { norm_phase<true>(F, H, MV(MK_A_MIX1), MV(MK_B_MIX1), XN, MV(MK_A_KV), MV(MK_B_KV), (bf16*)(ws + A_XNKV)); } SEAM(10);
    if (IN(11)) {
        { pg8::Gemm g{(const bf16*)(ws + A_XNKV), (const bf16*)(ws + WS_WKVB), M, DILKV, D}; pg8::StaticOrder S; S.init(M, DILKV, F.G, (int)blockIdx.x);
          pg8::EpiBf16 E{(bf16*)(ws + A_KVB), DILKV, 1.0f};
          pg8::gemm_phase<pg8::EpiBf16, pg8::StaticOrder, true, true, 0>(F.lds, g, S, E, mi0); }
        { pg8::Gemm g{XN, (const bf16*)(ws + WS_WQB), M, DILQ, D}; pg8::StaticOrder S; S.init(M, DILQ, F.G, (int)blockIdx.x);
          pg8::EpiBf16 E{(bf16*)(ws + A_QB), DILQ, C2_DIL};
          pg8::gemm_phase<pg8::EpiBf16, pg8::StaticOrder, true, true, 0>(F.lds, g, S, E, mi0); }
    } SEAM(11);
    if (IN(12)) {
        const bf16* Qp = (const bf16*)(ws + A_QB); const bf16* KV = (const bf16*)(ws + A_KVB); bf16* OG = (bf16*)(ws + A_OG); float* LSE = (float*)(ws + WS_LSE); const float* BT = (const float*)(ws + WS_BIAS);
        for (int u = (int)blockIdx.x; u < BATCH * 3 * 32 * 8; u += F.G) { const int h = u & 7, x = (u >> 3) & 31, bg = u >> 8; const int g = bg % 3, b = bg / 3;
            const int dil = (g == 0) ? 1 : (g == 1) ? 4 : 16; const int r = x % dil, qb = x / dil;
            att::attn_unit<64, true>(Qp + g * 512 + h * 64, DILQ, KV + g * 1024 + h * 64, DILKV, KV + g * 1024 + 512 + h * 64, DILKV, OG + (size_t)g * M * DILOUT + h * 64, DILOUT,
                                     LSE + (size_t)g * M * 8 + h, BT + (g * 8 + h) * 132, (long)b * SEQ + r, dil, qb * 256, (char*)lds); }
    } SEAM(12);
    if (IN(13)) { merge_phase(F); } SEAM(13);
    if (IN(14)) { pg8::Gemm g{(const bf16*)(ws + A_OD), (const bf16*)(ws + WS_WOB), M, D, DILOUT}; pg8::StaticOrder S; S.init(M, D, F.G, (int)blockIdx.x);
        pg8::EpiResid E{H, H, MV(MK_G_MIX1)};
        pg8::gemm_phase<pg8::EpiResid, pg8::StaticOrder, true, true, 0>(F.lds, g, S, E, mi0); } SEAM(14);
    if (IN(15)) { router_phase(F, H, MV(MK_A_FFN1), MV(MK_B_FFN1), XN); } SEAM(15);
    if (IN(16)) { lists_phase(F); } SEAM(16);
    if (IN(17)) { const int ntile = ((const int*)(ws + WS_TILEEXP))[300];
        pg8::Gemm g{XN, (const bf16*)(ws + WS_WEGU), ntile * 256, 2 * DFF, D}; pg8::StaticOrder S; S.init(ntile * 256, 2 * DFF, F.G, (int)blockIdx.x);
        pg8::EpiSwiGLU E{(bf16*)(ws + A_HIDS), DFF};
        const pg8::MoeInfo mi{(const int*)(ws + WS_LIST), (const int*)(ws + WS_TILEEXP), (size_t)2 * DFF * D * 2};
        pg8::gemm_phase<pg8::EpiSwiGLU, pg8::StaticOrder, true, true, 1>(F.lds, g, S, E, mi); } SEAM(17);
    if (IN(18)) { const int ntile = ((const int*)(ws + WS_TILEEXP))[300];
        pg8::Gemm g{(const bf16*)(ws + A_HIDS), (const bf16*)(ws + WS_WEDN), ntile * 256, D, DFF}; pg8::StaticOrder S; S.init(ntile * 256, D, F.G, (int)blockIdx.x);
        pg8::EpiMoeDown E{(bf16*)(ws + A_Y), (const float*)(ws + WS_SLOTG)};
        const pg8::MoeInfo mi{(const int*)(ws + WS_LIST), (const int*)(ws + WS_TILEEXP), (size_t)D * DFF * 2};
        pg8::gemm_phase<pg8::EpiMoeDown, pg8::StaticOrder, true, true, 2>(F.lds, g, S, E, mi); } SEAM(18);
    if (IN(19)) { final_phase(F, H, MV(MK_G_FFN1), F.in[25]); }
#undef IN
#undef SEAM
#undef MV
}

extern "C" void kernel_launch(void* const* d_in, const int* in_sizes, int n_in, void* d_out, int out_size, void* d_ws, size_t ws_size, hipStream_t stream) {
    static int grid = 0;
    if (grid == 0) {
        if (n_in != 26 || in_sizes[0] != M * D || out_size != M * D || ws_size < WS_END) { fprintf(stderr, "kernel_launch: unexpected shapes (n_in %d, in0 %d, out %d, ws %zu, need %zu); nothing launched\n", n_in, n_in > 0 ? in_sizes[0] : -1, out_size, ws_size, (size_t)WS_END); grid = -1; return; }
        int dev = 0, cus = 0, per_cu = 0;
        if (hipGetDevice(&dev) != hipSuccess || hipDeviceGetAttribute(&cus, hipDeviceAttributeMultiprocessorCount, dev) != hipSuccess) { grid = -1; return; }
        if (hipFuncSetAttribute((const void*)mk_fwd, hipFuncAttributeMaxDynamicSharedMemorySize, LDS_BYTES) != hipSuccess) { fprintf(stderr, "kernel_launch: hipFuncSetAttribute failed\n"); grid = -1; return; }
        if (hipOccupancyMaxActiveBlocksPerMultiprocessor(&per_cu, (const void*)mk_fwd, NWAVES * 64, LDS_BYTES) != hipSuccess || per_cu < 1) { fprintf(stderr, "kernel_launch: occupancy query reports %d\n", per_cu); }
        (void)hipGetLastError();
        grid = cus;
    }
    if (grid < 0) return;
    if (hipMemsetAsync((char*)d_ws + WS_CTL, 0, CTL_ZERO_BYTES, stream) != hipSuccess) return;
    Args a{};
    for (int i = 0; i < 26; ++i) a.in[i] = (const float*)d_in[i];
    a.out = (float*)d_out; a.ws = (unsigned char*)d_ws;
#if MK_ONE_LAUNCH
    a.ph_lo = 0; a.ph_hi = N_PHASES;
    hipLaunchKernelGGL(mk_fwd, dim3(grid), dim3(NWAVES * 64), LDS_BYTES, stream, a);
#else
    for (int p = 0; p < N_PHASES; ++p) { a.ph_lo = p; a.ph_hi = p + 1; hipLaunchKernelGGL(mk_fwd, dim3(grid), dim3(NWAVES * 64), LDS_BYTES, stream, a); }
#endif
}
```

```cpp
#include <hip/hip_runtime.h>
#include <hip/hip_bf16.h>
#include <cstdio>
#include <cstdint>
#include <cmath>
#ifndef MK_ONE_LAUNCH
#define MK_ONE_LAUNCH 1
#endif
namespace pg8 {
#define PG8_LAS __attribute__((address_space(3)))
typedef unsigned short bf16_t;
typedef short bf16x8 __attribute__((ext_vector_type(8)));
typedef float f32x4 __attribute__((ext_vector_type(4)));
typedef float f32x2 __attribute__((ext_vector_type(2)));
typedef unsigned u32x4 __attribute__((ext_vector_type(4)));
constexpr int BM = 256, BK = 64, HALF = 128, HTB = HALF * BK * 2  , STAGE_BYTES = 8 * HTB, NXCD = 8, WGM = 8;

__host__ __device__ __forceinline__ int lds_byte(int r, int c) { const int st = (r >> 4) * 2 + (c >> 5), rr = r & 15, cc = c & 31, ob = rr * 64 + cc * 2; return st * 1024 + (ob ^ (((ob >> 9) & 1) << 5)); }
__host__ __device__ __forceinline__ void stage_rc(int b, int& R, int& C) { const int st = b / 1024, sb = b % 1024, swz = sb ^ (((sb >> 9) & 1) << 5); R = (st >> 1) * 16 + swz / 64; C = (st & 1) * 32 + (swz % 64) / 2; }
__host__ __device__ __forceinline__ int perm32(int rho) { const int n = rho >> 4, i = rho & 15; return 8 * (i >> 2) + 4 * n + (i & 3); }

struct Unit { int pm, pn; };
struct Gemm { const bf16_t* A; const bf16_t* Bt; int M, N, K; };
struct MoeInfo { const int* list; const int* tile_expert; size_t bstride; };

struct StaticOrder {
    int nM, nN, nwg, G, c;
    __host__ __device__ void init(int M, int N, int G_, int c_) { nM = M / BM; nN = N / BM; nwg = nM * nN; G = G_; c = c_; }
    __host__ __device__ bool next(int i, Unit& u) const {
        const long L = (long)i * G + c; if (L >= nwg) return false;
        int wgid = (int)L; { const int q = nwg / NXCD, r = nwg % NXCD, xcd = wgid % NXCD, off = wgid / NXCD; wgid = (xcd < r ? xcd * (q + 1) : r * (q + 1) + (xcd - r) * q) + off; }
        const int nig = WGM * nN, gid = wgid / nig, fm = gid * WGM, gsz = (nM - fm) < WGM ? (nM - fm) : WGM;
        u.pm = fm + ((wgid % nig) % gsz); u.pn = (wgid % nig) / gsz; return true;
    }
    __device__ __forceinline__ void a_ready(const Unit&) const {}
    __device__ __forceinline__ void done(const Unit&) const {}
};

__device__ __forceinline__ unsigned cvt_pk_bf16(float lo, float hi) { unsigned r; asm volatile("v_cvt_pk_bf16_f32 %0, %1, %2" : "=v"(r) : "v"(lo), "v"(hi)); return r; }


template <class Epi, class Sched, bool ALIGN_EPI, bool SP2, int MODE>
__device__ __forceinline__ void gemm_phase(PG8_LAS unsigned char* lds, const Gemm g, const Sched& S, const Epi& E, const MoeInfo mi) {
    const int tid = threadIdx.x, wid = __builtin_amdgcn_readfirstlane(tid >> 6), lane = tid & 63, wr = wid >> 2, wc = wid & 3, fr = lane & 15, fq = lane >> 4;
    int K_ = g.K; asm volatile("" : "+s"(K_));
    const int K = K_, nt = K / BK;
    unsigned voffB[2]; int Rr[2], Cc[2];
#pragma unroll
    for (int i = 0; i < 2; ++i) { int R, C; stage_rc(tid * 16 + i * 8192, R, C); const int Rb = Epi::PERM ? ((R & ~31) + perm32(R & 31)) : R;
        Rr[i] = R; Cc[i] = C; voffB[i] = (unsigned)(Rb * K + C) * 2u; }
    const size_t kstep = (size_t)(BK * 2);
    const size_t hstep = (size_t)HALF * K * 2;
    const size_t tstep = 2 * hstep;
    const unsigned ldsw = (unsigned)wid * 1024u;
    const int aoff = lds_byte(wr * 64 + fr, fq * 8), boff = lds_byte(wc * 32 + fr, fq * 8);
    const unsigned rowb = (unsigned)K * 2u;
#define PG8_SA(b, h) (((b) * 2 + (h)) * HTB)
#define PG8_SB(b, h) ((4 + (b) * 2 + (h)) * HTB)
#define PG8_STAGE(bufoff, gbase, voff) do { _Pragma("unroll") for (int _i = 0; _i < 2; ++_i) \
        __builtin_amdgcn_global_load_lds((const unsigned*)((const char*)(gbase) + (voff)[_i]), (PG8_LAS unsigned*)(lds + (bufoff) + ldsw + _i * 8192), 16, 0, 0); } while (0)
#define PG8_LDA(dst, b, h) do { _Pragma("unroll") for (int m = 0; m < 4; ++m) _Pragma("unroll") for (int k = 0; k < 2; ++k) dst[m][k] = *(const PG8_LAS bf16x8*)(lds + PG8_SA(b, h) + aoff + m * 2048 + k * 1024); } while (0)
#define PG8_LDB(dst, b, h) do { _Pragma("unroll") for (int n = 0; n < 2; ++n) _Pragma("unroll") for (int k = 0; k < 2; ++k) dst[n][k] = *(const PG8_LAS bf16x8*)(lds + PG8_SB(b, h) + boff + n * 2048 + k * 1024); } while (0)
#define PG8_MMA(ai, bj, At, Bt) do { __builtin_amdgcn_s_setprio(1); _Pragma("unroll") for (int m = 0; m < 4; ++m) _Pragma("unroll") for (int n = 0; n < 2; ++n) _Pragma("unroll") for (int k = 0; k < 2; ++k) \
        acc[ai][bj][m][n] = __builtin_amdgcn_mfma_f32_16x16x32_bf16(Bt[n][k], At[m][k], acc[ai][bj][m][n], 0, 0, 0); __builtin_amdgcn_s_setprio(0); } while (0)
#define PG8_WAIT_V(n) asm volatile("s_waitcnt vmcnt(" #n ")" ::: "memory")
#define PG8_WAIT_L(n) asm volatile("s_waitcnt lgkmcnt(" #n ")" ::: "memory")
#define PG8_BAR __builtin_amdgcn_s_barrier()
#define PG8_SCHED __builtin_amdgcn_sched_barrier(0)
#define PG8_MKOFF(u, o) do { _Pragma("unroll") for (int _h = 0; _h < 2; ++_h) _Pragma("unroll") for (int _i = 0; _i < 2; ++_i) { \
        int _row = (u).pm * BM + _h * HALF + Rr[_i]; if (MODE == 1) _row = mi.list[_row]; (o)[_h][_i] = (unsigned)_row * rowb + (unsigned)Cc[_i] * 2u; } } while (0)
#define PG8_BBASE(u) ((const char*)g.Bt + (size_t)(u).pn * tstep + (MODE != 0 ? (size_t)mi.tile_expert[(u).pm] * mi.bstride : (size_t)0))
    Unit cur, nxt; int ui = 0;
    if (!S.next(0, cur)) return;
    f32x4 acc[2][2][4][2];
#pragma unroll
    for (int a = 0; a < 2; ++a)
#pragma unroll
        for (int b = 0; b < 2; ++b)
#pragma unroll
            for (int m = 0; m < 4; ++m)
#pragma unroll
                for (int n = 0; n < 2; ++n) acc[a][b][m][n] = (f32x4){0.f, 0.f, 0.f, 0.f};
    bf16x8 At[4][2], B0[2][2], B1[2][2];
    unsigned oc[2][2], on[2][2];
    PG8_MKOFF(cur, oc);
    const char* const Ab = (const char*)g.A;
    const char* cB = PG8_BBASE(cur);
    S.a_ready(cur);
    static_assert(SP2, "only the SP2 loop is kept");
    {
        PG8_STAGE(PG8_SB(0, 0), cB, voffB); PG8_STAGE(PG8_SB(0, 1), cB + hstep, voffB); PG8_STAGE(PG8_SA(0, 0), Ab, oc[0]); PG8_STAGE(PG8_SA(0, 1), Ab, oc[1]);
        if (wr == 1) PG8_BAR;
        PG8_WAIT_V(2); PG8_BAR;
        PG8_STAGE(PG8_SB(1, 0), cB + kstep, voffB); PG8_STAGE(PG8_SA(1, 0), Ab + kstep, oc[0]); PG8_STAGE(PG8_SB(1, 1), cB + hstep + kstep, voffB);
        PG8_WAIT_V(6); PG8_BAR;
    }
    for (;;) {
        const bool has_next = S.next(ui + 1, nxt);
        const char* nB = cB;
        if (has_next) { PG8_MKOFF(nxt, on); nB = PG8_BBASE(nxt); }
        else {
#pragma unroll
            for (int _h = 0; _h < 2; ++_h)
#pragma unroll
                for (int _i = 0; _i < 2; ++_i) on[_h][_i] = oc[_h][_i];
        }
        for (int t = 0; t < nt; t += 2) {
            const bool last = (t == nt - 2);
            const char* a1 = Ab + (size_t)(t + 1) * kstep;
            const char* a2 = last ? Ab : Ab + (size_t)(t + 2) * kstep; const char* b2 = last ? nB : cB + (size_t)(t + 2) * kstep;
            const char* a3 = a2 + kstep; const char* b3 = b2 + kstep;
            unsigned o2[2][2];
#pragma unroll
            for (int _h = 0; _h < 2; ++_h)
#pragma unroll
                for (int _i = 0; _i < 2; ++_i) o2[_h][_i] = last ? on[_h][_i] : oc[_h][_i];
            if (last && has_next) S.a_ready(nxt);
            PG8_LDB(B0, 0, 0); PG8_LDB(B1, 0, 1); PG8_SCHED; PG8_LDA(At, 0, 0); PG8_STAGE(PG8_SA(1, 1), a1, oc[1]);
            PG8_WAIT_V(8); PG8_WAIT_L(0); PG8_BAR; PG8_MMA(0, 0, At, B0); PG8_MMA(0, 1, At, B1); PG8_BAR; PG8_SCHED;
            PG8_LDA(At, 0, 1); PG8_STAGE(PG8_SB(0, 0), b2, voffB); PG8_STAGE(PG8_SB(0, 1), b2 + hstep, voffB); PG8_STAGE(PG8_SA(0, 0), a2, o2[0]);
            PG8_WAIT_V(8); PG8_WAIT_L(0); PG8_BAR; PG8_MMA(1, 0, At, B0); PG8_MMA(1, 1, At, B1); PG8_BAR; PG8_SCHED;
            PG8_LDB(B0, 1, 0); PG8_LDB(B1, 1, 1); PG8_SCHED; PG8_LDA(At, 1, 0); PG8_STAGE(PG8_SA(0, 1), a2, o2[1]);
            PG8_WAIT_V(8); PG8_WAIT_L(0); PG8_BAR; PG8_MMA(0, 0, At, B0); PG8_MMA(0, 1, At, B1); PG8_BAR; PG8_SCHED;
            PG8_LDA(At, 1, 1); PG8_STAGE(PG8_SB(1, 0), b3, voffB); PG8_STAGE(PG8_SB(1, 1), b3 + hstep, voffB); PG8_STAGE(PG8_SA(1, 0), a3, o2[0]);
            PG8_WAIT_V(8); PG8_WAIT_L(0); PG8_BAR; PG8_MMA(1, 0, At, B0); PG8_MMA(1, 1, At, B1); PG8_BAR; PG8_SCHED;
        }
        if constexpr (ALIGN_EPI) { if (wr == 0) PG8_BAR; }
        E(acc, cur, wr, wc, fr, fq); S.done(cur);
        if (!has_next) break;
#pragma unroll
        for (int a = 0; a < 2; ++a)
#pragma unroll
            for (int b = 0; b < 2; ++b)
#pragma unroll
                for (int m = 0; m < 4; ++m)
#pragma unroll
                    for (int n = 0; n < 2; ++n) acc[a][b][m][n] = (f32x4){0.f, 0.f, 0.f, 0.f};
        cur = nxt; cB = nB; ++ui;
#pragma unroll
        for (int _h = 0; _h < 2; ++_h)
#pragma unroll
            for (int _i = 0; _i < 2; ++_i) oc[_h][_i] = on[_h][_i];
        if constexpr (ALIGN_EPI) { if (wr == 1) PG8_BAR; }
    }
    PG8_WAIT_V(0);
    if constexpr (!ALIGN_EPI) { if (wr == 0) PG8_BAR; }
    PG8_BAR;
#undef PG8_SA
#undef PG8_SB
#undef PG8_STAGE
#undef PG8_LDA
#undef PG8_LDB
#undef PG8_MMA
#undef PG8_WAIT_V
#undef PG8_WAIT_L
#undef PG8_BAR
#undef PG8_SCHED
#undef PG8_MKOFF
#undef PG8_BBASE
}
}
namespace pg8 {
constexpr float LOG2E = 1.4426950408889634f;
struct EpiBf16 {
    static constexpr bool PERM = true;
    bf16_t* O; int ldc; float scale;
    __device__ __forceinline__ void operator()(const f32x4 (&acc)[2][2][4][2], const Unit& u, int wr, int wc, int fr, int fq) const {
        const int row0 = u.pm * BM + wr * 64 + fr; const int col0 = u.pn * BM + wc * 32 + 8 * fq;
#pragma unroll
        for (int ai = 0; ai < 2; ++ai)
#pragma unroll
            for (int m = 0; m < 4; ++m) { bf16_t* rowp = O + (size_t)(row0 + ai * HALF + m * 16) * ldc + col0;
#pragma unroll
                for (int bj = 0; bj < 2; ++bj) { const f32x4 v0 = acc[ai][bj][m][0] * scale, v1 = acc[ai][bj][m][1] * scale;
                    u32x4 w; w.x = cvt_pk_bf16(v0[0], v0[1]); w.y = cvt_pk_bf16(v0[2], v0[3]); w.z = cvt_pk_bf16(v1[0], v1[1]); w.w = cvt_pk_bf16(v1[2], v1[3]);
                    *(u32x4*)(rowp + bj * HALF) = w; } }
    }
};
struct EpiQ {
    static constexpr bool PERM = true;
    bf16_t* O; int ldc; float scale; const float* cs;
    __device__ __forceinline__ void operator()(const f32x4 (&acc)[2][2][4][2], const Unit& u, int wr, int wc, int fr, int fq) const {
        const int row0 = u.pm * BM + wr * 64 + fr; const int col0 = u.pn * BM + wc * 32 + 8 * fq;
        const int grp = u.pn * 8 + wc;
#pragma unroll
        for (int bj = 0; bj < 2; ++bj) { const bool rope = ((grp + 4 * bj) % 3) == 2;
#pragma unroll
            for (int ai = 0; ai < 2; ++ai)
#pragma unroll
                for (int m = 0; m < 4; ++m) { const int row = row0 + ai * HALF + m * 16; bf16_t* rowp = O + (size_t)row * ldc + col0 + bj * HALF;
                    f32x4 v0 = acc[ai][bj][m][0] * scale, v1 = acc[ai][bj][m][1] * scale;
                    if (rope) { const f32x4* cp = (const f32x4*)(cs + (size_t)row * 32 + 8 * fq); const f32x4 c0 = cp[0], c1 = cp[1];
                        f32x4 r0, r1;
                        r0[0] = v0[0] * c0[0] - v0[1] * c0[1]; r0[1] = v0[0] * c0[1] + v0[1] * c0[0];
                        r0[2] = v0[2] * c0[2] - v0[3] * c0[3]; r0[3] = v0[2] * c0[3] + v0[3] * c0[2];
                        r1[0] = v1[0] * c1[0] - v1[1] * c1[1]; r1[1] = v1[0] * c1[1] + v1[1] * c1[0];
                        r1[2] = v1[2] * c1[2] - v1[3] * c1[3]; r1[3] = v1[2] * c1[3] + v1[3] * c1[2];
                        v0 = r0; v1 = r1; }
                    u32x4 w; w.x = cvt_pk_bf16(v0[0], v0[1]); w.y = cvt_pk_bf16(v0[2], v0[3]); w.z = cvt_pk_bf16(v1[0], v1[1]); w.w = cvt_pk_bf16(v1[2], v1[3]);
                    *(u32x4*)rowp = w;
                    if (m & 1) asm volatile("" ::: "memory"); } }
    }
};
struct EpiKV {
    static constexpr bool PERM = true;
    bf16_t* Kb; bf16_t* Vb;
    __device__ __forceinline__ void operator()(const f32x4 (&acc)[2][2][4][2], const Unit& u, int wr, int wc, int fr, int fq) const {
        const int row0 = u.pm * BM + wr * 64 + fr;
        const bool isk = wc < 2;
        bf16_t* const base = isk ? Kb : Vb; const int pitch = isk ? 1536 : 1024, hs = isk ? 96 : 64, j0 = (isk ? wc : wc - 2) * 32 + 8 * fq;
#pragma unroll
        for (int ai = 0; ai < 2; ++ai)
#pragma unroll
            for (int m = 0; m < 4; ++m) { bf16_t* rowp = base + (size_t)(row0 + ai * HALF + m * 16) * pitch + j0;
#pragma unroll
                for (int bj = 0; bj < 2; ++bj) { const f32x4 v0 = acc[ai][bj][m][0], v1 = acc[ai][bj][m][1];
                    u32x4 w; w.x = cvt_pk_bf16(v0[0], v0[1]); w.y = cvt_pk_bf16(v0[2], v0[3]); w.z = cvt_pk_bf16(v1[0], v1[1]); w.w = cvt_pk_bf16(v1[2], v1[3]);
                    *(u32x4*)(rowp + (2 * u.pn + bj) * hs) = w; } }
    }
};
struct EpiResid {
    static constexpr bool PERM = false;
    const float* base; float* out; const float* gate;
    __device__ __forceinline__ void operator()(const f32x4 (&acc)[2][2][4][2], const Unit& u, int wr, int wc, int fr, int fq) const {
        const int row0 = u.pm * BM + wr * 64 + fr; const int col0 = u.pn * BM + wc * 32 + 4 * fq;
        const float* gp = gate + (size_t)((u.pm * BM) >> 13) * 1024 + col0;
        f32x4 gv[2][2];
#pragma unroll
        for (int bj = 0; bj < 2; ++bj)
#pragma unroll
            for (int n = 0; n < 2; ++n) gv[bj][n] = *(const f32x4*)(gp + bj * HALF + n * 16);
#pragma unroll
        for (int ai = 0; ai < 2; ++ai)
#pragma unroll
            for (int m = 0; m < 4; ++m) { const size_t off = (size_t)(row0 + ai * HALF + m * 16) * 1024 + col0;
#pragma unroll
                for (int bj = 0; bj < 2; ++bj)
#pragma unroll
                    for (int n = 0; n < 2; ++n) { const f32x4 bs = *(const f32x4*)(base + off + bj * HALF + n * 16);
                        *(f32x4*)(out + off + bj * HALF + n * 16) = bs + gv[bj][n] * acc[ai][bj][m][n]; }
                if (m & 1) asm volatile("" ::: "memory"); }
    }
};
__device__ __forceinline__ float silu_mul(float g, float u) { return g * u * __builtin_amdgcn_rcpf(1.0f + __builtin_amdgcn_exp2f(-g * LOG2E)); }
struct EpiSwiGLU {
    static constexpr bool PERM = true;
    bf16_t* O; int ldc;
    __device__ __forceinline__ void operator()(const f32x4 (&acc)[2][2][4][2], const Unit& u, int wr, int wc, int fr, int fq) const {
        const int row0 = u.pm * BM + wr * 64 + fr; const int col0 = u.pn * HALF + wc * 32 + 8 * fq;
#pragma unroll
        for (int ai = 0; ai < 2; ++ai)
#pragma unroll
            for (int m = 0; m < 4; ++m) { bf16_t* rowp = O + (size_t)(row0 + ai * HALF + m * 16) * ldc + col0;
                const f32x4 g0 = acc[ai][0][m][0], g1 = acc[ai][0][m][1], u0 = acc[ai][1][m][0], u1 = acc[ai][1][m][1];
                u32x4 w; w.x = cvt_pk_bf16(silu_mul(g0[0], u0[0]), silu_mul(g0[1], u0[1])); w.y = cvt_pk_bf16(silu_mul(g0[2], u0[2]), silu_mul(g0[3], u0[3]));
                w.z = cvt_pk_bf16(silu_mul(g1[0], u1[0]), silu_mul(g1[1], u1[1])); w.w = cvt_pk_bf16(silu_mul(g1[2], u1[2]), silu_mul(g1[3], u1[3]));
                *(u32x4*)rowp = w; }
    }
};
struct EpiMoeDown {
    static constexpr bool PERM = true;
    bf16_t* O; const float* sg;
    __device__ __forceinline__ void operator()(const f32x4 (&acc)[2][2][4][2], const Unit& u, int wr, int wc, int fr, int fq) const {
        const int row0 = u.pm * BM + wr * 64 + fr; const int col0 = u.pn * BM + wc * 32 + 8 * fq;
#pragma unroll
        for (int ai = 0; ai < 2; ++ai)
#pragma unroll
            for (int m = 0; m < 4; ++m) { const int row = row0 + ai * HALF + m * 16; const float s = sg[row]; bf16_t* rowp = O + (size_t)row * 1024 + col0;
#pragma unroll
                for (int bj = 0; bj < 2; ++bj) { const f32x4 v0 = acc[ai][bj][m][0] * s, v1 = acc[ai][bj][m][1] * s;
                    u32x4 w; w.x = cvt_pk_bf16(v0[0], v0[1]); w.y = cvt_pk_bf16(v0[2], v0[3]); w.z = cvt_pk_bf16(v1[0], v1[1]); w.w = cvt_pk_bf16(v1[2], v1[3]);
                    *(u32x4*)(rowp + bj * HALF) = w; } }
    }
};
}
namespace att {
using bf16 = unsigned short;
using bf16x8 = __attribute__((ext_vector_type(8))) short;
using s16x4 = __attribute__((ext_vector_type(4))) short;
using f32x16 = __attribute__((ext_vector_type(16))) float;
using u32x4 = __attribute__((ext_vector_type(4))) unsigned;
constexpr int NW = 8;
constexpr float THR = 8.0f;
__device__ __forceinline__ int crow(int r, int hi) { return (r & 3) + 8 * (r >> 2) + 4 * hi; }
__device__ __forceinline__ void glds16(const void* gsrc, unsigned lds_dst) { unsigned keep;
    asm volatile("s_mov_b32 %0, m0\n\ts_mov_b32 m0, %2\n\ts_nop 0\n\tglobal_load_lds_dwordx4 %1, off\n\ts_mov_b32 m0, %0" : "=&s"(keep) : "v"(gsrc), "s"(lds_dst) : "memory"); }
typedef float f32x2_t __attribute__((ext_vector_type(2))); typedef __bf16 bf16x2_t __attribute__((ext_vector_type(2)));
__device__ __forceinline__ unsigned cvtpk_s(float lo, float hi) { f32x2_t v = {lo, hi}; bf16x2_t b = __builtin_convertvector(v, bf16x2_t); return __builtin_bit_cast(unsigned, b); }
#define ATT_SBAR() __builtin_amdgcn_sched_barrier(0)
#define ATT_WAIT_BAR(N) asm volatile("s_waitcnt vmcnt(" #N ") lgkmcnt(0)\n\ts_barrier" ::: "memory")

template <int DQK> struct Lay {
    static constexpr int NKC = DQK / 8, KSLOT = NKC * 1024, ND0 = DQK / 16;
    static constexpr int LK = 0, LV = 3 * KSLOT, LWS = LV + 3 * 8192, LOST = LWS + NW * 256, LBIAS = LOST + NW * 4096, LEND = LBIAS + 1024;
};
static_assert(Lay<96>::LEND <= 131072 && Lay<64>::LEND <= 131072, "attention LDS");

__device__ __forceinline__ float rowmax32(const f32x16& p0, const f32x16& p1) {
    float a = __builtin_fmaxf(__builtin_fmaxf(p0[0], p0[1]), p1[0]), b = __builtin_fmaxf(__builtin_fmaxf(p0[2], p0[3]), p1[1]); a = __builtin_fmaxf(__builtin_fmaxf(a, p1[2]), p1[3]);
#pragma unroll
    for (int r = 4; r < 16; r += 4) { a = __builtin_fmaxf(__builtin_fmaxf(a, p0[r]), p0[r + 1]); b = __builtin_fmaxf(__builtin_fmaxf(b, p0[r + 2]), p0[r + 3]); a = __builtin_fmaxf(__builtin_fmaxf(a, p1[r]), p1[r + 1]); b = __builtin_fmaxf(__builtin_fmaxf(b, p1[r + 2]), p1[r + 3]); }
    float m = __builtin_fmaxf(a, b);
    auto rr = __builtin_amdgcn_permlane32_swap(__float_as_uint(m), __float_as_uint(m), false, false);
    return __builtin_fmaxf(__uint_as_float(rr[0]), __uint_as_float(rr[1]));
}
__device__ __forceinline__ void pv(f32x16* o, int vb, bf16x8 pa0, bf16x8 pa1, bf16x8 pa2, bf16x8 pa3) {
#pragma unroll
    for (int d0 = 0; d0 < 2; ++d0) { s16x4 lo[4], hi[4];
#pragma unroll
        for (int ks = 0; ks < 4; ++ks) {
            asm volatile("ds_read_b64_tr_b16 %0,%1 offset:%c2" : "=&v"(lo[ks]) : "v"(vb), "i"(d0 * 4096 + ks * 1024) : "memory");
            asm volatile("ds_read_b64_tr_b16 %0,%1 offset:%c2" : "=&v"(hi[ks]) : "v"(vb), "i"(d0 * 4096 + ks * 1024 + 512) : "memory"); }
        asm volatile("s_waitcnt lgkmcnt(0)" ::: "memory"); ATT_SBAR();
#define ATT_PK(k) (bf16x8){lo[k][0], lo[k][1], lo[k][2], lo[k][3], hi[k][0], hi[k][1], hi[k][2], hi[k][3]}
        o[d0] = __builtin_amdgcn_mfma_f32_32x32x16_bf16(pa0, ATT_PK(0), o[d0], 0, 0, 0);
        o[d0] = __builtin_amdgcn_mfma_f32_32x32x16_bf16(pa1, ATT_PK(1), o[d0], 0, 0, 0);
        o[d0] = __builtin_amdgcn_mfma_f32_32x32x16_bf16(pa2, ATT_PK(2), o[d0], 0, 0, 0);
        o[d0] = __builtin_amdgcn_mfma_f32_32x32x16_bf16(pa3, ATT_PK(3), o[d0], 0, 0, 0);
#undef ATT_PK
    }
}

template <int DQK, bool DIL>
__device__ __forceinline__ void attn_unit(const bf16* Qb, int pq, const bf16* __restrict__ Kb, int pk, const bf16* __restrict__ Vb, int pvp, bf16* Ob, int po, float* lse, const float* biasg,
                                          long rowbase, int dil, int q0, char* shm) {
    typedef Lay<DQK> L;
    const int tid = threadIdx.x, lane = tid & 63, r32 = lane & 31, hi = lane >> 5; const int wid = __builtin_amdgcn_readfirstlane(tid >> 6);
    const unsigned lds0 = (unsigned)(uintptr_t)shm;
    float* wsf = (float*)(shm + L::LWS) + wid * 64;
    const int kpos0 = DIL ? q0 - 128 : 0;
    const int t_begin = DIL ? (q0 == 0 ? 2 : 0) : 0;
    const int t_end = DIL ? 6 : (q0 + 256) / 64;
    const int wt0 = DIL ? (wid >> 1) : 0;
    const int wt1 = DIL ? 2 + (wid >> 1) : (q0 + 32 * wid + 31) / 64;
    const bool two_k = (L::NKC > 8) && (wid + 8 < L::NKC);
#define ATT_GROW(pos) (rowbase + (long)(pos) * dil)
#define ATT_ISSUE(t, s) do { const int kp_ = kpos0 + 64 * (t); \
        glds16(Kb + ATT_GROW(kp_ + lane) * pk + wid * 8, (unsigned)__builtin_amdgcn_readfirstlane(lds0 + L::LK + (s) * L::KSLOT + wid * 1024)); \
        if (two_k) glds16(Kb + ATT_GROW(kp_ + lane) * pk + (wid + 8) * 8, (unsigned)__builtin_amdgcn_readfirstlane(lds0 + L::LK + (s) * L::KSLOT + (wid + 8) * 1024)); \
        glds16(Vb + ATT_GROW(kp_ + 16 * (wid & 3) + (lane >> 2)) * pvp + (wid >> 2) * 32 + (lane & 3) * 8, (unsigned)__builtin_amdgcn_readfirstlane(lds0 + L::LV + (s) * 8192 + wid * 1024)); } while (0)
    if (DIL) { if (tid < 129) ((float*)(shm + L::LBIAS))[tid] = biasg[tid]; }
    ATT_ISSUE(t_begin, 0);
    if (t_begin + 1 < t_end) ATT_ISSUE(t_begin + 1, 1);
    bf16x8 qr[L::ND0];
    { const bf16* Qw = Qb + ATT_GROW(q0 + wid * 32 + r32) * pq + hi * 8;
#pragma unroll
      for (int d0 = 0; d0 < L::ND0; ++d0) qr[d0] = *reinterpret_cast<const bf16x8*>(Qw + d0 * 16); }
    float mhat = 0.f, l_reg = 0.f; f32x16 o[2]; o[0] = f32x16{}; o[1] = f32x16{}; f32x16 negm = f32x16{};
    bool first = true;
    const int qrel = (DIL ? 128 : q0) + wid * 32 + r32;
    const int vbl = (int)(lds0 + L::LV) + ((lane >> 4) & 1) * 32 + (lane & 3) * 8 + (4 * hi + ((lane & 15) >> 2)) * 64;
    int slot = 0;
    for (int t = t_begin; t < t_end; ++t) {
        if (t + 1 < t_end) { if (two_k) ATT_WAIT_BAR(3); else ATT_WAIT_BAR(2); } else ATT_WAIT_BAR(0);
        if (t + 2 < t_end) { const int s2 = slot >= 1 ? slot - 1 : 2; ATT_ISSUE(t + 2, s2); }
        if (t >= wt0 && t <= wt1) {
            f32x16 p0, p1;
            { const char* kb = shm + L::LK + slot * L::KSLOT + hi * 1024 + r32 * 16;
#pragma unroll
              for (int d0 = 0; d0 < L::ND0; ++d0) {
                const bf16x8 b0 = *reinterpret_cast<const bf16x8*>(kb + d0 * 2048);
                const bf16x8 b1 = *reinterpret_cast<const bf16x8*>(kb + d0 * 2048 + 512);
                if (d0 == 0) { p0 = __builtin_amdgcn_mfma_f32_32x32x16_bf16(b0, qr[0], negm, 0, 0, 0); p1 = __builtin_amdgcn_mfma_f32_32x32x16_bf16(b1, qr[0], negm, 0, 0, 0); }
                else { p0 = __builtin_amdgcn_mfma_f32_32x32x16_bf16(b0, qr[d0], p0, 0, 0, 0); p1 = __builtin_amdgcn_mfma_f32_32x32x16_bf16(b1, qr[d0], p1, 0, 0, 0); } } }
            if (DIL) { const float* bl = (const float*)(shm + L::LBIAS); const int jb = qrel - 64 * t - 4 * hi;
#pragma unroll
                for (int r = 0; r < 16; ++r) { const int j0 = jb - ((r & 3) + 8 * (r >> 2)), j1 = j0 - 32;
                    const int c0 = j0 < 0 ? 0 : (j0 > 128 ? 128 : j0), c1 = j1 < 0 ? 0 : (j1 > 128 ? 128 : j1);
                    const float b0 = bl[c0], b1 = bl[c1];
                    p0[r] = (j0 >= 0 && j0 <= 128) ? p0[r] + b0 : -INFINITY; p1[r] = (j1 >= 0 && j1 <= 128) ? p1[r] + b1 : -INFINITY; }
            } else if (64 * t + 63 > q0 + 32 * wid) { const int jb = qrel - 64 * t - 4 * hi;
#pragma unroll
                for (int r = 0; r < 16; ++r) { const int j0 = jb - ((r & 3) + 8 * (r >> 2)); if (j0 < 0) p0[r] = -INFINITY; if (j0 - 32 < 0) p1[r] = -INFINITY; } }
            const float rm = rowmax32(p0, p1);
            if (first) { first = false; const float dl = rm; mhat += dl;
#pragma unroll
                for (int r = 0; r < 16; ++r) { p0[r] -= dl; p1[r] -= dl; }
#pragma unroll
                for (int r = 0; r < 16; ++r) negm[r] = -mhat;
            } else if (__any(rm > THR)) { const float dl = __builtin_fmaxf(rm, 0.f); mhat += dl;
#pragma unroll
                for (int r = 0; r < 16; ++r) { p0[r] -= dl; p1[r] -= dl; }
#pragma unroll
                for (int r = 0; r < 16; ++r) negm[r] = -mhat;
                const float f = __builtin_amdgcn_exp2f(-dl); l_reg *= f; if (hi == 0) wsf[r32] = f;
                asm volatile("s_waitcnt lgkmcnt(0)" ::: "memory");
#pragma unroll
                for (int d_ = 0; d_ < 2; ++d_)
#pragma unroll
                    for (int r = 0; r < 16; ++r) o[d_][r] *= wsf[crow(r, hi)];
                asm volatile("s_waitcnt lgkmcnt(0)" ::: "memory");
            }
            float sacc = 0.f;
#pragma unroll
            for (int r = 0; r < 16; ++r) { p0[r] = __builtin_amdgcn_exp2f(p0[r]); p1[r] = __builtin_amdgcn_exp2f(p1[r]); sacc += p0[r] + p1[r]; }
            l_reg += sacc;
            u32x4 pw0, pw1, pw2, pw3;
#define ATT_PKW(P, B) cvtpk_s(P[B], P[B + 1])
            pw0 = (u32x4){ATT_PKW(p0, 0), ATT_PKW(p0, 2), ATT_PKW(p0, 4), ATT_PKW(p0, 6)}; pw1 = (u32x4){ATT_PKW(p0, 8), ATT_PKW(p0, 10), ATT_PKW(p0, 12), ATT_PKW(p0, 14)};
            pw2 = (u32x4){ATT_PKW(p1, 0), ATT_PKW(p1, 2), ATT_PKW(p1, 4), ATT_PKW(p1, 6)}; pw3 = (u32x4){ATT_PKW(p1, 8), ATT_PKW(p1, 10), ATT_PKW(p1, 12), ATT_PKW(p1, 14)};
#undef ATT_PKW
            ATT_SBAR();
            pv(o, vbl + slot * 8192, __builtin_bit_cast(bf16x8, pw0), __builtin_bit_cast(bf16x8, pw1), __builtin_bit_cast(bf16x8, pw2), __builtin_bit_cast(bf16x8, pw3));
        }
        slot = slot == 2 ? 0 : slot + 1;
    }
    { auto rr = __builtin_amdgcn_permlane32_swap(__float_as_uint(l_reg), __float_as_uint(l_reg), false, false); l_reg = __uint_as_float(rr[0]) + __uint_as_float(rr[1]); }
    if (hi == 0) wsf[32 + r32] = l_reg;
    asm volatile("s_waitcnt lgkmcnt(0)" ::: "memory");
    float rli[16];
#pragma unroll
    for (int r = 0; r < 16; ++r) rli[r] = __builtin_amdgcn_rcpf(wsf[32 + crow(r, hi)]);
    if (DIL) { if (hi == 0) lse[ATT_GROW(q0 + wid * 32 + r32) * 8] = mhat + __builtin_amdgcn_logf(l_reg); }
    { bf16* stg = (bf16*)(shm + L::LOST) + wid * 2048;
#pragma unroll
      for (int r = 0; r < 16; ++r) { const int orow = crow(r, hi);
#pragma unroll
        for (int d0 = 0; d0 < 2; ++d0) stg[orow * 64 + d0 * 32 + r32] = (bf16)(cvtpk_s(o[d0][r] * rli[r], 0.f) & 0xffffu); }
      asm volatile("s_waitcnt lgkmcnt(0)" ::: "memory");
#pragma unroll
      for (int i = 0; i < 4; ++i) { const int row = i * 8 + (lane >> 3), ch = lane & 7; const u32x4 v = *(const u32x4*)(stg + row * 64 + ch * 8);
        *(u32x4*)(Ob + ATT_GROW(q0 + wid * 32 + row) * po + ch * 8) = v; } }
    asm volatile("s_waitcnt lgkmcnt(0)\n\ts_barrier" ::: "memory");
#undef ATT_GROW
#undef ATT_ISSUE
}
#undef ATT_SBAR
#undef ATT_WAIT_BAR
}
constexpr int NWAVES = 8;
constexpr int BATCH = 4, SEQ = 8192, D = 1024, M = BATCH * SEQ;
constexpr int MLA_H = 16, QRANK = 384, KVRANK = 256, LATN = 672, LATP = 768, QUP = 1536, KVUP = 2048;
constexpr int DFF = 2816, NEXP = 8, DILQ = 1536, DILKV = 3072, DILOUT = 512;
constexpr int MAXSLOT = 67584;
constexpr float EPS = 1e-6f;
constexpr float C2_MLA = 0.1472444460259031f;
constexpr float C2_DIL = 0.18033688011112042f;
constexpr float LOG2E_F = 1.4426950408889634f;

constexpr size_t MiB = 1u << 20;
constexpr size_t WS_CTL = 0, CTL_ZERO_BYTES = 64 * 1024;
constexpr size_t WS_MODV = 1 * MiB;
constexpr size_t WS_BIAS = 1 * MiB + 256 * 1024;
constexpr size_t WS_ROUTE = 1 * MiB + 512 * 1024;
constexpr size_t WS_CNT = 2 * MiB;
constexpr size_t WS_LIST = 2 * MiB + 256 * 1024;
constexpr size_t WS_SLOTG = 2 * MiB + 768 * 1024;
constexpr size_t WS_TOKSLOT = 3 * MiB + 256 * 1024;
constexpr size_t WS_TILEEXP = 3 * MiB + 768 * 1024;
constexpr size_t WS_CS = 4 * MiB;
constexpr size_t WS_LSE = 8 * MiB;
constexpr size_t WS_WEGU = 12 * MiB, WS_WEDN = 100 * MiB, WS_WFGU = 144 * MiB, WS_WFDN = 155 * MiB, WS_WKVB = 161 * MiB, WS_WQB = 167 * MiB, WS_WOUT = 170 * MiB,
                 WS_WOB = 172 * MiB, WS_WMLAIN = 173 * MiB, WS_WQUP = 175 * MiB, WS_WKVUP = 177 * MiB;
constexpr size_t WS_ARENA = 180 * MiB;
constexpr size_t A_XN = WS_ARENA, A_LAT = WS_ARENA + 64 * MiB, A_QN = WS_ARENA + 112 * MiB, A_KVN = WS_ARENA + 136 * MiB, A_Q = WS_ARENA + 152 * MiB, A_K = WS_ARENA + 248 * MiB,
                 A_V = WS_ARENA + 344 * MiB, A_O = WS_ARENA + 408 * MiB, A_HID = WS_ARENA + 64 * MiB, A_XNKV = WS_ARENA + 64 * MiB, A_KVB = WS_ARENA + 128 * MiB, A_QB = WS_ARENA + 320 * MiB,
                 A_OG = WS_ARENA, A_OD = WS_ARENA + 128 * MiB, A_HIDS = WS_ARENA + 160 * MiB, A_Y = WS_ARENA;
constexpr size_t WS_END = WS_ARENA + 523 * MiB;
static_assert(A_HIDS + (size_t)MAXSLOT * DFF * 2 <= WS_END && A_Y + (size_t)MAXSLOT * D * 2 <= A_HIDS && A_O + (size_t)M * D * 2 <= WS_END, "arena map");
static_assert(WS_WEGU + (size_t)NEXP * 2 * DFF * D * 2 <= WS_WEDN && WS_WEDN + (size_t)NEXP * D * DFF * 2 <= WS_WFGU && WS_WFGU + (size_t)2 * DFF * D * 2 <= WS_WFDN && WS_WFDN + (size_t)D * DFF * 2 <= WS_WKVB, "weight map");
enum ModKind { MK_A_MIX0 = 0, MK_B_MIX0, MK_G_MIX0, MK_A_FFN0, MK_B_FFN0, MK_G_FFN0, MK_A_MIX1, MK_B_MIX1, MK_G_MIX1, MK_A_FFN1, MK_B_FFN1, MK_G_FFN1, MK_A_KV, MK_B_KV };
constexpr int CW_BAR = 4096;

constexpr int RING_BYTES = 131072;
constexpr int LDSCTL_OFF = RING_BYTES, MISC_OFF = LDSCTL_OFF + 320;
constexpr int LDS_BYTES = 147456;

#define GAS __attribute__((address_space(1)))
#define LAS __attribute__((address_space(3)))
typedef unsigned short bf16;
typedef unsigned v4u __attribute__((ext_vector_type(4)));
typedef unsigned v2u __attribute__((ext_vector_type(2)));
typedef float f32x4 __attribute__((ext_vector_type(4)));
typedef GAS unsigned gu32;
#define RLX_AGENT __ATOMIC_RELAXED, __HIP_MEMORY_SCOPE_AGENT
#define LDS_WAIT() asm volatile("s_waitcnt lgkmcnt(0)" ::: "memory")
#define VM_WAIT() asm volatile("s_waitcnt vmcnt(0)" ::: "memory")
__device__ __forceinline__ unsigned f2bf(float f) { unsigned u = __builtin_bit_cast(unsigned, f); return (u + 0x7fffu + ((u >> 16) & 1u)) >> 16; }
__device__ __forceinline__ unsigned pk2(float lo, float hi) { return f2bf(lo) | (f2bf(hi) << 16); }
__device__ __forceinline__ float bf_lo(unsigned w) { return __builtin_bit_cast(float, w << 16); }
__device__ __forceinline__ float bf_hi(unsigned w) { return __builtin_bit_cast(float, w & 0xffff0000u); }
__device__ __forceinline__ float wave_sum(float v) {
#pragma unroll
    for (int o = 1; o < 64; o <<= 1) v += __shfl_xor(v, o);
    return v;
}

#define XB_TMO      128
#define XB_XCNT(j)  (256  + 64 * (j))
#define XB_XSUB(j)  (1280 + 64 * (j))
#define XB_XGEN(j)  (2304 + 64 * (j))
#define XB_TOP      3328
#define XB_TOPGEN   3392
#define XCD_BAR_WORDS 3456
#define XB_SPIN_CAP (1u << 18)
__device__ __forceinline__ unsigned xb_ld(unsigned* p)              { return __hip_atomic_load(p, __ATOMIC_RELAXED, __HIP_MEMORY_SCOPE_AGENT); }
__device__ __forceinline__ unsigned xb_add(unsigned* p, unsigned v) { return __hip_atomic_fetch_add(p, v, __ATOMIC_RELAXED, __HIP_MEMORY_SCOPE_AGENT); }
__device__ __forceinline__ unsigned xb_xcc_id() { return (unsigned)__builtin_amdgcn_s_getreg((3 << 11) | 20) & 0xFu; }
#define XB_SPIN(cond, bar) do { unsigned _sp = 0; while (cond) { __builtin_amdgcn_s_sleep(1); \
    if ((++_sp & 255u) == 0u) { if (xb_ld(&(bar)[XB_TMO])) break; if (_sp > XB_SPIN_CAP) { atomicAdd(&(bar)[XB_TMO], 1u); break; } } } } while (0)
struct XcdBarrier { unsigned* bar; unsigned x; volatile LAS unsigned* st; };
__device__ __forceinline__ XcdBarrier xcd_barrier_post(unsigned* bar, volatile LAS unsigned* st) {
    XcdBarrier b; b.bar = bar; b.x = xb_xcc_id(); b.st = st;
    if (threadIdx.x == 0) (void)xb_add(&bar[XB_XCNT(b.x)], 1u);
    return b;
}
__device__ __forceinline__ void xcd_barrier_complete(unsigned* bar, unsigned x, unsigned& nloc, unsigned& nx) {
    const unsigned G = gridDim.x * gridDim.y * gridDim.z;
    unsigned sum, cnt, mine, sp = 0u;
    for (;;) {
        sum = 0u; cnt = 0u; mine = 0u;
#pragma unroll
        for (unsigned j = 0; j < 16; ++j) { const unsigned c = xb_ld(&bar[XB_XCNT(j)]); sum += c; cnt += (c > 0u) ? 1u : 0u; mine = (j == x) ? c : mine; }
        if (sum == G) break;
        __builtin_amdgcn_s_sleep(1);
        if ((++sp & 255u) == 0u) { if (xb_ld(&bar[XB_TMO])) break; if (sp > XB_SPIN_CAP) { atomicAdd(&bar[XB_TMO], 1u); break; } }
    }
    nloc = mine > 0u ? mine : 1u; nx = cnt > 0u ? cnt : 1u;
}
__device__ __forceinline__ void xcd_barrier(const XcdBarrier& b) {
    asm volatile("s_waitcnt vmcnt(0)" ::: "memory");
    __syncthreads();
    if (threadIdx.x == 0) {
        unsigned* bar = b.bar;
        __builtin_amdgcn_s_waitcnt(0);
        unsigned nloc = b.st[0], nx = b.st[1];
        if (nloc == 0u) { xcd_barrier_complete(bar, b.x, nloc, nx); b.st[0] = nloc; b.st[1] = nx; }
        const unsigned old = xb_add(&bar[XB_XSUB(b.x)], 1u);
        const unsigned gen = old / nloc;
        if (old + 1u == (gen + 1u) * nloc) {
            __builtin_amdgcn_fence(__ATOMIC_RELEASE, "agent");
            asm volatile("s_waitcnt vmcnt(0)" ::: "memory");
            const unsigned og = xb_add(&bar[XB_TOP], 1u);
            const unsigned tg = og / nx;
            if (og + 1u == (tg + 1u) * nx) xb_add(&bar[XB_TOPGEN], 1u);
            else XB_SPIN(xb_ld(&bar[XB_TOPGEN]) == tg, bar);
            __builtin_amdgcn_fence(__ATOMIC_ACQUIRE, "agent");
            xb_add(&bar[XB_XGEN(b.x)], 1u);
            asm volatile("s_waitcnt vmcnt(0)" ::: "memory");
        } else {
            XB_SPIN(xb_ld(&bar[XB_XGEN(b.x)]) == gen, bar);
            __builtin_amdgcn_fence(__ATOMIC_ACQUIRE, "agent");
            asm volatile("s_waitcnt vmcnt(0)" ::: "memory");
        }
    }
    __syncthreads();
}

struct Frame {
    LAS unsigned char* lds;
    volatile LAS unsigned* MISC;
    int tid, lane, wave;
    int vcu, G;
    unsigned char* ws;
    const float* in[26];
    float* out;
};
enum { MAP_PLAIN = 0, MAP_MLAIN = 1, MAP_QUP = 2, MAP_GU = 3 };
template <int MAP> __device__ __forceinline__ int dmap(int n) {
    if (MAP == MAP_MLAIN) { if (n < 640) return n; if (n < 656) return 640 + 2 * (n - 640); return 640 + 2 * (n - 656) + 1; }
    if (MAP == MAP_QUP) { const int h = n / 96, j = n % 96; if (j < 64) return n; if (j < 80) return h * 96 + 64 + 2 * (j - 64); return h * 96 + 64 + 2 * (j - 80) + 1; }
    if (MAP == MAP_GU) { const int up = n >= DFF ? 1 : 0; const int c = up ? n - DFF : n; return (c >> 7) * 256 + up * 128 + (c & 127); }
    return n;
}
template <int MAP> __device__ __forceinline__ void transpose_item(const float* W, int K, int N, bf16* WT, const float* ks, LAS float* scr, int item, int lane) {
    const int nblk = N / 32, kb = item / nblk, nb = item % nblk, k0 = 64 * kb, n0 = 32 * nb;
#pragma unroll 8
    for (int i = 0; i < 32; ++i) { const int kk = 2 * i + (lane >> 5); float v = W[(size_t)(k0 + kk) * N + n0 + (lane & 31)]; if (ks) v *= ks[k0 + kk]; scr[kk * 33 + (lane & 31)] = v; }
    LDS_WAIT(); asm volatile("" ::: "memory");
    const int c = lane & 7;
#pragma unroll
    for (int j = 0; j < 4; ++j) { const int n = (lane >> 3) + 8 * j; const LAS float* s = scr + (8 * c) * 33 + n;
        v4u o; o.x = pk2(s[0 * 33], s[1 * 33]); o.y = pk2(s[2 * 33], s[3 * 33]); o.z = pk2(s[4 * 33], s[5 * 33]); o.w = pk2(s[6 * 33], s[7 * 33]);
        *(GAS v4u*)(WT + (size_t)dmap<MAP>(n0 + n) * K + k0 + 8 * c) = o; }
    LDS_WAIT(); asm volatile("" ::: "memory");
}
__device__ __constant__ double INVF_D[16] = {1.0, 0.5623413251903491, 0.31622776601683794, 0.1778279410038923, 0.09999999999999999, 0.056234132519034905, 0.03162277660168379, 0.01778279410038923,
    0.01, 0.005623413251903491, 0.0031622776601683794, 0.0017782794100389228, 0.001, 0.000562341325190349, 0.00031622776601683794, 0.0001778279410038923};
__device__ __constant__ int RPB_TH[15] = {22, 30, 40, 54, 73, 99, 134, 182, 246, 332, 450, 609, 825, 1117, 1513};

__device__ __forceinline__ void p0_prologue(Frame& F) {
    const int gw = F.vcu * NWAVES + F.wave, NGW = F.G * NWAVES;
    const int gtid = F.vcu * (NWAVES * 64) + F.tid, NGT = F.G * NWAVES * 64;
    float* MODV = (float*)(F.ws + WS_MODV);
    {
        LAS float* cact = (LAS float*)F.lds;
        LAS float* red = (LAS float*)(F.lds + 16384);
        const float* cin = F.in[1];
        for (int i = F.tid; i < 4096; i += NWAVES * 64) { const int b = i >> 10, k = i & 1023; const float x = cin[i]; cact[k * 4 + b] = x / (1.0f + expf(-x)); }
        __syncthreads();
        constexpr int NTASK = (6 * D * 2 + 2 * D) / 64;
        for (int task = F.vcu; task < NTASK; task += F.G) {
            const int gc = task * 64 + F.lane;
            const float* W; int ldw, cc; const float* bias;
            if (gc < 6 * D) { W = F.in[5]; ldw = 6 * D; cc = gc; bias = F.in[6]; }
            else if (gc < 12 * D) { W = F.in[5] + (size_t)D * 6 * D; ldw = 6 * D; cc = gc - 6 * D; bias = F.in[6] + 6 * D; }
            else { W = F.in[14]; ldw = 2 * D; cc = gc - 12 * D; bias = F.in[15]; }
            float a0 = 0.f, a1 = 0.f, a2 = 0.f, a3 = 0.f;
            const int kbeg = F.wave * 128;
#pragma unroll 16
            for (int k = 0; k < 128; ++k) { const float w = W[(size_t)(kbeg + k) * ldw + cc]; const f32x4 ca = *(const LAS f32x4*)(cact + (kbeg + k) * 4);
                a0 += w * ca[0]; a1 += w * ca[1]; a2 += w * ca[2]; a3 += w * ca[3]; }
            red[(F.wave * 4 + 0) * 64 + F.lane] = a0; red[(F.wave * 4 + 1) * 64 + F.lane] = a1; red[(F.wave * 4 + 2) * 64 + F.lane] = a2; red[(F.wave * 4 + 3) * 64 + F.lane] = a3;
            __syncthreads();
            if (F.wave < 4) { const int b = F.wave; float s = 0.f;
#pragma unroll
                for (int w = 0; w < 8; ++w) s += red[(w * 4 + b) * 64 + F.lane];
                s += bias[cc];
                int kind; float val = s; const int j = cc & 1023, ch = cc >> 10;
                if (gc < 12 * D) { const int Lr = gc < 6 * D ? 0 : 1;
                    if (ch == 0) kind = 6 * Lr + 1; else if (ch == 1) { kind = 6 * Lr + 0; val = F.in[3][Lr * D + j] * (1.0f + s); } else if (ch == 2) kind = 6 * Lr + 2;
                    else if (ch == 3) kind = 6 * Lr + 4; else if (ch == 4) { kind = 6 * Lr + 3; val = F.in[4][Lr * D + j] * (1.0f + s); } else kind = 6 * Lr + 5;
                } else { if (ch == 0) kind = MK_B_KV; else { kind = MK_A_KV; val = F.in[13][j] * (1.0f + s); } }
                MODV[((size_t)kind * 4 + b) * D + j] = val; }
            __syncthreads();
        }
        __syncthreads();
    }
    {
        LAS float* scr = (LAS float*)(F.lds + F.wave * 8704);
        constexpr int I_MLAIN = (D / 64) * (LATN / 32), I_QUP = (QRANK / 64) * (QUP / 32), I_KVUP = (KVRANK / 64) * (KVUP / 32), I_OUT = (D / 64) * (D / 32), I_FGU = (D / 64) * (2 * DFF / 32),
                      I_FDN = (DFF / 64) * (D / 32), I_KVB = (D / 64) * (DILKV / 32), I_QB = (D / 64) * (DILQ / 32), I_OB = (DILOUT / 64) * (D / 32);
        constexpr int NSMALL = I_MLAIN + I_QUP + I_KVUP + I_OUT + I_FGU + I_FDN + I_KVB + I_QB + I_OB;
        constexpr int NITEMS = NSMALL + NEXP * (I_FGU + I_FDN);
        bf16* const ws16 = (bf16*)F.ws;
        for (int it = gw; it < NITEMS; it += NGW) {
            int r = it;
            if (r >= NSMALL) { r -= NSMALL;
                if (r < NEXP * I_FGU) { const int e = r / I_FGU; transpose_item<MAP_GU>(F.in[23] + (size_t)e * D * 2 * DFF, D, 2 * DFF, (bf16*)(F.ws + WS_WEGU) + (size_t)e * 2 * DFF * D, nullptr, scr, r % I_FGU, F.lane); continue; }
                r -= NEXP * I_FGU; { const int e = r / I_FDN; transpose_item<MAP_PLAIN>(F.in[24] + (size_t)e * DFF * D, DFF, D, (bf16*)(F.ws + WS_WEDN) + (size_t)e * D * DFF, nullptr, scr, r % I_FDN, F.lane); continue; } }
            if (r < I_MLAIN) { transpose_item<MAP_MLAIN>(F.in[7], D, LATN, (bf16*)(F.ws + WS_WMLAIN), nullptr, scr, r, F.lane); continue; } r -= I_MLAIN;
            if (r < I_QUP) { transpose_item<MAP_QUP>(F.in[9], QRANK, QUP, (bf16*)(F.ws + WS_WQUP), F.in[8], scr, r, F.lane); continue; } r -= I_QUP;
            if (r < I_KVUP) { transpose_item<MAP_PLAIN>(F.in[11], KVRANK, KVUP, (bf16*)(F.ws + WS_WKVUP), F.in[10], scr, r, F.lane); continue; } r -= I_KVUP;
            if (r < I_OUT) { transpose_item<MAP_PLAIN>(F.in[12], D, D, (bf16*)(F.ws + WS_WOUT), nullptr, scr, r, F.lane); continue; } r -= I_OUT;
            if (r < I_FGU) { transpose_item<MAP_GU>(F.in[20], D, 2 * DFF, (bf16*)(F.ws + WS_WFGU), nullptr, scr, r, F.lane); continue; } r -= I_FGU;
            if (r < I_FDN) { transpose_item<MAP_PLAIN>(F.in[21], DFF, D, (bf16*)(F.ws + WS_WFDN), nullptr, scr, r, F.lane); continue; } r -= I_FDN;
            if (r < I_KVB) { transpose_item<MAP_PLAIN>(F.in[16], D, DILKV, (bf16*)(F.ws + WS_WKVB), nullptr, scr, r, F.lane); continue; } r -= I_KVB;
            if (r < I_QB) { transpose_item<MAP_PLAIN>(F.in[18], D, DILQ, (bf16*)(F.ws + WS_WQB), nullptr, scr, r, F.lane); continue; } r -= I_QB;
            transpose_item<MAP_PLAIN>(F.in[19], DILOUT, D, (bf16*)(F.ws + WS_WOB), nullptr, scr, r, F.lane);
        }
        (void)ws16;
    }
    {
        v4u* padz = (v4u*)(F.ws + WS_WMLAIN + (size_t)LATN * D * 2);
        for (int i = gtid; i < (LATP - LATN) * D * 2 / 16; i += NGT) padz[i] = (v4u){0u, 0u, 0u, 0u};
        const int* pos = (const int*)F.in[2];
        float* cs = (float*)(F.ws + WS_CS);
        for (int i = gtid; i < M * 16; i += NGT) { const int row = i >> 4, k = i & 15;
            const double x = (double)pos[row] * INVF_D[k]; const double rev = x * 0.15915494309189535; const float fr = (float)(rev - __builtin_rint(rev));
            cs[(size_t)i * 2] = __builtin_amdgcn_cosf(fr); cs[(size_t)i * 2 + 1] = __builtin_amdgcn_sinf(fr); }
        const float* rpb = F.in[17];
        float* bt = (float*)(F.ws + WS_BIAS);
        for (int i = gtid; i < 24 * 129; i += NGT) { const int gh = i / 129, j = i % 129, g = gh >> 3; const int d = j * (g == 0 ? 1 : (g == 1 ? 4 : 16));
            int bk; if (d < 16) bk = d; else { bk = 16;
#pragma unroll
                for (int q = 0; q < 15; ++q) bk += (d >= RPB_TH[q]) ? 1 : 0; }
            bt[gh * 132 + j] = rpb[bk * 24 + gh] * LOG2E_F; }
    }
}

template <bool DUAL>
__device__ __forceinline__ void norm_phase(Frame& F, const float* H, const float* A0, const float* B0, bf16* O0, const float* A1, const float* B1, bf16* O1) {
    const int gw = F.vcu * NWAVES + F.wave, NGW = F.G * NWAVES;
    for (int c = gw; c < M / 16; c += NGW) {
        const int row0 = c * 16, b = row0 / SEQ;
        f32x4 a0[4], b0[4], a1[4], b1[4];
#pragma unroll
        for (int j = 0; j < 4; ++j) { a0[j] = *(const f32x4*)(A0 + b * D + 4 * F.lane + 256 * j); b0[j] = *(const f32x4*)(B0 + b * D + 4 * F.lane + 256 * j);
            if (DUAL) { a1[j] = *(const f32x4*)(A1 + b * D + 4 * F.lane + 256 * j); b1[j] = *(const f32x4*)(B1 + b * D + 4 * F.lane + 256 * j); } }
#pragma unroll 2
        for (int i = 0; i < 16; ++i) { const size_t row = (size_t)(row0 + i);
            const GAS f32x4* xr = (const GAS f32x4*)(H + row * D) + F.lane;
            f32x4 v[4]; float s = 0.f;
#pragma unroll
            for (int j = 0; j < 4; ++j) { v[j] = xr[64 * j]; s += (v[j].x * v[j].x + v[j].y * v[j].y) + (v[j].z * v[j].z + v[j].w * v[j].w); }
            const float rstd = 1.0f / sqrtf(wave_sum(s) * (1.f / D) + EPS);
            GAS v2u* o0 = (GAS v2u*)(O0 + row * D) + F.lane;
#pragma unroll
            for (int j = 0; j < 4; ++j) { const f32x4 y = v[j] * rstd * a0[j] + b0[j]; o0[64 * j] = (v2u){pk2(y.x, y.y), pk2(y.z, y.w)}; }
            if (DUAL) { GAS v2u* o1 = (GAS v2u*)(O1 + row * D) + F.lane;
#pragma unroll
                for (int j = 0; j < 4; ++j) { const f32x4 y = v[j] * rstd * a1[j] + b1[j]; o1[64 * j] = (v2u){pk2(y.x, y.y), pk2(y.z, y.w)}; } }
        }
    }
}

__device__ __forceinline__ void latnorm_phase(Frame& F) {
    const int gw = F.vcu * NWAVES + F.wave, NGW = F.G * NWAVES;
    const bf16* LAT = (const bf16*)(F.ws + A_LAT); bf16* QN = (bf16*)(F.ws + A_QN); bf16* KVN = (bf16*)(F.ws + A_KVN); bf16* KB = (bf16*)(F.ws + A_K);
    const float* cs = (const float*)(F.ws + WS_CS);
    for (int row = gw; row < M; row += NGW) {
        const unsigned* lr = (const unsigned*)(LAT + (size_t)row * LATP);
        unsigned q[3], kv[2];
#pragma unroll
        for (int j = 0; j < 3; ++j) q[j] = lr[F.lane + 64 * j];
#pragma unroll
        for (int j = 0; j < 2; ++j) kv[j] = lr[192 + F.lane + 64 * j];
        const unsigned kr = lr[320 + (F.lane & 15)];
        float sq = 0.f, sk = 0.f;
#pragma unroll
        for (int j = 0; j < 3; ++j) { const float a = bf_lo(q[j]), b = bf_hi(q[j]); sq += a * a + b * b; }
#pragma unroll
        for (int j = 0; j < 2; ++j) { const float a = bf_lo(kv[j]), b = bf_hi(kv[j]); sk += a * a + b * b; }
        const float rq = 1.0f / sqrtf(wave_sum(sq) * (1.f / QRANK) + EPS), rk = 1.0f / sqrtf(wave_sum(sk) * (1.f / KVRANK) + EPS);
        unsigned* qo = (unsigned*)(QN + (size_t)row * QRANK); unsigned* ko = (unsigned*)(KVN + (size_t)row * KVRANK);
#pragma unroll
        for (int j = 0; j < 3; ++j) qo[F.lane + 64 * j] = pk2(bf_lo(q[j]) * rq, bf_hi(q[j]) * rq);
#pragma unroll
        for (int j = 0; j < 2; ++j) ko[F.lane + 64 * j] = pk2(bf_lo(kv[j]) * rk, bf_hi(kv[j]) * rk);
        { const int i = F.lane & 15; const float c = cs[(size_t)row * 32 + 2 * i], s = cs[(size_t)row * 32 + 2 * i + 1]; const float x1 = bf_lo(kr), x2 = bf_hi(kr);
          const unsigned w = pk2(x1 * c - x2 * s, x1 * s + x2 * c);
          unsigned* kb = (unsigned*)(KB + (size_t)row * QUP);
#pragma unroll
          for (int hh = 0; hh < 4; ++hh) { const int h = (F.lane >> 4) * 4 + hh; kb[(h * 96 + 64) / 2 + i] = w; } }
    }
}

__device__ __forceinline__ void merge_phase(Frame& F) {
    const int gw = F.vcu * NWAVES + F.wave, NGW = F.G * NWAVES;
    const bf16* OG = (const bf16*)(F.ws + A_OG); const float* LSE = (const float*)(F.ws + WS_LSE); bf16* OD = (bf16*)(F.ws + A_OD);
    for (int row = gw; row < M; row += NGW) {
        const int h = F.lane >> 3;
        float l0 = LSE[((size_t)0 * M + row) * 8 + h], l1 = LSE[((size_t)1 * M + row) * 8 + h], l2 = LSE[((size_t)2 * M + row) * 8 + h];
        const float mx = fmaxf(l0, fmaxf(l1, l2)); float w0 = __builtin_amdgcn_exp2f(l0 - mx), w1 = __builtin_amdgcn_exp2f(l1 - mx), w2 = __builtin_amdgcn_exp2f(l2 - mx);
        const float inv = 1.0f / (w0 + w1 + w2); w0 *= inv; w1 *= inv; w2 *= inv;
        const v4u a = *(const v4u*)(OG + ((size_t)0 * M + row) * DILOUT + 8 * F.lane), b = *(const v4u*)(OG + ((size_t)1 * M + row) * DILOUT + 8 * F.lane), c = *(const v4u*)(OG + ((size_t)2 * M + row) * DILOUT + 8 * F.lane);
        v4u o;
#pragma unroll
        for (int k = 0; k < 4; ++k) o[k] = pk2(w0 * bf_lo(a[k]) + w1 * bf_lo(b[k]) + w2 * bf_lo(c[k]), w0 * bf_hi(a[k]) + w1 * bf_hi(b[k]) + w2 * bf_hi(c[k]));
        *(v4u*)(OD + (size_t)row * DILOUT + 8 * F.lane) = o;
    }
}

__device__ __forceinline__ void router_phase(Frame& F, const float* H, const float* A0, const float* B0, bf16* O0) {
    const int gw = F.vcu * NWAVES + F.wave, NGW = F.G * NWAVES;
    LAS float* wrt = (LAS float*)F.lds;
    { const float* wr = F.in[22]; for (int i = F.tid; i < 8192; i += NWAVES * 64) { const int col = i >> 3, e = i & 7; wrt[e * 1024 + col] = wr[i]; } }
    __syncthreads();
    v4u* ROUTE = (v4u*)(F.ws + WS_ROUTE); unsigned* CNT = (unsigned*)(F.ws + WS_CNT);
    for (int c = gw; c < M / 16; c += NGW) {
        const int row0 = c * 16, b = row0 / SEQ;
        f32x4 a0[4], b0[4];
#pragma unroll
        for (int j = 0; j < 4; ++j) { a0[j] = *(const f32x4*)(A0 + b * D + 4 * F.lane + 256 * j); b0[j] = *(const f32x4*)(B0 + b * D + 4 * F.lane + 256 * j); }
        unsigned cnt = 0u;
        for (int i = 0; i < 16; ++i) { const size_t row = (size_t)(row0 + i);
            const GAS f32x4* xr = (const GAS f32x4*)(H + row * D) + F.lane;
            f32x4 v[4]; float s = 0.f;
#pragma unroll
            for (int j = 0; j < 4; ++j) { v[j] = xr[64 * j]; s += (v[j].x * v[j].x + v[j].y * v[j].y) + (v[j].z * v[j].z + v[j].w * v[j].w); }
            const float rstd = 1.0f / sqrtf(wave_sum(s) * (1.f / D) + EPS);
            GAS v2u* o0 = (GAS v2u*)(O0 + row * D) + F.lane;
            float lg[8];
#pragma unroll
            for (int e = 0; e < 8; ++e) lg[e] = 0.f;
#pragma unroll
            for (int j = 0; j < 4; ++j) { const f32x4 y = v[j] * rstd * a0[j] + b0[j]; o0[64 * j] = (v2u){pk2(y.x, y.y), pk2(y.z, y.w)};
#pragma unroll
                for (int e = 0; e < 8; ++e) { const f32x4 w = *(const LAS f32x4*)(wrt + e * 1024 + 4 * F.lane + 256 * j); lg[e] += (y.x * w.x + y.y * w.y) + (y.z * w.z + y.w * w.w); } }
#pragma unroll
            for (int e = 0; e < 8; ++e) lg[e] = wave_sum(lg[e]);
            int e1 = 0; float v1 = lg[0];
#pragma unroll
            for (int e = 1; e < 8; ++e) if (lg[e] > v1) { v1 = lg[e]; e1 = e; }
            int e2 = -1; float v2 = -INFINITY;
#pragma unroll
            for (int e = 0; e < 8; ++e) if (e != e1 && lg[e] > v2) { v2 = lg[e]; e2 = e; }
            const float ex = expf(v2 - v1); const float g1 = 1.0f / (1.0f + ex), g2 = ex / (1.0f + ex);
            cnt += (F.lane == e1 ? 1u : 0u) + (F.lane == e2 ? 1u : 0u);
            if (F.lane == 0) ROUTE[row] = (v4u){(unsigned)e1 | ((unsigned)e2 << 8), __float_as_uint(g1), __float_as_uint(g2), 0u};
        }
        if (F.lane < 8) CNT[c * 8 + F.lane] = cnt;
    }
}

__device__ __forceinline__ void lists_phase(Frame& F) {
    const int gw = F.vcu * NWAVES + F.wave, NGW = F.G * NWAVES;
    const v4u* ROUTE = (const v4u*)(F.ws + WS_ROUTE); const unsigned* CNT = (const unsigned*)(F.ws + WS_CNT);
    int* LIST = (int*)(F.ws + WS_LIST); float* SLOTG = (float*)(F.ws + WS_SLOTG); int* TOKSLOT = (int*)(F.ws + WS_TOKSLOT); int* TILEEXP = (int*)(F.ws + WS_TILEEXP);
    for (int c = gw; c < M / 16; c += NGW) {
        unsigned lt[8], al[8];
#pragma unroll
        for (int e = 0; e < 8; ++e) { lt[e] = 0u; al[e] = 0u; }
        for (int cc = F.lane; cc < M / 16; cc += 64) { const v4u x = *(const v4u*)(CNT + cc * 8), y = *(const v4u*)(CNT + cc * 8 + 4); const bool bl = cc < c;
            al[0] += x.x; al[1] += x.y; al[2] += x.z; al[3] += x.w; al[4] += y.x; al[5] += y.y; al[6] += y.z; al[7] += y.w;
            if (bl) { lt[0] += x.x; lt[1] += x.y; lt[2] += x.z; lt[3] += x.w; lt[4] += y.x; lt[5] += y.y; lt[6] += y.z; lt[7] += y.w; } }
#pragma unroll
        for (int e = 0; e < 8; ++e) {
#pragma unroll
            for (int o = 1; o < 64; o <<= 1) { lt[e] += __shfl_xor(lt[e], o); al[e] += __shfl_xor(al[e], o); } }
        unsigned base[8]; unsigned run = 0u;
#pragma unroll
        for (int e = 0; e < 8; ++e) { base[e] = run; run += (al[e] + 255u) & ~255u; }
        const int row = c * 16 + (F.lane & 15);
        const v4u r = ROUTE[row]; const int e1 = (int)(r.x & 0xffu), e2 = (int)((r.x >> 8) & 0xffu);
        int s1 = 0, s2 = 0;
#pragma unroll
        for (int e = 0; e < 8; ++e) { const bool has = (F.lane < 16) && (e1 == e || e2 == e); const unsigned long long mk = __ballot(has);
            const int rank = __popcll(mk & ((1ull << F.lane) - 1ull)); const int sl = (int)(base[e] + lt[e]) + rank;
            if (e1 == e) s1 = sl; if (e2 == e) s2 = sl; }
        if (F.lane < 16) { LIST[s1] = row; LIST[s2] = row; SLOTG[s1] = __uint_as_float(r.y); SLOTG[s2] = __uint_as_float(r.z); TOKSLOT[row * 2] = s1; TOKSLOT[row * 2 + 1] = s2; }
        if (c == 0) {
#pragma unroll
            for (int e = 0; e < 8; ++e) { const unsigned pe = (al[e] + 255u) & ~255u;
                for (unsigned s = base[e] + al[e] + F.lane; s < base[e] + pe; s += 64) { LIST[s] = 0; SLOTG[s] = 0.f; }
                for (unsigned t = base[e] / 256u + F.lane; t < (base[e] + pe) / 256u; t += 64) TILEEXP[t] = e; }
            if (F.lane == 0) TILEEXP[300] = (int)(run / 256u);
        }
    }
}

__device__ __forceinline__ void final_phase(Frame& F, float* H, const float* gate, const float* gfin) {
    const int gw = F.vcu * NWAVES + F.wave, NGW = F.G * NWAVES;
    const bf16* Y = (const bf16*)(F.ws + A_Y); const int* TOKSLOT = (const int*)(F.ws + WS_TOKSLOT);
    for (int c = gw; c < M / 16; c += NGW) {
        const int row0 = c * 16, b = row0 / SEQ;
        f32x4 gt[4], gf[4];
#pragma unroll
        for (int j = 0; j < 4; ++j) { gt[j] = *(const f32x4*)(gate + b * D + 4 * F.lane + 256 * j); gf[j] = *(const f32x4*)(gfin + 4 * F.lane + 256 * j); }
#pragma unroll 2
        for (int i = 0; i < 16; ++i) { const size_t row = (size_t)(row0 + i);
            const int s1 = TOKSLOT[row * 2], s2 = TOKSLOT[row * 2 + 1];
            GAS f32x4* xr = (GAS f32x4*)(H + row * D) + F.lane;
            const GAS v2u* y1 = (const GAS v2u*)(Y + (size_t)s1 * D) + F.lane; const GAS v2u* y2 = (const GAS v2u*)(Y + (size_t)s2 * D) + F.lane;
            f32x4 v[4]; float s = 0.f;
#pragma unroll
            for (int j = 0; j < 4; ++j) { const f32x4 h = xr[64 * j]; const v2u p = y1[64 * j], q = y2[64 * j];
                f32x4 yy; yy.x = bf_lo(p.x) + bf_lo(q.x); yy.y = bf_hi(p.x) + bf_hi(q.x); yy.z = bf_lo(p.y) + bf_lo(q.y); yy.w = bf_hi(p.y) + bf_hi(q.y);
                v[j] = h + gt[j] * yy; s += (v[j].x * v[j].x + v[j].y * v[j].y) + (v[j].z * v[j].z + v[j].w * v[j].w); }
            const float rstd = 1.0f / sqrtf(wave_sum(s) * (1.f / D) + EPS);
#pragma unroll
            for (int j = 0; j < 4; ++j) xr[64 * j] = v[j] * rstd * gf[j];
        }
    }
}
#ifndef MK_ONE_LAUNCH
#define MK_ONE_LAUNCH 1
#endif
constexpr int N_PHASES = 20;
struct Args { const float* in[26]; float* out; unsigned char* ws; int ph_lo, ph_hi; };
static_assert(sizeof(Args) == 26 * 8 + 8 + 8 + 8, "Args has no padding");

__global__ void __launch_bounds__(NWAVES * 64, 2) mk_fwd(Args args) {
    extern __shared__ __attribute__((aligned(16))) unsigned char lds[];
    Frame F;
    F.lds = (LAS unsigned char*)lds;
    F.MISC = (volatile LAS unsigned*)(F.lds + MISC_OFF);
    F.tid = threadIdx.x; F.lane = F.tid & 63; F.wave = __builtin_amdgcn_readfirstlane(F.tid >> 6);
    F.G = gridDim.x; { const int bx = blockIdx.x; F.vcu = (F.G % 8 == 0) ? (bx % 8) * (F.G / 8) + bx / 8 : bx; }
    F.ws = args.ws; F.out = args.out;
#pragma unroll
    for (int i = 0; i < 26; ++i) F.in[i] = args.in[i];
    unsigned char* const ws = args.ws;
    for (int u = F.tid; u < (LDS_BYTES - LDSCTL_OFF) / 4; u += NWAVES * 64) ((LAS unsigned*)(F.lds + LDSCTL_OFF))[u] = 0u;
    __syncthreads();
    const int lo = args.ph_lo, hi = args.ph_hi;
    XcdBarrier bar; bar.bar = (unsigned*)(ws + WS_CTL) + CW_BAR; bar.x = 0; bar.st = nullptr;
    if (hi - lo > 1) bar = xcd_barrier_post((unsigned*)(ws + WS_CTL) + CW_BAR, F.MISC + 8);
#ifndef PHASE_MASK
#define PHASE_MASK 0xFFFFFu
#endif
#define IN(k) (((PHASE_MASK >> (k)) & 1u) && lo <= (k) && (k) < hi)
#define SEAM(k) do { if (IN(k) && IN((k) + 1)) xcd_barrier(bar); } while (0)
    const float* MODV = (const float*)(ws + WS_MODV);
#define MV(kind) (MODV + (size_t)(kind) * 4 * D)
    float* const H = args.out;
    bf16* const XN = (bf16*)(ws + A_XN);
    const pg8::MoeInfo mi0{nullptr, nullptr, 0};

    if (IN(0)) { p0_prologue(F); } SEAM(0);
    if (IN(1)) { norm_phase<false>(F, F.in[0], MV(MK_A_MIX0), MV(MK_B_MIX0), XN, nullptr, nullptr, nullptr); } SEAM(1);
    if (IN(2)) { pg8::Gemm g{XN, (const bf16*)(ws + WS_WMLAIN), M, LATP, D}; pg8::StaticOrder S; S.init(M, LATP, F.G, (int)blockIdx.x);
        pg8::EpiBf16 E{(bf16*)(ws + A_LAT), LATP, 1.0f};
        pg8::gemm_phase<pg8::EpiBf16, pg8::StaticOrder, true, true, 0>(F.lds, g, S, E, mi0); } SEAM(2);
    if (IN(3)) { latnorm_phase(F); } SEAM(3);
    if (IN(4)) {
#ifndef P4_SKIP_Q
        { pg8::Gemm g{(const bf16*)(ws + A_QN), (const bf16*)(ws + WS_WQUP), M, QUP, QRANK}; pg8::StaticOrder S; S.init(M, QUP, F.G, (int)blockIdx.x);
          pg8::EpiQ E{(bf16*)(ws + A_Q), QUP, C2_MLA, (const float*)(ws + WS_CS)};
          pg8::gemm_phase<pg8::EpiQ, pg8::StaticOrder, true, true, 0>(F.lds, g, S, E, mi0); }
#endif
#ifndef P4_SKIP_KV
        { pg8::Gemm g{(const bf16*)(ws + A_KVN), (const bf16*)(ws + WS_WKVUP), M, KVUP, KVRANK}; pg8::StaticOrder S; S.init(M, KVUP, F.G, (int)blockIdx.x);
          pg8::EpiKV E{(bf16*)(ws + A_K), (bf16*)(ws + A_V)};
          pg8::gemm_phase<pg8::EpiKV, pg8::StaticOrder, true, true, 0>(F.lds, g, S, E, mi0); }
#endif
    } SEAM(4);
    if (IN(5)) {
        const bf16* Qp = (const bf16*)(ws + A_Q); const bf16* Kp = (const bf16*)(ws + A_K); const bf16* Vp = (const bf16*)(ws + A_V); bf16* Op = (bf16*)(ws + A_O);
        if (F.G == 256) {
            for (int i = 0; i < 8; ++i) { const int bh = (F.vcu >> 3) + 32 * (i >> 2), s = F.vcu & 7, k = i & 3; const int qb = (k == 0) ? s : (k == 1) ? 15 - s : (k == 2) ? 16 + s : 31 - s;
                const int b = bh >> 4, h = bh & 15;
                att::attn_unit<96, false>(Qp + h * 96, QUP, Kp + h * 96, QUP, Vp + h * 64, D, Op + h * 64, D, nullptr, nullptr, (long)b * SEQ, 1, qb * 256, (char*)lds); }
        } else {
            for (int u = (int)blockIdx.x; u < BATCH * MLA_H * 32; u += F.G) { const int bh = u >> 5, qb = 31 - (u & 31); const int b = bh >> 4, h = bh & 15;
                att::attn_unit<96, false>(Qp + h * 96, QUP, Kp + h * 96, QUP, Vp + h * 64, D, Op + h * 64, D, nullptr, nullptr, (long)b * SEQ, 1, qb * 256, (char*)lds); }
        }
    } SEAM(5);
    if (IN(6)) { pg8::Gemm g{(const bf16*)(ws + A_O), (const bf16*)(ws + WS_WOUT), M, D, D}; pg8::StaticOrder S; S.init(M, D, F.G, (int)blockIdx.x);
        pg8::EpiResid E{F.in[0], H, MV(MK_G_MIX0)};
        pg8::gemm_phase<pg8::EpiResid, pg8::StaticOrder, true, true, 0>(F.lds, g, S, E, mi0); } SEAM(6);
    if (IN(7)) { norm_phase<false>(F, H, MV(MK_A_FFN0), MV(MK_B_FFN0), XN, nullptr, nullptr, nullptr); } SEAM(7);
    if (IN(8)) { pg8::Gemm g{XN, (const bf16*)(ws + WS_WFGU), M, 2 * DFF, D}; pg8::StaticOrder S; S.init(M, 2 * DFF, F.G, (int)blockIdx.x);
        pg8::EpiSwiGLU E{(bf16*)(ws + A_HID), DFF};
        pg8::gemm_phase<pg8::EpiSwiGLU, pg8::StaticOrder, true, true, 0>(F.lds, g, S, E, mi0); } SEAM(8);
    if (IN(9)) { pg8::Gemm g{(const bf16*)(ws + A_HID), (const bf16*)(ws + WS_WFDN), M, D, DFF}; pg8::StaticOrder S; S.init(M, D, F.G, (int)blockIdx.x);
        pg8::EpiResid E{H, H, MV(MK_G_FFN0)};
        pg8::gemm_phase<pg8::EpiResid, pg8::StaticOrder, true, true, 0>(F.lds, g, S, E, mi0); } SEAM(9);
    if (IN(10)) { norm_phase<true>(F, H, MV(MK_A_MIX1), MV(MK_B_MIX1), XN, MV(MK_A_KV), MV(MK_B_KV), (bf16*)(ws + A_XNKV)); } SEAM(10);
    if (IN(11)) {
        { pg8::Gemm g{(const bf16*)(ws + A_XNKV), (const bf16*)(ws + WS_WKVB), M, DILKV, D}; pg8::StaticOrder S; S.init(M, DILKV, F.G, (int)blockIdx.x);
          pg8::EpiBf16 E{(bf16*)(ws + A_KVB), DILKV, 1.0f};
          pg8::gemm_phase<pg8::EpiBf16, pg8::StaticOrder, true, true, 0>(F.lds, g, S, E, mi0); }
        { pg8::Gemm g{XN, (const bf16*)(ws + WS_WQB), M, DILQ, D}; pg8::StaticOrder S; S.init(M, DILQ, F.G, (int)blockIdx.x);
          pg8::EpiBf16 E{(bf16*)(ws + A_QB), DILQ, C2_DIL};
          pg8::gemm_phase<pg8::EpiBf16, pg8::StaticOrder, true, true, 0>(F.lds, g, S, E, mi0); }
    } SEAM(11);
    if (IN(12)) {
        const bf16* Qp = (const bf16*)(ws + A_QB); const bf16* KV = (const bf16*)(ws + A_KVB); bf16* OG = (bf16*)(ws + A_OG); float* LSE = (float*)(ws + WS_LSE); const float* BT = (const float*)(ws + WS_BIAS);
        for (int u = (int)blockIdx.x; u < BATCH * 3 * 32 * 8; u += F.G) { const int h = u & 7, x = (u >> 3) & 31, bg = u >> 8; const int g = bg % 3, b = bg / 3;
            const int dil = (g == 0) ? 1 : (g == 1) ? 4 : 16; const int r = x % dil, qb = x / dil;
            att::attn_unit<64, true>(Qp + g * 512 + h * 64, DILQ, KV + g * 1024 + h * 64, DILKV, KV + g * 1024 + 512 + h * 64, DILKV, OG + (size_t)g * M * DILOUT + h * 64, DILOUT,
                                     LSE + (size_t)g * M * 8 + h, BT + (g * 8 + h) * 132, (long)b * SEQ + r, dil, qb * 256, (char*)lds); }
    } SEAM(12);
    if (IN(13)) { merge_phase(F); } SEAM(13);
    if (IN(14)) { pg8::Gemm g{(const bf16*)(ws + A_OD), (const bf16*)(ws + WS_WOB), M, D, DILOUT}; pg8::StaticOrder S; S.init(M, D, F.G, (int)blockIdx.x);
        pg8::EpiResid E{H, H, MV(MK_G_MIX1)};
        pg8::gemm_phase<pg8::EpiResid, pg8::StaticOrder, true, true, 0>(F.lds, g, S, E, mi0); } SEAM(14);
    if (IN(15)) { router_phase(F, H, MV(MK_A_FFN1), MV(MK_B_FFN1), XN); } SEAM(15);
    if (IN(16)) { lists_phase(F); } SEAM(16);
    if (IN(17)) { const int ntile = ((const int*)(ws + WS_TILEEXP))[300];
        pg8::Gemm g{XN, (const bf16*)(ws + WS_WEGU), ntile * 256, 2 * DFF, D}; pg8::StaticOrder S; S.init(ntile * 256, 2 * DFF, F.G, (int)blockIdx.x);
        pg8::EpiSwiGLU E{(bf16*)(ws + A_HIDS), DFF};
        const pg8::MoeInfo mi{(const int*)(ws + WS_LIST), (const int*)(ws + WS_TILEEXP), (size_t)2 * DFF * D * 2};
        pg8::gemm_phase<pg8::EpiSwiGLU, pg8::StaticOrder, true, true, 1>(F.lds, g, S, E, mi); } SEAM(17);
    if (IN(18)) { const int ntile = ((const int*)(ws + WS_TILEEXP))[300];
        pg8::Gemm g{(const bf16*)(ws + A_HIDS), (const bf16*)(ws + WS_WEDN), ntile * 256, D, DFF}; pg8::StaticOrder S; S.init(ntile * 256, D, F.G, (int)blockIdx.x);
        pg8::EpiMoeDown E{(bf16*)(ws + A_Y), (const float*)(ws + WS_SLOTG)};
        const pg8::MoeInfo mi{(const int*)(ws + WS_LIST), (const int*)(ws + WS_TILEEXP), (size_t)D * DFF * 2};
        pg8::gemm_phase<pg8::EpiMoeDown, pg8::StaticOrder, true, true, 2>(F.lds, g, S, E, mi); } SEAM(18);
    if (IN(19)) { final_phase(F, H, MV(MK_G_FFN1), F.in[25]); }
#undef IN
#undef SEAM
#undef MV
}

extern "C" void kernel_launch(void* const* d_in, const int* in_sizes, int n_in, void* d_out, int out_size, void* d_ws, size_t ws_size, hipStream_t stream) {
    static int grid = 0;
    if (grid == 0) {
        if (n_in != 26 || in_sizes[0] != M * D || out_size != M * D || ws_size < WS_END) { fprintf(stderr, "kernel_launch: unexpected shapes (n_in %d, in0 %d, out %d, ws %zu, need %zu); nothing launched\n", n_in, n_in > 0 ? in_sizes[0] : -1, out_size, ws_size, (size_t)WS_END); grid = -1; return; }
        int dev = 0, cus = 0, per_cu = 0;
        if (hipGetDevice(&dev) != hipSuccess || hipDeviceGetAttribute(&cus, hipDeviceAttributeMultiprocessorCount, dev) != hipSuccess) { grid = -1; return; }
        if (hipFuncSetAttribute((const void*)mk_fwd, hipFuncAttributeMaxDynamicSharedMemorySize, LDS_BYTES) != hipSuccess) { fprintf(stderr, "kernel_launch: hipFuncSetAttribute failed\n"); grid = -1; return; }
        if (hipOccupancyMaxActiveBlocksPerMultiprocessor(&per_cu, (const void*)mk_fwd, NWAVES * 64, LDS_BYTES) != hipSuccess || per_cu < 1) { fprintf(stderr, "kernel_launch: occupancy query reports %d\n", per_cu); }
        (void)hipGetLastError();
        grid = cus;
    }
    if (grid < 0) return;
    if (hipMemsetAsync((char*)d_ws + WS_CTL, 0, CTL_ZERO_BYTES, stream) != hipSuccess) return;
    Args a{};
    for (int i = 0; i < 26; ++i) a.in[i] = (const float*)d_in[i];
    a.out = (float*)d_out; a.ws = (unsigned char*)d_ws;
#if MK_ONE_LAUNCH
    a.ph_lo = 0; a.ph_hi = N_PHASES;
    hipLaunchKernelGGL(mk_fwd, dim3(grid), dim3(NWAVES * 64), LDS_BYTES, stream, a);
#else
    for (int p = 0; p < N_PHASES; ++p) { a.ph_lo = p; a.ph_hi = p + 1; hipLaunchKernelGGL(mk_fwd, dim3(grid), dim3(NWAVES * 64), LDS_BYTES, stream, a); }
#endif
}
```

```cpp
#include <hip/hip_runtime.h>
#include <hip/hip_bf16.h>
#include <cstdio>
#include <cstdint>
#include <cmath>
#ifndef MK_ONE_LAUNCH
#define MK_ONE_LAUNCH 1
#endif
namespace pg8 {
#define PG8_LAS __attribute__((address_space(3)))
typedef unsigned short bf16_t;
typedef short bf16x8 __attribute__((ext_vector_type(8)));
typedef float f32x4 __attribute__((ext_vector_type(4)));
typedef float f32x2 __attribute__((ext_vector_type(2)));
typedef unsigned u32x4 __attribute__((ext_vector_type(4)));
constexpr int BM = 256, BK = 64, HALF = 128, HTB = HALF * BK * 2  , STAGE_BYTES = 8 * HTB, NXCD = 8, WGM = 8;

__host__ __device__ __forceinline__ int lds_byte(int r, int c) { const int st = (r >> 4) * 2 + (c >> 5), rr = r & 15, cc = c & 31, ob = rr * 64 + cc * 2; return st * 1024 + (ob ^ (((ob >> 9) & 1) << 5)); }
__host__ __device__ __forceinline__ void stage_rc(int b, int& R, int& C) { const int st = b / 1024, sb = b % 1024, swz = sb ^ (((sb >> 9) & 1) << 5); R = (st >> 1) * 16 + swz / 64; C = (st & 1) * 32 + (swz % 64) / 2; }
__host__ __device__ __forceinline__ int perm32(int rho) { const int n = rho >> 4, i = rho & 15; return 8 * (i >> 2) + 4 * n + (i & 3); }

struct Unit { int pm, pn; };
struct Gemm { const bf16_t* A; const bf16_t* Bt; int M, N, K; };
struct MoeInfo { const int* list; const int* tile_expert; size_t bstride; };

struct StaticOrder {
    int nM, nN, nwg, G, c;
    __host__ __device__ void init(int M, int N, int G_, int c_) { nM = M / BM; nN = N / BM; nwg = nM * nN; G = G_; c = c_; }
    __host__ __device__ bool next(int i, Unit& u) const {
        const long L = (long)i * G + c; if (L >= nwg) return false;
        int wgid = (int)L; { const int q = nwg / NXCD, r = nwg % NXCD, xcd = wgid % NXCD, off = wgid / NXCD; wgid = (xcd < r ? xcd * (q + 1) : r * (q + 1) + (xcd - r) * q) + off; }
        const int nig = WGM * nN, gid = wgid / nig, fm = gid * WGM, gsz = (nM - fm) < WGM ? (nM - fm) : WGM;
        u.pm = fm + ((wgid % nig) % gsz); u.pn = (wgid % nig) / gsz; return true;
    }
    __device__ __forceinline__ void a_ready(const Unit&) const {}
    __device__ __forceinline__ void done(const Unit&) const {}
};

__device__ __forceinline__ unsigned cvt_pk_bf16(float lo, float hi) { unsigned r; asm volatile("v_cvt_pk_bf16_f32 %0, %1, %2" : "=v"(r) : "v"(lo), "v"(hi)); return r; }


template <class Epi, class Sched, bool ALIGN_EPI, bool SP2, int MODE>
__device__ __forceinline__ void gemm_phase(PG8_LAS unsigned char* lds, const Gemm g, const Sched& S, const Epi& E, const MoeInfo mi) {
    const int tid = threadIdx.x, wid = __builtin_amdgcn_readfirstlane(tid >> 6), lane = tid & 63, wr = wid >> 2, wc = wid & 3, fr = lane & 15, fq = lane >> 4;
    int K_ = g.K; asm volatile("" : "+s"(K_));
    const int K = K_, nt = K / BK;
    unsigned voffB[2]; int Rr[2], Cc[2];
#pragma unroll
    for (int i = 0; i < 2; ++i) { int R, C; stage_rc(tid * 16 + i * 8192, R, C); const int Rb = Epi::PERM ? ((R & ~31) + perm32(R & 31)) : R;
        Rr[i] = R; Cc[i] = C; voffB[i] = (unsigned)(Rb * K + C) * 2u; }
    const size_t kstep = (size_t)(BK * 2);
    const size_t hstep = (size_t)HALF * K * 2;
    const size_t tstep = 2 * hstep;
    const unsigned ldsw = (unsigned)wid * 1024u;
    const int aoff = lds_byte(wr * 64 + fr, fq * 8), boff = lds_byte(wc * 32 + fr, fq * 8);
    const unsigned rowb = (unsigned)K * 2u;
#define PG8_SA(b, h) (((b) * 2 + (h)) * HTB)
#define PG8_SB(b, h) ((4 + (b) * 2 + (h)) * HTB)
#define PG8_STAGE(bufoff, gbase, voff) do { _Pragma("unroll") for (int _i = 0; _i < 2; ++_i) \
        __builtin_amdgcn_global_load_lds((const unsigned*)((const char*)(gbase) + (voff)[_i]), (PG8_LAS unsigned*)(lds + (bufoff) + ldsw + _i * 8192), 16, 0, 0); } while (0)
#define PG8_LDA(dst, b, h) do { _Pragma("unroll") for (int m = 0; m < 4; ++m) _Pragma("unroll") for (int k = 0; k < 2; ++k) dst[m][k] = *(const PG8_LAS bf16x8*)(lds + PG8_SA(b, h) + aoff + m * 2048 + k * 1024); } while (0)
#define PG8_LDB(dst, b, h) do { _Pragma("unroll") for (int n = 0; n < 2; ++n) _Pragma("unroll") for (int k = 0; k < 2; ++k) dst[n][k] = *(const PG8_LAS bf16x8*)(lds + PG8_SB(b, h) + boff + n * 2048 + k * 1024); } while (0)
#define PG8_MMA(ai, bj, At, Bt) do { __builtin_amdgcn_s_setprio(1); _Pragma("unroll") for (int m = 0; m < 4; ++m) _Pragma("unroll") for (int n = 0; n < 2; ++n) _Pragma("unroll") for (int k = 0; k < 2; ++k) \
        acc[ai][bj][m][n] = __builtin_amdgcn_mfma_f32_16x16x32_bf16(Bt[n][k], At[m][k], acc[ai][bj][m][n], 0, 0, 0); __builtin_amdgcn_s_setprio(0); } while (0)
#define PG8_WAIT_V(n) asm volatile("s_waitcnt vmcnt(" #n ")" ::: "memory")
#define PG8_WAIT_L(n) asm volatile("s_waitcnt lgkmcnt(" #n ")" ::: "memory")
#define PG8_BAR __builtin_amdgcn_s_barrier()
#define PG8_SCHED __builtin_amdgcn_sched_barrier(0)
#define PG8_MKOFF(u, o) do { _Pragma("unroll") for (int _h = 0; _h < 2; ++_h) _Pragma("unroll") for (int _i = 0; _i < 2; ++_i) { \
        int _row = (u).pm * BM + _h * HALF + Rr[_i]; if (MODE == 1) _row = mi.list[_row]; (o)[_h][_i] = (unsigned)_row * rowb + (unsigned)Cc[_i] * 2u; } } while (0)
#define PG8_BBASE(u) ((const char*)g.Bt + (size_t)(u).pn * tstep + (MODE != 0 ? (size_t)mi.tile_expert[(u).pm] * mi.bstride : (size_t)0))
    Unit cur, nxt; int ui = 0;
    if (!S.next(0, cur)) return;
    f32x4 acc[2][2][4][2];
#pragma unroll
    for (int a = 0; a < 2; ++a)
#pragma unroll
        for (int b = 0; b < 2; ++b)
#pragma unroll
            for (int m = 0; m < 4; ++m)
#pragma unroll
                for (int n = 0; n < 2; ++n) acc[a][b][m][n] = (f32x4){0.f, 0.f, 0.f, 0.f};
    bf16x8 At[4][2], B0[2][2], B1[2][2];
    unsigned oc[2][2], on[2][2];
    PG8_MKOFF(cur, oc);
    const char* const Ab = (const char*)g.A;
    const char* cB = PG8_BBASE(cur);
    S.a_ready(cur);
    static_assert(SP2, "only the SP2 loop is kept");
    {
        PG8_STAGE(PG8_SB(0, 0), cB, voffB); PG8_STAGE(PG8_SB(0, 1), cB + hstep, voffB); PG8_STAGE(PG8_SA(0, 0), Ab, oc[0]); PG8_STAGE(PG8_SA(0, 1), Ab, oc[1]);
        if (wr == 1) PG8_BAR;
        PG8_WAIT_V(2); PG8_BAR;
        PG8_STAGE(PG8_SB(1, 0), cB + kstep, voffB); PG8_STAGE(PG8_SA(1, 0), Ab + kstep, oc[0]); PG8_STAGE(PG8_SB(1, 1), cB + hstep + kstep, voffB);
        PG8_WAIT_V(6); PG8_BAR;
    }
    for (;;) {
        const bool has_next = S.next(ui + 1, nxt);
        const char* nB = cB;
        if (has_next) { PG8_MKOFF(nxt, on); nB = PG8_BBASE(nxt); }
        else {
#pragma unroll
            for (int _h = 0; _h < 2; ++_h)
#pragma unroll
                for (int _i = 0; _i < 2; ++_i) on[_h][_i] = oc[_h][_i];
        }
        for (int t = 0; t < nt; t += 2) {
            const bool last = (t == nt - 2);
            const char* a1 = Ab + (size_t)(t + 1) * kstep;
            const char* a2 = last ? Ab : Ab + (size_t)(t + 2) * kstep; const char* b2 = last ? nB : cB + (size_t)(t + 2) * kstep;
            const char* a3 = a2 + kstep; const char* b3 = b2 + kstep;
            unsigned o2[2][2];
#pragma unroll
            for (int _h = 0; _h < 2; ++_h)
#pragma unroll
                for (int _i = 0; _i < 2; ++_i) o2[_h][_i] = last ? on[_h][_i] : oc[_h][_i];
            if (last && has_next) S.a_ready(nxt);
            PG8_LDB(B0, 0, 0); PG8_LDB(B1, 0, 1); PG8_SCHED; PG8_LDA(At, 0, 0); PG8_STAGE(PG8_SA(1, 1), a1, oc[1]);
            PG8_WAIT_V(8); PG8_WAIT_L(0); PG8_BAR; PG8_MMA(0, 0, At, B0); PG8_MMA(0, 1, At, B1); PG8_BAR; PG8_SCHED;
            PG8_LDA(At, 0, 1); PG8_STAGE(PG8_SB(0, 0), b2, voffB); PG8_STAGE(PG8_SB(0, 1), b2 + hstep, voffB); PG8_STAGE(PG8_SA(0, 0), a2, o2[0]);
            PG8_WAIT_V(8); PG8_WAIT_L(0); PG8_BAR; PG8_MMA(1, 0, At, B0); PG8_MMA(1, 1, At, B1); PG8_BAR; PG8_SCHED;
            PG8_LDB(B0, 1, 0); PG8_LDB(B1, 1, 1); PG8_SCHED; PG8_LDA(At, 1, 0); PG8_STAGE(PG8_SA(0, 1), a2, o2[1]);
            PG8_WAIT_V(8); PG8_WAIT_L(0); PG8_BAR; PG8_MMA(0, 0, At, B0); PG8_MMA(0, 1, At, B1); PG8_BAR; PG8_SCHED;
            PG8_LDA(At, 1, 1); PG8_STAGE(PG8_SB(1, 0), b3, voffB); PG8_STAGE(PG8_SB(1, 1), b3 + hstep, voffB); PG8_STAGE(PG8_SA(1, 0), a3, o2[0]);
            PG8_WAIT_V(8); PG8_WAIT_L(0); PG8_BAR; PG8_MMA(1, 0, At, B0); PG8_MMA(1, 1, At, B1); PG8_BAR; PG8_SCHED;
        }
        if constexpr (ALIGN_EPI) { if (wr == 0) PG8_BAR; }
        E(acc, cur, wr, wc, fr, fq); S.done(cur);
        if (!has_next) break;
#pragma unroll
        for (int a = 0; a < 2; ++a)
#pragma unroll
            for (int b = 0; b < 2; ++b)
#pragma unroll
                for (int m = 0; m < 4; ++m)
#pragma unroll
                    for (int n = 0; n < 2; ++n) acc[a][b][m][n] = (f32x4){0.f, 0.f, 0.f, 0.f};
        cur = nxt; cB = nB; ++ui;
#pragma unroll
        for (int _h = 0; _h < 2; ++_h)
#pragma unroll
            for (int _i = 0; _i < 2; ++_i) oc[_h][_i] = on[_h][_i];
        if constexpr (ALIGN_EPI) { if (wr == 1) PG8_BAR; }
    }
    PG8_WAIT_V(0);
    if constexpr (!ALIGN_EPI) { if (wr == 0) PG8_BAR; }
    PG8_BAR;
#undef PG8_SA
#undef PG8_SB
#undef PG8_STAGE
#undef PG8_LDA
#undef PG8_LDB
#undef PG8_MMA
#undef PG8_WAIT_V
#undef PG8_WAIT_L
#undef PG8_BAR
#undef PG8_SCHED
#undef PG8_MKOFF
#undef PG8_BBASE
}
}
namespace pg8 {
constexpr float LOG2E = 1.4426950408889634f;
struct EpiBf16 {
    static constexpr bool PERM = true;
    bf16_t* O; int ldc; float scale;
    __device__ __forceinline__ void operator()(const f32x4 (&acc)[2][2][4][2], const Unit& u, int wr, int wc, int fr, int fq) const {
        const int row0 = u.pm * BM + wr * 64 + fr; const int col0 = u.pn * BM + wc * 32 + 8 * fq;
#pragma unroll
        for (int ai = 0; ai < 2; ++ai)
#pragma unroll
            for (int m = 0; m < 4; ++m) { bf16_t* rowp = O + (size_t)(row0 + ai * HALF + m * 16) * ldc + col0;
#pragma unroll
                for (int bj = 0; bj < 2; ++bj) { const f32x4 v0 = acc[ai][bj][m][0] * scale, v1 = acc[ai][bj][m][1] * scale;
                    u32x4 w; w.x = cvt_pk_bf16(v0[0], v0[1]); w.y = cvt_pk_bf16(v0[2], v0[3]); w.z = cvt_pk_bf16(v1[0], v1[1]); w.w = cvt_pk_bf16(v1[2], v1[3]);
                    *(u32x4*)(rowp + bj * HALF) = w; } }
    }
};
struct EpiQ {
    static constexpr bool PERM = true;
    bf16_t* O; int ldc; float scale; const float* cs;
    __device__ __forceinline__ void operator()(const f32x4 (&acc)[2][2][4][2], const Unit& u, int wr, int wc, int fr, int fq) const {
        const int row0 = u.pm * BM + wr * 64 + fr; const int col0 = u.pn * BM + wc * 32 + 8 * fq;
        const int grp = u.pn * 8 + wc;
#pragma unroll
        for (int bj = 0; bj < 2; ++bj) { const bool rope = ((grp + 4 * bj) % 3) == 2;
#pragma unroll
            for (int ai = 0; ai < 2; ++ai)
#pragma unroll
                for (int m = 0; m < 4; ++m) { const int row = row0 + ai * HALF + m * 16; bf16_t* rowp = O + (size_t)row * ldc + col0 + bj * HALF;
                    f32x4 v0 = acc[ai][bj][m][0] * scale, v1 = acc[ai][bj][m][1] * scale;
                    if (rope) { const f32x4* cp = (const f32x4*)(cs + (size_t)row * 32 + 8 * fq); const f32x4 c0 = cp[0], c1 = cp[1];
                        f32x4 r0, r1;
                        r0[0] = v0[0] * c0[0] - v0[1] * c0[1]; r0[1] = v0[0] * c0[1] + v0[1] * c0[0];
                        r0[2] = v0[2] * c0[2] - v0[3] * c0[3]; r0[3] = v0[2] * c0[3] + v0[3] * c0[2];
                        r1[0] = v1[0] * c1[0] - v1[1] * c1[1]; r1[1] = v1[0] * c1[1] + v1[1] * c1[0];
                        r1[2] = v1[2] * c1[2] - v1[3] * c1[3]; r1[3] = v1[2] * c1[3] + v1[3] * c1[2];
                        v0 = r0; v1 = r1; }
                    u32x4 w; w.x = cvt_pk_bf16(v0[0], v0[1]); w.y = cvt_pk_bf16(v0[2], v0[3]); w.z = cvt_pk_bf16(v1[0], v1[1]); w.w = cvt_pk_bf16(v1[2], v1[3]);
                    *(u32x4*)rowp = w;
                    if (m & 1) asm volatile("" ::: "memory"); } }
    }
};
struct EpiKV {
    static constexpr bool PERM = true;
    bf16_t* Kb; bf16_t* Vb;
    __device__ __forceinline__ void operator()(const f32x4 (&acc)[2][2][4][2], const Unit& u, int wr, int wc, int fr, int fq) const {
        const int row0 = u.pm * BM + wr * 64 + fr;
        const bool isk = wc < 2;
        bf16_t* const base = isk ? Kb : Vb; const int pitch = isk ? 1536 : 1024, hs = isk ? 96 : 64, j0 = (isk ? wc : wc - 2) * 32 + 8 * fq;
#pragma unroll
        for (int ai = 0; ai < 2; ++ai)
#pragma unroll
            for (int m = 0; m < 4; ++m) { bf16_t* rowp = base + (size_t)(row0 + ai * HALF + m * 16) * pitch + j0;
#pragma unroll
                for (int bj = 0; bj < 2; ++bj) { const f32x4 v0 = acc[ai][bj][m][0], v1 = acc[ai][bj][m][1];
                    u32x4 w; w.x = cvt_pk_bf16(v0[0], v0[1]); w.y = cvt_pk_bf16(v0[2], v0[3]); w.z = cvt_pk_bf16(v1[0], v1[1]); w.w = cvt_pk_bf16(v1[2], v1[3]);
                    *(u32x4*)(rowp + (2 * u.pn + bj) * hs) = w; } }
    }
};
struct EpiResid {
    static constexpr bool PERM = false;
    const float* base; float* out; const float* gate;
    __device__ __forceinline__ void operator()(const f32x4 (&acc)[2][2][4][2], const Unit& u, int wr, int wc, int fr, int fq) const {
        const int row0 = u.pm * BM + wr * 64 + fr; const int col0 = u.pn * BM + wc * 32 + 4 * fq;
        const float* gp = gate + (size_t)((u.pm * BM) >> 13) * 1024 + col0;
        f32x4 gv[2][2];
#pragma unroll
        for (int bj = 0; bj < 2; ++bj)
#pragma unroll
            for (int n = 0; n < 2; ++n) gv[bj][n] = *(const f32x4*)(gp + bj * HALF + n * 16);
#pragma unroll
        for (int ai = 0; ai < 2; ++ai)
#pragma unroll
            for (int m = 0; m < 4; ++m) { const size_t off = (size_t)(row0 + ai * HALF + m * 16) * 1024 + col0;
#pragma unroll
                for (int bj = 0; bj < 2; ++bj)
#pragma unroll
                    for (int n = 0; n < 2; ++n) { const f32x4 bs = *(const f32x4*)(base + off + bj * HALF + n * 16);
                        *(f32x4*)(out + off + bj * HALF + n * 16) = bs + gv[bj][n] * acc[ai][bj][m][n]; }
                if (m & 1) asm volatile("" ::: "memory"); }
    }
};
__device__ __forceinline__ float silu_mul(float g, float u) { return g * u * __builtin_amdgcn_rcpf(1.0f + __builtin_amdgcn_exp2f(-g * LOG2E)); }
struct EpiSwiGLU {
    static constexpr bool PERM = true;
    bf16_t* O; int ldc;
    __device__ __forceinline__ void operator()(const f32x4 (&acc)[2][2][4][2], const Unit& u, int wr, int wc, int fr, int fq) const {
        const int row0 = u.pm * BM + wr * 64 + fr; const int col0 = u.pn * HALF + wc * 32 + 8 * fq;
#pragma unroll
        for (int ai = 0; ai < 2; ++ai)
#pragma unroll
            for (int m = 0; m < 4; ++m) { bf16_t* rowp = O + (size_t)(row0 + ai * HALF + m * 16) * ldc + col0;
                const f32x4 g0 = acc[ai][0][m][0], g1 = acc[ai][0][m][1], u0 = acc[ai][1][m][0], u1 = acc[ai][1][m][1];
                u32x4 w; w.x = cvt_pk_bf16(silu_mul(g0[0], u0[0]), silu_mul(g0[1], u0[1])); w.y = cvt_pk_bf16(silu_mul(g0[2], u0[2]), silu_mul(g0[3], u0[3]));
                w.z = cvt_pk_bf16(silu_mul(g1[0], u1[0]), silu_mul(g1[1], u1[1])); w.w = cvt_pk_bf16(silu_mul(g1[2], u1[2]), silu_mul(g1[3], u1[3]));
                *(u32x4*)rowp = w; }
    }
};
struct EpiMoeDown {
    static constexpr bool PERM = true;
    bf16_t* O; const float* sg;
    __device__ __forceinline__ void operator()(const f32x4 (&acc)[2][2][4][2], const Unit& u, int wr, int wc, int fr, int fq) const {
        const int row0 = u.pm * BM + wr * 64 + fr; const int col0 = u.pn * BM + wc * 32 + 8 * fq;
#pragma unroll
        for (int ai = 0; ai < 2; ++ai)
#pragma unroll
            for (int m = 0; m < 4; ++m) { const int row = row0 + ai * HALF + m * 16; const float s = sg[row]; bf16_t* rowp = O + (size_t)row * 1024 + col0;
#pragma unroll
                for (int bj = 0; bj < 2; ++bj) { const f32x4 v0 = acc[ai][bj][m][0] * s, v1 = acc[ai][bj][m][1] * s;
                    u32x4 w; w.x = cvt_pk_bf16(v0[0], v0[1]); w.y = cvt_pk_bf16(v0[2], v0[3]); w.z = cvt_pk_bf16(v1[0], v1[1]); w.w = cvt_pk_bf16(v1[2], v1[3]);
                    *(u32x4*)(rowp + bj * HALF) = w; } }
    }
};
}
namespace att {
using bf16 = unsigned short;
using bf16x8 = __attribute__((ext_vector_type(8))) short;
using s16x4 = __attribute__((ext_vector_type(4))) short;
using f32x16 = __attribute__((ext_vector_type(16))) float;
using u32x4 = __attribute__((ext_vector_type(4))) unsigned;
constexpr int NW = 8;
constexpr float THR = 8.0f;
__device__ __forceinline__ int crow(int r, int hi) { return (r & 3) + 8 * (r >> 2) + 4 * hi; }
__device__ __forceinline__ void glds16(const void* gsrc, unsigned lds_dst) { unsigned keep;
    asm volatile("s_mov_b32 %0, m0\n\ts_mov_b32 m0, %2\n\ts_nop 0\n\tglobal_load_lds_dwordx4 %1, off\n\ts_mov_b32 m0, %0" : "=&s"(keep) : "v"(gsrc), "s"(lds_dst) : "memory"); }
typedef float f32x2_t __attribute__((ext_vector_type(2))); typedef __bf16 bf16x2_t __attribute__((ext_vector_type(2)));
__device__ __forceinline__ unsigned cvtpk_s(float lo, float hi) { f32x2_t v = {lo, hi}; bf16x2_t b = __builtin_convertvector(v, bf16x2_t); return __builtin_bit_cast(unsigned, b); }
#define ATT_SBAR() __builtin_amdgcn_sched_barrier(0)
#define ATT_WAIT_BAR(N) asm volatile("s_waitcnt vmcnt(" #N ") lgkmcnt(0)\n\ts_barrier" ::: "memory")

template <int DQK> struct Lay {
    static constexpr int NKC = DQK / 8, KSLOT = NKC * 1024, ND0 = DQK / 16;
    static constexpr int LK = 0, LV = 3 * KSLOT, LWS = LV + 3 * 8192, LOST = LWS + NW * 256, LBIAS = LOST + NW * 4096, LEND = LBIAS + 1024;
};
static_assert(Lay<96>::LEND <= 131072 && Lay<64>::LEND <= 131072, "attention LDS");

__device__ __forceinline__ float rowmax32(const f32x16& p0, const f32x16& p1) {
    float a = __builtin_fmaxf(__builtin_fmaxf(p0[0], p0[1]), p1[0]), b = __builtin_fmaxf(__builtin_fmaxf(p0[2], p0[3]), p1[1]); a = __builtin_fmaxf(__builtin_fmaxf(a, p1[2]), p1[3]);
#pragma unroll
    for (int r = 4; r < 16; r += 4) { a = __builtin_fmaxf(__builtin_fmaxf(a, p0[r]), p0[r + 1]); b = __builtin_fmaxf(__builtin_fmaxf(b, p0[r + 2]), p0[r + 3]); a = __builtin_fmaxf(__builtin_fmaxf(a, p1[r]), p1[r + 1]); b = __builtin_fmaxf(__builtin_fmaxf(b, p1[r + 2]), p1[r + 3]); }
    float m = __builtin_fmaxf(a, b);
    auto rr = __builtin_amdgcn_permlane32_swap(__float_as_uint(m), __float_as_uint(m), false, false);
    return __builtin_fmaxf(__uint_as_float(rr[0]), __uint_as_float(rr[1]));
}
__device__ __forceinline__ void pv(f32x16* o, int vb, bf16x8 pa0, bf16x8 pa1, bf16x8 pa2, bf16x8 pa3) {
#pragma unroll
    for (int d0 = 0; d0 < 2; ++d0) { s16x4 lo[4], hi[4];
#pragma unroll
        for (int ks = 0; ks < 4; ++ks) {
            asm volatile("ds_read_b64_tr_b16 %0,%1 offset:%c2" : "=&v"(lo[ks]) : "v"(vb), "i"(d0 * 4096 + ks * 1024) : "memory");
            asm volatile("ds_read_b64_tr_b16 %0,%1 offset:%c2" : "=&v"(hi[ks]) : "v"(vb), "i"(d0 * 4096 + ks * 1024 + 512) : "memory"); }
        asm volatile("s_waitcnt lgkmcnt(0)" ::: "memory"); ATT_SBAR();
#define ATT_PK(k) (bf16x8){lo[k][0], lo[k][1], lo[k][2], lo[k][3], hi[k][0], hi[k][1], hi[k][2], hi[k][3]}
        o[d0] = __builtin_amdgcn_mfma_f32_32x32x16_bf16(pa0, ATT_PK(0), o[d0], 0, 0, 0);
        o[d0] = __builtin_amdgcn_mfma_f32_32x32x16_bf16(pa1, ATT_PK(1), o[d0], 0, 0, 0);
        o[d0] = __builtin_amdgcn_mfma_f32_32x32x16_bf16(pa2, ATT_PK(2), o[d0], 0, 0, 0);
        o[d0] = __builtin_amdgcn_mfma_f32_32x32x16_bf16(pa3, ATT_PK(3), o[d0], 0, 0, 0);
#undef ATT_PK
    }
}

template <int DQK, bool DIL>
__device__ __forceinline__ void attn_unit(const bf16* Qb, int pq, const bf16* __restrict__ Kb, int pk, const bf16* __restrict__ Vb, int pvp, bf16* Ob, int po, float* lse, const float* biasg,
                                          long rowbase, int dil, int q0, char* shm) {
    typedef Lay<DQK> L;
    const int tid = threadIdx.x, lane = tid & 63, r32 = lane & 31, hi = lane >> 5; const int wid = __builtin_amdgcn_readfirstlane(tid >> 6);
    const unsigned lds0 = (unsigned)(uintptr_t)shm;
    float* wsf = (float*)(shm + L::LWS) + wid * 64;
    const int kpos0 = DIL ? q0 - 128 : 0;
    const int t_begin = DIL ? (q0 == 0 ? 2 : 0) : 0;
    const int t_end = DIL ? 6 : (q0 + 256) / 64;
    const int wt0 = DIL ? (wid >> 1) : 0;
    const int wt1 = DIL ? 2 + (wid >> 1) : (q0 + 32 * wid + 31) / 64;
    const bool two_k = (L::NKC > 8) && (wid + 8 < L::NKC);
#define ATT_GROW(pos) (rowbase + (long)(pos) * dil)
#define ATT_ISSUE(t, s) do { const int kp_ = kpos0 + 64 * (t); \
        glds16(Kb + ATT_GROW(kp_ + lane) * pk + wid * 8, (unsigned)__builtin_amdgcn_readfirstlane(lds0 + L::LK + (s) * L::KSLOT + wid * 1024)); \
        if (two_k) glds16(Kb + ATT_GROW(kp_ + lane) * pk + (wid + 8) * 8, (unsigned)__builtin_amdgcn_readfirstlane(lds0 + L::LK + (s) * L::KSLOT + (wid + 8) * 1024)); \
        glds16(Vb + ATT_GROW(kp_ + 16 * (wid & 3) + (lane >> 2)) * pvp + (wid >> 2) * 32 + (lane & 3) * 8, (unsigned)__builtin_amdgcn_readfirstlane(lds0 + L::LV + (s) * 8192 + wid * 1024)); } while (0)
    if (DIL) { if (tid < 129) ((float*)(shm + L::LBIAS))[tid] = biasg[tid]; }
    ATT_ISSUE(t_begin, 0);
    if (t_begin + 1 < t_end) ATT_ISSUE(t_begin + 1, 1);
    bf16x8 qr[L::ND0];
    { const bf16* Qw = Qb + ATT_GROW(q0 + wid * 32 + r32) * pq + hi * 8;
#pragma unroll
      for (int d0 = 0; d0 < L::ND0; ++d0) qr[d0] = *reinterpret_cast<const bf16x8*>(Qw + d0 * 16); }
    float mhat = 0.f, l_reg = 0.f; f32x16 o[2]; o[0] = f32x16{}; o[1] = f32x16{}; f32x16 negm = f32x16{};
    bool first = true;
    const int qrel = (DIL ? 128 : q0) + wid * 32 + r32;
    const int vbl = (int)(lds0 + L::LV) + ((lane >> 4) & 1) * 32 + (lane & 3) * 8 + (4 * hi + ((lane & 15) >> 2)) * 64;
    int slot = 0;
    for (int t = t_begin; t < t_end; ++t) {
        if (t + 1 < t_end) { if (two_k) ATT_WAIT_BAR(3); else ATT_WAIT_BAR(2); } else ATT_WAIT_BAR(0);
        if (t + 2 < t_end) { const int s2 = slot >= 1 ? slot - 1 : 2; ATT_ISSUE(t + 2, s2); }
        if (t >= wt0 && t <= wt1) {
            f32x16 p0, p1;
            { const char* kb = shm + L::LK + slot * L::KSLOT + hi * 1024 + r32 * 16;
#pragma unroll
              for (int d0 = 0; d0 < L::ND0; ++d0) {
                const bf16x8 b0 = *reinterpret_cast<const bf16x8*>(kb + d0 * 2048);
                const bf16x8 b1 = *reinterpret_cast<const bf16x8*>(kb + d0 * 2048 + 512);
                if (d0 == 0) { p0 = __builtin_amdgcn_mfma_f32_32x32x16_bf16(b0, qr[0], negm, 0, 0, 0); p1 = __builtin_amdgcn_mfma_f32_32x32x16_bf16(b1, qr[0], negm, 0, 0, 0); }
                else { p0 = __builtin_amdgcn_mfma_f32_32x32x16_bf16(b0, qr[d0], p0, 0, 0, 0); p1 = __builtin_amdgcn_mfma_f32_32x32x16_bf16(b1, qr[d0], p1, 0, 0, 0); } } }
            if (DIL) { const float* bl = (const float*)(shm + L::LBIAS); const int jb = qrel - 64 * t - 4 * hi;
#pragma unroll
                for (int r = 0; r < 16; ++r) { const int j0 = jb - ((r & 3) + 8 * (r >> 2)), j1 = j0 - 32;
                    const int c0 = j0 < 0 ? 0 : (j0 > 128 ? 128 : j0), c1 = j1 < 0 ? 0 : (j1 > 128 ? 128 : j1);
                    const float b0 = bl[c0], b1 = bl[c1];
                    p0[r] = (j0 >= 0 && j0 <= 128) ? p0[r] + b0 : -INFINITY; p1[r] = (j1 >= 0 && j1 <= 128) ? p1[r] + b1 : -INFINITY; }
            } else if (64 * t + 63 > q0 + 32 * wid) { const int jb = qrel - 64 * t - 4 * hi;
#pragma unroll
                for (int r = 0; r < 16; ++r) { const int j0 = jb - ((r & 3) + 8 * (r >> 2)); if (j0 < 0) p0[r] = -INFINITY; if (j0 - 32 < 0) p1[r] = -INFINITY; } }
            const float rm = rowmax32(p0, p1);
            if (first) { first = false; const float dl = rm; mhat += dl;
#pragma unroll
                for (int r = 0; r < 16; ++r) { p0[r] -= dl; p1[r] -= dl; }
#pragma unroll
                for (int r = 0; r < 16; ++r) negm[r] = -mhat;
            } else if (__any(rm > THR)) { const float dl = __builtin_fmaxf(rm, 0.f); mhat += dl;
#pragma unroll
                for (int r = 0; r < 16; ++r) { p0[r] -= dl; p1[r] -= dl; }
#pragma unroll
                for (int r = 0; r < 16; ++r) negm[r] = -mhat;
                const float f = __builtin_amdgcn_exp2f(-dl); l_reg *= f; if (hi == 0) wsf[r32] = f;
                asm volatile("s_waitcnt lgkmcnt(0)" ::: "memory");
#pragma unroll
                for (int d_ = 0; d_ < 2; ++d_)
#pragma unroll
                    for (int r = 0; r < 16; ++r) o[d_][r] *= wsf[crow(r, hi)];
                asm volatile("s_waitcnt lgkmcnt(0)" ::: "memory");
            }
            float sacc = 0.f;
#pragma unroll
            for (int r = 0; r < 16; ++r) { p0[r] = __builtin_amdgcn_exp2f(p0[r]); p1[r] = __builtin_amdgcn_exp2f(p1[r]); sacc += p0[r] + p1[r]; }
            l_reg += sacc;
            u32x4 pw0, pw1, pw2, pw3;
#define ATT_PKW(P, B) cvtpk_s(P[B], P[B + 1])
            pw0 = (u32x4){ATT_PKW(p0, 0), ATT_PKW(p0, 2), ATT_PKW(p0, 4), ATT_PKW(p0, 6)}; pw1 = (u32x4){ATT_PKW(p0, 8), ATT_PKW(p0, 10), ATT_PKW(p0, 12), ATT_PKW(p0, 14)};
            pw2 = (u32x4){ATT_PKW(p1, 0), ATT_PKW(p1, 2), ATT_PKW(p1, 4), ATT_PKW(p1, 6)}; pw3 = (u32x4){ATT_PKW(p1, 8), ATT_PKW(p1, 10), ATT_PKW(p1, 12), ATT_PKW(p1, 14)};
#undef ATT_PKW
            ATT_SBAR();
            pv(o, vbl + slot * 8192, __builtin_bit_cast(bf16x8, pw0), __builtin_bit_cast(bf16x8, pw1), __builtin_bit_cast(bf16x8, pw2), __builtin_bit_cast(bf16x8, pw3));
        }
        slot = slot == 2 ? 0 : slot + 1;
    }
    { auto rr = __builtin_amdgcn_permlane32_swap(__float_as_uint(l_reg), __float_as_uint(l_reg), false, false); l_reg = __uint_as_float(rr[0]) + __uint_as_float(rr[1]); }
    if (hi == 0) wsf[32 + r32] = l_reg;
    asm volatile("s_waitcnt lgkmcnt(0)" ::: "memory");
    float rli[16];
#pragma unroll
    for (int r = 0; r < 16; ++r) rli[r] = __builtin_amdgcn_rcpf(wsf[32 + crow(r, hi)]);
    if (DIL) { if (hi == 0) lse[ATT_GROW(q0 + wid * 32 + r32) * 8] = mhat + __builtin_amdgcn_logf(l_reg); }
    { bf16* stg = (bf16*)(shm + L::LOST) + wid * 2048;
#pragma unroll
      for (int r = 0; r < 16; ++r) { const int orow = crow(r, hi);
#pragma unroll
        for (int d0 = 0; d0 < 2; ++d0) stg[orow * 64 + d0 * 32 + r32] = (bf16)(cvtpk_s(o[d0][r] * rli[r], 0.f) & 0xffffu); }
      asm volatile("s_waitcnt lgkmcnt(0)" ::: "memory");
#pragma unroll
      for (int i = 0; i < 4; ++i) { const int row = i * 8 + (lane >> 3), ch = lane & 7; const u32x4 v = *(const u32x4*)(stg + row * 64 + ch * 8);
        *(u32x4*)(Ob + ATT_GROW(q0 + wid * 32 + row) * po + ch * 8) = v; } }
    asm volatile("s_waitcnt lgkmcnt(0)\n\ts_barrier" ::: "memory");
#undef ATT_GROW
#undef ATT_ISSUE
}
#undef ATT_SBAR
#undef ATT_WAIT_BAR
}
namespace mla {
using bf16 = unsigned short;
using bf16x8 = __attribute__((ext_vector_type(8))) short;
using s16x4 = __attribute__((ext_vector_type(4))) short;
using f32x16 = __attribute__((ext_vector_type(16))) float;
using u32x4 = __attribute__((ext_vector_type(4))) unsigned;
constexpr int SEQL = 8192, PQ = 1536, PV = 1024, HQ = 96, HV = 64;
constexpr int NW = 8, QBLK = 32, QB = QBLK * NW, KVBLK = 64;
__device__ __forceinline__ int crow(int r, int hi) { return (r & 3) + 8 * (r >> 2) + 4 * hi; }
#define SBAR() __builtin_amdgcn_sched_barrier(0)
__device__ __forceinline__ void cmask(f32x16& p0, f32x16& p1, int jb, int qrel, int hi) {
    const float NEG = -INFINITY; int kb = 64 * jb + 4 * hi;
#pragma unroll
    for (int r = 0; r < 16; ++r) { int kv = kb + (r & 3) + 8 * (r >> 2); if (kv > qrel) p0[r] = NEG; if (kv + 32 > qrel) p1[r] = NEG; }
}
constexpr int NSLOT = 3, KSLOTB = 12288, VSLOTB = 8192;
constexpr int LDS_K = 0, LDS_V = NSLOT * KSLOTB, LDS_WS = LDS_V + NSLOT * VSLOTB, LDS_OST = LDS_WS + NW * 64 * 4, LDS_BYTES = LDS_OST + NW * 4096;
static_assert(LDS_BYTES <= 131072, "mla attention LDS");
__device__ __forceinline__ void glds16(const void* gsrc, unsigned lds_dst) { unsigned keep;
    asm volatile("s_mov_b32 %0, m0\n\ts_mov_b32 m0, %2\n\ts_nop 0\n\tglobal_load_lds_dwordx4 %1, off\n\ts_mov_b32 m0, %0" : "=&s"(keep) : "v"(gsrc), "s"(lds_dst) : "memory"); }
__device__ __forceinline__ float max3f(float a, float b, float c) { float r; asm("v_max3_f32 %0, %1, %2, %3" : "=v"(r) : "v"(a), "v"(b), "v"(c)); return r; }
__device__ __forceinline__ float max2f(float a, float b) { float r; asm("v_max_f32_e32 %0, %1, %2" : "=v"(r) : "v"(a), "v"(b)); return r; }
__device__ __forceinline__ float fadd_s(float a, float b) { float r; asm("v_add_f32_e32 %0, %1, %2" : "=v"(r) : "v"(a), "v"(b)); return r; }
__device__ __forceinline__ float fsub_s(float a, float b) { float r; asm("v_sub_f32_e32 %0, %1, %2" : "=v"(r) : "v"(a), "v"(b)); return r; }
typedef float f32x2_t __attribute__((ext_vector_type(2))); typedef __bf16 bf16x2_t __attribute__((ext_vector_type(2)));
__device__ __forceinline__ unsigned cvtpk_s(float lo, float hi) { f32x2_t v = {lo, hi}; bf16x2_t b = __builtin_convertvector(v, bf16x2_t); return __builtin_bit_cast(unsigned, b); }
#define WAIT_BAR(N) asm volatile("s_waitcnt vmcnt(" #N ") lgkmcnt(0)\n\ts_barrier" ::: "memory")

__device__ __forceinline__ void qkt(f32x16& p0, f32x16& p1, const char* Kslot, const bf16x8* qr, const f32x16& negm, int r32, int hi) {
    const char* kb = Kslot + hi * 1024 + r32 * 16;
#pragma unroll
    for (int d0 = 0; d0 < 6; ++d0) {
        const bf16x8 b0 = *reinterpret_cast<const bf16x8*>(kb + d0 * 2048);
        const bf16x8 b1 = *reinterpret_cast<const bf16x8*>(kb + d0 * 2048 + 512);
        if (d0 == 0) { p0 = __builtin_amdgcn_mfma_f32_32x32x16_bf16(b0, qr[0], negm, 0, 0, 0); p1 = __builtin_amdgcn_mfma_f32_32x32x16_bf16(b1, qr[0], negm, 0, 0, 0); }
        else { p0 = __builtin_amdgcn_mfma_f32_32x32x16_bf16(b0, qr[d0], p0, 0, 0, 0); p1 = __builtin_amdgcn_mfma_f32_32x32x16_bf16(b1, qr[d0], p1, 0, 0, 0); } }
}
typedef __attribute__((address_space(3))) const char* lds_cptr;
typedef short v4i16_t __attribute__((ext_vector_type(4)));
__device__ __forceinline__ void kload12(bf16x8* kf, lds_cptr kp) {
#pragma unroll
    for (int j = 0; j < 6; ++j) { kf[2 * j] = *(const __attribute__((address_space(3))) bf16x8*)(kp + j * 2048); kf[2 * j + 1] = *(const __attribute__((address_space(3))) bf16x8*)(kp + j * 2048 + 512); }
}
__device__ __forceinline__ void kload2(bf16x8* kf, lds_cptr kp, int j) { kf[2 * j] = *(const __attribute__((address_space(3))) bf16x8*)(kp + j * 2048); kf[2 * j + 1] = *(const __attribute__((address_space(3))) bf16x8*)(kp + j * 2048 + 512); }
__device__ __forceinline__ s16x4 vtr(lds_cptr p) { return __builtin_bit_cast(s16x4, __builtin_amdgcn_ds_read_tr16_b64_v4i16((__attribute__((address_space(3))) v4i16_t*)p)); }
__device__ __forceinline__ float rowmax(const f32x16& p0, const f32x16& p1) {
    float a = max3f(p0[0], p0[1], p1[0]), b = max3f(p0[2], p0[3], p1[1]); a = max3f(a, p1[2], p1[3]);
#pragma unroll
    for (int r = 4; r < 16; r += 4) { a = max3f(a, p0[r], p0[r + 1]); b = max3f(b, p0[r + 2], p0[r + 3]); a = max3f(a, p1[r], p1[r + 1]); b = max3f(b, p1[r + 2], p1[r + 3]); }
    const float m = max2f(a, b);
    auto rr = __builtin_amdgcn_permlane32_swap(__float_as_uint(m), __float_as_uint(m), false, false);
    return max2f(__uint_as_float(rr[0]), __uint_as_float(rr[1]));
}
__device__ __forceinline__ void pv(f32x16* o, int vb, bf16x8 pa0, bf16x8 pa1, bf16x8 pa2, bf16x8 pa3) {
#pragma unroll
    for (int d0 = 0; d0 < 2; ++d0) { s16x4 lo[4], hi[4];
#pragma unroll
        for (int ks = 0; ks < 4; ++ks) {
            asm volatile("ds_read_b64_tr_b16 %0,%1 offset:%c2" : "=&v"(lo[ks]) : "v"(vb), "i"(d0 * 4096 + ks * 1024) : "memory");
            asm volatile("ds_read_b64_tr_b16 %0,%1 offset:%c2" : "=&v"(hi[ks]) : "v"(vb), "i"(d0 * 4096 + ks * 1024 + 512) : "memory"); }
        asm volatile("s_waitcnt lgkmcnt(0)" ::: "memory"); SBAR();
#define PK(k) (bf16x8){lo[k][0], lo[k][1], lo[k][2], lo[k][3], hi[k][0], hi[k][1], hi[k][2], hi[k][3]}
        o[d0] = __builtin_amdgcn_mfma_f32_32x32x16_bf16(pa0, PK(0), o[d0], 0, 0, 0);
        o[d0] = __builtin_amdgcn_mfma_f32_32x32x16_bf16(pa1, PK(1), o[d0], 0, 0, 0);
        o[d0] = __builtin_amdgcn_mfma_f32_32x32x16_bf16(pa2, PK(2), o[d0], 0, 0, 0);
        o[d0] = __builtin_amdgcn_mfma_f32_32x32x16_bf16(pa3, PK(3), o[d0], 0, 0, 0);
#undef PK
    }
}

template <int THRL> __device__ __forceinline__ void attn_unit(int b, int h, int qb, const bf16* Q, const bf16* __restrict__ K, const bf16* __restrict__ V, bf16* O, char* shm) {
    int tid_ = threadIdx.x; asm volatile("" : "+v"(tid_));
    const int tid = tid_, lane = tid & 63, r32 = lane & 31, hi = lane >> 5; const int wid = __builtin_amdgcn_readfirstlane(tid >> 6);
    const long rowbase = (long)b * SEQL; const int q0 = qb * QB;
    const bf16* Qw = Q + (rowbase + q0 + wid * QBLK) * PQ + h * HQ;
    const bf16* Kh = K + rowbase * PQ + h * HQ; const bf16* Vh = V + rowbase * PV + h * HV;
    const unsigned lds0 = (unsigned)(uintptr_t)shm;
    float* wsf = (float*)(shm + LDS_WS) + wid * 64;
    const bool k2 = wid < 4;
    const bf16* ksrc = Kh + (long)lane * PQ + wid * 8;
    const bf16* vsrc = Vh + (long)(16 * (wid & 3) + (lane >> 2)) * PV + (wid >> 2) * 32 + (lane & 3) * 8;
    const unsigned kdst = lds0 + LDS_K + wid * 1024, vdst = lds0 + LDS_V + wid * 1024;
#define DMA_K(t, slot) do { glds16(ksrc + (long)(t) * KVBLK * PQ, (unsigned)__builtin_amdgcn_readfirstlane(kdst + (slot))); \
        if (k2) glds16(ksrc + (long)(t) * KVBLK * PQ + 64, (unsigned)__builtin_amdgcn_readfirstlane(kdst + (slot) + 8192)); } while (0)
#define DMA_V(t, slot) glds16(vsrc + (long)(t) * KVBLK * PV, (unsigned)__builtin_amdgcn_readfirstlane(vdst + (slot)))
    const int vb0 = (int)(lds0 + LDS_V) + ((lane >> 4) & 1) * 32 + (lane & 3) * 8 + (4 * hi + ((lane & 15) >> 2)) * 64;
    const char* Kbase = shm + LDS_K; bf16x8 kf[12];
    const lds_cptr shm3 = (lds_cptr)shm; const lds_cptr kp0 = shm3 + LDS_K + hi * 1024 + r32 * 16; const lds_cptr vp0 = shm3 + LDS_V + ((lane >> 4) & 1) * 32 + (lane & 3) * 8 + (4 * hi + ((lane & 15) >> 2)) * 64;
    const int NT = (q0 + QB) / KVBLK;
#define WAIT_KV() do { if (k2) WAIT_BAR(3); else WAIT_BAR(2); } while (0)
#define WAIT_KKV() do { if (k2) WAIT_BAR(5); else WAIT_BAR(3); } while (0)
    DMA_K(0, 0); DMA_V(0, 0); DMA_K(1, KSLOTB);
    bf16x8 qr[6];
#pragma unroll
    for (int d0 = 0; d0 < 6; ++d0) qr[d0] = *reinterpret_cast<const bf16x8*>(&Qw[(long)r32 * PQ + d0 * 16 + hi * 8]);
    float mhat = 0.f, l_reg = 0.f; f32x16 o[2]; o[0] = f32x16{}; o[1] = f32x16{}; const f32x16 zero16 = f32x16{};
    const int qrel = wid * QBLK + r32;
#define CMASK(P0, P1, t) do { int jb_ = (t) - (NT - 4); if (jb_ >= 0) cmask(P0, P1, jb_, qrel, hi); } while (0)
    bool resc = false;
#define START(P0, P1) do { const float rm = rowmax(P0, P1); resc = false; \
    { const float dl = rm; mhat = fadd_s(mhat, dl); \
      _Pragma("unroll") for (int r = 0; r < 16; ++r) { P0[r] = fsub_s(P0[r], dl); P1[r] = fsub_s(P1[r], dl); } \
      } \
    _Pragma("unroll") for (int r = 0; r < 16; ++r) P0[r] = __builtin_amdgcn_exp2f(P0[r]); } while (0)
#define RESC() do { if (resc) { asm volatile("s_waitcnt lgkmcnt(0)" ::: "memory"); \
      _Pragma("unroll") for (int d_ = 0; d_ < 2; ++d_) _Pragma("unroll") for (int r = 0; r < 16; ++r) o[d_][r] *= wsf[crow(r, hi)]; } } while (0)
    f32x16 pA0, pA1, pB0, pB1;
    int sl_prev = 0, sl_cur = 0, sl_next = 1;
#define ROT() do { sl_prev = sl_cur; sl_cur = sl_next; sl_next = (sl_next == NSLOT - 1) ? 0 : sl_next + 1; } while (0)
    DMA_K(2, 2 * KSLOTB);
    WAIT_KKV();
    qkt(pA0, pA1, Kbase, qr, zero16, r32, hi); asm volatile("s_nop 15\n\ts_nop 7" : "+v"(pA0), "+v"(pA1)); CMASK(pA0, pA1, 0);
    START(pA0, pA1);
#pragma unroll
    for (int r = 0; r < 16; ++r) pA1[r] = __builtin_amdgcn_exp2f(pA1[r]);
    WAIT_BAR(0);
    DMA_K(3, 0); DMA_V(1, VSLOTB);
    ROT();
    kload12(kf, kp0 + sl_cur * KSLOTB);
    WAIT_KV();
    s16x4 vlo[8], vhi[8]; u32x4 pw0, pw1, pw2, pw3;
#define PKW(P, B) cvtpk_s(P[B], P[B + 1])
#define PAF(k) __builtin_bit_cast(bf16x8, pw##k)
#define VFR(i) (bf16x8){vlo[i][0], vlo[i][1], vlo[i][2], vlo[i][3], vhi[i][0], vhi[i][1], vhi[i][2], vhi[i][3]}
#define PIN(x) asm volatile("" : "+v"(x))
#define MX3(a, b, c) __builtin_fmaxf(__builtin_fmaxf((a), (b)), (c))
#define GAPA(MF, A0, A1, A2, A3, W0, W1, PW) do { MF; sacc += A0; sacc += A1; sacc += A2; sacc += A3; PIN(sacc); W0; W1; PIN(PW); SBAR(); } while (0)
#define GAPM(MF) do { MF; SBAR(); } while (0)
#define EX(v) __builtin_amdgcn_exp2f(v)
#define GAPB(MF, X, B) do { MF; X[B] = EX(X[B]); X[B + 1] = EX(X[B + 1]); X[B + 2] = EX(X[B + 2]); X[B + 3] = EX(X[B + 3]); PIN(X); SBAR(); } while (0)
#define VRD(i) do { vlo[i] = vtr(vp_ + (((i) >> 2) * 4096 + ((i) & 3) * 1024)); vhi[i] = vtr(vp_ + (((i) >> 2) * 4096 + ((i) & 3) * 1024 + 512)); } while (0)
#define KRD(G, j) do { if (G) { kload2(kf, kp0 + sl_next * KSLOTB, j); SBAR(); } } while (0)
#define MF32(a, b, c) __builtin_amdgcn_mfma_f32_32x32x16_bf16(a, b, c, 0, 0, 0)
#define STEP(C0, C1, P0, P1, t, GK, GV, GL) do { SBAR(); \
    const lds_cptr vp_ = vp0 + sl_prev * VSLOTB; \
    float sacc = (P0[0] + P0[1]); \
    GAPA(C0 = MF32(kf[0], qr[0], zero16), P0[2], P0[3], P0[4], P0[5],     pw0[0] = PKW(P0, 0), pw0[1] = PKW(P0, 2), pw0); \
    GAPA(C1 = MF32(kf[1], qr[0], zero16), P0[6], P0[7], P0[8], P0[9],     pw0[2] = PKW(P0, 4), pw0[3] = PKW(P0, 6), pw0); \
    GAPA(C0 = MF32(kf[2], qr[1], C0),   P0[10], P0[11], P0[12], P0[13], pw1[0] = PKW(P0, 8), pw1[1] = PKW(P0, 10), pw1); \
    GAPA(C1 = MF32(kf[3], qr[1], C1),   P0[14], P0[15], P1[0], P1[1],   pw1[2] = PKW(P0, 12), pw1[3] = PKW(P0, 14), pw1); \
    VRD(0); SBAR(); GAPA(C0 = MF32(kf[4], qr[2], C0),   P1[2], P1[3], P1[4], P1[5],     pw2[0] = PKW(P1, 0), pw2[1] = PKW(P1, 2), pw2); \
    VRD(4); SBAR(); GAPA(C1 = MF32(kf[5], qr[2], C1),   P1[6], P1[7], P1[8], P1[9],     pw2[2] = PKW(P1, 4), pw2[3] = PKW(P1, 6), pw2); \
    VRD(1); SBAR(); GAPA(C0 = MF32(kf[6], qr[3], C0),   P1[10], P1[11], P1[12], P1[13], pw3[0] = PKW(P1, 8), pw3[1] = PKW(P1, 10), pw3); \
    VRD(5); SBAR(); GAPA(C1 = MF32(kf[7], qr[3], C1),   P1[14], P1[15], 0.f, 0.f,       pw3[2] = PKW(P1, 12), pw3[3] = PKW(P1, 14), pw3); \
    VRD(2); SBAR(); GAPM(C0 = MF32(kf[8], qr[4], C0)); VRD(6); SBAR(); GAPM(C1 = MF32(kf[9], qr[4], C1)); \
    VRD(3); SBAR(); GAPM(C0 = MF32(kf[10], qr[5], C0)); VRD(7); SBAR(); GAPM(C1 = MF32(kf[11], qr[5], C1)); \
    l_reg += sacc; \
    if (GK) { DMA_K((t) + 3, sl_cur * KSLOTB); } if (GV) { DMA_V((t) + 1, sl_next * VSLOTB); } \
    CMASK(C0, C1, t); \
    { float a = MX3(C0[0], C0[1], C1[0]), b = MX3(C0[2], C0[3], C1[1]); a = MX3(a, C1[2], C1[3]); \
      _Pragma("unroll") for (int r = 4; r < 16; r += 4) { a = MX3(a, C0[r], C0[r + 1]); b = MX3(b, C0[r + 2], C0[r + 3]); a = MX3(a, C1[r], C1[r + 1]); b = MX3(b, C1[r + 2], C1[r + 3]); } \
      float rm = __builtin_fmaxf(a, b); { auto rr = __builtin_amdgcn_permlane32_swap(__float_as_uint(rm), __float_as_uint(rm), false, false); rm = __builtin_fmaxf(__uint_as_float(rr[0]), __uint_as_float(rr[1])); } \
      rm -= mhat; resc = false; \
      if (__builtin_expect(__any(rm > (float)THRL), 0)) { const float dl = __builtin_fmaxf(rm, 0.f); mhat += dl; \
        const float f = __builtin_amdgcn_exp2f(-dl); l_reg *= f; if (hi == 0) wsf[r32] = f; resc = true; } \
      _Pragma("unroll") for (int r = 0; r < 16; ++r) { C0[r] -= mhat; C1[r] -= mhat; } } \
    SBAR(); \
    GAPB(o[0] = MF32(PAF(0), VFR(0), o[0]), C0, 0); \
    KRD(GL, 0); GAPB(o[1] = MF32(PAF(0), VFR(4), o[1]), C0, 4); \
    KRD(GL, 1); GAPB(o[0] = MF32(PAF(1), VFR(1), o[0]), C0, 8); \
    KRD(GL, 2); GAPB(o[1] = MF32(PAF(1), VFR(5), o[1]), C0, 12); \
    KRD(GL, 3); GAPB(o[0] = MF32(PAF(2), VFR(2), o[0]), C1, 0); \
    KRD(GL, 4); GAPB(o[1] = MF32(PAF(2), VFR(6), o[1]), C1, 4); \
    KRD(GL, 5); GAPB(o[0] = MF32(PAF(3), VFR(3), o[0]), C1, 8); \
    GAPB(o[1] = MF32(PAF(3), VFR(7), o[1]), C1, 12); \
    } while (0)
    int t = 1;
#undef CMASK
#define CMASK(P0, P1, t) do { } while (0)
    for (; t + 5 < NT; t += 2) {
        STEP(pB0, pB1, pA0, pA1, t, true, true, true);     WAIT_KV(); RESC(); ROT();
        STEP(pA0, pA1, pB0, pB1, t + 1, true, true, true); WAIT_KV(); RESC(); ROT();
    }
#undef CMASK
#define CMASK(P0, P1, t) do { int jb_ = (t) - (NT - 4); if (jb_ >= 0) cmask(P0, P1, jb_, qrel, hi); } while (0)
#define ENDW(tt) do { if ((tt) + 3 < NT) { WAIT_KV(); } else if ((tt) + 2 < NT) { WAIT_BAR(1); } else { WAIT_BAR(0); } } while (0)
    for (; t + 1 < NT; t += 2) {
        STEP(pB0, pB1, pA0, pA1, t, (t + 3 < NT), (t + 1 < NT), (t + 1 < NT));         ENDW(t);     RESC(); ROT();
        STEP(pA0, pA1, pB0, pB1, t + 1, (t + 4 < NT), (t + 2 < NT), (t + 2 < NT));     ENDW(t + 1); RESC(); ROT();
    }
    STEP(pB0, pB1, pA0, pA1, NT - 1, false, false, false); RESC();
    { float sacc = pB0[0] + pB0[1];
#pragma unroll
      for (int r = 2; r < 16; ++r) sacc += pB0[r];
#pragma unroll
      for (int r = 0; r < 16; ++r) sacc += pB1[r];
      l_reg += sacc;
      pw0 = (u32x4){PKW(pB0, 0), PKW(pB0, 2), PKW(pB0, 4), PKW(pB0, 6)}; pw1 = (u32x4){PKW(pB0, 8), PKW(pB0, 10), PKW(pB0, 12), PKW(pB0, 14)}; pw2 = (u32x4){PKW(pB1, 0), PKW(pB1, 2), PKW(pB1, 4), PKW(pB1, 6)}; pw3 = (u32x4){PKW(pB1, 8), PKW(pB1, 10), PKW(pB1, 12), PKW(pB1, 14)};
      SBAR(); pv(o, vb0 + sl_cur * VSLOTB, PAF(0), PAF(1), PAF(2), PAF(3)); }
#undef PKW
#undef PAF
#undef VFR
#undef PIN
#undef MX3
#undef GAPA
#undef GAPM
#undef GAPB
#undef EX
#undef VRD
#undef KRD
#undef MF32
#undef STEP
#undef ENDW
    { auto rr = __builtin_amdgcn_permlane32_swap(__float_as_uint(l_reg), __float_as_uint(l_reg), false, false); l_reg = __uint_as_float(rr[0]) + __uint_as_float(rr[1]); }
    if (hi == 0) wsf[32 + r32] = l_reg; asm volatile("s_waitcnt lgkmcnt(0)" ::: "memory");
    float rli[16];
#pragma unroll
    for (int r = 0; r < 16; ++r) rli[r] = __builtin_amdgcn_rcpf(wsf[32 + crow(r, hi)]);
    bf16* Ow = O + (rowbase + q0 + wid * QBLK) * PV + h * HV;
    { bf16* stg = (bf16*)(shm + LDS_OST) + wid * 2048;
#pragma unroll
      for (int r = 0; r < 16; ++r) { const int orow = crow(r, hi);
#pragma unroll
        for (int d0 = 0; d0 < 2; ++d0) stg[orow * 64 + d0 * 32 + r32] = (bf16)(cvtpk_s(o[d0][r] * rli[r], 0.f) & 0xffffu); }
      asm volatile("s_waitcnt lgkmcnt(0)" ::: "memory");
#pragma unroll
      for (int i = 0; i < 4; ++i) { const int row = i * 8 + (lane >> 3), ch = lane & 7; const u32x4 v = *(const u32x4*)(stg + row * 64 + ch * 8); *(u32x4*)(Ow + (long)row * PV + ch * 8) = v; } }
    asm volatile("s_waitcnt lgkmcnt(0)\n\ts_barrier" ::: "memory");
#undef DMA_K
#undef DMA_V
#undef CMASK
#undef START
#undef RESC
#undef ROT
#undef WAIT_KV
#undef WAIT_KKV
}
#undef SBAR
#undef WAIT_BAR
}
constexpr int NWAVES = 8;
constexpr int BATCH = 4, SEQ = 8192, D = 1024, M = BATCH * SEQ;
constexpr int MLA_H = 16, QRANK = 384, KVRANK = 256, LATN = 672, LATP = 768, QUP = 1536, KVUP = 2048;
constexpr int DFF = 2816, NEXP = 8, DILQ = 1536, DILKV = 3072, DILOUT = 512;
constexpr int MAXSLOT = 67584;
constexpr float EPS = 1e-6f;
constexpr float C2_MLA = 0.1472444460259031f;
constexpr float C2_DIL = 0.18033688011112042f;
constexpr float LOG2E_F = 1.4426950408889634f;

constexpr size_t MiB = 1u << 20;
constexpr size_t WS_CTL = 0, CTL_ZERO_BYTES = 64 * 1024;
constexpr size_t WS_MODV = 1 * MiB;
constexpr size_t WS_BIAS = 1 * MiB + 256 * 1024;
constexpr size_t WS_ROUTE = 1 * MiB + 512 * 1024;
constexpr size_t WS_CNT = 2 * MiB;
constexpr size_t WS_LIST = 2 * MiB + 256 * 1024;
constexpr size_t WS_SLOTG = 2 * MiB + 768 * 1024;
constexpr size_t WS_TOKSLOT = 3 * MiB + 256 * 1024;
constexpr size_t WS_TILEEXP = 3 * MiB + 768 * 1024;
constexpr size_t WS_CS = 4 * MiB;
constexpr size_t WS_LSE = 8 * MiB;
constexpr size_t WS_WEGU = 12 * MiB, WS_WEDN = 100 * MiB, WS_WFGU = 144 * MiB, WS_WFDN = 155 * MiB, WS_WKVB = 161 * MiB, WS_WQB = 167 * MiB, WS_WOUT = 170 * MiB,
                 WS_WOB = 172 * MiB, WS_WMLAIN = 173 * MiB, WS_WQUP = 175 * MiB, WS_WKVUP = 177 * MiB;
constexpr size_t WS_ARENA = 180 * MiB;
constexpr size_t A_XN = WS_ARENA, A_LAT = WS_ARENA + 64 * MiB, A_QN = WS_ARENA + 112 * MiB, A_KVN = WS_ARENA + 136 * MiB, A_Q = WS_ARENA + 152 * MiB, A_K = WS_ARENA + 248 * MiB,
                 A_V = WS_ARENA + 344 * MiB, A_O = WS_ARENA + 408 * MiB, A_HID = WS_ARENA + 64 * MiB, A_XNKV = WS_ARENA + 64 * MiB, A_KVB = WS_ARENA + 128 * MiB, A_QB = WS_ARENA + 320 * MiB,
                 A_OG = WS_ARENA, A_OD = WS_ARENA + 128 * MiB, A_HIDS = WS_ARENA + 160 * MiB, A_Y = WS_ARENA;
constexpr size_t WS_END = WS_ARENA + 523 * MiB;
static_assert(A_HIDS + (size_t)MAXSLOT * DFF * 2 <= WS_END && A_Y + (size_t)MAXSLOT * D * 2 <= A_HIDS && A_O + (size_t)M * D * 2 <= WS_END, "arena map");
static_assert(WS_WEGU + (size_t)NEXP * 2 * DFF * D * 2 <= WS_WEDN && WS_WEDN + (size_t)NEXP * D * DFF * 2 <= WS_WFGU && WS_WFGU + (size_t)2 * DFF * D * 2 <= WS_WFDN && WS_WFDN + (size_t)D * DFF * 2 <= WS_WKVB, "weight map");
enum ModKind { MK_A_MIX0 = 0, MK_B_MIX0, MK_G_MIX0, MK_A_FFN0, MK_B_FFN0, MK_G_FFN0, MK_A_MIX1, MK_B_MIX1, MK_G_MIX1, MK_A_FFN1, MK_B_FFN1, MK_G_FFN1, MK_A_KV, MK_B_KV };
constexpr int CW_BAR = 4096;

constexpr int RING_BYTES = 131072;
constexpr int LDSCTL_OFF = RING_BYTES, MISC_OFF = LDSCTL_OFF + 320;
constexpr int LDS_BYTES = 147456;

#define GAS __attribute__((address_space(1)))
#define LAS __attribute__((address_space(3)))
typedef unsigned short bf16;
typedef unsigned v4u __attribute__((ext_vector_type(4)));
typedef unsigned v2u __attribute__((ext_vector_type(2)));
typedef float f32x4 __attribute__((ext_vector_type(4)));
typedef GAS unsigned gu32;
#define RLX_AGENT __ATOMIC_RELAXED, __HIP_MEMORY_SCOPE_AGENT
#define LDS_WAIT() asm volatile("s_waitcnt lgkmcnt(0)" ::: "memory")
#define VM_WAIT() asm volatile("s_waitcnt vmcnt(0)" ::: "memory")
__device__ __forceinline__ unsigned f2bf(float f) { unsigned u = __builtin_bit_cast(unsigned, f); return (u + 0x7fffu + ((u >> 16) & 1u)) >> 16; }
__device__ __forceinline__ unsigned pk2(float lo, float hi) { return f2bf(lo) | (f2bf(hi) << 16); }
__device__ __forceinline__ float bf_lo(unsigned w) { return __builtin_bit_cast(float, w << 16); }
__device__ __forceinline__ float bf_hi(unsigned w) { return __builtin_bit_cast(float, w & 0xffff0000u); }
__device__ __forceinline__ float wave_sum(float v) {
#pragma unroll
    for (int o = 1; o < 64; o <<= 1) v += __shfl_xor(v, o);
    return v;
}

#define XB_TMO      128
#define XB_XCNT(j)  (256  + 64 * (j))
#define XB_XSUB(j)  (1280 + 64 * (j))
#define XB_XGEN(j)  (2304 + 64 * (j))
#define XB_TOP      3328
#define XB_TOPGEN   3392
#define XCD_BAR_WORDS 3456
#define XB_SPIN_CAP (1u << 18)
__device__ __forceinline__ unsigned xb_ld(unsigned* p)              { return __hip_atomic_load(p, __ATOMIC_RELAXED, __HIP_MEMORY_SCOPE_AGENT); }
__device__ __forceinline__ unsigned xb_add(unsigned* p, unsigned v) { return __hip_atomic_fetch_add(p, v, __ATOMIC_RELAXED, __HIP_MEMORY_SCOPE_AGENT); }
__device__ __forceinline__ unsigned xb_xcc_id() { return (unsigned)__builtin_amdgcn_s_getreg((3 << 11) | 20) & 0xFu; }
#define XB_SPIN(cond, bar) do { unsigned _sp = 0; while (cond) { __builtin_amdgcn_s_sleep(1); \
    if ((++_sp & 255u) == 0u) { if (xb_ld(&(bar)[XB_TMO])) break; if (_sp > XB_SPIN_CAP) { atomicAdd(&(bar)[XB_TMO], 1u); break; } } } } while (0)
struct XcdBarrier { unsigned* bar; unsigned x; volatile LAS unsigned* st; };
__device__ __forceinline__ XcdBarrier xcd_barrier_post(unsigned* bar, volatile LAS unsigned* st) {
    XcdBarrier b; b.bar = bar; b.x = xb_xcc_id(); b.st = st;
    if (threadIdx.x == 0) (void)xb_add(&bar[XB_XCNT(b.x)], 1u);
    return b;
}
__device__ __forceinline__ void xcd_barrier_complete(unsigned* bar, unsigned x, unsigned& nloc, unsigned& nx) {
    const unsigned G = gridDim.x * gridDim.y * gridDim.z;
    unsigned sum, cnt, mine, sp = 0u;
    for (;;) {
        sum = 0u; cnt = 0u; mine = 0u;
#pragma unroll
        for (unsigned j = 0; j < 16; ++j) { const unsigned c = xb_ld(&bar[XB_XCNT(j)]); sum += c; cnt += (c > 0u) ? 1u : 0u; mine = (j == x) ? c : mine; }
        if (sum == G) break;
        __builtin_amdgcn_s_sleep(1);
        if ((++sp & 255u) == 0u) { if (xb_ld(&bar[XB_TMO])) break; if (sp > XB_SPIN_CAP) { atomicAdd(&bar[XB_TMO], 1u); break; } }
    }
    nloc = mine > 0u ? mine : 1u; nx = cnt > 0u ? cnt : 1u;
}
__device__ __forceinline__ void xcd_barrier(const XcdBarrier& b) {
    asm volatile("s_waitcnt vmcnt(0)" ::: "memory");
    __syncthreads();
    if (threadIdx.x == 0) {
        unsigned* bar = b.bar;
        __builtin_amdgcn_s_waitcnt(0);
        unsigned nloc = b.st[0], nx = b.st[1];
        if (nloc == 0u) { xcd_barrier_complete(bar, b.x, nloc, nx); b.st[0] = nloc; b.st[1] = nx; }
        const unsigned old = xb_add(&bar[XB_XSUB(b.x)], 1u);
        const unsigned gen = old / nloc;
        if (old + 1u == (gen + 1u) * nloc) {
            __builtin_amdgcn_fence(__ATOMIC_RELEASE, "agent");
            asm volatile("s_waitcnt vmcnt(0)" ::: "memory");
            const unsigned og = xb_add(&bar[XB_TOP], 1u);
            const unsigned tg = og / nx;
            if (og + 1u == (tg + 1u) * nx) xb_add(&bar[XB_TOPGEN], 1u);
            else XB_SPIN(xb_ld(&bar[XB_TOPGEN]) == tg, bar);
            __builtin_amdgcn_fence(__ATOMIC_ACQUIRE, "agent");
            xb_add(&bar[XB_XGEN(b.x)], 1u);
            asm volatile("s_waitcnt vmcnt(0)" ::: "memory");
        } else {
            XB_SPIN(xb_ld(&bar[XB_XGEN(b.x)]) == gen, bar);
            __builtin_amdgcn_fence(__ATOMIC_ACQUIRE, "agent");
            asm volatile("s_waitcnt vmcnt(0)" ::: "memory");
        }
    }
    __syncthreads();
}

struct Frame {
    LAS unsigned char* lds;
    volatile LAS unsigned* MISC;
    int tid, lane, wave;
    int vcu, G;
    unsigned char* ws;
    const float* in[26];
    float* out;
};
enum { MAP_PLAIN = 0, MAP_MLAIN = 1, MAP_QUP = 2, MAP_GU = 3 };
template <int MAP> __device__ __forceinline__ int dmap(int n) {
    if (MAP == MAP_MLAIN) { if (n < 640) return n; if (n < 656) return 640 + 2 * (n - 640); return 640 + 2 * (n - 656) + 1; }
    if (MAP == MAP_QUP) { const int h = n / 96, j = n % 96; if (j < 64) return n; if (j < 80) return h * 96 + 64 + 2 * (j - 64); return h * 96 + 64 + 2 * (j - 80) + 1; }
    if (MAP == MAP_GU) { const int up = n >= DFF ? 1 : 0; const int c = up ? n - DFF : n; return (c >> 7) * 256 + up * 128 + (c & 127); }
    return n;
}
template <int MAP> __device__ __forceinline__ void transpose_item(const float* W, int K, int N, bf16* WT, const float* ks, LAS float* scr, int item, int lane) {
    const int nblk = N / 32, kb = item / nblk, nb = item % nblk, k0 = 64 * kb, n0 = 32 * nb;
#pragma unroll 8
    for (int i = 0; i < 32; ++i) { const int kk = 2 * i + (lane >> 5); float v = W[(size_t)(k0 + kk) * N + n0 + (lane & 31)]; if (ks) v *= ks[k0 + kk]; scr[kk * 33 + (lane & 31)] = v; }
    LDS_WAIT(); asm volatile("" ::: "memory");
    const int c = lane & 7;
#pragma unroll
    for (int j = 0; j < 4; ++j) { const int n = (lane >> 3) + 8 * j; const LAS float* s = scr + (8 * c) * 33 + n;
        v4u o; o.x = pk2(s[0 * 33], s[1 * 33]); o.y = pk2(s[2 * 33], s[3 * 33]); o.z = pk2(s[4 * 33], s[5 * 33]); o.w = pk2(s[6 * 33], s[7 * 33]);
        *(GAS v4u*)(WT + (size_t)dmap<MAP>(n0 + n) * K + k0 + 8 * c) = o; }
    LDS_WAIT(); asm volatile("" ::: "memory");
}
__device__ __constant__ double INVF_D[16] = {1.0, 0.5623413251903491, 0.31622776601683794, 0.1778279410038923, 0.09999999999999999, 0.056234132519034905, 0.03162277660168379, 0.01778279410038923,
    0.01, 0.005623413251903491, 0.0031622776601683794, 0.0017782794100389228, 0.001, 0.000562341325190349, 0.00031622776601683794, 0.0001778279410038923};
__device__ __constant__ int RPB_TH[15] = {22, 30, 40, 54, 73, 99, 134, 182, 246, 332, 450, 609, 825, 1117, 1513};

__device__ __forceinline__ void p0_prologue(Frame& F) {
    const int gw = F.vcu * NWAVES + F.wave, NGW = F.G * NWAVES;
    const int gtid = F.vcu * (NWAVES * 64) + F.tid, NGT = F.G * NWAVES * 64;
    float* MODV = (float*)(F.ws + WS_MODV);
    {
        LAS float* cact = (LAS float*)F.lds;
        LAS float* red = (LAS float*)(F.lds + 16384);
        const float* cin = F.in[1];
        for (int i = F.tid; i < 4096; i += NWAVES * 64) { const int b = i >> 10, k = i & 1023; const float x = cin[i]; cact[k * 4 + b] = x / (1.0f + expf(-x)); }
        __syncthreads();
        constexpr int NTASK = (6 * D * 2 + 2 * D) / 64;
        for (int task = F.vcu; task < NTASK; task += F.G) {
            const int gc = task * 64 + F.lane;
            const float* W; int ldw, cc; const float* bias;
            if (gc < 6 * D) { W = F.in[5]; ldw = 6 * D; cc = gc; bias = F.in[6]; }
            else if (gc < 12 * D) { W = F.in[5] + (size_t)D * 6 * D; ldw = 6 * D; cc = gc - 6 * D; bias = F.in[6] + 6 * D; }
            else { W = F.in[14]; ldw = 2 * D; cc = gc - 12 * D; bias = F.in[15]; }
            float a0 = 0.f, a1 = 0.f, a2 = 0.f, a3 = 0.f;
            const int kbeg = F.wave * 128;
#pragma unroll 16
            for (int k = 0; k < 128; ++k) { const float w = W[(size_t)(kbeg + k) * ldw + cc]; const f32x4 ca = *(const LAS f32x4*)(cact + (kbeg + k) * 4);
                a0 += w * ca[0]; a1 += w * ca[1]; a2 += w * ca[2]; a3 += w * ca[3]; }
            red[(F.wave * 4 + 0) * 64 + F.lane] = a0; red[(F.wave * 4 + 1) * 64 + F.lane] = a1; red[(F.wave * 4 + 2) * 64 + F.lane] = a2; red[(F.wave * 4 + 3) * 64 + F.lane] = a3;
            __syncthreads();
            if (F.wave < 4) { const int b = F.wave; float s = 0.f;
#pragma unroll
                for (int w = 0; w < 8; ++w) s += red[(w * 4 + b) * 64 + F.lane];
                s += bias[cc];
                int kind; float val = s; const int j = cc & 1023, ch = cc >> 10;
                if (gc < 12 * D) { const int Lr = gc < 6 * D ? 0 : 1;
                    if (ch == 0) kind = 6 * Lr + 1; else if (ch == 1) { kind = 6 * Lr + 0; val = F.in[3][Lr * D + j] * (1.0f + s); } else if (ch == 2) kind = 6 * Lr + 2;
                    else if (ch == 3) kind = 6 * Lr + 4; else if (ch == 4) { kind = 6 * Lr + 3; val = F.in[4][Lr * D + j] * (1.0f + s); } else kind = 6 * Lr + 5;
                } else { if (ch == 0) kind = MK_B_KV; else { kind = MK_A_KV; val = F.in[13][j] * (1.0f + s); } }
                MODV[((size_t)kind * 4 + b) * D + j] = val; }
            __syncthreads();
        }
        __syncthreads();
    }
    {
        LAS float* scr = (LAS float*)(F.lds + F.wave * 8704);
        constexpr int I_MLAIN = (D / 64) * (LATN / 32), I_QUP = (QRANK / 64) * (QUP / 32), I_KVUP = (KVRANK / 64) * (KVUP / 32), I_OUT = (D / 64) * (D / 32), I_FGU = (D / 64) * (2 * DFF / 32),
                      I_FDN = (DFF / 64) * (D / 32), I_KVB = (D / 64) * (DILKV / 32), I_QB = (D / 64) * (DILQ / 32), I_OB = (DILOUT / 64) * (D / 32);
        constexpr int NSMALL = I_MLAIN + I_QUP + I_KVUP + I_OUT + I_FGU + I_FDN + I_KVB + I_QB + I_OB;
        constexpr int NITEMS = NSMALL + NEXP * (I_FGU + I_FDN);
        bf16* const ws16 = (bf16*)F.ws;
        for (int it = gw; it < NITEMS; it += NGW) {
            int r = it;
            if (r >= NSMALL) { r -= NSMALL;
                if (r < NEXP * I_FGU) { const int e = r / I_FGU; transpose_item<MAP_GU>(F.in[23] + (size_t)e * D * 2 * DFF, D, 2 * DFF, (bf16*)(F.ws + WS_WEGU) + (size_t)e * 2 * DFF * D, nullptr, scr, r % I_FGU, F.lane); continue; }
                r -= NEXP * I_FGU; { const int e = r / I_FDN; transpose_item<MAP_PLAIN>(F.in[24] + (size_t)e * DFF * D, DFF, D, (bf16*)(F.ws + WS_WEDN) + (size_t)e * D * DFF, nullptr, scr, r % I_FDN, F.lane); continue; } }
            if (r < I_MLAIN) { transpose_item<MAP_MLAIN>(F.in[7], D, LATN, (bf16*)(F.ws + WS_WMLAIN), nullptr, scr, r, F.lane); continue; } r -= I_MLAIN;
            if (r < I_QUP) { transpose_item<MAP_QUP>(F.in[9], QRANK, QUP, (bf16*)(F.ws + WS_WQUP), F.in[8], scr, r, F.lane); continue; } r -= I_QUP;
            if (r < I_KVUP) { transpose_item<MAP_PLAIN>(F.in[11], KVRANK, KVUP, (bf16*)(F.ws + WS_WKVUP), F.in[10], scr, r, F.lane); continue; } r -= I_KVUP;
            if (r < I_OUT) { transpose_item<MAP_PLAIN>(F.in[12], D, D, (bf16*)(F.ws + WS_WOUT), nullptr, scr, r, F.lane); continue; } r -= I_OUT;
            if (r < I_FGU) { transpose_item<MAP_GU>(F.in[20], D, 2 * DFF, (bf16*)(F.ws + WS_WFGU), nullptr, scr, r, F.lane); continue; } r -= I_FGU;
            if (r < I_FDN) { transpose_item<MAP_PLAIN>(F.in[21], DFF, D, (bf16*)(F.ws + WS_WFDN), nullptr, scr, r, F.lane); continue; } r -= I_FDN;
            if (r < I_KVB) { transpose_item<MAP_PLAIN>(F.in[16], D, DILKV, (bf16*)(F.ws + WS_WKVB), nullptr, scr, r, F.lane); continue; } r -= I_KVB;
            if (r < I_QB) { transpose_item<MAP_PLAIN>(F.in[18], D, DILQ, (bf16*)(F.ws + WS_WQB), nullptr, scr, r, F.lane); continue; } r -= I_QB;
            transpose_item<MAP_PLAIN>(F.in[19], DILOUT, D, (bf16*)(F.ws + WS_WOB), nullptr, scr, r, F.lane);
        }
        (void)ws16;
    }
    {
        v4u* padz = (v4u*)(F.ws + WS_WMLAIN + (size_t)LATN * D * 2);
        for (int i = gtid; i < (LATP - LATN) * D * 2 / 16; i += NGT) padz[i] = (v4u){0u, 0u, 0u, 0u};
        const int* pos = (const int*)F.in[2];
        float* cs = (float*)(F.ws + WS_CS);
        for (int i = gtid; i < M * 16; i += NGT) { const int row = i >> 4, k = i & 15;
            const double x = (double)pos[row] * INVF_D[k]; const double rev = x * 0.15915494309189535; const float fr = (float)(rev - __builtin_rint(rev));
            cs[(size_t)i * 2] = __builtin_amdgcn_cosf(fr); cs[(size_t)i * 2 + 1] = __builtin_amdgcn_sinf(fr); }
        const float* rpb = F.in[17];
        float* bt = (float*)(F.ws + WS_BIAS);
        for (int i = gtid; i < 24 * 129; i += NGT) { const int gh = i / 129, j = i % 129, g = gh >> 3; const int d = j * (g == 0 ? 1 : (g == 1 ? 4 : 16));
            int bk; if (d < 16) bk = d; else { bk = 16;
#pragma unroll
                for (int q = 0; q < 15; ++q) bk += (d >= RPB_TH[q]) ? 1 : 0; }
            bt[gh * 132 + j] = rpb[bk * 24 + gh] * LOG2E_F; }
    }
}

template <bool DUAL>
__device__ __forceinline__ void norm_phase(Frame& F, const float* H, const float* A0, const float* B0, bf16* O0, const float* A1, const float* B1, bf16* O1) {
    const int gw = F.vcu * NWAVES + F.wave, NGW = F.G * NWAVES;
    for (int c = gw; c < M / 16; c += NGW) {
        const int row0 = c * 16, b = row0 / SEQ;
        f32x4 a0[4], b0[4], a1[4], b1[4];
#pragma unroll
        for (int j = 0; j < 4; ++j) { a0[j] = *(const f32x4*)(A0 + b * D + 4 * F.lane + 256 * j); b0[j] = *(const f32x4*)(B0 + b * D + 4 * F.lane + 256 * j);
            if (DUAL) { a1[j] = *(const f32x4*)(A1 + b * D + 4 * F.lane + 256 * j); b1[j] = *(const f32x4*)(B1 + b * D + 4 * F.lane + 256 * j); } }
#pragma unroll 2
        for (int i = 0; i < 16; ++i) { const size_t row = (size_t)(row0 + i);
            const GAS f32x4* xr = (const GAS f32x4*)(H + row * D) + F.lane;
            f32x4 v[4]; float s = 0.f;
#pragma unroll
            for (int j = 0; j < 4; ++j) { v[j] = xr[64 * j]; s += (v[j].x * v[j].x + v[j].y * v[j].y) + (v[j].z * v[j].z + v[j].w * v[j].w); }
            const float rstd = 1.0f / sqrtf(wave_sum(s) * (1.f / D) + EPS);
            GAS v2u* o0 = (GAS v2u*)(O0 + row * D) + F.lane;
#pragma unroll
            for (int j = 0; j < 4; ++j) { const f32x4 y = v[j] * rstd * a0[j] + b0[j]; o0[64 * j] = (v2u){pk2(y.x, y.y), pk2(y.z, y.w)}; }
            if (DUAL) { GAS v2u* o1 = (GAS v2u*)(O1 + row * D) + F.lane;
#pragma unroll
                for (int j = 0; j < 4; ++j) { const f32x4 y = v[j] * rstd * a1[j] + b1[j]; o1[64 * j] = (v2u){pk2(y.x, y.y), pk2(y.z, y.w)}; } }
        }
    }
}

__device__ __forceinline__ void latnorm_phase(Frame& F) {
    const int gw = F.vcu * NWAVES + F.wave, NGW = F.G * NWAVES;
    const bf16* LAT = (const bf16*)(F.ws + A_LAT); bf16* QN = (bf16*)(F.ws + A_QN); bf16* KVN = (bf16*)(F.ws + A_KVN); bf16* KB = (bf16*)(F.ws + A_K);
    const float* cs = (const float*)(F.ws + WS_CS);
    for (int row = gw; row < M; row += NGW) {
        const unsigned* lr = (const unsigned*)(LAT + (size_t)row * LATP);
        unsigned q[3], kv[2];
#pragma unroll
        for (int j = 0; j < 3; ++j) q[j] = lr[F.lane + 64 * j];
#pragma unroll
        for (int j = 0; j < 2; ++j) kv[j] = lr[192 + F.lane + 64 * j];
        const unsigned kr = lr[320 + (F.lane & 15)];
        float sq = 0.f, sk = 0.f;
#pragma unroll
        for (int j = 0; j < 3; ++j) { const float a = bf_lo(q[j]), b = bf_hi(q[j]); sq += a * a + b * b; }
#pragma unroll
        for (int j = 0; j < 2; ++j) { const float a = bf_lo(kv[j]), b = bf_hi(kv[j]); sk += a * a + b * b; }
        const float rq = 1.0f / sqrtf(wave_sum(sq) * (1.f / QRANK) + EPS), rk = 1.0f / sqrtf(wave_sum(sk) * (1.f / KVRANK) + EPS);
        unsigned* qo = (unsigned*)(QN + (size_t)row * QRANK); unsigned* ko = (unsigned*)(KVN + (size_t)row * KVRANK);
#pragma unroll
        for (int j = 0; j < 3; ++j) qo[F.lane + 64 * j] = pk2(bf_lo(q[j]) * rq, bf_hi(q[j]) * rq);
#pragma unroll
        for (int j = 0; j < 2; ++j) ko[F.lane + 64 * j] = pk2(bf_lo(kv[j]) * rk, bf_hi(kv[j]) * rk);
        { const int i = F.lane & 15; const float c = cs[(size_t)row * 32 + 2 * i], s = cs[(size_t)row * 32 + 2 * i + 1]; const float x1 = bf_lo(kr), x2 = bf_hi(kr);
          const unsigned w = pk2(x1 * c - x2 * s, x1 * s + x2 * c);
          unsigned* kb = (unsigned*)(KB + (size_t)row * QUP);
#pragma unroll
          for (int hh = 0; hh < 4; ++hh) { const int h = (F.lane >> 4) * 4 + hh; kb[(h * 96 + 64) / 2 + i] = w; } }
    }
}

__device__ __forceinline__ void merge_phase(Frame& F) {
    const int gw = F.vcu * NWAVES + F.wave, NGW = F.G * NWAVES;
    const bf16* OG = (const bf16*)(F.ws + A_OG); const float* LSE = (const float*)(F.ws + WS_LSE); bf16* OD = (bf16*)(F.ws + A_OD);
    for (int row = gw; row < M; row += NGW) {
        const int h = F.lane >> 3;
        float l0 = LSE[((size_t)0 * M + row) * 8 + h], l1 = LSE[((size_t)1 * M + row) * 8 + h], l2 = LSE[((size_t)2 * M + row) * 8 + h];
        const float mx = fmaxf(l0, fmaxf(l1, l2)); float w0 = __builtin_amdgcn_exp2f(l0 - mx), w1 = __builtin_amdgcn_exp2f(l1 - mx), w2 = __builtin_amdgcn_exp2f(l2 - mx);
        const float inv = 1.0f / (w0 + w1 + w2); w0 *= inv; w1 *= inv; w2 *= inv;
        const v4u a = *(const v4u*)(OG + ((size_t)0 * M + row) * DILOUT + 8 * F.lane), b = *(const v4u*)(OG + ((size_t)1 * M + row) * DILOUT + 8 * F.lane), c = *(const v4u*)(OG + ((size_t)2 * M + row) * DILOUT + 8 * F.lane);
        v4u o;
#pragma unroll
        for (int k = 0; k < 4; ++k) o[k] = pk2(w0 * bf_lo(a[k]) + w1 * bf_lo(b[k]) + w2 * bf_lo(c[k]), w0 * bf_hi(a[k]) + w1 * bf_hi(b[k]) + w2 * bf_hi(c[k]));
        *(v4u*)(OD + (size_t)row * DILOUT + 8 * F.lane) = o;
    }
}

__device__ __forceinline__ void router_phase(Frame& F, const float* H, const float* A0, const float* B0, bf16* O0) {
    const int gw = F.vcu * NWAVES + F.wave, NGW = F.G * NWAVES;
    LAS float* wrt = (LAS float*)F.lds;
    { const float* wr = F.in[22]; for (int i = F.tid; i < 8192; i += NWAVES * 64) { const int col = i >> 3, e = i & 7; wrt[e * 1024 + col] = wr[i]; } }
    __syncthreads();
    v4u* ROUTE = (v4u*)(F.ws + WS_ROUTE); unsigned* CNT = (unsigned*)(F.ws + WS_CNT);
    for (int c = gw; c < M / 16; c += NGW) {
        const int row0 = c * 16, b = row0 / SEQ;
        f32x4 a0[4], b0[4];
#pragma unroll
        for (int j = 0; j < 4; ++j) { a0[j] = *(const f32x4*)(A0 + b * D + 4 * F.lane + 256 * j); b0[j] = *(const f32x4*)(B0 + b * D + 4 * F.lane + 256 * j); }
        unsigned cnt = 0u;
        for (int i = 0; i < 16; ++i) { const size_t row = (size_t)(row0 + i);
            const GAS f32x4* xr = (const GAS f32x4*)(H + row * D) + F.lane;
            f32x4 v[4]; float s = 0.f;
#pragma unroll
            for (int j = 0; j < 4; ++j) { v[j] = xr[64 * j]; s += (v[j].x * v[j].x + v[j].y * v[j].y) + (v[j].z * v[j].z + v[j].w * v[j].w); }
            const float rstd = 1.0f / sqrtf(wave_sum(s) * (1.f / D) + EPS);
            GAS v2u* o0 = (GAS v2u*)(O0 + row * D) + F.lane;
            float lg[8];
#pragma unroll
            for (int e = 0; e < 8; ++e) lg[e] = 0.f;
#pragma unroll
            for (int j = 0; j < 4; ++j) { const f32x4 y = v[j] * rstd * a0[j] + b0[j]; o0[64 * j] = (v2u){pk2(y.x, y.y), pk2(y.z, y.w)};
#pragma unroll
                for (int e = 0; e < 8; ++e) { const f32x4 w = *(const LAS f32x4*)(wrt + e * 1024 + 4 * F.lane + 256 * j); lg[e] += (y.x * w.x + y.y * w.y) + (y.z * w.z + y.w * w.w); } }
#pragma unroll
            for (int e = 0; e < 8; ++e) lg[e] = wave_sum(lg[e]);
            int e1 = 0; float v1 = lg[0];
#pragma unroll
            for (int e = 1; e < 8; ++e) if (lg[e] > v1) { v1 = lg[e]; e1 = e; }
            int e2 = -1; float v2 = -INFINITY;
#pragma unroll
            for (int e = 0; e < 8; ++e) if (e != e1 && lg[e] > v2) { v2 = lg[e]; e2 = e; }
            const float ex = expf(v2 - v1); const float g1 = 1.0f / (1.0f + ex), g2 = ex / (1.0f + ex);
            cnt += (F.lane == e1 ? 1u : 0u) + (F.lane == e2 ? 1u : 0u);
            if (F.lane == 0) ROUTE[row] = (v4u){(unsigned)e1 | ((unsigned)e2 << 8), __float_as_uint(g1), __float_as_uint(g2), 0u};
        }
        if (F.lane < 8) CNT[c * 8 + F.lane] = cnt;
    }
}

__device__ __forceinline__ void lists_phase(Frame& F) {
    const int gw = F.vcu * NWAVES + F.wave, NGW = F.G * NWAVES;
    const v4u* ROUTE = (const v4u*)(F.ws + WS_ROUTE); const unsigned* CNT = (const unsigned*)(F.ws + WS_CNT);
    int* LIST = (int*)(F.ws + WS_LIST); float* SLOTG = (float*)(F.ws + WS_SLOTG); int* TOKSLOT = (int*)(F.ws + WS_TOKSLOT); int* TILEEXP = (int*)(F.ws + WS_TILEEXP);
    for (int c = gw; c < M / 16; c += NGW) {
        unsigned lt[8], al[8];
#pragma unroll
        for (int e = 0; e < 8; ++e) { lt[e] = 0u; al[e] = 0u; }
        for (int cc = F.lane; cc < M / 16; cc += 64) { const v4u x = *(const v4u*)(CNT + cc * 8), y = *(const v4u*)(CNT + cc * 8 + 4); const bool bl = cc < c;
            al[0] += x.x; al[1] += x.y; al[2] += x.z; al[3] += x.w; al[4] += y.x; al[5] += y.y; al[6] += y.z; al[7] += y.w;
            if (bl) { lt[0] += x.x; lt[1] += x.y; lt[2] += x.z; lt[3] += x.w; lt[4] += y.x; lt[5] += y.y; lt[6] += y.z; lt[7] += y.w; } }
#pragma unroll
        for (int e = 0; e < 8; ++e) {
#pragma unroll
            for (int o = 1; o < 64; o <<= 1) { lt[e] += __shfl_xor(lt[e], o); al[e] += __shfl_xor(al[e], o); } }
        unsigned base[8]; unsigned run = 0u;
#pragma unroll
        for (int e = 0; e < 8; ++e) { base[e] = run; run += (al[e] + 255u) & ~255u; }
        const int row = c * 16 + (F.lane & 15);
        const v4u r = ROUTE[row]; const int e1 = (int)(r.x & 0xffu), e2 = (int)((r.x >> 8) & 0xffu);
        int s1 = 0, s2 = 0;
#pragma unroll
        for (int e = 0; e < 8; ++e) { const bool has = (F.lane < 16) && (e1 == e || e2 == e); const unsigned long long mk = __ballot(has);
            const int rank = __popcll(mk & ((1ull << F.lane) - 1ull)); const int sl = (int)(base[e] + lt[e]) + rank;
            if (e1 == e) s1 = sl; if (e2 == e) s2 = sl; }
        if (F.lane < 16) { LIST[s1] = row; LIST[s2] = row; SLOTG[s1] = __uint_as_float(r.y); SLOTG[s2] = __uint_as_float(r.z); TOKSLOT[row * 2] = s1; TOKSLOT[row * 2 + 1] = s2; }
        if (c == 0) {
#pragma unroll
            for (int e = 0; e < 8; ++e) { const unsigned pe = (al[e] + 255u) & ~255u;
                for (unsigned s = base[e] + al[e] + F.lane; s < base[e] + pe; s += 64) { LIST[s] = 0; SLOTG[s] = 0.f; }
                for (unsigned t = base[e] / 256u + F.lane; t < (base[e] + pe) / 256u; t += 64) TILEEXP[t] = e; }
            if (F.lane == 0) TILEEXP[300] = (int)(run / 256u);
        }
    }
}

__device__ __forceinline__ void final_phase(Frame& F, float* H, const float* gate, const float* gfin) {
    const int gw = F.vcu * NWAVES + F.wave, NGW = F.G * NWAVES;
    const bf16* Y = (const bf16*)(F.ws + A_Y); const int* TOKSLOT = (const int*)(F.ws + WS_TOKSLOT);
    for (int c = gw; c < M / 16; c += NGW) {
        const int row0 = c * 16, b = row0 / SEQ;
        f32x4 gt[4], gf[4];
#pragma unroll
        for (int j = 0; j < 4; ++j) { gt[j] = *(const f32x4*)(gate + b * D + 4 * F.lane + 256 * j); gf[j] = *(const f32x4*)(gfin + 4 * F.lane + 256 * j); }
#pragma unroll 2
        for (int i = 0; i < 16; ++i) { const size_t row = (size_t)(row0 + i);
            const int s1 = TOKSLOT[row * 2], s2 = TOKSLOT[row * 2 + 1];
            GAS f32x4* xr = (GAS f32x4*)(H + row * D) + F.lane;
            const GAS v2u* y1 = (const GAS v2u*)(Y + (size_t)s1 * D) + F.lane; const GAS v2u* y2 = (const GAS v2u*)(Y + (size_t)s2 * D) + F.lane;
            f32x4 v[4]; float s = 0.f;
#pragma unroll
            for (int j = 0; j < 4; ++j) { const f32x4 h = xr[64 * j]; const v2u p = y1[64 * j], q = y2[64 * j];
                f32x4 yy; yy.x = bf_lo(p.x) + bf_lo(q.x); yy.y = bf_hi(p.x) + bf_hi(q.x); yy.z = bf_lo(p.y) + bf_lo(q.y); yy.w = bf_hi(p.y) + bf_hi(q.y);
                v[j] = h + gt[j] * yy; s += (v[j].x * v[j].x + v[j].y * v[j].y) + (v[j].z * v[j].z + v[j].w * v[j].w); }
            const float rstd = 1.0f / sqrtf(wave_sum(s) * (1.f / D) + EPS);
#pragma unroll
            for (int j = 0; j < 4; ++j) xr[64 * j] = v[j] * rstd * gf[j];
        }
    }
}
#ifndef MK_ONE_LAUNCH
#define MK_ONE_LAUNCH 1
#endif
constexpr int N_PHASES = 20;
struct Args { const float* in[26]; float* out; unsigned char* ws; int ph_lo, ph_hi; };
static_assert(sizeof(Args) == 26 * 8 + 8 + 8 + 8, "Args has no padding");

__global__ void __launch_bounds__(NWAVES * 64, 2) mk_fwd(Args args) {
    extern __shared__ __attribute__((aligned(16))) unsigned char lds[];
    Frame F;
    F.lds = (LAS unsigned char*)lds;
    F.MISC = (volatile LAS unsigned*)(F.lds + MISC_OFF);
    F.tid = threadIdx.x; F.lane = F.tid & 63; F.wave = __builtin_amdgcn_readfirstlane(F.tid >> 6);
    F.G = gridDim.x; { const int bx = blockIdx.x; F.vcu = (F.G % 8 == 0) ? (bx % 8) * (F.G / 8) + bx / 8 : bx; }
    F.ws = args.ws; F.out = args.out;
#pragma unroll
    for (int i = 0; i < 26; ++i) F.in[i] = args.in[i];
    unsigned char* const ws = args.ws;
    for (int u = F.tid; u < (LDS_BYTES - LDSCTL_OFF) / 4; u += NWAVES * 64) ((LAS unsigned*)(F.lds + LDSCTL_OFF))[u] = 0u;
    __syncthreads();
    const int lo = args.ph_lo, hi = args.ph_hi;
    XcdBarrier bar; bar.bar = (unsigned*)(ws + WS_CTL) + CW_BAR; bar.x = 0; bar.st = nullptr;
    if (hi - lo > 1) bar = xcd_barrier_post((unsigned*)(ws + WS_CTL) + CW_BAR, F.MISC + 8);
#ifndef PHASE_MASK
#define PHASE_MASK 0xFFFFFu
#endif
#define IN(k) (((PHASE_MASK >> (k)) & 1u) && lo <= (k) && (k) < hi)
#ifndef REPEAT_MASK
#define REPEAT_MASK 0u
#endif
#define REP(k) (((REPEAT_MASK >> (k)) & 1u) ? 2 : 1)
#define SEAM(k) do { if (IN(k) && IN((k) + 1)) xcd_barrier(bar); } while (0)
    const float* MODV = (const float*)(ws + WS_MODV);
#define MV(kind) (MODV + (size_t)(kind) * 4 * D)
    float* const H = args.out;
    bf16* const XN = (bf16*)(ws + A_XN);
    const pg8::MoeInfo mi0{nullptr, nullptr, 0};

    if (IN(0)) for (int rep_ = 0; rep_ < REP(0); ++rep_) { p0_prologue(F); } SEAM(0);
    if (IN(1)) for (int rep_ = 0; rep_ < REP(1); ++rep_) { norm_phase<false>(F, F.in[0], MV(MK_A_MIX0), MV(MK_B_MIX0), XN, nullptr, nullptr, nullptr); } SEAM(1);
    if (IN(2)) for (int rep_ = 0; rep_ < REP(2); ++rep_) { pg8::Gemm g{XN, (const bf16*)(ws + WS_WMLAIN), M, LATP, D}; pg8::StaticOrder S; S.init(M, LATP, F.G, (int)blockIdx.x);
        pg8::EpiBf16 E{(bf16*)(ws + A_LAT), LATP, 1.0f};
        pg8::gemm_phase<pg8::EpiBf16, pg8::StaticOrder, true, true, 0>(F.lds, g, S, E, mi0); } SEAM(2);
    if (IN(3)) for (int rep_ = 0; rep_ < REP(3); ++rep_) { latnorm_phase(F); } SEAM(3);
    if (IN(4)) for (int rep_ = 0; rep_ < REP(4); ++rep_) {
#ifndef P4_SKIP_Q
        { pg8::Gemm g{(const bf16*)(ws + A_QN), (const bf16*)(ws + WS_WQUP), M, QUP, QRANK}; pg8::StaticOrder S; S.init(M, QUP, F.G, (int)blockIdx.x);
          pg8::EpiQ E{(bf16*)(ws + A_Q), QUP, C2_MLA, (const float*)(ws + WS_CS)};
          pg8::gemm_phase<pg8::EpiQ, pg8::StaticOrder, true, true, 0>(F.lds, g, S, E, mi0); }
#endif
#ifndef P4_SKIP_KV
        { pg8::Gemm g{(const bf16*)(ws + A_KVN), (const bf16*)(ws + WS_WKVUP), M, KVUP, KVRANK}; pg8::StaticOrder S; S.init(M, KVUP, F.G, (int)blockIdx.x);
          pg8::EpiKV E{(bf16*)(ws + A_K), (bf16*)(ws + A_V)};
          pg8::gemm_phase<pg8::EpiKV, pg8::StaticOrder, true, true, 0>(F.lds, g, S, E, mi0); }
#endif
    } SEAM(4);
    if (IN(5)) for (int rep_ = 0; rep_ < REP(5); ++rep_) {
        const bf16* Qp = (const bf16*)(ws + A_Q); const bf16* Kp = (const bf16*)(ws + A_K); const bf16* Vp = (const bf16*)(ws + A_V); bf16* Op = (bf16*)(ws + A_O);
        if (F.G == 256) {
            for (int i = 0; i < 8; ++i) { const int bh = (F.vcu >> 3) + 32 * (i >> 2), s = F.vcu & 7, k = i & 3; const int qb = (k == 0) ? s : (k == 1) ? 15 - s : (k == 2) ? 16 + s : 31 - s;
                const int b = bh >> 4, h = bh & 15;
                mla::attn_unit<8>(b, h, qb, Qp, Kp, Vp, Op, (char*)lds); }
        } else {
            for (int u = (int)blockIdx.x; u < BATCH * MLA_H * 32; u += F.G) { const int bh = u >> 5, qb = 31 - (u & 31); const int b = bh >> 4, h = bh & 15;
                mla::attn_unit<8>(b, h, qb, Qp, Kp, Vp, Op, (char*)lds); }
        }
    } SEAM(5);
    if (IN(6)) for (int rep_ = 0; rep_ < REP(6); ++rep_) { pg8::Gemm g{(const bf16*)(ws + A_O), (const bf16*)(ws + WS_WOUT), M, D, D}; pg8::StaticOrder S; S.init(M, D, F.G, (int)blockIdx.x);
        pg8::EpiResid E{F.in[0], H, MV(MK_G_MIX0)};
        pg8::gemm_phase<pg8::EpiResid, pg8::StaticOrder, true, true, 0>(F.lds, g, S, E, mi0); } SEAM(6);
    if (IN(7)) for (int rep_ = 0; rep_ < REP(7); ++rep_) { norm_phase<false>(F, H, MV(MK_A_FFN0), MV(MK_B_FFN0), XN, nullptr, nullptr, nullptr); } SEAM(7);
    if (IN(8)) for (int rep_ = 0; rep_ < REP(8); ++rep_) { pg8::Gemm g{XN, (const bf16*)(ws + WS_WFGU), M, 2 * DFF, D}; pg8::StaticOrder S; S.init(M, 2 * DFF, F.G, (int)blockIdx.x);
        pg8::EpiSwiGLU E{(bf16*)(ws + A_HID), DFF};
        pg8::gemm_phase<pg8::EpiSwiGLU, pg8::StaticOrder, true, true, 0>(F.lds, g, S, E, mi0); } SEAM(8);
    if (IN(9)) for (int rep_ = 0; rep_ < REP(9); ++rep_) { pg8::Gemm g{(const bf16*)(ws + A_HID), (const bf16*)(ws + WS_WFDN), M, D, DFF}; pg8::StaticOrder S; S.init(M, D, F.G, (int)blockIdx.x);
        pg8::EpiResid E{H, H, MV(MK_G_FFN0)};
        pg8::gemm_phase<pg8::EpiResid, pg8::StaticOrder, true, true, 0>(F.lds, g, S, E, mi0); } SEAM(9);
    if (IN(10)) for (int rep_ = 0; rep_ < REP(10); ++rep_) { norm_phase<true>(F, H, MV(MK_A_MIX1), MV(MK_B_MIX1), XN, MV(MK_A_KV), MV(MK_B_KV), (bf16*)(ws + A_XNKV)); } SEAM(10);
    if (IN(11)) for (int rep_ = 0; rep_ < REP(11); ++rep_) {
        { pg8::Gemm g{(const bf16*)(ws + A_XNKV), (const bf16*)(ws + WS_WKVB), M, DILKV, D}; pg8::StaticOrder S; S.init(M, DILKV, F.G, (int)blockIdx.x);
          pg8::EpiBf16 E{(bf16*)(ws + A_KVB), DILKV, 1.0f};
          pg8::gemm_phase<pg8::EpiBf16, pg8::StaticOrder, true, true, 0>(F.lds, g, S, E, mi0); }
        { pg8::Gemm g{XN, (const bf16*)(ws + WS_WQB), M, DILQ, D}; pg8::StaticOrder S; S.init(M, DILQ, F.G, (int)blockIdx.x);
          pg8::EpiBf16 E{(bf16*)(ws + A_QB), DILQ, C2_DIL};
          pg8::gemm_phase<pg8::EpiBf16, pg8::StaticOrder, true, true, 0>(F.lds, g, S, E, mi0); }
    } SEAM(11);
    if (IN(12)) for (int rep_ = 0; rep_ < REP(12); ++rep_) {
        const bf16* Qp = (const bf16*)(ws + A_QB); const bf16* KV = (const bf16*)(ws + A_KVB); bf16* OG = (bf16*)(ws + A_OG); float* LSE = (float*)(ws + WS_LSE); const float* BT = (const float*)(ws + WS_BIAS);
        for (int u = (int)blockIdx.x; u < BATCH * 3 * 32 * 8; u += F.G) { const int h = u & 7, x = (u >> 3) & 31, bg = u >> 8; const int g = bg % 3, b = bg / 3;
            const int dil = (g == 0) ? 1 : (g == 1) ? 4 : 16; const int r = x % dil, qb = x / dil;
            att::attn_unit<64, true>(Qp + g * 512 + h * 64, DILQ, KV + g * 1024 + h * 64, DILKV, KV + g * 1024 + 512 + h * 64, DILKV, OG + (size_t)g * M * DILOUT + h * 64, DILOUT,
                                     LSE + (size_t)g * M * 8 + h, BT + (g * 8 + h) * 132, (long)b * SEQ + r, dil, qb * 256, (char*)lds); }
    } SEAM(12);
    if (IN(13)) for (int rep_ = 0; rep_ < REP(13); ++rep_) { merge_phase(F); } SEAM(13);
    if (IN(14)) for (int rep_ = 0; rep_ < REP(14); ++rep_) { pg8::Gemm g{(const bf16*)(ws + A_OD), (const bf16*)(ws + WS_WOB), M, D, DILOUT}; pg8::StaticOrder S; S.init(M, D, F.G, (int)blockIdx.x);
        pg8::EpiResid E{H, H, MV(MK_G_MIX1)};
        pg8::gemm_phase<pg8::EpiResid, pg8::StaticOrder, true, true, 0>(F.lds, g, S, E, mi0); } SEAM(14);
    if (IN(15)) for (int rep_ = 0; rep_ < REP(15); ++rep_) { router_phase(F, H, MV(MK_A_FFN1), MV(MK_B_FFN1), XN); } SEAM(15);
    if (IN(16)) for (int rep_ = 0; rep_ < REP(16); ++rep_) { lists_phase(F); } SEAM(16);
    if (IN(17)) for (int rep_ = 0; rep_ < REP(17); ++rep_) { const int ntile = ((const int*)(ws + WS_TILEEXP))[300];
        pg8::Gemm g{XN, (const bf16*)(ws + WS_WEGU), ntile * 256, 2 * DFF, D}; pg8::StaticOrder S; S.init(ntile * 256, 2 * DFF, F.G, (int)blockIdx.x);
        pg8::EpiSwiGLU E{(bf16*)(ws + A_HIDS), DFF};
        const pg8::MoeInfo mi{(const int*)(ws + WS_LIST), (const int*)(ws + WS_TILEEXP), (size_t)2 * DFF * D * 2};
        pg8::gemm_phase<pg8::EpiSwiGLU, pg8::StaticOrder, true, true, 1>(F.lds, g, S, E, mi); } SEAM(17);
    if (IN(18)) for (int rep_ = 0; rep_ < REP(18); ++rep_) { const int ntile = ((const int*)(ws + WS_TILEEXP))[300];
        pg8::Gemm g{(const bf16*)(ws + A_HIDS), (const bf16*)(ws + WS_WEDN), ntile * 256, D, DFF}; pg8::StaticOrder S; S.init(ntile * 256, D, F.G, (int)blockIdx.x);
        pg8::EpiMoeDown E{(bf16*)(ws + A_Y), (const float*)(ws + WS_SLOTG)};
        const pg8::MoeInfo mi{(const int*)(ws + WS_LIST), (const int*)(ws + WS_TILEEXP), (size_t)D * DFF * 2};
        pg8::gemm_phase<pg8::EpiMoeDown, pg8::StaticOrder, true, true, 2>(F.lds, g, S, E, mi); } SEAM(18);
    if (IN(19)) for (int rep_ = 0; rep_ < REP(19); ++rep_) { final_phase(F, H, MV(MK_G_FFN1), F.in[25]); }
#undef IN
#undef SEAM
#undef MV
}

extern "C" void kernel_launch(void* const* d_in, const int* in_sizes, int n_in, void* d_out, int out_size, void* d_ws, size_t ws_size, hipStream_t stream) {
    static int grid = 0;
    if (grid == 0) {
        if (n_in != 26 || in_sizes[0] != M * D || out_size != M * D || ws_size < WS_END) { fprintf(stderr, "kernel_launch: unexpected shapes (n_in %d, in0 %d, out %d, ws %zu, need %zu); nothing launched\n", n_in, n_in > 0 ? in_sizes[0] : -1, out_size, ws_size, (size_t)WS_END); grid = -1; return; }
        int dev = 0, cus = 0, per_cu = 0;
        if (hipGetDevice(&dev) != hipSuccess || hipDeviceGetAttribute(&cus, hipDeviceAttributeMultiprocessorCount, dev) != hipSuccess) { grid = -1; return; }
        if (hipFuncSetAttribute((const void*)mk_fwd, hipFuncAttributeMaxDynamicSharedMemorySize, LDS_BYTES) != hipSuccess) { fprintf(stderr, "kernel_launch: hipFuncSetAttribute failed\n"); grid = -1; return; }
        if (hipOccupancyMaxActiveBlocksPerMultiprocessor(&per_cu, (const void*)mk_fwd, NWAVES * 64, LDS_BYTES) != hipSuccess || per_cu < 1) { fprintf(stderr, "kernel_launch: occupancy query reports %d\n", per_cu); }
        (void)hipGetLastError();
        grid = cus;
    }
    if (grid < 0) return;
    if (hipMemsetAsync((char*)d_ws + WS_CTL, 0, CTL_ZERO_BYTES, stream) != hipSuccess) return;
    Args a{};
    for (int i = 0; i < 26; ++i) a.in[i] = (const float*)d_in[i];
    a.out = (float*)d_out; a.ws = (unsigned char*)d_ws;
#if MK_ONE_LAUNCH
    a.ph_lo = 0; a.ph_hi = N_PHASES;
    hipLaunchKernelGGL(mk_fwd, dim3(grid), dim3(NWAVES * 64), LDS_BYTES, stream, a);
#else
    for (int p = 0; p < N_PHASES; ++p) { a.ph_lo = p; a.ph_hi = p + 1; hipLaunchKernelGGL(mk_fwd, dim3(grid), dim3(NWAVES * 64), LDS_BYTES, stream, a); }
#endif
}
```

```cpp
#include <hip/hip_runtime.h>
#include <hip/hip_bf16.h>
#include <cstdio>
#include <cstdint>
#include <cmath>
#ifndef MK_ONE_LAUNCH
#define MK_ONE_LAUNCH 1
#endif
#ifndef PG8_STAGGER
#define PG8_STAGGER 0
#endif
namespace pg8 {
#define PG8_LAS __attribute__((address_space(3)))
typedef unsigned short bf16_t;
typedef short bf16x8 __attribute__((ext_vector_type(8)));
typedef float f32x4 __attribute__((ext_vector_type(4)));
typedef float f32x2 __attribute__((ext_vector_type(2)));
typedef unsigned u32x4 __attribute__((ext_vector_type(4)));
constexpr int BM = 256, BK = 64, HALF = 128, HTB = HALF * BK * 2  , STAGE_BYTES = 8 * HTB, NXCD = 8, WGM = 8;

__host__ __device__ __forceinline__ int lds_byte(int r, int c) { const int st = (r >> 4) * 2 + (c >> 5), rr = r & 15, cc = c & 31, ob = rr * 64 + cc * 2; return st * 1024 + (ob ^ (((ob >> 9) & 1) << 5)); }
__host__ __device__ __forceinline__ void stage_rc(int b, int& R, int& C) { const int st = b / 1024, sb = b % 1024, swz = sb ^ (((sb >> 9) & 1) << 5); R = (st >> 1) * 16 + swz / 64; C = (st & 1) * 32 + (swz % 64) / 2; }
__host__ __device__ __forceinline__ int perm32(int rho) { const int n = rho >> 4, i = rho & 15; return 8 * (i >> 2) + 4 * n + (i & 3); }

struct Unit { int pm, pn; };
struct Gemm { const bf16_t* A; const bf16_t* Bt; int M, N, K; };
struct MoeInfo { const int* list; const int* tile_expert; size_t bstride; };

struct StaticOrder {
    int nM, nN, nwg, G, c;
    __host__ __device__ void init(int M, int N, int G_, int c_) { nM = M / BM; nN = N / BM; nwg = nM * nN; G = G_; c = c_; }
    __host__ __device__ bool next(int i, Unit& u) const {
        const long L = (long)i * G + c; if (L >= nwg) return false;
        int wgid = (int)L; { const int q = nwg / NXCD, r = nwg % NXCD, xcd = wgid % NXCD, off = wgid / NXCD; wgid = (xcd < r ? xcd * (q + 1) : r * (q + 1) + (xcd - r) * q) + off; }
        const int nig = WGM * nN, gid = wgid / nig, fm = gid * WGM, gsz = (nM - fm) < WGM ? (nM - fm) : WGM;
        u.pm = fm + ((wgid % nig) % gsz); u.pn = (wgid % nig) / gsz; return true;
    }
    __device__ __forceinline__ void a_ready(const Unit&) const {}
    __device__ __forceinline__ void done(const Unit&) const {}
};

__device__ __forceinline__ unsigned cvt_pk_bf16(float lo, float hi) { unsigned r; asm volatile("v_cvt_pk_bf16_f32 %0, %1, %2" : "=v"(r) : "v"(lo), "v"(hi)); return r; }


template <class Epi, class Sched, bool ALIGN_EPI, bool SP2, int MODE>
__device__ __forceinline__ void gemm_phase(PG8_LAS unsigned char* lds, const Gemm g, const Sched& S, const Epi& E, const MoeInfo mi) {
    const int tid = threadIdx.x, wid = __builtin_amdgcn_readfirstlane(tid >> 6), lane = tid & 63, wr = wid >> 2, wc = wid & 3, fr = lane & 15, fq = lane >> 4;
    int K_ = g.K; asm volatile("" : "+s"(K_));
    const int K = K_, nt = K / BK;
    unsigned voffB[2]; int Rr[2], Cc[2];
#pragma unroll
    for (int i = 0; i < 2; ++i) { int R, C; stage_rc(tid * 16 + i * 8192, R, C); const int Rb = Epi::PERM ? ((R & ~31) + perm32(R & 31)) : R;
        Rr[i] = R; Cc[i] = C; voffB[i] = (unsigned)(Rb * K + C) * 2u; }
    const size_t kstep = (size_t)(BK * 2);
    const size_t hstep = (size_t)HALF * K * 2;
    const size_t tstep = 2 * hstep;
    const unsigned ldsw = (unsigned)wid * 1024u;
    const int aoff = lds_byte(wr * 64 + fr, fq * 8), boff = lds_byte(wc * 32 + fr, fq * 8);
    const unsigned rowb = (unsigned)K * 2u;
#define PG8_SA(b, h) (((b) * 2 + (h)) * HTB)
#define PG8_SB(b, h) ((4 + (b) * 2 + (h)) * HTB)
#define PG8_STAGE(bufoff, gbase, voff) do { _Pragma("unroll") for (int _i = 0; _i < 2; ++_i) \
        __builtin_amdgcn_global_load_lds((const unsigned*)((const char*)(gbase) + (voff)[_i]), (PG8_LAS unsigned*)(lds + (bufoff) + ldsw + _i * 8192), 16, 0, 0); } while (0)
#define PG8_LDA(dst, b, h) do { _Pragma("unroll") for (int m = 0; m < 4; ++m) _Pragma("unroll") for (int k = 0; k < 2; ++k) dst[m][k] = *(const PG8_LAS bf16x8*)(lds + PG8_SA(b, h) + aoff + m * 2048 + k * 1024); } while (0)
#define PG8_LDB(dst, b, h) do { _Pragma("unroll") for (int n = 0; n < 2; ++n) _Pragma("unroll") for (int k = 0; k < 2; ++k) dst[n][k] = *(const PG8_LAS bf16x8*)(lds + PG8_SB(b, h) + boff + n * 2048 + k * 1024); } while (0)
#define PG8_MMA(ai, bj, At, Bt) do { __builtin_amdgcn_s_setprio(1); _Pragma("unroll") for (int m = 0; m < 4; ++m) _Pragma("unroll") for (int n = 0; n < 2; ++n) _Pragma("unroll") for (int k = 0; k < 2; ++k) \
        acc[ai][bj][m][n] = __builtin_amdgcn_mfma_f32_16x16x32_bf16(Bt[n][k], At[m][k], acc[ai][bj][m][n], 0, 0, 0); __builtin_amdgcn_s_setprio(0); } while (0)
#define PG8_WAIT_V(n) asm volatile("s_waitcnt vmcnt(" #n ")" ::: "memory")
#define PG8_WAIT_L(n) asm volatile("s_waitcnt lgkmcnt(" #n ")" ::: "memory")
#define PG8_BAR __builtin_amdgcn_s_barrier()
#define PG8_SCHED __builtin_amdgcn_sched_barrier(0)
#define PG8_MKOFF(u, o) do { _Pragma("unroll") for (int _h = 0; _h < 2; ++_h) _Pragma("unroll") for (int _i = 0; _i < 2; ++_i) { \
        int _row = (u).pm * BM + _h * HALF + Rr[_i]; if (MODE == 1) _row = mi.list[_row]; (o)[_h][_i] = (unsigned)_row * rowb + (unsigned)Cc[_i] * 2u; } } while (0)
#define PG8_BBASE(u) ((const char*)g.Bt + (size_t)(u).pn * tstep + (MODE != 0 ? (size_t)mi.tile_expert[(u).pm] * mi.bstride : (size_t)0))
    Unit cur, nxt; int ui = 0;
    if (!S.next(0, cur)) return;
#if PG8_STAGGER
    {
        const int grp = ((int)blockIdx.x >> 3) & 3;
        if (grp) { if (wid == 0) { const unsigned long long t0 = __builtin_amdgcn_s_memrealtime(); const unsigned long long dt = (unsigned long long)(grp * nt * PG8_STAGGER);
                       while (__builtin_amdgcn_s_memrealtime() - t0 < dt) __builtin_amdgcn_s_sleep(8); }
                   __syncthreads(); }
    }
#endif
    f32x4 acc[2][2][4][2];
#pragma unroll
    for (int a = 0; a < 2; ++a)
#pragma unroll
        for (int b = 0; b < 2; ++b)
#pragma unroll
            for (int m = 0; m < 4; ++m)
#pragma unroll
                for (int n = 0; n < 2; ++n) acc[a][b][m][n] = (f32x4){0.f, 0.f, 0.f, 0.f};
    bf16x8 At[4][2], B0[2][2], B1[2][2];
    unsigned oc[2][2], on[2][2];
    PG8_MKOFF(cur, oc);
    const char* const Ab = (const char*)g.A;
    const char* cB = PG8_BBASE(cur);
    S.a_ready(cur);
    static_assert(SP2, "only the SP2 loop is kept");
    {
        PG8_STAGE(PG8_SB(0, 0), cB, voffB); PG8_STAGE(PG8_SB(0, 1), cB + hstep, voffB); PG8_STAGE(PG8_SA(0, 0), Ab, oc[0]); PG8_STAGE(PG8_SA(0, 1), Ab, oc[1]);
        if (wr == 1) PG8_BAR;
        PG8_WAIT_V(2); PG8_BAR;
        PG8_STAGE(PG8_SB(1, 0), cB + kstep, voffB); PG8_STAGE(PG8_SA(1, 0), Ab + kstep, oc[0]); PG8_STAGE(PG8_SB(1, 1), cB + hstep + kstep, voffB);
        PG8_WAIT_V(6); PG8_BAR;
    }
    for (;;) {
        const bool has_next = S.next(ui + 1, nxt);
        const char* nB = cB;
        if (has_next) { PG8_MKOFF(nxt, on); nB = PG8_BBASE(nxt); }
        else {
#pragma unroll
            for (int _h = 0; _h < 2; ++_h)
#pragma unroll
                for (int _i = 0; _i < 2; ++_i) on[_h][_i] = oc[_h][_i];
        }
        for (int t = 0; t < nt; t += 2) {
            const bool last = (t == nt - 2);
            const char* a1 = Ab + (size_t)(t + 1) * kstep;
            const char* a2 = last ? Ab : Ab + (size_t)(t + 2) * kstep; const char* b2 = last ? nB : cB + (size_t)(t + 2) * kstep;
            const char* a3 = a2 + kstep; const char* b3 = b2 + kstep;
            unsigned o2[2][2];
#pragma unroll
            for (int _h = 0; _h < 2; ++_h)
#pragma unroll
                for (int _i = 0; _i < 2; ++_i) o2[_h][_i] = last ? on[_h][_i] : oc[_h][_i];
            if (last && has_next) S.a_ready(nxt);
            PG8_LDB(B0, 0, 0); PG8_LDB(B1, 0, 1); PG8_SCHED; PG8_LDA(At, 0, 0); PG8_STAGE(PG8_SA(1, 1), a1, oc[1]);
            PG8_WAIT_V(8); PG8_WAIT_L(0); PG8_BAR; PG8_MMA(0, 0, At, B0); PG8_MMA(0, 1, At, B1); PG8_BAR; PG8_SCHED;
            PG8_LDA(At, 0, 1); PG8_STAGE(PG8_SB(0, 0), b2, voffB); PG8_STAGE(PG8_SB(0, 1), b2 + hstep, voffB); PG8_STAGE(PG8_SA(0, 0), a2, o2[0]);
            PG8_WAIT_V(8); PG8_WAIT_L(0); PG8_BAR; PG8_MMA(1, 0, At, B0); PG8_MMA(1, 1, At, B1); PG8_BAR; PG8_SCHED;
            PG8_LDB(B0, 1, 0); PG8_LDB(B1, 1, 1); PG8_SCHED; PG8_LDA(At, 1, 0); PG8_STAGE(PG8_SA(0, 1), a2, o2[1]);
            PG8_WAIT_V(8); PG8_WAIT_L(0); PG8_BAR; PG8_MMA(0, 0, At, B0); PG8_MMA(0, 1, At, B1); PG8_BAR; PG8_SCHED;
            PG8_LDA(At, 1, 1); PG8_STAGE(PG8_SB(1, 0), b3, voffB); PG8_STAGE(PG8_SB(1, 1), b3 + hstep, voffB); PG8_STAGE(PG8_SA(1, 0), a3, o2[0]);
            PG8_WAIT_V(8); PG8_WAIT_L(0); PG8_BAR; PG8_MMA(1, 0, At, B0); PG8_MMA(1, 1, At, B1); PG8_BAR; PG8_SCHED;
        }
        if constexpr (ALIGN_EPI) { if (wr == 0) PG8_BAR; }
        E(acc, cur, wr, wc, fr, fq); S.done(cur);
        if (!has_next) break;
#pragma unroll
        for (int a = 0; a < 2; ++a)
#pragma unroll
            for (int b = 0; b < 2; ++b)
#pragma unroll
                for (int m = 0; m < 4; ++m)
#pragma unroll
                    for (int n = 0; n < 2; ++n) acc[a][b][m][n] = (f32x4){0.f, 0.f, 0.f, 0.f};
        cur = nxt; cB = nB; ++ui;
#pragma unroll
        for (int _h = 0; _h < 2; ++_h)
#pragma unroll
            for (int _i = 0; _i < 2; ++_i) oc[_h][_i] = on[_h][_i];
        if constexpr (ALIGN_EPI) { if (wr == 1) PG8_BAR; }
    }
    PG8_WAIT_V(0);
    if constexpr (!ALIGN_EPI) { if (wr == 0) PG8_BAR; }
    PG8_BAR;
#undef PG8_SA
#undef PG8_SB
#undef PG8_STAGE
#undef PG8_LDA
#undef PG8_LDB
#undef PG8_MMA
#undef PG8_WAIT_V
#undef PG8_WAIT_L
#undef PG8_BAR
#undef PG8_SCHED
#undef PG8_MKOFF
#undef PG8_BBASE
}
}
namespace pg8 {
constexpr float LOG2E = 1.4426950408889634f;
struct EpiBf16 {
    static constexpr bool PERM = true;
    bf16_t* O; int ldc; float scale;
    __device__ __forceinline__ void operator()(const f32x4 (&acc)[2][2][4][2], const Unit& u, int wr, int wc, int fr, int fq) const {
        const int row0 = u.pm * BM + wr * 64 + fr; const int col0 = u.pn * BM + wc * 32 + 8 * fq;
#pragma unroll
        for (int ai = 0; ai < 2; ++ai)
#pragma unroll
            for (int m = 0; m < 4; ++m) { bf16_t* rowp = O + (size_t)(row0 + ai * HALF + m * 16) * ldc + col0;
#pragma unroll
                for (int bj = 0; bj < 2; ++bj) { const f32x4 v0 = acc[ai][bj][m][0] * scale, v1 = acc[ai][bj][m][1] * scale;
                    u32x4 w; w.x = cvt_pk_bf16(v0[0], v0[1]); w.y = cvt_pk_bf16(v0[2], v0[3]); w.z = cvt_pk_bf16(v1[0], v1[1]); w.w = cvt_pk_bf16(v1[2], v1[3]);
                    *(u32x4*)(rowp + bj * HALF) = w; } }
    }
};
struct EpiQ {
    static constexpr bool PERM = true;
    bf16_t* O; int ldc; float scale; const float* cs;
    __device__ __forceinline__ void operator()(const f32x4 (&acc)[2][2][4][2], const Unit& u, int wr, int wc, int fr, int fq) const {
        const int row0 = u.pm * BM + wr * 64 + fr; const int col0 = u.pn * BM + wc * 32 + 8 * fq;
        const int grp = u.pn * 8 + wc;
#pragma unroll
        for (int bj = 0; bj < 2; ++bj) { const bool rope = ((grp + 4 * bj) % 3) == 2;
#pragma unroll
            for (int ai = 0; ai < 2; ++ai)
#pragma unroll
                for (int m = 0; m < 4; ++m) { const int row = row0 + ai * HALF + m * 16; bf16_t* rowp = O + (size_t)row * ldc + col0 + bj * HALF;
                    f32x4 v0 = acc[ai][bj][m][0] * scale, v1 = acc[ai][bj][m][1] * scale;
                    if (rope) { const f32x4* cp = (const f32x4*)(cs + (size_t)row * 32 + 8 * fq); const f32x4 c0 = cp[0], c1 = cp[1];
                        f32x4 r0, r1;
                        r0[0] = v0[0] * c0[0] - v0[1] * c0[1]; r0[1] = v0[0] * c0[1] + v0[1] * c0[0];
                        r0[2] = v0[2] * c0[2] - v0[3] * c0[3]; r0[3] = v0[2] * c0[3] + v0[3] * c0[2];
                        r1[0] = v1[0] * c1[0] - v1[1] * c1[1]; r1[1] = v1[0] * c1[1] + v1[1] * c1[0];
                        r1[2] = v1[2] * c1[2] - v1[3] * c1[3]; r1[3] = v1[2] * c1[3] + v1[3] * c1[2];
                        v0 = r0; v1 = r1; }
                    u32x4 w; w.x = cvt_pk_bf16(v0[0], v0[1]); w.y = cvt_pk_bf16(v0[2], v0[3]); w.z = cvt_pk_bf16(v1[0], v1[1]); w.w = cvt_pk_bf16(v1[2], v1[3]);
                    *(u32x4*)rowp = w;
                    if (m & 1) asm volatile("" ::: "memory"); } }
    }
};
struct EpiKV {
    static constexpr bool PERM = true;
    bf16_t* Kb; bf16_t* Vb;
    __device__ __forceinline__ void operator()(const f32x4 (&acc)[2][2][4][2], const Unit& u, int wr, int wc, int fr, int fq) const {
        const int row0 = u.pm * BM + wr * 64 + fr;
        const bool isk = wc < 2;
        bf16_t* const base = isk ? Kb : Vb; const int pitch = isk ? 1536 : 1024, hs = isk ? 96 : 64, j0 = (isk ? wc : wc - 2) * 32 + 8 * fq;
#pragma unroll
        for (int ai = 0; ai < 2; ++ai)
#pragma unroll
            for (int m = 0; m < 4; ++m) { bf16_t* rowp = base + (size_t)(row0 + ai * HALF + m * 16) * pitch + j0;
#pragma unroll
                for (int bj = 0; bj < 2; ++bj) { const f32x4 v0 = acc[ai][bj][m][0], v1 = acc[ai][bj][m][1];
                    u32x4 w; w.x = cvt_pk_bf16(v0[0], v0[1]); w.y = cvt_pk_bf16(v0[2], v0[3]); w.z = cvt_pk_bf16(v1[0], v1[1]); w.w = cvt_pk_bf16(v1[2], v1[3]);
                    *(u32x4*)(rowp + (2 * u.pn + bj) * hs) = w; } }
    }
};
template <bool BASEF32> struct EpiResid {
    static constexpr bool PERM = true;
    static constexpr int HP = 2048;
    const void* base; bf16_t* out; const float* gate;
    __device__ __forceinline__ void operator()(const f32x4 (&acc)[2][2][4][2], const Unit& u, int wr, int wc, int fr, int fq) const {
        const int row0 = u.pm * BM + wr * 64 + fr; const int col0 = u.pn * BM + wc * 32 + 8 * fq;
        const float* gp = gate + (size_t)((u.pm * BM) >> 13) * 1024 + col0;
        f32x4 gv[2][2];
#pragma unroll
        for (int bj = 0; bj < 2; ++bj)
#pragma unroll
            for (int n = 0; n < 2; ++n) gv[bj][n] = *(const f32x4*)(gp + bj * HALF + n * 4);
#pragma unroll
        for (int ai = 0; ai < 2; ++ai)
#pragma unroll
            for (int m = 0; m < 4; ++m) { const size_t row = (size_t)(row0 + ai * HALF + m * 16);
#pragma unroll
                for (int bj = 0; bj < 2; ++bj) { f32x4 b0, b1;
                    if (BASEF32) { const float* bp = (const float*)base + row * 1024 + col0 + bj * HALF; b0 = *(const f32x4*)bp; b1 = *(const f32x4*)(bp + 4); }
                    else { const u32x4 hb = *(const u32x4*)((const bf16_t*)base + row * HP + col0 + bj * HALF);
                        b0 = (f32x4){__builtin_bit_cast(float, hb.x << 16), __builtin_bit_cast(float, hb.x & 0xffff0000u), __builtin_bit_cast(float, hb.y << 16), __builtin_bit_cast(float, hb.y & 0xffff0000u)};
                        b1 = (f32x4){__builtin_bit_cast(float, hb.z << 16), __builtin_bit_cast(float, hb.z & 0xffff0000u), __builtin_bit_cast(float, hb.w << 16), __builtin_bit_cast(float, hb.w & 0xffff0000u)}; }
                    const f32x4 v0 = b0 + gv[bj][0] * acc[ai][bj][m][0], v1 = b1 + gv[bj][1] * acc[ai][bj][m][1];
                    u32x4 w; w.x = cvt_pk_bf16(v0[0], v0[1]); w.y = cvt_pk_bf16(v0[2], v0[3]); w.z = cvt_pk_bf16(v1[0], v1[1]); w.w = cvt_pk_bf16(v1[2], v1[3]);
                    *(u32x4*)(out + row * HP + col0 + bj * HALF) = w; }
                if (m & 1) asm volatile("" ::: "memory"); }
    }
};
__device__ __forceinline__ float silu_mul(float g, float u) { return g * u * __builtin_amdgcn_rcpf(1.0f + __builtin_amdgcn_exp2f(-g * LOG2E)); }
struct EpiSwiGLU {
    static constexpr bool PERM = true;
    bf16_t* O; int ldc;
    __device__ __forceinline__ void operator()(const f32x4 (&acc)[2][2][4][2], const Unit& u, int wr, int wc, int fr, int fq) const {
        const int row0 = u.pm * BM + wr * 64 + fr; const int col0 = u.pn * HALF + wc * 32 + 8 * fq;
#pragma unroll
        for (int ai = 0; ai < 2; ++ai)
#pragma unroll
            for (int m = 0; m < 4; ++m) { bf16_t* rowp = O + (size_t)(row0 + ai * HALF + m * 16) * ldc + col0;
                const f32x4 g0 = acc[ai][0][m][0], g1 = acc[ai][0][m][1], u0 = acc[ai][1][m][0], u1 = acc[ai][1][m][1];
                u32x4 w; w.x = cvt_pk_bf16(silu_mul(g0[0], u0[0]), silu_mul(g0[1], u0[1])); w.y = cvt_pk_bf16(silu_mul(g0[2], u0[2]), silu_mul(g0[3], u0[3]));
                w.z = cvt_pk_bf16(silu_mul(g1[0], u1[0]), silu_mul(g1[1], u1[1])); w.w = cvt_pk_bf16(silu_mul(g1[2], u1[2]), silu_mul(g1[3], u1[3]));
                *(u32x4*)rowp = w; }
    }
};
struct EpiMoeDown {
    static constexpr bool PERM = true;
    bf16_t* O; const float* sg;
    __device__ __forceinline__ void operator()(const f32x4 (&acc)[2][2][4][2], const Unit& u, int wr, int wc, int fr, int fq) const {
        const int row0 = u.pm * BM + wr * 64 + fr; const int col0 = u.pn * BM + wc * 32 + 8 * fq;
#pragma unroll
        for (int ai = 0; ai < 2; ++ai)
#pragma unroll
            for (int m = 0; m < 4; ++m) { const int row = row0 + ai * HALF + m * 16; const float s = sg[row]; bf16_t* rowp = O + (size_t)row * 1024 + col0;
#pragma unroll
                for (int bj = 0; bj < 2; ++bj) { const f32x4 v0 = acc[ai][bj][m][0] * s, v1 = acc[ai][bj][m][1] * s;
                    u32x4 w; w.x = cvt_pk_bf16(v0[0], v0[1]); w.y = cvt_pk_bf16(v0[2], v0[3]); w.z = cvt_pk_bf16(v1[0], v1[1]); w.w = cvt_pk_bf16(v1[2], v1[3]);
                    *(u32x4*)(rowp + bj * HALF) = w; } }
    }
};
}
namespace att {
using bf16 = unsigned short;
using bf16x8 = __attribute__((ext_vector_type(8))) short;
using s16x4 = __attribute__((ext_vector_type(4))) short;
using f32x16 = __attribute__((ext_vector_type(16))) float;
using u32x4 = __attribute__((ext_vector_type(4))) unsigned;
constexpr int NW = 8;
constexpr float THR = 8.0f;
__device__ __forceinline__ int crow(int r, int hi) { return (r & 3) + 8 * (r >> 2) + 4 * hi; }
__device__ __forceinline__ void glds16(const void* gsrc, unsigned lds_dst) { unsigned keep;
    asm volatile("s_mov_b32 %0, m0\n\ts_mov_b32 m0, %2\n\ts_nop 0\n\tglobal_load_lds_dwordx4 %1, off\n\ts_mov_b32 m0, %0" : "=&s"(keep) : "v"(gsrc), "s"(lds_dst) : "memory"); }
typedef float f32x2_t __attribute__((ext_vector_type(2))); typedef __bf16 bf16x2_t __attribute__((ext_vector_type(2)));
__device__ __forceinline__ unsigned cvtpk_s(float lo, float hi) { f32x2_t v = {lo, hi}; bf16x2_t b = __builtin_convertvector(v, bf16x2_t); return __builtin_bit_cast(unsigned, b); }
#define ATT_SBAR() __builtin_amdgcn_sched_barrier(0)
#define ATT_WAIT_BAR(N) asm volatile("s_waitcnt vmcnt(" #N ") lgkmcnt(0)\n\ts_barrier" ::: "memory")

template <int DQK> struct Lay {
    static constexpr int NKC = DQK / 8, KSLOT = NKC * 1024, ND0 = DQK / 16;
    static constexpr int LK = 0, LV = 3 * KSLOT, LWS = LV + 3 * 8192, LOST = LWS + NW * 256, LBIAS = LOST + NW * 4096, LEND = LBIAS + 1024;
};
static_assert(Lay<96>::LEND <= 131072 && Lay<64>::LEND <= 131072, "attention LDS");

__device__ __forceinline__ float rowmax32(const f32x16& p0, const f32x16& p1) {
    float a = __builtin_fmaxf(__builtin_fmaxf(p0[0], p0[1]), p1[0]), b = __builtin_fmaxf(__builtin_fmaxf(p0[2], p0[3]), p1[1]); a = __builtin_fmaxf(__builtin_fmaxf(a, p1[2]), p1[3]);
#pragma unroll
    for (int r = 4; r < 16; r += 4) { a = __builtin_fmaxf(__builtin_fmaxf(a, p0[r]), p0[r + 1]); b = __builtin_fmaxf(__builtin_fmaxf(b, p0[r + 2]), p0[r + 3]); a = __builtin_fmaxf(__builtin_fmaxf(a, p1[r]), p1[r + 1]); b = __builtin_fmaxf(__builtin_fmaxf(b, p1[r + 2]), p1[r + 3]); }
    float m = __builtin_fmaxf(a, b);
    auto rr = __builtin_amdgcn_permlane32_swap(__float_as_uint(m), __float_as_uint(m), false, false);
    return __builtin_fmaxf(__uint_as_float(rr[0]), __uint_as_float(rr[1]));
}
__device__ __forceinline__ void pv(f32x16* o, int vb, bf16x8 pa0, bf16x8 pa1, bf16x8 pa2, bf16x8 pa3) {
#pragma unroll
    for (int d0 = 0; d0 < 2; ++d0) { s16x4 lo[4], hi[4];
#pragma unroll
        for (int ks = 0; ks < 4; ++ks) {
            asm volatile("ds_read_b64_tr_b16 %0,%1 offset:%c2" : "=&v"(lo[ks]) : "v"(vb), "i"(d0 * 4096 + ks * 1024) : "memory");
            asm volatile("ds_read_b64_tr_b16 %0,%1 offset:%c2" : "=&v"(hi[ks]) : "v"(vb), "i"(d0 * 4096 + ks * 1024 + 512) : "memory"); }
        asm volatile("s_waitcnt lgkmcnt(0)" ::: "memory"); ATT_SBAR();
#define ATT_PK(k) (bf16x8){lo[k][0], lo[k][1], lo[k][2], lo[k][3], hi[k][0], hi[k][1], hi[k][2], hi[k][3]}
        o[d0] = __builtin_amdgcn_mfma_f32_32x32x16_bf16(pa0, ATT_PK(0), o[d0], 0, 0, 0);
        o[d0] = __builtin_amdgcn_mfma_f32_32x32x16_bf16(pa1, ATT_PK(1), o[d0], 0, 0, 0);
        o[d0] = __builtin_amdgcn_mfma_f32_32x32x16_bf16(pa2, ATT_PK(2), o[d0], 0, 0, 0);
        o[d0] = __builtin_amdgcn_mfma_f32_32x32x16_bf16(pa3, ATT_PK(3), o[d0], 0, 0, 0);
#undef ATT_PK
    }
}

template <int DQK, bool DIL>
__device__ __forceinline__ void attn_unit(const bf16* Qb, int pq, const bf16* __restrict__ Kb, int pk, const bf16* __restrict__ Vb, int pvp, bf16* Ob, int po, float* lse, const float* biasg,
                                          long rowbase, int dil, int q0, char* shm) {
    typedef Lay<DQK> L;
    const int tid = threadIdx.x, lane = tid & 63, r32 = lane & 31, hi = lane >> 5; const int wid = __builtin_amdgcn_readfirstlane(tid >> 6);
    const unsigned lds0 = (unsigned)(uintptr_t)shm;
    float* wsf = (float*)(shm + L::LWS) + wid * 64;
    const int kpos0 = DIL ? q0 - 128 : 0;
    const int t_begin = DIL ? (q0 == 0 ? 2 : 0) : 0;
    const int t_end = DIL ? 6 : (q0 + 256) / 64;
    const int wt0 = DIL ? (wid >> 1) : 0;
    const int wt1 = DIL ? 2 + (wid >> 1) : (q0 + 32 * wid + 31) / 64;
    const bool two_k = (L::NKC > 8) && (wid + 8 < L::NKC);
#define ATT_GROW(pos) (rowbase + (long)(pos) * dil)
#define ATT_ISSUE(t, s) do { const int kp_ = kpos0 + 64 * (t); \
        glds16(Kb + ATT_GROW(kp_ + lane) * pk + wid * 8, (unsigned)__builtin_amdgcn_readfirstlane(lds0 + L::LK + (s) * L::KSLOT + wid * 1024)); \
        if (two_k) glds16(Kb + ATT_GROW(kp_ + lane) * pk + (wid + 8) * 8, (unsigned)__builtin_amdgcn_readfirstlane(lds0 + L::LK + (s) * L::KSLOT + (wid + 8) * 1024)); \
        glds16(Vb + ATT_GROW(kp_ + 16 * (wid & 3) + (lane >> 2)) * pvp + (wid >> 2) * 32 + (lane & 3) * 8, (unsigned)__builtin_amdgcn_readfirstlane(lds0 + L::LV + (s) * 8192 + wid * 1024)); } while (0)
    if (DIL) { if (tid < 129) ((float*)(shm + L::LBIAS))[tid] = biasg[tid]; }
    ATT_ISSUE(t_begin, 0);
    if (t_begin + 1 < t_end) ATT_ISSUE(t_begin + 1, 1);
    bf16x8 qr[L::ND0];
    { const bf16* Qw = Qb + ATT_GROW(q0 + wid * 32 + r32) * pq + hi * 8;
#pragma unroll
      for (int d0 = 0; d0 < L::ND0; ++d0) qr[d0] = *reinterpret_cast<const bf16x8*>(Qw + d0 * 16); }
    float mhat = 0.f, l_reg = 0.f; f32x16 o[2]; o[0] = f32x16{}; o[1] = f32x16{}; f32x16 negm = f32x16{};
    bool first = true;
    const int qrel = (DIL ? 128 : q0) + wid * 32 + r32;
    const int vbl = (int)(lds0 + L::LV) + ((lane >> 4) & 1) * 32 + (lane & 3) * 8 + (4 * hi + ((lane & 15) >> 2)) * 64;
    int slot = 0;
    for (int t = t_begin; t < t_end; ++t) {
        if (t + 1 < t_end) { if (two_k) ATT_WAIT_BAR(3); else ATT_WAIT_BAR(2); } else ATT_WAIT_BAR(0);
        if (t + 2 < t_end) { const int s2 = slot >= 1 ? slot - 1 : 2; ATT_ISSUE(t + 2, s2); }
        if (t >= wt0 && t <= wt1) {
            f32x16 p0, p1;
            { const char* kb = shm + L::LK + slot * L::KSLOT + hi * 1024 + r32 * 16;
#pragma unroll
              for (int d0 = 0; d0 < L::ND0; ++d0) {
                const bf16x8 b0 = *reinterpret_cast<const bf16x8*>(kb + d0 * 2048);
                const bf16x8 b1 = *reinterpret_cast<const bf16x8*>(kb + d0 * 2048 + 512);
                if (d0 == 0) { p0 = __builtin_amdgcn_mfma_f32_32x32x16_bf16(b0, qr[0], negm, 0, 0, 0); p1 = __builtin_amdgcn_mfma_f32_32x32x16_bf16(b1, qr[0], negm, 0, 0, 0); }
                else { p0 = __builtin_amdgcn_mfma_f32_32x32x16_bf16(b0, qr[d0], p0, 0, 0, 0); p1 = __builtin_amdgcn_mfma_f32_32x32x16_bf16(b1, qr[d0], p1, 0, 0, 0); } } }
            if (DIL) { const float* bl = (const float*)(shm + L::LBIAS); const int jb = qrel - 64 * t - 4 * hi;
#pragma unroll
                for (int r = 0; r < 16; ++r) { const int j0 = jb - ((r & 3) + 8 * (r >> 2)), j1 = j0 - 32;
                    const int c0 = j0 < 0 ? 0 : (j0 > 128 ? 128 : j0), c1 = j1 < 0 ? 0 : (j1 > 128 ? 128 : j1);
                    const float b0 = bl[c0], b1 = bl[c1];
                    p0[r] = (j0 >= 0 && j0 <= 128) ? p0[r] + b0 : -INFINITY; p1[r] = (j1 >= 0 && j1 <= 128) ? p1[r] + b1 : -INFINITY; }
            } else if (64 * t + 63 > q0 + 32 * wid) { const int jb = qrel - 64 * t - 4 * hi;
#pragma unroll
                for (int r = 0; r < 16; ++r) { const int j0 = jb - ((r & 3) + 8 * (r >> 2)); if (j0 < 0) p0[r] = -INFINITY; if (j0 - 32 < 0) p1[r] = -INFINITY; } }
            const float rm = rowmax32(p0, p1);
            if (first) { first = false; const float dl = rm; mhat += dl;
#pragma unroll
                for (int r = 0; r < 16; ++r) { p0[r] -= dl; p1[r] -= dl; }
#pragma unroll
                for (int r = 0; r < 16; ++r) negm[r] = -mhat;
            } else if (__any(rm > THR)) { const float dl = __builtin_fmaxf(rm, 0.f); mhat += dl;
#pragma unroll
                for (int r = 0; r < 16; ++r) { p0[r] -= dl; p1[r] -= dl; }
#pragma unroll
                for (int r = 0; r < 16; ++r) negm[r] = -mhat;
                const float f = __builtin_amdgcn_exp2f(-dl); l_reg *= f; if (hi == 0) wsf[r32] = f;
                asm volatile("s_waitcnt lgkmcnt(0)" ::: "memory");
#pragma unroll
                for (int d_ = 0; d_ < 2; ++d_)
#pragma unroll
                    for (int r = 0; r < 16; ++r) o[d_][r] *= wsf[crow(r, hi)];
                asm volatile("s_waitcnt lgkmcnt(0)" ::: "memory");
            }
            float sacc = 0.f;
#pragma unroll
            for (int r = 0; r < 16; ++r) { p0[r] = __builtin_amdgcn_exp2f(p0[r]); p1[r] = __builtin_amdgcn_exp2f(p1[r]); sacc += p0[r] + p1[r]; }
            l_reg += sacc;
            u32x4 pw0, pw1, pw2, pw3;
#define ATT_PKW(P, B) cvtpk_s(P[B], P[B + 1])
            pw0 = (u32x4){ATT_PKW(p0, 0), ATT_PKW(p0, 2), ATT_PKW(p0, 4), ATT_PKW(p0, 6)}; pw1 = (u32x4){ATT_PKW(p0, 8), ATT_PKW(p0, 10), ATT_PKW(p0, 12), ATT_PKW(p0, 14)};
            pw2 = (u32x4){ATT_PKW(p1, 0), ATT_PKW(p1, 2), ATT_PKW(p1, 4), ATT_PKW(p1, 6)}; pw3 = (u32x4){ATT_PKW(p1, 8), ATT_PKW(p1, 10), ATT_PKW(p1, 12), ATT_PKW(p1, 14)};
#undef ATT_PKW
            ATT_SBAR();
            pv(o, vbl + slot * 8192, __builtin_bit_cast(bf16x8, pw0), __builtin_bit_cast(bf16x8, pw1), __builtin_bit_cast(bf16x8, pw2), __builtin_bit_cast(bf16x8, pw3));
        }
        slot = slot == 2 ? 0 : slot + 1;
    }
    { auto rr = __builtin_amdgcn_permlane32_swap(__float_as_uint(l_reg), __float_as_uint(l_reg), false, false); l_reg = __uint_as_float(rr[0]) + __uint_as_float(rr[1]); }
    if (hi == 0) wsf[32 + r32] = l_reg;
    asm volatile("s_waitcnt lgkmcnt(0)" ::: "memory");
    float rli[16];
#pragma unroll
    for (int r = 0; r < 16; ++r) rli[r] = __builtin_amdgcn_rcpf(wsf[32 + crow(r, hi)]);
    if (DIL) { if (hi == 0) lse[ATT_GROW(q0 + wid * 32 + r32) * 8] = mhat + __builtin_amdgcn_logf(l_reg); }
    { bf16* stg = (bf16*)(shm + L::LOST) + wid * 2048;
#pragma unroll
      for (int r = 0; r < 16; ++r) { const int orow = crow(r, hi);
#pragma unroll
        for (int d0 = 0; d0 < 2; ++d0) stg[orow * 64 + d0 * 32 + r32] = (bf16)(cvtpk_s(o[d0][r] * rli[r], 0.f) & 0xffffu); }
      asm volatile("s_waitcnt lgkmcnt(0)" ::: "memory");
#pragma unroll
      for (int i = 0; i < 4; ++i) { const int row = i * 8 + (lane >> 3), ch = lane & 7; const u32x4 v = *(const u32x4*)(stg + row * 64 + ch * 8);
        *(u32x4*)(Ob + ATT_GROW(q0 + wid * 32 + row) * po + ch * 8) = v; } }
    asm volatile("s_waitcnt lgkmcnt(0)\n\ts_barrier" ::: "memory");
#undef ATT_GROW
#undef ATT_ISSUE
}
#undef ATT_SBAR
#undef ATT_WAIT_BAR
}
namespace mla {
using bf16 = unsigned short;
using bf16x8 = __attribute__((ext_vector_type(8))) short;
using s16x4 = __attribute__((ext_vector_type(4))) short;
using f32x16 = __attribute__((ext_vector_type(16))) float;
using u32x4 = __attribute__((ext_vector_type(4))) unsigned;
constexpr int SEQL = 8192, PQ = 1536, PV = 1024, HQ = 96, HV = 64;
constexpr int NW = 8, QBLK = 32, QB = QBLK * NW, KVBLK = 64;
__device__ __forceinline__ int crow(int r, int hi) { return (r & 3) + 8 * (r >> 2) + 4 * hi; }
#define SBAR() __builtin_amdgcn_sched_barrier(0)
__device__ __forceinline__ void cmask(f32x16& p0, f32x16& p1, int jb, int qrel, int hi) {
    const float NEG = -INFINITY; int kb = 64 * jb + 4 * hi;
#pragma unroll
    for (int r = 0; r < 16; ++r) { int kv = kb + (r & 3) + 8 * (r >> 2); if (kv > qrel) p0[r] = NEG; if (kv + 32 > qrel) p1[r] = NEG; }
}
constexpr int NSLOT = 3, KSLOTB = 12288, VSLOTB = 8192;
constexpr int LDS_K = 0, LDS_V = NSLOT * KSLOTB, LDS_WS = LDS_V + NSLOT * VSLOTB, LDS_OST = LDS_WS + NW * 64 * 4, LDS_BYTES = LDS_OST + NW * 4096;
static_assert(LDS_BYTES <= 131072, "mla attention LDS");
__device__ __forceinline__ void glds16(const void* gsrc, unsigned lds_dst) { unsigned keep;
    asm volatile("s_mov_b32 %0, m0\n\ts_mov_b32 m0, %2\n\ts_nop 0\n\tglobal_load_lds_dwordx4 %1, off\n\ts_mov_b32 m0, %0" : "=&s"(keep) : "v"(gsrc), "s"(lds_dst) : "memory"); }
__device__ __forceinline__ float max3f(float a, float b, float c) { float r; asm("v_max3_f32 %0, %1, %2, %3" : "=v"(r) : "v"(a), "v"(b), "v"(c)); return r; }
__device__ __forceinline__ float max2f(float a, float b) { float r; asm("v_max_f32_e32 %0, %1, %2" : "=v"(r) : "v"(a), "v"(b)); return r; }
__device__ __forceinline__ float fadd_s(float a, float b) { float r; asm("v_add_f32_e32 %0, %1, %2" : "=v"(r) : "v"(a), "v"(b)); return r; }
__device__ __forceinline__ float fsub_s(float a, float b) { float r; asm("v_sub_f32_e32 %0, %1, %2" : "=v"(r) : "v"(a), "v"(b)); return r; }
typedef float f32x2_t __attribute__((ext_vector_type(2))); typedef __bf16 bf16x2_t __attribute__((ext_vector_type(2)));
__device__ __forceinline__ unsigned cvtpk_s(float lo, float hi) { f32x2_t v = {lo, hi}; bf16x2_t b = __builtin_convertvector(v, bf16x2_t); return __builtin_bit_cast(unsigned, b); }
#define WAIT_BAR(N) asm volatile("s_waitcnt vmcnt(" #N ") lgkmcnt(0)\n\ts_barrier" ::: "memory")

__device__ __forceinline__ void qkt(f32x16& p0, f32x16& p1, const char* Kslot, const bf16x8* qr, const f32x16& negm, int r32, int hi) {
    const char* kb = Kslot + hi * 1024 + r32 * 16;
#pragma unroll
    for (int d0 = 0; d0 < 6; ++d0) {
        const bf16x8 b0 = *reinterpret_cast<const bf16x8*>(kb + d0 * 2048);
        const bf16x8 b1 = *reinterpret_cast<const bf16x8*>(kb + d0 * 2048 + 512);
        if (d0 == 0) { p0 = __builtin_amdgcn_mfma_f32_32x32x16_bf16(b0, qr[0], negm, 0, 0, 0); p1 = __builtin_amdgcn_mfma_f32_32x32x16_bf16(b1, qr[0], negm, 0, 0, 0); }
        else { p0 = __builtin_amdgcn_mfma_f32_32x32x16_bf16(b0, qr[d0], p0, 0, 0, 0); p1 = __builtin_amdgcn_mfma_f32_32x32x16_bf16(b1, qr[d0], p1, 0, 0, 0); } }
}
typedef __attribute__((address_space(3))) const char* lds_cptr;
typedef short v4i16_t __attribute__((ext_vector_type(4)));
__device__ __forceinline__ void kload12(bf16x8* kf, lds_cptr kp) {
#pragma unroll
    for (int j = 0; j < 6; ++j) { kf[2 * j] = *(const __attribute__((address_space(3))) bf16x8*)(kp + j * 2048); kf[2 * j + 1] = *(const __attribute__((address_space(3))) bf16x8*)(kp + j * 2048 + 512); }
}
__device__ __forceinline__ void kload2(bf16x8* kf, lds_cptr kp, int j) { kf[2 * j] = *(const __attribute__((address_space(3))) bf16x8*)(kp + j * 2048); kf[2 * j + 1] = *(const __attribute__((address_space(3))) bf16x8*)(kp + j * 2048 + 512); }
__device__ __forceinline__ s16x4 vtr(lds_cptr p) { return __builtin_bit_cast(s16x4, __builtin_amdgcn_ds_read_tr16_b64_v4i16((__attribute__((address_space(3))) v4i16_t*)p)); }
__device__ __forceinline__ float rowmax(const f32x16& p0, const f32x16& p1) {
    float a = max3f(p0[0], p0[1], p1[0]), b = max3f(p0[2], p0[3], p1[1]); a = max3f(a, p1[2], p1[3]);
#pragma unroll
    for (int r = 4; r < 16; r += 4) { a = max3f(a, p0[r], p0[r + 1]); b = max3f(b, p0[r + 2], p0[r + 3]); a = max3f(a, p1[r], p1[r + 1]); b = max3f(b, p1[r + 2], p1[r + 3]); }
    const float m = max2f(a, b);
    auto rr = __builtin_amdgcn_permlane32_swap(__float_as_uint(m), __float_as_uint(m), false, false);
    return max2f(__uint_as_float(rr[0]), __uint_as_float(rr[1]));
}
__device__ __forceinline__ void pv(f32x16* o, int vb, bf16x8 pa0, bf16x8 pa1, bf16x8 pa2, bf16x8 pa3) {
#pragma unroll
    for (int d0 = 0; d0 < 2; ++d0) { s16x4 lo[4], hi[4];
#pragma unroll
        for (int ks = 0; ks < 4; ++ks) {
            asm volatile("ds_read_b64_tr_b16 %0,%1 offset:%c2" : "=&v"(lo[ks]) : "v"(vb), "i"(d0 * 4096 + ks * 1024) : "memory");
            asm volatile("ds_read_b64_tr_b16 %0,%1 offset:%c2" : "=&v"(hi[ks]) : "v"(vb), "i"(d0 * 4096 + ks * 1024 + 512) : "memory"); }
        asm volatile("s_waitcnt lgkmcnt(0)" ::: "memory"); SBAR();
#define PK(k) (bf16x8){lo[k][0], lo[k][1], lo[k][2], lo[k][3], hi[k][0], hi[k][1], hi[k][2], hi[k][3]}
        o[d0] = __builtin_amdgcn_mfma_f32_32x32x16_bf16(pa0, PK(0), o[d0], 0, 0, 0);
        o[d0] = __builtin_amdgcn_mfma_f32_32x32x16_bf16(pa1, PK(1), o[d0], 0, 0, 0);
        o[d0] = __builtin_amdgcn_mfma_f32_32x32x16_bf16(pa2, PK(2), o[d0], 0, 0, 0);
        o[d0] = __builtin_amdgcn_mfma_f32_32x32x16_bf16(pa3, PK(3), o[d0], 0, 0, 0);
#undef PK
    }
}

template <int THRL> __device__ __forceinline__ void attn_unit(int b, int h, int qb, const bf16* Q, const bf16* __restrict__ K, const bf16* __restrict__ V, bf16* O, char* shm) {
    int tid_ = threadIdx.x; asm volatile("" : "+v"(tid_));
    const int tid = tid_, lane = tid & 63, r32 = lane & 31, hi = lane >> 5; const int wid = __builtin_amdgcn_readfirstlane(tid >> 6);
    const long rowbase = (long)b * SEQL; const int q0 = qb * QB;
    const bf16* Qw = Q + (rowbase + q0 + wid * QBLK) * PQ + h * HQ;
    const bf16* Kh = K + rowbase * PQ + h * HQ; const bf16* Vh = V + rowbase * PV + h * HV;
    const unsigned lds0 = (unsigned)(uintptr_t)shm;
    float* wsf = (float*)(shm + LDS_WS) + wid * 64;
    const bool k2 = wid < 4;
    const bf16* ksrc = Kh + (long)lane * PQ + wid * 8;
    const bf16* vsrc = Vh + (long)(16 * (wid & 3) + (lane >> 2)) * PV + (wid >> 2) * 32 + (lane & 3) * 8;
    const unsigned kdst = lds0 + LDS_K + wid * 1024, vdst = lds0 + LDS_V + wid * 1024;
#define DMA_K(t, slot) do { glds16(ksrc + (long)(t) * KVBLK * PQ, (unsigned)__builtin_amdgcn_readfirstlane(kdst + (slot))); \
        if (k2) glds16(ksrc + (long)(t) * KVBLK * PQ + 64, (unsigned)__builtin_amdgcn_readfirstlane(kdst + (slot) + 8192)); } while (0)
#define DMA_V(t, slot) glds16(vsrc + (long)(t) * KVBLK * PV, (unsigned)__builtin_amdgcn_readfirstlane(vdst + (slot)))
    const int vb0 = (int)(lds0 + LDS_V) + ((lane >> 4) & 1) * 32 + (lane & 3) * 8 + (4 * hi + ((lane & 15) >> 2)) * 64;
    const char* Kbase = shm + LDS_K; bf16x8 kf[12];
    const lds_cptr shm3 = (lds_cptr)shm; const lds_cptr kp0 = shm3 + LDS_K + hi * 1024 + r32 * 16; const lds_cptr vp0 = shm3 + LDS_V + ((lane >> 4) & 1) * 32 + (lane & 3) * 8 + (4 * hi + ((lane & 15) >> 2)) * 64;
    const int NT = (q0 + QB) / KVBLK;
#define WAIT_KV() do { if (k2) WAIT_BAR(3); else WAIT_BAR(2); } while (0)
#define WAIT_KKV() do { if (k2) WAIT_BAR(5); else WAIT_BAR(3); } while (0)
    DMA_K(0, 0); DMA_V(0, 0); DMA_K(1, KSLOTB);
    bf16x8 qr[6];
#pragma unroll
    for (int d0 = 0; d0 < 6; ++d0) qr[d0] = *reinterpret_cast<const bf16x8*>(&Qw[(long)r32 * PQ + d0 * 16 + hi * 8]);
    float mhat = 0.f, l_reg = 0.f; f32x16 o[2]; o[0] = f32x16{}; o[1] = f32x16{}; f32x16 negm = f32x16{}; asm volatile("" : "+v"(negm));
    const int qrel = wid * QBLK + r32;
#define CMASK(P0, P1, t) do { int jb_ = (t) - (NT - 4); if (jb_ >= 0) cmask(P0, P1, jb_, qrel, hi); } while (0)
    bool resc = false;
#define START(P0, P1) do { const float rm = rowmax(P0, P1); resc = false; \
    { const float dl = rm; mhat = fadd_s(mhat, dl); \
      _Pragma("unroll") for (int r = 0; r < 16; ++r) { P0[r] = fsub_s(P0[r], dl); P1[r] = fsub_s(P1[r], dl); } \
      _Pragma("unroll") for (int r = 0; r < 16; ++r) negm[r] = -mhat; asm volatile("" : "+v"(negm)); } \
    _Pragma("unroll") for (int r = 0; r < 16; ++r) P0[r] = __builtin_amdgcn_exp2f(P0[r]); } while (0)
#define RESC() do { if (resc) { asm volatile("s_waitcnt lgkmcnt(0)" ::: "memory"); \
      _Pragma("unroll") for (int d_ = 0; d_ < 2; ++d_) _Pragma("unroll") for (int r = 0; r < 16; ++r) o[d_][r] *= wsf[crow(r, hi)]; } } while (0)
    f32x16 pA0, pA1, pB0, pB1;
    int sl_prev = 0, sl_cur = 0, sl_next = 1;
#define ROT() do { sl_prev = sl_cur; sl_cur = sl_next; sl_next = (sl_next == NSLOT - 1) ? 0 : sl_next + 1; } while (0)
    DMA_K(2, 2 * KSLOTB);
    WAIT_KKV();
    qkt(pA0, pA1, Kbase, qr, negm, r32, hi); asm volatile("s_nop 15\n\ts_nop 7" : "+v"(pA0), "+v"(pA1)); CMASK(pA0, pA1, 0);
    START(pA0, pA1);
#pragma unroll
    for (int r = 0; r < 16; ++r) pA1[r] = __builtin_amdgcn_exp2f(pA1[r]);
    WAIT_BAR(0);
    DMA_K(3, 0); DMA_V(1, VSLOTB);
    ROT();
    kload12(kf, kp0 + sl_cur * KSLOTB);
    WAIT_KV();
    s16x4 vlo[8], vhi[8]; u32x4 pw0, pw1, pw2, pw3;
#define PKW(P, B) cvtpk_s(P[B], P[B + 1])
#define PAF(k) __builtin_bit_cast(bf16x8, pw##k)
#define VFR(i) (bf16x8){vlo[i][0], vlo[i][1], vlo[i][2], vlo[i][3], vhi[i][0], vhi[i][1], vhi[i][2], vhi[i][3]}
#define PIN(x) asm volatile("" : "+v"(x))
#define MX3(a, b, c) __builtin_fmaxf(__builtin_fmaxf((a), (b)), (c))
#define GAPA(MF, A0, A1, A2, A3, W0, W1, PW) do { MF; sacc += A0; sacc += A1; sacc += A2; sacc += A3; PIN(sacc); W0; W1; PIN(PW); SBAR(); } while (0)
#define GAPM(MF) do { MF; SBAR(); } while (0)
#define EX(v) __builtin_amdgcn_exp2f(v)
#define GAPB(MF, X, B) do { MF; X[B] = EX(X[B]); X[B + 1] = EX(X[B + 1]); X[B + 2] = EX(X[B + 2]); X[B + 3] = EX(X[B + 3]); PIN(X); SBAR(); } while (0)
#define VRD(i) do { vlo[i] = vtr(vp_ + (((i) >> 2) * 4096 + ((i) & 3) * 1024)); vhi[i] = vtr(vp_ + (((i) >> 2) * 4096 + ((i) & 3) * 1024 + 512)); } while (0)
#define KRD(G, j) do { if (G) { kload2(kf, kp0 + sl_next * KSLOTB, j); SBAR(); } } while (0)
#define MF32(a, b, c) __builtin_amdgcn_mfma_f32_32x32x16_bf16(a, b, c, 0, 0, 0)
#define STEP(C0, C1, P0, P1, t, GK, GV, GL) do { SBAR(); \
    const lds_cptr vp_ = vp0 + sl_prev * VSLOTB; \
    float sacc = (P0[0] + P0[1]); \
    GAPA(C0 = MF32(kf[0], qr[0], negm), P0[2], P0[3], P0[4], P0[5],     pw0[0] = PKW(P0, 0), pw0[1] = PKW(P0, 2), pw0); \
    GAPA(C1 = MF32(kf[1], qr[0], negm), P0[6], P0[7], P0[8], P0[9],     pw0[2] = PKW(P0, 4), pw0[3] = PKW(P0, 6), pw0); \
    GAPA(C0 = MF32(kf[2], qr[1], C0),   P0[10], P0[11], P0[12], P0[13], pw1[0] = PKW(P0, 8), pw1[1] = PKW(P0, 10), pw1); \
    GAPA(C1 = MF32(kf[3], qr[1], C1),   P0[14], P0[15], P1[0], P1[1],   pw1[2] = PKW(P0, 12), pw1[3] = PKW(P0, 14), pw1); \
    VRD(0); SBAR(); GAPA(C0 = MF32(kf[4], qr[2], C0),   P1[2], P1[3], P1[4], P1[5],     pw2[0] = PKW(P1, 0), pw2[1] = PKW(P1, 2), pw2); \
    VRD(4); SBAR(); GAPA(C1 = MF32(kf[5], qr[2], C1),   P1[6], P1[7], P1[8], P1[9],     pw2[2] = PKW(P1, 4), pw2[3] = PKW(P1, 6), pw2); \
    VRD(1); SBAR(); GAPA(C0 = MF32(kf[6], qr[3], C0),   P1[10], P1[11], P1[12], P1[13], pw3[0] = PKW(P1, 8), pw3[1] = PKW(P1, 10), pw3); \
    VRD(5); SBAR(); GAPA(C1 = MF32(kf[7], qr[3], C1),   P1[14], P1[15], 0.f, 0.f,       pw3[2] = PKW(P1, 12), pw3[3] = PKW(P1, 14), pw3); \
    VRD(2); SBAR(); GAPM(C0 = MF32(kf[8], qr[4], C0)); VRD(6); SBAR(); GAPM(C1 = MF32(kf[9], qr[4], C1)); \
    VRD(3); SBAR(); GAPM(C0 = MF32(kf[10], qr[5], C0)); VRD(7); SBAR(); GAPM(C1 = MF32(kf[11], qr[5], C1)); \
    l_reg += sacc; \
    if (GK) { DMA_K((t) + 3, sl_cur * KSLOTB); } if (GV) { DMA_V((t) + 1, sl_next * VSLOTB); } \
    CMASK(C0, C1, t); \
    { float a = MX3(C0[0], C0[1], C1[0]), b = MX3(C0[2], C0[3], C1[1]); a = MX3(a, C1[2], C1[3]); \
      _Pragma("unroll") for (int r = 4; r < 16; r += 4) { a = MX3(a, C0[r], C0[r + 1]); b = MX3(b, C0[r + 2], C0[r + 3]); a = MX3(a, C1[r], C1[r + 1]); b = MX3(b, C1[r + 2], C1[r + 3]); } \
      float rm = __builtin_fmaxf(a, b); { auto rr = __builtin_amdgcn_permlane32_swap(__float_as_uint(rm), __float_as_uint(rm), false, false); rm = __builtin_fmaxf(__uint_as_float(rr[0]), __uint_as_float(rr[1])); } \
      resc = false; \
      if (__builtin_expect(__any(rm > (float)THRL), 0)) { const float dl = __builtin_fmaxf(rm, 0.f); mhat += dl; \
        _Pragma("unroll") for (int r = 0; r < 16; ++r) { C0[r] -= dl; C1[r] -= dl; } \
        _Pragma("unroll") for (int r = 0; r < 16; ++r) negm[r] = -mhat; asm volatile("" : "+v"(negm)); \
        const float f = __builtin_amdgcn_exp2f(-dl); l_reg *= f; if (hi == 0) wsf[r32] = f; resc = true; } } \
    SBAR(); \
    GAPB(o[0] = MF32(PAF(0), VFR(0), o[0]), C0, 0); \
    KRD(GL, 0); GAPB(o[1] = MF32(PAF(0), VFR(4), o[1]), C0, 4); \
    KRD(GL, 1); GAPB(o[0] = MF32(PAF(1), VFR(1), o[0]), C0, 8); \
    KRD(GL, 2); GAPB(o[1] = MF32(PAF(1), VFR(5), o[1]), C0, 12); \
    KRD(GL, 3); GAPB(o[0] = MF32(PAF(2), VFR(2), o[0]), C1, 0); \
    KRD(GL, 4); GAPB(o[1] = MF32(PAF(2), VFR(6), o[1]), C1, 4); \
    KRD(GL, 5); GAPB(o[0] = MF32(PAF(3), VFR(3), o[0]), C1, 8); \
    GAPB(o[1] = MF32(PAF(3), VFR(7), o[1]), C1, 12); \
    } while (0)
    int t = 1;
#undef CMASK
#define CMASK(P0, P1, t) do { } while (0)
    for (; t + 5 < NT; t += 2) {
        STEP(pB0, pB1, pA0, pA1, t, true, true, true);     WAIT_KV(); RESC(); ROT();
        STEP(pA0, pA1, pB0, pB1, t + 1, true, true, true); WAIT_KV(); RESC(); ROT();
    }
#undef CMASK
#define CMASK(P0, P1, t) do { int jb_ = (t) - (NT - 4); if (jb_ >= 0) cmask(P0, P1, jb_, qrel, hi); } while (0)
#define ENDW(tt) do { if ((tt) + 3 < NT) { WAIT_KV(); } else if ((tt) + 2 < NT) { WAIT_BAR(1); } else { WAIT_BAR(0); } } while (0)
    for (; t + 1 < NT; t += 2) {
        STEP(pB0, pB1, pA0, pA1, t, (t + 3 < NT), (t + 1 < NT), (t + 1 < NT));         ENDW(t);     RESC(); ROT();
        STEP(pA0, pA1, pB0, pB1, t + 1, (t + 4 < NT), (t + 2 < NT), (t + 2 < NT));     ENDW(t + 1); RESC(); ROT();
    }
    STEP(pB0, pB1, pA0, pA1, NT - 1, false, false, false); RESC();
    { float sacc = pB0[0] + pB0[1];
#pragma unroll
      for (int r = 2; r < 16; ++r) sacc += pB0[r];
#pragma unroll
      for (int r = 0; r < 16; ++r) sacc += pB1[r];
      l_reg += sacc;
      pw0 = (u32x4){PKW(pB0, 0), PKW(pB0, 2), PKW(pB0, 4), PKW(pB0, 6)}; pw1 = (u32x4){PKW(pB0, 8), PKW(pB0, 10), PKW(pB0, 12), PKW(pB0, 14)}; pw2 = (u32x4){PKW(pB1, 0), PKW(pB1, 2), PKW(pB1, 4), PKW(pB1, 6)}; pw3 = (u32x4){PKW(pB1, 8), PKW(pB1, 10), PKW(pB1, 12), PKW(pB1, 14)};
      SBAR(); pv(o, vb0 + sl_cur * VSLOTB, PAF(0), PAF(1), PAF(2), PAF(3)); }
#undef PKW
#undef PAF
#undef VFR
#undef PIN
#undef MX3
#undef GAPA
#undef GAPM
#undef GAPB
#undef EX
#undef VRD
#undef KRD
#undef MF32
#undef STEP
#undef ENDW
    { auto rr = __builtin_amdgcn_permlane32_swap(__float_as_uint(l_reg), __float_as_uint(l_reg), false, false); l_reg = __uint_as_float(rr[0]) + __uint_as_float(rr[1]); }
    if (hi == 0) wsf[32 + r32] = l_reg; asm volatile("s_waitcnt lgkmcnt(0)" ::: "memory");
    float rli[16];
#pragma unroll
    for (int r = 0; r < 16; ++r) rli[r] = __builtin_amdgcn_rcpf(wsf[32 + crow(r, hi)]);
    bf16* Ow = O + (rowbase + q0 + wid * QBLK) * PV + h * HV;
    { bf16* stg = (bf16*)(shm + LDS_OST) + wid * 2048;
#pragma unroll
      for (int r = 0; r < 16; ++r) { const int orow = crow(r, hi);
#pragma unroll
        for (int d0 = 0; d0 < 2; ++d0) stg[orow * 64 + d0 * 32 + r32] = (bf16)(cvtpk_s(o[d0][r] * rli[r], 0.f) & 0xffffu); }
      asm volatile("s_waitcnt lgkmcnt(0)" ::: "memory");
#pragma unroll
      for (int i = 0; i < 4; ++i) { const int row = i * 8 + (lane >> 3), ch = lane & 7; const u32x4 v = *(const u32x4*)(stg + row * 64 + ch * 8); *(u32x4*)(Ow + (long)row * PV + ch * 8) = v; } }
    asm volatile("s_waitcnt lgkmcnt(0)\n\ts_barrier" ::: "memory");
#undef DMA_K
#undef DMA_V
#undef CMASK
#undef START
#undef RESC
#undef ROT
#undef WAIT_KV
#undef WAIT_KKV
}
#undef SBAR
#undef WAIT_BAR
}
constexpr int NWAVES = 8;
constexpr int BATCH = 4, SEQ = 8192, D = 1024, M = BATCH * SEQ;
constexpr int MLA_H = 16, QRANK = 384, KVRANK = 256, LATN = 672, LATP = 768, QUP = 1536, KVUP = 2048;
constexpr int DFF = 2816, NEXP = 8, DILQ = 1536, DILKV = 3072, DILOUT = 512;
constexpr int MAXSLOT = 67584;
constexpr float EPS = 1e-6f;
constexpr float C2_MLA = 0.1472444460259031f;
constexpr float C2_DIL = 0.18033688011112042f;
constexpr float LOG2E_F = 1.4426950408889634f;

constexpr size_t MiB = 1u << 20;
constexpr size_t WS_CTL = 0, CTL_ZERO_BYTES = 64 * 1024;
constexpr size_t WS_MODV = 1 * MiB;
constexpr size_t WS_BIAS = 1 * MiB + 256 * 1024;
constexpr size_t WS_ROUTE = 1 * MiB + 512 * 1024;
constexpr size_t WS_CNT = 2 * MiB;
constexpr size_t WS_LIST = 2 * MiB + 256 * 1024;
constexpr size_t WS_SLOTG = 2 * MiB + 768 * 1024;
constexpr size_t WS_TOKSLOT = 3 * MiB + 256 * 1024;
constexpr size_t WS_TILEEXP = 3 * MiB + 768 * 1024;
constexpr size_t WS_CS = 4 * MiB;
constexpr size_t WS_LSE = 8 * MiB;
constexpr size_t WS_WEGU = 12 * MiB, WS_WEDN = 100 * MiB, WS_WFGU = 144 * MiB, WS_WFDN = 155 * MiB, WS_WKVB = 161 * MiB, WS_WQB = 167 * MiB, WS_WOUT = 170 * MiB,
                 WS_WOB = 172 * MiB, WS_WMLAIN = 173 * MiB, WS_WQUP = 175 * MiB, WS_WKVUP = 177 * MiB;
constexpr size_t WS_ARENA = 180 * MiB;
constexpr size_t A_XN = WS_ARENA, A_LAT = WS_ARENA + 64 * MiB, A_QN = WS_ARENA + 112 * MiB, A_KVN = WS_ARENA + 136 * MiB, A_Q = WS_ARENA + 152 * MiB, A_K = WS_ARENA + 248 * MiB,
                 A_V = WS_ARENA + 344 * MiB, A_O = WS_ARENA + 408 * MiB, A_HID = WS_ARENA + 64 * MiB, A_XNKV = WS_ARENA + 64 * MiB, A_KVB = WS_ARENA + 128 * MiB, A_QB = WS_ARENA + 320 * MiB,
                 A_OG = WS_ARENA, A_OD = WS_ARENA + 128 * MiB, A_HIDS = WS_ARENA + 160 * MiB, A_Y = WS_ARENA;
constexpr size_t WS_END = WS_ARENA + 523 * MiB;
static_assert(A_HIDS + (size_t)MAXSLOT * DFF * 2 <= WS_END && A_Y + (size_t)MAXSLOT * D * 2 <= A_HIDS && A_O + (size_t)M * D * 2 <= WS_END, "arena map");
static_assert(WS_WEGU + (size_t)NEXP * 2 * DFF * D * 2 <= WS_WEDN && WS_WEDN + (size_t)NEXP * D * DFF * 2 <= WS_WFGU && WS_WFGU + (size_t)2 * DFF * D * 2 <= WS_WFDN && WS_WFDN + (size_t)D * DFF * 2 <= WS_WKVB, "weight map");
enum ModKind { MK_A_MIX0 = 0, MK_B_MIX0, MK_G_MIX0, MK_A_FFN0, MK_B_FFN0, MK_G_FFN0, MK_A_MIX1, MK_B_MIX1, MK_G_MIX1, MK_A_FFN1, MK_B_FFN1, MK_G_FFN1, MK_A_KV, MK_B_KV };
constexpr int CW_BAR = 4096;

constexpr int RING_BYTES = 131072;
constexpr int LDSCTL_OFF = RING_BYTES, MISC_OFF = LDSCTL_OFF + 320;
constexpr int LDS_BYTES = 147456;

#define GAS __attribute__((address_space(1)))
#define LAS __attribute__((address_space(3)))
typedef unsigned short bf16;
typedef unsigned v4u __attribute__((ext_vector_type(4)));
typedef unsigned v2u __attribute__((ext_vector_type(2)));
typedef float f32x4 __attribute__((ext_vector_type(4)));
typedef GAS unsigned gu32;
#define RLX_AGENT __ATOMIC_RELAXED, __HIP_MEMORY_SCOPE_AGENT
#define LDS_WAIT() asm volatile("s_waitcnt lgkmcnt(0)" ::: "memory")
#define VM_WAIT() asm volatile("s_waitcnt vmcnt(0)" ::: "memory")
__device__ __forceinline__ unsigned f2bf(float f) { unsigned u = __builtin_bit_cast(unsigned, f); return (u + 0x7fffu + ((u >> 16) & 1u)) >> 16; }
__device__ __forceinline__ unsigned pk2(float lo, float hi) { return f2bf(lo) | (f2bf(hi) << 16); }
__device__ __forceinline__ float bf_lo(unsigned w) { return __builtin_bit_cast(float, w << 16); }
__device__ __forceinline__ float bf_hi(unsigned w) { return __builtin_bit_cast(float, w & 0xffff0000u); }
__device__ __forceinline__ float wave_sum(float v) {
#pragma unroll
    for (int o = 1; o < 64; o <<= 1) v += __shfl_xor(v, o);
    return v;
}

#define XB_TMO      128
#define XB_XCNT(j)  (256  + 64 * (j))
#define XB_XSUB(j)  (1280 + 64 * (j))
#define XB_XGEN(j)  (2304 + 64 * (j))
#define XB_TOP      3328
#define XB_TOPGEN   3392
#define XCD_BAR_WORDS 3456
#define XB_SPIN_CAP (1u << 18)
__device__ __forceinline__ unsigned xb_ld(unsigned* p)              { return __hip_atomic_load(p, __ATOMIC_RELAXED, __HIP_MEMORY_SCOPE_AGENT); }
__device__ __forceinline__ unsigned xb_add(unsigned* p, unsigned v) { return __hip_atomic_fetch_add(p, v, __ATOMIC_RELAXED, __HIP_MEMORY_SCOPE_AGENT); }
__device__ __forceinline__ unsigned xb_xcc_id() { return (unsigned)__builtin_amdgcn_s_getreg((3 << 11) | 20) & 0xFu; }
#define XB_SPIN(cond, bar) do { unsigned _sp = 0; while (cond) { __builtin_amdgcn_s_sleep(1); \
    if ((++_sp & 255u) == 0u) { if (xb_ld(&(bar)[XB_TMO])) break; if (_sp > XB_SPIN_CAP) { atomicAdd(&(bar)[XB_TMO], 1u); break; } } } } while (0)
struct XcdBarrier { unsigned* bar; unsigned x; volatile LAS unsigned* st; };
__device__ __forceinline__ XcdBarrier xcd_barrier_post(unsigned* bar, volatile LAS unsigned* st) {
    XcdBarrier b; b.bar = bar; b.x = xb_xcc_id(); b.st = st;
    if (threadIdx.x == 0) (void)xb_add(&bar[XB_XCNT(b.x)], 1u);
    return b;
}
__device__ __forceinline__ void xcd_barrier_complete(unsigned* bar, unsigned x, unsigned& nloc, unsigned& nx) {
    const unsigned G = gridDim.x * gridDim.y * gridDim.z;
    unsigned sum, cnt, mine, sp = 0u;
    for (;;) {
        sum = 0u; cnt = 0u; mine = 0u;
#pragma unroll
        for (unsigned j = 0; j < 16; ++j) { const unsigned c = xb_ld(&bar[XB_XCNT(j)]); sum += c; cnt += (c > 0u) ? 1u : 0u; mine = (j == x) ? c : mine; }
        if (sum == G) break;
        __builtin_amdgcn_s_sleep(1);
        if ((++sp & 255u) == 0u) { if (xb_ld(&bar[XB_TMO])) break; if (sp > XB_SPIN_CAP) { atomicAdd(&bar[XB_TMO], 1u); break; } }
    }
    nloc = mine > 0u ? mine : 1u; nx = cnt > 0u ? cnt : 1u;
}
__device__ __forceinline__ void xcd_barrier(const XcdBarrier& b) {
    asm volatile("s_waitcnt vmcnt(0)" ::: "memory");
    __syncthreads();
    if (threadIdx.x == 0) {
        unsigned* bar = b.bar;
        __builtin_amdgcn_s_waitcnt(0);
        unsigned nloc = b.st[0], nx = b.st[1];
        if (nloc == 0u) { xcd_barrier_complete(bar, b.x, nloc, nx); b.st[0] = nloc; b.st[1] = nx; }
        const unsigned old = xb_add(&bar[XB_XSUB(b.x)], 1u);
        const unsigned gen = old / nloc;
        if (old + 1u == (gen + 1u) * nloc) {
            __builtin_amdgcn_fence(__ATOMIC_RELEASE, "agent");
            asm volatile("s_waitcnt vmcnt(0)" ::: "memory");
            const unsigned og = xb_add(&bar[XB_TOP], 1u);
            const unsigned tg = og / nx;
            if (og + 1u == (tg + 1u) * nx) xb_add(&bar[XB_TOPGEN], 1u);
            else XB_SPIN(xb_ld(&bar[XB_TOPGEN]) == tg, bar);
            __builtin_amdgcn_fence(__ATOMIC_ACQUIRE, "agent");
            xb_add(&bar[XB_XGEN(b.x)], 1u);
            asm volatile("s_waitcnt vmcnt(0)" ::: "memory");
        } else {
            XB_SPIN(xb_ld(&bar[XB_XGEN(b.x)]) == gen, bar);
            __builtin_amdgcn_fence(__ATOMIC_ACQUIRE, "agent");
            asm volatile("s_waitcnt vmcnt(0)" ::: "memory");
        }
    }
    __syncthreads();
}

struct Frame {
    LAS unsigned char* lds;
    volatile LAS unsigned* MISC;
    int tid, lane, wave;
    int vcu, G;
    unsigned char* ws;
    const float* in[26];
    float* out;
};
enum { MAP_PLAIN = 0, MAP_MLAIN = 1, MAP_QUP = 2, MAP_GU = 3 };
template <int MAP> __device__ __forceinline__ int dmap(int n) {
    if (MAP == MAP_MLAIN) { if (n < 640) return n; if (n < 656) return 640 + 2 * (n - 640); return 640 + 2 * (n - 656) + 1; }
    if (MAP == MAP_QUP) { const int h = n / 96, j = n % 96; if (j < 64) return n; if (j < 80) return h * 96 + 64 + 2 * (j - 64); return h * 96 + 64 + 2 * (j - 80) + 1; }
    if (MAP == MAP_GU) { const int up = n >= DFF ? 1 : 0; const int c = up ? n - DFF : n; return (c >> 7) * 256 + up * 128 + (c & 127); }
    return n;
}
template <int MAP> __device__ __forceinline__ void transpose_item(const float* W, int K, int N, bf16* WT, const float* ks, LAS float* scr, int item, int lane) {
    const int nblk = N / 32, kb = item / nblk, nb = item % nblk, k0 = 64 * kb, n0 = 32 * nb;
    float v[32];
    const float* src = W + (size_t)(k0 + (lane >> 5)) * N + n0 + (lane & 31);
#pragma unroll
    for (int i = 0; i < 32; ++i) v[i] = __builtin_nontemporal_load(src + (size_t)(2 * i) * N);
    if (ks) {
#pragma unroll
        for (int i = 0; i < 32; ++i) v[i] *= ks[k0 + 2 * i + (lane >> 5)]; }
#pragma unroll
    for (int i = 0; i < 32; ++i) scr[(2 * i + (lane >> 5)) * 33 + (lane & 31)] = v[i];
    LDS_WAIT(); asm volatile("" ::: "memory");
    const int c = lane & 7;
#pragma unroll
    for (int j = 0; j < 4; ++j) { const int n = (lane >> 3) + 8 * j; const LAS float* s = scr + (8 * c) * 33 + n;
        v4u o; o.x = pk2(s[0 * 33], s[1 * 33]); o.y = pk2(s[2 * 33], s[3 * 33]); o.z = pk2(s[4 * 33], s[5 * 33]); o.w = pk2(s[6 * 33], s[7 * 33]);
        *(GAS v4u*)(WT + (size_t)dmap<MAP>(n0 + n) * K + k0 + 8 * c) = o; }
    LDS_WAIT(); asm volatile("" ::: "memory");
}
__device__ __constant__ double INVF_D[16] = {1.0, 0.5623413251903491, 0.31622776601683794, 0.1778279410038923, 0.09999999999999999, 0.056234132519034905, 0.03162277660168379, 0.01778279410038923,
    0.01, 0.005623413251903491, 0.0031622776601683794, 0.0017782794100389228, 0.001, 0.000562341325190349, 0.00031622776601683794, 0.0001778279410038923};
__device__ __constant__ int RPB_TH[15] = {22, 30, 40, 54, 73, 99, 134, 182, 246, 332, 450, 609, 825, 1117, 1513};

__device__ __forceinline__ void p0_prologue(Frame& F) {
    const int gw = F.vcu * NWAVES + F.wave, NGW = F.G * NWAVES;
    const int gtid = F.vcu * (NWAVES * 64) + F.tid, NGT = F.G * NWAVES * 64;
    float* MODV = (float*)(F.ws + WS_MODV);
    {
        LAS float* cact = (LAS float*)F.lds;
        LAS float* red = (LAS float*)(F.lds + 16384);
        const float* cin = F.in[1];
        for (int i = F.tid; i < 4096; i += NWAVES * 64) { const int b = i >> 10, k = i & 1023; const float x = cin[i]; cact[k * 4 + b] = x / (1.0f + expf(-x)); }
        __syncthreads();
        constexpr int NTASK = (6 * D * 2 + 2 * D) / 64;
        for (int task = F.vcu; task < NTASK; task += F.G) {
            const int gc = task * 64 + F.lane;
            const float* W; int ldw, cc; const float* bias;
            if (gc < 6 * D) { W = F.in[5]; ldw = 6 * D; cc = gc; bias = F.in[6]; }
            else if (gc < 12 * D) { W = F.in[5] + (size_t)D * 6 * D; ldw = 6 * D; cc = gc - 6 * D; bias = F.in[6] + 6 * D; }
            else { W = F.in[14]; ldw = 2 * D; cc = gc - 12 * D; bias = F.in[15]; }
            float a0 = 0.f, a1 = 0.f, a2 = 0.f, a3 = 0.f;
            const int kbeg = F.wave * 128;
#pragma unroll 16
            for (int k = 0; k < 128; ++k) { const float w = W[(size_t)(kbeg + k) * ldw + cc]; const f32x4 ca = *(const LAS f32x4*)(cact + (kbeg + k) * 4);
                a0 += w * ca[0]; a1 += w * ca[1]; a2 += w * ca[2]; a3 += w * ca[3]; }
            red[(F.wave * 4 + 0) * 64 + F.lane] = a0; red[(F.wave * 4 + 1) * 64 + F.lane] = a1; red[(F.wave * 4 + 2) * 64 + F.lane] = a2; red[(F.wave * 4 + 3) * 64 + F.lane] = a3;
            __syncthreads();
            if (F.wave < 4) { const int b = F.wave; float s = 0.f;
#pragma unroll
                for (int w = 0; w < 8; ++w) s += red[(w * 4 + b) * 64 + F.lane];
                s += bias[cc];
                int kind; float val = s; const int j = cc & 1023, ch = cc >> 10;
                if (gc < 12 * D) { const int Lr = gc < 6 * D ? 0 : 1;
                    if (ch == 0) kind = 6 * Lr + 1; else if (ch == 1) { kind = 6 * Lr + 0; val = F.in[3][Lr * D + j] * (1.0f + s); } else if (ch == 2) kind = 6 * Lr + 2;
                    else if (ch == 3) kind = 6 * Lr + 4; else if (ch == 4) { kind = 6 * Lr + 3; val = F.in[4][Lr * D + j] * (1.0f + s); } else kind = 6 * Lr + 5;
                } else { if (ch == 0) kind = MK_B_KV; else { kind = MK_A_KV; val = F.in[13][j] * (1.0f + s); } }
                MODV[((size_t)kind * 4 + b) * D + j] = val; }
            __syncthreads();
        }
        __syncthreads();
    }
    {
        LAS float* scr = (LAS float*)(F.lds + F.wave * 8704);
        constexpr int I_MLAIN = (D / 64) * (LATN / 32), I_QUP = (QRANK / 64) * (QUP / 32), I_KVUP = (KVRANK / 64) * (KVUP / 32), I_OUT = (D / 64) * (D / 32), I_FGU = (D / 64) * (2 * DFF / 32),
                      I_FDN = (DFF / 64) * (D / 32), I_KVB = (D / 64) * (DILKV / 32), I_QB = (D / 64) * (DILQ / 32), I_OB = (DILOUT / 64) * (D / 32);
        constexpr int NSMALL = I_MLAIN + I_QUP + I_KVUP + I_OUT + I_FGU + I_FDN + I_KVB + I_QB + I_OB;
        constexpr int NITEMS = NSMALL + NEXP * (I_FGU + I_FDN);
        bf16* const ws16 = (bf16*)F.ws;
        for (int it = gw; it < NITEMS; it += NGW) {
            int r = it;
            if (r >= NSMALL) { r -= NSMALL;
                if (r < NEXP * I_FGU) { const int e = r / I_FGU; transpose_item<MAP_GU>(F.in[23] + (size_t)e * D * 2 * DFF, D, 2 * DFF, (bf16*)(F.ws + WS_WEGU) + (size_t)e * 2 * DFF * D, nullptr, scr, r % I_FGU, F.lane); continue; }
                r -= NEXP * I_FGU; { const int e = r / I_FDN; transpose_item<MAP_PLAIN>(F.in[24] + (size_t)e * DFF * D, DFF, D, (bf16*)(F.ws + WS_WEDN) + (size_t)e * D * DFF, nullptr, scr, r % I_FDN, F.lane); continue; } }
            if (r < I_MLAIN) { transpose_item<MAP_MLAIN>(F.in[7], D, LATN, (bf16*)(F.ws + WS_WMLAIN), nullptr, scr, r, F.lane); continue; } r -= I_MLAIN;
            if (r < I_QUP) { transpose_item<MAP_QUP>(F.in[9], QRANK, QUP, (bf16*)(F.ws + WS_WQUP), F.in[8], scr, r, F.lane); continue; } r -= I_QUP;
            if (r < I_KVUP) { transpose_item<MAP_PLAIN>(F.in[11], KVRANK, KVUP, (bf16*)(F.ws + WS_WKVUP), F.in[10], scr, r, F.lane); continue; } r -= I_KVUP;
            if (r < I_OUT) { transpose_item<MAP_PLAIN>(F.in[12], D, D, (bf16*)(F.ws + WS_WOUT), nullptr, scr, r, F.lane); continue; } r -= I_OUT;
            if (r < I_FGU) { transpose_item<MAP_GU>(F.in[20], D, 2 * DFF, (bf16*)(F.ws + WS_WFGU), nullptr, scr, r, F.lane); continue; } r -= I_FGU;
            if (r < I_FDN) { transpose_item<MAP_PLAIN>(F.in[21], DFF, D, (bf16*)(F.ws + WS_WFDN), nullptr, scr, r, F.lane); continue; } r -= I_FDN;
            if (r < I_KVB) { transpose_item<MAP_PLAIN>(F.in[16], D, DILKV, (bf16*)(F.ws + WS_WKVB), nullptr, scr, r, F.lane); continue; } r -= I_KVB;
            if (r < I_QB) { transpose_item<MAP_PLAIN>(F.in[18], D, DILQ, (bf16*)(F.ws + WS_WQB), nullptr, scr, r, F.lane); continue; } r -= I_QB;
            transpose_item<MAP_PLAIN>(F.in[19], DILOUT, D, (bf16*)(F.ws + WS_WOB), nullptr, scr, r, F.lane);
        }
        (void)ws16;
    }
    {
        v4u* padz = (v4u*)(F.ws + WS_WMLAIN + (size_t)LATN * D * 2);
        for (int i = gtid; i < (LATP - LATN) * D * 2 / 16; i += NGT) padz[i] = (v4u){0u, 0u, 0u, 0u};
        const int* pos = (const int*)F.in[2];
        float* cs = (float*)(F.ws + WS_CS);
        for (int i = gtid; i < M * 16; i += NGT) { const int row = i >> 4, k = i & 15;
            const double x = (double)pos[row] * INVF_D[k]; const double rev = x * 0.15915494309189535; const float fr = (float)(rev - __builtin_rint(rev));
            cs[(size_t)i * 2] = __builtin_amdgcn_cosf(fr); cs[(size_t)i * 2 + 1] = __builtin_amdgcn_sinf(fr); }
        const float* rpb = F.in[17];
        float* bt = (float*)(F.ws + WS_BIAS);
        for (int i = gtid; i < 24 * 129; i += NGT) { const int gh = i / 129, j = i % 129, g = gh >> 3; const int d = j * (g == 0 ? 1 : (g == 1 ? 4 : 16));
            int bk; if (d < 16) bk = d; else { bk = 16;
#pragma unroll
                for (int q = 0; q < 15; ++q) bk += (d >= RPB_TH[q]) ? 1 : 0; }
            bt[gh * 132 + j] = rpb[bk * 24 + gh] * LOG2E_F; }
    }
}

constexpr int HPITCH = 2048;
__device__ __forceinline__ void ld8_f32(const float* p, f32x4& a, f32x4& b) { a = *(const f32x4*)p; b = *(const f32x4*)(p + 4); }
__device__ __forceinline__ void ld8_bf16(const bf16* p, f32x4& a, f32x4& b) { const v4u w = *(const GAS v4u*)p; a = (f32x4){bf_lo(w.x), bf_hi(w.x), bf_lo(w.y), bf_hi(w.y)}; b = (f32x4){bf_lo(w.z), bf_hi(w.z), bf_lo(w.w), bf_hi(w.w)}; }
__device__ __forceinline__ float ssq8(const f32x4& a, const f32x4& b) { return ((a.x * a.x + a.y * a.y) + (a.z * a.z + a.w * a.w)) + ((b.x * b.x + b.y * b.y) + (b.z * b.z + b.w * b.w)); }
__device__ __forceinline__ v4u pk8(const f32x4& a, const f32x4& b) { return (v4u){pk2(a.x, a.y), pk2(a.z, a.w), pk2(b.x, b.y), pk2(b.z, b.w)}; }
template <bool DUAL, bool INF32>
__device__ __forceinline__ void norm_phase(Frame& F, const void* Hin, const float* A0, const float* B0, bf16* O0, const float* A1, const float* B1, bf16* O1) {
    const int gw = F.vcu * NWAVES + F.wave, NGW = F.G * NWAVES;
    for (int c = gw; c < M / 16; c += NGW) {
        const int row0 = c * 16, b = row0 / SEQ;
        f32x4 a0[2][2], b0[2][2], a1[2][2], b1[2][2];
#pragma unroll
        for (int j = 0; j < 2; ++j) { const int co = b * D + 8 * F.lane + 512 * j; ld8_f32(A0 + co, a0[j][0], a0[j][1]); ld8_f32(B0 + co, b0[j][0], b0[j][1]);
            if (DUAL) { ld8_f32(A1 + co, a1[j][0], a1[j][1]); ld8_f32(B1 + co, b1[j][0], b1[j][1]); } }
#pragma unroll 2
        for (int i = 0; i < 16; ++i) { const size_t row = (size_t)(row0 + i);
            f32x4 v[2][2]; float s = 0.f;
#pragma unroll
            for (int j = 0; j < 2; ++j) { if (INF32) ld8_f32((const float*)Hin + row * D + 8 * F.lane + 512 * j, v[j][0], v[j][1]); else ld8_bf16((const bf16*)Hin + row * HPITCH + 8 * F.lane + 512 * j, v[j][0], v[j][1]);
                s += ssq8(v[j][0], v[j][1]); }
            const float rstd = 1.0f / sqrtf(wave_sum(s) * (1.f / D) + EPS);
#pragma unroll
            for (int j = 0; j < 2; ++j) *(GAS v4u*)(O0 + row * D + 8 * F.lane + 512 * j) = pk8(v[j][0] * rstd * a0[j][0] + b0[j][0], v[j][1] * rstd * a0[j][1] + b0[j][1]);
            if (DUAL) {
#pragma unroll
                for (int j = 0; j < 2; ++j) *(GAS v4u*)(O1 + row * D + 8 * F.lane + 512 * j) = pk8(v[j][0] * rstd * a1[j][0] + b1[j][0], v[j][1] * rstd * a1[j][1] + b1[j][1]); }
        }
    }
}

__device__ __forceinline__ void latnorm_phase(Frame& F) {
    const int gw = F.vcu * NWAVES + F.wave, NGW = F.G * NWAVES;
    const bf16* LAT = (const bf16*)(F.ws + A_LAT); bf16* QN = (bf16*)(F.ws + A_QN); bf16* KVN = (bf16*)(F.ws + A_KVN); bf16* KB = (bf16*)(F.ws + A_K);
    const float* cs = (const float*)(F.ws + WS_CS);
    for (int row = gw; row < M; row += NGW) {
        const unsigned* lr = (const unsigned*)(LAT + (size_t)row * LATP);
        unsigned q[3], kv[2];
#pragma unroll
        for (int j = 0; j < 3; ++j) q[j] = lr[F.lane + 64 * j];
#pragma unroll
        for (int j = 0; j < 2; ++j) kv[j] = lr[192 + F.lane + 64 * j];
        const unsigned kr = lr[320 + (F.lane & 15)];
        float sq = 0.f, sk = 0.f;
#pragma unroll
        for (int j = 0; j < 3; ++j) { const float a = bf_lo(q[j]), b = bf_hi(q[j]); sq += a * a + b * b; }
#pragma unroll
        for (int j = 0; j < 2; ++j) { const float a = bf_lo(kv[j]), b = bf_hi(kv[j]); sk += a * a + b * b; }
        const float rq = 1.0f / sqrtf(wave_sum(sq) * (1.f / QRANK) + EPS), rk = 1.0f / sqrtf(wave_sum(sk) * (1.f / KVRANK) + EPS);
        unsigned* qo = (unsigned*)(QN + (size_t)row * QRANK); unsigned* ko = (unsigned*)(KVN + (size_t)row * KVRANK);
#pragma unroll
        for (int j = 0; j < 3; ++j) qo[F.lane + 64 * j] = pk2(bf_lo(q[j]) * rq, bf_hi(q[j]) * rq);
#pragma unroll
        for (int j = 0; j < 2; ++j) ko[F.lane + 64 * j] = pk2(bf_lo(kv[j]) * rk, bf_hi(kv[j]) * rk);
        { const int i = F.lane & 15; const float c = cs[(size_t)row * 32 + 2 * i], s = cs[(size_t)row * 32 + 2 * i + 1]; const float x1 = bf_lo(kr), x2 = bf_hi(kr);
          const unsigned w = pk2(x1 * c - x2 * s, x1 * s + x2 * c);
          unsigned* kb = (unsigned*)(KB + (size_t)row * QUP);
#pragma unroll
          for (int hh = 0; hh < 4; ++hh) { const int h = (F.lane >> 4) * 4 + hh; kb[(h * 96 + 64) / 2 + i] = w; } }
    }
}

__device__ __forceinline__ void merge_phase(Frame& F) {
    const int gw = F.vcu * NWAVES + F.wave, NGW = F.G * NWAVES;
    const bf16* OG = (const bf16*)(F.ws + A_OG); const float* LSE = (const float*)(F.ws + WS_LSE); bf16* OD = (bf16*)(F.ws + A_OD);
    for (int row = gw; row < M; row += NGW) {
        const int h = F.lane >> 3;
        float l0 = LSE[((size_t)0 * M + row) * 8 + h], l1 = LSE[((size_t)1 * M + row) * 8 + h], l2 = LSE[((size_t)2 * M + row) * 8 + h];
        const float mx = fmaxf(l0, fmaxf(l1, l2)); float w0 = __builtin_amdgcn_exp2f(l0 - mx), w1 = __builtin_amdgcn_exp2f(l1 - mx), w2 = __builtin_amdgcn_exp2f(l2 - mx);
        const float inv = 1.0f / (w0 + w1 + w2); w0 *= inv; w1 *= inv; w2 *= inv;
        const v4u a = *(const v4u*)(OG + ((size_t)0 * M + row) * DILOUT + 8 * F.lane), b = *(const v4u*)(OG + ((size_t)1 * M + row) * DILOUT + 8 * F.lane), c = *(const v4u*)(OG + ((size_t)2 * M + row) * DILOUT + 8 * F.lane);
        v4u o;
#pragma unroll
        for (int k = 0; k < 4; ++k) o[k] = pk2(w0 * bf_lo(a[k]) + w1 * bf_lo(b[k]) + w2 * bf_lo(c[k]), w0 * bf_hi(a[k]) + w1 * bf_hi(b[k]) + w2 * bf_hi(c[k]));
        *(v4u*)(OD + (size_t)row * DILOUT + 8 * F.lane) = o;
    }
}

__device__ __forceinline__ void router_phase(Frame& F, const bf16* H, const float* A0, const float* B0, bf16* O0) {
    const int gw = F.vcu * NWAVES + F.wave, NGW = F.G * NWAVES;
    LAS float* wrt = (LAS float*)F.lds;
    { const float* wr = F.in[22]; for (int i = F.tid; i < 8192; i += NWAVES * 64) { const int col = i >> 3, e = i & 7; wrt[e * 1024 + col] = wr[i]; } }
    __syncthreads();
    v4u* ROUTE = (v4u*)(F.ws + WS_ROUTE); unsigned* CNT = (unsigned*)(F.ws + WS_CNT);
    for (int c = gw; c < M / 16; c += NGW) {
        const int row0 = c * 16, b = row0 / SEQ;
        f32x4 a0[2][2], b0[2][2];
#pragma unroll
        for (int j = 0; j < 2; ++j) { const int co = b * D + 8 * F.lane + 512 * j; ld8_f32(A0 + co, a0[j][0], a0[j][1]); ld8_f32(B0 + co, b0[j][0], b0[j][1]); }
        unsigned cnt = 0u;
        for (int i = 0; i < 16; ++i) { const size_t row = (size_t)(row0 + i);
            f32x4 v[2][2]; float s = 0.f;
#pragma unroll
            for (int j = 0; j < 2; ++j) { ld8_bf16(H + row * HPITCH + 8 * F.lane + 512 * j, v[j][0], v[j][1]); s += ssq8(v[j][0], v[j][1]); }
            const float rstd = 1.0f / sqrtf(wave_sum(s) * (1.f / D) + EPS);
            float lg[8];
#pragma unroll
            for (int e = 0; e < 8; ++e) lg[e] = 0.f;
#pragma unroll
            for (int j = 0; j < 2; ++j) { const f32x4 y0 = v[j][0] * rstd * a0[j][0] + b0[j][0], y1 = v[j][1] * rstd * a0[j][1] + b0[j][1];
                *(GAS v4u*)(O0 + row * D + 8 * F.lane + 512 * j) = pk8(y0, y1);
#pragma unroll
                for (int e = 0; e < 8; ++e) { const LAS float* wp = wrt + e * 1024 + 8 * F.lane + 512 * j; const f32x4 w0 = *(const LAS f32x4*)wp, w1 = *(const LAS f32x4*)(wp + 4);
                    lg[e] += ((y0.x * w0.x + y0.y * w0.y) + (y0.z * w0.z + y0.w * w0.w)) + ((y1.x * w1.x + y1.y * w1.y) + (y1.z * w1.z + y1.w * w1.w)); } }
#pragma unroll
            for (int e = 0; e < 8; ++e) lg[e] = wave_sum(lg[e]);
            int e1 = 0; float v1 = lg[0];
#pragma unroll
            for (int e = 1; e < 8; ++e) if (lg[e] > v1) { v1 = lg[e]; e1 = e; }
            int e2 = -1; float v2 = -INFINITY;
#pragma unroll
            for (int e = 0; e < 8; ++e) if (e != e1 && lg[e] > v2) { v2 = lg[e]; e2 = e; }
            const float ex = expf(v2 - v1); const float g1 = 1.0f / (1.0f + ex), g2 = ex / (1.0f + ex);
            cnt += (F.lane == e1 ? 1u : 0u) + (F.lane == e2 ? 1u : 0u);
            if (F.lane == 0) ROUTE[row] = (v4u){(unsigned)e1 | ((unsigned)e2 << 8), __float_as_uint(g1), __float_as_uint(g2), 0u};
        }
        if (F.lane < 8) CNT[c * 8 + F.lane] = cnt;
    }
}

__device__ __forceinline__ void lists_phase(Frame& F) {
    const int gw = F.vcu * NWAVES + F.wave, NGW = F.G * NWAVES;
    const v4u* ROUTE = (const v4u*)(F.ws + WS_ROUTE); const unsigned* CNT = (const unsigned*)(F.ws + WS_CNT);
    int* LIST = (int*)(F.ws + WS_LIST); float* SLOTG = (float*)(F.ws + WS_SLOTG); int* TOKSLOT = (int*)(F.ws + WS_TOKSLOT); int* TILEEXP = (int*)(F.ws + WS_TILEEXP);
    for (int c = gw; c < M / 16; c += NGW) {
        unsigned lt[8], al[8];
#pragma unroll
        for (int e = 0; e < 8; ++e) { lt[e] = 0u; al[e] = 0u; }
        for (int cc = F.lane; cc < M / 16; cc += 64) { const v4u x = *(const v4u*)(CNT + cc * 8), y = *(const v4u*)(CNT + cc * 8 + 4); const bool bl = cc < c;
            al[0] += x.x; al[1] += x.y; al[2] += x.z; al[3] += x.w; al[4] += y.x; al[5] += y.y; al[6] += y.z; al[7] += y.w;
            if (bl) { lt[0] += x.x; lt[1] += x.y; lt[2] += x.z; lt[3] += x.w; lt[4] += y.x; lt[5] += y.y; lt[6] += y.z; lt[7] += y.w; } }
#pragma unroll
        for (int e = 0; e < 8; ++e) {
#pragma unroll
            for (int o = 1; o < 64; o <<= 1) { lt[e] += __shfl_xor(lt[e], o); al[e] += __shfl_xor(al[e], o); } }
        unsigned base[8]; unsigned run = 0u;
#pragma unroll
        for (int e = 0; e < 8; ++e) { base[e] = run; run += (al[e] + 255u) & ~255u; }
        const int row = c * 16 + (F.lane & 15);
        const v4u r = ROUTE[row]; const int e1 = (int)(r.x & 0xffu), e2 = (int)((r.x >> 8) & 0xffu);
        int s1 = 0, s2 = 0;
#pragma unroll
        for (int e = 0; e < 8; ++e) { const bool has = (F.lane < 16) && (e1 == e || e2 == e); const unsigned long long mk = __ballot(has);
            const int rank = __popcll(mk & ((1ull << F.lane) - 1ull)); const int sl = (int)(base[e] + lt[e]) + rank;
            if (e1 == e) s1 = sl; if (e2 == e) s2 = sl; }
        if (F.lane < 16) { LIST[s1] = row; LIST[s2] = row; SLOTG[s1] = __uint_as_float(r.y); SLOTG[s2] = __uint_as_float(r.z); TOKSLOT[row * 2] = s1; TOKSLOT[row * 2 + 1] = s2; }
        if (c == 0) {
#pragma unroll
            for (int e = 0; e < 8; ++e) { const unsigned pe = (al[e] + 255u) & ~255u;
                for (unsigned s = base[e] + al[e] + F.lane; s < base[e] + pe; s += 64) { LIST[s] = 0; SLOTG[s] = 0.f; }
                for (unsigned t = base[e] / 256u + F.lane; t < (base[e] + pe) / 256u; t += 64) TILEEXP[t] = e; }
            if (F.lane == 0) TILEEXP[300] = (int)(run / 256u);
        }
    }
}

__device__ __forceinline__ void final_phase(Frame& F, float* OUT, const float* gate, const float* gfin) {
    const int gw = F.vcu * NWAVES + F.wave, NGW = F.G * NWAVES;
    const bf16* Y = (const bf16*)(F.ws + A_Y); const int* TOKSLOT = (const int*)(F.ws + WS_TOKSLOT); const bf16* H = (const bf16*)OUT;
    for (int c = gw; c < M / 16; c += NGW) {
        const int row0 = c * 16, b = row0 / SEQ;
        f32x4 gt[2][2], gf[2][2];
#pragma unroll
        for (int j = 0; j < 2; ++j) { ld8_f32(gate + b * D + 8 * F.lane + 512 * j, gt[j][0], gt[j][1]); ld8_f32(gfin + 8 * F.lane + 512 * j, gf[j][0], gf[j][1]); }
#pragma unroll 2
        for (int i = 0; i < 16; ++i) { const size_t row = (size_t)(row0 + i);
            const int s1 = TOKSLOT[row * 2], s2 = TOKSLOT[row * 2 + 1];
            f32x4 v[2][2]; float s = 0.f;
#pragma unroll
            for (int j = 0; j < 2; ++j) { f32x4 h0, h1, p0, p1, q0, q1; ld8_bf16(H + row * HPITCH + 8 * F.lane + 512 * j, h0, h1);
                ld8_bf16(Y + (size_t)s1 * D + 8 * F.lane + 512 * j, p0, p1); ld8_bf16(Y + (size_t)s2 * D + 8 * F.lane + 512 * j, q0, q1);
                v[j][0] = h0 + gt[j][0] * (p0 + q0); v[j][1] = h1 + gt[j][1] * (p1 + q1); s += ssq8(v[j][0], v[j][1]); }
            const float rstd = 1.0f / sqrtf(wave_sum(s) * (1.f / D) + EPS);
            asm volatile("" ::: "memory");
#pragma unroll
            for (int j = 0; j < 2; ++j) { float* op = OUT + row * D + 8 * F.lane + 512 * j; *(GAS f32x4*)op = v[j][0] * rstd * gf[j][0]; *(GAS f32x4*)(op + 4) = v[j][1] * rstd * gf[j][1]; }
        }
    }
}
#ifndef MK_ONE_LAUNCH
#define MK_ONE_LAUNCH 1
#endif
constexpr int N_PHASES = 20;
struct Args { const float* in[26]; float* out; unsigned char* ws; int ph_lo, ph_hi; };
static_assert(sizeof(Args) == 26 * 8 + 8 + 8 + 8, "Args has no padding");

__global__ void __launch_bounds__(NWAVES * 64, 2) mk_fwd(Args args) {
    extern __shared__ __attribute__((aligned(16))) unsigned char lds[];
    Frame F;
    F.lds = (LAS unsigned char*)lds;
    F.MISC = (volatile LAS unsigned*)(F.lds + MISC_OFF);
    F.tid = threadIdx.x; F.lane = F.tid & 63; F.wave = __builtin_amdgcn_readfirstlane(F.tid >> 6);
    F.G = gridDim.x; { const int bx = blockIdx.x; F.vcu = (F.G % 8 == 0) ? (bx % 8) * (F.G / 8) + bx / 8 : bx; }
    F.ws = args.ws; F.out = args.out;
#pragma unroll
    for (int i = 0; i < 26; ++i) F.in[i] = args.in[i];
    unsigned char* const ws = args.ws;
    for (int u = F.tid; u < (LDS_BYTES - LDSCTL_OFF) / 4; u += NWAVES * 64) ((LAS unsigned*)(F.lds + LDSCTL_OFF))[u] = 0u;
    __syncthreads();
    const int lo = args.ph_lo, hi = args.ph_hi;
    XcdBarrier bar; bar.bar = (unsigned*)(ws + WS_CTL) + CW_BAR; bar.x = 0; bar.st = nullptr;
    if (hi - lo > 1) bar = xcd_barrier_post((unsigned*)(ws + WS_CTL) + CW_BAR, F.MISC + 8);
#ifndef PHASE_MASK
#define PHASE_MASK 0xFFFFFu
#endif
#define IN(k) (((PHASE_MASK >> (k)) & 1u) && lo <= (k) && (k) < hi)
#ifndef REPEAT_MASK
#define REPEAT_MASK 0u
#endif
#define REP(k) (((REPEAT_MASK >> (k)) & 1u) ? 2 : 1)
#define SEAM(k) do { if (IN(k) && IN((k) + 1)) xcd_barrier(bar); } while (0)
    const float* MODV = (const float*)(ws + WS_MODV);
#define MV(kind) (MODV + (size_t)(kind) * 4 * D)
    bf16* const H = (bf16*)args.out;
    bf16* const XN = (bf16*)(ws + A_XN);
    const pg8::MoeInfo mi0{nullptr, nullptr, 0};

    if (IN(0)) for (int rep_ = 0; rep_ < REP(0); ++rep_) { p0_prologue(F); } SEAM(0);
    if (IN(1)) for (int rep_ = 0; rep_ < REP(1); ++rep_) { norm_phase<false, true>(F, F.in[0], MV(MK_A_MIX0), MV(MK_B_MIX0), XN, nullptr, nullptr, nullptr); } SEAM(1);
    if (IN(2)) for (int rep_ = 0; rep_ < REP(2); ++rep_) { pg8::Gemm g{XN, (const bf16*)(ws + WS_WMLAIN), M, LATP, D}; pg8::StaticOrder S; S.init(M, LATP, F.G, (int)blockIdx.x);
        pg8::EpiBf16 E{(bf16*)(ws + A_LAT), LATP, 1.0f};
        pg8::gemm_phase<pg8::EpiBf16, pg8::StaticOrder, true, true, 0>(F.lds, g, S, E, mi0); } SEAM(2);
    if (IN(3)) for (int rep_ = 0; rep_ < REP(3); ++rep_) { latnorm_phase(F); } SEAM(3);
    if (IN(4)) for (int rep_ = 0; rep_ < REP(4); ++rep_) {
#ifndef P4_SKIP_Q
        { pg8::Gemm g{(const bf16*)(ws + A_QN), (const bf16*)(ws + WS_WQUP), M, QUP, QRANK}; pg8::StaticOrder S; S.init(M, QUP, F.G, (int)blockIdx.x);
          pg8::EpiQ E{(bf16*)(ws + A_Q), QUP, C2_MLA, (const float*)(ws + WS_CS)};
          pg8::gemm_phase<pg8::EpiQ, pg8::StaticOrder, true, true, 0>(F.lds, g, S, E, mi0); }
#endif
#ifndef P4_SKIP_KV
        { pg8::Gemm g{(const bf16*)(ws + A_KVN), (const bf16*)(ws + WS_WKVUP), M, KVUP, KVRANK}; pg8::StaticOrder S; S.init(M, KVUP, F.G, (int)blockIdx.x);
          pg8::EpiKV E{(bf16*)(ws + A_K), (bf16*)(ws + A_V)};
          pg8::gemm_phase<pg8::EpiKV, pg8::StaticOrder, true, true, 0>(F.lds, g, S, E, mi0); }
#endif
    } SEAM(4);
    if (IN(5)) for (int rep_ = 0; rep_ < REP(5); ++rep_) {
        const bf16* Qp = (const bf16*)(ws + A_Q); const bf16* Kp = (const bf16*)(ws + A_K); const bf16* Vp = (const bf16*)(ws + A_V); bf16* Op = (bf16*)(ws + A_O);
        if (F.G == 256) {
            for (int i = 0; i < 8; ++i) { const int bh = (F.vcu >> 3) + 32 * (i >> 2), s = F.vcu & 7, k = i & 3; const int qb = (k == 0) ? s : (k == 1) ? 15 - s : (k == 2) ? 16 + s : 31 - s;
                const int b = bh >> 4, h = bh & 15;
                mla::attn_unit<8>(b, h, qb, Qp, Kp, Vp, Op, (char*)lds); }
        } else {
            for (int u = (int)blockIdx.x; u < BATCH * MLA_H * 32; u += F.G) { const int bh = u >> 5, qb = 31 - (u & 31); const int b = bh >> 4, h = bh & 15;
                mla::attn_unit<8>(b, h, qb, Qp, Kp, Vp, Op, (char*)lds); }
        }
    } SEAM(5);
    if (IN(6)) for (int rep_ = 0; rep_ < REP(6); ++rep_) { pg8::Gemm g{(const bf16*)(ws + A_O), (const bf16*)(ws + WS_WOUT), M, D, D}; pg8::StaticOrder S; S.init(M, D, F.G, (int)blockIdx.x);
        pg8::EpiResid<true> E{F.in[0], H, MV(MK_G_MIX0)};
        pg8::gemm_phase<pg8::EpiResid<true>, pg8::StaticOrder, true, true, 0>(F.lds, g, S, E, mi0); } SEAM(6);
    if (IN(7)) for (int rep_ = 0; rep_ < REP(7); ++rep_) { norm_phase<false, false>(F, H, MV(MK_A_FFN0), MV(MK_B_FFN0), XN, nullptr, nullptr, nullptr); } SEAM(7);
    if (IN(8)) for (int rep_ = 0; rep_ < REP(8); ++rep_) { pg8::Gemm g{XN, (const bf16*)(ws + WS_WFGU), M, 2 * DFF, D}; pg8::StaticOrder S; S.init(M, 2 * DFF, F.G, (int)blockIdx.x);
        pg8::EpiSwiGLU E{(bf16*)(ws + A_HID), DFF};
        pg8::gemm_phase<pg8::EpiSwiGLU, pg8::StaticOrder, true, true, 0>(F.lds, g, S, E, mi0); } SEAM(8);
    if (IN(9)) for (int rep_ = 0; rep_ < REP(9); ++rep_) { pg8::Gemm g{(const bf16*)(ws + A_HID), (const bf16*)(ws + WS_WFDN), M, D, DFF}; pg8::StaticOrder S; S.init(M, D, F.G, (int)blockIdx.x);
        pg8::EpiResid<false> E{H, H, MV(MK_G_FFN0)};
        pg8::gemm_phase<pg8::EpiResid<false>, pg8::StaticOrder, true, true, 0>(F.lds, g, S, E, mi0); } SEAM(9);
    if (IN(10)) for (int rep_ = 0; rep_ < REP(10); ++rep_) { norm_phase<true, false>(F, H, MV(MK_A_MIX1), MV(MK_B_MIX1), XN, MV(MK_A_KV), MV(MK_B_KV), (bf16*)(ws + A_XNKV)); } SEAM(10);
    if (IN(11)) for (int rep_ = 0; rep_ < REP(11); ++rep_) {
        { pg8::Gemm g{(const bf16*)(ws + A_XNKV), (const bf16*)(ws + WS_WKVB), M, DILKV, D}; pg8::StaticOrder S; S.init(M, DILKV, F.G, (int)blockIdx.x);
          pg8::EpiBf16 E{(bf16*)(ws + A_KVB), DILKV, 1.0f};
          pg8::gemm_phase<pg8::EpiBf16, pg8::StaticOrder, true, true, 0>(F.lds, g, S, E, mi0); }
        { pg8::Gemm g{XN, (const bf16*)(ws + WS_WQB), M, DILQ, D}; pg8::StaticOrder S; S.init(M, DILQ, F.G, (int)blockIdx.x);
          pg8::EpiBf16 E{(bf16*)(ws + A_QB), DILQ, C2_DIL};
          pg8::gemm_phase<pg8::EpiBf16, pg8::StaticOrder, true, true, 0>(F.lds, g, S, E, mi0); }
    } SEAM(11);
    if (IN(12)) for (int rep_ = 0; rep_ < REP(12); ++rep_) {
        const bf16* Qp = (const bf16*)(ws + A_QB); const bf16* KV = (const bf16*)(ws + A_KVB); bf16* OG = (bf16*)(ws + A_OG); float* LSE = (float*)(ws + WS_LSE); const float* BT = (const float*)(ws + WS_BIAS);
        for (int u = (int)blockIdx.x; u < BATCH * 3 * 32 * 8; u += F.G) { const int h = u & 7, x = (u >> 3) & 31, bg = u >> 8; const int g = bg % 3, b = bg / 3;
            const int dil = (g == 0) ? 1 : (g == 1) ? 4 : 16; const int r = x % dil, qb = x / dil;
            att::attn_unit<64, true>(Qp + g * 512 + h * 64, DILQ, KV + g * 1024 + h * 64, DILKV, KV + g * 1024 + 512 + h * 64, DILKV, OG + (size_t)g * M * DILOUT + h * 64, DILOUT,
                                     LSE + (size_t)g * M * 8 + h, BT + (g * 8 + h) * 132, (long)b * SEQ + r, dil, qb * 256, (char*)lds); }
    } SEAM(12);
    if (IN(13)) for (int rep_ = 0; rep_ < REP(13); ++rep_) { merge_phase(F); } SEAM(13);
    if (IN(14)) for (int rep_ = 0; rep_ < REP(14); ++rep_) { pg8::Gemm g{(const bf16*)(ws + A_OD), (const bf16*)(ws + WS_WOB), M, D, DILOUT}; pg8::StaticOrder S; S.init(M, D, F.G, (int)blockIdx.x);
        pg8::EpiResid<false> E{H, H, MV(MK_G_MIX1)};
        pg8::gemm_phase<pg8::EpiResid<false>, pg8::StaticOrder, true, true, 0>(F.lds, g, S, E, mi0); } SEAM(14);
    if (IN(15)) for (int rep_ = 0; rep_ < REP(15); ++rep_) { router_phase(F, H, MV(MK_A_FFN1), MV(MK_B_FFN1), XN); } SEAM(15);
    if (IN(16)) for (int rep_ = 0; rep_ < REP(16); ++rep_) { lists_phase(F); } SEAM(16);
    if (IN(17)) for (int rep_ = 0; rep_ < REP(17); ++rep_) { const int ntile = ((const int*)(ws + WS_TILEEXP))[300];
        pg8::Gemm g{XN, (const bf16*)(ws + WS_WEGU), ntile * 256, 2 * DFF, D}; pg8::StaticOrder S; S.init(ntile * 256, 2 * DFF, F.G, (int)blockIdx.x);
        pg8::EpiSwiGLU E{(bf16*)(ws + A_HIDS), DFF};
        const pg8::MoeInfo mi{(const int*)(ws + WS_LIST), (const int*)(ws + WS_TILEEXP), (size_t)2 * DFF * D * 2};
        pg8::gemm_phase<pg8::EpiSwiGLU, pg8::StaticOrder, true, true, 1>(F.lds, g, S, E, mi); } SEAM(17);
    if (IN(18)) for (int rep_ = 0; rep_ < REP(18); ++rep_) { const int ntile = ((const int*)(ws + WS_TILEEXP))[300];
        pg8::Gemm g{(const bf16*)(ws + A_HIDS), (const bf16*)(ws + WS_WEDN), ntile * 256, D, DFF}; pg8::StaticOrder S; S.init(ntile * 256, D, F.G, (int)blockIdx.x);
        pg8::EpiMoeDown E{(bf16*)(ws + A_Y), (const float*)(ws + WS_SLOTG)};
        const pg8::MoeInfo mi{(const int*)(ws + WS_LIST), (const int*)(ws + WS_TILEEXP), (size_t)D * DFF * 2};
        pg8::gemm_phase<pg8::EpiMoeDown, pg8::StaticOrder, true, true, 2>(F.lds, g, S, E, mi); } SEAM(18);
    if (IN(19)) for (int rep_ = 0; rep_ < REP(19); ++rep_) { final_phase(F, args.out, MV(MK_G_FFN1), F.in[25]); }
#undef IN
#undef SEAM
#undef MV
}

extern "C" void kernel_launch(void* const* d_in, const int* in_sizes, int n_in, void* d_out, int out_size, void* d_ws, size_t ws_size, hipStream_t stream) {
    static int grid = 0;
    if (grid == 0) {
        if (n_in != 26 || in_sizes[0] != M * D || out_size != M * D || ws_size < WS_END) { fprintf(stderr, "kernel_launch: unexpected shapes (n_in %d, in0 %d, out %d, ws %zu, need %zu); nothing launched\n", n_in, n_in > 0 ? in_sizes[0] : -1, out_size, ws_size, (size_t)WS_END); grid = -1; return; }
        int dev = 0, cus = 0, per_cu = 0;
        if (hipGetDevice(&dev) != hipSuccess || hipDeviceGetAttribute(&cus, hipDeviceAttributeMultiprocessorCount, dev) != hipSuccess) { grid = -1; return; }
        if (hipFuncSetAttribute((const void*)mk_fwd, hipFuncAttributeMaxDynamicSharedMemorySize, LDS_BYTES) != hipSuccess) { fprintf(stderr, "kernel_launch: hipFuncSetAttribute failed\n"); grid = -1; return; }
        if (hipOccupancyMaxActiveBlocksPerMultiprocessor(&per_cu, (const void*)mk_fwd, NWAVES * 64, LDS_BYTES) != hipSuccess || per_cu < 1) { fprintf(stderr, "kernel_launch: occupancy query reports %d\n", per_cu); }
        (void)hipGetLastError();
        grid = cus;
    }
    if (grid < 0) return;
    if (hipMemsetAsync((char*)d_ws + WS_CTL, 0, CTL_ZERO_BYTES, stream) != hipSuccess) return;
    Args a{};
    for (int i = 0; i < 26; ++i) a.in[i] = (const float*)d_in[i];
    a.out = (float*)d_out; a.ws = (unsigned char*)d_ws;
#if MK_ONE_LAUNCH
    a.ph_lo = 0; a.ph_hi = N_PHASES;
    hipLaunchKernelGGL(mk_fwd, dim3(grid), dim3(NWAVES * 64), LDS_BYTES, stream, a);
#else
    for (int p = 0; p < N_PHASES; ++p) { a.ph_lo = p; a.ph_hi = p + 1; hipLaunchKernelGGL(mk_fwd, dim3(grid), dim3(NWAVES * 64), LDS_BYTES, stream, a); }
#endif
}
```

```cpp
#include <hip/hip_runtime.h>
#include <hip/hip_bf16.h>
#include <cstdio>
#include <cstdint>
#include <cmath>
#ifndef MK_ONE_LAUNCH
#define MK_ONE_LAUNCH 1
#endif
#ifndef PG8_STAGGER
#define PG8_STAGGER 0
#endif
namespace pg8 {
#define PG8_LAS __attribute__((address_space(3)))
typedef unsigned short bf16_t;
typedef short bf16x8 __attribute__((ext_vector_type(8)));
typedef float f32x4 __attribute__((ext_vector_type(4)));
typedef float f32x2 __attribute__((ext_vector_type(2)));
typedef unsigned u32x4 __attribute__((ext_vector_type(4)));
constexpr int BM = 256, BK = 64, HALF = 128, HTB = HALF * BK * 2  , STAGE_BYTES = 8 * HTB, NXCD = 8, WGM = 8;

__host__ __device__ __forceinline__ int lds_byte(int r, int c) { const int st = (r >> 4) * 2 + (c >> 5), rr = r & 15, cc = c & 31, ob = rr * 64 + cc * 2; return st * 1024 + (ob ^ (((ob >> 9) & 1) << 5)); }
__host__ __device__ __forceinline__ void stage_rc(int b, int& R, int& C) { const int st = b / 1024, sb = b % 1024, swz = sb ^ (((sb >> 9) & 1) << 5); R = (st >> 1) * 16 + swz / 64; C = (st & 1) * 32 + (swz % 64) / 2; }
__host__ __device__ __forceinline__ int perm32(int rho) { const int n = rho >> 4, i = rho & 15; return 8 * (i >> 2) + 4 * n + (i & 3); }

struct Unit { int pm, pn; };
struct Gemm { const bf16_t* A; const bf16_t* Bt; int M, N, K; };
struct MoeInfo { const int* list; const int* tile_expert; size_t bstride; };

struct StaticOrder {
    int nM, nN, nwg, G, c;
    __host__ __device__ void init(int M, int N, int G_, int c_) { nM = M / BM; nN = N / BM; nwg = nM * nN; G = G_; c = c_; }
    __host__ __device__ bool next(int i, Unit& u) const {
        const long L = (long)i * G + c; if (L >= nwg) return false;
        int wgid = (int)L; { const int q = nwg / NXCD, r = nwg % NXCD, xcd = wgid % NXCD, off = wgid / NXCD; wgid = (xcd < r ? xcd * (q + 1) : r * (q + 1) + (xcd - r) * q) + off; }
        const int nig = WGM * nN, gid = wgid / nig, fm = gid * WGM, gsz = (nM - fm) < WGM ? (nM - fm) : WGM;
        u.pm = fm + ((wgid % nig) % gsz); u.pn = (wgid % nig) / gsz; return true;
    }
    __device__ __forceinline__ void a_ready(const Unit&) const {}
    __device__ __forceinline__ void done(const Unit&) const {}
};

__device__ __forceinline__ unsigned cvt_pk_bf16(float lo, float hi) { unsigned r; asm volatile("v_cvt_pk_bf16_f32 %0, %1, %2" : "=v"(r) : "v"(lo), "v"(hi)); return r; }


template <class Epi, class Sched, bool ALIGN_EPI, bool SP2, int MODE>
__device__ __forceinline__ void gemm_phase(PG8_LAS unsigned char* lds, const Gemm g, const Sched& S, const Epi& E, const MoeInfo mi) {
    const int tid = threadIdx.x, wid = __builtin_amdgcn_readfirstlane(tid >> 6), lane = tid & 63, wr = wid >> 2, wc = wid & 3, fr = lane & 15, fq = lane >> 4;
    int K_ = g.K; asm volatile("" : "+s"(K_));
    const int K = K_, nt = K / BK;
    unsigned voffB[2]; int Rr[2], Cc[2];
#pragma unroll
    for (int i = 0; i < 2; ++i) { int R, C; stage_rc(tid * 16 + i * 8192, R, C); const int Rb = Epi::PERM ? ((R & ~31) + perm32(R & 31)) : R;
        Rr[i] = R; Cc[i] = C; voffB[i] = (unsigned)(Rb * K + C) * 2u; }
    const size_t kstep = (size_t)(BK * 2);
    const size_t hstep = (size_t)HALF * K * 2;
    const size_t tstep = 2 * hstep;
    const unsigned ldsw = (unsigned)wid * 1024u;
    const int aoff = lds_byte(wr * 64 + fr, fq * 8), boff = lds_byte(wc * 32 + fr, fq * 8);
    const unsigned rowb = (unsigned)K * 2u;
#define PG8_SA(b, h) (((b) * 2 + (h)) * HTB)
#define PG8_SB(b, h) ((4 + (b) * 2 + (h)) * HTB)
#define PG8_STAGE(bufoff, gbase, voff) do { _Pragma("unroll") for (int _i = 0; _i < 2; ++_i) \
        __builtin_amdgcn_global_load_lds((const unsigned*)((const char*)(gbase) + (voff)[_i]), (PG8_LAS unsigned*)(lds + (bufoff) + ldsw + _i * 8192), 16, 0, 0); } while (0)
#define PG8_LDA(dst, b, h) do { _Pragma("unroll") for (int m = 0; m < 4; ++m) _Pragma("unroll") for (int k = 0; k < 2; ++k) dst[m][k] = *(const PG8_LAS bf16x8*)(lds + PG8_SA(b, h) + aoff + m * 2048 + k * 1024); } while (0)
#define PG8_LDB(dst, b, h) do { _Pragma("unroll") for (int n = 0; n < 2; ++n) _Pragma("unroll") for (int k = 0; k < 2; ++k) dst[n][k] = *(const PG8_LAS bf16x8*)(lds + PG8_SB(b, h) + boff + n * 2048 + k * 1024); } while (0)
#define PG8_MMA(ai, bj, At, Bt) do { __builtin_amdgcn_s_setprio(1); _Pragma("unroll") for (int m = 0; m < 4; ++m) _Pragma("unroll") for (int n = 0; n < 2; ++n) _Pragma("unroll") for (int k = 0; k < 2; ++k) \
        acc[ai][bj][m][n] = __builtin_amdgcn_mfma_f32_16x16x32_bf16(Bt[n][k], At[m][k], acc[ai][bj][m][n], 0, 0, 0); __builtin_amdgcn_s_setprio(0); } while (0)
#define PG8_WAIT_V(n) asm volatile("s_waitcnt vmcnt(" #n ")" ::: "memory")
#define PG8_WAIT_L(n) asm volatile("s_waitcnt lgkmcnt(" #n ")" ::: "memory")
#define PG8_BAR __builtin_amdgcn_s_barrier()
#define PG8_SCHED __builtin_amdgcn_sched_barrier(0)
#define PG8_MKOFF(u, o) do { _Pragma("unroll") for (int _h = 0; _h < 2; ++_h) _Pragma("unroll") for (int _i = 0; _i < 2; ++_i) { \
        int _row = (u).pm * BM + _h * HALF + Rr[_i]; if (MODE == 1) _row = mi.list[_row]; (o)[_h][_i] = (unsigned)_row * rowb + (unsigned)Cc[_i] * 2u; } } while (0)
#define PG8_BBASE(u) ((const char*)g.Bt + (size_t)(u).pn * tstep + (MODE != 0 ? (size_t)mi.tile_expert[(u).pm] * mi.bstride : (size_t)0))
    Unit cur, nxt; int ui = 0;
    if (!S.next(0, cur)) return;
#if PG8_STAGGER
    {
        const int grp = ((int)blockIdx.x >> 3) & 3;
        if (grp) { if (wid == 0) { const unsigned long long t0 = __builtin_amdgcn_s_memrealtime(); const unsigned long long dt = (unsigned long long)(grp * nt * PG8_STAGGER);
                       while (__builtin_amdgcn_s_memrealtime() - t0 < dt) __builtin_amdgcn_s_sleep(8); }
                   __syncthreads(); }
    }
#endif
    f32x4 acc[2][2][4][2];
#pragma unroll
    for (int a = 0; a < 2; ++a)
#pragma unroll
        for (int b = 0; b < 2; ++b)
#pragma unroll
            for (int m = 0; m < 4; ++m)
#pragma unroll
                for (int n = 0; n < 2; ++n) acc[a][b][m][n] = (f32x4){0.f, 0.f, 0.f, 0.f};
    bf16x8 At[4][2], B0[2][2], B1[2][2];
    unsigned oc[2][2], on[2][2];
    PG8_MKOFF(cur, oc);
    const char* const Ab = (const char*)g.A;
    const char* cB = PG8_BBASE(cur);
    S.a_ready(cur);
    static_assert(SP2, "only the SP2 loop is kept");
    {
        PG8_STAGE(PG8_SB(0, 0), cB, voffB); PG8_STAGE(PG8_SB(0, 1), cB + hstep, voffB); PG8_STAGE(PG8_SA(0, 0), Ab, oc[0]); PG8_STAGE(PG8_SA(0, 1), Ab, oc[1]);
        if (wr == 1) PG8_BAR;
        PG8_WAIT_V(2); PG8_BAR;
        PG8_STAGE(PG8_SB(1, 0), cB + kstep, voffB); PG8_STAGE(PG8_SA(1, 0), Ab + kstep, oc[0]); PG8_STAGE(PG8_SB(1, 1), cB + hstep + kstep, voffB);
        PG8_WAIT_V(6); PG8_BAR;
    }
    Unit nn; unsigned onn[2][2]; bool has_next_c = false;
    if constexpr (MODE == 1) { has_next_c = S.next(1, nxt); if (has_next_c) PG8_MKOFF(nxt, on); }
    for (;;) {
        bool has_next; bool has_nn = false;
        if constexpr (MODE == 1) { has_next = has_next_c; has_nn = has_next && S.next(ui + 2, nn); if (has_nn) PG8_MKOFF(nn, onn); }
        else has_next = S.next(ui + 1, nxt);
        const char* nB = cB;
        if (has_next) { if constexpr (MODE != 1) PG8_MKOFF(nxt, on); nB = PG8_BBASE(nxt); }
        else {
#pragma unroll
            for (int _h = 0; _h < 2; ++_h)
#pragma unroll
                for (int _i = 0; _i < 2; ++_i) on[_h][_i] = oc[_h][_i];
        }
        for (int t = 0; t < nt; t += 2) {
            const bool last = (t == nt - 2);
            const char* a1 = Ab + (size_t)(t + 1) * kstep;
            const char* a2 = last ? Ab : Ab + (size_t)(t + 2) * kstep; const char* b2 = last ? nB : cB + (size_t)(t + 2) * kstep;
            const char* a3 = a2 + kstep; const char* b3 = b2 + kstep;
            unsigned o2[2][2];
#pragma unroll
            for (int _h = 0; _h < 2; ++_h)
#pragma unroll
                for (int _i = 0; _i < 2; ++_i) o2[_h][_i] = last ? on[_h][_i] : oc[_h][_i];
            if (last && has_next) S.a_ready(nxt);
            PG8_LDB(B0, 0, 0); PG8_LDB(B1, 0, 1); PG8_SCHED; PG8_LDA(At, 0, 0); PG8_STAGE(PG8_SA(1, 1), a1, oc[1]);
            PG8_WAIT_V(8); PG8_WAIT_L(0); PG8_BAR; PG8_MMA(0, 0, At, B0); PG8_MMA(0, 1, At, B1); PG8_BAR; PG8_SCHED;
            PG8_LDA(At, 0, 1); PG8_STAGE(PG8_SB(0, 0), b2, voffB); PG8_STAGE(PG8_SB(0, 1), b2 + hstep, voffB); PG8_STAGE(PG8_SA(0, 0), a2, o2[0]);
            PG8_WAIT_V(8); PG8_WAIT_L(0); PG8_BAR; PG8_MMA(1, 0, At, B0); PG8_MMA(1, 1, At, B1); PG8_BAR; PG8_SCHED;
            PG8_LDB(B0, 1, 0); PG8_LDB(B1, 1, 1); PG8_SCHED; PG8_LDA(At, 1, 0); PG8_STAGE(PG8_SA(0, 1), a2, o2[1]);
            PG8_WAIT_V(8); PG8_WAIT_L(0); PG8_BAR; PG8_MMA(0, 0, At, B0); PG8_MMA(0, 1, At, B1); PG8_BAR; PG8_SCHED;
            PG8_LDA(At, 1, 1); PG8_STAGE(PG8_SB(1, 0), b3, voffB); PG8_STAGE(PG8_SB(1, 1), b3 + hstep, voffB); PG8_STAGE(PG8_SA(1, 0), a3, o2[0]);
            PG8_WAIT_V(8); PG8_WAIT_L(0); PG8_BAR; PG8_MMA(1, 0, At, B0); PG8_MMA(1, 1, At, B1); PG8_BAR; PG8_SCHED;
        }
        if constexpr (ALIGN_EPI) { if (wr == 0) PG8_BAR; }
        E(acc, cur, wr, wc, fr, fq); S.done(cur);
        if (!has_next) break;
#pragma unroll
        for (int a = 0; a < 2; ++a)
#pragma unroll
            for (int b = 0; b < 2; ++b)
#pragma unroll
                for (int m = 0; m < 4; ++m)
#pragma unroll
                    for (int n = 0; n < 2; ++n) acc[a][b][m][n] = (f32x4){0.f, 0.f, 0.f, 0.f};
        cur = nxt; cB = nB; ++ui;
#pragma unroll
        for (int _h = 0; _h < 2; ++_h)
#pragma unroll
            for (int _i = 0; _i < 2; ++_i) oc[_h][_i] = on[_h][_i];
        if constexpr (MODE == 1) { nxt = nn; has_next_c = has_nn;
#pragma unroll
            for (int _h = 0; _h < 2; ++_h)
#pragma unroll
                for (int _i = 0; _i < 2; ++_i) on[_h][_i] = onn[_h][_i]; }
        if constexpr (ALIGN_EPI) { if (wr == 1) PG8_BAR; }
    }
    PG8_WAIT_V(0);
    if constexpr (!ALIGN_EPI) { if (wr == 0) PG8_BAR; }
    PG8_BAR;
#undef PG8_SA
#undef PG8_SB
#undef PG8_STAGE
#undef PG8_LDA
#undef PG8_LDB
#undef PG8_MMA
#undef PG8_WAIT_V
#undef PG8_WAIT_L
#undef PG8_BAR
#undef PG8_SCHED
#undef PG8_MKOFF
#undef PG8_BBASE
}
}
namespace pg8 {
constexpr float LOG2E = 1.4426950408889634f;
struct EpiBf16 {
    static constexpr bool PERM = true;
    bf16_t* O; int ldc; float scale;
    __device__ __forceinline__ void operator()(const f32x4 (&acc)[2][2][4][2], const Unit& u, int wr, int wc, int fr, int fq) const {
        const int row0 = u.pm * BM + wr * 64 + fr; const int col0 = u.pn * BM + wc * 32 + 8 * fq;
#pragma unroll
        for (int ai = 0; ai < 2; ++ai)
#pragma unroll
            for (int m = 0; m < 4; ++m) { bf16_t* rowp = O + (size_t)(row0 + ai * HALF + m * 16) * ldc + col0;
#pragma unroll
                for (int bj = 0; bj < 2; ++bj) { const f32x4 v0 = acc[ai][bj][m][0] * scale, v1 = acc[ai][bj][m][1] * scale;
                    u32x4 w; w.x = cvt_pk_bf16(v0[0], v0[1]); w.y = cvt_pk_bf16(v0[2], v0[3]); w.z = cvt_pk_bf16(v1[0], v1[1]); w.w = cvt_pk_bf16(v1[2], v1[3]);
                    *(u32x4*)(rowp + bj * HALF) = w; } }
    }
};
struct EpiQ {
    static constexpr bool PERM = true;
    bf16_t* O; int ldc; float scale; const float* cs;
    __device__ __forceinline__ void operator()(const f32x4 (&acc)[2][2][4][2], const Unit& u, int wr, int wc, int fr, int fq) const {
        const int row0 = u.pm * BM + wr * 64 + fr; const int col0 = u.pn * BM + wc * 32 + 8 * fq;
        const int grp = u.pn * 8 + wc;
#pragma unroll
        for (int bj = 0; bj < 2; ++bj) { const bool rope = ((grp + 4 * bj) % 3) == 2;
#pragma unroll
            for (int ai = 0; ai < 2; ++ai)
#pragma unroll
                for (int m = 0; m < 4; ++m) { const int row = row0 + ai * HALF + m * 16; bf16_t* rowp = O + (size_t)row * ldc + col0 + bj * HALF;
                    f32x4 v0 = acc[ai][bj][m][0] * scale, v1 = acc[ai][bj][m][1] * scale;
                    if (rope) { const f32x4* cp = (const f32x4*)(cs + (size_t)row * 32 + 8 * fq); const f32x4 c0 = cp[0], c1 = cp[1];
                        f32x4 r0, r1;
                        r0[0] = v0[0] * c0[0] - v0[1] * c0[1]; r0[1] = v0[0] * c0[1] + v0[1] * c0[0];
                        r0[2] = v0[2] * c0[2] - v0[3] * c0[3]; r0[3] = v0[2] * c0[3] + v0[3] * c0[2];
                        r1[0] = v1[0] * c1[0] - v1[1] * c1[1]; r1[1] = v1[0] * c1[1] + v1[1] * c1[0];
                        r1[2] = v1[2] * c1[2] - v1[3] * c1[3]; r1[3] = v1[2] * c1[3] + v1[3] * c1[2];
                        v0 = r0; v1 = r1; }
                    u32x4 w; w.x = cvt_pk_bf16(v0[0], v0[1]); w.y = cvt_pk_bf16(v0[2], v0[3]); w.z = cvt_pk_bf16(v1[0], v1[1]); w.w = cvt_pk_bf16(v1[2], v1[3]);
                    *(u32x4*)rowp = w;
                    if (m & 1) asm volatile("" ::: "memory"); } }
    }
};
struct EpiKV {
    static constexpr bool PERM = true;
    bf16_t* Kb; bf16_t* Vb;
    __device__ __forceinline__ void operator()(const f32x4 (&acc)[2][2][4][2], const Unit& u, int wr, int wc, int fr, int fq) const {
        const int row0 = u.pm * BM + wr * 64 + fr;
        const bool isk = wc < 2;
        bf16_t* const base = isk ? Kb : Vb; const int pitch = isk ? 1536 : 1024, hs = isk ? 96 : 64, j0 = (isk ? wc : wc - 2) * 32 + 8 * fq;
#pragma unroll
        for (int ai = 0; ai < 2; ++ai)
#pragma unroll
            for (int m = 0; m < 4; ++m) { bf16_t* rowp = base + (size_t)(row0 + ai * HALF + m * 16) * pitch + j0;
#pragma unroll
                for (int bj = 0; bj < 2; ++bj) { const f32x4 v0 = acc[ai][bj][m][0], v1 = acc[ai][bj][m][1];
                    u32x4 w; w.x = cvt_pk_bf16(v0[0], v0[1]); w.y = cvt_pk_bf16(v0[2], v0[3]); w.z = cvt_pk_bf16(v1[0], v1[1]); w.w = cvt_pk_bf16(v1[2], v1[3]);
                    *(u32x4*)(rowp + (2 * u.pn + bj) * hs) = w; } }
    }
};
template <bool BASEF32> struct EpiResid {
    static constexpr bool PERM = true;
    static constexpr int HP = 2048;
    const void* base; bf16_t* out; const float* gate;
    __device__ __forceinline__ void operator()(const f32x4 (&acc)[2][2][4][2], const Unit& u, int wr, int wc, int fr, int fq) const {
        const int row0 = u.pm * BM + wr * 64 + fr; const int col0 = u.pn * BM + wc * 32 + 8 * fq;
        const float* gp = gate + (size_t)((u.pm * BM) >> 13) * 1024 + col0;
        f32x4 gv[2][2];
#pragma unroll
        for (int bj = 0; bj < 2; ++bj)
#pragma unroll
            for (int n = 0; n < 2; ++n) gv[bj][n] = *(const f32x4*)(gp + bj * HALF + n * 4);
#pragma unroll
        for (int ai = 0; ai < 2; ++ai)
#pragma unroll
            for (int m = 0; m < 4; ++m) { const size_t row = (size_t)(row0 + ai * HALF + m * 16);
#pragma unroll
                for (int bj = 0; bj < 2; ++bj) { f32x4 b0, b1;
                    if (BASEF32) { const float* bp = (const float*)base + row * 1024 + col0 + bj * HALF; b0 = *(const f32x4*)bp; b1 = *(const f32x4*)(bp + 4); }
                    else { const u32x4 hb = *(const u32x4*)((const bf16_t*)base + row * HP + col0 + bj * HALF);
                        b0 = (f32x4){__builtin_bit_cast(float, hb.x << 16), __builtin_bit_cast(float, hb.x & 0xffff0000u), __builtin_bit_cast(float, hb.y << 16), __builtin_bit_cast(float, hb.y & 0xffff0000u)};
                        b1 = (f32x4){__builtin_bit_cast(float, hb.z << 16), __builtin_bit_cast(float, hb.z & 0xffff0000u), __builtin_bit_cast(float, hb.w << 16), __builtin_bit_cast(float, hb.w & 0xffff0000u)}; }
                    const f32x4 v0 = b0 + gv[bj][0] * acc[ai][bj][m][0], v1 = b1 + gv[bj][1] * acc[ai][bj][m][1];
                    u32x4 w; w.x = cvt_pk_bf16(v0[0], v0[1]); w.y = cvt_pk_bf16(v0[2], v0[3]); w.z = cvt_pk_bf16(v1[0], v1[1]); w.w = cvt_pk_bf16(v1[2], v1[3]);
                    *(u32x4*)(out + row * HP + col0 + bj * HALF) = w; }
                if (m & 1) asm volatile("" ::: "memory"); }
    }
};
__device__ __forceinline__ float silu_mul(float g, float u) { return g * u * __builtin_amdgcn_rcpf(1.0f + __builtin_amdgcn_exp2f(-g * LOG2E)); }
struct EpiSwiGLU {
    static constexpr bool PERM = true;
    bf16_t* O; int ldc;
    __device__ __forceinline__ void operator()(const f32x4 (&acc)[2][2][4][2], const Unit& u, int wr, int wc, int fr, int fq) const {
        const int row0 = u.pm * BM + wr * 64 + fr; const int col0 = u.pn * HALF + wc * 32 + 8 * fq;
#pragma unroll
        for (int ai = 0; ai < 2; ++ai)
#pragma unroll
            for (int m = 0; m < 4; ++m) { bf16_t* rowp = O + (size_t)(row0 + ai * HALF + m * 16) * ldc + col0;
                const f32x4 g0 = acc[ai][0][m][0], g1 = acc[ai][0][m][1], u0 = acc[ai][1][m][0], u1 = acc[ai][1][m][1];
                u32x4 w; w.x = cvt_pk_bf16(silu_mul(g0[0], u0[0]), silu_mul(g0[1], u0[1])); w.y = cvt_pk_bf16(silu_mul(g0[2], u0[2]), silu_mul(g0[3], u0[3]));
                w.z = cvt_pk_bf16(silu_mul(g1[0], u1[0]), silu_mul(g1[1], u1[1])); w.w = cvt_pk_bf16(silu_mul(g1[2], u1[2]), silu_mul(g1[3], u1[3]));
                *(u32x4*)rowp = w; }
    }
};
struct EpiMoeDown {
    static constexpr bool PERM = true;
    bf16_t* O; const float* sg;
    __device__ __forceinline__ void operator()(const f32x4 (&acc)[2][2][4][2], const Unit& u, int wr, int wc, int fr, int fq) const {
        const int row0 = u.pm * BM + wr * 64 + fr; const int col0 = u.pn * BM + wc * 32 + 8 * fq;
#pragma unroll
        for (int ai = 0; ai < 2; ++ai)
#pragma unroll
            for (int m = 0; m < 4; ++m) { const int row = row0 + ai * HALF + m * 16; const float s = sg[row]; bf16_t* rowp = O + (size_t)row * 1024 + col0;
#pragma unroll
                for (int bj = 0; bj < 2; ++bj) { const f32x4 v0 = acc[ai][bj][m][0] * s, v1 = acc[ai][bj][m][1] * s;
                    u32x4 w; w.x = cvt_pk_bf16(v0[0], v0[1]); w.y = cvt_pk_bf16(v0[2], v0[3]); w.z = cvt_pk_bf16(v1[0], v1[1]); w.w = cvt_pk_bf16(v1[2], v1[3]);
                    *(u32x4*)(rowp + bj * HALF) = w; } }
    }
};
template <bool KV> struct EpiDil {
    static constexpr bool PERM = true;
    bf16_t* O; float scale;
    __device__ __forceinline__ void operator()(const f32x4 (&acc)[2][2][4][2], const Unit& u, int wr, int wc, int fr, int fq) const {
        const int row0 = u.pm * BM + wr * 64 + fr;
#pragma unroll
        for (int bj = 0; bj < 2; ++bj) { const int col = u.pn * BM + bj * HALF + wc * 32 + 8 * fq;
            const int g = KV ? (col >> 10) : (col >> 9), h = (col >> 6) & 7, d = col & 63, kv = KV ? ((col >> 9) & 1) : 0;
            const int sh = 2 * g;
#pragma unroll
            for (int ai = 0; ai < 2; ++ai)
#pragma unroll
                for (int m = 0; m < 4; ++m) { const int row = row0 + ai * HALF + m * 16, b = row >> 13, t = row & 8191;
                    const int r = t & ((1 << sh) - 1), pos = t >> sh;
                    const size_t rec = (size_t)g * 262144 + (size_t)((((b << sh) + r) * 8 + h) * (8192 >> sh) + pos);
                    bf16_t* dst = KV ? (O + rec * 128 + kv * 64 + d) : (O + rec * 64 + d);
                    const f32x4 v0 = acc[ai][bj][m][0] * scale, v1 = acc[ai][bj][m][1] * scale;
                    u32x4 w; w.x = cvt_pk_bf16(v0[0], v0[1]); w.y = cvt_pk_bf16(v0[2], v0[3]); w.z = cvt_pk_bf16(v1[0], v1[1]); w.w = cvt_pk_bf16(v1[2], v1[3]);
                    *(u32x4*)dst = w; } }
    }
};
}
namespace att {
using bf16 = unsigned short;
using bf16x8 = __attribute__((ext_vector_type(8))) short;
using s16x4 = __attribute__((ext_vector_type(4))) short;
using f32x16 = __attribute__((ext_vector_type(16))) float;
using u32x4 = __attribute__((ext_vector_type(4))) unsigned;
constexpr int NW = 8;
constexpr float THR = 8.0f;
__device__ __forceinline__ int crow(int r, int hi) { return (r & 3) + 8 * (r >> 2) + 4 * hi; }
__device__ __forceinline__ void glds16(const void* gsrc, unsigned lds_dst) { unsigned keep;
    asm volatile("s_mov_b32 %0, m0\n\ts_mov_b32 m0, %2\n\ts_nop 0\n\tglobal_load_lds_dwordx4 %1, off\n\ts_mov_b32 m0, %0" : "=&s"(keep) : "v"(gsrc), "s"(lds_dst) : "memory"); }
typedef float f32x2_t __attribute__((ext_vector_type(2))); typedef __bf16 bf16x2_t __attribute__((ext_vector_type(2)));
__device__ __forceinline__ unsigned cvtpk_s(float lo, float hi) { f32x2_t v = {lo, hi}; bf16x2_t b = __builtin_convertvector(v, bf16x2_t); return __builtin_bit_cast(unsigned, b); }
#define ATT_SBAR() __builtin_amdgcn_sched_barrier(0)
#define ATT_WAIT_BAR(N) asm volatile("s_waitcnt vmcnt(" #N ") lgkmcnt(0)\n\ts_barrier" ::: "memory")

template <int DQK> struct Lay {
    static constexpr int NKC = DQK / 8, KSLOT = NKC * 1024, ND0 = DQK / 16;
    static constexpr int LK = 0, LV = 3 * KSLOT, LWS = LV + 3 * 8192, LOST = LWS + NW * 256, LBIAS = LOST + NW * 4096, LEND = LBIAS + 1024;
};
static_assert(Lay<96>::LEND <= 131072 && Lay<64>::LEND <= 131072, "attention LDS");

__device__ __forceinline__ float rowmax32(const f32x16& p0, const f32x16& p1) {
    float a = __builtin_fmaxf(__builtin_fmaxf(p0[0], p0[1]), p1[0]), b = __builtin_fmaxf(__builtin_fmaxf(p0[2], p0[3]), p1[1]); a = __builtin_fmaxf(__builtin_fmaxf(a, p1[2]), p1[3]);
#pragma unroll
    for (int r = 4; r < 16; r += 4) { a = __builtin_fmaxf(__builtin_fmaxf(a, p0[r]), p0[r + 1]); b = __builtin_fmaxf(__builtin_fmaxf(b, p0[r + 2]), p0[r + 3]); a = __builtin_fmaxf(__builtin_fmaxf(a, p1[r]), p1[r + 1]); b = __builtin_fmaxf(__builtin_fmaxf(b, p1[r + 2]), p1[r + 3]); }
    float m = __builtin_fmaxf(a, b);
    auto rr = __builtin_amdgcn_permlane32_swap(__float_as_uint(m), __float_as_uint(m), false, false);
    return __builtin_fmaxf(__uint_as_float(rr[0]), __uint_as_float(rr[1]));
}
__device__ __forceinline__ void pv(f32x16* o, int vb, bf16x8 pa0, bf16x8 pa1, bf16x8 pa2, bf16x8 pa3) {
#pragma unroll
    for (int d0 = 0; d0 < 2; ++d0) { s16x4 lo[4], hi[4];
#pragma unroll
        for (int ks = 0; ks < 4; ++ks) {
            asm volatile("ds_read_b64_tr_b16 %0,%1 offset:%c2" : "=&v"(lo[ks]) : "v"(vb), "i"(d0 * 4096 + ks * 1024) : "memory");
            asm volatile("ds_read_b64_tr_b16 %0,%1 offset:%c2" : "=&v"(hi[ks]) : "v"(vb), "i"(d0 * 4096 + ks * 1024 + 512) : "memory"); }
        asm volatile("s_waitcnt lgkmcnt(0)" ::: "memory"); ATT_SBAR();
#define ATT_PK(k) (bf16x8){lo[k][0], lo[k][1], lo[k][2], lo[k][3], hi[k][0], hi[k][1], hi[k][2], hi[k][3]}
        o[d0] = __builtin_amdgcn_mfma_f32_32x32x16_bf16(pa0, ATT_PK(0), o[d0], 0, 0, 0);
        o[d0] = __builtin_amdgcn_mfma_f32_32x32x16_bf16(pa1, ATT_PK(1), o[d0], 0, 0, 0);
        o[d0] = __builtin_amdgcn_mfma_f32_32x32x16_bf16(pa2, ATT_PK(2), o[d0], 0, 0, 0);
        o[d0] = __builtin_amdgcn_mfma_f32_32x32x16_bf16(pa3, ATT_PK(3), o[d0], 0, 0, 0);
#undef ATT_PK
    }
}

template <int DQK, bool DIL>
__device__ __forceinline__ void attn_unit(const bf16* Qb, int pq, const bf16* __restrict__ Kb, int pk, const bf16* __restrict__ Vb, int pvp, bf16* Ob, int po, float* lse, const float* biasg,
                                          long rowbase, int dil, int q0, char* shm) {
    typedef Lay<DQK> L;
    const int tid = threadIdx.x, lane = tid & 63, r32 = lane & 31, hi = lane >> 5; const int wid = __builtin_amdgcn_readfirstlane(tid >> 6);
    const unsigned lds0 = (unsigned)(uintptr_t)shm;
    float* wsf = (float*)(shm + L::LWS) + wid * 64;
    const int kpos0 = DIL ? q0 - 128 : 0;
    const int t_begin = DIL ? (q0 == 0 ? 2 : 0) : 0;
    const int t_end = DIL ? 6 : (q0 + 256) / 64;
    const int wt0 = DIL ? (wid >> 1) : 0;
    const int wt1 = DIL ? 2 + (wid >> 1) : (q0 + 32 * wid + 31) / 64;
    const bool two_k = (L::NKC > 8) && (wid + 8 < L::NKC);
#define ATT_GROW(pos) (rowbase + (long)(pos) * dil)
#define ATT_ISSUE(t, s) do { const int kp_ = kpos0 + 64 * (t); \
        glds16(Kb + ATT_GROW(kp_ + lane) * pk + wid * 8, (unsigned)__builtin_amdgcn_readfirstlane(lds0 + L::LK + (s) * L::KSLOT + wid * 1024)); \
        if (two_k) glds16(Kb + ATT_GROW(kp_ + lane) * pk + (wid + 8) * 8, (unsigned)__builtin_amdgcn_readfirstlane(lds0 + L::LK + (s) * L::KSLOT + (wid + 8) * 1024)); \
        glds16(Vb + ATT_GROW(kp_ + 16 * (wid & 3) + (lane >> 2)) * pvp + (wid >> 2) * 32 + (lane & 3) * 8, (unsigned)__builtin_amdgcn_readfirstlane(lds0 + L::LV + (s) * 8192 + wid * 1024)); } while (0)
    if (DIL) { if (tid < 129) ((float*)(shm + L::LBIAS))[tid] = biasg[tid]; }
    ATT_ISSUE(t_begin, 0);
    if (t_begin + 1 < t_end) ATT_ISSUE(t_begin + 1, 1);
    bf16x8 qr[L::ND0];
    { const bf16* Qw = Qb + ATT_GROW(q0 + wid * 32 + r32) * pq + hi * 8;
#pragma unroll
      for (int d0 = 0; d0 < L::ND0; ++d0) qr[d0] = *reinterpret_cast<const bf16x8*>(Qw + d0 * 16); }
    float mhat = 0.f, l_reg = 0.f; f32x16 o[2]; o[0] = f32x16{}; o[1] = f32x16{}; f32x16 negm = f32x16{};
    bool first = true;
    const int qrel = (DIL ? 128 : q0) + wid * 32 + r32;
    const int vbl = (int)(lds0 + L::LV) + ((lane >> 4) & 1) * 32 + (lane & 3) * 8 + (4 * hi + ((lane & 15) >> 2)) * 64;
    int slot = 0;
    for (int t = t_begin; t < t_end; ++t) {
        if (t + 1 < t_end) { if (two_k) ATT_WAIT_BAR(3); else ATT_WAIT_BAR(2); } else ATT_WAIT_BAR(0);
        if (t + 2 < t_end) { const int s2 = slot >= 1 ? slot - 1 : 2; ATT_ISSUE(t + 2, s2); }
        if (t >= wt0 && t <= wt1) {
            f32x16 p0, p1;
            { const char* kb = shm + L::LK + slot * L::KSLOT + hi * 1024 + r32 * 16;
#pragma unroll
              for (int d0 = 0; d0 < L::ND0; ++d0) {
                const bf16x8 b0 = *reinterpret_cast<const bf16x8*>(kb + d0 * 2048);
                const bf16x8 b1 = *reinterpret_cast<const bf16x8*>(kb + d0 * 2048 + 512);
                if (d0 == 0) { p0 = __builtin_amdgcn_mfma_f32_32x32x16_bf16(b0, qr[0], negm, 0, 0, 0); p1 = __builtin_amdgcn_mfma_f32_32x32x16_bf16(b1, qr[0], negm, 0, 0, 0); }
                else { p0 = __builtin_amdgcn_mfma_f32_32x32x16_bf16(b0, qr[d0], p0, 0, 0, 0); p1 = __builtin_amdgcn_mfma_f32_32x32x16_bf16(b1, qr[d0], p1, 0, 0, 0); } } }
            if (DIL) { const float* bl = (const float*)(shm + L::LBIAS); const int jb = qrel - 64 * t - 4 * hi;
#pragma unroll
                for (int r = 0; r < 16; ++r) { const int j0 = jb - ((r & 3) + 8 * (r >> 2)), j1 = j0 - 32;
                    const int c0 = j0 < 0 ? 0 : (j0 > 128 ? 128 : j0), c1 = j1 < 0 ? 0 : (j1 > 128 ? 128 : j1);
                    const float b0 = bl[c0], b1 = bl[c1];
                    p0[r] = (j0 >= 0 && j0 <= 128) ? p0[r] + b0 : -INFINITY; p1[r] = (j1 >= 0 && j1 <= 128) ? p1[r] + b1 : -INFINITY; }
            } else if (64 * t + 63 > q0 + 32 * wid) { const int jb = qrel - 64 * t - 4 * hi;
#pragma unroll
                for (int r = 0; r < 16; ++r) { const int j0 = jb - ((r & 3) + 8 * (r >> 2)); if (j0 < 0) p0[r] = -INFINITY; if (j0 - 32 < 0) p1[r] = -INFINITY; } }
            const float rm = rowmax32(p0, p1);
            if (first) { first = false; const float dl = rm; mhat += dl;
#pragma unroll
                for (int r = 0; r < 16; ++r) { p0[r] -= dl; p1[r] -= dl; }
#pragma unroll
                for (int r = 0; r < 16; ++r) negm[r] = -mhat;
            } else if (__any(rm > THR)) { const float dl = __builtin_fmaxf(rm, 0.f); mhat += dl;
#pragma unroll
                for (int r = 0; r < 16; ++r) { p0[r] -= dl; p1[r] -= dl; }
#pragma unroll
                for (int r = 0; r < 16; ++r) negm[r] = -mhat;
                const float f = __builtin_amdgcn_exp2f(-dl); l_reg *= f; if (hi == 0) wsf[r32] = f;
                asm volatile("s_waitcnt lgkmcnt(0)" ::: "memory");
#pragma unroll
                for (int d_ = 0; d_ < 2; ++d_)
#pragma unroll
                    for (int r = 0; r < 16; ++r) o[d_][r] *= wsf[crow(r, hi)];
                asm volatile("s_waitcnt lgkmcnt(0)" ::: "memory");
            }
            float sacc = 0.f;
#pragma unroll
            for (int r = 0; r < 16; ++r) { p0[r] = __builtin_amdgcn_exp2f(p0[r]); p1[r] = __builtin_amdgcn_exp2f(p1[r]); sacc += p0[r] + p1[r]; }
            l_reg += sacc;
            u32x4 pw0, pw1, pw2, pw3;
#define ATT_PKW(P, B) cvtpk_s(P[B], P[B + 1])
            pw0 = (u32x4){ATT_PKW(p0, 0), ATT_PKW(p0, 2), ATT_PKW(p0, 4), ATT_PKW(p0, 6)}; pw1 = (u32x4){ATT_PKW(p0, 8), ATT_PKW(p0, 10), ATT_PKW(p0, 12), ATT_PKW(p0, 14)};
            pw2 = (u32x4){ATT_PKW(p1, 0), ATT_PKW(p1, 2), ATT_PKW(p1, 4), ATT_PKW(p1, 6)}; pw3 = (u32x4){ATT_PKW(p1, 8), ATT_PKW(p1, 10), ATT_PKW(p1, 12), ATT_PKW(p1, 14)};
#undef ATT_PKW
            ATT_SBAR();
            pv(o, vbl + slot * 8192, __builtin_bit_cast(bf16x8, pw0), __builtin_bit_cast(bf16x8, pw1), __builtin_bit_cast(bf16x8, pw2), __builtin_bit_cast(bf16x8, pw3));
        }
        slot = slot == 2 ? 0 : slot + 1;
    }
    { auto rr = __builtin_amdgcn_permlane32_swap(__float_as_uint(l_reg), __float_as_uint(l_reg), false, false); l_reg = __uint_as_float(rr[0]) + __uint_as_float(rr[1]); }
    if (hi == 0) wsf[32 + r32] = l_reg;
    asm volatile("s_waitcnt lgkmcnt(0)" ::: "memory");
    float rli[16];
#pragma unroll
    for (int r = 0; r < 16; ++r) rli[r] = __builtin_amdgcn_rcpf(wsf[32 + crow(r, hi)]);
    if (DIL) { if (hi == 0) lse[ATT_GROW(q0 + wid * 32 + r32) * 8] = mhat + __builtin_amdgcn_logf(l_reg); }
    { bf16* stg = (bf16*)(shm + L::LOST) + wid * 2048;
#pragma unroll
      for (int r = 0; r < 16; ++r) { const int orow = crow(r, hi);
#pragma unroll
        for (int d0 = 0; d0 < 2; ++d0) stg[orow * 64 + d0 * 32 + r32] = (bf16)(cvtpk_s(o[d0][r] * rli[r], 0.f) & 0xffffu); }
      asm volatile("s_waitcnt lgkmcnt(0)" ::: "memory");
#pragma unroll
      for (int i = 0; i < 4; ++i) { const int row = i * 8 + (lane >> 3), ch = lane & 7; const u32x4 v = *(const u32x4*)(stg + row * 64 + ch * 8);
        *(u32x4*)(Ob + ATT_GROW(q0 + wid * 32 + row) * po + ch * 8) = v; } }
    asm volatile("s_waitcnt lgkmcnt(0)\n\ts_barrier" ::: "memory");
#undef ATT_GROW
#undef ATT_ISSUE
}
#undef ATT_SBAR
#undef ATT_WAIT_BAR
}
namespace mla {
using bf16 = unsigned short;
using bf16x8 = __attribute__((ext_vector_type(8))) short;
using s16x4 = __attribute__((ext_vector_type(4))) short;
using f32x16 = __attribute__((ext_vector_type(16))) float;
using u32x4 = __attribute__((ext_vector_type(4))) unsigned;
constexpr int SEQL = 8192, PQ = 1536, PV = 1024, HQ = 96, HV = 64;
constexpr int NW = 8, QBLK = 32, QB = QBLK * NW, KVBLK = 64;
__device__ __forceinline__ int crow(int r, int hi) { return (r & 3) + 8 * (r >> 2) + 4 * hi; }
#define SBAR() __builtin_amdgcn_sched_barrier(0)
__device__ __forceinline__ void cmask(f32x16& p0, f32x16& p1, int jb, int qrel, int hi) {
    const float NEG = -INFINITY; int kb = 64 * jb + 4 * hi;
#pragma unroll
    for (int r = 0; r < 16; ++r) { int kv = kb + (r & 3) + 8 * (r >> 2); if (kv > qrel) p0[r] = NEG; if (kv + 32 > qrel) p1[r] = NEG; }
}
constexpr int NSLOT = 3, KSLOTB = 12288, VSLOTB = 8192;
constexpr int LDS_K = 0, LDS_V = NSLOT * KSLOTB, LDS_WS = LDS_V + NSLOT * VSLOTB, LDS_OST = LDS_WS + NW * 64 * 4, LDS_BYTES = LDS_OST + NW * 4096;
static_assert(LDS_BYTES <= 131072, "mla attention LDS");
__device__ __forceinline__ void glds16(const void* gsrc, unsigned lds_dst) { unsigned keep;
    asm volatile("s_mov_b32 %0, m0\n\ts_mov_b32 m0, %2\n\ts_nop 0\n\tglobal_load_lds_dwordx4 %1, off\n\ts_mov_b32 m0, %0" : "=&s"(keep) : "v"(gsrc), "s"(lds_dst) : "memory"); }
__device__ __forceinline__ float max3f(float a, float b, float c) { float r; asm("v_max3_f32 %0, %1, %2, %3" : "=v"(r) : "v"(a), "v"(b), "v"(c)); return r; }
__device__ __forceinline__ float max2f(float a, float b) { float r; asm("v_max_f32_e32 %0, %1, %2" : "=v"(r) : "v"(a), "v"(b)); return r; }
__device__ __forceinline__ float fadd_s(float a, float b) { float r; asm("v_add_f32_e32 %0, %1, %2" : "=v"(r) : "v"(a), "v"(b)); return r; }
__device__ __forceinline__ float fsub_s(float a, float b) { float r; asm("v_sub_f32_e32 %0, %1, %2" : "=v"(r) : "v"(a), "v"(b)); return r; }
typedef float f32x2_t __attribute__((ext_vector_type(2))); typedef __bf16 bf16x2_t __attribute__((ext_vector_type(2)));
__device__ __forceinline__ unsigned cvtpk_s(float lo, float hi) { f32x2_t v = {lo, hi}; bf16x2_t b = __builtin_convertvector(v, bf16x2_t); return __builtin_bit_cast(unsigned, b); }
#define WAIT_BAR(N) asm volatile("s_waitcnt vmcnt(" #N ") lgkmcnt(0)\n\ts_barrier" ::: "memory")

__device__ __forceinline__ void qkt(f32x16& p0, f32x16& p1, const char* Kslot, const bf16x8* qr, const f32x16& negm, int r32, int hi) {
    const char* kb = Kslot + hi * 1024 + r32 * 16;
#pragma unroll
    for (int d0 = 0; d0 < 6; ++d0) {
        const bf16x8 b0 = *reinterpret_cast<const bf16x8*>(kb + d0 * 2048);
        const bf16x8 b1 = *reinterpret_cast<const bf16x8*>(kb + d0 * 2048 + 512);
        if (d0 == 0) { p0 = __builtin_amdgcn_mfma_f32_32x32x16_bf16(b0, qr[0], negm, 0, 0, 0); p1 = __builtin_amdgcn_mfma_f32_32x32x16_bf16(b1, qr[0], negm, 0, 0, 0); }
        else { p0 = __builtin_amdgcn_mfma_f32_32x32x16_bf16(b0, qr[d0], p0, 0, 0, 0); p1 = __builtin_amdgcn_mfma_f32_32x32x16_bf16(b1, qr[d0], p1, 0, 0, 0); } }
}
typedef __attribute__((address_space(3))) const char* lds_cptr;
typedef short v4i16_t __attribute__((ext_vector_type(4)));
__device__ __forceinline__ void kload12(bf16x8* kf, lds_cptr kp) {
#pragma unroll
    for (int j = 0; j < 6; ++j) { kf[2 * j] = *(const __attribute__((address_space(3))) bf16x8*)(kp + j * 2048); kf[2 * j + 1] = *(const __attribute__((address_space(3))) bf16x8*)(kp + j * 2048 + 512); }
}
__device__ __forceinline__ void kload2(bf16x8* kf, lds_cptr kp, int j) { kf[2 * j] = *(const __attribute__((address_space(3))) bf16x8*)(kp + j * 2048); kf[2 * j + 1] = *(const __attribute__((address_space(3))) bf16x8*)(kp + j * 2048 + 512); }
__device__ __forceinline__ s16x4 vtr(lds_cptr p) { return __builtin_bit_cast(s16x4, __builtin_amdgcn_ds_read_tr16_b64_v4i16((__attribute__((address_space(3))) v4i16_t*)p)); }
__device__ __forceinline__ float rowmax(const f32x16& p0, const f32x16& p1) {
    float a = max3f(p0[0], p0[1], p1[0]), b = max3f(p0[2], p0[3], p1[1]); a = max3f(a, p1[2], p1[3]);
#pragma unroll
    for (int r = 4; r < 16; r += 4) { a = max3f(a, p0[r], p0[r + 1]); b = max3f(b, p0[r + 2], p0[r + 3]); a = max3f(a, p1[r], p1[r + 1]); b = max3f(b, p1[r + 2], p1[r + 3]); }
    const float m = max2f(a, b);
    auto rr = __builtin_amdgcn_permlane32_swap(__float_as_uint(m), __float_as_uint(m), false, false);
    return max2f(__uint_as_float(rr[0]), __uint_as_float(rr[1]));
}
__device__ __forceinline__ void pv(f32x16* o, int vb, bf16x8 pa0, bf16x8 pa1, bf16x8 pa2, bf16x8 pa3) {
#pragma unroll
    for (int d0 = 0; d0 < 2; ++d0) { s16x4 lo[4], hi[4];
#pragma unroll
        for (int ks = 0; ks < 4; ++ks) {
            asm volatile("ds_read_b64_tr_b16 %0,%1 offset:%c2" : "=&v"(lo[ks]) : "v"(vb), "i"(d0 * 4096 + ks * 1024) : "memory");
            asm volatile("ds_read_b64_tr_b16 %0,%1 offset:%c2" : "=&v"(hi[ks]) : "v"(vb), "i"(d0 * 4096 + ks * 1024 + 512) : "memory"); }
        asm volatile("s_waitcnt lgkmcnt(0)" ::: "memory"); SBAR();
#define PK(k) (bf16x8){lo[k][0], lo[k][1], lo[k][2], lo[k][3], hi[k][0], hi[k][1], hi[k][2], hi[k][3]}
        o[d0] = __builtin_amdgcn_mfma_f32_32x32x16_bf16(pa0, PK(0), o[d0], 0, 0, 0);
        o[d0] = __builtin_amdgcn_mfma_f32_32x32x16_bf16(pa1, PK(1), o[d0], 0, 0, 0);
        o[d0] = __builtin_amdgcn_mfma_f32_32x32x16_bf16(pa2, PK(2), o[d0], 0, 0, 0);
        o[d0] = __builtin_amdgcn_mfma_f32_32x32x16_bf16(pa3, PK(3), o[d0], 0, 0, 0);
#undef PK
    }
}

template <int THRL> __device__ __forceinline__ void attn_unit(int b, int h, int qb, const bf16* Q, const bf16* __restrict__ K, const bf16* __restrict__ V, bf16* O, char* shm) {
    int tid_ = threadIdx.x; asm volatile("" : "+v"(tid_));
    const int tid = tid_, lane = tid & 63, r32 = lane & 31, hi = lane >> 5; const int wid = __builtin_amdgcn_readfirstlane(tid >> 6);
    const long rowbase = (long)b * SEQL; const int q0 = qb * QB;
    const bf16* Qw = Q + (rowbase + q0 + wid * QBLK) * PQ + h * HQ;
    const bf16* Kh = K + rowbase * PQ + h * HQ; const bf16* Vh = V + rowbase * PV + h * HV;
    const unsigned lds0 = (unsigned)(uintptr_t)shm;
    float* wsf = (float*)(shm + LDS_WS) + wid * 64;
    const bool k2 = wid < 4;
    const bf16* ksrc = Kh + (long)lane * PQ + wid * 8;
    const bf16* vsrc = Vh + (long)(16 * (wid & 3) + (lane >> 2)) * PV + (wid >> 2) * 32 + (lane & 3) * 8;
    const unsigned kdst = lds0 + LDS_K + wid * 1024, vdst = lds0 + LDS_V + wid * 1024;
#define DMA_K(t, slot) do { glds16(ksrc + (long)(t) * KVBLK * PQ, (unsigned)__builtin_amdgcn_readfirstlane(kdst + (slot))); \
        if (k2) glds16(ksrc + (long)(t) * KVBLK * PQ + 64, (unsigned)__builtin_amdgcn_readfirstlane(kdst + (slot) + 8192)); } while (0)
#define DMA_V(t, slot) glds16(vsrc + (long)(t) * KVBLK * PV, (unsigned)__builtin_amdgcn_readfirstlane(vdst + (slot)))
    const int vb0 = (int)(lds0 + LDS_V) + ((lane >> 4) & 1) * 32 + (lane & 3) * 8 + (4 * hi + ((lane & 15) >> 2)) * 64;
    const char* Kbase = shm + LDS_K; bf16x8 kf[12];
    const lds_cptr shm3 = (lds_cptr)shm; const lds_cptr kp0 = shm3 + LDS_K + hi * 1024 + r32 * 16; const lds_cptr vp0 = shm3 + LDS_V + ((lane >> 4) & 1) * 32 + (lane & 3) * 8 + (4 * hi + ((lane & 15) >> 2)) * 64;
    const int NT = (q0 + QB) / KVBLK;
#define WAIT_KV() do { if (k2) WAIT_BAR(3); else WAIT_BAR(2); } while (0)
#define WAIT_KKV() do { if (k2) WAIT_BAR(5); else WAIT_BAR(3); } while (0)
    DMA_K(0, 0); DMA_V(0, 0); DMA_K(1, KSLOTB);
    bf16x8 qr[6];
#pragma unroll
    for (int d0 = 0; d0 < 6; ++d0) qr[d0] = *reinterpret_cast<const bf16x8*>(&Qw[(long)r32 * PQ + d0 * 16 + hi * 8]);
    float mhat = 0.f, l_reg = 0.f; f32x16 o[2]; o[0] = f32x16{}; o[1] = f32x16{}; f32x16 negm = f32x16{}; asm volatile("" : "+v"(negm));
    const int qrel = wid * QBLK + r32;
#define CMASK(P0, P1, t) do { int jb_ = (t) - (NT - 4); if (jb_ >= 0) cmask(P0, P1, jb_, qrel, hi); } while (0)
    bool resc = false;
#define START(P0, P1) do { const float rm = rowmax(P0, P1); resc = false; \
    { const float dl = rm; mhat = fadd_s(mhat, dl); \
      _Pragma("unroll") for (int r = 0; r < 16; ++r) { P0[r] = fsub_s(P0[r], dl); P1[r] = fsub_s(P1[r], dl); } \
      _Pragma("unroll") for (int r = 0; r < 16; ++r) negm[r] = -mhat; asm volatile("" : "+v"(negm)); } \
    _Pragma("unroll") for (int r = 0; r < 16; ++r) P0[r] = __builtin_amdgcn_exp2f(P0[r]); } while (0)
#define RESC() do { if (resc) { asm volatile("s_waitcnt lgkmcnt(0)" ::: "memory"); \
      _Pragma("unroll") for (int d_ = 0; d_ < 2; ++d_) _Pragma("unroll") for (int r = 0; r < 16; ++r) o[d_][r] *= wsf[crow(r, hi)]; } } while (0)
    f32x16 pA0, pA1, pB0, pB1;
    int sl_prev = 0, sl_cur = 0, sl_next = 1;
#define ROT() do { sl_prev = sl_cur; sl_cur = sl_next; sl_next = (sl_next == NSLOT - 1) ? 0 : sl_next + 1; } while (0)
    DMA_K(2, 2 * KSLOTB);
    WAIT_KKV();
    qkt(pA0, pA1, Kbase, qr, negm, r32, hi); asm volatile("s_nop 15\n\ts_nop 7" : "+v"(pA0), "+v"(pA1)); CMASK(pA0, pA1, 0);
    START(pA0, pA1);
#pragma unroll
    for (int r = 0; r < 16; ++r) pA1[r] = __builtin_amdgcn_exp2f(pA1[r]);
    WAIT_BAR(0);
    DMA_K(3, 0); DMA_V(1, VSLOTB);
    ROT();
    kload12(kf, kp0 + sl_cur * KSLOTB);
    WAIT_KV();
    s16x4 vlo[8], vhi[8]; u32x4 pw0, pw1, pw2, pw3;
#define PKW(P, B) cvtpk_s(P[B], P[B + 1])
#define PAF(k) __builtin_bit_cast(bf16x8, pw##k)
#define VFR(i) (bf16x8){vlo[i][0], vlo[i][1], vlo[i][2], vlo[i][3], vhi[i][0], vhi[i][1], vhi[i][2], vhi[i][3]}
#define PIN(x) asm volatile("" : "+v"(x))
#define MX3(a, b, c) __builtin_fmaxf(__builtin_fmaxf((a), (b)), (c))
#define GAPA(MF, A0, A1, A2, A3, W0, W1, PW) do { MF; sacc += A0; sacc += A1; sacc += A2; sacc += A3; PIN(sacc); W0; W1; PIN(PW); SBAR(); } while (0)
#define GAPM(MF) do { MF; SBAR(); } while (0)
#define EX(v) __builtin_amdgcn_exp2f(v)
#define GAPB(MF, X, B) do { MF; X[B] = EX(X[B]); X[B + 1] = EX(X[B + 1]); X[B + 2] = EX(X[B + 2]); X[B + 3] = EX(X[B + 3]); PIN(X); SBAR(); } while (0)
#define VRD(i) do { vlo[i] = vtr(vp_ + (((i) >> 2) * 4096 + ((i) & 3) * 1024)); vhi[i] = vtr(vp_ + (((i) >> 2) * 4096 + ((i) & 3) * 1024 + 512)); } while (0)
#define KRD(G, j) do { if (G) { kload2(kf, kp0 + sl_next * KSLOTB, j); SBAR(); } } while (0)
#define MF32(a, b, c) __builtin_amdgcn_mfma_f32_32x32x16_bf16(a, b, c, 0, 0, 0)
#define STEP(C0, C1, P0, P1, t, GK, GV, GL) do { SBAR(); \
    const lds_cptr vp_ = vp0 + sl_prev * VSLOTB; \
    float sacc = (P0[0] + P0[1]); \
    GAPA(C0 = MF32(kf[0], qr[0], negm), P0[2], P0[3], P0[4], P0[5],     pw0[0] = PKW(P0, 0), pw0[1] = PKW(P0, 2), pw0); \
    GAPA(C1 = MF32(kf[1], qr[0], negm), P0[6], P0[7], P0[8], P0[9],     pw0[2] = PKW(P0, 4), pw0[3] = PKW(P0, 6), pw0); \
    GAPA(C0 = MF32(kf[2], qr[1], C0),   P0[10], P0[11], P0[12], P0[13], pw1[0] = PKW(P0, 8), pw1[1] = PKW(P0, 10), pw1); \
    GAPA(C1 = MF32(kf[3], qr[1], C1),   P0[14], P0[15], P1[0], P1[1],   pw1[2] = PKW(P0, 12), pw1[3] = PKW(P0, 14), pw1); \
    VRD(0); SBAR(); GAPA(C0 = MF32(kf[4], qr[2], C0),   P1[2], P1[3], P1[4], P1[5],     pw2[0] = PKW(P1, 0), pw2[1] = PKW(P1, 2), pw2); \
    VRD(4); SBAR(); GAPA(C1 = MF32(kf[5], qr[2], C1),   P1[6], P1[7], P1[8], P1[9],     pw2[2] = PKW(P1, 4), pw2[3] = PKW(P1, 6), pw2); \
    VRD(1); SBAR(); GAPA(C0 = MF32(kf[6], qr[3], C0),   P1[10], P1[11], P1[12], P1[13], pw3[0] = PKW(P1, 8), pw3[1] = PKW(P1, 10), pw3); \
    VRD(5); SBAR(); GAPA(C1 = MF32(kf[7], qr[3], C1),   P1[14], P1[15], 0.f, 0.f,       pw3[2] = PKW(P1, 12), pw3[3] = PKW(P1, 14), pw3); \
    VRD(2); SBAR(); GAPM(C0 = MF32(kf[8], qr[4], C0)); VRD(6); SBAR(); GAPM(C1 = MF32(kf[9], qr[4], C1)); \
    VRD(3); SBAR(); GAPM(C0 = MF32(kf[10], qr[5], C0)); VRD(7); SBAR(); GAPM(C1 = MF32(kf[11], qr[5], C1)); \
    l_reg += sacc; \
    if (GK) { DMA_K((t) + 3, sl_cur * KSLOTB); } if (GV) { DMA_V((t) + 1, sl_next * VSLOTB); } \
    CMASK(C0, C1, t); \
    { float a = MX3(C0[0], C0[1], C1[0]), b = MX3(C0[2], C0[3], C1[1]); a = MX3(a, C1[2], C1[3]); \
      _Pragma("unroll") for (int r = 4; r < 16; r += 4) { a = MX3(a, C0[r], C0[r + 1]); b = MX3(b, C0[r + 2], C0[r + 3]); a = MX3(a, C1[r], C1[r + 1]); b = MX3(b, C1[r + 2], C1[r + 3]); } \
      float rm = __builtin_fmaxf(a, b); { auto rr = __builtin_amdgcn_permlane32_swap(__float_as_uint(rm), __float_as_uint(rm), false, false); rm = __builtin_fmaxf(__uint_as_float(rr[0]), __uint_as_float(rr[1])); } \
      resc = false; \
      if (__builtin_expect(__any(rm > (float)THRL), 0)) { const float dl = __builtin_fmaxf(rm, 0.f); mhat += dl; \
        _Pragma("unroll") for (int r = 0; r < 16; ++r) { C0[r] -= dl; C1[r] -= dl; } \
        _Pragma("unroll") for (int r = 0; r < 16; ++r) negm[r] = -mhat; asm volatile("" : "+v"(negm)); \
        const float f = __builtin_amdgcn_exp2f(-dl); l_reg *= f; if (hi == 0) wsf[r32] = f; resc = true; } } \
    SBAR(); \
    GAPB(o[0] = MF32(PAF(0), VFR(0), o[0]), C0, 0); \
    KRD(GL, 0); GAPB(o[1] = MF32(PAF(0), VFR(4), o[1]), C0, 4); \
    KRD(GL, 1); GAPB(o[0] = MF32(PAF(1), VFR(1), o[0]), C0, 8); \
    KRD(GL, 2); GAPB(o[1] = MF32(PAF(1), VFR(5), o[1]), C0, 12); \
    KRD(GL, 3); GAPB(o[0] = MF32(PAF(2), VFR(2), o[0]), C1, 0); \
    KRD(GL, 4); GAPB(o[1] = MF32(PAF(2), VFR(6), o[1]), C1, 4); \
    KRD(GL, 5); GAPB(o[0] = MF32(PAF(3), VFR(3), o[0]), C1, 8); \
    GAPB(o[1] = MF32(PAF(3), VFR(7), o[1]), C1, 12); \
    } while (0)
    int t = 1;
#undef CMASK
#define CMASK(P0, P1, t) do { } while (0)
    for (; t + 5 < NT; t += 2) {
        STEP(pB0, pB1, pA0, pA1, t, true, true, true);     WAIT_KV(); RESC(); ROT();
        STEP(pA0, pA1, pB0, pB1, t + 1, true, true, true); WAIT_KV(); RESC(); ROT();
    }
#undef CMASK
#define CMASK(P0, P1, t) do { int jb_ = (t) - (NT - 4); if (jb_ >= 0) cmask(P0, P1, jb_, qrel, hi); } while (0)
#define ENDW(tt) do { if ((tt) + 3 < NT) { WAIT_KV(); } else if ((tt) + 2 < NT) { WAIT_BAR(1); } else { WAIT_BAR(0); } } while (0)
    for (; t + 1 < NT; t += 2) {
        STEP(pB0, pB1, pA0, pA1, t, (t + 3 < NT), (t + 1 < NT), (t + 1 < NT));         ENDW(t);     RESC(); ROT();
        STEP(pA0, pA1, pB0, pB1, t + 1, (t + 4 < NT), (t + 2 < NT), (t + 2 < NT));     ENDW(t + 1); RESC(); ROT();
    }
    STEP(pB0, pB1, pA0, pA1, NT - 1, false, false, false); RESC();
    { float sacc = pB0[0] + pB0[1];
#pragma unroll
      for (int r = 2; r < 16; ++r) sacc += pB0[r];
#pragma unroll
      for (int r = 0; r < 16; ++r) sacc += pB1[r];
      l_reg += sacc;
      pw0 = (u32x4){PKW(pB0, 0), PKW(pB0, 2), PKW(pB0, 4), PKW(pB0, 6)}; pw1 = (u32x4){PKW(pB0, 8), PKW(pB0, 10), PKW(pB0, 12), PKW(pB0, 14)}; pw2 = (u32x4){PKW(pB1, 0), PKW(pB1, 2), PKW(pB1, 4), PKW(pB1, 6)}; pw3 = (u32x4){PKW(pB1, 8), PKW(pB1, 10), PKW(pB1, 12), PKW(pB1, 14)};
      SBAR(); pv(o, vb0 + sl_cur * VSLOTB, PAF(0), PAF(1), PAF(2), PAF(3)); }
#undef PKW
#undef PAF
#undef VFR
#undef PIN
#undef MX3
#undef GAPA
#undef GAPM
#undef GAPB
#undef EX
#undef VRD
#undef KRD
#undef MF32
#undef STEP
#undef ENDW
    { auto rr = __builtin_amdgcn_permlane32_swap(__float_as_uint(l_reg), __float_as_uint(l_reg), false, false); l_reg = __uint_as_float(rr[0]) + __uint_as_float(rr[1]); }
    if (hi == 0) wsf[32 + r32] = l_reg; asm volatile("s_waitcnt lgkmcnt(0)" ::: "memory");
    float rli[16];
#pragma unroll
    for (int r = 0; r < 16; ++r) rli[r] = __builtin_amdgcn_rcpf(wsf[32 + crow(r, hi)]);
    bf16* Ow = O + (rowbase + q0 + wid * QBLK) * PV + h * HV;
    { bf16* stg = (bf16*)(shm + LDS_OST) + wid * 2048;
#pragma unroll
      for (int r = 0; r < 16; ++r) { const int orow = crow(r, hi);
#pragma unroll
        for (int d0 = 0; d0 < 2; ++d0) stg[orow * 64 + d0 * 32 + r32] = (bf16)(cvtpk_s(o[d0][r] * rli[r], 0.f) & 0xffffu); }
      asm volatile("s_waitcnt lgkmcnt(0)" ::: "memory");
#pragma unroll
      for (int i = 0; i < 4; ++i) { const int row = i * 8 + (lane >> 3), ch = lane & 7; const u32x4 v = *(const u32x4*)(stg + row * 64 + ch * 8); *(u32x4*)(Ow + (long)row * PV + ch * 8) = v; } }
    asm volatile("s_waitcnt lgkmcnt(0)\n\ts_barrier" ::: "memory");
#undef DMA_K
#undef DMA_V
#undef CMASK
#undef START
#undef RESC
#undef ROT
#undef WAIT_KV
#undef WAIT_KKV
}
#undef SBAR
#undef WAIT_BAR
}
namespace dila {
using bf16 = unsigned short;
using bf16x8 = __attribute__((ext_vector_type(8))) short;
using f32x16 = __attribute__((ext_vector_type(16))) float;
using u32x4 = __attribute__((ext_vector_type(4))) unsigned;
constexpr int NW = 8, SEQL = 8192, PQ = 1536, PKV = 3072, PO = 512, MROWS = 4 * SEQL;
constexpr int L_K = 0, L_V = 6 * 8192, L_WQ = 12 * 8192, L_WO = L_WQ + NW * 4096, L_WSF = L_WO + NW * 2048, L_BIAS = L_WSF + NW * 256, L_END = L_BIAS + 3 * 288 * 4;
constexpr float THR = 8.0f;
#define DIL_WAIT_BAR(N) asm volatile("s_waitcnt vmcnt(" #N ") lgkmcnt(0)\n\ts_barrier" ::: "memory")
struct UnitP { int sb, oo, lo, rowbase, dil, q0, g; };
__device__ __forceinline__ UnitP decode(int j, int h) {
    const int x = j & 31, bg = j >> 5; const int g = bg % 3, b = bg / 3;
    const int sh = 2 * g, dil = 1 << sh; const int r = x & (dil - 1), qb = x >> sh;
    UnitP p; p.sb = g * 262144 + ((b * dil + r) * 8 + h) * (SEQL >> sh); p.oo = g * MROWS * PO + h * 64; p.lo = g * MROWS * 8 + h;
    p.rowbase = b * SEQL + r; p.dil = dil; p.q0 = qb * 256; p.g = g; return p;
}

__device__ __forceinline__ void dil_phase(const bf16* QB, const bf16* KV, bf16* OG, float* LSE, const float* BT, char* shm, int G) {
    int tid_ = threadIdx.x; asm volatile("" : "+v"(tid_));
    const int tid = tid_, lane = tid & 63, r32 = lane & 31, hi = lane >> 5; const int wid = __builtin_amdgcn_readfirstlane(tid >> 6);
    const unsigned lds0 = (unsigned)(uintptr_t)shm;
    float* wsf = (float*)(shm + L_WSF) + wid * 64;
    char* wq = shm + L_WQ + wid * 4096;
    char* wo = shm + L_WO + wid * 2048;
    const int wt0 = wid >> 1, wt1 = 2 + (wid >> 1);
    const int G8 = G & ~7, c = (int)blockIdx.x;
    if (c >= G8) return;
    const int h = c & 7, j0 = c >> 3, jstep = G8 >> 3;
    const int NU = (384 - j0 + jstep - 1) / jstep;
    for (int i = tid; i < 3 * 288; i += NW * 64) ((float*)(shm + L_BIAS))[i] = BT[((i / 288) * 8 + h) * 288 + (i % 288)];
#define DIL_GROW(P, pos) ((long)((P).rowbase + (pos) * (P).dil))
#define DIL_ISSUE_TILE(P, t) do { int kp_ = (P).q0 - 128 + 64 * (t); if (kp_ < 0) kp_ = 0; \
        att::glds16(KV + (size_t)((P).sb + kp_ + lane) * 128 + wid * 8, (unsigned)__builtin_amdgcn_readfirstlane(lds0 + L_K + (t) * 8192 + wid * 1024)); \
        att::glds16(KV + (size_t)((P).sb + kp_ + 16 * (wid & 3) + (lane >> 2)) * 128 + 64 + (wid >> 2) * 32 + (lane & 3) * 8, (unsigned)__builtin_amdgcn_readfirstlane(lds0 + L_V + (t) * 8192 + wid * 1024)); } while (0)
#define DIL_ISSUE_Q(P) do { _Pragma("unroll") for (int j_ = 0; j_ < 4; ++j_) \
        att::glds16(QB + (size_t)((P).sb + (P).q0 + wid * 32 + 8 * j_ + (lane >> 3)) * 64 + (lane & 7) * 8, (unsigned)__builtin_amdgcn_readfirstlane(lds0 + L_WQ + wid * 4096 + j_ * 1024)); } while (0)
    if (NU <= 0) return;
    UnitP cur = decode(j0, h), nxt = cur;
    asm volatile("s_waitcnt vmcnt(0) lgkmcnt(0)\n\ts_barrier" ::: "memory");
    DIL_ISSUE_Q(cur); DIL_ISSUE_TILE(cur, 0); DIL_ISSUE_TILE(cur, 5); DIL_ISSUE_TILE(cur, 1); DIL_ISSUE_TILE(cur, 4);
    bf16x8 qr[4]; float mhat = 0.f, l_reg = 0.f; f32x16 o[2]; o[0] = f32x16{}; o[1] = f32x16{}; f32x16 negm = f32x16{}; bool first = true;
    const int vbl = (int)(lds0 + L_V) + ((lane >> 4) & 1) * 32 + (lane & 3) * 8 + (4 * hi + ((lane & 15) >> 2)) * 64;
    for (int ui = 0; ui < NU; ++ui) {
        const bool has_next = ui + 1 < NU;
        if (has_next) nxt = decode(j0 + (ui + 1) * jstep, h);
        const int tb = cur.q0 == 0 ? 2 : 0;
        const float* bl0 = (const float*)(shm + L_BIAS) + cur.g * 288 + (191 - (128 + 32 * (wid & 1) + r32 - 4 * hi));
#pragma unroll 1
        for (int k = 0; k < 3; ++k) {
            if (k < 2) DIL_WAIT_BAR(0); else DIL_WAIT_BAR(8);
            if (k == 0) { DIL_ISSUE_TILE(cur, 2); DIL_ISSUE_TILE(cur, 3); }
            else if (has_next) { if (k == 1) { DIL_ISSUE_Q(nxt); DIL_ISSUE_TILE(nxt, 0); DIL_ISSUE_TILE(nxt, 5); } else { DIL_ISSUE_TILE(nxt, 1); DIL_ISSUE_TILE(nxt, 4); } }
            const int t = wid < 4 ? wt0 + k : wt1 - k;
            if (k == 0) {
#pragma unroll
                for (int d0 = 0; d0 < 4; ++d0) qr[d0] = *reinterpret_cast<const bf16x8*>(wq + r32 * 128 + d0 * 32 + hi * 16);
                mhat = 0.f; l_reg = 0.f; o[0] = f32x16{}; o[1] = f32x16{}; negm = f32x16{}; first = true;
            }
            if (t >= tb) {
                f32x16 p0, p1;
                { const char* kb = shm + L_K + t * 8192 + hi * 1024 + r32 * 16;
#pragma unroll
                  for (int d0 = 0; d0 < 4; ++d0) {
                    const bf16x8 b0 = *reinterpret_cast<const bf16x8*>(kb + d0 * 2048);
                    const bf16x8 b1 = *reinterpret_cast<const bf16x8*>(kb + d0 * 2048 + 512);
                    if (d0 == 0) { p0 = __builtin_amdgcn_mfma_f32_32x32x16_bf16(b0, qr[0], negm, 0, 0, 0); p1 = __builtin_amdgcn_mfma_f32_32x32x16_bf16(b1, qr[0], negm, 0, 0, 0); }
                    else { p0 = __builtin_amdgcn_mfma_f32_32x32x16_bf16(b0, qr[d0], p0, 0, 0, 0); p1 = __builtin_amdgcn_mfma_f32_32x32x16_bf16(b1, qr[d0], p1, 0, 0, 0); } } }
                { const float* bl = bl0 + 64 * (t - wt0);
                  float bv0[16], bv1[16];
#pragma unroll
                  for (int r = 0; r < 16; ++r) { bv0[r] = bl[(r & 3) + 8 * (r >> 2)]; bv1[r] = bl[(r & 3) + 8 * (r >> 2) + 32]; }
#pragma unroll
                  for (int r = 0; r < 16; ++r) { p0[r] += bv0[r]; p1[r] += bv1[r]; } }
                const float rm = att::rowmax32(p0, p1);
                if (first) { first = false; const float dl = rm; mhat += dl;
#pragma unroll
                    for (int r = 0; r < 16; ++r) { p0[r] -= dl; p1[r] -= dl; }
#pragma unroll
                    for (int r = 0; r < 16; ++r) negm[r] = -mhat;
                } else if (__any(rm > THR)) { const float dl = __builtin_fmaxf(rm, 0.f); mhat += dl;
#pragma unroll
                    for (int r = 0; r < 16; ++r) { p0[r] -= dl; p1[r] -= dl; }
#pragma unroll
                    for (int r = 0; r < 16; ++r) negm[r] = -mhat;
                    const float f = __builtin_amdgcn_exp2f(-dl); l_reg *= f; if (hi == 0) wsf[r32] = f;
                    asm volatile("s_waitcnt lgkmcnt(0)" ::: "memory");
#pragma unroll
                    for (int d_ = 0; d_ < 2; ++d_)
#pragma unroll
                        for (int r = 0; r < 16; ++r) o[d_][r] *= wsf[att::crow(r, hi)];
                    asm volatile("s_waitcnt lgkmcnt(0)" ::: "memory");
                }
                float sacc = 0.f;
#pragma unroll
                for (int r = 0; r < 16; ++r) { p0[r] = __builtin_amdgcn_exp2f(p0[r]); p1[r] = __builtin_amdgcn_exp2f(p1[r]); sacc += p0[r] + p1[r]; }
                l_reg += sacc;
                u32x4 pw0, pw1, pw2, pw3;
#define DIL_PKW(P, B) att::cvtpk_s(P[B], P[B + 1])
                pw0 = (u32x4){DIL_PKW(p0, 0), DIL_PKW(p0, 2), DIL_PKW(p0, 4), DIL_PKW(p0, 6)}; pw1 = (u32x4){DIL_PKW(p0, 8), DIL_PKW(p0, 10), DIL_PKW(p0, 12), DIL_PKW(p0, 14)};
                pw2 = (u32x4){DIL_PKW(p1, 0), DIL_PKW(p1, 2), DIL_PKW(p1, 4), DIL_PKW(p1, 6)}; pw3 = (u32x4){DIL_PKW(p1, 8), DIL_PKW(p1, 10), DIL_PKW(p1, 12), DIL_PKW(p1, 14)};
#undef DIL_PKW
                __builtin_amdgcn_sched_barrier(0);
                att::pv(o, vbl + t * 8192, __builtin_bit_cast(bf16x8, pw0), __builtin_bit_cast(bf16x8, pw1), __builtin_bit_cast(bf16x8, pw2), __builtin_bit_cast(bf16x8, pw3));
            }
            if (k == 2) {
                { auto rr = __builtin_amdgcn_permlane32_swap(__float_as_uint(l_reg), __float_as_uint(l_reg), false, false); l_reg = __uint_as_float(rr[0]) + __uint_as_float(rr[1]); }
                if (hi == 0) wsf[32 + r32] = l_reg;
                asm volatile("s_waitcnt lgkmcnt(0)" ::: "memory");
                float rli[16];
#pragma unroll
                for (int r = 0; r < 16; ++r) rli[r] = __builtin_amdgcn_rcpf(wsf[32 + att::crow(r, hi)]);
                if (hi == 0) LSE[cur.lo + DIL_GROW(cur, cur.q0 + wid * 32 + r32) * 8] = mhat + __builtin_amdgcn_logf(l_reg);
                bf16* stg = (bf16*)wo;
#pragma unroll
                for (int d0 = 0; d0 < 2; ++d0) {
#pragma unroll
                    for (int r = 0; r < 16; ++r) stg[att::crow(r, hi) * 32 + r32] = (bf16)(att::cvtpk_s(o[d0][r] * rli[r], 0.f) & 0xffffu);
                    asm volatile("s_waitcnt lgkmcnt(0)" ::: "memory");
#pragma unroll
                    for (int i = 0; i < 2; ++i) { const int row = i * 16 + (lane >> 2), ch = lane & 3; const u32x4 v = *(const u32x4*)(stg + row * 32 + ch * 8);
                        *(u32x4*)(OG + cur.oo + DIL_GROW(cur, cur.q0 + wid * 32 + row) * PO + d0 * 32 + ch * 8) = v; }
                    asm volatile("s_waitcnt lgkmcnt(0)" ::: "memory"); }
            }
        }
        cur = nxt;
    }
    asm volatile("s_waitcnt vmcnt(0) lgkmcnt(0)\n\ts_barrier" ::: "memory");
#undef DIL_GROW
#undef DIL_ISSUE_TILE
#undef DIL_ISSUE_Q
}
#undef DIL_WAIT_BAR
}
constexpr int NWAVES = 8;
constexpr int BATCH = 4, SEQ = 8192, D = 1024, M = BATCH * SEQ;
constexpr int MLA_H = 16, QRANK = 384, KVRANK = 256, LATN = 672, LATP = 768, QUP = 1536, KVUP = 2048;
constexpr int DFF = 2816, NEXP = 8, DILQ = 1536, DILKV = 3072, DILOUT = 512;
constexpr int MAXSLOT = 67584;
constexpr float EPS = 1e-6f;
constexpr float C2_MLA = 0.1472444460259031f;
constexpr float C2_DIL = 0.18033688011112042f;
constexpr float LOG2E_F = 1.4426950408889634f;

constexpr size_t MiB = 1u << 20;
constexpr size_t WS_CTL = 0, CTL_ZERO_BYTES = 64 * 1024;
constexpr size_t WS_MODV = 1 * MiB;
constexpr size_t WS_BIAS = 1 * MiB + 256 * 1024;
constexpr size_t WS_ROUTE = 1 * MiB + 512 * 1024;
constexpr size_t WS_CNT = 2 * MiB;
constexpr size_t WS_LIST = 2 * MiB + 256 * 1024;
constexpr size_t WS_SLOTG = 2 * MiB + 768 * 1024;
constexpr size_t WS_TOKSLOT = 3 * MiB + 256 * 1024;
constexpr size_t WS_TILEEXP = 3 * MiB + 768 * 1024;
constexpr size_t WS_CS = 4 * MiB;
constexpr size_t WS_LSE = 8 * MiB;
constexpr size_t WS_WEGU = 12 * MiB, WS_WEDN = 100 * MiB, WS_WFGU = 144 * MiB, WS_WFDN = 155 * MiB, WS_WKVB = 161 * MiB, WS_WQB = 167 * MiB, WS_WOUT = 170 * MiB,
                 WS_WOB = 172 * MiB, WS_WMLAIN = 173 * MiB, WS_WQUP = 175 * MiB, WS_WKVUP = 177 * MiB;
constexpr size_t WS_ARENA = 180 * MiB;
constexpr size_t A_XN = WS_ARENA, A_LAT = WS_ARENA + 64 * MiB, A_QN = WS_ARENA + 112 * MiB, A_KVN = WS_ARENA + 136 * MiB, A_Q = WS_ARENA + 152 * MiB, A_K = WS_ARENA + 248 * MiB,
                 A_V = WS_ARENA + 344 * MiB, A_O = WS_ARENA + 408 * MiB, A_HID = WS_ARENA + 64 * MiB, A_XNKV = WS_ARENA + 64 * MiB, A_KVB = WS_ARENA + 128 * MiB, A_QB = WS_ARENA + 320 * MiB,
                 A_OG = WS_ARENA, A_OD = WS_ARENA + 128 * MiB, A_HIDS = WS_ARENA + 160 * MiB, A_Y = WS_ARENA;
constexpr size_t WS_END = WS_ARENA + 523 * MiB;
static_assert(A_HIDS + (size_t)MAXSLOT * DFF * 2 <= WS_END && A_Y + (size_t)MAXSLOT * D * 2 <= A_HIDS && A_O + (size_t)M * D * 2 <= WS_END, "arena map");
static_assert(WS_WEGU + (size_t)NEXP * 2 * DFF * D * 2 <= WS_WEDN && WS_WEDN + (size_t)NEXP * D * DFF * 2 <= WS_WFGU && WS_WFGU + (size_t)2 * DFF * D * 2 <= WS_WFDN && WS_WFDN + (size_t)D * DFF * 2 <= WS_WKVB, "weight map");
enum ModKind { MK_A_MIX0 = 0, MK_B_MIX0, MK_G_MIX0, MK_A_FFN0, MK_B_FFN0, MK_G_FFN0, MK_A_MIX1, MK_B_MIX1, MK_G_MIX1, MK_A_FFN1, MK_B_FFN1, MK_G_FFN1, MK_A_KV, MK_B_KV };
constexpr int CW_BAR = 4096;

constexpr int RING_BYTES = 131072;
constexpr int LDS_BYTES = 163840;
constexpr int LDSCTL_OFF = LDS_BYTES - 1024, MISC_OFF = LDSCTL_OFF + 320;

#define GAS __attribute__((address_space(1)))
#define LAS __attribute__((address_space(3)))
typedef unsigned short bf16;
typedef unsigned v4u __attribute__((ext_vector_type(4)));
typedef unsigned v2u __attribute__((ext_vector_type(2)));
typedef float f32x4 __attribute__((ext_vector_type(4)));
typedef GAS unsigned gu32;
#define RLX_AGENT __ATOMIC_RELAXED, __HIP_MEMORY_SCOPE_AGENT
#define LDS_WAIT() asm volatile("s_waitcnt lgkmcnt(0)" ::: "memory")
#define VM_WAIT() asm volatile("s_waitcnt vmcnt(0)" ::: "memory")
__device__ __forceinline__ unsigned f2bf(float f) { unsigned u = __builtin_bit_cast(unsigned, f); return (u + 0x7fffu + ((u >> 16) & 1u)) >> 16; }
__device__ __forceinline__ unsigned pk2(float lo, float hi) { return f2bf(lo) | (f2bf(hi) << 16); }
__device__ __forceinline__ float bf_lo(unsigned w) { return __builtin_bit_cast(float, w << 16); }
__device__ __forceinline__ float bf_hi(unsigned w) { return __builtin_bit_cast(float, w & 0xffff0000u); }
__device__ __forceinline__ float wave_sum(float v) {
#pragma unroll
    for (int o = 1; o < 64; o <<= 1) v += __shfl_xor(v, o);
    return v;
}

#define XB_TMO      128
#define XB_XCNT(j)  (256  + 64 * (j))
#define XB_XSUB(j)  (1280 + 64 * (j))
#define XB_XGEN(j)  (2304 + 64 * (j))
#define XB_TOP      3328
#define XB_TOPGEN   3392
#define XCD_BAR_WORDS 3456
#define XB_SPIN_CAP (1u << 18)
__device__ __forceinline__ unsigned xb_ld(unsigned* p)              { return __hip_atomic_load(p, __ATOMIC_RELAXED, __HIP_MEMORY_SCOPE_AGENT); }
__device__ __forceinline__ unsigned xb_add(unsigned* p, unsigned v) { return __hip_atomic_fetch_add(p, v, __ATOMIC_RELAXED, __HIP_MEMORY_SCOPE_AGENT); }
__device__ __forceinline__ unsigned xb_xcc_id() { return (unsigned)__builtin_amdgcn_s_getreg((3 << 11) | 20) & 0xFu; }
#define XB_SPIN(cond, bar) do { unsigned _sp = 0; while (cond) { __builtin_amdgcn_s_sleep(1); \
    if ((++_sp & 255u) == 0u) { if (xb_ld(&(bar)[XB_TMO])) break; if (_sp > XB_SPIN_CAP) { atomicAdd(&(bar)[XB_TMO], 1u); break; } } } } while (0)
struct XcdBarrier { unsigned* bar; unsigned x; volatile LAS unsigned* st; };
__device__ __forceinline__ XcdBarrier xcd_barrier_post(unsigned* bar, volatile LAS unsigned* st) {
    XcdBarrier b; b.bar = bar; b.x = xb_xcc_id(); b.st = st;
    if (threadIdx.x == 0) (void)xb_add(&bar[XB_XCNT(b.x)], 1u);
    return b;
}
__device__ __forceinline__ void xcd_barrier_complete(unsigned* bar, unsigned x, unsigned& nloc, unsigned& nx) {
    const unsigned G = gridDim.x * gridDim.y * gridDim.z;
    unsigned sum, cnt, mine, sp = 0u;
    for (;;) {
        sum = 0u; cnt = 0u; mine = 0u;
#pragma unroll
        for (unsigned j = 0; j < 16; ++j) { const unsigned c = xb_ld(&bar[XB_XCNT(j)]); sum += c; cnt += (c > 0u) ? 1u : 0u; mine = (j == x) ? c : mine; }
        if (sum == G) break;
        __builtin_amdgcn_s_sleep(1);
        if ((++sp & 255u) == 0u) { if (xb_ld(&bar[XB_TMO])) break; if (sp > XB_SPIN_CAP) { atomicAdd(&bar[XB_TMO], 1u); break; } }
    }
    nloc = mine > 0u ? mine : 1u; nx = cnt > 0u ? cnt : 1u;
}
__device__ __forceinline__ void xcd_barrier(const XcdBarrier& b) {
    asm volatile("s_waitcnt vmcnt(0)" ::: "memory");
    __syncthreads();
    if (threadIdx.x == 0) {
        unsigned* bar = b.bar;
        __builtin_amdgcn_s_waitcnt(0);
        unsigned nloc = b.st[0], nx = b.st[1];
        if (nloc == 0u) { xcd_barrier_complete(bar, b.x, nloc, nx); b.st[0] = nloc; b.st[1] = nx; }
        const unsigned old = xb_add(&bar[XB_XSUB(b.x)], 1u);
        const unsigned gen = old / nloc;
        if (old + 1u == (gen + 1u) * nloc) {
            __builtin_amdgcn_fence(__ATOMIC_RELEASE, "agent");
            asm volatile("s_waitcnt vmcnt(0)" ::: "memory");
            const unsigned og = xb_add(&bar[XB_TOP], 1u);
            const unsigned tg = og / nx;
            if (og + 1u == (tg + 1u) * nx) xb_add(&bar[XB_TOPGEN], 1u);
            else XB_SPIN(xb_ld(&bar[XB_TOPGEN]) == tg, bar);
            __builtin_amdgcn_fence(__ATOMIC_ACQUIRE, "agent");
            xb_add(&bar[XB_XGEN(b.x)], 1u);
            asm volatile("s_waitcnt vmcnt(0)" ::: "memory");
        } else {
            XB_SPIN(xb_ld(&bar[XB_XGEN(b.x)]) == gen, bar);
            __builtin_amdgcn_fence(__ATOMIC_ACQUIRE, "agent");
            asm volatile("s_waitcnt vmcnt(0)" ::: "memory");
        }
    }
    __syncthreads();
}

struct Frame {
    LAS unsigned char* lds;
    volatile LAS unsigned* MISC;
    int tid, lane, wave;
    int vcu, G;
    unsigned char* ws;
    const float* in[26];
    float* out;
};
enum { MAP_PLAIN = 0, MAP_MLAIN = 1, MAP_QUP = 2, MAP_GU = 3 };
template <int MAP> __device__ __forceinline__ int dmap(int n) {
    if (MAP == MAP_MLAIN) { if (n < 640) return n; if (n < 656) return 640 + 2 * (n - 640); return 640 + 2 * (n - 656) + 1; }
    if (MAP == MAP_QUP) { const int h = n / 96, j = n % 96; if (j < 64) return n; if (j < 80) return h * 96 + 64 + 2 * (j - 64); return h * 96 + 64 + 2 * (j - 80) + 1; }
    if (MAP == MAP_GU) { const int up = n >= DFF ? 1 : 0; const int c = up ? n - DFF : n; return (c >> 7) * 256 + up * 128 + (c & 127); }
    return n;
}
template <int MAP> __device__ __forceinline__ void transpose_item(const float* W, int K, int N, bf16* WT, const float* ks, LAS float* scr, int item, int lane) {
    const int nblk = N / 32, kb = item / nblk, nb = item % nblk, k0 = 64 * kb, n0 = 32 * nb;
    float v[32];
    const float* src = W + (size_t)(k0 + (lane >> 5)) * N + n0 + (lane & 31);
#pragma unroll
    for (int i = 0; i < 32; ++i) v[i] = __builtin_nontemporal_load(src + (size_t)(2 * i) * N);
    if (ks) {
#pragma unroll
        for (int i = 0; i < 32; ++i) v[i] *= ks[k0 + 2 * i + (lane >> 5)]; }
#pragma unroll
    for (int i = 0; i < 32; ++i) scr[(2 * i + (lane >> 5)) * 33 + (lane & 31)] = v[i];
    LDS_WAIT(); asm volatile("" ::: "memory");
    const int c = lane & 7;
#pragma unroll
    for (int j = 0; j < 4; ++j) { const int n = (lane >> 3) + 8 * j; const LAS float* s = scr + (8 * c) * 33 + n;
        v4u o; o.x = pk2(s[0 * 33], s[1 * 33]); o.y = pk2(s[2 * 33], s[3 * 33]); o.z = pk2(s[4 * 33], s[5 * 33]); o.w = pk2(s[6 * 33], s[7 * 33]);
        *(GAS v4u*)(WT + (size_t)dmap<MAP>(n0 + n) * K + k0 + 8 * c) = o; }
    LDS_WAIT(); asm volatile("" ::: "memory");
}
__device__ __constant__ double INVF_D[16] = {1.0, 0.5623413251903491, 0.31622776601683794, 0.1778279410038923, 0.09999999999999999, 0.056234132519034905, 0.03162277660168379, 0.01778279410038923,
    0.01, 0.005623413251903491, 0.0031622776601683794, 0.0017782794100389228, 0.001, 0.000562341325190349, 0.00031622776601683794, 0.0001778279410038923};
__device__ __constant__ int RPB_TH[15] = {22, 30, 40, 54, 73, 99, 134, 182, 246, 332, 450, 609, 825, 1117, 1513};

__device__ __forceinline__ void p0_prologue(Frame& F) {
    const int gw = F.vcu * NWAVES + F.wave, NGW = F.G * NWAVES;
    const int gtid = F.vcu * (NWAVES * 64) + F.tid, NGT = F.G * NWAVES * 64;
    float* MODV = (float*)(F.ws + WS_MODV);
    {
        LAS float* cact = (LAS float*)F.lds;
        LAS float* red = (LAS float*)(F.lds + 16384);
        const float* cin = F.in[1];
        for (int i = F.tid; i < 4096; i += NWAVES * 64) { const int b = i >> 10, k = i & 1023; const float x = cin[i]; cact[k * 4 + b] = x / (1.0f + expf(-x)); }
        __syncthreads();
        constexpr int NTASK = (6 * D * 2 + 2 * D) / 64;
        for (int task = F.vcu; task < NTASK; task += F.G) {
            const int gc = task * 64 + F.lane;
            const float* W; int ldw, cc; const float* bias;
            if (gc < 6 * D) { W = F.in[5]; ldw = 6 * D; cc = gc; bias = F.in[6]; }
            else if (gc < 12 * D) { W = F.in[5] + (size_t)D * 6 * D; ldw = 6 * D; cc = gc - 6 * D; bias = F.in[6] + 6 * D; }
            else { W = F.in[14]; ldw = 2 * D; cc = gc - 12 * D; bias = F.in[15]; }
            float a0 = 0.f, a1 = 0.f, a2 = 0.f, a3 = 0.f;
            const int kbeg = F.wave * 128;
#pragma unroll 16
            for (int k = 0; k < 128; ++k) { const float w = W[(size_t)(kbeg + k) * ldw + cc]; const f32x4 ca = *(const LAS f32x4*)(cact + (kbeg + k) * 4);
                a0 += w * ca[0]; a1 += w * ca[1]; a2 += w * ca[2]; a3 += w * ca[3]; }
            red[(F.wave * 4 + 0) * 64 + F.lane] = a0; red[(F.wave * 4 + 1) * 64 + F.lane] = a1; red[(F.wave * 4 + 2) * 64 + F.lane] = a2; red[(F.wave * 4 + 3) * 64 + F.lane] = a3;
            __syncthreads();
            if (F.wave < 4) { const int b = F.wave; float s = 0.f;
#pragma unroll
                for (int w = 0; w < 8; ++w) s += red[(w * 4 + b) * 64 + F.lane];
                s += bias[cc];
                int kind; float val = s; const int j = cc & 1023, ch = cc >> 10;
                if (gc < 12 * D) { const int Lr = gc < 6 * D ? 0 : 1;
                    if (ch == 0) kind = 6 * Lr + 1; else if (ch == 1) { kind = 6 * Lr + 0; val = F.in[3][Lr * D + j] * (1.0f + s); } else if (ch == 2) kind = 6 * Lr + 2;
                    else if (ch == 3) kind = 6 * Lr + 4; else if (ch == 4) { kind = 6 * Lr + 3; val = F.in[4][Lr * D + j] * (1.0f + s); } else kind = 6 * Lr + 5;
                } else { if (ch == 0) kind = MK_B_KV; else { kind = MK_A_KV; val = F.in[13][j] * (1.0f + s); } }
                MODV[((size_t)kind * 4 + b) * D + j] = val; }
            __syncthreads();
        }
        __syncthreads();
    }
    {
        LAS float* scr = (LAS float*)(F.lds + F.wave * 8704);
        constexpr int I_MLAIN = (D / 64) * (LATN / 32), I_QUP = (QRANK / 64) * (QUP / 32), I_KVUP = (KVRANK / 64) * (KVUP / 32), I_OUT = (D / 64) * (D / 32), I_FGU = (D / 64) * (2 * DFF / 32),
                      I_FDN = (DFF / 64) * (D / 32), I_KVB = (D / 64) * (DILKV / 32), I_QB = (D / 64) * (DILQ / 32), I_OB = (DILOUT / 64) * (D / 32);
        constexpr int NSMALL = I_MLAIN + I_QUP + I_KVUP + I_OUT + I_FGU + I_FDN + I_KVB + I_QB + I_OB;
        constexpr int NITEMS = NSMALL + NEXP * (I_FGU + I_FDN);
        bf16* const ws16 = (bf16*)F.ws;
        for (int it = gw; it < NITEMS; it += NGW) {
            int r = it;
            if (r >= NSMALL) { r -= NSMALL;
                if (r < NEXP * I_FGU) { const int e = r / I_FGU; transpose_item<MAP_GU>(F.in[23] + (size_t)e * D * 2 * DFF, D, 2 * DFF, (bf16*)(F.ws + WS_WEGU) + (size_t)e * 2 * DFF * D, nullptr, scr, r % I_FGU, F.lane); continue; }
                r -= NEXP * I_FGU; { const int e = r / I_FDN; transpose_item<MAP_PLAIN>(F.in[24] + (size_t)e * DFF * D, DFF, D, (bf16*)(F.ws + WS_WEDN) + (size_t)e * D * DFF, nullptr, scr, r % I_FDN, F.lane); continue; } }
            if (r < I_MLAIN) { transpose_item<MAP_MLAIN>(F.in[7], D, LATN, (bf16*)(F.ws + WS_WMLAIN), nullptr, scr, r, F.lane); continue; } r -= I_MLAIN;
            if (r < I_QUP) { transpose_item<MAP_QUP>(F.in[9], QRANK, QUP, (bf16*)(F.ws + WS_WQUP), F.in[8], scr, r, F.lane); continue; } r -= I_QUP;
            if (r < I_KVUP) { transpose_item<MAP_PLAIN>(F.in[11], KVRANK, KVUP, (bf16*)(F.ws + WS_WKVUP), F.in[10], scr, r, F.lane); continue; } r -= I_KVUP;
            if (r < I_OUT) { transpose_item<MAP_PLAIN>(F.in[12], D, D, (bf16*)(F.ws + WS_WOUT), nullptr, scr, r, F.lane); continue; } r -= I_OUT;
            if (r < I_FGU) { transpose_item<MAP_GU>(F.in[20], D, 2 * DFF, (bf16*)(F.ws + WS_WFGU), nullptr, scr, r, F.lane); continue; } r -= I_FGU;
            if (r < I_FDN) { transpose_item<MAP_PLAIN>(F.in[21], DFF, D, (bf16*)(F.ws + WS_WFDN), nullptr, scr, r, F.lane); continue; } r -= I_FDN;
            if (r < I_KVB) { transpose_item<MAP_PLAIN>(F.in[16], D, DILKV, (bf16*)(F.ws + WS_WKVB), nullptr, scr, r, F.lane); continue; } r -= I_KVB;
            if (r < I_QB) { transpose_item<MAP_PLAIN>(F.in[18], D, DILQ, (bf16*)(F.ws + WS_WQB), nullptr, scr, r, F.lane); continue; } r -= I_QB;
            transpose_item<MAP_PLAIN>(F.in[19], DILOUT, D, (bf16*)(F.ws + WS_WOB), nullptr, scr, r, F.lane);
        }
        (void)ws16;
    }
    {
        v4u* padz = (v4u*)(F.ws + WS_WMLAIN + (size_t)LATN * D * 2);
        for (int i = gtid; i < (LATP - LATN) * D * 2 / 16; i += NGT) padz[i] = (v4u){0u, 0u, 0u, 0u};
        const int* pos = (const int*)F.in[2];
        float* cs = (float*)(F.ws + WS_CS);
        for (int i = gtid; i < M * 16; i += NGT) { const int row = i >> 4, k = i & 15;
            const double x = (double)pos[row] * INVF_D[k]; const double rev = x * 0.15915494309189535; const float fr = (float)(rev - __builtin_rint(rev));
            cs[(size_t)i * 2] = __builtin_amdgcn_cosf(fr); cs[(size_t)i * 2 + 1] = __builtin_amdgcn_sinf(fr); }
        const float* rpb = F.in[17];
        float* bt = (float*)(F.ws + WS_BIAS);
        for (int i = gtid; i < 24 * 288; i += NGT) { const int gh = i / 288, ii = i % 288, j = 191 - ii, g = gh >> 3; const int d = j * (g == 0 ? 1 : (g == 1 ? 4 : 16));
            float val = -INFINITY;
            if (j >= 0 && j <= 128) { int bk; if (d < 16) bk = d; else { bk = 16;
#pragma unroll
                for (int q = 0; q < 15; ++q) bk += (d >= RPB_TH[q]) ? 1 : 0; }
                val = rpb[bk * 24 + gh] * LOG2E_F; }
            bt[i] = val; }
    }
}

constexpr int HPITCH = 2048;
__device__ __forceinline__ void ld8_f32(const float* p, f32x4& a, f32x4& b) { a = *(const f32x4*)p; b = *(const f32x4*)(p + 4); }
__device__ __forceinline__ void ld8_bf16(const bf16* p, f32x4& a, f32x4& b) { const v4u w = *(const GAS v4u*)p; a = (f32x4){bf_lo(w.x), bf_hi(w.x), bf_lo(w.y), bf_hi(w.y)}; b = (f32x4){bf_lo(w.z), bf_hi(w.z), bf_lo(w.w), bf_hi(w.w)}; }
__device__ __forceinline__ float ssq8(const f32x4& a, const f32x4& b) { return ((a.x * a.x + a.y * a.y) + (a.z * a.z + a.w * a.w)) + ((b.x * b.x + b.y * b.y) + (b.z * b.z + b.w * b.w)); }
__device__ __forceinline__ v4u pk8(const f32x4& a, const f32x4& b) { return (v4u){pk2(a.x, a.y), pk2(a.z, a.w), pk2(b.x, b.y), pk2(b.z, b.w)}; }
template <bool DUAL, bool INF32>
__device__ __forceinline__ void norm_phase(Frame& F, const void* Hin, const float* A0, const float* B0, bf16* O0, const float* A1, const float* B1, bf16* O1) {
    const int gw = F.vcu * NWAVES + F.wave, NGW = F.G * NWAVES;
    for (int c = gw; c < M / 16; c += NGW) {
        const int row0 = c * 16, b = row0 / SEQ;
        f32x4 a0[2][2], b0[2][2], a1[2][2], b1[2][2];
#pragma unroll
        for (int j = 0; j < 2; ++j) { const int co = b * D + 8 * F.lane + 512 * j; ld8_f32(A0 + co, a0[j][0], a0[j][1]); ld8_f32(B0 + co, b0[j][0], b0[j][1]);
            if (DUAL) { ld8_f32(A1 + co, a1[j][0], a1[j][1]); ld8_f32(B1 + co, b1[j][0], b1[j][1]); } }
#pragma unroll 2
        for (int i = 0; i < 16; ++i) { const size_t row = (size_t)(row0 + i);
            f32x4 v[2][2]; float s = 0.f;
#pragma unroll
            for (int j = 0; j < 2; ++j) { if (INF32) ld8_f32((const float*)Hin + row * D + 8 * F.lane + 512 * j, v[j][0], v[j][1]); else ld8_bf16((const bf16*)Hin + row * HPITCH + 8 * F.lane + 512 * j, v[j][0], v[j][1]);
                s += ssq8(v[j][0], v[j][1]); }
            const float rstd = 1.0f / sqrtf(wave_sum(s) * (1.f / D) + EPS);
#pragma unroll
            for (int j = 0; j < 2; ++j) *(GAS v4u*)(O0 + row * D + 8 * F.lane + 512 * j) = pk8(v[j][0] * rstd * a0[j][0] + b0[j][0], v[j][1] * rstd * a0[j][1] + b0[j][1]);
            if (DUAL) {
#pragma unroll
                for (int j = 0; j < 2; ++j) *(GAS v4u*)(O1 + row * D + 8 * F.lane + 512 * j) = pk8(v[j][0] * rstd * a1[j][0] + b1[j][0], v[j][1] * rstd * a1[j][1] + b1[j][1]); }
        }
    }
}

__device__ __forceinline__ void latnorm_phase(Frame& F) {
    const int gw = F.vcu * NWAVES + F.wave, NGW = F.G * NWAVES;
    const bf16* LAT = (const bf16*)(F.ws + A_LAT); bf16* QN = (bf16*)(F.ws + A_QN); bf16* KVN = (bf16*)(F.ws + A_KVN); bf16* KB = (bf16*)(F.ws + A_K);
    const float* cs = (const float*)(F.ws + WS_CS);
    for (int row = gw; row < M; row += NGW) {
        const unsigned* lr = (const unsigned*)(LAT + (size_t)row * LATP);
        unsigned q[3], kv[2];
#pragma unroll
        for (int j = 0; j < 3; ++j) q[j] = lr[F.lane + 64 * j];
#pragma unroll
        for (int j = 0; j < 2; ++j) kv[j] = lr[192 + F.lane + 64 * j];
        const unsigned kr = lr[320 + (F.lane & 15)];
        float sq = 0.f, sk = 0.f;
#pragma unroll
        for (int j = 0; j < 3; ++j) { const float a = bf_lo(q[j]), b = bf_hi(q[j]); sq += a * a + b * b; }
#pragma unroll
        for (int j = 0; j < 2; ++j) { const float a = bf_lo(kv[j]), b = bf_hi(kv[j]); sk += a * a + b * b; }
        const float rq = 1.0f / sqrtf(wave_sum(sq) * (1.f / QRANK) + EPS), rk = 1.0f / sqrtf(wave_sum(sk) * (1.f / KVRANK) + EPS);
        unsigned* qo = (unsigned*)(QN + (size_t)row * QRANK); unsigned* ko = (unsigned*)(KVN + (size_t)row * KVRANK);
#pragma unroll
        for (int j = 0; j < 3; ++j) qo[F.lane + 64 * j] = pk2(bf_lo(q[j]) * rq, bf_hi(q[j]) * rq);
#pragma unroll
        for (int j = 0; j < 2; ++j) ko[F.lane + 64 * j] = pk2(bf_lo(kv[j]) * rk, bf_hi(kv[j]) * rk);
        { const int i = F.lane & 15; const float c = cs[(size_t)row * 32 + 2 * i], s = cs[(size_t)row * 32 + 2 * i + 1]; const float x1 = bf_lo(kr), x2 = bf_hi(kr);
          const unsigned w = pk2(x1 * c - x2 * s, x1 * s + x2 * c);
          unsigned* kb = (unsigned*)(KB + (size_t)row * QUP);
#pragma unroll
          for (int hh = 0; hh < 4; ++hh) { const int h = (F.lane >> 4) * 4 + hh; kb[(h * 96 + 64) / 2 + i] = w; } }
    }
}

__device__ __forceinline__ void merge_phase(Frame& F) {
    const int gw = F.vcu * NWAVES + F.wave, NGW = F.G * NWAVES;
    const bf16* OG = (const bf16*)(F.ws + A_OG); const float* LSE = (const float*)(F.ws + WS_LSE); bf16* OD = (bf16*)(F.ws + A_OD);
    for (int row = gw; row < M; row += NGW) {
        const int h = F.lane >> 3;
        float l0 = LSE[((size_t)0 * M + row) * 8 + h], l1 = LSE[((size_t)1 * M + row) * 8 + h], l2 = LSE[((size_t)2 * M + row) * 8 + h];
        const float mx = fmaxf(l0, fmaxf(l1, l2)); float w0 = __builtin_amdgcn_exp2f(l0 - mx), w1 = __builtin_amdgcn_exp2f(l1 - mx), w2 = __builtin_amdgcn_exp2f(l2 - mx);
        const float inv = 1.0f / (w0 + w1 + w2); w0 *= inv; w1 *= inv; w2 *= inv;
        const v4u a = *(const v4u*)(OG + ((size_t)0 * M + row) * DILOUT + 8 * F.lane), b = *(const v4u*)(OG + ((size_t)1 * M + row) * DILOUT + 8 * F.lane), c = *(const v4u*)(OG + ((size_t)2 * M + row) * DILOUT + 8 * F.lane);
        v4u o;
#pragma unroll
        for (int k = 0; k < 4; ++k) o[k] = pk2(w0 * bf_lo(a[k]) + w1 * bf_lo(b[k]) + w2 * bf_lo(c[k]), w0 * bf_hi(a[k]) + w1 * bf_hi(b[k]) + w2 * bf_hi(c[k]));
        *(v4u*)(OD + (size_t)row * DILOUT + 8 * F.lane) = o;
    }
}

__device__ __forceinline__ void router_phase(Frame& F, const bf16* H, const float* A0, const float* B0, bf16* O0) {
    const int gw = F.vcu * NWAVES + F.wave, NGW = F.G * NWAVES;
    LAS float* wrt = (LAS float*)F.lds;
    { const float* wr = F.in[22]; for (int i = F.tid; i < 8192; i += NWAVES * 64) { const int col = i >> 3, e = i & 7; wrt[e * 1024 + col] = wr[i]; } }
    __syncthreads();
    v4u* ROUTE = (v4u*)(F.ws + WS_ROUTE); unsigned* CNT = (unsigned*)(F.ws + WS_CNT);
    for (int c = gw; c < M / 16; c += NGW) {
        const int row0 = c * 16, b = row0 / SEQ;
        f32x4 a0[2][2], b0[2][2];
#pragma unroll
        for (int j = 0; j < 2; ++j) { const int co = b * D + 8 * F.lane + 512 * j; ld8_f32(A0 + co, a0[j][0], a0[j][1]); ld8_f32(B0 + co, b0[j][0], b0[j][1]); }
        unsigned cnt = 0u;
        for (int i = 0; i < 16; ++i) { const size_t row = (size_t)(row0 + i);
            f32x4 v[2][2]; float s = 0.f;
#pragma unroll
            for (int j = 0; j < 2; ++j) { ld8_bf16(H + row * HPITCH + 8 * F.lane + 512 * j, v[j][0], v[j][1]); s += ssq8(v[j][0], v[j][1]); }
            const float rstd = 1.0f / sqrtf(wave_sum(s) * (1.f / D) + EPS);
            float lg[8];
#pragma unroll
            for (int e = 0; e < 8; ++e) lg[e] = 0.f;
#pragma unroll
            for (int j = 0; j < 2; ++j) { const f32x4 y0 = v[j][0] * rstd * a0[j][0] + b0[j][0], y1 = v[j][1] * rstd * a0[j][1] + b0[j][1];
                *(GAS v4u*)(O0 + row * D + 8 * F.lane + 512 * j) = pk8(y0, y1);
#pragma unroll
                for (int e = 0; e < 8; ++e) { const LAS float* wp = wrt + e * 1024 + 8 * F.lane + 512 * j; const f32x4 w0 = *(const LAS f32x4*)wp, w1 = *(const LAS f32x4*)(wp + 4);
                    lg[e] += ((y0.x * w0.x + y0.y * w0.y) + (y0.z * w0.z + y0.w * w0.w)) + ((y1.x * w1.x + y1.y * w1.y) + (y1.z * w1.z + y1.w * w1.w)); } }
#pragma unroll
            for (int e = 0; e < 8; ++e) lg[e] = wave_sum(lg[e]);
            int e1 = 0; float v1 = lg[0];
#pragma unroll
            for (int e = 1; e < 8; ++e) if (lg[e] > v1) { v1 = lg[e]; e1 = e; }
            int e2 = -1; float v2 = -INFINITY;
#pragma unroll
            for (int e = 0; e < 8; ++e) if (e != e1 && lg[e] > v2) { v2 = lg[e]; e2 = e; }
            const float ex = expf(v2 - v1); const float g1 = 1.0f / (1.0f + ex), g2 = ex / (1.0f + ex);
            cnt += (F.lane == e1 ? 1u : 0u) + (F.lane == e2 ? 1u : 0u);
            if (F.lane == 0) ROUTE[row] = (v4u){(unsigned)e1 | ((unsigned)e2 << 8), __float_as_uint(g1), __float_as_uint(g2), 0u};
        }
        if (F.lane < 8) CNT[c * 8 + F.lane] = cnt;
    }
}

__device__ __forceinline__ void lists_phase(Frame& F) {
    const int gw = F.vcu * NWAVES + F.wave, NGW = F.G * NWAVES;
    const v4u* ROUTE = (const v4u*)(F.ws + WS_ROUTE); const unsigned* CNT = (const unsigned*)(F.ws + WS_CNT);
    int* LIST = (int*)(F.ws + WS_LIST); float* SLOTG = (float*)(F.ws + WS_SLOTG); int* TOKSLOT = (int*)(F.ws + WS_TOKSLOT); int* TILEEXP = (int*)(F.ws + WS_TILEEXP);
    for (int c = gw; c < M / 16; c += NGW) {
        unsigned lt[8], al[8];
#pragma unroll
        for (int e = 0; e < 8; ++e) { lt[e] = 0u; al[e] = 0u; }
        for (int cc = F.lane; cc < M / 16; cc += 64) { const v4u x = *(const v4u*)(CNT + cc * 8), y = *(const v4u*)(CNT + cc * 8 + 4); const bool bl = cc < c;
            al[0] += x.x; al[1] += x.y; al[2] += x.z; al[3] += x.w; al[4] += y.x; al[5] += y.y; al[6] += y.z; al[7] += y.w;
            if (bl) { lt[0] += x.x; lt[1] += x.y; lt[2] += x.z; lt[3] += x.w; lt[4] += y.x; lt[5] += y.y; lt[6] += y.z; lt[7] += y.w; } }
#pragma unroll
        for (int e = 0; e < 8; ++e) {
#pragma unroll
            for (int o = 1; o < 64; o <<= 1) { lt[e] += __shfl_xor(lt[e], o); al[e] += __shfl_xor(al[e], o); } }
        unsigned base[8]; unsigned run = 0u;
#pragma unroll
        for (int e = 0; e < 8; ++e) { base[e] = run; run += (al[e] + 255u) & ~255u; }
        const int row = c * 16 + (F.lane & 15);
        const v4u r = ROUTE[row]; const int e1 = (int)(r.x & 0xffu), e2 = (int)((r.x >> 8) & 0xffu);
        int s1 = 0, s2 = 0;
#pragma unroll
        for (int e = 0; e < 8; ++e) { const bool has = (F.lane < 16) && (e1 == e || e2 == e); const unsigned long long mk = __ballot(has);
            const int rank = __popcll(mk & ((1ull << F.lane) - 1ull)); const int sl = (int)(base[e] + lt[e]) + rank;
            if (e1 == e) s1 = sl; if (e2 == e) s2 = sl; }
        if (F.lane < 16) { LIST[s1] = row; LIST[s2] = row; SLOTG[s1] = __uint_as_float(r.y); SLOTG[s2] = __uint_as_float(r.z); TOKSLOT[row * 2] = s1; TOKSLOT[row * 2 + 1] = s2; }
        if (c == 0) {
#pragma unroll
            for (int e = 0; e < 8; ++e) { const unsigned pe = (al[e] + 255u) & ~255u;
                for (unsigned s = base[e] + al[e] + F.lane; s < base[e] + pe; s += 64) { LIST[s] = 0; SLOTG[s] = 0.f; }
                for (unsigned t = base[e] / 256u + F.lane; t < (base[e] + pe) / 256u; t += 64) TILEEXP[t] = e; }
            if (F.lane == 0) TILEEXP[300] = (int)(run / 256u);
        }
    }
}

__device__ __forceinline__ void final_phase(Frame& F, float* OUT, const float* gate, const float* gfin) {
    const int gw = F.vcu * NWAVES + F.wave, NGW = F.G * NWAVES;
    const bf16* Y = (const bf16*)(F.ws + A_Y); const int* TOKSLOT = (const int*)(F.ws + WS_TOKSLOT); const bf16* H = (const bf16*)OUT;
    for (int c = gw; c < M / 16; c += NGW) {
        const int row0 = c * 16, b = row0 / SEQ;
        f32x4 gt[2][2], gf[2][2];
#pragma unroll
        for (int j = 0; j < 2; ++j) { ld8_f32(gate + b * D + 8 * F.lane + 512 * j, gt[j][0], gt[j][1]); ld8_f32(gfin + 8 * F.lane + 512 * j, gf[j][0], gf[j][1]); }
#pragma unroll 2
        for (int i = 0; i < 16; ++i) { const size_t row = (size_t)(row0 + i);
            const int s1 = TOKSLOT[row * 2], s2 = TOKSLOT[row * 2 + 1];
            f32x4 v[2][2]; float s = 0.f;
#pragma unroll
            for (int j = 0; j < 2; ++j) { f32x4 h0, h1, p0, p1, q0, q1; ld8_bf16(H + row * HPITCH + 8 * F.lane + 512 * j, h0, h1);
                ld8_bf16(Y + (size_t)s1 * D + 8 * F.lane + 512 * j, p0, p1); ld8_bf16(Y + (size_t)s2 * D + 8 * F.lane + 512 * j, q0, q1);
                v[j][0] = h0 + gt[j][0] * (p0 + q0); v[j][1] = h1 + gt[j][1] * (p1 + q1); s += ssq8(v[j][0], v[j][1]); }
            const float rstd = 1.0f / sqrtf(wave_sum(s) * (1.f / D) + EPS);
            asm volatile("" ::: "memory");
#pragma unroll
            for (int j = 0; j < 2; ++j) { float* op = OUT + row * D + 8 * F.lane + 512 * j; *(GAS f32x4*)op = v[j][0] * rstd * gf[j][0]; *(GAS f32x4*)(op + 4) = v[j][1] * rstd * gf[j][1]; }
        }
    }
}
#ifndef MK_ONE_LAUNCH
#define MK_ONE_LAUNCH 1
#endif
constexpr int N_PHASES = 20;
struct Args { const float* in[26]; float* out; unsigned char* ws; int ph_lo, ph_hi; };
static_assert(sizeof(Args) == 26 * 8 + 8 + 8 + 8, "Args has no padding");

__global__ void __launch_bounds__(NWAVES * 64, 2) mk_fwd(Args args) {
    extern __shared__ __attribute__((aligned(16))) unsigned char lds[];
    Frame F;
    F.lds = (LAS unsigned char*)lds;
    F.MISC = (volatile LAS unsigned*)(F.lds + MISC_OFF);
    F.tid = threadIdx.x; F.lane = F.tid & 63; F.wave = __builtin_amdgcn_readfirstlane(F.tid >> 6);
    F.G = gridDim.x; { const int bx = blockIdx.x; F.vcu = (F.G % 8 == 0) ? (bx % 8) * (F.G / 8) + bx / 8 : bx; }
    F.ws = args.ws; F.out = args.out;
#pragma unroll
    for (int i = 0; i < 26; ++i) F.in[i] = args.in[i];
    unsigned char* const ws = args.ws;
    for (int u = F.tid; u < (LDS_BYTES - LDSCTL_OFF) / 4; u += NWAVES * 64) ((LAS unsigned*)(F.lds + LDSCTL_OFF))[u] = 0u;
    __syncthreads();
    const int lo = args.ph_lo, hi = args.ph_hi;
    XcdBarrier bar; bar.bar = (unsigned*)(ws + WS_CTL) + CW_BAR; bar.x = 0; bar.st = nullptr;
    if (hi - lo > 1) bar = xcd_barrier_post((unsigned*)(ws + WS_CTL) + CW_BAR, F.MISC + 8);
#ifndef PHASE_MASK
#define PHASE_MASK 0xFFFFFu
#endif
#define IN(k) (((PHASE_MASK >> (k)) & 1u) && lo <= (k) && (k) < hi)
#ifndef REPEAT_MASK
#define REPEAT_MASK 0u
#endif
#define REP(k) (((REPEAT_MASK >> (k)) & 1u) ? 2 : 1)
#define SEAM(k) do { if (IN(k) && IN((k) + 1)) xcd_barrier(bar); } while (0)
    const float* MODV = (const float*)(ws + WS_MODV);
#define MV(kind) (MODV + (size_t)(kind) * 4 * D)
    bf16* const H = (bf16*)args.out;
    bf16* const XN = (bf16*)(ws + A_XN);
    const pg8::MoeInfo mi0{nullptr, nullptr, 0};

    if (IN(0)) for (int rep_ = 0; rep_ < REP(0); ++rep_) { p0_prologue(F); } SEAM(0);
    if (IN(1)) for (int rep_ = 0; rep_ < REP(1); ++rep_) { norm_phase<false, true>(F, F.in[0], MV(MK_A_MIX0), MV(MK_B_MIX0), XN, nullptr, nullptr, nullptr); } SEAM(1);
    if (IN(2)) for (int rep_ = 0; rep_ < REP(2); ++rep_) { pg8::Gemm g{XN, (const bf16*)(ws + WS_WMLAIN), M, LATP, D}; pg8::StaticOrder S; S.init(M, LATP, F.G, (int)blockIdx.x);
        pg8::EpiBf16 E{(bf16*)(ws + A_LAT), LATP, 1.0f};
        pg8::gemm_phase<pg8::EpiBf16, pg8::StaticOrder, true, true, 0>(F.lds, g, S, E, mi0); } SEAM(2);
    if (IN(3)) for (int rep_ = 0; rep_ < REP(3); ++rep_) { latnorm_phase(F); } SEAM(3);
    if (IN(4)) for (int rep_ = 0; rep_ < REP(4); ++rep_) {
#ifndef P4_SKIP_Q
        { pg8::Gemm g{(const bf16*)(ws + A_QN), (const bf16*)(ws + WS_WQUP), M, QUP, QRANK}; pg8::StaticOrder S; S.init(M, QUP, F.G, (int)blockIdx.x);
          pg8::EpiQ E{(bf16*)(ws + A_Q), QUP, C2_MLA, (const float*)(ws + WS_CS)};
          pg8::gemm_phase<pg8::EpiQ, pg8::StaticOrder, true, true, 0>(F.lds, g, S, E, mi0); }
#endif
#ifndef P4_SKIP_KV
        { pg8::Gemm g{(const bf16*)(ws + A_KVN), (const bf16*)(ws + WS_WKVUP), M, KVUP, KVRANK}; pg8::StaticOrder S; S.init(M, KVUP, F.G, (int)blockIdx.x);
          pg8::EpiKV E{(bf16*)(ws + A_K), (bf16*)(ws + A_V)};
          pg8::gemm_phase<pg8::EpiKV, pg8::StaticOrder, true, true, 0>(F.lds, g, S, E, mi0); }
#endif
    } SEAM(4);
    if (IN(5)) for (int rep_ = 0; rep_ < REP(5); ++rep_) {
        const bf16* Qp = (const bf16*)(ws + A_Q); const bf16* Kp = (const bf16*)(ws + A_K); const bf16* Vp = (const bf16*)(ws + A_V); bf16* Op = (bf16*)(ws + A_O);
        if (F.G == 256) {
            for (int i = 0; i < 8; ++i) { const int bh = (F.vcu >> 3) + 32 * (i >> 2), s = F.vcu & 7, k = i & 3; const int qb = (k == 0) ? s : (k == 1) ? 15 - s : (k == 2) ? 16 + s : 31 - s;
                const int b = bh >> 4, h = bh & 15;
                mla::attn_unit<8>(b, h, qb, Qp, Kp, Vp, Op, (char*)lds); }
        } else {
            for (int u = (int)blockIdx.x; u < BATCH * MLA_H * 32; u += F.G) { const int bh = u >> 5, qb = 31 - (u & 31); const int b = bh >> 4, h = bh & 15;
                mla::attn_unit<8>(b, h, qb, Qp, Kp, Vp, Op, (char*)lds); }
        }
    } SEAM(5);
    if (IN(6)) for (int rep_ = 0; rep_ < REP(6); ++rep_) { pg8::Gemm g{(const bf16*)(ws + A_O), (const bf16*)(ws + WS_WOUT), M, D, D}; pg8::StaticOrder S; S.init(M, D, F.G, (int)blockIdx.x);
        pg8::EpiResid<true> E{F.in[0], H, MV(MK_G_MIX0)};
        pg8::gemm_phase<pg8::EpiResid<true>, pg8::StaticOrder, true, true, 0>(F.lds, g, S, E, mi0); } SEAM(6);
    if (IN(7)) for (int rep_ = 0; rep_ < REP(7); ++rep_) { norm_phase<false, false>(F, H, MV(MK_A_FFN0), MV(MK_B_FFN0), XN, nullptr, nullptr, nullptr); } SEAM(7);
    if (IN(8)) for (int rep_ = 0; rep_ < REP(8); ++rep_) { pg8::Gemm g{XN, (const bf16*)(ws + WS_WFGU), M, 2 * DFF, D}; pg8::StaticOrder S; S.init(M, 2 * DFF, F.G, (int)blockIdx.x);
        pg8::EpiSwiGLU E{(bf16*)(ws + A_HID), DFF};
        pg8::gemm_phase<pg8::EpiSwiGLU, pg8::StaticOrder, true, true, 0>(F.lds, g, S, E, mi0); } SEAM(8);
    if (IN(9)) for (int rep_ = 0; rep_ < REP(9); ++rep_) { pg8::Gemm g{(const bf16*)(ws + A_HID), (const bf16*)(ws + WS_WFDN), M, D, DFF}; pg8::StaticOrder S; S.init(M, D, F.G, (int)blockIdx.x);
        pg8::EpiResid<false> E{H, H, MV(MK_G_FFN0)};
        pg8::gemm_phase<pg8::EpiResid<false>, pg8::StaticOrder, true, true, 0>(F.lds, g, S, E, mi0); } SEAM(9);
    if (IN(10)) for (int rep_ = 0; rep_ < REP(10); ++rep_) { norm_phase<true, false>(F, H, MV(MK_A_MIX1), MV(MK_B_MIX1), XN, MV(MK_A_KV), MV(MK_B_KV), (bf16*)(ws + A_XNKV)); } SEAM(10);
    if (IN(11)) for (int rep_ = 0; rep_ < REP(11); ++rep_) {
        { pg8::Gemm g{(const bf16*)(ws + A_XNKV), (const bf16*)(ws + WS_WKVB), M, DILKV, D}; pg8::StaticOrder S; S.init(M, DILKV, F.G, (int)blockIdx.x);
          pg8::EpiDil<true> E{(bf16*)(ws + A_KVB), 1.0f};
          pg8::gemm_phase<pg8::EpiDil<true>, pg8::StaticOrder, true, true, 0>(F.lds, g, S, E, mi0); }
        { pg8::Gemm g{XN, (const bf16*)(ws + WS_WQB), M, DILQ, D}; pg8::StaticOrder S; S.init(M, DILQ, F.G, (int)blockIdx.x);
          pg8::EpiDil<false> E{(bf16*)(ws + A_QB), C2_DIL};
          pg8::gemm_phase<pg8::EpiDil<false>, pg8::StaticOrder, true, true, 0>(F.lds, g, S, E, mi0); }
    } SEAM(11);
    if (IN(12)) for (int rep_ = 0; rep_ < REP(12); ++rep_) {
        const bf16* Qp = (const bf16*)(ws + A_QB); const bf16* KV = (const bf16*)(ws + A_KVB); bf16* OG = (bf16*)(ws + A_OG); float* LSE = (float*)(ws + WS_LSE); const float* BT = (const float*)(ws + WS_BIAS);
        dila::dil_phase(Qp, KV, OG, LSE, BT, (char*)lds, F.G);
    } SEAM(12);
    if (IN(13)) for (int rep_ = 0; rep_ < REP(13); ++rep_) { merge_phase(F); } SEAM(13);
    if (IN(14)) for (int rep_ = 0; rep_ < REP(14); ++rep_) { pg8::Gemm g{(const bf16*)(ws + A_OD), (const bf16*)(ws + WS_WOB), M, D, DILOUT}; pg8::StaticOrder S; S.init(M, D, F.G, (int)blockIdx.x);
        pg8::EpiResid<false> E{H, H, MV(MK_G_MIX1)};
        pg8::gemm_phase<pg8::EpiResid<false>, pg8::StaticOrder, true, true, 0>(F.lds, g, S, E, mi0); } SEAM(14);
    if (IN(15)) for (int rep_ = 0; rep_ < REP(15); ++rep_) { router_phase(F, H, MV(MK_A_FFN1), MV(MK_B_FFN1), XN); } SEAM(15);
    if (IN(16)) for (int rep_ = 0; rep_ < REP(16); ++rep_) { lists_phase(F); } SEAM(16);
    if (IN(17)) for (int rep_ = 0; rep_ < REP(17); ++rep_) { const int ntile = ((const int*)(ws + WS_TILEEXP))[300];
        pg8::Gemm g{XN, (const bf16*)(ws + WS_WEGU), ntile * 256, 2 * DFF, D}; pg8::StaticOrder S; S.init(ntile * 256, 2 * DFF, F.G, (int)blockIdx.x);
        pg8::EpiSwiGLU E{(bf16*)(ws + A_HIDS), DFF};
        const pg8::MoeInfo mi{(const int*)(ws + WS_LIST), (const int*)(ws + WS_TILEEXP), (size_t)2 * DFF * D * 2};
        pg8::gemm_phase<pg8::EpiSwiGLU, pg8::StaticOrder, true, true, 1>(F.lds, g, S, E, mi); } SEAM(17);
    if (IN(18)) for (int rep_ = 0; rep_ < REP(18); ++rep_) { const int ntile = ((const int*)(ws + WS_TILEEXP))[300];
        pg8::Gemm g{(const bf16*)(ws + A_HIDS), (const bf16*)(ws + WS_WEDN), ntile * 256, D, DFF}; pg8::StaticOrder S; S.init(ntile * 256, D, F.G, (int)blockIdx.x);
        pg8::EpiMoeDown E{(bf16*)(ws + A_Y), (const float*)(ws + WS_SLOTG)};
        const pg8::MoeInfo mi{(const int*)(ws + WS_LIST), (const int*)(ws + WS_TILEEXP), (size_t)D * DFF * 2};
        pg8::gemm_phase<pg8::EpiMoeDown, pg8::StaticOrder, true, true, 2>(F.lds, g, S, E, mi); } SEAM(18);
    if (IN(19)) for (int rep_ = 0; rep_ < REP(19); ++rep_) { final_phase(F, args.out, MV(MK_G_FFN1), F.in[25]); }
#undef IN
#undef SEAM
#undef MV
}

extern "C" void kernel_launch(void* const* d_in, const int* in_sizes, int n_in, void* d_out, int out_size, void* d_ws, size_t ws_size, hipStream_t stream) {
    static int grid = 0;
    if (grid == 0) {
        if (n_in != 26 || in_sizes[0] != M * D || out_size != M * D || ws_size < WS_END) { fprintf(stderr, "kernel_launch: unexpected shapes (n_in %d, in0 %d, out %d, ws %zu, need %zu); nothing launched\n", n_in, n_in > 0 ? in_sizes[0] : -1, out_size, ws_size, (size_t)WS_END); grid = -1; return; }
        int dev = 0, cus = 0, per_cu = 0;
        if (hipGetDevice(&dev) != hipSuccess || hipDeviceGetAttribute(&cus, hipDeviceAttributeMultiprocessorCount, dev) != hipSuccess) { grid = -1; return; }
        if (hipFuncSetAttribute((const void*)mk_fwd, hipFuncAttributeMaxDynamicSharedMemorySize, LDS_BYTES) != hipSuccess) { fprintf(stderr, "kernel_launch: hipFuncSetAttribute failed\n"); grid = -1; return; }
        if (hipOccupancyMaxActiveBlocksPerMultiprocessor(&per_cu, (const void*)mk_fwd, NWAVES * 64, LDS_BYTES) != hipSuccess || per_cu < 1) { fprintf(stderr, "kernel_launch: occupancy query reports %d\n", per_cu); }
        (void)hipGetLastError();
        grid = cus;
    }
    if (grid < 0) return;
    if (hipMemsetAsync((char*)d_ws + WS_CTL, 0, CTL_ZERO_BYTES, stream) != hipSuccess) return;
    Args a{};
    for (int i = 0; i < 26; ++i) a.in[i] = (const float*)d_in[i];
    a.out = (float*)d_out; a.ws = (unsigned char*)d_ws;
#if MK_ONE_LAUNCH
    a.ph_lo = 0; a.ph_hi = N_PHASES;
    hipLaunchKernelGGL(mk_fwd, dim3(grid), dim3(NWAVES * 64), LDS_BYTES, stream, a);
#else
    for (int p = 0; p < N_PHASES; ++p) { a.ph_lo = p; a.ph_hi = p + 1; hipLaunchKernelGGL(mk_fwd, dim3(grid), dim3(NWAVES * 64), LDS_BYTES, stream, a); }
#endif
}
```

```cpp
#include <hip/hip_runtime.h>
#include <hip/hip_bf16.h>
#include <cstdio>
#include <cstdint>
#include <cmath>
#ifndef MK_ONE_LAUNCH
#define MK_ONE_LAUNCH 1
#endif
#ifndef PG8_STAGGER
#define PG8_STAGGER 0
#endif
namespace pg8 {
#define PG8_LAS __attribute__((address_space(3)))
typedef unsigned short bf16_t;
typedef short bf16x8 __attribute__((ext_vector_type(8)));
typedef float f32x4 __attribute__((ext_vector_type(4)));
typedef float f32x2 __attribute__((ext_vector_type(2)));
typedef unsigned u32x4 __attribute__((ext_vector_type(4)));
typedef int i32x4 __attribute__((ext_vector_type(4)));
template <bool I8> struct AccT { typedef f32x4 type; }; template <> struct AccT<true> { typedef i32x4 type; };
constexpr int BM = 256, BK = 64, HALF = 128, HTB = HALF * BK * 2  , STAGE_BYTES = 8 * HTB, NXCD = 8, WGM = 8;

__host__ __device__ __forceinline__ int lds_byte(int r, int c) { const int st = (r >> 4) * 2 + (c >> 5), rr = r & 15, cc = c & 31, ob = rr * 64 + cc * 2; return st * 1024 + (ob ^ (((ob >> 9) & 1) << 5)); }
__host__ __device__ __forceinline__ void stage_rc(int b, int& R, int& C) { const int st = b / 1024, sb = b % 1024, swz = sb ^ (((sb >> 9) & 1) << 5); R = (st >> 1) * 16 + swz / 64; C = (st & 1) * 32 + (swz % 64) / 2; }
__host__ __device__ __forceinline__ int perm32(int rho) { const int n = rho >> 4, i = rho & 15; return 8 * (i >> 2) + 4 * n + (i & 3); }

struct Unit { int pm, pn; };
struct Gemm { const bf16_t* A; const bf16_t* Bt; int M, N, K; };
struct MoeInfo { const int* list; const int* tile_expert; size_t bstride; };

struct StaticOrder {
    int nM, nN, nwg, G, c;
    __host__ __device__ void init(int M, int N, int G_, int c_) { nM = M / BM; nN = N / BM; nwg = nM * nN; G = G_; c = c_; }
    __host__ __device__ bool next(int i, Unit& u) const {
        const long L = (long)i * G + c; if (L >= nwg) return false;
        int wgid = (int)L; { const int q = nwg / NXCD, r = nwg % NXCD, xcd = wgid % NXCD, off = wgid / NXCD; wgid = (xcd < r ? xcd * (q + 1) : r * (q + 1) + (xcd - r) * q) + off; }
        const int nig = WGM * nN, gid = wgid / nig, fm = gid * WGM, gsz = (nM - fm) < WGM ? (nM - fm) : WGM;
        u.pm = fm + ((wgid % nig) % gsz); u.pn = (wgid % nig) / gsz; return true;
    }
    __device__ __forceinline__ void a_ready(const Unit&) const {}
    __device__ __forceinline__ void done(const Unit&) const {}
};

__device__ __forceinline__ unsigned cvt_pk_bf16(float lo, float hi) { unsigned r; asm volatile("v_cvt_pk_bf16_f32 %0, %1, %2" : "=v"(r) : "v"(lo), "v"(hi)); return r; }


template <class Epi, class Sched, bool ALIGN_EPI, bool SP2, int MODE, bool I8 = false>
__device__ __forceinline__ void gemm_phase(PG8_LAS unsigned char* lds, const Gemm g, const Sched& S, const Epi& E, const MoeInfo mi) {
    const int tid = threadIdx.x, wid = __builtin_amdgcn_readfirstlane(tid >> 6), lane = tid & 63, wr = wid >> 2, wc = wid & 3, fr = lane & 15, fq = lane >> 4;
    int K_ = g.K; asm volatile("" : "+s"(K_));
    constexpr int ES = I8 ? 1 : 2;
    const int K = K_, nt = (K * ES) / (BK * 2);
    unsigned voffB[2]; int Rr[2], Cc[2];
#pragma unroll
    for (int i = 0; i < 2; ++i) { int R, C; stage_rc(tid * 16 + i * 8192, R, C); const int Rb = Epi::PERM ? ((R & ~31) + perm32(R & 31)) : R;
        Rr[i] = R; Cc[i] = C; voffB[i] = (unsigned)(Rb * K) * (unsigned)ES + (unsigned)C * 2u; }
    const size_t kstep = (size_t)(BK * 2);
    const size_t hstep = (size_t)HALF * K * ES;
    const size_t tstep = 2 * hstep;
    const unsigned ldsw = (unsigned)wid * 1024u;
    const int aoff = lds_byte(wr * 64 + fr, fq * 8), boff = lds_byte(wc * 32 + fr, fq * 8);
    const unsigned rowb = (unsigned)K * (unsigned)ES;
#define PG8_SA(b, h) (((b) * 2 + (h)) * HTB)
#define PG8_SB(b, h) ((4 + (b) * 2 + (h)) * HTB)
#define PG8_STAGE(bufoff, gbase, voff) do { _Pragma("unroll") for (int _i = 0; _i < 2; ++_i) \
        __builtin_amdgcn_global_load_lds((const unsigned*)((const char*)(gbase) + (voff)[_i]), (PG8_LAS unsigned*)(lds + (bufoff) + ldsw + _i * 8192), 16, 0, 0); } while (0)
#define PG8_LDA(dst, b, h) do { _Pragma("unroll") for (int m = 0; m < 4; ++m) _Pragma("unroll") for (int k = 0; k < 2; ++k) dst[m][k] = *(const PG8_LAS bf16x8*)(lds + PG8_SA(b, h) + aoff + m * 2048 + k * 1024); } while (0)
#define PG8_LDB(dst, b, h) do { _Pragma("unroll") for (int n = 0; n < 2; ++n) _Pragma("unroll") for (int k = 0; k < 2; ++k) dst[n][k] = *(const PG8_LAS bf16x8*)(lds + PG8_SB(b, h) + boff + n * 2048 + k * 1024); } while (0)
#define PG8_MMA(ai, bj, At, Bt) do { __builtin_amdgcn_s_setprio(1); _Pragma("unroll") for (int m = 0; m < 4; ++m) _Pragma("unroll") for (int n = 0; n < 2; ++n) _Pragma("unroll") for (int k = 0; k < 2; ++k) { \
        if constexpr (I8) acc[ai][bj][m][n] = __builtin_amdgcn_mfma_i32_16x16x64_i8(__builtin_bit_cast(i32x4, Bt[n][k]), __builtin_bit_cast(i32x4, At[m][k]), acc[ai][bj][m][n], 0, 0, 0); \
        else acc[ai][bj][m][n] = __builtin_amdgcn_mfma_f32_16x16x32_bf16(Bt[n][k], At[m][k], acc[ai][bj][m][n], 0, 0, 0); } __builtin_amdgcn_s_setprio(0); } while (0)
#define PG8_WAIT_V(n) asm volatile("s_waitcnt vmcnt(" #n ")" ::: "memory")
#define PG8_WAIT_L(n) asm volatile("s_waitcnt lgkmcnt(" #n ")" ::: "memory")
#define PG8_BAR __builtin_amdgcn_s_barrier()
#define PG8_SCHED __builtin_amdgcn_sched_barrier(0)
#define PG8_MKOFF(u, o) do { _Pragma("unroll") for (int _h = 0; _h < 2; ++_h) _Pragma("unroll") for (int _i = 0; _i < 2; ++_i) { \
        int _row = (u).pm * BM + _h * HALF + Rr[_i]; if (MODE == 1) _row = mi.list[_row]; (o)[_h][_i] = (unsigned)_row * rowb + (unsigned)Cc[_i] * 2u; } } while (0)
#define PG8_BBASE(u) ((const char*)g.Bt + (size_t)(u).pn * tstep + (MODE != 0 ? (size_t)mi.tile_expert[(u).pm] * mi.bstride : (size_t)0))
    Unit cur, nxt; int ui = 0;
    if (!S.next(0, cur)) return;
#if PG8_STAGGER
    {
        const int grp = ((int)blockIdx.x >> 3) & 3;
        if (grp) { if (wid == 0) { const unsigned long long t0 = __builtin_amdgcn_s_memrealtime(); const unsigned long long dt = (unsigned long long)(grp * nt * PG8_STAGGER);
                       while (__builtin_amdgcn_s_memrealtime() - t0 < dt) __builtin_amdgcn_s_sleep(8); }
                   __syncthreads(); }
    }
#endif
    typedef typename AccT<I8>::type acc_t;
    acc_t acc[2][2][4][2];
#pragma unroll
    for (int a = 0; a < 2; ++a)
#pragma unroll
        for (int b = 0; b < 2; ++b)
#pragma unroll
            for (int m = 0; m < 4; ++m)
#pragma unroll
                for (int n = 0; n < 2; ++n) acc[a][b][m][n] = acc_t{};
    bf16x8 At[4][2], B0[2][2], B1[2][2];
    unsigned oc[2][2], on[2][2];
    PG8_MKOFF(cur, oc);
    const char* const Ab = (const char*)g.A;
    const char* cB = PG8_BBASE(cur);
    S.a_ready(cur);
    static_assert(SP2, "only the SP2 loop is kept");
    {
        PG8_STAGE(PG8_SB(0, 0), cB, voffB); PG8_STAGE(PG8_SB(0, 1), cB + hstep, voffB); PG8_STAGE(PG8_SA(0, 0), Ab, oc[0]); PG8_STAGE(PG8_SA(0, 1), Ab, oc[1]);
        if (wr == 1) PG8_BAR;
        PG8_WAIT_V(2); PG8_BAR;
        PG8_STAGE(PG8_SB(1, 0), cB + kstep, voffB); PG8_STAGE(PG8_SA(1, 0), Ab + kstep, oc[0]); PG8_STAGE(PG8_SB(1, 1), cB + hstep + kstep, voffB);
        PG8_WAIT_V(6); PG8_BAR;
    }
    Unit nn; unsigned onn[2][2]; bool has_next_c = false;
    if constexpr (MODE == 1) { has_next_c = S.next(1, nxt); if (has_next_c) PG8_MKOFF(nxt, on); }
    for (;;) {
        bool has_next; bool has_nn = false;
        if constexpr (MODE == 1) { has_next = has_next_c; has_nn = has_next && S.next(ui + 2, nn); if (has_nn) PG8_MKOFF(nn, onn); }
        else has_next = S.next(ui + 1, nxt);
        const char* nB = cB;
        if (has_next) { if constexpr (MODE != 1) PG8_MKOFF(nxt, on); nB = PG8_BBASE(nxt); }
        else {
#pragma unroll
            for (int _h = 0; _h < 2; ++_h)
#pragma unroll
                for (int _i = 0; _i < 2; ++_i) on[_h][_i] = oc[_h][_i];
        }
        for (int t = 0; t < nt; t += 2) {
            const bool last = (t == nt - 2);
            const char* a1 = Ab + (size_t)(t + 1) * kstep;
            const char* a2 = last ? Ab : Ab + (size_t)(t + 2) * kstep; const char* b2 = last ? nB : cB + (size_t)(t + 2) * kstep;
            const char* a3 = a2 + kstep; const char* b3 = b2 + kstep;
            unsigned o2[2][2];
#pragma unroll
            for (int _h = 0; _h < 2; ++_h)
#pragma unroll
                for (int _i = 0; _i < 2; ++_i) o2[_h][_i] = last ? on[_h][_i] : oc[_h][_i];
            if (last && has_next) S.a_ready(nxt);
            PG8_LDB(B0, 0, 0); PG8_LDB(B1, 0, 1); PG8_SCHED; PG8_LDA(At, 0, 0); PG8_STAGE(PG8_SA(1, 1), a1, oc[1]);
            PG8_WAIT_V(8); PG8_WAIT_L(0); PG8_BAR; PG8_MMA(0, 0, At, B0); PG8_MMA(0, 1, At, B1); PG8_BAR; PG8_SCHED;
            PG8_LDA(At, 0, 1); PG8_STAGE(PG8_SB(0, 0), b2, voffB); PG8_STAGE(PG8_SB(0, 1), b2 + hstep, voffB); PG8_STAGE(PG8_SA(0, 0), a2, o2[0]);
            PG8_WAIT_V(8); PG8_WAIT_L(0); PG8_BAR; PG8_MMA(1, 0, At, B0); PG8_MMA(1, 1, At, B1); PG8_BAR; PG8_SCHED;
            PG8_LDB(B0, 1, 0); PG8_LDB(B1, 1, 1); PG8_SCHED; PG8_LDA(At, 1, 0); PG8_STAGE(PG8_SA(0, 1), a2, o2[1]);
            PG8_WAIT_V(8); PG8_WAIT_L(0); PG8_BAR; PG8_MMA(0, 0, At, B0); PG8_MMA(0, 1, At, B1); PG8_BAR; PG8_SCHED;
            PG8_LDA(At, 1, 1); PG8_STAGE(PG8_SB(1, 0), b3, voffB); PG8_STAGE(PG8_SB(1, 1), b3 + hstep, voffB); PG8_STAGE(PG8_SA(1, 0), a3, o2[0]);
            PG8_WAIT_V(8); PG8_WAIT_L(0); PG8_BAR; PG8_MMA(1, 0, At, B0); PG8_MMA(1, 1, At, B1); PG8_BAR; PG8_SCHED;
        }
        if constexpr (ALIGN_EPI) { if (wr == 0) PG8_BAR; }
        E(acc, cur, wr, wc, fr, fq); S.done(cur);
        if (!has_next) break;
#pragma unroll
        for (int a = 0; a < 2; ++a)
#pragma unroll
            for (int b = 0; b < 2; ++b)
#pragma unroll
                for (int m = 0; m < 4; ++m)
#pragma unroll
                    for (int n = 0; n < 2; ++n) acc[a][b][m][n] = acc_t{};
        cur = nxt; cB = nB; ++ui;
#pragma unroll
        for (int _h = 0; _h < 2; ++_h)
#pragma unroll
            for (int _i = 0; _i < 2; ++_i) oc[_h][_i] = on[_h][_i];
        if constexpr (MODE == 1) { nxt = nn; has_next_c = has_nn;
#pragma unroll
            for (int _h = 0; _h < 2; ++_h)
#pragma unroll
                for (int _i = 0; _i < 2; ++_i) on[_h][_i] = onn[_h][_i]; }
        if constexpr (ALIGN_EPI) { if (wr == 1) PG8_BAR; }
    }
    PG8_WAIT_V(0);
    if constexpr (!ALIGN_EPI) { if (wr == 0) PG8_BAR; }
    PG8_BAR;
#undef PG8_SA
#undef PG8_SB
#undef PG8_STAGE
#undef PG8_LDA
#undef PG8_LDB
#undef PG8_MMA
#undef PG8_WAIT_V
#undef PG8_WAIT_L
#undef PG8_BAR
#undef PG8_SCHED
#undef PG8_MKOFF
#undef PG8_BBASE
}
}
namespace pg8 {
constexpr float LOG2E = 1.4426950408889634f;
struct EpiBf16 {
    static constexpr bool PERM = true;
    bf16_t* O; int ldc; float scale;
    __device__ __forceinline__ void operator()(const f32x4 (&acc)[2][2][4][2], const Unit& u, int wr, int wc, int fr, int fq) const {
        const int row0 = u.pm * BM + wr * 64 + fr; const int col0 = u.pn * BM + wc * 32 + 8 * fq;
#pragma unroll
        for (int ai = 0; ai < 2; ++ai)
#pragma unroll
            for (int m = 0; m < 4; ++m) { bf16_t* rowp = O + (size_t)(row0 + ai * HALF + m * 16) * ldc + col0;
#pragma unroll
                for (int bj = 0; bj < 2; ++bj) { const f32x4 v0 = acc[ai][bj][m][0] * scale, v1 = acc[ai][bj][m][1] * scale;
                    u32x4 w; w.x = cvt_pk_bf16(v0[0], v0[1]); w.y = cvt_pk_bf16(v0[2], v0[3]); w.z = cvt_pk_bf16(v1[0], v1[1]); w.w = cvt_pk_bf16(v1[2], v1[3]);
                    *(u32x4*)(rowp + bj * HALF) = w; } }
    }
};
struct EpiQ {
    static constexpr bool PERM = true;
    bf16_t* O; int ldc; float scale; const float* cs;
    __device__ __forceinline__ void operator()(const f32x4 (&acc)[2][2][4][2], const Unit& u, int wr, int wc, int fr, int fq) const {
        const int row0 = u.pm * BM + wr * 64 + fr; const int col0 = u.pn * BM + wc * 32 + 8 * fq;
        const int grp = u.pn * 8 + wc;
#pragma unroll
        for (int bj = 0; bj < 2; ++bj) { const bool rope = ((grp + 4 * bj) % 3) == 2;
#pragma unroll
            for (int ai = 0; ai < 2; ++ai)
#pragma unroll
                for (int m = 0; m < 4; ++m) { const int row = row0 + ai * HALF + m * 16; bf16_t* rowp = O + (size_t)row * ldc + col0 + bj * HALF;
                    f32x4 v0 = acc[ai][bj][m][0] * scale, v1 = acc[ai][bj][m][1] * scale;
                    if (rope) { const f32x4* cp = (const f32x4*)(cs + (size_t)row * 32 + 8 * fq); const f32x4 c0 = cp[0], c1 = cp[1];
                        f32x4 r0, r1;
                        r0[0] = v0[0] * c0[0] - v0[1] * c0[1]; r0[1] = v0[0] * c0[1] + v0[1] * c0[0];
                        r0[2] = v0[2] * c0[2] - v0[3] * c0[3]; r0[3] = v0[2] * c0[3] + v0[3] * c0[2];
                        r1[0] = v1[0] * c1[0] - v1[1] * c1[1]; r1[1] = v1[0] * c1[1] + v1[1] * c1[0];
                        r1[2] = v1[2] * c1[2] - v1[3] * c1[3]; r1[3] = v1[2] * c1[3] + v1[3] * c1[2];
                        v0 = r0; v1 = r1; }
                    u32x4 w; w.x = cvt_pk_bf16(v0[0], v0[1]); w.y = cvt_pk_bf16(v0[2], v0[3]); w.z = cvt_pk_bf16(v1[0], v1[1]); w.w = cvt_pk_bf16(v1[2], v1[3]);
                    *(u32x4*)rowp = w;
                    if (m & 1) asm volatile("" ::: "memory"); } }
    }
};
struct EpiKV {
    static constexpr bool PERM = true;
    bf16_t* Kb; bf16_t* Vb;
    __device__ __forceinline__ void operator()(const f32x4 (&acc)[2][2][4][2], const Unit& u, int wr, int wc, int fr, int fq) const {
        const int row0 = u.pm * BM + wr * 64 + fr;
        const bool isk = wc < 2;
        bf16_t* const base = isk ? Kb : Vb; const int pitch = isk ? 1536 : 1024, hs = isk ? 96 : 64, j0 = (isk ? wc : wc - 2) * 32 + 8 * fq;
#pragma unroll
        for (int ai = 0; ai < 2; ++ai)
#pragma unroll
            for (int m = 0; m < 4; ++m) { bf16_t* rowp = base + (size_t)(row0 + ai * HALF + m * 16) * pitch + j0;
#pragma unroll
                for (int bj = 0; bj < 2; ++bj) { const f32x4 v0 = acc[ai][bj][m][0], v1 = acc[ai][bj][m][1];
                    u32x4 w; w.x = cvt_pk_bf16(v0[0], v0[1]); w.y = cvt_pk_bf16(v0[2], v0[3]); w.z = cvt_pk_bf16(v1[0], v1[1]); w.w = cvt_pk_bf16(v1[2], v1[3]);
                    *(u32x4*)(rowp + (2 * u.pn + bj) * hs) = w; } }
    }
};
template <bool BASEF32> struct EpiResid {
    static constexpr bool PERM = true;
    static constexpr int HP = 2048;
    const void* base; bf16_t* out; const float* gate;
    __device__ __forceinline__ void operator()(const f32x4 (&acc)[2][2][4][2], const Unit& u, int wr, int wc, int fr, int fq) const {
        const int row0 = u.pm * BM + wr * 64 + fr; const int col0 = u.pn * BM + wc * 32 + 8 * fq;
        const float* gp = gate + (size_t)((u.pm * BM) >> 13) * 1024 + col0;
        f32x4 gv[2][2];
#pragma unroll
        for (int bj = 0; bj < 2; ++bj)
#pragma unroll
            for (int n = 0; n < 2; ++n) gv[bj][n] = *(const f32x4*)(gp + bj * HALF + n * 4);
#pragma unroll
        for (int ai = 0; ai < 2; ++ai)
#pragma unroll
            for (int m = 0; m < 4; ++m) { const size_t row = (size_t)(row0 + ai * HALF + m * 16);
#pragma unroll
                for (int bj = 0; bj < 2; ++bj) { f32x4 b0, b1;
                    if (BASEF32) { const float* bp = (const float*)base + row * 1024 + col0 + bj * HALF; b0 = *(const f32x4*)bp; b1 = *(const f32x4*)(bp + 4); }
                    else { const u32x4 hb = *(const u32x4*)((const bf16_t*)base + row * HP + col0 + bj * HALF);
                        b0 = (f32x4){__builtin_bit_cast(float, hb.x << 16), __builtin_bit_cast(float, hb.x & 0xffff0000u), __builtin_bit_cast(float, hb.y << 16), __builtin_bit_cast(float, hb.y & 0xffff0000u)};
                        b1 = (f32x4){__builtin_bit_cast(float, hb.z << 16), __builtin_bit_cast(float, hb.z & 0xffff0000u), __builtin_bit_cast(float, hb.w << 16), __builtin_bit_cast(float, hb.w & 0xffff0000u)}; }
                    const f32x4 v0 = b0 + gv[bj][0] * acc[ai][bj][m][0], v1 = b1 + gv[bj][1] * acc[ai][bj][m][1];
                    u32x4 w; w.x = cvt_pk_bf16(v0[0], v0[1]); w.y = cvt_pk_bf16(v0[2], v0[3]); w.z = cvt_pk_bf16(v1[0], v1[1]); w.w = cvt_pk_bf16(v1[2], v1[3]);
                    *(u32x4*)(out + row * HP + col0 + bj * HALF) = w; }
                if (m & 1) asm volatile("" ::: "memory"); }
    }
};
__device__ __forceinline__ float silu_mul(float g, float u) { return g * u * __builtin_amdgcn_rcpf(1.0f + __builtin_amdgcn_exp2f(-g * LOG2E)); }
struct EpiSwiGLU {
    static constexpr bool PERM = true;
    bf16_t* O; int ldc;
    __device__ __forceinline__ void operator()(const f32x4 (&acc)[2][2][4][2], const Unit& u, int wr, int wc, int fr, int fq) const {
        const int row0 = u.pm * BM + wr * 64 + fr; const int col0 = u.pn * HALF + wc * 32 + 8 * fq;
#pragma unroll
        for (int ai = 0; ai < 2; ++ai)
#pragma unroll
            for (int m = 0; m < 4; ++m) { bf16_t* rowp = O + (size_t)(row0 + ai * HALF + m * 16) * ldc + col0;
                const f32x4 g0 = acc[ai][0][m][0], g1 = acc[ai][0][m][1], u0 = acc[ai][1][m][0], u1 = acc[ai][1][m][1];
                u32x4 w; w.x = cvt_pk_bf16(silu_mul(g0[0], u0[0]), silu_mul(g0[1], u0[1])); w.y = cvt_pk_bf16(silu_mul(g0[2], u0[2]), silu_mul(g0[3], u0[3]));
                w.z = cvt_pk_bf16(silu_mul(g1[0], u1[0]), silu_mul(g1[1], u1[1])); w.w = cvt_pk_bf16(silu_mul(g1[2], u1[2]), silu_mul(g1[3], u1[3]));
                *(u32x4*)rowp = w; }
    }
};
struct EpiMoeDown {
    static constexpr bool PERM = true;
    bf16_t* O; const float* sg;
    __device__ __forceinline__ void operator()(const f32x4 (&acc)[2][2][4][2], const Unit& u, int wr, int wc, int fr, int fq) const {
        const int row0 = u.pm * BM + wr * 64 + fr; const int col0 = u.pn * BM + wc * 32 + 8 * fq;
#pragma unroll
        for (int ai = 0; ai < 2; ++ai)
#pragma unroll
            for (int m = 0; m < 4; ++m) { const int row = row0 + ai * HALF + m * 16; const float s = sg[row]; bf16_t* rowp = O + (size_t)row * 1024 + col0;
#pragma unroll
                for (int bj = 0; bj < 2; ++bj) { const f32x4 v0 = acc[ai][bj][m][0] * s, v1 = acc[ai][bj][m][1] * s;
                    u32x4 w; w.x = cvt_pk_bf16(v0[0], v0[1]); w.y = cvt_pk_bf16(v0[2], v0[3]); w.z = cvt_pk_bf16(v1[0], v1[1]); w.w = cvt_pk_bf16(v1[2], v1[3]);
                    *(u32x4*)(rowp + bj * HALF) = w; } }
    }
};
template <bool KV> struct EpiDil {
    static constexpr bool PERM = true;
    bf16_t* O; float scale;
    __device__ __forceinline__ void operator()(const f32x4 (&acc)[2][2][4][2], const Unit& u, int wr, int wc, int fr, int fq) const {
        const int row0 = u.pm * BM + wr * 64 + fr;
#pragma unroll
        for (int bj = 0; bj < 2; ++bj) { const int col = u.pn * BM + bj * HALF + wc * 32 + 8 * fq;
            const int g = KV ? (col >> 10) : (col >> 9), h = (col >> 6) & 7, d = col & 63, kv = KV ? ((col >> 9) & 1) : 0;
            const int sh = 2 * g;
#pragma unroll
            for (int ai = 0; ai < 2; ++ai)
#pragma unroll
                for (int m = 0; m < 4; ++m) { const int row = row0 + ai * HALF + m * 16, b = row >> 13, t = row & 8191;
                    const int r = t & ((1 << sh) - 1), pos = t >> sh;
                    const size_t rec = (size_t)g * 262144 + (size_t)((((b << sh) + r) * 8 + h) * (8192 >> sh) + pos);
                    bf16_t* dst = KV ? (O + rec * 128 + kv * 64 + d) : (O + rec * 64 + d);
                    const f32x4 v0 = acc[ai][bj][m][0] * scale, v1 = acc[ai][bj][m][1] * scale;
                    u32x4 w; w.x = cvt_pk_bf16(v0[0], v0[1]); w.y = cvt_pk_bf16(v0[2], v0[3]); w.z = cvt_pk_bf16(v1[0], v1[1]); w.w = cvt_pk_bf16(v1[2], v1[3]);
                    *(u32x4*)dst = w; } }
    }
};
}
namespace pg8 {
__device__ __forceinline__ f32x4 i2f(const i32x4& a, float sa, const f32x4& sb) { return (f32x4){(float)a[0], (float)a[1], (float)a[2], (float)a[3]} * sa * sb; }
struct EpiBf16Q {
    static constexpr bool PERM = true;
    bf16_t* O; int ldc; const float* sA; const float* sB;
    __device__ __forceinline__ void operator()(const i32x4 (&acc)[2][2][4][2], const Unit& u, int wr, int wc, int fr, int fq) const {
        const int row0 = u.pm * BM + wr * 64 + fr; const int col0 = u.pn * BM + wc * 32 + 8 * fq;
        f32x4 sb[2][2];
#pragma unroll
        for (int bj = 0; bj < 2; ++bj)
#pragma unroll
            for (int n = 0; n < 2; ++n) sb[bj][n] = *(const f32x4*)(sB + col0 + bj * HALF + 4 * n);
#pragma unroll
        for (int ai = 0; ai < 2; ++ai)
#pragma unroll
            for (int m = 0; m < 4; ++m) { const int row = row0 + ai * HALF + m * 16; const float sa = sA[row]; bf16_t* rowp = O + (size_t)row * ldc + col0;
#pragma unroll
                for (int bj = 0; bj < 2; ++bj) { const f32x4 v0 = i2f(acc[ai][bj][m][0], sa, sb[bj][0]), v1 = i2f(acc[ai][bj][m][1], sa, sb[bj][1]);
                    u32x4 w; w.x = cvt_pk_bf16(v0[0], v0[1]); w.y = cvt_pk_bf16(v0[2], v0[3]); w.z = cvt_pk_bf16(v1[0], v1[1]); w.w = cvt_pk_bf16(v1[2], v1[3]);
                    *(u32x4*)(rowp + bj * HALF) = w; } }
    }
};
template <bool KV> struct EpiDilQ {
    static constexpr bool PERM = true;
    bf16_t* O; const float* sA; const float* sB;
    __device__ __forceinline__ void operator()(const i32x4 (&acc)[2][2][4][2], const Unit& u, int wr, int wc, int fr, int fq) const {
        bf16_t* const O_ = O; constexpr float scale_ = KV ? 1.0f : 0.18033688011112042f; const float* const sA_ = sA; const float* const sB_ = sB;
        const int row0 = u.pm * BM + wr * 64 + fr;
        const int colt = u.pn * BM;
        const int g = KV ? (colt >> 10) : (colt >> 9), kv = KV ? ((colt >> 9) & 1) : 0, sh = 2 * g, npos = 8192 >> sh;
        constexpr int RS = KV ? 128 : 64;
        const int d = (wc & 1) * 32 + 8 * fq;
        size_t hoff[2]; f32x4 sb[2][2];
#pragma unroll
        for (int bj = 0; bj < 2; ++bj) { const int col = colt + bj * HALF + wc * 32 + 8 * fq; const int h = (col >> 6) & 7;
            hoff[bj] = (size_t)h * npos * RS + kv * 64 + d; sb[bj][0] = *(const f32x4*)(sB_ + col) * scale_; sb[bj][1] = *(const f32x4*)(sB_ + col + 4) * scale_; }
#pragma unroll
        for (int ai = 0; ai < 2; ++ai)
#pragma unroll
            for (int m = 0; m < 4; ++m) { const int row = row0 + ai * HALF + m * 16, b = row >> 13, t = row & 8191;
                const int r = t & ((1 << sh) - 1), pos = t >> sh;
                bf16_t* rp = O_ + ((size_t)g * 262144 + (size_t)(((b << sh) + r) * 8 * npos + pos)) * RS;
                const float sa = sA_[row];
#pragma unroll
                for (int bj = 0; bj < 2; ++bj) { const f32x4 v0 = i2f(acc[ai][bj][m][0], sa, sb[bj][0]), v1 = i2f(acc[ai][bj][m][1], sa, sb[bj][1]);
                    u32x4 w; w.x = cvt_pk_bf16(v0[0], v0[1]); w.y = cvt_pk_bf16(v0[2], v0[3]); w.z = cvt_pk_bf16(v1[0], v1[1]); w.w = cvt_pk_bf16(v1[2], v1[3]);
                    *(u32x4*)(rp + hoff[bj]) = w; }
                if (m & 1) asm volatile("" ::: "memory"); }
    }
};
struct EpiSwiGLUQ {
    static constexpr bool PERM = true;
    bf16_t* O; int ldc; const float* sA; const float* sB; const int* list; const int* tile_expert;
    __device__ __forceinline__ void operator()(const i32x4 (&acc)[2][2][4][2], const Unit& u, int wr, int wc, int fr, int fq) const {
        const int row0 = u.pm * BM + wr * 64 + fr; const int col0 = u.pn * HALF + wc * 32 + 8 * fq;
        const float* sb = sB + (tile_expert ? (size_t)tile_expert[u.pm] * (2 * 2816) : (size_t)0) + u.pn * BM + wc * 32 + 8 * fq;
        const f32x4 sg0 = *(const f32x4*)sb, sg1 = *(const f32x4*)(sb + 4), su0 = *(const f32x4*)(sb + HALF), su1 = *(const f32x4*)(sb + HALF + 4);
#pragma unroll
        for (int ai = 0; ai < 2; ++ai)
#pragma unroll
            for (int m = 0; m < 4; ++m) { const int row = row0 + ai * HALF + m * 16; const float sa = sA[list ? list[row] : row]; bf16_t* rowp = O + (size_t)row * ldc + col0;
                const f32x4 g0 = i2f(acc[ai][0][m][0], sa, sg0), g1 = i2f(acc[ai][0][m][1], sa, sg1), u0 = i2f(acc[ai][1][m][0], sa, su0), u1 = i2f(acc[ai][1][m][1], sa, su1);
                u32x4 w; w.x = cvt_pk_bf16(silu_mul(g0[0], u0[0]), silu_mul(g0[1], u0[1])); w.y = cvt_pk_bf16(silu_mul(g0[2], u0[2]), silu_mul(g0[3], u0[3]));
                w.z = cvt_pk_bf16(silu_mul(g1[0], u1[0]), silu_mul(g1[1], u1[1])); w.w = cvt_pk_bf16(silu_mul(g1[2], u1[2]), silu_mul(g1[3], u1[3]));
                *(u32x4*)rowp = w; }
    }
};
}
namespace att {
using bf16 = unsigned short;
using bf16x8 = __attribute__((ext_vector_type(8))) short;
using s16x4 = __attribute__((ext_vector_type(4))) short;
using f32x16 = __attribute__((ext_vector_type(16))) float;
using u32x4 = __attribute__((ext_vector_type(4))) unsigned;
constexpr int NW = 8;
constexpr float THR = 8.0f;
__device__ __forceinline__ int crow(int r, int hi) { return (r & 3) + 8 * (r >> 2) + 4 * hi; }
__device__ __forceinline__ void glds16(const void* gsrc, unsigned lds_dst) { unsigned keep;
    asm volatile("s_mov_b32 %0, m0\n\ts_mov_b32 m0, %2\n\ts_nop 0\n\tglobal_load_lds_dwordx4 %1, off\n\ts_mov_b32 m0, %0" : "=&s"(keep) : "v"(gsrc), "s"(lds_dst) : "memory"); }
typedef float f32x2_t __attribute__((ext_vector_type(2))); typedef __bf16 bf16x2_t __attribute__((ext_vector_type(2)));
__device__ __forceinline__ unsigned cvtpk_s(float lo, float hi) { f32x2_t v = {lo, hi}; bf16x2_t b = __builtin_convertvector(v, bf16x2_t); return __builtin_bit_cast(unsigned, b); }
#define ATT_SBAR() __builtin_amdgcn_sched_barrier(0)
#define ATT_WAIT_BAR(N) asm volatile("s_waitcnt vmcnt(" #N ") lgkmcnt(0)\n\ts_barrier" ::: "memory")

template <int DQK> struct Lay {
    static constexpr int NKC = DQK / 8, KSLOT = NKC * 1024, ND0 = DQK / 16;
    static constexpr int LK = 0, LV = 3 * KSLOT, LWS = LV + 3 * 8192, LOST = LWS + NW * 256, LBIAS = LOST + NW * 4096, LEND = LBIAS + 1024;
};
static_assert(Lay<96>::LEND <= 131072 && Lay<64>::LEND <= 131072, "attention LDS");

__device__ __forceinline__ float rowmax32(const f32x16& p0, const f32x16& p1) {
    float a = __builtin_fmaxf(__builtin_fmaxf(p0[0], p0[1]), p1[0]), b = __builtin_fmaxf(__builtin_fmaxf(p0[2], p0[3]), p1[1]); a = __builtin_fmaxf(__builtin_fmaxf(a, p1[2]), p1[3]);
#pragma unroll
    for (int r = 4; r < 16; r += 4) { a = __builtin_fmaxf(__builtin_fmaxf(a, p0[r]), p0[r + 1]); b = __builtin_fmaxf(__builtin_fmaxf(b, p0[r + 2]), p0[r + 3]); a = __builtin_fmaxf(__builtin_fmaxf(a, p1[r]), p1[r + 1]); b = __builtin_fmaxf(__builtin_fmaxf(b, p1[r + 2]), p1[r + 3]); }
    float m = __builtin_fmaxf(a, b);
    auto rr = __builtin_amdgcn_permlane32_swap(__float_as_uint(m), __float_as_uint(m), false, false);
    return __builtin_fmaxf(__uint_as_float(rr[0]), __uint_as_float(rr[1]));
}
__device__ __forceinline__ void pv(f32x16* o, int vb, bf16x8 pa0, bf16x8 pa1, bf16x8 pa2, bf16x8 pa3) {
#pragma unroll
    for (int d0 = 0; d0 < 2; ++d0) { s16x4 lo[4], hi[4];
#pragma unroll
        for (int ks = 0; ks < 4; ++ks) {
            asm volatile("ds_read_b64_tr_b16 %0,%1 offset:%c2" : "=&v"(lo[ks]) : "v"(vb), "i"(d0 * 4096 + ks * 1024) : "memory");
            asm volatile("ds_read_b64_tr_b16 %0,%1 offset:%c2" : "=&v"(hi[ks]) : "v"(vb), "i"(d0 * 4096 + ks * 1024 + 512) : "memory"); }
        asm volatile("s_waitcnt lgkmcnt(0)" ::: "memory"); ATT_SBAR();
#define ATT_PK(k) (bf16x8){lo[k][0], lo[k][1], lo[k][2], lo[k][3], hi[k][0], hi[k][1], hi[k][2], hi[k][3]}
        o[d0] = __builtin_amdgcn_mfma_f32_32x32x16_bf16(pa0, ATT_PK(0), o[d0], 0, 0, 0);
        o[d0] = __builtin_amdgcn_mfma_f32_32x32x16_bf16(pa1, ATT_PK(1), o[d0], 0, 0, 0);
        o[d0] = __builtin_amdgcn_mfma_f32_32x32x16_bf16(pa2, ATT_PK(2), o[d0], 0, 0, 0);
        o[d0] = __builtin_amdgcn_mfma_f32_32x32x16_bf16(pa3, ATT_PK(3), o[d0], 0, 0, 0);
#undef ATT_PK
    }
}

template <int DQK, bool DIL>
__device__ __forceinline__ void attn_unit(const bf16* Qb, int pq, const bf16* __restrict__ Kb, int pk, const bf16* __restrict__ Vb, int pvp, bf16* Ob, int po, float* lse, const float* biasg,
                                          long rowbase, int dil, int q0, char* shm) {
    typedef Lay<DQK> L;
    const int tid = threadIdx.x, lane = tid & 63, r32 = lane & 31, hi = lane >> 5; const int wid = __builtin_amdgcn_readfirstlane(tid >> 6);
    const unsigned lds0 = (unsigned)(uintptr_t)shm;
    float* wsf = (float*)(shm + L::LWS) + wid * 64;
    const int kpos0 = DIL ? q0 - 128 : 0;
    const int t_begin = DIL ? (q0 == 0 ? 2 : 0) : 0;
    const int t_end = DIL ? 6 : (q0 + 256) / 64;
    const int wt0 = DIL ? (wid >> 1) : 0;
    const int wt1 = DIL ? 2 + (wid >> 1) : (q0 + 32 * wid + 31) / 64;
    const bool two_k = (L::NKC > 8) && (wid + 8 < L::NKC);
#define ATT_GROW(pos) (rowbase + (long)(pos) * dil)
#define ATT_ISSUE(t, s) do { const int kp_ = kpos0 + 64 * (t); \
        glds16(Kb + ATT_GROW(kp_ + lane) * pk + wid * 8, (unsigned)__builtin_amdgcn_readfirstlane(lds0 + L::LK + (s) * L::KSLOT + wid * 1024)); \
        if (two_k) glds16(Kb + ATT_GROW(kp_ + lane) * pk + (wid + 8) * 8, (unsigned)__builtin_amdgcn_readfirstlane(lds0 + L::LK + (s) * L::KSLOT + (wid + 8) * 1024)); \
        glds16(Vb + ATT_GROW(kp_ + 16 * (wid & 3) + (lane >> 2)) * pvp + (wid >> 2) * 32 + (lane & 3) * 8, (unsigned)__builtin_amdgcn_readfirstlane(lds0 + L::LV + (s) * 8192 + wid * 1024)); } while (0)
    if (DIL) { if (tid < 129) ((float*)(shm + L::LBIAS))[tid] = biasg[tid]; }
    ATT_ISSUE(t_begin, 0);
    if (t_begin + 1 < t_end) ATT_ISSUE(t_begin + 1, 1);
    bf16x8 qr[L::ND0];
    { const bf16* Qw = Qb + ATT_GROW(q0 + wid * 32 + r32) * pq + hi * 8;
#pragma unroll
      for (int d0 = 0; d0 < L::ND0; ++d0) qr[d0] = *reinterpret_cast<const bf16x8*>(Qw + d0 * 16); }
    float mhat = 0.f, l_reg = 0.f; f32x16 o[2]; o[0] = f32x16{}; o[1] = f32x16{}; f32x16 negm = f32x16{};
    bool first = true;
    const int qrel = (DIL ? 128 : q0) + wid * 32 + r32;
    const int vbl = (int)(lds0 + L::LV) + ((lane >> 4) & 1) * 32 + (lane & 3) * 8 + (4 * hi + ((lane & 15) >> 2)) * 64;
    int slot = 0;
    for (int t = t_begin; t < t_end; ++t) {
        if (t + 1 < t_end) { if (two_k) ATT_WAIT_BAR(3); else ATT_WAIT_BAR(2); } else ATT_WAIT_BAR(0);
        if (t + 2 < t_end) { const int s2 = slot >= 1 ? slot - 1 : 2; ATT_ISSUE(t + 2, s2); }
        if (t >= wt0 && t <= wt1) {
            f32x16 p0, p1;
            { const char* kb = shm + L::LK + slot * L::KSLOT + hi * 1024 + r32 * 16;
#pragma unroll
              for (int d0 = 0; d0 < L::ND0; ++d0) {
                const bf16x8 b0 = *reinterpret_cast<const bf16x8*>(kb + d0 * 2048);
                const bf16x8 b1 = *reinterpret_cast<const bf16x8*>(kb + d0 * 2048 + 512);
                if (d0 == 0) { p0 = __builtin_amdgcn_mfma_f32_32x32x16_bf16(b0, qr[0], negm, 0, 0, 0); p1 = __builtin_amdgcn_mfma_f32_32x32x16_bf16(b1, qr[0], negm, 0, 0, 0); }
                else { p0 = __builtin_amdgcn_mfma_f32_32x32x16_bf16(b0, qr[d0], p0, 0, 0, 0); p1 = __builtin_amdgcn_mfma_f32_32x32x16_bf16(b1, qr[d0], p1, 0, 0, 0); } } }
            if (DIL) { const float* bl = (const float*)(shm + L::LBIAS); const int jb = qrel - 64 * t - 4 * hi;
#pragma unroll
                for (int r = 0; r < 16; ++r) { const int j0 = jb - ((r & 3) + 8 * (r >> 2)), j1 = j0 - 32;
                    const int c0 = j0 < 0 ? 0 : (j0 > 128 ? 128 : j0), c1 = j1 < 0 ? 0 : (j1 > 128 ? 128 : j1);
                    const float b0 = bl[c0], b1 = bl[c1];
                    p0[r] = (j0 >= 0 && j0 <= 128) ? p0[r] + b0 : -INFINITY; p1[r] = (j1 >= 0 && j1 <= 128) ? p1[r] + b1 : -INFINITY; }
            } else if (64 * t + 63 > q0 + 32 * wid) { const int jb = qrel - 64 * t - 4 * hi;
#pragma unroll
                for (int r = 0; r < 16; ++r) { const int j0 = jb - ((r & 3) + 8 * (r >> 2)); if (j0 < 0) p0[r] = -INFINITY; if (j0 - 32 < 0) p1[r] = -INFINITY; } }
            const float rm = rowmax32(p0, p1);
            if (first) { first = false; const float dl = rm; mhat += dl;
#pragma unroll
                for (int r = 0; r < 16; ++r) { p0[r] -= dl; p1[r] -= dl; }
#pragma unroll
                for (int r = 0; r < 16; ++r) negm[r] = -mhat;
            } else if (__any(rm > THR)) { const float dl = __builtin_fmaxf(rm, 0.f); mhat += dl;
#pragma unroll
                for (int r = 0; r < 16; ++r) { p0[r] -= dl; p1[r] -= dl; }
#pragma unroll
                for (int r = 0; r < 16; ++r) negm[r] = -mhat;
                const float f = __builtin_amdgcn_exp2f(-dl); l_reg *= f; if (hi == 0) wsf[r32] = f;
                asm volatile("s_waitcnt lgkmcnt(0)" ::: "memory");
#pragma unroll
                for (int d_ = 0; d_ < 2; ++d_)
#pragma unroll
                    for (int r = 0; r < 16; ++r) o[d_][r] *= wsf[crow(r, hi)];
                asm volatile("s_waitcnt lgkmcnt(0)" ::: "memory");
            }
            float sacc = 0.f;
#pragma unroll
            for (int r = 0; r < 16; ++r) { p0[r] = __builtin_amdgcn_exp2f(p0[r]); p1[r] = __builtin_amdgcn_exp2f(p1[r]); sacc += p0[r] + p1[r]; }
            l_reg += sacc;
            u32x4 pw0, pw1, pw2, pw3;
#define ATT_PKW(P, B) cvtpk_s(P[B], P[B + 1])
            pw0 = (u32x4){ATT_PKW(p0, 0), ATT_PKW(p0, 2), ATT_PKW(p0, 4), ATT_PKW(p0, 6)}; pw1 = (u32x4){ATT_PKW(p0, 8), ATT_PKW(p0, 10), ATT_PKW(p0, 12), ATT_PKW(p0, 14)};
            pw2 = (u32x4){ATT_PKW(p1, 0), ATT_PKW(p1, 2), ATT_PKW(p1, 4), ATT_PKW(p1, 6)}; pw3 = (u32x4){ATT_PKW(p1, 8), ATT_PKW(p1, 10), ATT_PKW(p1, 12), ATT_PKW(p1, 14)};
#undef ATT_PKW
            ATT_SBAR();
            pv(o, vbl + slot * 8192, __builtin_bit_cast(bf16x8, pw0), __builtin_bit_cast(bf16x8, pw1), __builtin_bit_cast(bf16x8, pw2), __builtin_bit_cast(bf16x8, pw3));
        }
        slot = slot == 2 ? 0 : slot + 1;
    }
    { auto rr = __builtin_amdgcn_permlane32_swap(__float_as_uint(l_reg), __float_as_uint(l_reg), false, false); l_reg = __uint_as_float(rr[0]) + __uint_as_float(rr[1]); }
    if (hi == 0) wsf[32 + r32] = l_reg;
    asm volatile("s_waitcnt lgkmcnt(0)" ::: "memory");
    float rli[16];
#pragma unroll
    for (int r = 0; r < 16; ++r) rli[r] = __builtin_amdgcn_rcpf(wsf[32 + crow(r, hi)]);
    if (DIL) { if (hi == 0) lse[ATT_GROW(q0 + wid * 32 + r32) * 8] = mhat + __builtin_amdgcn_logf(l_reg); }
    { bf16* stg = (bf16*)(shm + L::LOST) + wid * 2048;
#pragma unroll
      for (int r = 0; r < 16; ++r) { const int orow = crow(r, hi);
#pragma unroll
        for (int d0 = 0; d0 < 2; ++d0) stg[orow * 64 + d0 * 32 + r32] = (bf16)(cvtpk_s(o[d0][r] * rli[r], 0.f) & 0xffffu); }
      asm volatile("s_waitcnt lgkmcnt(0)" ::: "memory");
#pragma unroll
      for (int i = 0; i < 4; ++i) { const int row = i * 8 + (lane >> 3), ch = lane & 7; const u32x4 v = *(const u32x4*)(stg + row * 64 + ch * 8);
        *(u32x4*)(Ob + ATT_GROW(q0 + wid * 32 + row) * po + ch * 8) = v; } }
    asm volatile("s_waitcnt lgkmcnt(0)\n\ts_barrier" ::: "memory");
#undef ATT_GROW
#undef ATT_ISSUE
}
#undef ATT_SBAR
#undef ATT_WAIT_BAR
}
namespace mla {
using bf16 = unsigned short;
using bf16x8 = __attribute__((ext_vector_type(8))) short;
using s16x4 = __attribute__((ext_vector_type(4))) short;
using f32x16 = __attribute__((ext_vector_type(16))) float;
using u32x4 = __attribute__((ext_vector_type(4))) unsigned;
constexpr int SEQL = 8192, PQ = 1536, PV = 1024, HQ = 96, HV = 64;
constexpr int NW = 8, QBLK = 32, QB = QBLK * NW, KVBLK = 64;
__device__ __forceinline__ int crow(int r, int hi) { return (r & 3) + 8 * (r >> 2) + 4 * hi; }
#define SBAR() __builtin_amdgcn_sched_barrier(0)
__device__ __forceinline__ void cmask(f32x16& p0, f32x16& p1, int jb, int qrel, int hi) {
    const float NEG = -INFINITY; int kb = 64 * jb + 4 * hi;
#pragma unroll
    for (int r = 0; r < 16; ++r) { int kv = kb + (r & 3) + 8 * (r >> 2); if (kv > qrel) p0[r] = NEG; if (kv + 32 > qrel) p1[r] = NEG; }
}
constexpr int NSLOT = 3, KSLOTB = 12288, VSLOTB = 8192;
constexpr int LDS_K = 0, LDS_V = NSLOT * KSLOTB, LDS_WS = LDS_V + NSLOT * VSLOTB, LDS_OST = LDS_WS + NW * 64 * 4, LDS_BYTES = LDS_OST + NW * 4096;
static_assert(LDS_BYTES <= 131072, "mla attention LDS");
__device__ __forceinline__ void glds16(const void* gsrc, unsigned lds_dst) { unsigned keep;
    asm volatile("s_mov_b32 %0, m0\n\ts_mov_b32 m0, %2\n\ts_nop 0\n\tglobal_load_lds_dwordx4 %1, off\n\ts_mov_b32 m0, %0" : "=&s"(keep) : "v"(gsrc), "s"(lds_dst) : "memory"); }
__device__ __forceinline__ float max3f(float a, float b, float c) { float r; asm("v_max3_f32 %0, %1, %2, %3" : "=v"(r) : "v"(a), "v"(b), "v"(c)); return r; }
__device__ __forceinline__ float max2f(float a, float b) { float r; asm("v_max_f32_e32 %0, %1, %2" : "=v"(r) : "v"(a), "v"(b)); return r; }
__device__ __forceinline__ float fadd_s(float a, float b) { float r; asm("v_add_f32_e32 %0, %1, %2" : "=v"(r) : "v"(a), "v"(b)); return r; }
__device__ __forceinline__ float fsub_s(float a, float b) { float r; asm("v_sub_f32_e32 %0, %1, %2" : "=v"(r) : "v"(a), "v"(b)); return r; }
typedef float f32x2_t __attribute__((ext_vector_type(2))); typedef __bf16 bf16x2_t __attribute__((ext_vector_type(2)));
__device__ __forceinline__ unsigned cvtpk_s(float lo, float hi) { f32x2_t v = {lo, hi}; bf16x2_t b = __builtin_convertvector(v, bf16x2_t); return __builtin_bit_cast(unsigned, b); }
#define WAIT_BAR(N) asm volatile("s_waitcnt vmcnt(" #N ") lgkmcnt(0)\n\ts_barrier" ::: "memory")

__device__ __forceinline__ void qkt(f32x16& p0, f32x16& p1, const char* Kslot, const bf16x8* qr, const f32x16& negm, int r32, int hi) {
    const char* kb = Kslot + hi * 1024 + r32 * 16;
#pragma unroll
    for (int d0 = 0; d0 < 6; ++d0) {
        const bf16x8 b0 = *reinterpret_cast<const bf16x8*>(kb + d0 * 2048);
        const bf16x8 b1 = *reinterpret_cast<const bf16x8*>(kb + d0 * 2048 + 512);
        if (d0 == 0) { p0 = __builtin_amdgcn_mfma_f32_32x32x16_bf16(b0, qr[0], negm, 0, 0, 0); p1 = __builtin_amdgcn_mfma_f32_32x32x16_bf16(b1, qr[0], negm, 0, 0, 0); }
        else { p0 = __builtin_amdgcn_mfma_f32_32x32x16_bf16(b0, qr[d0], p0, 0, 0, 0); p1 = __builtin_amdgcn_mfma_f32_32x32x16_bf16(b1, qr[d0], p1, 0, 0, 0); } }
}
typedef __attribute__((address_space(3))) const char* lds_cptr;
typedef short v4i16_t __attribute__((ext_vector_type(4)));
__device__ __forceinline__ void kload12(bf16x8* kf, lds_cptr kp) {
#pragma unroll
    for (int j = 0; j < 6; ++j) { kf[2 * j] = *(const __attribute__((address_space(3))) bf16x8*)(kp + j * 2048); kf[2 * j + 1] = *(const __attribute__((address_space(3))) bf16x8*)(kp + j * 2048 + 512); }
}
__device__ __forceinline__ void kload2(bf16x8* kf, lds_cptr kp, int j) { kf[2 * j] = *(const __attribute__((address_space(3))) bf16x8*)(kp + j * 2048); kf[2 * j + 1] = *(const __attribute__((address_space(3))) bf16x8*)(kp + j * 2048 + 512); }
__device__ __forceinline__ s16x4 vtr(lds_cptr p) { return __builtin_bit_cast(s16x4, __builtin_amdgcn_ds_read_tr16_b64_v4i16((__attribute__((address_space(3))) v4i16_t*)p)); }
__device__ __forceinline__ float rowmax(const f32x16& p0, const f32x16& p1) {
    float a = max3f(p0[0], p0[1], p1[0]), b = max3f(p0[2], p0[3], p1[1]); a = max3f(a, p1[2], p1[3]);
#pragma unroll
    for (int r = 4; r < 16; r += 4) { a = max3f(a, p0[r], p0[r + 1]); b = max3f(b, p0[r + 2], p0[r + 3]); a = max3f(a, p1[r], p1[r + 1]); b = max3f(b, p1[r + 2], p1[r + 3]); }
    const float m = max2f(a, b);
    auto rr = __builtin_amdgcn_permlane32_swap(__float_as_uint(m), __float_as_uint(m), false, false);
    return max2f(__uint_as_float(rr[0]), __uint_as_float(rr[1]));
}
__device__ __forceinline__ void pv(f32x16* o, int vb, bf16x8 pa0, bf16x8 pa1, bf16x8 pa2, bf16x8 pa3) {
#pragma unroll
    for (int d0 = 0; d0 < 2; ++d0) { s16x4 lo[4], hi[4];
#pragma unroll
        for (int ks = 0; ks < 4; ++ks) {
            asm volatile("ds_read_b64_tr_b16 %0,%1 offset:%c2" : "=&v"(lo[ks]) : "v"(vb), "i"(d0 * 4096 + ks * 1024) : "memory");
            asm volatile("ds_read_b64_tr_b16 %0,%1 offset:%c2" : "=&v"(hi[ks]) : "v"(vb), "i"(d0 * 4096 + ks * 1024 + 512) : "memory"); }
        asm volatile("s_waitcnt lgkmcnt(0)" ::: "memory"); SBAR();
#define PK(k) (bf16x8){lo[k][0], lo[k][1], lo[k][2], lo[k][3], hi[k][0], hi[k][1], hi[k][2], hi[k][3]}
        o[d0] = __builtin_amdgcn_mfma_f32_32x32x16_bf16(pa0, PK(0), o[d0], 0, 0, 0);
        o[d0] = __builtin_amdgcn_mfma_f32_32x32x16_bf16(pa1, PK(1), o[d0], 0, 0, 0);
        o[d0] = __builtin_amdgcn_mfma_f32_32x32x16_bf16(pa2, PK(2), o[d0], 0, 0, 0);
        o[d0] = __builtin_amdgcn_mfma_f32_32x32x16_bf16(pa3, PK(3), o[d0], 0, 0, 0);
#undef PK
    }
}

template <int THRL> __device__ __forceinline__ void attn_unit(int b, int h, int qb, const bf16* Q, const bf16* __restrict__ K, const bf16* __restrict__ V, bf16* O, char* shm) {
    int tid_ = threadIdx.x; asm volatile("" : "+v"(tid_));
    const int tid = tid_, lane = tid & 63, r32 = lane & 31, hi = lane >> 5; const int wid = __builtin_amdgcn_readfirstlane(tid >> 6);
    const long rowbase = (long)b * SEQL; const int q0 = qb * QB;
    const bf16* Qw = Q + (rowbase + q0 + wid * QBLK) * PQ + h * HQ;
    const bf16* Kh = K + rowbase * PQ + h * HQ; const bf16* Vh = V + rowbase * PV + h * HV;
    const unsigned lds0 = (unsigned)(uintptr_t)shm;
    float* wsf = (float*)(shm + LDS_WS) + wid * 64;
    const bool k2 = wid < 4;
    const bf16* ksrc = Kh + (long)lane * PQ + wid * 8;
    const bf16* vsrc = Vh + (long)(16 * (wid & 3) + (lane >> 2)) * PV + (wid >> 2) * 32 + (lane & 3) * 8;
    const unsigned kdst = lds0 + LDS_K + wid * 1024, vdst = lds0 + LDS_V + wid * 1024;
#define DMA_K(t, slot) do { glds16(ksrc + (long)(t) * KVBLK * PQ, (unsigned)__builtin_amdgcn_readfirstlane(kdst + (slot))); \
        if (k2) glds16(ksrc + (long)(t) * KVBLK * PQ + 64, (unsigned)__builtin_amdgcn_readfirstlane(kdst + (slot) + 8192)); } while (0)
#define DMA_V(t, slot) glds16(vsrc + (long)(t) * KVBLK * PV, (unsigned)__builtin_amdgcn_readfirstlane(vdst + (slot)))
    const int vb0 = (int)(lds0 + LDS_V) + ((lane >> 4) & 1) * 32 + (lane & 3) * 8 + (4 * hi + ((lane & 15) >> 2)) * 64;
    const char* Kbase = shm + LDS_K; bf16x8 kf[12];
    const lds_cptr shm3 = (lds_cptr)shm; const lds_cptr kp0 = shm3 + LDS_K + hi * 1024 + r32 * 16; const lds_cptr vp0 = shm3 + LDS_V + ((lane >> 4) & 1) * 32 + (lane & 3) * 8 + (4 * hi + ((lane & 15) >> 2)) * 64;
    const int NT = (q0 + QB) / KVBLK;
#define WAIT_KV() do { if (k2) WAIT_BAR(3); else WAIT_BAR(2); } while (0)
#define WAIT_KKV() do { if (k2) WAIT_BAR(5); else WAIT_BAR(3); } while (0)
    DMA_K(0, 0); DMA_V(0, 0); DMA_K(1, KSLOTB);
    bf16x8 qr[6];
#pragma unroll
    for (int d0 = 0; d0 < 6; ++d0) qr[d0] = *reinterpret_cast<const bf16x8*>(&Qw[(long)r32 * PQ + d0 * 16 + hi * 8]);
    float mhat = 0.f, l_reg = 0.f; f32x16 o[2]; o[0] = f32x16{}; o[1] = f32x16{}; f32x16 negm = f32x16{}; asm volatile("" : "+v"(negm));
    const int qrel = wid * QBLK + r32;
#define CMASK(P0, P1, t) do { int jb_ = (t) - (NT - 4); if (jb_ >= 0) cmask(P0, P1, jb_, qrel, hi); } while (0)
    bool resc = false;
#define START(P0, P1) do { const float rm = rowmax(P0, P1); resc = false; \
    { const float dl = rm; mhat = fadd_s(mhat, dl); \
      _Pragma("unroll") for (int r = 0; r < 16; ++r) { P0[r] = fsub_s(P0[r], dl); P1[r] = fsub_s(P1[r], dl); } \
      _Pragma("unroll") for (int r = 0; r < 16; ++r) negm[r] = -mhat; asm volatile("" : "+v"(negm)); } \
    _Pragma("unroll") for (int r = 0; r < 16; ++r) P0[r] = __builtin_amdgcn_exp2f(P0[r]); } while (0)
#define RESC() do { if (resc) { asm volatile("s_waitcnt lgkmcnt(0)" ::: "memory"); \
      _Pragma("unroll") for (int d_ = 0; d_ < 2; ++d_) _Pragma("unroll") for (int r = 0; r < 16; ++r) o[d_][r] *= wsf[crow(r, hi)]; } } while (0)
    f32x16 pA0, pA1, pB0, pB1;
    int sl_prev = 0, sl_cur = 0, sl_next = 1;
#define ROT() do { sl_prev = sl_cur; sl_cur = sl_next; sl_next = (sl_next == NSLOT - 1) ? 0 : sl_next + 1; } while (0)
    DMA_K(2, 2 * KSLOTB);
    WAIT_KKV();
    qkt(pA0, pA1, Kbase, qr, negm, r32, hi); asm volatile("s_nop 15\n\ts_nop 7" : "+v"(pA0), "+v"(pA1)); CMASK(pA0, pA1, 0);
    START(pA0, pA1);
#pragma unroll
    for (int r = 0; r < 16; ++r) pA1[r] = __builtin_amdgcn_exp2f(pA1[r]);
    WAIT_BAR(0);
    DMA_K(3, 0); DMA_V(1, VSLOTB);
    ROT();
    kload12(kf, kp0 + sl_cur * KSLOTB);
    WAIT_KV();
    s16x4 vlo[8], vhi[8]; u32x4 pw0, pw1, pw2, pw3;
#define PKW(P, B) cvtpk_s(P[B], P[B + 1])
#define PAF(k) __builtin_bit_cast(bf16x8, pw##k)
#define VFR(i) (bf16x8){vlo[i][0], vlo[i][1], vlo[i][2], vlo[i][3], vhi[i][0], vhi[i][1], vhi[i][2], vhi[i][3]}
#define PIN(x) asm volatile("" : "+v"(x))
#define MX3(a, b, c) __builtin_fmaxf(__builtin_fmaxf((a), (b)), (c))
#define GAPA(MF, A0, A1, A2, A3, W0, W1, PW) do { MF; sacc += A0; sacc += A1; sacc += A2; sacc += A3; PIN(sacc); W0; W1; PIN(PW); SBAR(); } while (0)
#define GAPM(MF) do { MF; SBAR(); } while (0)
#define EX(v) __builtin_amdgcn_exp2f(v)
#define GAPB(MF, X, B) do { MF; X[B] = EX(X[B]); X[B + 1] = EX(X[B + 1]); X[B + 2] = EX(X[B + 2]); X[B + 3] = EX(X[B + 3]); PIN(X); SBAR(); } while (0)
#define VRD(i) do { vlo[i] = vtr(vp_ + (((i) >> 2) * 4096 + ((i) & 3) * 1024)); vhi[i] = vtr(vp_ + (((i) >> 2) * 4096 + ((i) & 3) * 1024 + 512)); } while (0)
#define KRD(G, j) do { if (G) { kload2(kf, kp0 + sl_next * KSLOTB, j); SBAR(); } } while (0)
#define MF32(a, b, c) __builtin_amdgcn_mfma_f32_32x32x16_bf16(a, b, c, 0, 0, 0)
#define STEP(C0, C1, P0, P1, t, GK, GV, GL) do { SBAR(); \
    const lds_cptr vp_ = vp0 + sl_prev * VSLOTB; \
    float sacc = (P0[0] + P0[1]); \
    GAPA(C0 = MF32(kf[0], qr[0], negm), P0[2], P0[3], P0[4], P0[5],     pw0[0] = PKW(P0, 0), pw0[1] = PKW(P0, 2), pw0); \
    GAPA(C1 = MF32(kf[1], qr[0], negm), P0[6], P0[7], P0[8], P0[9],     pw0[2] = PKW(P0, 4), pw0[3] = PKW(P0, 6), pw0); \
    GAPA(C0 = MF32(kf[2], qr[1], C0),   P0[10], P0[11], P0[12], P0[13], pw1[0] = PKW(P0, 8), pw1[1] = PKW(P0, 10), pw1); \
    GAPA(C1 = MF32(kf[3], qr[1], C1),   P0[14], P0[15], P1[0], P1[1],   pw1[2] = PKW(P0, 12), pw1[3] = PKW(P0, 14), pw1); \
    VRD(0); SBAR(); GAPA(C0 = MF32(kf[4], qr[2], C0),   P1[2], P1[3], P1[4], P1[5],     pw2[0] = PKW(P1, 0), pw2[1] = PKW(P1, 2), pw2); \
    VRD(4); SBAR(); GAPA(C1 = MF32(kf[5], qr[2], C1),   P1[6], P1[7], P1[8], P1[9],     pw2[2] = PKW(P1, 4), pw2[3] = PKW(P1, 6), pw2); \
    VRD(1); SBAR(); GAPA(C0 = MF32(kf[6], qr[3], C0),   P1[10], P1[11], P1[12], P1[13], pw3[0] = PKW(P1, 8), pw3[1] = PKW(P1, 10), pw3); \
    VRD(5); SBAR(); GAPA(C1 = MF32(kf[7], qr[3], C1),   P1[14], P1[15], 0.f, 0.f,       pw3[2] = PKW(P1, 12), pw3[3] = PKW(P1, 14), pw3); \
    VRD(2); SBAR(); GAPM(C0 = MF32(kf[8], qr[4], C0)); VRD(6); SBAR(); GAPM(C1 = MF32(kf[9], qr[4], C1)); \
    VRD(3); SBAR(); GAPM(C0 = MF32(kf[10], qr[5], C0)); VRD(7); SBAR(); GAPM(C1 = MF32(kf[11], qr[5], C1)); \
    l_reg += sacc; \
    if (GK) { DMA_K((t) + 3, sl_cur * KSLOTB); } if (GV) { DMA_V((t) + 1, sl_next * VSLOTB); } \
    CMASK(C0, C1, t); \
    { float a = MX3(C0[0], C0[1], C1[0]), b = MX3(C0[2], C0[3], C1[1]); a = MX3(a, C1[2], C1[3]); \
      _Pragma("unroll") for (int r = 4; r < 16; r += 4) { a = MX3(a, C0[r], C0[r + 1]); b = MX3(b, C0[r + 2], C0[r + 3]); a = MX3(a, C1[r], C1[r + 1]); b = MX3(b, C1[r + 2], C1[r + 3]); } \
      float rm = __builtin_fmaxf(a, b); { auto rr = __builtin_amdgcn_permlane32_swap(__float_as_uint(rm), __float_as_uint(rm), false, false); rm = __builtin_fmaxf(__uint_as_float(rr[0]), __uint_as_float(rr[1])); } \
      resc = false; \
      if (__builtin_expect(__any(rm > (float)THRL), 0)) { const float dl = __builtin_fmaxf(rm, 0.f); mhat += dl; \
        _Pragma("unroll") for (int r = 0; r < 16; ++r) { C0[r] -= dl; C1[r] -= dl; } \
        _Pragma("unroll") for (int r = 0; r < 16; ++r) negm[r] = -mhat; asm volatile("" : "+v"(negm)); \
        const float f = __builtin_amdgcn_exp2f(-dl); l_reg *= f; if (hi == 0) wsf[r32] = f; resc = true; } } \
    SBAR(); \
    GAPB(o[0] = MF32(PAF(0), VFR(0), o[0]), C0, 0); \
    KRD(GL, 0); GAPB(o[1] = MF32(PAF(0), VFR(4), o[1]), C0, 4); \
    KRD(GL, 1); GAPB(o[0] = MF32(PAF(1), VFR(1), o[0]), C0, 8); \
    KRD(GL, 2); GAPB(o[1] = MF32(PAF(1), VFR(5), o[1]), C0, 12); \
    KRD(GL, 3); GAPB(o[0] = MF32(PAF(2), VFR(2), o[0]), C1, 0); \
    KRD(GL, 4); GAPB(o[1] = MF32(PAF(2), VFR(6), o[1]), C1, 4); \
    KRD(GL, 5); GAPB(o[0] = MF32(PAF(3), VFR(3), o[0]), C1, 8); \
    GAPB(o[1] = MF32(PAF(3), VFR(7), o[1]), C1, 12); \
    } while (0)
    int t = 1;
#undef CMASK
#define CMASK(P0, P1, t) do { } while (0)
    for (; t + 5 < NT; t += 2) {
        STEP(pB0, pB1, pA0, pA1, t, true, true, true);     WAIT_KV(); RESC(); ROT();
        STEP(pA0, pA1, pB0, pB1, t + 1, true, true, true); WAIT_KV(); RESC(); ROT();
    }
#undef CMASK
#define CMASK(P0, P1, t) do { int jb_ = (t) - (NT - 4); if (jb_ >= 0) cmask(P0, P1, jb_, qrel, hi); } while (0)
#define ENDW(tt) do { if ((tt) + 3 < NT) { WAIT_KV(); } else if ((tt) + 2 < NT) { WAIT_BAR(1); } else { WAIT_BAR(0); } } while (0)
    for (; t + 1 < NT; t += 2) {
        STEP(pB0, pB1, pA0, pA1, t, (t + 3 < NT), (t + 1 < NT), (t + 1 < NT));         ENDW(t);     RESC(); ROT();
        STEP(pA0, pA1, pB0, pB1, t + 1, (t + 4 < NT), (t + 2 < NT), (t + 2 < NT));     ENDW(t + 1); RESC(); ROT();
    }
    STEP(pB0, pB1, pA0, pA1, NT - 1, false, false, false); RESC();
    { float sacc = pB0[0] + pB0[1];
#pragma unroll
      for (int r = 2; r < 16; ++r) sacc += pB0[r];
#pragma unroll
      for (int r = 0; r < 16; ++r) sacc += pB1[r];
      l_reg += sacc;
      pw0 = (u32x4){PKW(pB0, 0), PKW(pB0, 2), PKW(pB0, 4), PKW(pB0, 6)}; pw1 = (u32x4){PKW(pB0, 8), PKW(pB0, 10), PKW(pB0, 12), PKW(pB0, 14)}; pw2 = (u32x4){PKW(pB1, 0), PKW(pB1, 2), PKW(pB1, 4), PKW(pB1, 6)}; pw3 = (u32x4){PKW(pB1, 8), PKW(pB1, 10), PKW(pB1, 12), PKW(pB1, 14)};
      SBAR(); pv(o, vb0 + sl_cur * VSLOTB, PAF(0), PAF(1), PAF(2), PAF(3)); }
#undef PKW
#undef PAF
#undef VFR
#undef PIN
#undef MX3
#undef GAPA
#undef GAPM
#undef GAPB
#undef EX
#undef VRD
#undef KRD
#undef MF32
#undef STEP
#undef ENDW
    { auto rr = __builtin_amdgcn_permlane32_swap(__float_as_uint(l_reg), __float_as_uint(l_reg), false, false); l_reg = __uint_as_float(rr[0]) + __uint_as_float(rr[1]); }
    if (hi == 0) wsf[32 + r32] = l_reg; asm volatile("s_waitcnt lgkmcnt(0)" ::: "memory");
    float rli[16];
#pragma unroll
    for (int r = 0; r < 16; ++r) rli[r] = __builtin_amdgcn_rcpf(wsf[32 + crow(r, hi)]);
    bf16* Ow = O + (rowbase + q0 + wid * QBLK) * PV + h * HV;
    { bf16* stg = (bf16*)(shm + LDS_OST) + wid * 2048;
#pragma unroll
      for (int r = 0; r < 16; ++r) { const int orow = crow(r, hi);
#pragma unroll
        for (int d0 = 0; d0 < 2; ++d0) stg[orow * 64 + d0 * 32 + r32] = (bf16)(cvtpk_s(o[d0][r] * rli[r], 0.f) & 0xffffu); }
      asm volatile("s_waitcnt lgkmcnt(0)" ::: "memory");
#pragma unroll
      for (int i = 0; i < 4; ++i) { const int row = i * 8 + (lane >> 3), ch = lane & 7; const u32x4 v = *(const u32x4*)(stg + row * 64 + ch * 8); *(u32x4*)(Ow + (long)row * PV + ch * 8) = v; } }
    asm volatile("s_waitcnt lgkmcnt(0)\n\ts_barrier" ::: "memory");
#undef DMA_K
#undef DMA_V
#undef CMASK
#undef START
#undef RESC
#undef ROT
#undef WAIT_KV
#undef WAIT_KKV
}
#undef SBAR
#undef WAIT_BAR
}
namespace dila {
using bf16 = unsigned short;
using bf16x8 = __attribute__((ext_vector_type(8))) short;
using f32x16 = __attribute__((ext_vector_type(16))) float;
using u32x4 = __attribute__((ext_vector_type(4))) unsigned;
constexpr int NW = 8, SEQL = 8192, PQ = 1536, PKV = 3072, PO = 512, MROWS = 4 * SEQL;
constexpr int L_K = 0, L_V = 6 * 8192, L_WQ = 12 * 8192, L_WO = L_WQ + NW * 4096, L_WSF = L_WO + NW * 2048, L_BIAS = L_WSF + NW * 256, L_END = L_BIAS + 3 * 288 * 4;
constexpr float THR = 8.0f;
#define DIL_WAIT_BAR(N) asm volatile("s_waitcnt vmcnt(" #N ") lgkmcnt(0)\n\ts_barrier" ::: "memory")
struct UnitP { int sb, oo, lo, rowbase, dil, q0, g; };
__device__ __forceinline__ UnitP decode(int j, int h) {
    const int x = j & 31, bg = j >> 5; const int g = bg % 3, b = bg / 3;
    const int sh = 2 * g, dil = 1 << sh; const int r = x & (dil - 1), qb = x >> sh;
    UnitP p; p.sb = g * 262144 + ((b * dil + r) * 8 + h) * (SEQL >> sh); p.oo = g * MROWS * PO + h * 64; p.lo = g * MROWS * 8 + h;
    p.rowbase = b * SEQL + r; p.dil = dil; p.q0 = qb * 256; p.g = g; return p;
}

__device__ __forceinline__ void dil_phase(const bf16* QB, const bf16* KV, bf16* OG, float* LSE, const float* BT, char* shm, int G) {
    int tid_ = threadIdx.x; asm volatile("" : "+v"(tid_));
    const int tid = tid_, lane = tid & 63, r32 = lane & 31, hi = lane >> 5; const int wid = __builtin_amdgcn_readfirstlane(tid >> 6);
    const unsigned lds0 = (unsigned)(uintptr_t)shm;
    float* wsf = (float*)(shm + L_WSF) + wid * 64;
    char* wq = shm + L_WQ + wid * 4096;
    char* wo = shm + L_WO + wid * 2048;
    const int wt0 = wid >> 1, wt1 = 2 + (wid >> 1);
    const int G8 = G & ~7, c = (int)blockIdx.x;
    if (c >= G8) return;
    const int h = c & 7, j0 = c >> 3, jstep = G8 >> 3;
    const int NU = (384 - j0 + jstep - 1) / jstep;
    for (int i = tid; i < 3 * 288; i += NW * 64) ((float*)(shm + L_BIAS))[i] = BT[((i / 288) * 8 + h) * 288 + (i % 288)];
#define DIL_GROW(P, pos) ((long)((P).rowbase + (pos) * (P).dil))
#define DIL_ISSUE_TILE(P, t) do { int kp_ = (P).q0 - 128 + 64 * (t); if (kp_ < 0) kp_ = 0; \
        att::glds16(KV + (size_t)((P).sb + kp_ + lane) * 128 + wid * 8, (unsigned)__builtin_amdgcn_readfirstlane(lds0 + L_K + (t) * 8192 + wid * 1024)); \
        att::glds16(KV + (size_t)((P).sb + kp_ + 16 * (wid & 3) + (lane >> 2)) * 128 + 64 + (wid >> 2) * 32 + (lane & 3) * 8, (unsigned)__builtin_amdgcn_readfirstlane(lds0 + L_V + (t) * 8192 + wid * 1024)); } while (0)
#define DIL_ISSUE_Q(P) do { _Pragma("unroll") for (int j_ = 0; j_ < 4; ++j_) \
        att::glds16(QB + (size_t)((P).sb + (P).q0 + wid * 32 + 8 * j_ + (lane >> 3)) * 64 + (lane & 7) * 8, (unsigned)__builtin_amdgcn_readfirstlane(lds0 + L_WQ + wid * 4096 + j_ * 1024)); } while (0)
    if (NU <= 0) return;
    UnitP cur = decode(j0, h), nxt = cur;
    asm volatile("s_waitcnt vmcnt(0) lgkmcnt(0)\n\ts_barrier" ::: "memory");
    DIL_ISSUE_Q(cur); DIL_ISSUE_TILE(cur, 0); DIL_ISSUE_TILE(cur, 5); DIL_ISSUE_TILE(cur, 1); DIL_ISSUE_TILE(cur, 4);
    bf16x8 qr[4]; float mhat = 0.f, l_reg = 0.f; f32x16 o[2]; o[0] = f32x16{}; o[1] = f32x16{}; f32x16 negm = f32x16{}; bool first = true;
    const int vbl = (int)(lds0 + L_V) + ((lane >> 4) & 1) * 32 + (lane & 3) * 8 + (4 * hi + ((lane & 15) >> 2)) * 64;
    for (int ui = 0; ui < NU; ++ui) {
        const bool has_next = ui + 1 < NU;
        if (has_next) nxt = decode(j0 + (ui + 1) * jstep, h);
        const int tb = cur.q0 == 0 ? 2 : 0;
        const float* bl0 = (const float*)(shm + L_BIAS) + cur.g * 288 + (191 - (128 + 32 * (wid & 1) + r32 - 4 * hi));
#pragma unroll 1
        for (int k = 0; k < 3; ++k) {
            if (k < 2) DIL_WAIT_BAR(0); else DIL_WAIT_BAR(8);
            if (k == 0) { DIL_ISSUE_TILE(cur, 2); DIL_ISSUE_TILE(cur, 3); }
            else if (has_next) { if (k == 1) { DIL_ISSUE_Q(nxt); DIL_ISSUE_TILE(nxt, 0); DIL_ISSUE_TILE(nxt, 5); } else { DIL_ISSUE_TILE(nxt, 1); DIL_ISSUE_TILE(nxt, 4); } }
            const int t = wid < 4 ? wt0 + k : wt1 - k;
            if (k == 0) {
#pragma unroll
                for (int d0 = 0; d0 < 4; ++d0) qr[d0] = *reinterpret_cast<const bf16x8*>(wq + r32 * 128 + d0 * 32 + hi * 16);
                mhat = 0.f; l_reg = 0.f; o[0] = f32x16{}; o[1] = f32x16{}; negm = f32x16{}; first = true;
            }
            if (t >= tb) {
                f32x16 p0, p1;
                { const char* kb = shm + L_K + t * 8192 + hi * 1024 + r32 * 16;
#pragma unroll
                  for (int d0 = 0; d0 < 4; ++d0) {
                    const bf16x8 b0 = *reinterpret_cast<const bf16x8*>(kb + d0 * 2048);
                    const bf16x8 b1 = *reinterpret_cast<const bf16x8*>(kb + d0 * 2048 + 512);
                    if (d0 == 0) { p0 = __builtin_amdgcn_mfma_f32_32x32x16_bf16(b0, qr[0], negm, 0, 0, 0); p1 = __builtin_amdgcn_mfma_f32_32x32x16_bf16(b1, qr[0], negm, 0, 0, 0); }
                    else { p0 = __builtin_amdgcn_mfma_f32_32x32x16_bf16(b0, qr[d0], p0, 0, 0, 0); p1 = __builtin_amdgcn_mfma_f32_32x32x16_bf16(b1, qr[d0], p1, 0, 0, 0); } } }
                { const float* bl = bl0 + 64 * (t - wt0);
                  float bv0[16], bv1[16];
#pragma unroll
                  for (int r = 0; r < 16; ++r) { bv0[r] = bl[(r & 3) + 8 * (r >> 2)]; bv1[r] = bl[(r & 3) + 8 * (r >> 2) + 32]; }
#pragma unroll
                  for (int r = 0; r < 16; ++r) { p0[r] += bv0[r]; p1[r] += bv1[r]; } }
                const float rm = att::rowmax32(p0, p1);
                if (first) { first = false; const float dl = rm; mhat += dl;
#pragma unroll
                    for (int r = 0; r < 16; ++r) { p0[r] -= dl; p1[r] -= dl; }
#pragma unroll
                    for (int r = 0; r < 16; ++r) negm[r] = -mhat;
                } else if (__any(rm > THR)) { const float dl = __builtin_fmaxf(rm, 0.f); mhat += dl;
#pragma unroll
                    for (int r = 0; r < 16; ++r) { p0[r] -= dl; p1[r] -= dl; }
#pragma unroll
                    for (int r = 0; r < 16; ++r) negm[r] = -mhat;
                    const float f = __builtin_amdgcn_exp2f(-dl); l_reg *= f; if (hi == 0) wsf[r32] = f;
                    asm volatile("s_waitcnt lgkmcnt(0)" ::: "memory");
#pragma unroll
                    for (int d_ = 0; d_ < 2; ++d_)
#pragma unroll
                        for (int r = 0; r < 16; ++r) o[d_][r] *= wsf[att::crow(r, hi)];
                    asm volatile("s_waitcnt lgkmcnt(0)" ::: "memory");
                }
                float sacc = 0.f;
#pragma unroll
                for (int r = 0; r < 16; ++r) { p0[r] = __builtin_amdgcn_exp2f(p0[r]); p1[r] = __builtin_amdgcn_exp2f(p1[r]); sacc += p0[r] + p1[r]; }
                l_reg += sacc;
                u32x4 pw0, pw1, pw2, pw3;
#define DIL_PKW(P, B) att::cvtpk_s(P[B], P[B + 1])
                pw0 = (u32x4){DIL_PKW(p0, 0), DIL_PKW(p0, 2), DIL_PKW(p0, 4), DIL_PKW(p0, 6)}; pw1 = (u32x4){DIL_PKW(p0, 8), DIL_PKW(p0, 10), DIL_PKW(p0, 12), DIL_PKW(p0, 14)};
                pw2 = (u32x4){DIL_PKW(p1, 0), DIL_PKW(p1, 2), DIL_PKW(p1, 4), DIL_PKW(p1, 6)}; pw3 = (u32x4){DIL_PKW(p1, 8), DIL_PKW(p1, 10), DIL_PKW(p1, 12), DIL_PKW(p1, 14)};
#undef DIL_PKW
                __builtin_amdgcn_sched_barrier(0);
                att::pv(o, vbl + t * 8192, __builtin_bit_cast(bf16x8, pw0), __builtin_bit_cast(bf16x8, pw1), __builtin_bit_cast(bf16x8, pw2), __builtin_bit_cast(bf16x8, pw3));
            }
            if (k == 2) {
                { auto rr = __builtin_amdgcn_permlane32_swap(__float_as_uint(l_reg), __float_as_uint(l_reg), false, false); l_reg = __uint_as_float(rr[0]) + __uint_as_float(rr[1]); }
                if (hi == 0) wsf[32 + r32] = l_reg;
                asm volatile("s_waitcnt lgkmcnt(0)" ::: "memory");
                float rli[16];
#pragma unroll
                for (int r = 0; r < 16; ++r) rli[r] = __builtin_amdgcn_rcpf(wsf[32 + att::crow(r, hi)]);
                if (hi == 0) LSE[cur.lo + DIL_GROW(cur, cur.q0 + wid * 32 + r32) * 8] = mhat + __builtin_amdgcn_logf(l_reg);
                bf16* stg = (bf16*)wo;
#pragma unroll
                for (int d0 = 0; d0 < 2; ++d0) {
#pragma unroll
                    for (int r = 0; r < 16; ++r) stg[att::crow(r, hi) * 32 + r32] = (bf16)(att::cvtpk_s(o[d0][r] * rli[r], 0.f) & 0xffffu);
                    asm volatile("s_waitcnt lgkmcnt(0)" ::: "memory");
#pragma unroll
                    for (int i = 0; i < 2; ++i) { const int row = i * 16 + (lane >> 2), ch = lane & 3; const u32x4 v = *(const u32x4*)(stg + row * 32 + ch * 8);
                        *(u32x4*)(OG + cur.oo + DIL_GROW(cur, cur.q0 + wid * 32 + row) * PO + d0 * 32 + ch * 8) = v; }
                    asm volatile("s_waitcnt lgkmcnt(0)" ::: "memory"); }
            }
        }
        cur = nxt;
    }
    asm volatile("s_waitcnt vmcnt(0) lgkmcnt(0)\n\ts_barrier" ::: "memory");
#undef DIL_GROW
#undef DIL_ISSUE_TILE
#undef DIL_ISSUE_Q
}
#undef DIL_WAIT_BAR
}
constexpr int NWAVES = 8;
constexpr int BATCH = 4, SEQ = 8192, D = 1024, M = BATCH * SEQ;
constexpr int MLA_H = 16, QRANK = 384, KVRANK = 256, LATN = 672, LATP = 768, QUP = 1536, KVUP = 2048;
constexpr int DFF = 2816, NEXP = 8, DILQ = 1536, DILKV = 3072, DILOUT = 512;
constexpr int MAXSLOT = 67584;
constexpr float EPS = 1e-6f;
constexpr float C2_MLA = 0.1472444460259031f;
constexpr float C2_DIL = 0.18033688011112042f;
constexpr float LOG2E_F = 1.4426950408889634f;

constexpr size_t MiB = 1u << 20;
constexpr size_t WS_CTL = 0, CTL_ZERO_BYTES = 64 * 1024;
constexpr size_t WS_MODV = 1 * MiB;
constexpr size_t WS_BIAS = 1 * MiB + 256 * 1024;
constexpr size_t WS_ROUTE = 1 * MiB + 512 * 1024;
constexpr size_t WS_CNT = 2 * MiB;
constexpr size_t WS_LIST = 2 * MiB + 256 * 1024;
constexpr size_t WS_SLOTG = 2 * MiB + 768 * 1024;
constexpr size_t WS_TOKSLOT = 3 * MiB + 256 * 1024;
constexpr size_t WS_TILEEXP = 3 * MiB + 768 * 1024;
constexpr size_t WS_CS = 4 * MiB;
constexpr size_t WS_LSE = 8 * MiB;
constexpr size_t WS_SB = 11 * MiB;
constexpr size_t SB_LAT = 0, SB_FGU = 768, SB_KVB = 768 + 5632, SB_QB = SB_KVB + 3072, SB_EGU = SB_QB + 1536, SB_END = SB_EGU + 8 * 5632;
constexpr size_t WS_XS = 11 * MiB + 256 * 1024, WS_XSKV = 11 * MiB + 512 * 1024;
constexpr size_t WS_WEGU = 12 * MiB, WS_WEDN = 100 * MiB, WS_WFGU = 144 * MiB, WS_WFDN = 155 * MiB, WS_WKVB = 161 * MiB, WS_WQB = 167 * MiB, WS_WOUT = 170 * MiB,
                 WS_WOB = 172 * MiB, WS_WMLAIN = 173 * MiB, WS_WQUP = 175 * MiB, WS_WKVUP = 177 * MiB;
constexpr size_t WS_ARENA = 180 * MiB;
constexpr size_t A_XN = WS_ARENA, A_LAT = WS_ARENA + 64 * MiB, A_QN = WS_ARENA + 112 * MiB, A_KVN = WS_ARENA + 136 * MiB, A_Q = WS_ARENA + 152 * MiB, A_K = WS_ARENA + 248 * MiB,
                 A_V = WS_ARENA + 344 * MiB, A_O = WS_ARENA + 408 * MiB, A_HID = WS_ARENA + 64 * MiB, A_XNKV = WS_ARENA + 64 * MiB, A_KVB = WS_ARENA + 128 * MiB, A_QB = WS_ARENA + 320 * MiB,
                 A_OG = WS_ARENA, A_OD = WS_ARENA + 128 * MiB, A_HIDS = WS_ARENA + 160 * MiB, A_Y = WS_ARENA;
constexpr size_t WS_END = WS_ARENA + 523 * MiB;
static_assert(A_HIDS + (size_t)MAXSLOT * DFF * 2 <= WS_END && A_Y + (size_t)MAXSLOT * D * 2 <= A_HIDS && A_O + (size_t)M * D * 2 <= WS_END, "arena map");
static_assert(WS_WEGU + (size_t)NEXP * 2 * DFF * D * 2 <= WS_WEDN && WS_WEDN + (size_t)NEXP * D * DFF * 2 <= WS_WFGU && WS_WFGU + (size_t)2 * DFF * D * 2 <= WS_WFDN && WS_WFDN + (size_t)D * DFF * 2 <= WS_WKVB, "weight map");
enum ModKind { MK_A_MIX0 = 0, MK_B_MIX0, MK_G_MIX0, MK_A_FFN0, MK_B_FFN0, MK_G_FFN0, MK_A_MIX1, MK_B_MIX1, MK_G_MIX1, MK_A_FFN1, MK_B_FFN1, MK_G_FFN1, MK_A_KV, MK_B_KV };
constexpr int CW_BAR = 4096;
constexpr int CW_RANK = 8192;

constexpr int RING_BYTES = 131072;
constexpr int LDS_BYTES = 163840;
constexpr int LDSCTL_OFF = LDS_BYTES - 1024, MISC_OFF = LDSCTL_OFF + 320;

#define GAS __attribute__((address_space(1)))
#define LAS __attribute__((address_space(3)))
typedef unsigned short bf16;
typedef signed char i8;
typedef unsigned v4u __attribute__((ext_vector_type(4)));
typedef unsigned v2u __attribute__((ext_vector_type(2)));
typedef float f32x4 __attribute__((ext_vector_type(4)));
typedef GAS unsigned gu32;
#define RLX_AGENT __ATOMIC_RELAXED, __HIP_MEMORY_SCOPE_AGENT
#define LDS_WAIT() asm volatile("s_waitcnt lgkmcnt(0)" ::: "memory")
#define VM_WAIT() asm volatile("s_waitcnt vmcnt(0)" ::: "memory")
__device__ __forceinline__ unsigned f2bf(float f) { unsigned u = __builtin_bit_cast(unsigned, f); return (u + 0x7fffu + ((u >> 16) & 1u)) >> 16; }
__device__ __forceinline__ unsigned pk2(float lo, float hi) { return f2bf(lo) | (f2bf(hi) << 16); }
__device__ __forceinline__ float bf_lo(unsigned w) { return __builtin_bit_cast(float, w << 16); }
__device__ __forceinline__ float bf_hi(unsigned w) { return __builtin_bit_cast(float, w & 0xffff0000u); }
__device__ __forceinline__ float wave_sum(float v) {
#pragma unroll
    for (int o = 1; o < 64; o <<= 1) v += __shfl_xor(v, o);
    return v;
}

#define XB_TMO      128
#define XB_XCNT(j)  (256  + 64 * (j))
#define XB_XSUB(j)  (1280 + 64 * (j))
#define XB_XGEN(j)  (2304 + 64 * (j))
#define XB_TOP      3328
#define XB_TOPGEN   3392
#define XCD_BAR_WORDS 3456
#define XB_SPIN_CAP (1u << 18)
__device__ __forceinline__ unsigned xb_ld(unsigned* p)              { return __hip_atomic_load(p, __ATOMIC_RELAXED, __HIP_MEMORY_SCOPE_AGENT); }
__device__ __forceinline__ unsigned xb_add(unsigned* p, unsigned v) { return __hip_atomic_fetch_add(p, v, __ATOMIC_RELAXED, __HIP_MEMORY_SCOPE_AGENT); }
__device__ __forceinline__ unsigned xb_xcc_id() { return (unsigned)__builtin_amdgcn_s_getreg((3 << 11) | 20) & 0xFu; }
#define XB_SPIN(cond, bar) do { unsigned _sp = 0; while (cond) { __builtin_amdgcn_s_sleep(1); \
    if ((++_sp & 255u) == 0u) { if (xb_ld(&(bar)[XB_TMO])) break; if (_sp > XB_SPIN_CAP) { atomicAdd(&(bar)[XB_TMO], 1u); break; } } } } while (0)
struct XcdBarrier { unsigned* bar; unsigned x; volatile LAS unsigned* st; };
__device__ __forceinline__ XcdBarrier xcd_barrier_post(unsigned* bar, volatile LAS unsigned* st) {
    XcdBarrier b; b.bar = bar; b.x = xb_xcc_id(); b.st = st;
    if (threadIdx.x == 0) (void)xb_add(&bar[XB_XCNT(b.x)], 1u);
    return b;
}
__device__ __forceinline__ void xcd_barrier_complete(unsigned* bar, unsigned x, unsigned& nloc, unsigned& nx) {
    const unsigned G = gridDim.x * gridDim.y * gridDim.z;
    unsigned sum, cnt, mine, sp = 0u;
    for (;;) {
        sum = 0u; cnt = 0u; mine = 0u;
#pragma unroll
        for (unsigned j = 0; j < 16; ++j) { const unsigned c = xb_ld(&bar[XB_XCNT(j)]); sum += c; cnt += (c > 0u) ? 1u : 0u; mine = (j == x) ? c : mine; }
        if (sum == G) break;
        __builtin_amdgcn_s_sleep(1);
        if ((++sp & 255u) == 0u) { if (xb_ld(&bar[XB_TMO])) break; if (sp > XB_SPIN_CAP) { atomicAdd(&bar[XB_TMO], 1u); break; } }
    }
    nloc = mine > 0u ? mine : 1u; nx = cnt > 0u ? cnt : 1u;
}
__device__ __forceinline__ void xcd_barrier(const XcdBarrier& b) {
    asm volatile("s_waitcnt vmcnt(0)" ::: "memory");
    __syncthreads();
    if (threadIdx.x == 0) {
        unsigned* bar = b.bar;
        __builtin_amdgcn_s_waitcnt(0);
        unsigned nloc = b.st[0], nx = b.st[1];
        if (nloc == 0u) { xcd_barrier_complete(bar, b.x, nloc, nx); b.st[0] = nloc; b.st[1] = nx; }
        const unsigned old = xb_add(&bar[XB_XSUB(b.x)], 1u);
        const unsigned gen = old / nloc;
        if (old + 1u == (gen + 1u) * nloc) {
            __builtin_amdgcn_fence(__ATOMIC_RELEASE, "agent");
            asm volatile("s_waitcnt vmcnt(0)" ::: "memory");
            const unsigned og = xb_add(&bar[XB_TOP], 1u);
            const unsigned tg = og / nx;
            if (og + 1u == (tg + 1u) * nx) xb_add(&bar[XB_TOPGEN], 1u);
            else XB_SPIN(xb_ld(&bar[XB_TOPGEN]) == tg, bar);
            __builtin_amdgcn_fence(__ATOMIC_ACQUIRE, "agent");
            xb_add(&bar[XB_XGEN(b.x)], 1u);
            asm volatile("s_waitcnt vmcnt(0)" ::: "memory");
        } else {
            XB_SPIN(xb_ld(&bar[XB_XGEN(b.x)]) == gen, bar);
            __builtin_amdgcn_fence(__ATOMIC_ACQUIRE, "agent");
            asm volatile("s_waitcnt vmcnt(0)" ::: "memory");
        }
    }
    __syncthreads();
}

struct Frame {
    LAS unsigned char* lds;
    volatile LAS unsigned* MISC;
    int tid, lane, wave;
    int vcu, G;
    unsigned char* ws;
    const float* in[26];
    float* out;
};
enum { MAP_PLAIN = 0, MAP_MLAIN = 1, MAP_QUP = 2, MAP_GU = 3 };
template <int MAP> __device__ __forceinline__ int dmap(int n) {
    if (MAP == MAP_MLAIN) { if (n < 640) return n; if (n < 656) return 640 + 2 * (n - 640); return 640 + 2 * (n - 656) + 1; }
    if (MAP == MAP_QUP) { const int h = n / 96, j = n % 96; if (j < 64) return n; if (j < 80) return h * 96 + 64 + 2 * (j - 64); return h * 96 + 64 + 2 * (j - 80) + 1; }
    if (MAP == MAP_GU) { const int up = n >= DFF ? 1 : 0; const int c = up ? n - DFF : n; return (c >> 7) * 256 + up * 128 + (c & 127); }
    return n;
}
template <int MAP> __device__ __forceinline__ void transpose_item(const float* W, int K, int N, bf16* WT, const float* ks, LAS float* scr, int item, int lane) {
    const int nblk = N / 32, kb = item / nblk, nb = item % nblk, k0 = 64 * kb, n0 = 32 * nb;
    float v[32];
    const float* src = W + (size_t)(k0 + (lane >> 5)) * N + n0 + (lane & 31);
#pragma unroll
    for (int i = 0; i < 32; ++i) v[i] = __builtin_nontemporal_load(src + (size_t)(2 * i) * N);
    if (ks) {
#pragma unroll
        for (int i = 0; i < 32; ++i) v[i] *= ks[k0 + 2 * i + (lane >> 5)]; }
#pragma unroll
    for (int i = 0; i < 32; ++i) scr[(2 * i + (lane >> 5)) * 33 + (lane & 31)] = v[i];
    LDS_WAIT(); asm volatile("" ::: "memory");
    const int c = lane & 7;
#pragma unroll
    for (int j = 0; j < 4; ++j) { const int n = (lane >> 3) + 8 * j; const LAS float* s = scr + (8 * c) * 33 + n;
        v4u o; o.x = pk2(s[0 * 33], s[1 * 33]); o.y = pk2(s[2 * 33], s[3 * 33]); o.z = pk2(s[4 * 33], s[5 * 33]); o.w = pk2(s[6 * 33], s[7 * 33]);
        *(GAS v4u*)(WT + (size_t)dmap<MAP>(n0 + n) * K + k0 + 8 * c) = o; }
    LDS_WAIT(); asm volatile("" ::: "memory");
}
__device__ __forceinline__ float wave_max(float v) {
#pragma unroll
    for (int o = 1; o < 64; o <<= 1) v = fmaxf(v, __shfl_xor(v, o));
    return v;
}
__device__ __forceinline__ float amax8(const f32x4& a, const f32x4& b) { return fmaxf(fmaxf(fmaxf(fabsf(a.x), fabsf(a.y)), fmaxf(fabsf(a.z), fabsf(a.w))), fmaxf(fmaxf(fabsf(b.x), fabsf(b.y)), fmaxf(fabsf(b.z), fabsf(b.w)))); }
__device__ __forceinline__ unsigned q4(const f32x4& a, float inv) { const int q0 = (int)__builtin_rintf(a.x * inv), q1 = (int)__builtin_rintf(a.y * inv), q2 = (int)__builtin_rintf(a.z * inv), q3 = (int)__builtin_rintf(a.w * inv);
    return ((unsigned)q0 & 0xffu) | (((unsigned)q1 & 0xffu) << 8) | (((unsigned)q2 & 0xffu) << 16) | (((unsigned)q3 & 0xffu) << 24); }
template <int MAP> __device__ __forceinline__ void quant_item(const float* W, int N, i8* WT, float* SB, LAS float* scr, int item, int lane) {
    constexpr int K = 1024;
    const int n0 = 32 * item;
    const float* src = W + (size_t)(lane >> 5) * N + n0 + (lane & 31);
    float mx = 0.f;
    for (int kb = 0; kb < K / 64; ++kb) { float v[32];
#pragma unroll
        for (int i = 0; i < 32; ++i) v[i] = src[(size_t)(64 * kb + 2 * i) * N];
#pragma unroll
        for (int i = 0; i < 32; ++i) mx = fmaxf(mx, fabsf(v[i])); }
    mx = fmaxf(mx, __shfl_xor(mx, 32));
    const float sc = mx > 0.f ? mx * (1.0f / 127.0f) : 1.0f, inv = mx > 0.f ? 127.0f / mx : 0.f;
    if (lane < 32) SB[dmap<MAP>(n0 + lane)] = sc;
    for (int kb = 0; kb < K / 64; ++kb) { float v[32];
#pragma unroll
        for (int i = 0; i < 32; ++i) v[i] = src[(size_t)(64 * kb + 2 * i) * N];
#pragma unroll
        for (int i = 0; i < 32; ++i) scr[(2 * i + (lane >> 5)) * 33 + (lane & 31)] = v[i] * inv;
        LDS_WAIT(); asm volatile("" ::: "memory");
        const int c = lane & 7;
#pragma unroll
        for (int j = 0; j < 4; ++j) { const int n = (lane >> 3) + 8 * j; const LAS float* s = scr + (8 * c) * 33 + n;
            const f32x4 lo = (f32x4){s[0 * 33], s[1 * 33], s[2 * 33], s[3 * 33]}, hi = (f32x4){s[4 * 33], s[5 * 33], s[6 * 33], s[7 * 33]};
            *(GAS v2u*)(WT + (size_t)dmap<MAP>(n0 + n) * K + 64 * kb + 8 * c) = (v2u){q4(lo, 1.0f), q4(hi, 1.0f)}; }
        LDS_WAIT(); asm volatile("" ::: "memory"); }
}
__device__ __constant__ double INVF_D[16] = {1.0, 0.5623413251903491, 0.31622776601683794, 0.1778279410038923, 0.09999999999999999, 0.056234132519034905, 0.03162277660168379, 0.01778279410038923,
    0.01, 0.005623413251903491, 0.0031622776601683794, 0.0017782794100389228, 0.001, 0.000562341325190349, 0.00031622776601683794, 0.0001778279410038923};
__device__ __constant__ int RPB_TH[15] = {22, 30, 40, 54, 73, 99, 134, 182, 246, 332, 450, 609, 825, 1117, 1513};

__device__ __forceinline__ void p0_prologue(Frame& F) {
    const int gw = F.vcu * NWAVES + F.wave, NGW = F.G * NWAVES;
    const int gtid = F.vcu * (NWAVES * 64) + F.tid, NGT = F.G * NWAVES * 64;
    float* MODV = (float*)(F.ws + WS_MODV);
    {
        LAS float* cact = (LAS float*)F.lds;
        LAS float* red = (LAS float*)(F.lds + 16384);
        const float* cin = F.in[1];
        for (int i = F.tid; i < 4096; i += NWAVES * 64) { const int b = i >> 10, k = i & 1023; const float x = cin[i]; cact[k * 4 + b] = x / (1.0f + expf(-x)); }
        __syncthreads();
        constexpr int NTASK = (6 * D * 2 + 2 * D) / 64;
        for (int task = F.vcu; task < NTASK; task += F.G) {
            const int gc = task * 64 + F.lane;
            const float* W; int ldw, cc; const float* bias;
            if (gc < 6 * D) { W = F.in[5]; ldw = 6 * D; cc = gc; bias = F.in[6]; }
            else if (gc < 12 * D) { W = F.in[5] + (size_t)D * 6 * D; ldw = 6 * D; cc = gc - 6 * D; bias = F.in[6] + 6 * D; }
            else { W = F.in[14]; ldw = 2 * D; cc = gc - 12 * D; bias = F.in[15]; }
            float a0 = 0.f, a1 = 0.f, a2 = 0.f, a3 = 0.f;
            const int kbeg = F.wave * 128;
#pragma unroll 16
            for (int k = 0; k < 128; ++k) { const float w = W[(size_t)(kbeg + k) * ldw + cc]; const f32x4 ca = *(const LAS f32x4*)(cact + (kbeg + k) * 4);
                a0 += w * ca[0]; a1 += w * ca[1]; a2 += w * ca[2]; a3 += w * ca[3]; }
            red[(F.wave * 4 + 0) * 64 + F.lane] = a0; red[(F.wave * 4 + 1) * 64 + F.lane] = a1; red[(F.wave * 4 + 2) * 64 + F.lane] = a2; red[(F.wave * 4 + 3) * 64 + F.lane] = a3;
            __syncthreads();
            if (F.wave < 4) { const int b = F.wave; float s = 0.f;
#pragma unroll
                for (int w = 0; w < 8; ++w) s += red[(w * 4 + b) * 64 + F.lane];
                s += bias[cc];
                int kind; float val = s; const int j = cc & 1023, ch = cc >> 10;
                if (gc < 12 * D) { const int Lr = gc < 6 * D ? 0 : 1;
                    if (ch == 0) kind = 6 * Lr + 1; else if (ch == 1) { kind = 6 * Lr + 0; val = F.in[3][Lr * D + j] * (1.0f + s); } else if (ch == 2) kind = 6 * Lr + 2;
                    else if (ch == 3) kind = 6 * Lr + 4; else if (ch == 4) { kind = 6 * Lr + 3; val = F.in[4][Lr * D + j] * (1.0f + s); } else kind = 6 * Lr + 5;
                } else { if (ch == 0) kind = MK_B_KV; else { kind = MK_A_KV; val = F.in[13][j] * (1.0f + s); } }
                MODV[((size_t)kind * 4 + b) * D + j] = val; }
            __syncthreads();
        }
        __syncthreads();
    }
    {
        LAS float* scr = (LAS float*)(F.lds + F.wave * 8704);
        constexpr int Q_MLAIN = LATN / 32, Q_FGU = 2 * DFF / 32, Q_KVB = DILKV / 32, Q_QB = DILQ / 32;
        constexpr int NI8 = Q_MLAIN + Q_FGU + Q_KVB + Q_QB + NEXP * Q_FGU;
        constexpr int I_QUP = (QRANK / 64) * (QUP / 32), I_KVUP = (KVRANK / 64) * (KVUP / 32), I_OUT = (D / 64) * (D / 32), I_FDN = (DFF / 64) * (D / 32), I_OB = (DILOUT / 64) * (D / 32);
        constexpr int NB16 = I_QUP + I_KVUP + I_OUT + I_FDN + I_OB + NEXP * I_FDN;
        float* const SB = (float*)(F.ws + WS_SB);
#define P0_I8_ITEM(idx) do { int r = (idx); \
            if (r < Q_MLAIN) { quant_item<MAP_MLAIN>(F.in[7], LATN, (i8*)(F.ws + WS_WMLAIN), SB + SB_LAT, scr, r, F.lane); break; } r -= Q_MLAIN; \
            if (r < Q_FGU) { quant_item<MAP_GU>(F.in[20], 2 * DFF, (i8*)(F.ws + WS_WFGU), SB + SB_FGU, scr, r, F.lane); break; } r -= Q_FGU; \
            if (r < Q_KVB) { quant_item<MAP_PLAIN>(F.in[16], DILKV, (i8*)(F.ws + WS_WKVB), SB + SB_KVB, scr, r, F.lane); break; } r -= Q_KVB; \
            if (r < Q_QB) { quant_item<MAP_PLAIN>(F.in[18], DILQ, (i8*)(F.ws + WS_WQB), SB + SB_QB, scr, r, F.lane); break; } r -= Q_QB; \
            { const int e = r / Q_FGU; quant_item<MAP_GU>(F.in[23] + (size_t)e * D * 2 * DFF, 2 * DFF, (i8*)(F.ws + WS_WEGU) + (size_t)e * 2 * DFF * D, SB + SB_EGU + (size_t)e * 2 * DFF, scr, r % Q_FGU, F.lane); } } while (0)
#define P0_B16_ITEM(idx) do { int r = (idx); \
            if (r < I_QUP) { transpose_item<MAP_QUP>(F.in[9], QRANK, QUP, (bf16*)(F.ws + WS_WQUP), F.in[8], scr, r, F.lane); break; } r -= I_QUP; \
            if (r < I_KVUP) { transpose_item<MAP_PLAIN>(F.in[11], KVRANK, KVUP, (bf16*)(F.ws + WS_WKVUP), F.in[10], scr, r, F.lane); break; } r -= I_KVUP; \
            if (r < I_OUT) { transpose_item<MAP_PLAIN>(F.in[12], D, D, (bf16*)(F.ws + WS_WOUT), nullptr, scr, r, F.lane); break; } r -= I_OUT; \
            if (r < I_FDN) { transpose_item<MAP_PLAIN>(F.in[21], DFF, D, (bf16*)(F.ws + WS_WFDN), nullptr, scr, r, F.lane); break; } r -= I_FDN; \
            if (r < I_OB) { transpose_item<MAP_PLAIN>(F.in[19], DILOUT, D, (bf16*)(F.ws + WS_WOB), nullptr, scr, r, F.lane); break; } r -= I_OB; \
            { const int e = r / I_FDN; transpose_item<MAP_PLAIN>(F.in[24] + (size_t)e * DFF * D, DFF, D, (bf16*)(F.ws + WS_WEDN) + (size_t)e * D * DFF, nullptr, scr, r % I_FDN, F.lane); } } while (0)
        if (NGW > NI8) {
            if (gw < NI8) { P0_I8_ITEM(gw); for (int q = 0; q < 3; ++q) { const int it = gw + q * NI8; if (it < NB16) P0_B16_ITEM(it); } }
            else for (int it = 3 * NI8 + (gw - NI8); it < NB16; it += NGW - NI8) P0_B16_ITEM(it);
        } else {
            for (int it = gw; it < NI8; it += NGW) P0_I8_ITEM(it);
            for (int it = gw; it < NB16; it += NGW) P0_B16_ITEM(it);
        }
#undef P0_I8_ITEM
#undef P0_B16_ITEM
    }
    {
        v4u* padz = (v4u*)(F.ws + WS_WMLAIN + (size_t)LATN * D);
        for (int i = gtid; i < (LATP - LATN) * D / 16; i += NGT) padz[i] = (v4u){0u, 0u, 0u, 0u};
        for (int i = gtid; i < LATP - LATN; i += NGT) ((float*)(F.ws + WS_SB))[SB_LAT + LATN + i] = 1.0f;
        const int* pos = (const int*)F.in[2];
        float* cs = (float*)(F.ws + WS_CS);
        for (int i = gtid; i < M * 16; i += NGT) { const int row = i >> 4, k = i & 15;
            const double x = (double)pos[row] * INVF_D[k]; const double rev = x * 0.15915494309189535; const float fr = (float)(rev - __builtin_rint(rev));
            cs[(size_t)i * 2] = __builtin_amdgcn_cosf(fr); cs[(size_t)i * 2 + 1] = __builtin_amdgcn_sinf(fr); }
        const float* rpb = F.in[17];
        float* bt = (float*)(F.ws + WS_BIAS);
        for (int i = gtid; i < 24 * 288; i += NGT) { const int gh = i / 288, ii = i % 288, j = 191 - ii, g = gh >> 3; const int d = j * (g == 0 ? 1 : (g == 1 ? 4 : 16));
            float val = -INFINITY;
            if (j >= 0 && j <= 128) { int bk; if (d < 16) bk = d; else { bk = 16;
#pragma unroll
                for (int q = 0; q < 15; ++q) bk += (d >= RPB_TH[q]) ? 1 : 0; }
                val = rpb[bk * 24 + gh] * LOG2E_F; }
            bt[i] = val; }
    }
}

constexpr int HPITCH = 2048;
__device__ __forceinline__ void ld8_f32(const float* p, f32x4& a, f32x4& b) { a = *(const f32x4*)p; b = *(const f32x4*)(p + 4); }
__device__ __forceinline__ void ld8_bf16(const bf16* p, f32x4& a, f32x4& b) { const v4u w = *(const GAS v4u*)p; a = (f32x4){bf_lo(w.x), bf_hi(w.x), bf_lo(w.y), bf_hi(w.y)}; b = (f32x4){bf_lo(w.z), bf_hi(w.z), bf_lo(w.w), bf_hi(w.w)}; }
__device__ __forceinline__ float ssq8(const f32x4& a, const f32x4& b) { return ((a.x * a.x + a.y * a.y) + (a.z * a.z + a.w * a.w)) + ((b.x * b.x + b.y * b.y) + (b.z * b.z + b.w * b.w)); }
__device__ __forceinline__ v4u pk8(const f32x4& a, const f32x4& b) { return (v4u){pk2(a.x, a.y), pk2(a.z, a.w), pk2(b.x, b.y), pk2(b.z, b.w)}; }
__device__ __forceinline__ void quant_row(const f32x4 (&y)[2][2], i8* orow, float* srow, int lane) {
    const float mx = wave_max(fmaxf(amax8(y[0][0], y[0][1]), amax8(y[1][0], y[1][1])));
    const float sc = mx > 0.f ? mx * (1.0f / 127.0f) : 1.0f, inv = mx > 0.f ? 127.0f / mx : 0.f;
#pragma unroll
    for (int j = 0; j < 2; ++j) *(GAS v2u*)(orow + 8 * lane + 512 * j) = (v2u){q4(y[j][0], inv), q4(y[j][1], inv)};
    if (lane == 0) *srow = sc;
}
template <bool DUAL, bool INF32>
__device__ __forceinline__ void norm_phase(Frame& F, const void* Hin, const float* A0, const float* B0, i8* O0, float* S0, const float* A1, const float* B1, i8* O1, float* S1) {
    const int gw = F.vcu * NWAVES + F.wave, NGW = F.G * NWAVES;
    for (int c = gw; c < M / 16; c += NGW) {
        const int row0 = c * 16, b = row0 / SEQ;
        f32x4 a0[2][2], b0[2][2], a1[2][2], b1[2][2];
#pragma unroll
        for (int j = 0; j < 2; ++j) { const int co = b * D + 8 * F.lane + 512 * j; ld8_f32(A0 + co, a0[j][0], a0[j][1]); ld8_f32(B0 + co, b0[j][0], b0[j][1]);
            if (DUAL) { ld8_f32(A1 + co, a1[j][0], a1[j][1]); ld8_f32(B1 + co, b1[j][0], b1[j][1]); } }
#pragma unroll 2
        for (int i = 0; i < 16; ++i) { const size_t row = (size_t)(row0 + i);
            f32x4 v[2][2]; float s = 0.f;
#pragma unroll
            for (int j = 0; j < 2; ++j) { if (INF32) ld8_f32((const float*)Hin + row * D + 8 * F.lane + 512 * j, v[j][0], v[j][1]); else ld8_bf16((const bf16*)Hin + row * HPITCH + 8 * F.lane + 512 * j, v[j][0], v[j][1]);
                s += ssq8(v[j][0], v[j][1]); }
            const float rstd = 1.0f / sqrtf(wave_sum(s) * (1.f / D) + EPS);
            f32x4 y[2][2];
#pragma unroll
            for (int j = 0; j < 2; ++j) { y[j][0] = v[j][0] * rstd * a0[j][0] + b0[j][0]; y[j][1] = v[j][1] * rstd * a0[j][1] + b0[j][1]; }
            quant_row(y, O0 + row * D, S0 + row, F.lane);
            if (DUAL) {
#pragma unroll
                for (int j = 0; j < 2; ++j) { y[j][0] = v[j][0] * rstd * a1[j][0] + b1[j][0]; y[j][1] = v[j][1] * rstd * a1[j][1] + b1[j][1]; }
                quant_row(y, O1 + row * D, S1 + row, F.lane); }
        }
    }
}

__device__ __forceinline__ void latnorm_phase(Frame& F) {
    const int gw = F.vcu * NWAVES + F.wave, NGW = F.G * NWAVES;
    const bf16* LAT = (const bf16*)(F.ws + A_LAT); bf16* QN = (bf16*)(F.ws + A_QN); bf16* KVN = (bf16*)(F.ws + A_KVN); bf16* KB = (bf16*)(F.ws + A_K);
    const float* cs = (const float*)(F.ws + WS_CS);
    for (int row = gw; row < M; row += NGW) {
        const unsigned* lr = (const unsigned*)(LAT + (size_t)row * LATP);
        unsigned q[3], kv[2];
#pragma unroll
        for (int j = 0; j < 3; ++j) q[j] = lr[F.lane + 64 * j];
#pragma unroll
        for (int j = 0; j < 2; ++j) kv[j] = lr[192 + F.lane + 64 * j];
        const unsigned kr = lr[320 + (F.lane & 15)];
        float sq = 0.f, sk = 0.f;
#pragma unroll
        for (int j = 0; j < 3; ++j) { const float a = bf_lo(q[j]), b = bf_hi(q[j]); sq += a * a + b * b; }
#pragma unroll
        for (int j = 0; j < 2; ++j) { const float a = bf_lo(kv[j]), b = bf_hi(kv[j]); sk += a * a + b * b; }
        const float rq = 1.0f / sqrtf(wave_sum(sq) * (1.f / QRANK) + EPS), rk = 1.0f / sqrtf(wave_sum(sk) * (1.f / KVRANK) + EPS);
        unsigned* qo = (unsigned*)(QN + (size_t)row * QRANK); unsigned* ko = (unsigned*)(KVN + (size_t)row * KVRANK);
#pragma unroll
        for (int j = 0; j < 3; ++j) qo[F.lane + 64 * j] = pk2(bf_lo(q[j]) * rq, bf_hi(q[j]) * rq);
#pragma unroll
        for (int j = 0; j < 2; ++j) ko[F.lane + 64 * j] = pk2(bf_lo(kv[j]) * rk, bf_hi(kv[j]) * rk);
        { const int i = F.lane & 15; const float c = cs[(size_t)row * 32 + 2 * i], s = cs[(size_t)row * 32 + 2 * i + 1]; const float x1 = bf_lo(kr), x2 = bf_hi(kr);
          const unsigned w = pk2(x1 * c - x2 * s, x1 * s + x2 * c);
          unsigned* kb = (unsigned*)(KB + (size_t)row * QUP);
#pragma unroll
          for (int hh = 0; hh < 4; ++hh) { const int h = (F.lane >> 4) * 4 + hh; kb[(h * 96 + 64) / 2 + i] = w; } }
    }
}

__device__ __forceinline__ void merge_phase(Frame& F) {
    const int gw = F.vcu * NWAVES + F.wave, NGW = F.G * NWAVES;
    const bf16* OG = (const bf16*)(F.ws + A_OG); const float* LSE = (const float*)(F.ws + WS_LSE); bf16* OD = (bf16*)(F.ws + A_OD);
    for (int row = gw; row < M; row += NGW) {
        const int h = F.lane >> 3;
        float l0 = LSE[((size_t)0 * M + row) * 8 + h], l1 = LSE[((size_t)1 * M + row) * 8 + h], l2 = LSE[((size_t)2 * M + row) * 8 + h];
        const float mx = fmaxf(l0, fmaxf(l1, l2)); float w0 = __builtin_amdgcn_exp2f(l0 - mx), w1 = __builtin_amdgcn_exp2f(l1 - mx), w2 = __builtin_amdgcn_exp2f(l2 - mx);
        const float inv = 1.0f / (w0 + w1 + w2); w0 *= inv; w1 *= inv; w2 *= inv;
        const v4u a = *(const v4u*)(OG + ((size_t)0 * M + row) * DILOUT + 8 * F.lane), b = *(const v4u*)(OG + ((size_t)1 * M + row) * DILOUT + 8 * F.lane), c = *(const v4u*)(OG + ((size_t)2 * M + row) * DILOUT + 8 * F.lane);
        v4u o;
#pragma unroll
        for (int k = 0; k < 4; ++k) o[k] = pk2(w0 * bf_lo(a[k]) + w1 * bf_lo(b[k]) + w2 * bf_lo(c[k]), w0 * bf_hi(a[k]) + w1 * bf_hi(b[k]) + w2 * bf_hi(c[k]));
        *(v4u*)(OD + (size_t)row * DILOUT + 8 * F.lane) = o;
    }
}

__device__ __forceinline__ void router_phase(Frame& F, const bf16* H, const float* A0, const float* B0, i8* O0, float* S0) {
    const int gw = F.vcu * NWAVES + F.wave, NGW = F.G * NWAVES;
    LAS float* wrt = (LAS float*)F.lds;
    { const float* wr = F.in[22]; for (int i = F.tid; i < 8192; i += NWAVES * 64) { const int col = i >> 3, e = i & 7; wrt[e * 1024 + col] = wr[i]; } }
    __syncthreads();
    v4u* ROUTE = (v4u*)(F.ws + WS_ROUTE); unsigned* CNT = (unsigned*)(F.ws + WS_CNT);
    for (int c = gw; c < M / 16; c += NGW) {
        const int row0 = c * 16, b = row0 / SEQ;
        f32x4 a0[2][2], b0[2][2];
#pragma unroll
        for (int j = 0; j < 2; ++j) { const int co = b * D + 8 * F.lane + 512 * j; ld8_f32(A0 + co, a0[j][0], a0[j][1]); ld8_f32(B0 + co, b0[j][0], b0[j][1]); }
        unsigned cnt = 0u;
        for (int i = 0; i < 16; ++i) { const size_t row = (size_t)(row0 + i);
            f32x4 v[2][2]; float s = 0.f;
#pragma unroll
            for (int j = 0; j < 2; ++j) { ld8_bf16(H + row * HPITCH + 8 * F.lane + 512 * j, v[j][0], v[j][1]); s += ssq8(v[j][0], v[j][1]); }
            const float rstd = 1.0f / sqrtf(wave_sum(s) * (1.f / D) + EPS);
            float lg[8];
#pragma unroll
            for (int e = 0; e < 8; ++e) lg[e] = 0.f;
            f32x4 yq[2][2];
#pragma unroll
            for (int j = 0; j < 2; ++j) { const f32x4 y0 = v[j][0] * rstd * a0[j][0] + b0[j][0], y1 = v[j][1] * rstd * a0[j][1] + b0[j][1];
                yq[j][0] = y0; yq[j][1] = y1;
#pragma unroll
                for (int e = 0; e < 8; ++e) { const LAS float* wp = wrt + e * 1024 + 8 * F.lane + 512 * j; const f32x4 w0 = *(const LAS f32x4*)wp, w1 = *(const LAS f32x4*)(wp + 4);
                    lg[e] += ((y0.x * w0.x + y0.y * w0.y) + (y0.z * w0.z + y0.w * w0.w)) + ((y1.x * w1.x + y1.y * w1.y) + (y1.z * w1.z + y1.w * w1.w)); } }
            quant_row(yq, O0 + row * D, S0 + row, F.lane);
#pragma unroll
            for (int e = 0; e < 8; ++e) lg[e] = wave_sum(lg[e]);
            int e1 = 0; float v1 = lg[0];
#pragma unroll
            for (int e = 1; e < 8; ++e) if (lg[e] > v1) { v1 = lg[e]; e1 = e; }
            int e2 = -1; float v2 = -INFINITY;
#pragma unroll
            for (int e = 0; e < 8; ++e) if (e != e1 && lg[e] > v2) { v2 = lg[e]; e2 = e; }
            const float ex = expf(v2 - v1); const float g1 = 1.0f / (1.0f + ex), g2 = ex / (1.0f + ex);
            cnt += (F.lane == e1 ? 1u : 0u) + (F.lane == e2 ? 1u : 0u);
            if (F.lane == 0) ROUTE[row] = (v4u){(unsigned)e1 | ((unsigned)e2 << 8), __float_as_uint(g1), __float_as_uint(g2), 0u};
        }
        if (F.lane < 8) CNT[c * 8 + F.lane] = cnt;
    }
}

__device__ __forceinline__ void lists_phase(Frame& F) {
    const int gw = F.vcu * NWAVES + F.wave, NGW = F.G * NWAVES;
    const v4u* ROUTE = (const v4u*)(F.ws + WS_ROUTE); const unsigned* CNT = (const unsigned*)(F.ws + WS_CNT);
    int* LIST = (int*)(F.ws + WS_LIST); float* SLOTG = (float*)(F.ws + WS_SLOTG); int* TOKSLOT = (int*)(F.ws + WS_TOKSLOT); int* TILEEXP = (int*)(F.ws + WS_TILEEXP);
    for (int c = gw; c < M / 16; c += NGW) {
        unsigned lt[8], al[8];
#pragma unroll
        for (int e = 0; e < 8; ++e) { lt[e] = 0u; al[e] = 0u; }
        for (int cc = F.lane; cc < M / 16; cc += 64) { const v4u x = *(const v4u*)(CNT + cc * 8), y = *(const v4u*)(CNT + cc * 8 + 4); const bool bl = cc < c;
            al[0] += x.x; al[1] += x.y; al[2] += x.z; al[3] += x.w; al[4] += y.x; al[5] += y.y; al[6] += y.z; al[7] += y.w;
            if (bl) { lt[0] += x.x; lt[1] += x.y; lt[2] += x.z; lt[3] += x.w; lt[4] += y.x; lt[5] += y.y; lt[6] += y.z; lt[7] += y.w; } }
#pragma unroll
        for (int e = 0; e < 8; ++e) {
#pragma unroll
            for (int o = 1; o < 64; o <<= 1) { lt[e] += __shfl_xor(lt[e], o); al[e] += __shfl_xor(al[e], o); } }
        unsigned base[8]; unsigned run = 0u;
#pragma unroll
        for (int e = 0; e < 8; ++e) { base[e] = run; run += (al[e] + 255u) & ~255u; }
        const int row = c * 16 + (F.lane & 15);
        const v4u r = ROUTE[row]; const int e1 = (int)(r.x & 0xffu), e2 = (int)((r.x >> 8) & 0xffu);
        int s1 = 0, s2 = 0;
#pragma unroll
        for (int e = 0; e < 8; ++e) { const bool has = (F.lane < 16) && (e1 == e || e2 == e); const unsigned long long mk = __ballot(has);
            const int rank = __popcll(mk & ((1ull << F.lane) - 1ull)); const int sl = (int)(base[e] + lt[e]) + rank;
            if (e1 == e) s1 = sl; if (e2 == e) s2 = sl; }
        if (F.lane < 16) { LIST[s1] = row; LIST[s2] = row; SLOTG[s1] = __uint_as_float(r.y); SLOTG[s2] = __uint_as_float(r.z); TOKSLOT[row * 2] = s1; TOKSLOT[row * 2 + 1] = s2; }
        if (c == 0) {
#pragma unroll
            for (int e = 0; e < 8; ++e) { const unsigned pe = (al[e] + 255u) & ~255u;
                for (unsigned s = base[e] + al[e] + F.lane; s < base[e] + pe; s += 64) { LIST[s] = 0; SLOTG[s] = 0.f; }
                for (unsigned t = base[e] / 256u + F.lane; t < (base[e] + pe) / 256u; t += 64) TILEEXP[t] = e; }
            if (F.lane == 0) TILEEXP[300] = (int)(run / 256u);
        }
    }
}

__device__ __forceinline__ void final_phase(Frame& F, float* OUT, const float* gate, const float* gfin) {
    const int gw = F.vcu * NWAVES + F.wave, NGW = F.G * NWAVES;
    const bf16* Y = (const bf16*)(F.ws + A_Y); const int* TOKSLOT = (const int*)(F.ws + WS_TOKSLOT); const bf16* H = (const bf16*)OUT;
    for (int c = gw; c < M / 16; c += NGW) {
        const int row0 = c * 16, b = row0 / SEQ;
        f32x4 gt[2][2], gf[2][2];
#pragma unroll
        for (int j = 0; j < 2; ++j) { ld8_f32(gate + b * D + 8 * F.lane + 512 * j, gt[j][0], gt[j][1]); ld8_f32(gfin + 8 * F.lane + 512 * j, gf[j][0], gf[j][1]); }
#pragma unroll 2
        for (int i = 0; i < 16; ++i) { const size_t row = (size_t)(row0 + i);
            const int s1 = TOKSLOT[row * 2], s2 = TOKSLOT[row * 2 + 1];
            f32x4 v[2][2]; float s = 0.f;
#pragma unroll
            for (int j = 0; j < 2; ++j) { f32x4 h0, h1, p0, p1, q0, q1; ld8_bf16(H + row * HPITCH + 8 * F.lane + 512 * j, h0, h1);
                ld8_bf16(Y + (size_t)s1 * D + 8 * F.lane + 512 * j, p0, p1); ld8_bf16(Y + (size_t)s2 * D + 8 * F.lane + 512 * j, q0, q1);
                v[j][0] = h0 + gt[j][0] * (p0 + q0); v[j][1] = h1 + gt[j][1] * (p1 + q1); s += ssq8(v[j][0], v[j][1]); }
            const float rstd = 1.0f / sqrtf(wave_sum(s) * (1.f / D) + EPS);
            asm volatile("" ::: "memory");
#pragma unroll
            for (int j = 0; j < 2; ++j) { float* op = OUT + row * D + 8 * F.lane + 512 * j; *(GAS f32x4*)op = v[j][0] * rstd * gf[j][0]; *(GAS f32x4*)(op + 4) = v[j][1] * rstd * gf[j][1]; }
        }
    }
}
#ifndef MK_ONE_LAUNCH
#define MK_ONE_LAUNCH 1
#endif
constexpr int N_PHASES = 20;
struct Args { const float* in[26]; float* out; unsigned char* ws; int ph_lo, ph_hi; };
static_assert(sizeof(Args) == 26 * 8 + 8 + 8 + 8, "Args has no padding");

__global__ void __launch_bounds__(NWAVES * 64, 2) mk_fwd(Args args) {
    extern __shared__ __attribute__((aligned(16))) unsigned char lds[];
    Frame F;
    F.lds = (LAS unsigned char*)lds;
    F.MISC = (volatile LAS unsigned*)(F.lds + MISC_OFF);
    F.tid = threadIdx.x; F.lane = F.tid & 63; F.wave = __builtin_amdgcn_readfirstlane(F.tid >> 6);
    F.G = gridDim.x; { const int bx = blockIdx.x; F.vcu = (F.G % 8 == 0) ? (bx % 8) * (F.G / 8) + bx / 8 : bx; }
    F.ws = args.ws; F.out = args.out;
#pragma unroll
    for (int i = 0; i < 26; ++i) F.in[i] = args.in[i];
    unsigned char* const ws = args.ws;
    for (int u = F.tid; u < (LDS_BYTES - LDSCTL_OFF) / 4; u += NWAVES * 64) ((LAS unsigned*)(F.lds + LDSCTL_OFF))[u] = 0u;
    __syncthreads();
    const int lo = args.ph_lo, hi = args.ph_hi;
    XcdBarrier bar; bar.bar = (unsigned*)(ws + WS_CTL) + CW_BAR; bar.x = 0; bar.st = nullptr;
    if (hi - lo > 1) bar = xcd_barrier_post((unsigned*)(ws + WS_CTL) + CW_BAR, F.MISC + 8);
    int cid = (int)blockIdx.x;
    if (hi - lo > 1) { if (F.tid == 0) F.MISC[12] = xb_add((unsigned*)(ws + WS_CTL) + CW_RANK + 64 * bar.x, 1u); }

#ifndef PHASE_MASK
#define PHASE_MASK 0xFFFFFu
#endif
#define IN(k) (((PHASE_MASK >> (k)) & 1u) && lo <= (k) && (k) < hi)
#ifndef REPEAT_MASK
#define REPEAT_MASK 0u
#endif
#define REP(k) (((REPEAT_MASK >> (k)) & 1u) ? 2 : 1)
#define SEAM(k) do { if (IN(k) && IN((k) + 1)) xcd_barrier(bar); } while (0)
    const float* MODV = (const float*)(ws + WS_MODV);
#define MV(kind) (MODV + (size_t)(kind) * 4 * D)
    bf16* const H = (bf16*)args.out;
    i8* const XN = (i8*)(ws + A_XN); i8* const XNKV = (i8*)(ws + A_XNKV);
    float* const XS = (float*)(ws + WS_XS); float* const XSKV = (float*)(ws + WS_XSKV); const float* const SB = (const float*)(ws + WS_SB);
    const pg8::MoeInfo mi0{nullptr, nullptr, 0};

    if (IN(0)) for (int rep_ = 0; rep_ < REP(0); ++rep_) { p0_prologue(F); } SEAM(0);
    if (IN(0) && IN(1)) {
        if (F.tid == 0) { bool ok = (F.G % 8) == 0;
            for (unsigned j = 0; j < 16; ++j) { const unsigned cnt_ = xb_ld((unsigned*)(ws + WS_CTL) + CW_BAR + XB_XCNT(j)); ok = ok && (cnt_ == (j < 8 ? (unsigned)F.G / 8u : 0u)); }
            F.MISC[13] = ok ? (F.MISC[12] * 8u + bar.x) : (unsigned)blockIdx.x; }
        __syncthreads();
        cid = (int)F.MISC[13];
        F.vcu = (F.G % 8 == 0) ? (cid % 8) * (F.G / 8) + cid / 8 : cid;
    }

    if (IN(1)) for (int rep_ = 0; rep_ < REP(1); ++rep_) { norm_phase<false, true>(F, F.in[0], MV(MK_A_MIX0), MV(MK_B_MIX0), XN, XS, nullptr, nullptr, nullptr, nullptr); } SEAM(1);
    if (IN(2)) for (int rep_ = 0; rep_ < REP(2); ++rep_) { pg8::Gemm g{(const bf16*)XN, (const bf16*)(ws + WS_WMLAIN), M, LATP, D}; pg8::StaticOrder S; S.init(M, LATP, F.G, cid);
        pg8::EpiBf16Q E{(bf16*)(ws + A_LAT), LATP, XS, SB + SB_LAT};
        pg8::gemm_phase<pg8::EpiBf16Q, pg8::StaticOrder, true, true, 0, true>(F.lds, g, S, E, mi0); } SEAM(2);
    if (IN(3)) for (int rep_ = 0; rep_ < REP(3); ++rep_) { latnorm_phase(F); } SEAM(3);
    if (IN(4)) for (int rep_ = 0; rep_ < REP(4); ++rep_) {
#ifndef P4_SKIP_Q
        { pg8::Gemm g{(const bf16*)(ws + A_QN), (const bf16*)(ws + WS_WQUP), M, QUP, QRANK}; pg8::StaticOrder S; S.init(M, QUP, F.G, cid);
          pg8::EpiQ E{(bf16*)(ws + A_Q), QUP, C2_MLA, (const float*)(ws + WS_CS)};
          pg8::gemm_phase<pg8::EpiQ, pg8::StaticOrder, true, true, 0>(F.lds, g, S, E, mi0); }
#endif
#ifndef P4_SKIP_KV
        { pg8::Gemm g{(const bf16*)(ws + A_KVN), (const bf16*)(ws + WS_WKVUP), M, KVUP, KVRANK}; pg8::StaticOrder S; S.init(M, KVUP, F.G, cid);
          pg8::EpiKV E{(bf16*)(ws + A_K), (bf16*)(ws + A_V)};
          pg8::gemm_phase<pg8::EpiKV, pg8::StaticOrder, true, true, 0>(F.lds, g, S, E, mi0); }
#endif
    } SEAM(4);
    if (IN(5)) for (int rep_ = 0; rep_ < REP(5); ++rep_) {
        const bf16* Qp = (const bf16*)(ws + A_Q); const bf16* Kp = (const bf16*)(ws + A_K); const bf16* Vp = (const bf16*)(ws + A_V); bf16* Op = (bf16*)(ws + A_O);
        if (F.G == 256) {
            for (int i = 0; i < 8; ++i) { const int bh = (F.vcu >> 3) + 32 * (i >> 2), s = F.vcu & 7, k = i & 3; const int qb = (k == 0) ? s : (k == 1) ? 15 - s : (k == 2) ? 16 + s : 31 - s;
                const int b = bh >> 4, h = bh & 15;
                mla::attn_unit<8>(b, h, qb, Qp, Kp, Vp, Op, (char*)lds); }
        } else {
            for (int u = (int)blockIdx.x; u < BATCH * MLA_H * 32; u += F.G) { const int bh = u >> 5, qb = 31 - (u & 31); const int b = bh >> 4, h = bh & 15;
                mla::attn_unit<8>(b, h, qb, Qp, Kp, Vp, Op, (char*)lds); }
        }
    } SEAM(5);
    if (IN(6)) for (int rep_ = 0; rep_ < REP(6); ++rep_) { pg8::Gemm g{(const bf16*)(ws + A_O), (const bf16*)(ws + WS_WOUT), M, D, D}; pg8::StaticOrder S; S.init(M, D, F.G, cid);
        pg8::EpiResid<true> E{F.in[0], H, MV(MK_G_MIX0)};
        pg8::gemm_phase<pg8::EpiResid<true>, pg8::StaticOrder, true, true, 0>(F.lds, g, S, E, mi0); } SEAM(6);
    if (IN(7)) for (int rep_ = 0; rep_ < REP(7); ++rep_) { norm_phase<false, false>(F, H, MV(MK_A_FFN0), MV(MK_B_FFN0), XN, XS, nullptr, nullptr, nullptr, nullptr); } SEAM(7);
    if (IN(8)) for (int rep_ = 0; rep_ < REP(8); ++rep_) { pg8::Gemm g{(const bf16*)XN, (const bf16*)(ws + WS_WFGU), M, 2 * DFF, D}; pg8::StaticOrder S; S.init(M, 2 * DFF, F.G, cid);
        pg8::EpiSwiGLUQ E{(bf16*)(ws + A_HID), DFF, XS, SB + SB_FGU, nullptr, nullptr};
        pg8::gemm_phase<pg8::EpiSwiGLUQ, pg8::StaticOrder, true, true, 0, true>(F.lds, g, S, E, mi0); } SEAM(8);
    if (IN(9)) for (int rep_ = 0; rep_ < REP(9); ++rep_) { pg8::Gemm g{(const bf16*)(ws + A_HID), (const bf16*)(ws + WS_WFDN), M, D, DFF}; pg8::StaticOrder S; S.init(M, D, F.G, cid);
        pg8::EpiResid<false> E{H, H, MV(MK_G_FFN0)};
        pg8::gemm_phase<pg8::EpiResid<false>, pg8::StaticOrder, true, true, 0>(F.lds, g, S, E, mi0); } SEAM(9);
    if (IN(10)) for (int rep_ = 0; rep_ < REP(10); ++rep_) { norm_phase<true, false>(F, H, MV(MK_A_MIX1), MV(MK_B_MIX1), XN, XS, MV(MK_A_KV), MV(MK_B_KV), XNKV, XSKV); } SEAM(10);
    if (IN(11)) for (int rep_ = 0; rep_ < REP(11); ++rep_) {
        { pg8::Gemm g{(const bf16*)XNKV, (const bf16*)(ws + WS_WKVB), M, DILKV, D}; pg8::StaticOrder S; S.init(M, DILKV, F.G, cid);
          pg8::EpiDilQ<true> E{(bf16*)(ws + A_KVB), XSKV, SB + SB_KVB};
          pg8::gemm_phase<pg8::EpiDilQ<true>, pg8::StaticOrder, true, true, 0, true>(F.lds, g, S, E, mi0); }
        { pg8::Gemm g{(const bf16*)XN, (const bf16*)(ws + WS_WQB), M, DILQ, D}; pg8::StaticOrder S; S.init(M, DILQ, F.G, cid);
          pg8::EpiDilQ<false> E{(bf16*)(ws + A_QB), XS, SB + SB_QB};
          pg8::gemm_phase<pg8::EpiDilQ<false>, pg8::StaticOrder, true, true, 0, true>(F.lds, g, S, E, mi0); }
    } SEAM(11);
    if (IN(12)) for (int rep_ = 0; rep_ < REP(12); ++rep_) {
        const bf16* Qp = (const bf16*)(ws + A_QB); const bf16* KV = (const bf16*)(ws + A_KVB); bf16* OG = (bf16*)(ws + A_OG); float* LSE = (float*)(ws + WS_LSE); const float* BT = (const float*)(ws + WS_BIAS);
        dila::dil_phase(Qp, KV, OG, LSE, BT, (char*)lds, F.G);
    } SEAM(12);
    if (IN(13)) for (int rep_ = 0; rep_ < REP(13); ++rep_) { merge_phase(F); } SEAM(13);
    if (IN(14)) for (int rep_ = 0; rep_ < REP(14); ++rep_) { pg8::Gemm g{(const bf16*)(ws + A_OD), (const bf16*)(ws + WS_WOB), M, D, DILOUT}; pg8::StaticOrder S; S.init(M, D, F.G, cid);
        pg8::EpiResid<false> E{H, H, MV(MK_G_MIX1)};
        pg8::gemm_phase<pg8::EpiResid<false>, pg8::StaticOrder, true, true, 0>(F.lds, g, S, E, mi0); } SEAM(14);
    if (IN(15)) for (int rep_ = 0; rep_ < REP(15); ++rep_) { router_phase(F, H, MV(MK_A_FFN1), MV(MK_B_FFN1), XN, XS); } SEAM(15);
    if (IN(16)) for (int rep_ = 0; rep_ < REP(16); ++rep_) { lists_phase(F); } SEAM(16);
    if (IN(17)) for (int rep_ = 0; rep_ < REP(17); ++rep_) { const int ntile = ((const int*)(ws + WS_TILEEXP))[300];
        pg8::Gemm g{(const bf16*)XN, (const bf16*)(ws + WS_WEGU), ntile * 256, 2 * DFF, D}; pg8::StaticOrder S; S.init(ntile * 256, 2 * DFF, F.G, cid);
        const pg8::MoeInfo mi{(const int*)(ws + WS_LIST), (const int*)(ws + WS_TILEEXP), (size_t)2 * DFF * D};
        pg8::EpiSwiGLUQ E{(bf16*)(ws + A_HIDS), DFF, XS, SB + SB_EGU, mi.list, mi.tile_expert};
        pg8::gemm_phase<pg8::EpiSwiGLUQ, pg8::StaticOrder, true, true, 1, true>(F.lds, g, S, E, mi); } SEAM(17);
    if (IN(18)) for (int rep_ = 0; rep_ < REP(18); ++rep_) { const int ntile = ((const int*)(ws + WS_TILEEXP))[300];
        pg8::Gemm g{(const bf16*)(ws + A_HIDS), (const bf16*)(ws + WS_WEDN), ntile * 256, D, DFF}; pg8::StaticOrder S; S.init(ntile * 256, D, F.G, cid);
        pg8::EpiMoeDown E{(bf16*)(ws + A_Y), (const float*)(ws + WS_SLOTG)};
        const pg8::MoeInfo mi{(const int*)(ws + WS_LIST), (const int*)(ws + WS_TILEEXP), (size_t)D * DFF * 2};
        pg8::gemm_phase<pg8::EpiMoeDown, pg8::StaticOrder, true, true, 2>(F.lds, g, S, E, mi); } SEAM(18);
    if (IN(19)) for (int rep_ = 0; rep_ < REP(19); ++rep_) { final_phase(F, args.out, MV(MK_G_FFN1), F.in[25]); }
#undef IN
#undef SEAM
#undef MV
}

extern "C" void kernel_launch(void* const* d_in, const int* in_sizes, int n_in, void* d_out, int out_size, void* d_ws, size_t ws_size, hipStream_t stream) {
    static int grid = 0;
    if (grid == 0) {
        if (n_in != 26 || in_sizes[0] != M * D || out_size != M * D || ws_size < WS_END) { fprintf(stderr, "kernel_launch: unexpected shapes (n_in %d, in0 %d, out %d, ws %zu, need %zu); nothing launched\n", n_in, n_in > 0 ? in_sizes[0] : -1, out_size, ws_size, (size_t)WS_END); grid = -1; return; }
        int dev = 0, cus = 0, per_cu = 0;
        if (hipGetDevice(&dev) != hipSuccess || hipDeviceGetAttribute(&cus, hipDeviceAttributeMultiprocessorCount, dev) != hipSuccess) { grid = -1; return; }
        if (hipFuncSetAttribute((const void*)mk_fwd, hipFuncAttributeMaxDynamicSharedMemorySize, LDS_BYTES) != hipSuccess) { fprintf(stderr, "kernel_launch: hipFuncSetAttribute failed\n"); grid = -1; return; }
        if (hipOccupancyMaxActiveBlocksPerMultiprocessor(&per_cu, (const void*)mk_fwd, NWAVES * 64, LDS_BYTES) != hipSuccess || per_cu < 1) { fprintf(stderr, "kernel_launch: occupancy query reports %d\n", per_cu); }
        (void)hipGetLastError();
        grid = cus;
    }
    if (grid < 0) return;
    if (hipMemsetAsync((char*)d_ws + WS_CTL, 0, CTL_ZERO_BYTES, stream) != hipSuccess) return;
    Args a{};
    for (int i = 0; i < 26; ++i) a.in[i] = (const float*)d_in[i];
    a.out = (float*)d_out; a.ws = (unsigned char*)d_ws;
#if MK_ONE_LAUNCH
    a.ph_lo = 0; a.ph_hi = N_PHASES;
    hipLaunchKernelGGL(mk_fwd, dim3(grid), dim3(NWAVES * 64), LDS_BYTES, stream, a);
#else
    for (int p = 0; p < N_PHASES; ++p) { a.ph_lo = p; a.ph_hi = p + 1; hipLaunchKernelGGL(mk_fwd, dim3(grid), dim3(NWAVES * 64), LDS_BYTES, stream, a); }
#endif
}
```

```cpp
#include <hip/hip_runtime.h>
#include <hip/hip_bf16.h>
#include <cstdio>
#include <cstdint>
#include <cmath>
#ifndef MK_ONE_LAUNCH
#define MK_ONE_LAUNCH 1
#endif
#ifndef PG8_STAGGER
#define PG8_STAGGER 0
#endif
namespace pg8 {
#define PG8_LAS __attribute__((address_space(3)))
typedef unsigned short bf16_t;
typedef short bf16x8 __attribute__((ext_vector_type(8)));
typedef float f32x4 __attribute__((ext_vector_type(4)));
typedef float f32x2 __attribute__((ext_vector_type(2)));
typedef unsigned u32x4 __attribute__((ext_vector_type(4)));
typedef int i32x4 __attribute__((ext_vector_type(4)));
typedef int i32x8 __attribute__((ext_vector_type(8)));
template <int PREC> struct AccT { typedef f32x4 type; }; template <> struct AccT<1> { typedef i32x4 type; };
constexpr int BM = 256, BK = 64, HALF = 128, HTB = HALF * BK * 2  , STAGE_BYTES = 8 * HTB, NXCD = 8, WGM = 8;

__host__ __device__ __forceinline__ int lds_byte(int r, int c) { const int st = (r >> 4) * 2 + (c >> 5), rr = r & 15, cc = c & 31, ob = rr * 64 + cc * 2; return st * 1024 + (ob ^ (((ob >> 9) & 1) << 5)); }
__host__ __device__ __forceinline__ void stage_rc(int b, int& R, int& C) { const int st = b / 1024, sb = b % 1024, swz = sb ^ (((sb >> 9) & 1) << 5); R = (st >> 1) * 16 + swz / 64; C = (st & 1) * 32 + (swz % 64) / 2; }
__host__ __device__ __forceinline__ int perm32(int rho) { const int n = rho >> 4, i = rho & 15; return 8 * (i >> 2) + 4 * n + (i & 3); }

struct Unit { int pm, pn; };
struct Gemm { const bf16_t* A; const bf16_t* Bt; int M, N, K; };
struct MoeInfo { const int* list; const int* tile_expert; size_t bstride; };

struct StaticOrder {
    int nM, nN, nwg, G, c;
    __host__ __device__ void init(int M, int N, int G_, int c_) { nM = M / BM; nN = N / BM; nwg = nM * nN; G = G_; c = c_; }
    __host__ __device__ bool next(int i, Unit& u) const {
        const long L = (long)i * G + c; if (L >= nwg) return false;
        int wgid = (int)L; { const int q = nwg / NXCD, r = nwg % NXCD, xcd = wgid % NXCD, off = wgid / NXCD; wgid = (xcd < r ? xcd * (q + 1) : r * (q + 1) + (xcd - r) * q) + off; }
        const int nig = WGM * nN, gid = wgid / nig, fm = gid * WGM, gsz = (nM - fm) < WGM ? (nM - fm) : WGM;
        u.pm = fm + ((wgid % nig) % gsz); u.pn = (wgid % nig) / gsz; return true;
    }
    __device__ __forceinline__ void a_ready(const Unit&) const {}
    __device__ __forceinline__ void done(const Unit&) const {}
};

__device__ __forceinline__ unsigned cvt_pk_bf16(float lo, float hi) { unsigned r; asm volatile("v_cvt_pk_bf16_f32 %0, %1, %2" : "=v"(r) : "v"(lo), "v"(hi)); return r; }


template <class Epi, class Sched, bool ALIGN_EPI, bool SP2, int MODE, int PREC = 0>
__device__ __forceinline__ void gemm_phase(PG8_LAS unsigned char* lds, const Gemm g, const Sched& S, const Epi& E, const MoeInfo mi) {
    const int tid = threadIdx.x, wid = __builtin_amdgcn_readfirstlane(tid >> 6), lane = tid & 63, wr = wid >> 2, wc = wid & 3, fr = lane & 15, fq = lane >> 4;
    int K_ = g.K; asm volatile("" : "+s"(K_));
    constexpr int ES = PREC ? 1 : 2;
    const int K = K_, nt = (K * ES) / (BK * 2);
    unsigned voffB[2]; int Rr[2], Cc[2];
#pragma unroll
    for (int i = 0; i < 2; ++i) { int R, C; stage_rc(tid * 16 + i * 8192, R, C); const int Rb = Epi::PERM ? ((R & ~31) + perm32(R & 31)) : R;
        Rr[i] = R; Cc[i] = C; voffB[i] = (unsigned)(Rb * K) * (unsigned)ES + (unsigned)C * 2u; }
    const size_t kstep = (size_t)(BK * 2);
    const size_t hstep = (size_t)HALF * K * ES;
    const size_t tstep = 2 * hstep;
    const unsigned ldsw = (unsigned)wid * 1024u;
    const int aoff = lds_byte(wr * 64 + fr, fq * 8), boff = lds_byte(wc * 32 + fr, fq * 8);
    const unsigned rowb = (unsigned)K * (unsigned)ES;
#define PG8_SA(b, h) (((b) * 2 + (h)) * HTB)
#define PG8_SB(b, h) ((4 + (b) * 2 + (h)) * HTB)
#define PG8_STAGE(bufoff, gbase, voff) do { _Pragma("unroll") for (int _i = 0; _i < 2; ++_i) \
        __builtin_amdgcn_global_load_lds((const unsigned*)((const char*)(gbase) + (voff)[_i]), (PG8_LAS unsigned*)(lds + (bufoff) + ldsw + _i * 8192), 16, 0, 0); } while (0)
#define PG8_LDA(dst, b, h) do { _Pragma("unroll") for (int m = 0; m < 4; ++m) { if constexpr (PREC == 2) { \
            const i32x4 lo_ = *(const PG8_LAS i32x4*)(lds + PG8_SA(b, h) + aoff + m * 2048), hi_ = *(const PG8_LAS i32x4*)(lds + PG8_SA(b, h) + aoff + m * 2048 + 1024); \
            dst##8[m] = (i32x8){lo_[0], lo_[1], lo_[2], lo_[3], hi_[0], hi_[1], hi_[2], hi_[3]}; } \
        else { _Pragma("unroll") for (int k = 0; k < 2; ++k) dst[m][k] = *(const PG8_LAS bf16x8*)(lds + PG8_SA(b, h) + aoff + m * 2048 + k * 1024); } } } while (0)
#define PG8_LDB(dst, b, h) do { _Pragma("unroll") for (int n = 0; n < 2; ++n) { if constexpr (PREC == 2) { \
            const i32x4 lo_ = *(const PG8_LAS i32x4*)(lds + PG8_SB(b, h) + boff + n * 2048), hi_ = *(const PG8_LAS i32x4*)(lds + PG8_SB(b, h) + boff + n * 2048 + 1024); \
            dst##8[n] = (i32x8){lo_[0], lo_[1], lo_[2], lo_[3], hi_[0], hi_[1], hi_[2], hi_[3]}; } \
        else { _Pragma("unroll") for (int k = 0; k < 2; ++k) dst[n][k] = *(const PG8_LAS bf16x8*)(lds + PG8_SB(b, h) + boff + n * 2048 + k * 1024); } } } while (0)
#define PG8_MMA(ai, bj, At, Bt) do { __builtin_amdgcn_s_setprio(1); _Pragma("unroll") for (int m = 0; m < 4; ++m) _Pragma("unroll") for (int n = 0; n < 2; ++n) { \
        if constexpr (PREC == 2) asm volatile("s_nop 1\n\tv_mfma_scale_f32_16x16x128_f8f6f4 %0, %1, %2, %0, %3, %3 op_sel_hi:[0,0,0]" : "+v"(acc[ai][bj][m][n]) : "v"(Bt##8[n]), "v"(At##8[m]), "v"(one_scale));   \
        else { _Pragma("unroll") for (int k = 0; k < 2; ++k) { \
            if constexpr (PREC == 1) acc[ai][bj][m][n] = __builtin_amdgcn_mfma_i32_16x16x64_i8(__builtin_bit_cast(i32x4, Bt[n][k]), __builtin_bit_cast(i32x4, At[m][k]), acc[ai][bj][m][n], 0, 0, 0); \
            else acc[ai][bj][m][n] = __builtin_amdgcn_mfma_f32_16x16x32_bf16(Bt[n][k], At[m][k], acc[ai][bj][m][n], 0, 0, 0); } } } __builtin_amdgcn_s_setprio(0); } while (0)
#define PG8_WAIT_V(n) asm volatile("s_waitcnt vmcnt(" #n ")" ::: "memory")
#define PG8_WAIT_L(n) asm volatile("s_waitcnt lgkmcnt(" #n ")" ::: "memory")
#define PG8_BAR __builtin_amdgcn_s_barrier()
#define PG8_SCHED __builtin_amdgcn_sched_barrier(0)
#define PG8_MKOFF(u, o) do { _Pragma("unroll") for (int _h = 0; _h < 2; ++_h) _Pragma("unroll") for (int _i = 0; _i < 2; ++_i) { \
        int _row = (u).pm * BM + _h * HALF + Rr[_i]; if (MODE == 1) _row = mi.list[_row]; (o)[_h][_i] = (unsigned)_row * rowb + (unsigned)Cc[_i] * 2u; } } while (0)
#define PG8_BBASE(u) ((const char*)g.Bt + (size_t)(u).pn * tstep + (MODE != 0 ? (size_t)mi.tile_expert[(u).pm] * mi.bstride : (size_t)0))
    Unit cur, nxt; int ui = 0;
    if (!S.next(0, cur)) return;
#if PG8_STAGGER
    {
        const int grp = ((int)blockIdx.x >> 3) & 3;
        if (grp) { if (wid == 0) { const unsigned long long t0 = __builtin_amdgcn_s_memrealtime(); const unsigned long long dt = (unsigned long long)(grp * nt * PG8_STAGGER);
                       while (__builtin_amdgcn_s_memrealtime() - t0 < dt) __builtin_amdgcn_s_sleep(8); }
                   __syncthreads(); }
    }
#endif
    typedef typename AccT<PREC>::type acc_t;
    acc_t acc[2][2][4][2];
#pragma unroll
    for (int a = 0; a < 2; ++a)
#pragma unroll
        for (int b = 0; b < 2; ++b)
#pragma unroll
            for (int m = 0; m < 4; ++m)
#pragma unroll
                for (int n = 0; n < 2; ++n) acc[a][b][m][n] = acc_t{};
    bf16x8 At[4][2], B0[2][2], B1[2][2];
    const int one_scale = 0x7f7f7f7f;
    unsigned oc[2][2], on[2][2];
    const char* const Ab = (const char*)g.A;
    const char* cAu = Ab;
    if constexpr (MODE == 1) { PG8_MKOFF(cur, oc); } else { Unit u0_; u0_.pm = 0; u0_.pn = 0; PG8_MKOFF(u0_, oc); cAu = Ab + (size_t)cur.pm * tstep; }
    const char* cB = PG8_BBASE(cur);
    S.a_ready(cur);
    static_assert(SP2, "only the SP2 loop is kept");
    {
        PG8_STAGE(PG8_SB(0, 0), cB, voffB); PG8_STAGE(PG8_SB(0, 1), cB + hstep, voffB); PG8_STAGE(PG8_SA(0, 0), cAu, oc[0]); PG8_STAGE(PG8_SA(0, 1), cAu, oc[1]);
        if (wr == 1) PG8_BAR;
        PG8_WAIT_V(2); PG8_BAR;
        PG8_STAGE(PG8_SB(1, 0), cB + kstep, voffB); PG8_STAGE(PG8_SA(1, 0), cAu + kstep, oc[0]); PG8_STAGE(PG8_SB(1, 1), cB + hstep + kstep, voffB);
        PG8_WAIT_V(6); PG8_BAR;
    }
    Unit nn; unsigned onn[2][2]; bool has_next_c = false;
    if constexpr (MODE == 1) { has_next_c = S.next(1, nxt); if (has_next_c) PG8_MKOFF(nxt, on); }
    for (;;) {
        bool has_next; bool has_nn = false;
        if constexpr (MODE == 1) { has_next = has_next_c; has_nn = has_next && S.next(ui + 2, nn); if (has_nn) PG8_MKOFF(nn, onn); }
        else has_next = S.next(ui + 1, nxt);
        const char* nB = cB; const char* nAu = cAu;
        if (has_next) { if constexpr (MODE != 1) nAu = Ab + (size_t)nxt.pm * tstep; nB = PG8_BBASE(nxt); }
        else if constexpr (MODE == 1) {
#pragma unroll
            for (int _h = 0; _h < 2; ++_h)
#pragma unroll
                for (int _i = 0; _i < 2; ++_i) on[_h][_i] = oc[_h][_i];
        }
        for (int t = 0; t < nt; t += 2) {
            const bool last = (t == nt - 2);
            i32x8 At8[4], B08[2], B18[2];
            const char* a1 = cAu + (size_t)(t + 1) * kstep;
            const char* a2 = last ? nAu : cAu + (size_t)(t + 2) * kstep; const char* b2 = last ? nB : cB + (size_t)(t + 2) * kstep;
            const char* a3 = a2 + kstep; const char* b3 = b2 + kstep;
            unsigned o2[2][2];
#pragma unroll
            for (int _h = 0; _h < 2; ++_h)
#pragma unroll
                for (int _i = 0; _i < 2; ++_i) o2[_h][_i] = (MODE == 1 && last) ? on[_h][_i] : oc[_h][_i];
            if (last && has_next) S.a_ready(nxt);
            PG8_LDB(B0, 0, 0); PG8_LDB(B1, 0, 1); PG8_SCHED; PG8_LDA(At, 0, 0); PG8_STAGE(PG8_SA(1, 1), a1, oc[1]);
            PG8_WAIT_V(8); PG8_WAIT_L(0); PG8_BAR; PG8_MMA(0, 0, At, B0); PG8_MMA(0, 1, At, B1); PG8_BAR; PG8_SCHED;
            PG8_LDA(At, 0, 1); PG8_STAGE(PG8_SB(0, 0), b2, voffB); PG8_STAGE(PG8_SB(0, 1), b2 + hstep, voffB); PG8_STAGE(PG8_SA(0, 0), a2, o2[0]);
            PG8_WAIT_V(8); PG8_WAIT_L(0); PG8_BAR; PG8_MMA(1, 0, At, B0); PG8_MMA(1, 1, At, B1); PG8_BAR; PG8_SCHED;
            PG8_LDB(B0, 1, 0); PG8_LDB(B1, 1, 1); PG8_SCHED; PG8_LDA(At, 1, 0); PG8_STAGE(PG8_SA(0, 1), a2, o2[1]);
            PG8_WAIT_V(8); PG8_WAIT_L(0); PG8_BAR; PG8_MMA(0, 0, At, B0); PG8_MMA(0, 1, At, B1); PG8_BAR; PG8_SCHED;
            PG8_LDA(At, 1, 1); PG8_STAGE(PG8_SB(1, 0), b3, voffB); PG8_STAGE(PG8_SB(1, 1), b3 + hstep, voffB); PG8_STAGE(PG8_SA(1, 0), a3, o2[0]);
            PG8_WAIT_V(8); PG8_WAIT_L(0); PG8_BAR; PG8_MMA(1, 0, At, B0); PG8_MMA(1, 1, At, B1); PG8_BAR; PG8_SCHED;
        }
        if constexpr (ALIGN_EPI) { if (wr == 0) PG8_BAR; }
        if constexpr (PREC == 2) asm volatile("s_nop 15\n\ts_nop 15" ::: "memory");
        E(acc, cur, wr, wc, fr, fq); S.done(cur);
        if (!has_next) break;
#pragma unroll
        for (int a = 0; a < 2; ++a)
#pragma unroll
            for (int b = 0; b < 2; ++b)
#pragma unroll
                for (int m = 0; m < 4; ++m)
#pragma unroll
                    for (int n = 0; n < 2; ++n) acc[a][b][m][n] = acc_t{};
        cur = nxt; cB = nB; cAu = nAu; ++ui;
        if constexpr (MODE == 1) {
#pragma unroll
            for (int _h = 0; _h < 2; ++_h)
#pragma unroll
                for (int _i = 0; _i < 2; ++_i) oc[_h][_i] = on[_h][_i]; }
        if constexpr (MODE == 1) { nxt = nn; has_next_c = has_nn;
#pragma unroll
            for (int _h = 0; _h < 2; ++_h)
#pragma unroll
                for (int _i = 0; _i < 2; ++_i) on[_h][_i] = onn[_h][_i]; }
        if constexpr (ALIGN_EPI) { if (wr == 1) PG8_BAR; }
    }
    PG8_WAIT_V(0);
    if constexpr (!ALIGN_EPI) { if (wr == 0) PG8_BAR; }
    PG8_BAR;
#undef PG8_SA
#undef PG8_SB
#undef PG8_STAGE
#undef PG8_LDA
#undef PG8_LDB
#undef PG8_MMA
#undef PG8_WAIT_V
#undef PG8_WAIT_L
#undef PG8_BAR
#undef PG8_SCHED
#undef PG8_MKOFF
#undef PG8_BBASE
}
}
namespace pg8 {
constexpr float LOG2E = 1.4426950408889634f;
struct EpiBf16 {
    static constexpr bool PERM = true;
    bf16_t* O; int ldc; float scale;
    __device__ __forceinline__ void operator()(const f32x4 (&acc)[2][2][4][2], const Unit& u, int wr, int wc, int fr, int fq) const {
        const int row0 = u.pm * BM + wr * 64 + fr; const int col0 = u.pn * BM + wc * 32 + 8 * fq;
#pragma unroll
        for (int ai = 0; ai < 2; ++ai)
#pragma unroll
            for (int m = 0; m < 4; ++m) { bf16_t* rowp = O + (size_t)(row0 + ai * HALF + m * 16) * ldc + col0;
#pragma unroll
                for (int bj = 0; bj < 2; ++bj) { const f32x4 v0 = acc[ai][bj][m][0] * scale, v1 = acc[ai][bj][m][1] * scale;
                    u32x4 w; w.x = cvt_pk_bf16(v0[0], v0[1]); w.y = cvt_pk_bf16(v0[2], v0[3]); w.z = cvt_pk_bf16(v1[0], v1[1]); w.w = cvt_pk_bf16(v1[2], v1[3]);
                    *(u32x4*)(rowp + bj * HALF) = w; } }
    }
};
struct EpiQ {
    static constexpr bool PERM = true;
    bf16_t* O; int ldc; float scale; const float* cs;
    __device__ __forceinline__ void operator()(const f32x4 (&acc)[2][2][4][2], const Unit& u, int wr, int wc, int fr, int fq) const {
        const int row0 = u.pm * BM + wr * 64 + fr; const int col0 = u.pn * BM + wc * 32 + 8 * fq;
        const int grp = u.pn * 8 + wc;
#pragma unroll
        for (int bj = 0; bj < 2; ++bj) { const bool rope = ((grp + 4 * bj) % 3) == 2;
#pragma unroll
            for (int ai = 0; ai < 2; ++ai)
#pragma unroll
                for (int m = 0; m < 4; ++m) { const int row = row0 + ai * HALF + m * 16; bf16_t* rowp = O + (size_t)row * ldc + col0 + bj * HALF;
                    f32x4 v0 = acc[ai][bj][m][0] * scale, v1 = acc[ai][bj][m][1] * scale;
                    if (rope) { const f32x4* cp = (const f32x4*)(cs + (size_t)row * 32 + 8 * fq); const f32x4 c0 = cp[0], c1 = cp[1];
                        f32x4 r0, r1;
                        r0[0] = v0[0] * c0[0] - v0[1] * c0[1]; r0[1] = v0[0] * c0[1] + v0[1] * c0[0];
                        r0[2] = v0[2] * c0[2] - v0[3] * c0[3]; r0[3] = v0[2] * c0[3] + v0[3] * c0[2];
                        r1[0] = v1[0] * c1[0] - v1[1] * c1[1]; r1[1] = v1[0] * c1[1] + v1[1] * c1[0];
                        r1[2] = v1[2] * c1[2] - v1[3] * c1[3]; r1[3] = v1[2] * c1[3] + v1[3] * c1[2];
                        v0 = r0; v1 = r1; }
                    u32x4 w; w.x = cvt_pk_bf16(v0[0], v0[1]); w.y = cvt_pk_bf16(v0[2], v0[3]); w.z = cvt_pk_bf16(v1[0], v1[1]); w.w = cvt_pk_bf16(v1[2], v1[3]);
                    *(u32x4*)rowp = w;
                    if (m & 1) asm volatile("" ::: "memory"); } }
    }
};
struct EpiKV {
    static constexpr bool PERM = true;
    bf16_t* Kb; bf16_t* Vb;
    __device__ __forceinline__ void operator()(const f32x4 (&acc)[2][2][4][2], const Unit& u, int wr, int wc, int fr, int fq) const {
        const int row0 = u.pm * BM + wr * 64 + fr;
        const bool isk = wc < 2;
        bf16_t* const base = isk ? Kb : Vb; const int pitch = isk ? 1536 : 1024, hs = isk ? 96 : 64, j0 = (isk ? wc : wc - 2) * 32 + 8 * fq;
#pragma unroll
        for (int ai = 0; ai < 2; ++ai)
#pragma unroll
            for (int m = 0; m < 4; ++m) { bf16_t* rowp = base + (size_t)(row0 + ai * HALF + m * 16) * pitch + j0;
#pragma unroll
                for (int bj = 0; bj < 2; ++bj) { const f32x4 v0 = acc[ai][bj][m][0], v1 = acc[ai][bj][m][1];
                    u32x4 w; w.x = cvt_pk_bf16(v0[0], v0[1]); w.y = cvt_pk_bf16(v0[2], v0[3]); w.z = cvt_pk_bf16(v1[0], v1[1]); w.w = cvt_pk_bf16(v1[2], v1[3]);
                    *(u32x4*)(rowp + (2 * u.pn + bj) * hs) = w; } }
    }
};
template <bool BASEF32> struct EpiResid {
    static constexpr bool PERM = true;
    static constexpr int HP = 2048;
    const void* base; bf16_t* out; const float* gate; const float* sB;
    __device__ __forceinline__ void operator()(const f32x4 (&acc)[2][2][4][2], const Unit& u, int wr, int wc, int fr, int fq) const {
        const int row0 = u.pm * BM + wr * 64 + fr; const int col0 = u.pn * BM + wc * 32 + 8 * fq;
        const float* gp = gate + (size_t)((u.pm * BM) >> 13) * 1024 + col0;
        f32x4 gv[2][2];
#pragma unroll
        for (int bj = 0; bj < 2; ++bj)
#pragma unroll
            for (int n = 0; n < 2; ++n) { gv[bj][n] = *(const f32x4*)(gp + bj * HALF + n * 4); if (sB) gv[bj][n] = gv[bj][n] * *(const f32x4*)(sB + col0 + bj * HALF + n * 4); }
#pragma unroll
        for (int ai = 0; ai < 2; ++ai)
#pragma unroll
            for (int m = 0; m < 4; ++m) { const size_t row = (size_t)(row0 + ai * HALF + m * 16);
#pragma unroll
                for (int bj = 0; bj < 2; ++bj) { f32x4 b0, b1;
                    if (BASEF32) { const float* bp = (const float*)base + row * 1024 + col0 + bj * HALF; b0 = *(const f32x4*)bp; b1 = *(const f32x4*)(bp + 4); }
                    else { const u32x4 hb = *(const u32x4*)((const bf16_t*)base + row * HP + col0 + bj * HALF);
                        b0 = (f32x4){__builtin_bit_cast(float, hb.x << 16), __builtin_bit_cast(float, hb.x & 0xffff0000u), __builtin_bit_cast(float, hb.y << 16), __builtin_bit_cast(float, hb.y & 0xffff0000u)};
                        b1 = (f32x4){__builtin_bit_cast(float, hb.z << 16), __builtin_bit_cast(float, hb.z & 0xffff0000u), __builtin_bit_cast(float, hb.w << 16), __builtin_bit_cast(float, hb.w & 0xffff0000u)}; }
                    const f32x4 v0 = b0 + gv[bj][0] * acc[ai][bj][m][0], v1 = b1 + gv[bj][1] * acc[ai][bj][m][1];
                    u32x4 w; w.x = cvt_pk_bf16(v0[0], v0[1]); w.y = cvt_pk_bf16(v0[2], v0[3]); w.z = cvt_pk_bf16(v1[0], v1[1]); w.w = cvt_pk_bf16(v1[2], v1[3]);
                    *(u32x4*)(out + row * HP + col0 + bj * HALF) = w; }
                if (m & 1) asm volatile("" ::: "memory"); }
    }
};
__device__ __forceinline__ float silu_mul(float g, float u) { return g * u * __builtin_amdgcn_rcpf(1.0f + __builtin_amdgcn_exp2f(-g * LOG2E)); }
struct EpiSwiGLU {
    static constexpr bool PERM = true;
    bf16_t* O; int ldc;
    __device__ __forceinline__ void operator()(const f32x4 (&acc)[2][2][4][2], const Unit& u, int wr, int wc, int fr, int fq) const {
        const int row0 = u.pm * BM + wr * 64 + fr; const int col0 = u.pn * HALF + wc * 32 + 8 * fq;
#pragma unroll
        for (int ai = 0; ai < 2; ++ai)
#pragma unroll
            for (int m = 0; m < 4; ++m) { bf16_t* rowp = O + (size_t)(row0 + ai * HALF + m * 16) * ldc + col0;
                const f32x4 g0 = acc[ai][0][m][0], g1 = acc[ai][0][m][1], u0 = acc[ai][1][m][0], u1 = acc[ai][1][m][1];
                u32x4 w; w.x = cvt_pk_bf16(silu_mul(g0[0], u0[0]), silu_mul(g0[1], u0[1])); w.y = cvt_pk_bf16(silu_mul(g0[2], u0[2]), silu_mul(g0[3], u0[3]));
                w.z = cvt_pk_bf16(silu_mul(g1[0], u1[0]), silu_mul(g1[1], u1[1])); w.w = cvt_pk_bf16(silu_mul(g1[2], u1[2]), silu_mul(g1[3], u1[3]));
                *(u32x4*)rowp = w; }
    }
};
struct EpiMoeDown {
    static constexpr bool PERM = true;
    bf16_t* O; const float* sg; const float* sB; const int* tile_expert;
    __device__ __forceinline__ void operator()(const f32x4 (&acc)[2][2][4][2], const Unit& u, int wr, int wc, int fr, int fq) const {
        const int row0 = u.pm * BM + wr * 64 + fr; const int col0 = u.pn * BM + wc * 32 + 8 * fq;
        const float* sb = sB + (size_t)tile_expert[u.pm] * 1024 + col0;
        f32x4 sv[2][2];
#pragma unroll
        for (int bj = 0; bj < 2; ++bj)
#pragma unroll
            for (int n = 0; n < 2; ++n) sv[bj][n] = *(const f32x4*)(sb + bj * HALF + 4 * n);
#pragma unroll
        for (int ai = 0; ai < 2; ++ai)
#pragma unroll
            for (int m = 0; m < 4; ++m) { const int row = row0 + ai * HALF + m * 16; const float s = sg[row]; bf16_t* rowp = O + (size_t)row * 1024 + col0;
#pragma unroll
                for (int bj = 0; bj < 2; ++bj) { const f32x4 v0 = acc[ai][bj][m][0] * sv[bj][0] * s, v1 = acc[ai][bj][m][1] * sv[bj][1] * s;
                    u32x4 w; w.x = cvt_pk_bf16(v0[0], v0[1]); w.y = cvt_pk_bf16(v0[2], v0[3]); w.z = cvt_pk_bf16(v1[0], v1[1]); w.w = cvt_pk_bf16(v1[2], v1[3]);
                    *(u32x4*)(rowp + bj * HALF) = w; } }
    }
};
template <bool KV> struct EpiDil {
    static constexpr bool PERM = true;
    bf16_t* O; float scale;
    __device__ __forceinline__ void operator()(const f32x4 (&acc)[2][2][4][2], const Unit& u, int wr, int wc, int fr, int fq) const {
        const int row0 = u.pm * BM + wr * 64 + fr;
#pragma unroll
        for (int bj = 0; bj < 2; ++bj) { const int col = u.pn * BM + bj * HALF + wc * 32 + 8 * fq;
            const int g = KV ? (col >> 10) : (col >> 9), h = (col >> 6) & 7, d = col & 63, kv = KV ? ((col >> 9) & 1) : 0;
            const int sh = 2 * g;
#pragma unroll
            for (int ai = 0; ai < 2; ++ai)
#pragma unroll
                for (int m = 0; m < 4; ++m) { const int row = row0 + ai * HALF + m * 16, b = row >> 13, t = row & 8191;
                    const int r = t & ((1 << sh) - 1), pos = t >> sh;
                    const size_t rec = (size_t)g * 262144 + (size_t)((((b << sh) + r) * 8 + h) * (8192 >> sh) + pos);
                    bf16_t* dst = KV ? (O + rec * 128 + kv * 64 + d) : (O + rec * 64 + d);
                    const f32x4 v0 = acc[ai][bj][m][0] * scale, v1 = acc[ai][bj][m][1] * scale;
                    u32x4 w; w.x = cvt_pk_bf16(v0[0], v0[1]); w.y = cvt_pk_bf16(v0[2], v0[3]); w.z = cvt_pk_bf16(v1[0], v1[1]); w.w = cvt_pk_bf16(v1[2], v1[3]);
                    *(u32x4*)dst = w; } }
    }
};
}
namespace pg8 {
__device__ __forceinline__ f32x4 i2f(const i32x4& a, float sa, const f32x4& sb) { return (f32x4){(float)a[0], (float)a[1], (float)a[2], (float)a[3]} * sa * sb; }
struct EpiBf16Q {
    static constexpr bool PERM = true;
    bf16_t* O; int ldc; const float* sA; const float* sB;
    __device__ __forceinline__ void operator()(const i32x4 (&acc)[2][2][4][2], const Unit& u, int wr, int wc, int fr, int fq) const {
        const int row0 = u.pm * BM + wr * 64 + fr; const int col0 = u.pn * BM + wc * 32 + 8 * fq;
        f32x4 sb[2][2];
#pragma unroll
        for (int bj = 0; bj < 2; ++bj)
#pragma unroll
            for (int n = 0; n < 2; ++n) sb[bj][n] = *(const f32x4*)(sB + col0 + bj * HALF + 4 * n);
#pragma unroll
        for (int ai = 0; ai < 2; ++ai)
#pragma unroll
            for (int m = 0; m < 4; ++m) { const int row = row0 + ai * HALF + m * 16; const float sa = sA[row]; bf16_t* rowp = O + (size_t)row * ldc + col0;
#pragma unroll
                for (int bj = 0; bj < 2; ++bj) { const f32x4 v0 = i2f(acc[ai][bj][m][0], sa, sb[bj][0]), v1 = i2f(acc[ai][bj][m][1], sa, sb[bj][1]);
                    u32x4 w; w.x = cvt_pk_bf16(v0[0], v0[1]); w.y = cvt_pk_bf16(v0[2], v0[3]); w.z = cvt_pk_bf16(v1[0], v1[1]); w.w = cvt_pk_bf16(v1[2], v1[3]);
                    *(u32x4*)(rowp + bj * HALF) = w; } }
    }
};
template <bool KV> struct EpiDilQ {
    static constexpr bool PERM = true;
    bf16_t* O; const float* sA; const float* sB;
    __device__ __forceinline__ void operator()(const i32x4 (&acc)[2][2][4][2], const Unit& u, int wr, int wc, int fr, int fq) const {
        bf16_t* const O_ = O; constexpr float scale_ = KV ? 1.0f : 0.18033688011112042f; const float* const sA_ = sA; const float* const sB_ = sB;
        const int row0 = u.pm * BM + wr * 64 + fr;
        const int colt = u.pn * BM;
        const int g = KV ? (colt >> 10) : (colt >> 9), kv = KV ? ((colt >> 9) & 1) : 0, sh = 2 * g, npos = 8192 >> sh;
        constexpr int RS = KV ? 128 : 64;
        const int d = (wc & 1) * 32 + 8 * fq;
        size_t hoff[2]; f32x4 sb[2][2];
#pragma unroll
        for (int bj = 0; bj < 2; ++bj) { const int col = colt + bj * HALF + wc * 32 + 8 * fq; const int h = (col >> 6) & 7;
            hoff[bj] = (size_t)h * npos * RS + kv * 64 + d; sb[bj][0] = *(const f32x4*)(sB_ + col) * scale_; sb[bj][1] = *(const f32x4*)(sB_ + col + 4) * scale_; }
#pragma unroll
        for (int ai = 0; ai < 2; ++ai)
#pragma unroll
            for (int m = 0; m < 4; ++m) { const int row = row0 + ai * HALF + m * 16, b = row >> 13, t = row & 8191;
                const int r = t & ((1 << sh) - 1), pos = t >> sh;
                bf16_t* rp = O_ + ((size_t)g * 262144 + (size_t)(((b << sh) + r) * 8 * npos + pos)) * RS;
                const float sa = sA_[row];
#pragma unroll
                for (int bj = 0; bj < 2; ++bj) { const f32x4 v0 = i2f(acc[ai][bj][m][0], sa, sb[bj][0]), v1 = i2f(acc[ai][bj][m][1], sa, sb[bj][1]);
                    u32x4 w; w.x = cvt_pk_bf16(v0[0], v0[1]); w.y = cvt_pk_bf16(v0[2], v0[3]); w.z = cvt_pk_bf16(v1[0], v1[1]); w.w = cvt_pk_bf16(v1[2], v1[3]);
                    *(u32x4*)(rp + hoff[bj]) = w; }
                if (m & 1) asm volatile("" ::: "memory"); }
    }
};
constexpr float HSCALE = 8.0f;
__device__ __forceinline__ unsigned pk4_fp8(float a, float b, float c, float d) {
    a = __builtin_fminf(__builtin_fmaxf(a, -448.f), 448.f); b = __builtin_fminf(__builtin_fmaxf(b, -448.f), 448.f); c = __builtin_fminf(__builtin_fmaxf(c, -448.f), 448.f); d = __builtin_fminf(__builtin_fmaxf(d, -448.f), 448.f);
    int w = 0; w = __builtin_amdgcn_cvt_pk_fp8_f32(a, b, w, false); w = __builtin_amdgcn_cvt_pk_fp8_f32(c, d, w, true); return (unsigned)w; }
struct EpiSwiGLUQ {
    static constexpr bool PERM = true;
    unsigned char* O; int ldc; const float* sA; const float* sB; const int* list; const int* tile_expert;
    __device__ __forceinline__ void operator()(const i32x4 (&acc)[2][2][4][2], const Unit& u, int wr, int wc, int fr, int fq) const {
        const int row0 = u.pm * BM + wr * 64 + fr; const int col0 = u.pn * HALF + wc * 32 + 8 * fq;
        const float* sb = sB + (tile_expert ? (size_t)tile_expert[u.pm] * (2 * 2816) : (size_t)0) + u.pn * BM + wc * 32 + 8 * fq;
        const f32x4 sg0 = *(const f32x4*)sb, sg1 = *(const f32x4*)(sb + 4), su0 = *(const f32x4*)(sb + HALF) * HSCALE, su1 = *(const f32x4*)(sb + HALF + 4) * HSCALE;
        typedef unsigned u32x2 __attribute__((ext_vector_type(2)));
#pragma unroll
        for (int ai = 0; ai < 2; ++ai)
#pragma unroll
            for (int m = 0; m < 4; ++m) { const int row = row0 + ai * HALF + m * 16; const float sa = sA[list ? list[row] : row]; unsigned char* rowp = O + (size_t)row * ldc + col0;
                const f32x4 g0 = i2f(acc[ai][0][m][0], sa, sg0), g1 = i2f(acc[ai][0][m][1], sa, sg1), u0 = i2f(acc[ai][1][m][0], sa, su0), u1 = i2f(acc[ai][1][m][1], sa, su1);
                u32x2 w; w.x = pk4_fp8(silu_mul(g0[0], u0[0]), silu_mul(g0[1], u0[1]), silu_mul(g0[2], u0[2]), silu_mul(g0[3], u0[3]));
                w.y = pk4_fp8(silu_mul(g1[0], u1[0]), silu_mul(g1[1], u1[1]), silu_mul(g1[2], u1[2]), silu_mul(g1[3], u1[3]));
                *(u32x2*)rowp = w; }
    }
};
}
namespace att {
using bf16 = unsigned short;
using bf16x8 = __attribute__((ext_vector_type(8))) short;
using s16x4 = __attribute__((ext_vector_type(4))) short;
using f32x16 = __attribute__((ext_vector_type(16))) float;
using u32x4 = __attribute__((ext_vector_type(4))) unsigned;
constexpr int NW = 8;
constexpr float THR = 8.0f;
__device__ __forceinline__ int crow(int r, int hi) { return (r & 3) + 8 * (r >> 2) + 4 * hi; }
__device__ __forceinline__ void glds16(const void* gsrc, unsigned lds_dst) { unsigned keep;
    asm volatile("s_mov_b32 %0, m0\n\ts_mov_b32 m0, %2\n\ts_nop 0\n\tglobal_load_lds_dwordx4 %1, off\n\ts_mov_b32 m0, %0" : "=&s"(keep) : "v"(gsrc), "s"(lds_dst) : "memory"); }
typedef float f32x2_t __attribute__((ext_vector_type(2))); typedef __bf16 bf16x2_t __attribute__((ext_vector_type(2)));
__device__ __forceinline__ unsigned cvtpk_s(float lo, float hi) { f32x2_t v = {lo, hi}; bf16x2_t b = __builtin_convertvector(v, bf16x2_t); return __builtin_bit_cast(unsigned, b); }
#define ATT_SBAR() __builtin_amdgcn_sched_barrier(0)
#define ATT_WAIT_BAR(N) asm volatile("s_waitcnt vmcnt(" #N ") lgkmcnt(0)\n\ts_barrier" ::: "memory")

template <int DQK> struct Lay {
    static constexpr int NKC = DQK / 8, KSLOT = NKC * 1024, ND0 = DQK / 16;
    static constexpr int LK = 0, LV = 3 * KSLOT, LWS = LV + 3 * 8192, LOST = LWS + NW * 256, LBIAS = LOST + NW * 4096, LEND = LBIAS + 1024;
};
static_assert(Lay<96>::LEND <= 131072 && Lay<64>::LEND <= 131072, "attention LDS");

__device__ __forceinline__ float rowmax32(const f32x16& p0, const f32x16& p1) {
    float a = __builtin_fmaxf(__builtin_fmaxf(p0[0], p0[1]), p1[0]), b = __builtin_fmaxf(__builtin_fmaxf(p0[2], p0[3]), p1[1]); a = __builtin_fmaxf(__builtin_fmaxf(a, p1[2]), p1[3]);
#pragma unroll
    for (int r = 4; r < 16; r += 4) { a = __builtin_fmaxf(__builtin_fmaxf(a, p0[r]), p0[r + 1]); b = __builtin_fmaxf(__builtin_fmaxf(b, p0[r + 2]), p0[r + 3]); a = __builtin_fmaxf(__builtin_fmaxf(a, p1[r]), p1[r + 1]); b = __builtin_fmaxf(__builtin_fmaxf(b, p1[r + 2]), p1[r + 3]); }
    float m = __builtin_fmaxf(a, b);
    auto rr = __builtin_amdgcn_permlane32_swap(__float_as_uint(m), __float_as_uint(m), false, false);
    return __builtin_fmaxf(__uint_as_float(rr[0]), __uint_as_float(rr[1]));
}
__device__ __forceinline__ void pv(f32x16* o, int vb, bf16x8 pa0, bf16x8 pa1, bf16x8 pa2, bf16x8 pa3) {
#pragma unroll
    for (int d0 = 0; d0 < 2; ++d0) { s16x4 lo[4], hi[4];
#pragma unroll
        for (int ks = 0; ks < 4; ++ks) {
            asm volatile("ds_read_b64_tr_b16 %0,%1 offset:%c2" : "=&v"(lo[ks]) : "v"(vb), "i"(d0 * 4096 + ks * 1024) : "memory");
            asm volatile("ds_read_b64_tr_b16 %0,%1 offset:%c2" : "=&v"(hi[ks]) : "v"(vb), "i"(d0 * 4096 + ks * 1024 + 512) : "memory"); }
        asm volatile("s_waitcnt lgkmcnt(0)" ::: "memory"); ATT_SBAR();
#define ATT_PK(k) (bf16x8){lo[k][0], lo[k][1], lo[k][2], lo[k][3], hi[k][0], hi[k][1], hi[k][2], hi[k][3]}
        o[d0] = __builtin_amdgcn_mfma_f32_32x32x16_bf16(pa0, ATT_PK(0), o[d0], 0, 0, 0);
        o[d0] = __builtin_amdgcn_mfma_f32_32x32x16_bf16(pa1, ATT_PK(1), o[d0], 0, 0, 0);
        o[d0] = __builtin_amdgcn_mfma_f32_32x32x16_bf16(pa2, ATT_PK(2), o[d0], 0, 0, 0);
        o[d0] = __builtin_amdgcn_mfma_f32_32x32x16_bf16(pa3, ATT_PK(3), o[d0], 0, 0, 0);
#undef ATT_PK
    }
}

template <int DQK, bool DIL>
__device__ __forceinline__ void attn_unit(const bf16* Qb, int pq, const bf16* __restrict__ Kb, int pk, const bf16* __restrict__ Vb, int pvp, bf16* Ob, int po, float* lse, const float* biasg,
                                          long rowbase, int dil, int q0, char* shm) {
    typedef Lay<DQK> L;
    const int tid = threadIdx.x, lane = tid & 63, r32 = lane & 31, hi = lane >> 5; const int wid = __builtin_amdgcn_readfirstlane(tid >> 6);
    const unsigned lds0 = (unsigned)(uintptr_t)shm;
    float* wsf = (float*)(shm + L::LWS) + wid * 64;
    const int kpos0 = DIL ? q0 - 128 : 0;
    const int t_begin = DIL ? (q0 == 0 ? 2 : 0) : 0;
    const int t_end = DIL ? 6 : (q0 + 256) / 64;
    const int wt0 = DIL ? (wid >> 1) : 0;
    const int wt1 = DIL ? 2 + (wid >> 1) : (q0 + 32 * wid + 31) / 64;
    const bool two_k = (L::NKC > 8) && (wid + 8 < L::NKC);
#define ATT_GROW(pos) (rowbase + (long)(pos) * dil)
#define ATT_ISSUE(t, s) do { const int kp_ = kpos0 + 64 * (t); \
        glds16(Kb + ATT_GROW(kp_ + lane) * pk + wid * 8, (unsigned)__builtin_amdgcn_readfirstlane(lds0 + L::LK + (s) * L::KSLOT + wid * 1024)); \
        if (two_k) glds16(Kb + ATT_GROW(kp_ + lane) * pk + (wid + 8) * 8, (unsigned)__builtin_amdgcn_readfirstlane(lds0 + L::LK + (s) * L::KSLOT + (wid + 8) * 1024)); \
        glds16(Vb + ATT_GROW(kp_ + 16 * (wid & 3) + (lane >> 2)) * pvp + (wid >> 2) * 32 + (lane & 3) * 8, (unsigned)__builtin_amdgcn_readfirstlane(lds0 + L::LV + (s) * 8192 + wid * 1024)); } while (0)
    if (DIL) { if (tid < 129) ((float*)(shm + L::LBIAS))[tid] = biasg[tid]; }
    ATT_ISSUE(t_begin, 0);
    if (t_begin + 1 < t_end) ATT_ISSUE(t_begin + 1, 1);
    bf16x8 qr[L::ND0];
    { const bf16* Qw = Qb + ATT_GROW(q0 + wid * 32 + r32) * pq + hi * 8;
#pragma unroll
      for (int d0 = 0; d0 < L::ND0; ++d0) qr[d0] = *reinterpret_cast<const bf16x8*>(Qw + d0 * 16); }
    float mhat = 0.f, l_reg = 0.f; f32x16 o[2]; o[0] = f32x16{}; o[1] = f32x16{}; f32x16 negm = f32x16{};
    bool first = true;
    const int qrel = (DIL ? 128 : q0) + wid * 32 + r32;
    const int vbl = (int)(lds0 + L::LV) + ((lane >> 4) & 1) * 32 + (lane & 3) * 8 + (4 * hi + ((lane & 15) >> 2)) * 64;
    int slot = 0;
    for (int t = t_begin; t < t_end; ++t) {
        if (t + 1 < t_end) { if (two_k) ATT_WAIT_BAR(3); else ATT_WAIT_BAR(2); } else ATT_WAIT_BAR(0);
        if (t + 2 < t_end) { const int s2 = slot >= 1 ? slot - 1 : 2; ATT_ISSUE(t + 2, s2); }
        if (t >= wt0 && t <= wt1) {
            f32x16 p0, p1;
            { const char* kb = shm + L::LK + slot * L::KSLOT + hi * 1024 + r32 * 16;
#pragma unroll
              for (int d0 = 0; d0 < L::ND0; ++d0) {
                const bf16x8 b0 = *reinterpret_cast<const bf16x8*>(kb + d0 * 2048);
                const bf16x8 b1 = *reinterpret_cast<const bf16x8*>(kb + d0 * 2048 + 512);
                if (d0 == 0) { p0 = __builtin_amdgcn_mfma_f32_32x32x16_bf16(b0, qr[0], negm, 0, 0, 0); p1 = __builtin_amdgcn_mfma_f32_32x32x16_bf16(b1, qr[0], negm, 0, 0, 0); }
                else { p0 = __builtin_amdgcn_mfma_f32_32x32x16_bf16(b0, qr[d0], p0, 0, 0, 0); p1 = __builtin_amdgcn_mfma_f32_32x32x16_bf16(b1, qr[d0], p1, 0, 0, 0); } } }
            if (DIL) { const float* bl = (const float*)(shm + L::LBIAS); const int jb = qrel - 64 * t - 4 * hi;
#pragma unroll
                for (int r = 0; r < 16; ++r) { const int j0 = jb - ((r & 3) + 8 * (r >> 2)), j1 = j0 - 32;
                    const int c0 = j0 < 0 ? 0 : (j0 > 128 ? 128 : j0), c1 = j1 < 0 ? 0 : (j1 > 128 ? 128 : j1);
                    const float b0 = bl[c0], b1 = bl[c1];
                    p0[r] = (j0 >= 0 && j0 <= 128) ? p0[r] + b0 : -INFINITY; p1[r] = (j1 >= 0 && j1 <= 128) ? p1[r] + b1 : -INFINITY; }
            } else if (64 * t + 63 > q0 + 32 * wid) { const int jb = qrel - 64 * t - 4 * hi;
#pragma unroll
                for (int r = 0; r < 16; ++r) { const int j0 = jb - ((r & 3) + 8 * (r >> 2)); if (j0 < 0) p0[r] = -INFINITY; if (j0 - 32 < 0) p1[r] = -INFINITY; } }
            const float rm = rowmax32(p0, p1);
            if (first) { first = false; const float dl = rm; mhat += dl;
#pragma unroll
                for (int r = 0; r < 16; ++r) { p0[r] -= dl; p1[r] -= dl; }
#pragma unroll
                for (int r = 0; r < 16; ++r) negm[r] = -mhat;
            } else if (__any(rm > THR)) { const float dl = __builtin_fmaxf(rm, 0.f); mhat += dl;
#pragma unroll
                for (int r = 0; r < 16; ++r) { p0[r] -= dl; p1[r] -= dl; }
#pragma unroll
                for (int r = 0; r < 16; ++r) negm[r] = -mhat;
                const float f = __builtin_amdgcn_exp2f(-dl); l_reg *= f; if (hi == 0) wsf[r32] = f;
                asm volatile("s_waitcnt lgkmcnt(0)" ::: "memory");
#pragma unroll
                for (int d_ = 0; d_ < 2; ++d_)
#pragma unroll
                    for (int r = 0; r < 16; ++r) o[d_][r] *= wsf[crow(r, hi)];
                asm volatile("s_waitcnt lgkmcnt(0)" ::: "memory");
            }
            float sacc = 0.f;
#pragma unroll
            for (int r = 0; r < 16; ++r) { p0[r] = __builtin_amdgcn_exp2f(p0[r]); p1[r] = __builtin_amdgcn_exp2f(p1[r]); sacc += p0[r] + p1[r]; }
            l_reg += sacc;
            u32x4 pw0, pw1, pw2, pw3;
#define ATT_PKW(P, B) cvtpk_s(P[B], P[B + 1])
            pw0 = (u32x4){ATT_PKW(p0, 0), ATT_PKW(p0, 2), ATT_PKW(p0, 4), ATT_PKW(p0, 6)}; pw1 = (u32x4){ATT_PKW(p0, 8), ATT_PKW(p0, 10), ATT_PKW(p0, 12), ATT_PKW(p0, 14)};
            pw2 = (u32x4){ATT_PKW(p1, 0), ATT_PKW(p1, 2), ATT_PKW(p1, 4), ATT_PKW(p1, 6)}; pw3 = (u32x4){ATT_PKW(p1, 8), ATT_PKW(p1, 10), ATT_PKW(p1, 12), ATT_PKW(p1, 14)};
#undef ATT_PKW
            ATT_SBAR();
            pv(o, vbl + slot * 8192, __builtin_bit_cast(bf16x8, pw0), __builtin_bit_cast(bf16x8, pw1), __builtin_bit_cast(bf16x8, pw2), __builtin_bit_cast(bf16x8, pw3));
        }
        slot = slot == 2 ? 0 : slot + 1;
    }
    { auto rr = __builtin_amdgcn_permlane32_swap(__float_as_uint(l_reg), __float_as_uint(l_reg), false, false); l_reg = __uint_as_float(rr[0]) + __uint_as_float(rr[1]); }
    if (hi == 0) wsf[32 + r32] = l_reg;
    asm volatile("s_waitcnt lgkmcnt(0)" ::: "memory");
    float rli[16];
#pragma unroll
    for (int r = 0; r < 16; ++r) rli[r] = __builtin_amdgcn_rcpf(wsf[32 + crow(r, hi)]);
    if (DIL) { if (hi == 0) lse[ATT_GROW(q0 + wid * 32 + r32) * 8] = mhat + __builtin_amdgcn_logf(l_reg); }
    { bf16* stg = (bf16*)(shm + L::LOST) + wid * 2048;
#pragma unroll
      for (int r = 0; r < 16; ++r) { const int orow = crow(r, hi);
#pragma unroll
        for (int d0 = 0; d0 < 2; ++d0) stg[orow * 64 + d0 * 32 + r32] = (bf16)(cvtpk_s(o[d0][r] * rli[r], 0.f) & 0xffffu); }
      asm volatile("s_waitcnt lgkmcnt(0)" ::: "memory");
#pragma unroll
      for (int i = 0; i < 4; ++i) { const int row = i * 8 + (lane >> 3), ch = lane & 7; const u32x4 v = *(const u32x4*)(stg + row * 64 + ch * 8);
        *(u32x4*)(Ob + ATT_GROW(q0 + wid * 32 + row) * po + ch * 8) = v; } }
    asm volatile("s_waitcnt lgkmcnt(0)\n\ts_barrier" ::: "memory");
#undef ATT_GROW
#undef ATT_ISSUE
}
#undef ATT_SBAR
#undef ATT_WAIT_BAR
}
namespace mla {
using bf16 = unsigned short;
using bf16x8 = __attribute__((ext_vector_type(8))) short;
using s16x4 = __attribute__((ext_vector_type(4))) short;
using f32x16 = __attribute__((ext_vector_type(16))) float;
using u32x4 = __attribute__((ext_vector_type(4))) unsigned;
constexpr int SEQL = 8192, PQ = 1536, PV = 1024, HQ = 96, HV = 64;
constexpr int NW = 8, QBLK = 32, QB = QBLK * NW, KVBLK = 64;
__device__ __forceinline__ int crow(int r, int hi) { return (r & 3) + 8 * (r >> 2) + 4 * hi; }
#define SBAR() __builtin_amdgcn_sched_barrier(0)
__device__ __forceinline__ void cmask(f32x16& p0, f32x16& p1, int jb, int qrel, int hi) {
    const float NEG = -INFINITY; int kb = 64 * jb + 4 * hi;
#pragma unroll
    for (int r = 0; r < 16; ++r) { int kv = kb + (r & 3) + 8 * (r >> 2); if (kv > qrel) p0[r] = NEG; if (kv + 32 > qrel) p1[r] = NEG; }
}
constexpr int NSLOT = 3, KSLOTB = 12288, VSLOTB = 8192;
constexpr int LDS_K = 0, LDS_V = NSLOT * KSLOTB, LDS_WS = LDS_V + NSLOT * VSLOTB, LDS_OST = LDS_WS + NW * 64 * 4, LDS_BYTES = LDS_OST + NW * 4096;
static_assert(LDS_BYTES <= 131072, "mla attention LDS");
__device__ __forceinline__ void glds16(const void* gsrc, unsigned lds_dst) { unsigned keep;
    asm volatile("s_mov_b32 %0, m0\n\ts_mov_b32 m0, %2\n\ts_nop 0\n\tglobal_load_lds_dwordx4 %1, off\n\ts_mov_b32 m0, %0" : "=&s"(keep) : "v"(gsrc), "s"(lds_dst) : "memory"); }
__device__ __forceinline__ float max3f(float a, float b, float c) { float r; asm("v_max3_f32 %0, %1, %2, %3" : "=v"(r) : "v"(a), "v"(b), "v"(c)); return r; }
__device__ __forceinline__ float max2f(float a, float b) { float r; asm("v_max_f32_e32 %0, %1, %2" : "=v"(r) : "v"(a), "v"(b)); return r; }
__device__ __forceinline__ float fadd_s(float a, float b) { float r; asm("v_add_f32_e32 %0, %1, %2" : "=v"(r) : "v"(a), "v"(b)); return r; }
__device__ __forceinline__ float fsub_s(float a, float b) { float r; asm("v_sub_f32_e32 %0, %1, %2" : "=v"(r) : "v"(a), "v"(b)); return r; }
typedef float f32x2_t __attribute__((ext_vector_type(2))); typedef __bf16 bf16x2_t __attribute__((ext_vector_type(2)));
__device__ __forceinline__ unsigned cvtpk_s(float lo, float hi) { f32x2_t v = {lo, hi}; bf16x2_t b = __builtin_convertvector(v, bf16x2_t); return __builtin_bit_cast(unsigned, b); }
#define WAIT_BAR(N) asm volatile("s_waitcnt vmcnt(" #N ") lgkmcnt(0)\n\ts_barrier" ::: "memory")

__device__ __forceinline__ void qkt(f32x16& p0, f32x16& p1, const char* Kslot, const bf16x8* qr, const f32x16& negm, int r32, int hi) {
    const char* kb = Kslot + hi * 1024 + r32 * 16;
#pragma unroll
    for (int d0 = 0; d0 < 6; ++d0) {
        const bf16x8 b0 = *reinterpret_cast<const bf16x8*>(kb + d0 * 2048);
        const bf16x8 b1 = *reinterpret_cast<const bf16x8*>(kb + d0 * 2048 + 512);
        if (d0 == 0) { p0 = __builtin_amdgcn_mfma_f32_32x32x16_bf16(b0, qr[0], negm, 0, 0, 0); p1 = __builtin_amdgcn_mfma_f32_32x32x16_bf16(b1, qr[0], negm, 0, 0, 0); }
        else { p0 = __builtin_amdgcn_mfma_f32_32x32x16_bf16(b0, qr[d0], p0, 0, 0, 0); p1 = __builtin_amdgcn_mfma_f32_32x32x16_bf16(b1, qr[d0], p1, 0, 0, 0); } }
}
typedef __attribute__((address_space(3))) const char* lds_cptr;
typedef short v4i16_t __attribute__((ext_vector_type(4)));
__device__ __forceinline__ void kload12(bf16x8* kf, lds_cptr kp) {
#pragma unroll
    for (int j = 0; j < 6; ++j) { kf[2 * j] = *(const __attribute__((address_space(3))) bf16x8*)(kp + j * 2048); kf[2 * j + 1] = *(const __attribute__((address_space(3))) bf16x8*)(kp + j * 2048 + 512); }
}
__device__ __forceinline__ void kload2(bf16x8* kf, lds_cptr kp, int j) { kf[2 * j] = *(const __attribute__((address_space(3))) bf16x8*)(kp + j * 2048); kf[2 * j + 1] = *(const __attribute__((address_space(3))) bf16x8*)(kp + j * 2048 + 512); }
__device__ __forceinline__ s16x4 vtr(lds_cptr p) { return __builtin_bit_cast(s16x4, __builtin_amdgcn_ds_read_tr16_b64_v4i16((__attribute__((address_space(3))) v4i16_t*)p)); }
__device__ __forceinline__ float rowmax(const f32x16& p0, const f32x16& p1) {
    float a = max3f(p0[0], p0[1], p1[0]), b = max3f(p0[2], p0[3], p1[1]); a = max3f(a, p1[2], p1[3]);
#pragma unroll
    for (int r = 4; r < 16; r += 4) { a = max3f(a, p0[r], p0[r + 1]); b = max3f(b, p0[r + 2], p0[r + 3]); a = max3f(a, p1[r], p1[r + 1]); b = max3f(b, p1[r + 2], p1[r + 3]); }
    const float m = max2f(a, b);
    auto rr = __builtin_amdgcn_permlane32_swap(__float_as_uint(m), __float_as_uint(m), false, false);
    return max2f(__uint_as_float(rr[0]), __uint_as_float(rr[1]));
}
__device__ __forceinline__ void pv(f32x16* o, int vb, bf16x8 pa0, bf16x8 pa1, bf16x8 pa2, bf16x8 pa3) {
#pragma unroll
    for (int d0 = 0; d0 < 2; ++d0) { s16x4 lo[4], hi[4];
#pragma unroll
        for (int ks = 0; ks < 4; ++ks) {
            asm volatile("ds_read_b64_tr_b16 %0,%1 offset:%c2" : "=&v"(lo[ks]) : "v"(vb), "i"(d0 * 4096 + ks * 1024) : "memory");
            asm volatile("ds_read_b64_tr_b16 %0,%1 offset:%c2" : "=&v"(hi[ks]) : "v"(vb), "i"(d0 * 4096 + ks * 1024 + 512) : "memory"); }
        asm volatile("s_waitcnt lgkmcnt(0)" ::: "memory"); SBAR();
#define PK(k) (bf16x8){lo[k][0], lo[k][1], lo[k][2], lo[k][3], hi[k][0], hi[k][1], hi[k][2], hi[k][3]}
        o[d0] = __builtin_amdgcn_mfma_f32_32x32x16_bf16(pa0, PK(0), o[d0], 0, 0, 0);
        o[d0] = __builtin_amdgcn_mfma_f32_32x32x16_bf16(pa1, PK(1), o[d0], 0, 0, 0);
        o[d0] = __builtin_amdgcn_mfma_f32_32x32x16_bf16(pa2, PK(2), o[d0], 0, 0, 0);
        o[d0] = __builtin_amdgcn_mfma_f32_32x32x16_bf16(pa3, PK(3), o[d0], 0, 0, 0);
#undef PK
    }
}

template <int THRL> __device__ __forceinline__ void attn_unit(int b, int h, int qb, const bf16* Q, const bf16* __restrict__ K, const bf16* __restrict__ V, bf16* O, char* shm) {
    int tid_ = threadIdx.x; asm volatile("" : "+v"(tid_));
    const int tid = tid_, lane = tid & 63, r32 = lane & 31, hi = lane >> 5; const int wid = __builtin_amdgcn_readfirstlane(tid >> 6);
    const long rowbase = (long)b * SEQL; const int q0 = qb * QB;
    const bf16* Qw = Q + (rowbase + q0 + wid * QBLK) * PQ + h * HQ;
    const bf16* Kh = K + rowbase * PQ + h * HQ; const bf16* Vh = V + rowbase * PV + h * HV;
    const unsigned lds0 = (unsigned)(uintptr_t)shm;
    float* wsf = (float*)(shm + LDS_WS) + wid * 64;
    const bool k2 = wid < 4;
    const bf16* ksrc = Kh + (long)lane * PQ + wid * 8;
    const bf16* vsrc = Vh + (long)(16 * (wid & 3) + (lane >> 2)) * PV + (wid >> 2) * 32 + (lane & 3) * 8;
    const unsigned kdst = lds0 + LDS_K + wid * 1024, vdst = lds0 + LDS_V + wid * 1024;
#define DMA_K(t, slot) do { glds16(ksrc + (long)(t) * KVBLK * PQ, (unsigned)__builtin_amdgcn_readfirstlane(kdst + (slot))); \
        if (k2) glds16(ksrc + (long)(t) * KVBLK * PQ + 64, (unsigned)__builtin_amdgcn_readfirstlane(kdst + (slot) + 8192)); } while (0)
#define DMA_V(t, slot) glds16(vsrc + (long)(t) * KVBLK * PV, (unsigned)__builtin_amdgcn_readfirstlane(vdst + (slot)))
    const int vb0 = (int)(lds0 + LDS_V) + ((lane >> 4) & 1) * 32 + (lane & 3) * 8 + (4 * hi + ((lane & 15) >> 2)) * 64;
    const char* Kbase = shm + LDS_K; bf16x8 kf[12];
    const lds_cptr shm3 = (lds_cptr)shm; const lds_cptr kp0 = shm3 + LDS_K + hi * 1024 + r32 * 16; const lds_cptr vp0 = shm3 + LDS_V + ((lane >> 4) & 1) * 32 + (lane & 3) * 8 + (4 * hi + ((lane & 15) >> 2)) * 64;
    const int NT = (q0 + QB) / KVBLK;
#define WAIT_KV() do { if (k2) WAIT_BAR(3); else WAIT_BAR(2); } while (0)
#define WAIT_KKV() do { if (k2) WAIT_BAR(5); else WAIT_BAR(3); } while (0)
    DMA_K(0, 0); DMA_V(0, 0); DMA_K(1, KSLOTB);
    bf16x8 qr[6];
#pragma unroll
    for (int d0 = 0; d0 < 6; ++d0) qr[d0] = *reinterpret_cast<const bf16x8*>(&Qw[(long)r32 * PQ + d0 * 16 + hi * 8]);
    float mhat = 0.f, l_reg = 0.f; f32x16 o[2]; o[0] = f32x16{}; o[1] = f32x16{}; f32x16 negm = f32x16{}; asm volatile("" : "+v"(negm));
    const int qrel = wid * QBLK + r32;
#define CMASK(P0, P1, t) do { int jb_ = (t) - (NT - 4); if (jb_ >= 0) cmask(P0, P1, jb_, qrel, hi); } while (0)
    bool resc = false;
#define START(P0, P1) do { const float rm = rowmax(P0, P1); resc = false; \
    { const float dl = rm; mhat = fadd_s(mhat, dl); \
      _Pragma("unroll") for (int r = 0; r < 16; ++r) { P0[r] = fsub_s(P0[r], dl); P1[r] = fsub_s(P1[r], dl); } \
      _Pragma("unroll") for (int r = 0; r < 16; ++r) negm[r] = -mhat; asm volatile("" : "+v"(negm)); } \
    _Pragma("unroll") for (int r = 0; r < 16; ++r) P0[r] = __builtin_amdgcn_exp2f(P0[r]); } while (0)
#define RESC() do { if (resc) { asm volatile("s_waitcnt lgkmcnt(0)" ::: "memory"); \
      _Pragma("unroll") for (int d_ = 0; d_ < 2; ++d_) _Pragma("unroll") for (int r = 0; r < 16; ++r) o[d_][r] *= wsf[crow(r, hi)]; } } while (0)
    f32x16 pA0, pA1, pB0, pB1;
    int sl_prev = 0, sl_cur = 0, sl_next = 1;
#define ROT() do { sl_prev = sl_cur; sl_cur = sl_next; sl_next = (sl_next == NSLOT - 1) ? 0 : sl_next + 1; } while (0)
    DMA_K(2, 2 * KSLOTB);
    WAIT_KKV();
    qkt(pA0, pA1, Kbase, qr, negm, r32, hi); asm volatile("s_nop 15\n\ts_nop 7" : "+v"(pA0), "+v"(pA1)); CMASK(pA0, pA1, 0);
    START(pA0, pA1);
#pragma unroll
    for (int r = 0; r < 16; ++r) pA1[r] = __builtin_amdgcn_exp2f(pA1[r]);
    WAIT_BAR(0);
    DMA_K(3, 0); DMA_V(1, VSLOTB);
    ROT();
    kload12(kf, kp0 + sl_cur * KSLOTB);
    WAIT_KV();
    s16x4 vlo[8], vhi[8]; u32x4 pw0, pw1, pw2, pw3;
#define PKW(P, B) cvtpk_s(P[B], P[B + 1])
#define PAF(k) __builtin_bit_cast(bf16x8, pw##k)
#define VFR(i) (bf16x8){vlo[i][0], vlo[i][1], vlo[i][2], vlo[i][3], vhi[i][0], vhi[i][1], vhi[i][2], vhi[i][3]}
#define PIN(x) asm volatile("" : "+v"(x))
#define MX3(a, b, c) __builtin_fmaxf(__builtin_fmaxf((a), (b)), (c))
#define GAPA(MF, A0, A1, A2, A3, W0, W1, PW) do { MF; sacc += A0; sacc += A1; sacc += A2; sacc += A3; PIN(sacc); W0; W1; PIN(PW); SBAR(); } while (0)
#define GAPM(MF) do { MF; SBAR(); } while (0)
#define EX(v) __builtin_amdgcn_exp2f(v)
#define GAPB(MF, X, B) do { MF; X[B] = EX(X[B]); X[B + 1] = EX(X[B + 1]); X[B + 2] = EX(X[B + 2]); X[B + 3] = EX(X[B + 3]); PIN(X); SBAR(); } while (0)
#define VRD(i) do { vlo[i] = vtr(vp_ + (((i) >> 2) * 4096 + ((i) & 3) * 1024)); vhi[i] = vtr(vp_ + (((i) >> 2) * 4096 + ((i) & 3) * 1024 + 512)); } while (0)
#define KRD(G, j) do { if (G) { kload2(kf, kp0 + sl_next * KSLOTB, j); SBAR(); } } while (0)
#define MF32(a, b, c) __builtin_amdgcn_mfma_f32_32x32x16_bf16(a, b, c, 0, 0, 0)
#define STEP(C0, C1, P0, P1, t, GK, GV, GL) do { SBAR(); \
    const lds_cptr vp_ = vp0 + sl_prev * VSLOTB; \
    float sacc = (P0[0] + P0[1]); \
    GAPA(C0 = MF32(kf[0], qr[0], negm), P0[2], P0[3], P0[4], P0[5],     pw0[0] = PKW(P0, 0), pw0[1] = PKW(P0, 2), pw0); \
    GAPA(C1 = MF32(kf[1], qr[0], negm), P0[6], P0[7], P0[8], P0[9],     pw0[2] = PKW(P0, 4), pw0[3] = PKW(P0, 6), pw0); \
    GAPA(C0 = MF32(kf[2], qr[1], C0),   P0[10], P0[11], P0[12], P0[13], pw1[0] = PKW(P0, 8), pw1[1] = PKW(P0, 10), pw1); \
    GAPA(C1 = MF32(kf[3], qr[1], C1),   P0[14], P0[15], P1[0], P1[1],   pw1[2] = PKW(P0, 12), pw1[3] = PKW(P0, 14), pw1); \
    VRD(0); SBAR(); GAPA(C0 = MF32(kf[4], qr[2], C0),   P1[2], P1[3], P1[4], P1[5],     pw2[0] = PKW(P1, 0), pw2[1] = PKW(P1, 2), pw2); \
    VRD(4); SBAR(); GAPA(C1 = MF32(kf[5], qr[2], C1),   P1[6], P1[7], P1[8], P1[9],     pw2[2] = PKW(P1, 4), pw2[3] = PKW(P1, 6), pw2); \
    VRD(1); SBAR(); GAPA(C0 = MF32(kf[6], qr[3], C0),   P1[10], P1[11], P1[12], P1[13], pw3[0] = PKW(P1, 8), pw3[1] = PKW(P1, 10), pw3); \
    VRD(5); SBAR(); GAPA(C1 = MF32(kf[7], qr[3], C1),   P1[14], P1[15], 0.f, 0.f,       pw3[2] = PKW(P1, 12), pw3[3] = PKW(P1, 14), pw3); \
    VRD(2); SBAR(); GAPM(C0 = MF32(kf[8], qr[4], C0)); VRD(6); SBAR(); GAPM(C1 = MF32(kf[9], qr[4], C1)); \
    VRD(3); SBAR(); GAPM(C0 = MF32(kf[10], qr[5], C0)); VRD(7); SBAR(); GAPM(C1 = MF32(kf[11], qr[5], C1)); \
    l_reg += sacc; \
    if (GK) { DMA_K((t) + 3, sl_cur * KSLOTB); } if (GV) { DMA_V((t) + 1, sl_next * VSLOTB); } \
    CMASK(C0, C1, t); \
    { float a = MX3(C0[0], C0[1], C1[0]), b = MX3(C0[2], C0[3], C1[1]); a = MX3(a, C1[2], C1[3]); \
      _Pragma("unroll") for (int r = 4; r < 16; r += 4) { a = MX3(a, C0[r], C0[r + 1]); b = MX3(b, C0[r + 2], C0[r + 3]); a = MX3(a, C1[r], C1[r + 1]); b = MX3(b, C1[r + 2], C1[r + 3]); } \
      float rm = __builtin_fmaxf(a, b); { auto rr = __builtin_amdgcn_permlane32_swap(__float_as_uint(rm), __float_as_uint(rm), false, false); rm = __builtin_fmaxf(__uint_as_float(rr[0]), __uint_as_float(rr[1])); } \
      resc = false; \
      if (__builtin_expect(__any(rm > (float)THRL), 0)) { const float dl = __builtin_fmaxf(rm, 0.f); mhat += dl; \
        _Pragma("unroll") for (int r = 0; r < 16; ++r) { C0[r] -= dl; C1[r] -= dl; } \
        _Pragma("unroll") for (int r = 0; r < 16; ++r) negm[r] = -mhat; asm volatile("" : "+v"(negm)); \
        const float f = __builtin_amdgcn_exp2f(-dl); l_reg *= f; if (hi == 0) wsf[r32] = f; resc = true; } } \
    SBAR(); \
    GAPB(o[0] = MF32(PAF(0), VFR(0), o[0]), C0, 0); \
    KRD(GL, 0); GAPB(o[1] = MF32(PAF(0), VFR(4), o[1]), C0, 4); \
    KRD(GL, 1); GAPB(o[0] = MF32(PAF(1), VFR(1), o[0]), C0, 8); \
    KRD(GL, 2); GAPB(o[1] = MF32(PAF(1), VFR(5), o[1]), C0, 12); \
    KRD(GL, 3); GAPB(o[0] = MF32(PAF(2), VFR(2), o[0]), C1, 0); \
    KRD(GL, 4); GAPB(o[1] = MF32(PAF(2), VFR(6), o[1]), C1, 4); \
    KRD(GL, 5); GAPB(o[0] = MF32(PAF(3), VFR(3), o[0]), C1, 8); \
    GAPB(o[1] = MF32(PAF(3), VFR(7), o[1]), C1, 12); \
    } while (0)
    int t = 1;
#undef CMASK
#define CMASK(P0, P1, t) do { } while (0)
    for (; t + 5 < NT; t += 2) {
        STEP(pB0, pB1, pA0, pA1, t, true, true, true);     WAIT_KV(); RESC(); ROT();
        STEP(pA0, pA1, pB0, pB1, t + 1, true, true, true); WAIT_KV(); RESC(); ROT();
    }
#undef CMASK
#define CMASK(P0, P1, t) do { int jb_ = (t) - (NT - 4); if (jb_ >= 0) cmask(P0, P1, jb_, qrel, hi); } while (0)
#define ENDW(tt) do { if ((tt) + 3 < NT) { WAIT_KV(); } else if ((tt) + 2 < NT) { WAIT_BAR(1); } else { WAIT_BAR(0); } } while (0)
    for (; t + 1 < NT; t += 2) {
        STEP(pB0, pB1, pA0, pA1, t, (t + 3 < NT), (t + 1 < NT), (t + 1 < NT));         ENDW(t);     RESC(); ROT();
        STEP(pA0, pA1, pB0, pB1, t + 1, (t + 4 < NT), (t + 2 < NT), (t + 2 < NT));     ENDW(t + 1); RESC(); ROT();
    }
    STEP(pB0, pB1, pA0, pA1, NT - 1, false, false, false); RESC();
    { float sacc = pB0[0] + pB0[1];
#pragma unroll
      for (int r = 2; r < 16; ++r) sacc += pB0[r];
#pragma unroll
      for (int r = 0; r < 16; ++r) sacc += pB1[r];
      l_reg += sacc;
      pw0 = (u32x4){PKW(pB0, 0), PKW(pB0, 2), PKW(pB0, 4), PKW(pB0, 6)}; pw1 = (u32x4){PKW(pB0, 8), PKW(pB0, 10), PKW(pB0, 12), PKW(pB0, 14)}; pw2 = (u32x4){PKW(pB1, 0), PKW(pB1, 2), PKW(pB1, 4), PKW(pB1, 6)}; pw3 = (u32x4){PKW(pB1, 8), PKW(pB1, 10), PKW(pB1, 12), PKW(pB1, 14)};
      SBAR(); pv(o, vb0 + sl_cur * VSLOTB, PAF(0), PAF(1), PAF(2), PAF(3)); }
#undef PKW
#undef PAF
#undef VFR
#undef PIN
#undef MX3
#undef GAPA
#undef GAPM
#undef GAPB
#undef EX
#undef VRD
#undef KRD
#undef MF32
#undef STEP
#undef ENDW
    { auto rr = __builtin_amdgcn_permlane32_swap(__float_as_uint(l_reg), __float_as_uint(l_reg), false, false); l_reg = __uint_as_float(rr[0]) + __uint_as_float(rr[1]); }
    if (hi == 0) wsf[32 + r32] = l_reg; asm volatile("s_waitcnt lgkmcnt(0)" ::: "memory");
    float rli[16];
#pragma unroll
    for (int r = 0; r < 16; ++r) rli[r] = __builtin_amdgcn_rcpf(wsf[32 + crow(r, hi)]);
    bf16* Ow = O + (rowbase + q0 + wid * QBLK) * PV + h * HV;
    { bf16* stg = (bf16*)(shm + LDS_OST) + wid * 2048;
#pragma unroll
      for (int r = 0; r < 16; ++r) { const int orow = crow(r, hi);
#pragma unroll
        for (int d0 = 0; d0 < 2; ++d0) stg[orow * 64 + d0 * 32 + r32] = (bf16)(cvtpk_s(o[d0][r] * rli[r], 0.f) & 0xffffu); }
      asm volatile("s_waitcnt lgkmcnt(0)" ::: "memory");
#pragma unroll
      for (int i = 0; i < 4; ++i) { const int row = i * 8 + (lane >> 3), ch = lane & 7; const u32x4 v = *(const u32x4*)(stg + row * 64 + ch * 8); *(u32x4*)(Ow + (long)row * PV + ch * 8) = v; } }
    asm volatile("s_waitcnt lgkmcnt(0)\n\ts_barrier" ::: "memory");
#undef DMA_K
#undef DMA_V
#undef CMASK
#undef START
#undef RESC
#undef ROT
#undef WAIT_KV
#undef WAIT_KKV
}
#undef SBAR
#undef WAIT_BAR
}
namespace dila {
using bf16 = unsigned short;
using bf16x8 = __attribute__((ext_vector_type(8))) short;
using f32x16 = __attribute__((ext_vector_type(16))) float;
using u32x4 = __attribute__((ext_vector_type(4))) unsigned;
constexpr int NW = 8, SEQL = 8192, PQ = 1536, PKV = 3072, PO = 512, MROWS = 4 * SEQL;
constexpr int L_K = 0, L_V = 6 * 8192, L_WQ = 12 * 8192, L_WO = L_WQ + NW * 4096, L_WSF = L_WO + NW * 2048, L_BIAS = L_WSF + NW * 256, L_END = L_BIAS + 3 * 288 * 4;
constexpr float THR = 8.0f;
#define DIL_WAIT_BAR(N) asm volatile("s_waitcnt vmcnt(" #N ") lgkmcnt(0)\n\ts_barrier" ::: "memory")
struct UnitP { int sb, oo, lo, rowbase, dil, q0, g; };
__device__ __forceinline__ UnitP decode(int j, int h) {
    const int x = j & 31, bg = j >> 5; const int g = bg % 3, b = bg / 3;
    const int sh = 2 * g, dil = 1 << sh; const int r = x & (dil - 1), qb = x >> sh;
    UnitP p; p.sb = g * 262144 + ((b * dil + r) * 8 + h) * (SEQL >> sh); p.oo = g * MROWS * PO + h * 64; p.lo = g * MROWS * 8 + h;
    p.rowbase = b * SEQL + r; p.dil = dil; p.q0 = qb * 256; p.g = g; return p;
}

__device__ __forceinline__ void dil_phase(const bf16* QB, const bf16* KV, bf16* OG, float* LSE, const float* BT, char* shm, int G) {
    int tid_ = threadIdx.x; asm volatile("" : "+v"(tid_));
    const int tid = tid_, lane = tid & 63, r32 = lane & 31, hi = lane >> 5; const int wid = __builtin_amdgcn_readfirstlane(tid >> 6);
    const unsigned lds0 = (unsigned)(uintptr_t)shm;
    float* wsf = (float*)(shm + L_WSF) + wid * 64;
    char* wq = shm + L_WQ + wid * 4096;
    char* wo = shm + L_WO + wid * 2048;
    const int wt0 = wid >> 1, wt1 = 2 + (wid >> 1);
    const int G8 = G & ~7, c = (int)blockIdx.x;
    if (c >= G8) return;
    const int h = c & 7, j0 = c >> 3, jstep = G8 >> 3;
    const int NU = (384 - j0 + jstep - 1) / jstep;
    for (int i = tid; i < 3 * 288; i += NW * 64) ((float*)(shm + L_BIAS))[i] = BT[((i / 288) * 8 + h) * 288 + (i % 288)];
#define DIL_GROW(P, pos) ((long)((P).rowbase + (pos) * (P).dil))
#define DIL_ISSUE_TILE(P, t) do { int kp_ = (P).q0 - 128 + 64 * (t); if (kp_ < 0) kp_ = 0; \
        att::glds16(KV + (size_t)((P).sb + kp_ + lane) * 128 + wid * 8, (unsigned)__builtin_amdgcn_readfirstlane(lds0 + L_K + (t) * 8192 + wid * 1024)); \
        att::glds16(KV + (size_t)((P).sb + kp_ + 16 * (wid & 3) + (lane >> 2)) * 128 + 64 + (wid >> 2) * 32 + (lane & 3) * 8, (unsigned)__builtin_amdgcn_readfirstlane(lds0 + L_V + (t) * 8192 + wid * 1024)); } while (0)
#define DIL_ISSUE_Q(P) do { _Pragma("unroll") for (int j_ = 0; j_ < 4; ++j_) \
        att::glds16(QB + (size_t)((P).sb + (P).q0 + wid * 32 + 8 * j_ + (lane >> 3)) * 64 + (lane & 7) * 8, (unsigned)__builtin_amdgcn_readfirstlane(lds0 + L_WQ + wid * 4096 + j_ * 1024)); } while (0)
    if (NU <= 0) return;
    UnitP cur = decode(j0, h), nxt = cur;
    asm volatile("s_waitcnt vmcnt(0) lgkmcnt(0)\n\ts_barrier" ::: "memory");
    DIL_ISSUE_Q(cur); DIL_ISSUE_TILE(cur, 0); DIL_ISSUE_TILE(cur, 5); DIL_ISSUE_TILE(cur, 1); DIL_ISSUE_TILE(cur, 4);
    bf16x8 qr[4]; float mhat = 0.f, l_reg = 0.f; f32x16 o[2]; o[0] = f32x16{}; o[1] = f32x16{}; f32x16 negm = f32x16{}; bool first = true;
    const int vbl = (int)(lds0 + L_V) + ((lane >> 4) & 1) * 32 + (lane & 3) * 8 + (4 * hi + ((lane & 15) >> 2)) * 64;
    for (int ui = 0; ui < NU; ++ui) {
        const bool has_next = ui + 1 < NU;
        if (has_next) nxt = decode(j0 + (ui + 1) * jstep, h);
        const int tb = cur.q0 == 0 ? 2 : 0;
        const float* bl0 = (const float*)(shm + L_BIAS) + cur.g * 288 + (191 - (128 + 32 * (wid & 1) + r32 - 4 * hi));
#pragma unroll 1
        for (int k = 0; k < 3; ++k) {
            if (k < 2) DIL_WAIT_BAR(0); else DIL_WAIT_BAR(8);
            if (k == 0) { DIL_ISSUE_TILE(cur, 2); DIL_ISSUE_TILE(cur, 3); }
            else if (has_next) { if (k == 1) { DIL_ISSUE_Q(nxt); DIL_ISSUE_TILE(nxt, 0); DIL_ISSUE_TILE(nxt, 5); } else { DIL_ISSUE_TILE(nxt, 1); DIL_ISSUE_TILE(nxt, 4); } }
            const int t = wid < 4 ? wt0 + k : wt1 - k;
            if (k == 0) {
#pragma unroll
                for (int d0 = 0; d0 < 4; ++d0) qr[d0] = *reinterpret_cast<const bf16x8*>(wq + r32 * 128 + d0 * 32 + hi * 16);
                mhat = 0.f; l_reg = 0.f; o[0] = f32x16{}; o[1] = f32x16{}; negm = f32x16{}; first = true;
            }
            if (t >= tb) {
                f32x16 p0, p1;
                { const char* kb = shm + L_K + t * 8192 + hi * 1024 + r32 * 16;
#pragma unroll
                  for (int d0 = 0; d0 < 4; ++d0) {
                    const bf16x8 b0 = *reinterpret_cast<const bf16x8*>(kb + d0 * 2048);
                    const bf16x8 b1 = *reinterpret_cast<const bf16x8*>(kb + d0 * 2048 + 512);
                    if (d0 == 0) { p0 = __builtin_amdgcn_mfma_f32_32x32x16_bf16(b0, qr[0], negm, 0, 0, 0); p1 = __builtin_amdgcn_mfma_f32_32x32x16_bf16(b1, qr[0], negm, 0, 0, 0); }
                    else { p0 = __builtin_amdgcn_mfma_f32_32x32x16_bf16(b0, qr[d0], p0, 0, 0, 0); p1 = __builtin_amdgcn_mfma_f32_32x32x16_bf16(b1, qr[d0], p1, 0, 0, 0); } } }
                { const float* bl = bl0 + 64 * (t - wt0);
                  float bv0[16], bv1[16];
#pragma unroll
                  for (int r = 0; r < 16; ++r) { bv0[r] = bl[(r & 3) + 8 * (r >> 2)]; bv1[r] = bl[(r & 3) + 8 * (r >> 2) + 32]; }
#pragma unroll
                  for (int r = 0; r < 16; ++r) { p0[r] += bv0[r]; p1[r] += bv1[r]; } }
                const float rm = att::rowmax32(p0, p1);
                if (first) { first = false; const float dl = rm; mhat += dl;
#pragma unroll
                    for (int r = 0; r < 16; ++r) { p0[r] -= dl; p1[r] -= dl; }
#pragma unroll
                    for (int r = 0; r < 16; ++r) negm[r] = -mhat;
                } else if (__any(rm > THR)) { const float dl = __builtin_fmaxf(rm, 0.f); mhat += dl;
#pragma unroll
                    for (int r = 0; r < 16; ++r) { p0[r] -= dl; p1[r] -= dl; }
#pragma unroll
                    for (int r = 0; r < 16; ++r) negm[r] = -mhat;
                    const float f = __builtin_amdgcn_exp2f(-dl); l_reg *= f; if (hi == 0) wsf[r32] = f;
                    asm volatile("s_waitcnt lgkmcnt(0)" ::: "memory");
#pragma unroll
                    for (int d_ = 0; d_ < 2; ++d_)
#pragma unroll
                        for (int r = 0; r < 16; ++r) o[d_][r] *= wsf[att::crow(r, hi)];
                    asm volatile("s_waitcnt lgkmcnt(0)" ::: "memory");
                }
                float sacc = 0.f;
#pragma unroll
                for (int r = 0; r < 16; ++r) { p0[r] = __builtin_amdgcn_exp2f(p0[r]); p1[r] = __builtin_amdgcn_exp2f(p1[r]); sacc += p0[r] + p1[r]; }
                l_reg += sacc;
                u32x4 pw0, pw1, pw2, pw3;
#define DIL_PKW(P, B) att::cvtpk_s(P[B], P[B + 1])
                pw0 = (u32x4){DIL_PKW(p0, 0), DIL_PKW(p0, 2), DIL_PKW(p0, 4), DIL_PKW(p0, 6)}; pw1 = (u32x4){DIL_PKW(p0, 8), DIL_PKW(p0, 10), DIL_PKW(p0, 12), DIL_PKW(p0, 14)};
                pw2 = (u32x4){DIL_PKW(p1, 0), DIL_PKW(p1, 2), DIL_PKW(p1, 4), DIL_PKW(p1, 6)}; pw3 = (u32x4){DIL_PKW(p1, 8), DIL_PKW(p1, 10), DIL_PKW(p1, 12), DIL_PKW(p1, 14)};
#undef DIL_PKW
                __builtin_amdgcn_sched_barrier(0);
                att::pv(o, vbl + t * 8192, __builtin_bit_cast(bf16x8, pw0), __builtin_bit_cast(bf16x8, pw1), __builtin_bit_cast(bf16x8, pw2), __builtin_bit_cast(bf16x8, pw3));
            }
            if (k == 2) {
                { auto rr = __builtin_amdgcn_permlane32_swap(__float_as_uint(l_reg), __float_as_uint(l_reg), false, false); l_reg = __uint_as_float(rr[0]) + __uint_as_float(rr[1]); }
                if (hi == 0) wsf[32 + r32] = l_reg;
                asm volatile("s_waitcnt lgkmcnt(0)" ::: "memory");
                float rli[16];
#pragma unroll
                for (int r = 0; r < 16; ++r) rli[r] = __builtin_amdgcn_rcpf(wsf[32 + att::crow(r, hi)]);
                if (hi == 0) LSE[cur.lo + DIL_GROW(cur, cur.q0 + wid * 32 + r32) * 8] = mhat + __builtin_amdgcn_logf(l_reg);
                bf16* stg = (bf16*)wo;
#pragma unroll
                for (int d0 = 0; d0 < 2; ++d0) {
#pragma unroll
                    for (int r = 0; r < 16; ++r) stg[att::crow(r, hi) * 32 + r32] = (bf16)(att::cvtpk_s(o[d0][r] * rli[r], 0.f) & 0xffffu);
                    asm volatile("s_waitcnt lgkmcnt(0)" ::: "memory");
#pragma unroll
                    for (int i = 0; i < 2; ++i) { const int row = i * 16 + (lane >> 2), ch = lane & 3; const u32x4 v = *(const u32x4*)(stg + row * 32 + ch * 8);
                        *(u32x4*)(OG + cur.oo + DIL_GROW(cur, cur.q0 + wid * 32 + row) * PO + d0 * 32 + ch * 8) = v; }
                    asm volatile("s_waitcnt lgkmcnt(0)" ::: "memory"); }
            }
        }
        cur = nxt;
    }
    asm volatile("s_waitcnt vmcnt(0) lgkmcnt(0)\n\ts_barrier" ::: "memory");
#undef DIL_GROW
#undef DIL_ISSUE_TILE
#undef DIL_ISSUE_Q
}
#undef DIL_WAIT_BAR
}
constexpr int NWAVES = 8;
constexpr int BATCH = 4, SEQ = 8192, D = 1024, M = BATCH * SEQ;
constexpr int MLA_H = 16, QRANK = 384, KVRANK = 256, LATN = 672, LATP = 768, QUP = 1536, KVUP = 2048;
constexpr int DFF = 2816, NEXP = 8, DILQ = 1536, DILKV = 3072, DILOUT = 512;
constexpr int MAXSLOT = 67584;
constexpr float EPS = 1e-6f;
constexpr float C2_MLA = 0.1472444460259031f;
constexpr float C2_DIL = 0.18033688011112042f;
constexpr float LOG2E_F = 1.4426950408889634f;

constexpr size_t MiB = 1u << 20;
constexpr size_t WS_CTL = 0, CTL_ZERO_BYTES = 512 * 1024;
constexpr size_t WS_CM = 256 * 1024;
constexpr int CM_LAT = 0, CM_FGU = 672, CM_KVB = CM_FGU + 5632, CM_QB = CM_KVB + 3072, CM_EGU = CM_QB + 1536, CM_FDN = CM_EGU + 8 * 5632, CM_EDN = CM_FDN + 1024, CM_END = CM_EDN + 8 * 1024;
static_assert(WS_CM + (size_t)CM_END * 4 <= 512 * 1024, "column maxima inside the zeroed region");
constexpr size_t WS_MODV = 1 * MiB;
constexpr size_t WS_BIAS = 1 * MiB + 256 * 1024;
constexpr size_t WS_ROUTE = 1 * MiB + 512 * 1024;
constexpr size_t WS_CNT = 2 * MiB;
constexpr size_t WS_LIST = 2 * MiB + 256 * 1024;
constexpr size_t WS_SLOTG = 2 * MiB + 768 * 1024;
constexpr size_t WS_TOKSLOT = 3 * MiB + 256 * 1024;
constexpr size_t WS_TILEEXP = 3 * MiB + 768 * 1024;
constexpr size_t WS_CS = 4 * MiB;
constexpr size_t WS_LSE = 8 * MiB;
constexpr size_t WS_SB = 11 * MiB;
constexpr size_t SB_LAT = 0, SB_FGU = 768, SB_KVB = 768 + 5632, SB_QB = SB_KVB + 3072, SB_EGU = SB_QB + 1536, SB_FDN = SB_EGU + 8 * 5632, SB_EDN = SB_FDN + 1024, SB_END = SB_EDN + 8 * 1024;
constexpr size_t WS_XS = 11 * MiB + 512 * 1024, WS_XSKV = 11 * MiB + 768 * 1024;
constexpr size_t WS_WEGU = 12 * MiB, WS_WEDN = 100 * MiB, WS_WFGU = 144 * MiB, WS_WFDN = 155 * MiB, WS_WKVB = 161 * MiB, WS_WQB = 167 * MiB, WS_WOUT = 170 * MiB,
                 WS_WOB = 172 * MiB, WS_WMLAIN = 173 * MiB, WS_WQUP = 175 * MiB, WS_WKVUP = 177 * MiB;
constexpr size_t WS_ARENA = 180 * MiB;
constexpr size_t A_XN = WS_ARENA, A_LAT = WS_ARENA + 64 * MiB, A_QN = WS_ARENA + 112 * MiB, A_KVN = WS_ARENA + 136 * MiB, A_Q = WS_ARENA + 152 * MiB, A_K = WS_ARENA + 248 * MiB,
                 A_V = WS_ARENA + 344 * MiB, A_O = WS_ARENA + 408 * MiB, A_HID = WS_ARENA + 64 * MiB, A_XNKV = WS_ARENA + 64 * MiB, A_KVB = WS_ARENA + 128 * MiB, A_QB = WS_ARENA + 320 * MiB,
                 A_OG = WS_ARENA, A_OD = WS_ARENA + 128 * MiB, A_HIDS = WS_ARENA + 160 * MiB, A_Y = WS_ARENA;
constexpr size_t WS_END = WS_ARENA + 523 * MiB;
static_assert(A_HIDS + (size_t)MAXSLOT * DFF * 2 <= WS_END && A_Y + (size_t)MAXSLOT * D * 2 <= A_HIDS && A_O + (size_t)M * D * 2 <= WS_END, "arena map");
static_assert(WS_WEGU + (size_t)NEXP * 2 * DFF * D * 2 <= WS_WEDN && WS_WEDN + (size_t)NEXP * D * DFF * 2 <= WS_WFGU && WS_WFGU + (size_t)2 * DFF * D * 2 <= WS_WFDN && WS_WFDN + (size_t)D * DFF * 2 <= WS_WKVB, "weight map");
enum ModKind { MK_A_MIX0 = 0, MK_B_MIX0, MK_G_MIX0, MK_A_FFN0, MK_B_FFN0, MK_G_FFN0, MK_A_MIX1, MK_B_MIX1, MK_G_MIX1, MK_A_FFN1, MK_B_FFN1, MK_G_FFN1, MK_A_KV, MK_B_KV };
constexpr int CW_BAR = 4096;
constexpr int CW_RANK = 8192;

constexpr int RING_BYTES = 131072;
constexpr int LDS_BYTES = 163840;
constexpr int LDSCTL_OFF = LDS_BYTES - 1024, MISC_OFF = LDSCTL_OFF + 320;

#define GAS __attribute__((address_space(1)))
#define LAS __attribute__((address_space(3)))
typedef unsigned short bf16;
typedef signed char i8;
typedef unsigned v4u __attribute__((ext_vector_type(4)));
typedef unsigned v2u __attribute__((ext_vector_type(2)));
typedef float f32x4 __attribute__((ext_vector_type(4)));
typedef GAS unsigned gu32;
#define RLX_AGENT __ATOMIC_RELAXED, __HIP_MEMORY_SCOPE_AGENT
#define LDS_WAIT() asm volatile("s_waitcnt lgkmcnt(0)" ::: "memory")
#define VM_WAIT() asm volatile("s_waitcnt vmcnt(0)" ::: "memory")
__device__ __forceinline__ unsigned f2bf(float f) { unsigned u = __builtin_bit_cast(unsigned, f); return (u + 0x7fffu + ((u >> 16) & 1u)) >> 16; }
__device__ __forceinline__ unsigned pk2(float lo, float hi) { return f2bf(lo) | (f2bf(hi) << 16); }
__device__ __forceinline__ float bf_lo(unsigned w) { return __builtin_bit_cast(float, w << 16); }
__device__ __forceinline__ float bf_hi(unsigned w) { return __builtin_bit_cast(float, w & 0xffff0000u); }
__device__ __forceinline__ float wave_sum(float v) {
#pragma unroll
    for (int o = 1; o < 64; o <<= 1) v += __shfl_xor(v, o);
    return v;
}

#define XB_TMO      128
#define XB_XCNT(j)  (256  + 64 * (j))
#define XB_XSUB(j)  (1280 + 64 * (j))
#define XB_XGEN(j)  (2304 + 64 * (j))
#define XB_TOP      3328
#define XB_TOPGEN   3392
#define XCD_BAR_WORDS 3456
#define XB_SPIN_CAP (1u << 18)
__device__ __forceinline__ unsigned xb_ld(unsigned* p)              { return __hip_atomic_load(p, __ATOMIC_RELAXED, __HIP_MEMORY_SCOPE_AGENT); }
__device__ __forceinline__ unsigned xb_add(unsigned* p, unsigned v) { return __hip_atomic_fetch_add(p, v, __ATOMIC_RELAXED, __HIP_MEMORY_SCOPE_AGENT); }
__device__ __forceinline__ unsigned xb_xcc_id() { return (unsigned)__builtin_amdgcn_s_getreg((3 << 11) | 20) & 0xFu; }
#define XB_SPIN(cond, bar) do { unsigned _sp = 0; while (cond) { __builtin_amdgcn_s_sleep(1); \
    if ((++_sp & 255u) == 0u) { if (xb_ld(&(bar)[XB_TMO])) break; if (_sp > XB_SPIN_CAP) { atomicAdd(&(bar)[XB_TMO], 1u); break; } } } } while (0)
struct XcdBarrier { unsigned* bar; unsigned x; volatile LAS unsigned* st; };
__device__ __forceinline__ XcdBarrier xcd_barrier_post(unsigned* bar, volatile LAS unsigned* st) {
    XcdBarrier b; b.bar = bar; b.x = xb_xcc_id(); b.st = st;
    if (threadIdx.x == 0) (void)xb_add(&bar[XB_XCNT(b.x)], 1u);
    return b;
}
__device__ __forceinline__ void xcd_barrier_complete(unsigned* bar, unsigned x, unsigned& nloc, unsigned& nx) {
    const unsigned G = gridDim.x * gridDim.y * gridDim.z;
    unsigned sum, cnt, mine, sp = 0u;
    for (;;) {
        sum = 0u; cnt = 0u; mine = 0u;
#pragma unroll
        for (unsigned j = 0; j < 16; ++j) { const unsigned c = xb_ld(&bar[XB_XCNT(j)]); sum += c; cnt += (c > 0u) ? 1u : 0u; mine = (j == x) ? c : mine; }
        if (sum == G) break;
        __builtin_amdgcn_s_sleep(1);
        if ((++sp & 255u) == 0u) { if (xb_ld(&bar[XB_TMO])) break; if (sp > XB_SPIN_CAP) { atomicAdd(&bar[XB_TMO], 1u); break; } }
    }
    nloc = mine > 0u ? mine : 1u; nx = cnt > 0u ? cnt : 1u;
}
__device__ __forceinline__ void xcd_barrier(const XcdBarrier& b) {
    asm volatile("s_waitcnt vmcnt(0)" ::: "memory");
    __syncthreads();
    if (threadIdx.x == 0) {
        unsigned* bar = b.bar;
        __builtin_amdgcn_s_waitcnt(0);
        unsigned nloc = b.st[0], nx = b.st[1];
        if (nloc == 0u) { xcd_barrier_complete(bar, b.x, nloc, nx); b.st[0] = nloc; b.st[1] = nx; }
        const unsigned old = xb_add(&bar[XB_XSUB(b.x)], 1u);
        const unsigned gen = old / nloc;
        if (old + 1u == (gen + 1u) * nloc) {
            __builtin_amdgcn_fence(__ATOMIC_RELEASE, "agent");
            asm volatile("s_waitcnt vmcnt(0)" ::: "memory");
            const unsigned og = xb_add(&bar[XB_TOP], 1u);
            const unsigned tg = og / nx;
            if (og + 1u == (tg + 1u) * nx) xb_add(&bar[XB_TOPGEN], 1u);
            else XB_SPIN(xb_ld(&bar[XB_TOPGEN]) == tg, bar);
            __builtin_amdgcn_fence(__ATOMIC_ACQUIRE, "agent");
            xb_add(&bar[XB_XGEN(b.x)], 1u);
            asm volatile("s_waitcnt vmcnt(0)" ::: "memory");
        } else {
            XB_SPIN(xb_ld(&bar[XB_XGEN(b.x)]) == gen, bar);
            __builtin_amdgcn_fence(__ATOMIC_ACQUIRE, "agent");
            asm volatile("s_waitcnt vmcnt(0)" ::: "memory");
        }
    }
    __syncthreads();
}

struct Frame {
    LAS unsigned char* lds;
    volatile LAS unsigned* MISC;
    int tid, lane, wave;
    int vcu, G;
    unsigned char* ws;
    const float* in[26];
    float* out;
};
enum { MAP_PLAIN = 0, MAP_MLAIN = 1, MAP_QUP = 2, MAP_GU = 3 };
template <int MAP> __device__ __forceinline__ int dmap(int n) {
    if (MAP == MAP_MLAIN) { if (n < 640) return n; if (n < 656) return 640 + 2 * (n - 640); return 640 + 2 * (n - 656) + 1; }
    if (MAP == MAP_QUP) { const int h = n / 96, j = n % 96; if (j < 64) return n; if (j < 80) return h * 96 + 64 + 2 * (j - 64); return h * 96 + 64 + 2 * (j - 80) + 1; }
    if (MAP == MAP_GU) { const int up = n >= DFF ? 1 : 0; const int c = up ? n - DFF : n; return (c >> 7) * 256 + up * 128 + (c & 127); }
    return n;
}
template <int MAP> __device__ __forceinline__ void transpose_item(const float* W, int K, int N, bf16* WT, const float* ks, LAS float* scr, int item, int lane) {
    const int nblk = N / 32, kb = item / nblk, nb = item % nblk, k0 = 64 * kb, n0 = 32 * nb;
    float v[32];
    const float* src = W + (size_t)(k0 + (lane >> 5)) * N + n0 + (lane & 31);
#pragma unroll
    for (int i = 0; i < 32; ++i) v[i] = __builtin_nontemporal_load(src + (size_t)(2 * i) * N);
    if (ks) {
#pragma unroll
        for (int i = 0; i < 32; ++i) v[i] *= ks[k0 + 2 * i + (lane >> 5)]; }
#pragma unroll
    for (int i = 0; i < 32; ++i) scr[(2 * i + (lane >> 5)) * 33 + (lane & 31)] = v[i];
    LDS_WAIT(); asm volatile("" ::: "memory");
    const int c = lane & 7;
#pragma unroll
    for (int j = 0; j < 4; ++j) { const int n = (lane >> 3) + 8 * j; const LAS float* s = scr + (8 * c) * 33 + n;
        v4u o; o.x = pk2(s[0 * 33], s[1 * 33]); o.y = pk2(s[2 * 33], s[3 * 33]); o.z = pk2(s[4 * 33], s[5 * 33]); o.w = pk2(s[6 * 33], s[7 * 33]);
        *(GAS v4u*)(WT + (size_t)dmap<MAP>(n0 + n) * K + k0 + 8 * c) = o; }
    LDS_WAIT(); asm volatile("" ::: "memory");
}
__device__ __forceinline__ float wave_max(float v) {
#pragma unroll
    for (int o = 1; o < 64; o <<= 1) v = fmaxf(v, __shfl_xor(v, o));
    return v;
}
__device__ __forceinline__ float amax8(const f32x4& a, const f32x4& b) { return fmaxf(fmaxf(fmaxf(fabsf(a.x), fabsf(a.y)), fmaxf(fabsf(a.z), fabsf(a.w))), fmaxf(fmaxf(fabsf(b.x), fabsf(b.y)), fmaxf(fabsf(b.z), fabsf(b.w)))); }
__device__ __forceinline__ unsigned q4(const f32x4& a, float inv) { const int q0 = (int)__builtin_rintf(a.x * inv), q1 = (int)__builtin_rintf(a.y * inv), q2 = (int)__builtin_rintf(a.z * inv), q3 = (int)__builtin_rintf(a.w * inv);
    return ((unsigned)q0 & 0xffu) | (((unsigned)q1 & 0xffu) << 8) | (((unsigned)q2 & 0xffu) << 16) | (((unsigned)q3 & 0xffu) << 24); }
__device__ __forceinline__ void colmax_item(const float* W, int K, int N, unsigned* CM, int item, int lane) {
    const int nblk = (N + 63) / 64, kb = item / nblk, nb = item % nblk, n = 64 * nb + lane;
    if (n < N) { const float* src = W + (size_t)(64 * kb) * N + n; float mx = 0.f;
#pragma unroll 16
        for (int i = 0; i < 64; ++i) mx = fmaxf(mx, fabsf(__builtin_nontemporal_load(src + (size_t)i * N)));
        atomicMax(CM + n, __float_as_uint(mx)); }
}
template <int MAP, int FMT> __device__ __forceinline__ void conv_item(const float* W, int K, int N, unsigned char* WT, const unsigned* CM, float* SB, float post, LAS float* scr, int item, int lane) {
    const int nblk = N / 32, kb = item / nblk, nb = item % nblk, k0 = 64 * kb, n0 = 32 * nb;
    const float mx = __uint_as_float(CM[n0 + (lane & 31)]);
    const float inv = mx > 0.f ? (FMT == 1 ? 127.0f : 256.0f) / mx : 0.f;
    if (kb == 0 && lane < 32) SB[dmap<MAP>(n0 + lane)] = mx > 0.f ? (FMT == 1 ? mx * (1.0f / 127.0f) : mx * (1.0f / 256.0f) * post) : 1.0f;
    float v[32];
    const float* src = W + (size_t)(k0 + (lane >> 5)) * N + n0 + (lane & 31);
#pragma unroll
    for (int i = 0; i < 32; ++i) v[i] = src[(size_t)(2 * i) * N];
#pragma unroll
    for (int i = 0; i < 32; ++i) scr[(2 * i + (lane >> 5)) * 33 + (lane & 31)] = v[i] * inv;
    LDS_WAIT(); asm volatile("" ::: "memory");
    const int c = lane & 7;
#pragma unroll
    for (int j = 0; j < 4; ++j) { const int n = (lane >> 3) + 8 * j; const LAS float* s = scr + (8 * c) * 33 + n;
        const f32x4 lo = (f32x4){s[0 * 33], s[1 * 33], s[2 * 33], s[3 * 33]}, hi = (f32x4){s[4 * 33], s[5 * 33], s[6 * 33], s[7 * 33]};
        v2u o; if (FMT == 1) o = (v2u){q4(lo, 1.0f), q4(hi, 1.0f)}; else o = (v2u){pg8::pk4_fp8(lo.x, lo.y, lo.z, lo.w), pg8::pk4_fp8(hi.x, hi.y, hi.z, hi.w)};
        *(GAS v2u*)(WT + (size_t)dmap<MAP>(n0 + n) * K + k0 + 8 * c) = o; }
    LDS_WAIT(); asm volatile("" ::: "memory");
}
__device__ __constant__ double INVF_D[16] = {1.0, 0.5623413251903491, 0.31622776601683794, 0.1778279410038923, 0.09999999999999999, 0.056234132519034905, 0.03162277660168379, 0.01778279410038923,
    0.01, 0.005623413251903491, 0.0031622776601683794, 0.0017782794100389228, 0.001, 0.000562341325190349, 0.00031622776601683794, 0.0001778279410038923};
__device__ __constant__ int RPB_TH[15] = {22, 30, 40, 54, 73, 99, 134, 182, 246, 332, 450, 609, 825, 1117, 1513};

__device__ __forceinline__ void p0_prologue(Frame& F) {
    const int gw = F.vcu * NWAVES + F.wave, NGW = F.G * NWAVES;
    const int gtid = F.vcu * (NWAVES * 64) + F.tid, NGT = F.G * NWAVES * 64;
    float* MODV = (float*)(F.ws + WS_MODV);
    {
        LAS float* cact = (LAS float*)F.lds;
        LAS float* red = (LAS float*)(F.lds + 16384);
        const float* cin = F.in[1];
        for (int i = F.tid; i < 4096; i += NWAVES * 64) { const int b = i >> 10, k = i & 1023; const float x = cin[i]; cact[k * 4 + b] = x / (1.0f + expf(-x)); }
        __syncthreads();
        constexpr int NTASK = (6 * D * 2 + 2 * D) / 64;
        for (int task = F.vcu; task < NTASK; task += F.G) {
            const int gc = task * 64 + F.lane;
            const float* W; int ldw, cc; const float* bias;
            if (gc < 6 * D) { W = F.in[5]; ldw = 6 * D; cc = gc; bias = F.in[6]; }
            else if (gc < 12 * D) { W = F.in[5] + (size_t)D * 6 * D; ldw = 6 * D; cc = gc - 6 * D; bias = F.in[6] + 6 * D; }
            else { W = F.in[14]; ldw = 2 * D; cc = gc - 12 * D; bias = F.in[15]; }
            float a0 = 0.f, a1 = 0.f, a2 = 0.f, a3 = 0.f;
            const int kbeg = F.wave * 128;
#pragma unroll 16
            for (int k = 0; k < 128; ++k) { const float w = W[(size_t)(kbeg + k) * ldw + cc]; const f32x4 ca = *(const LAS f32x4*)(cact + (kbeg + k) * 4);
                a0 += w * ca[0]; a1 += w * ca[1]; a2 += w * ca[2]; a3 += w * ca[3]; }
            red[(F.wave * 4 + 0) * 64 + F.lane] = a0; red[(F.wave * 4 + 1) * 64 + F.lane] = a1; red[(F.wave * 4 + 2) * 64 + F.lane] = a2; red[(F.wave * 4 + 3) * 64 + F.lane] = a3;
            __syncthreads();
            if (F.wave < 4) { const int b = F.wave; float s = 0.f;
#pragma unroll
                for (int w = 0; w < 8; ++w) s += red[(w * 4 + b) * 64 + F.lane];
                s += bias[cc];
                int kind; float val = s; const int j = cc & 1023, ch = cc >> 10;
                if (gc < 12 * D) { const int Lr = gc < 6 * D ? 0 : 1;
                    if (ch == 0) kind = 6 * Lr + 1; else if (ch == 1) { kind = 6 * Lr + 0; val = F.in[3][Lr * D + j] * (1.0f + s); } else if (ch == 2) kind = 6 * Lr + 2;
                    else if (ch == 3) kind = 6 * Lr + 4; else if (ch == 4) { kind = 6 * Lr + 3; val = F.in[4][Lr * D + j] * (1.0f + s); } else kind = 6 * Lr + 5;
                } else { if (ch == 0) kind = MK_B_KV; else { kind = MK_A_KV; val = F.in[13][j] * (1.0f + s); } }
                MODV[((size_t)kind * 4 + b) * D + j] = val; }
            __syncthreads();
        }
        __syncthreads();
    }
    {
        unsigned* const CM = (unsigned*)(F.ws + WS_CM);
        constexpr int C_MLAIN = (D / 64) * ((LATN + 63) / 64), C_FGU = (D / 64) * (2 * DFF / 64), C_KVB = (D / 64) * (DILKV / 64), C_QB = (D / 64) * (DILQ / 64), C_FDN = (DFF / 64) * (D / 64);
        constexpr int NCM = C_MLAIN + C_FGU + C_KVB + C_QB + NEXP * C_FGU + C_FDN + NEXP * C_FDN;
        for (int it = gw; it < NCM; it += NGW) { int r = it;
            if (r < C_MLAIN) { colmax_item(F.in[7], D, LATN, CM + CM_LAT, r, F.lane); continue; } r -= C_MLAIN;
            if (r < C_FGU) { colmax_item(F.in[20], D, 2 * DFF, CM + CM_FGU, r, F.lane); continue; } r -= C_FGU;
            if (r < C_KVB) { colmax_item(F.in[16], D, DILKV, CM + CM_KVB, r, F.lane); continue; } r -= C_KVB;
            if (r < C_QB) { colmax_item(F.in[18], D, DILQ, CM + CM_QB, r, F.lane); continue; } r -= C_QB;
            if (r < NEXP * C_FGU) { const int e = r / C_FGU; colmax_item(F.in[23] + (size_t)e * D * 2 * DFF, D, 2 * DFF, CM + CM_EGU + e * 2 * DFF, r % C_FGU, F.lane); continue; } r -= NEXP * C_FGU;
            if (r < C_FDN) { colmax_item(F.in[21], DFF, D, CM + CM_FDN, r, F.lane); continue; } r -= C_FDN;
            { const int e = r / C_FDN; colmax_item(F.in[24] + (size_t)e * DFF * D, DFF, D, CM + CM_EDN + e * D, r % C_FDN, F.lane); } }
    }
    {
        v4u* padz = (v4u*)(F.ws + WS_WMLAIN + (size_t)LATN * D);
        for (int i = gtid; i < (LATP - LATN) * D / 16; i += NGT) padz[i] = (v4u){0u, 0u, 0u, 0u};
        for (int i = gtid; i < LATP - LATN; i += NGT) ((float*)(F.ws + WS_SB))[SB_LAT + LATN + i] = 1.0f;
        const int* pos = (const int*)F.in[2];
        float* cs = (float*)(F.ws + WS_CS);
        for (int i = gtid; i < M * 16; i += NGT) { const int row = i >> 4, k = i & 15;
            const double x = (double)pos[row] * INVF_D[k]; const double rev = x * 0.15915494309189535; const float fr = (float)(rev - __builtin_rint(rev));
            cs[(size_t)i * 2] = __builtin_amdgcn_cosf(fr); cs[(size_t)i * 2 + 1] = __builtin_amdgcn_sinf(fr); }
        const float* rpb = F.in[17];
        float* bt = (float*)(F.ws + WS_BIAS);
        for (int i = gtid; i < 24 * 288; i += NGT) { const int gh = i / 288, ii = i % 288, j = 191 - ii, g = gh >> 3; const int d = j * (g == 0 ? 1 : (g == 1 ? 4 : 16));
            float val = -INFINITY;
            if (j >= 0 && j <= 128) { int bk; if (d < 16) bk = d; else { bk = 16;
#pragma unroll
                for (int q = 0; q < 15; ++q) bk += (d >= RPB_TH[q]) ? 1 : 0; }
                val = rpb[bk * 24 + gh] * LOG2E_F; }
            bt[i] = val; }
    }
}

__device__ __forceinline__ void p1_convert(Frame& F) {
    const int gw = F.vcu * NWAVES + F.wave, NGW = F.G * NWAVES;
    LAS float* scr = (LAS float*)(F.lds + F.wave * 8704);
    const unsigned* const CM = (const unsigned*)(F.ws + WS_CM); float* const SB = (float*)(F.ws + WS_SB);
    constexpr int I_MLAIN = (D / 64) * (LATN / 32), I_FGU = (D / 64) * (2 * DFF / 32), I_KVB = (D / 64) * (DILKV / 32), I_QB = (D / 64) * (DILQ / 32), I_FDN = (DFF / 64) * (D / 32);
    constexpr int I_QUP = (QRANK / 64) * (QUP / 32), I_KVUP = (KVRANK / 64) * (KVUP / 32), I_OUT = (D / 64) * (D / 32), I_OB = (DILOUT / 64) * (D / 32);
    constexpr int NITEMS = I_MLAIN + I_FGU + I_KVB + I_QB + NEXP * I_FGU + I_FDN + NEXP * I_FDN + I_QUP + I_KVUP + I_OUT + I_OB;
    constexpr float POST = 1.0f / pg8::HSCALE;
    for (int it = gw; it < NITEMS; it += NGW) { int r = it;
        if (r < NEXP * I_FGU) { const int e = r / I_FGU; conv_item<MAP_GU, 1>(F.in[23] + (size_t)e * D * 2 * DFF, D, 2 * DFF, F.ws + WS_WEGU + (size_t)e * 2 * DFF * D, CM + CM_EGU + e * 2 * DFF, SB + SB_EGU + (size_t)e * 2 * DFF, 1.f, scr, r % I_FGU, F.lane); continue; } r -= NEXP * I_FGU;
        if (r < NEXP * I_FDN) { const int e = r / I_FDN; conv_item<MAP_PLAIN, 2>(F.in[24] + (size_t)e * DFF * D, DFF, D, F.ws + WS_WEDN + (size_t)e * D * DFF, CM + CM_EDN + e * D, SB + SB_EDN + (size_t)e * D, POST, scr, r % I_FDN, F.lane); continue; } r -= NEXP * I_FDN;
        if (r < I_FGU) { conv_item<MAP_GU, 1>(F.in[20], D, 2 * DFF, F.ws + WS_WFGU, CM + CM_FGU, SB + SB_FGU, 1.f, scr, r, F.lane); continue; } r -= I_FGU;
        if (r < I_FDN) { conv_item<MAP_PLAIN, 2>(F.in[21], DFF, D, F.ws + WS_WFDN, CM + CM_FDN, SB + SB_FDN, POST, scr, r, F.lane); continue; } r -= I_FDN;
        if (r < I_KVB) { conv_item<MAP_PLAIN, 1>(F.in[16], D, DILKV, F.ws + WS_WKVB, CM + CM_KVB, SB + SB_KVB, 1.f, scr, r, F.lane); continue; } r -= I_KVB;
        if (r < I_QB) { conv_item<MAP_PLAIN, 1>(F.in[18], D, DILQ, F.ws + WS_WQB, CM + CM_QB, SB + SB_QB, 1.f, scr, r, F.lane); continue; } r -= I_QB;
        if (r < I_MLAIN) { conv_item<MAP_MLAIN, 1>(F.in[7], D, LATN, F.ws + WS_WMLAIN, CM + CM_LAT, SB + SB_LAT, 1.f, scr, r, F.lane); continue; } r -= I_MLAIN;
        if (r < I_QUP) { transpose_item<MAP_QUP>(F.in[9], QRANK, QUP, (bf16*)(F.ws + WS_WQUP), F.in[8], scr, r, F.lane); continue; } r -= I_QUP;
        if (r < I_KVUP) { transpose_item<MAP_PLAIN>(F.in[11], KVRANK, KVUP, (bf16*)(F.ws + WS_WKVUP), F.in[10], scr, r, F.lane); continue; } r -= I_KVUP;
        if (r < I_OUT) { transpose_item<MAP_PLAIN>(F.in[12], D, D, (bf16*)(F.ws + WS_WOUT), nullptr, scr, r, F.lane); continue; } r -= I_OUT;
        transpose_item<MAP_PLAIN>(F.in[19], DILOUT, D, (bf16*)(F.ws + WS_WOB), nullptr, scr, r, F.lane);
    }
    __syncthreads();
}

constexpr int HPITCH = 2048;
__device__ __forceinline__ void ld8_f32(const float* p, f32x4& a, f32x4& b) { a = *(const f32x4*)p; b = *(const f32x4*)(p + 4); }
__device__ __forceinline__ void ld8_bf16(const bf16* p, f32x4& a, f32x4& b) { const v4u w = *(const GAS v4u*)p; a = (f32x4){bf_lo(w.x), bf_hi(w.x), bf_lo(w.y), bf_hi(w.y)}; b = (f32x4){bf_lo(w.z), bf_hi(w.z), bf_lo(w.w), bf_hi(w.w)}; }
__device__ __forceinline__ float ssq8(const f32x4& a, const f32x4& b) { return ((a.x * a.x + a.y * a.y) + (a.z * a.z + a.w * a.w)) + ((b.x * b.x + b.y * b.y) + (b.z * b.z + b.w * b.w)); }
__device__ __forceinline__ v4u pk8(const f32x4& a, const f32x4& b) { return (v4u){pk2(a.x, a.y), pk2(a.z, a.w), pk2(b.x, b.y), pk2(b.z, b.w)}; }
__device__ __forceinline__ void quant_row(const f32x4 (&y)[2][2], i8* orow, float* srow, int lane) {
    const float mx = wave_max(fmaxf(amax8(y[0][0], y[0][1]), amax8(y[1][0], y[1][1])));
    const float sc = mx > 0.f ? mx * (1.0f / 127.0f) : 1.0f, inv = mx > 0.f ? 127.0f / mx : 0.f;
#pragma unroll
    for (int j = 0; j < 2; ++j) *(GAS v2u*)(orow + 8 * lane + 512 * j) = (v2u){q4(y[j][0], inv), q4(y[j][1], inv)};
    if (lane == 0) *srow = sc;
}
template <bool DUAL, bool INF32>
__device__ __forceinline__ void norm_phase(Frame& F, const void* Hin, const float* A0, const float* B0, i8* O0, float* S0, const float* A1, const float* B1, i8* O1, float* S1) {
    const int gw = F.vcu * NWAVES + F.wave, NGW = F.G * NWAVES;
    for (int c = gw; c < M / 16; c += NGW) {
        const int row0 = c * 16, b = row0 / SEQ;
        f32x4 a0[2][2], b0[2][2], a1[2][2], b1[2][2];
#pragma unroll
        for (int j = 0; j < 2; ++j) { const int co = b * D + 8 * F.lane + 512 * j; ld8_f32(A0 + co, a0[j][0], a0[j][1]); ld8_f32(B0 + co, b0[j][0], b0[j][1]);
            if (DUAL) { ld8_f32(A1 + co, a1[j][0], a1[j][1]); ld8_f32(B1 + co, b1[j][0], b1[j][1]); } }
#pragma unroll 2
        for (int i = 0; i < 16; ++i) { const size_t row = (size_t)(row0 + i);
            f32x4 v[2][2]; float s = 0.f;
#pragma unroll
            for (int j = 0; j < 2; ++j) { if (INF32) ld8_f32((const float*)Hin + row * D + 8 * F.lane + 512 * j, v[j][0], v[j][1]); else ld8_bf16((const bf16*)Hin + row * HPITCH + 8 * F.lane + 512 * j, v[j][0], v[j][1]);
                s += ssq8(v[j][0], v[j][1]); }
            const float rstd = 1.0f / sqrtf(wave_sum(s) * (1.f / D) + EPS);
            f32x4 y[2][2];
#pragma unroll
            for (int j = 0; j < 2; ++j) { y[j][0] = v[j][0] * rstd * a0[j][0] + b0[j][0]; y[j][1] = v[j][1] * rstd * a0[j][1] + b0[j][1]; }
            quant_row(y, O0 + row * D, S0 + row, F.lane);
            if (DUAL) {
#pragma unroll
                for (int j = 0; j < 2; ++j) { y[j][0] = v[j][0] * rstd * a1[j][0] + b1[j][0]; y[j][1] = v[j][1] * rstd * a1[j][1] + b1[j][1]; }
                quant_row(y, O1 + row * D, S1 + row, F.lane); }
        }
    }
}

__device__ __forceinline__ void latnorm_phase(Frame& F) {
    const int gw = F.vcu * NWAVES + F.wave, NGW = F.G * NWAVES;
    const bf16* LAT = (const bf16*)(F.ws + A_LAT); bf16* QN = (bf16*)(F.ws + A_QN); bf16* KVN = (bf16*)(F.ws + A_KVN); bf16* KB = (bf16*)(F.ws + A_K);
    const float* cs = (const float*)(F.ws + WS_CS);
    for (int row = gw; row < M; row += NGW) {
        const unsigned* lr = (const unsigned*)(LAT + (size_t)row * LATP);
        unsigned q[3], kv[2];
#pragma unroll
        for (int j = 0; j < 3; ++j) q[j] = lr[F.lane + 64 * j];
#pragma unroll
        for (int j = 0; j < 2; ++j) kv[j] = lr[192 + F.lane + 64 * j];
        const unsigned kr = lr[320 + (F.lane & 15)];
        float sq = 0.f, sk = 0.f;
#pragma unroll
        for (int j = 0; j < 3; ++j) { const float a = bf_lo(q[j]), b = bf_hi(q[j]); sq += a * a + b * b; }
#pragma unroll
        for (int j = 0; j < 2; ++j) { const float a = bf_lo(kv[j]), b = bf_hi(kv[j]); sk += a * a + b * b; }
        const float rq = 1.0f / sqrtf(wave_sum(sq) * (1.f / QRANK) + EPS), rk = 1.0f / sqrtf(wave_sum(sk) * (1.f / KVRANK) + EPS);
        unsigned* qo = (unsigned*)(QN + (size_t)row * QRANK); unsigned* ko = (unsigned*)(KVN + (size_t)row * KVRANK);
#pragma unroll
        for (int j = 0; j < 3; ++j) qo[F.lane + 64 * j] = pk2(bf_lo(q[j]) * rq, bf_hi(q[j]) * rq);
#pragma unroll
        for (int j = 0; j < 2; ++j) ko[F.lane + 64 * j] = pk2(bf_lo(kv[j]) * rk, bf_hi(kv[j]) * rk);
        { const int i = F.lane & 15; const float c = cs[(size_t)row * 32 + 2 * i], s = cs[(size_t)row * 32 + 2 * i + 1]; const float x1 = bf_lo(kr), x2 = bf_hi(kr);
          const unsigned w = pk2(x1 * c - x2 * s, x1 * s + x2 * c);
          unsigned* kb = (unsigned*)(KB + (size_t)row * QUP);
#pragma unroll
          for (int hh = 0; hh < 4; ++hh) { const int h = (F.lane >> 4) * 4 + hh; kb[(h * 96 + 64) / 2 + i] = w; } }
    }
}

__device__ __forceinline__ void merge_phase(Frame& F) {
    const int gw = F.vcu * NWAVES + F.wave, NGW = F.G * NWAVES;
    const bf16* OG = (const bf16*)(F.ws + A_OG); const float* LSE = (const float*)(F.ws + WS_LSE); bf16* OD = (bf16*)(F.ws + A_OD);
    for (int row = gw; row < M; row += NGW) {
        const int h = F.lane >> 3;
        float l0 = LSE[((size_t)0 * M + row) * 8 + h], l1 = LSE[((size_t)1 * M + row) * 8 + h], l2 = LSE[((size_t)2 * M + row) * 8 + h];
        const float mx = fmaxf(l0, fmaxf(l1, l2)); float w0 = __builtin_amdgcn_exp2f(l0 - mx), w1 = __builtin_amdgcn_exp2f(l1 - mx), w2 = __builtin_amdgcn_exp2f(l2 - mx);
        const float inv = 1.0f / (w0 + w1 + w2); w0 *= inv; w1 *= inv; w2 *= inv;
        const v4u a = *(const v4u*)(OG + ((size_t)0 * M + row) * DILOUT + 8 * F.lane), b = *(const v4u*)(OG + ((size_t)1 * M + row) * DILOUT + 8 * F.lane), c = *(const v4u*)(OG + ((size_t)2 * M + row) * DILOUT + 8 * F.lane);
        v4u o;
#pragma unroll
        for (int k = 0; k < 4; ++k) o[k] = pk2(w0 * bf_lo(a[k]) + w1 * bf_lo(b[k]) + w2 * bf_lo(c[k]), w0 * bf_hi(a[k]) + w1 * bf_hi(b[k]) + w2 * bf_hi(c[k]));
        *(v4u*)(OD + (size_t)row * DILOUT + 8 * F.lane) = o;
    }
}

__device__ __forceinline__ void router_phase(Frame& F, const bf16* H, const float* A0, const float* B0, i8* O0, float* S0) {
    const int gw = F.vcu * NWAVES + F.wave, NGW = F.G * NWAVES;
    LAS float* wrt = (LAS float*)F.lds;
    { const float* wr = F.in[22]; for (int i = F.tid; i < 8192; i += NWAVES * 64) { const int col = i >> 3, e = i & 7; wrt[e * 1024 + col] = wr[i]; } }
    __syncthreads();
    v4u* ROUTE = (v4u*)(F.ws + WS_ROUTE); unsigned* CNT = (unsigned*)(F.ws + WS_CNT);
    for (int c = gw; c < M / 16; c += NGW) {
        const int row0 = c * 16, b = row0 / SEQ;
        f32x4 a0[2][2], b0[2][2];
#pragma unroll
        for (int j = 0; j < 2; ++j) { const int co = b * D + 8 * F.lane + 512 * j; ld8_f32(A0 + co, a0[j][0], a0[j][1]); ld8_f32(B0 + co, b0[j][0], b0[j][1]); }
        unsigned cnt = 0u;
        for (int i = 0; i < 16; ++i) { const size_t row = (size_t)(row0 + i);
            f32x4 v[2][2]; float s = 0.f;
#pragma unroll
            for (int j = 0; j < 2; ++j) { ld8_bf16(H + row * HPITCH + 8 * F.lane + 512 * j, v[j][0], v[j][1]); s += ssq8(v[j][0], v[j][1]); }
            const float rstd = 1.0f / sqrtf(wave_sum(s) * (1.f / D) + EPS);
            float lg[8];
#pragma unroll
            for (int e = 0; e < 8; ++e) lg[e] = 0.f;
            f32x4 yq[2][2];
#pragma unroll
            for (int j = 0; j < 2; ++j) { const f32x4 y0 = v[j][0] * rstd * a0[j][0] + b0[j][0], y1 = v[j][1] * rstd * a0[j][1] + b0[j][1];
                yq[j][0] = y0; yq[j][1] = y1;
#pragma unroll
                for (int e = 0; e < 8; ++e) { const LAS float* wp = wrt + e * 1024 + 8 * F.lane + 512 * j; const f32x4 w0 = *(const LAS f32x4*)wp, w1 = *(const LAS f32x4*)(wp + 4);
                    lg[e] += ((y0.x * w0.x + y0.y * w0.y) + (y0.z * w0.z + y0.w * w0.w)) + ((y1.x * w1.x + y1.y * w1.y) + (y1.z * w1.z + y1.w * w1.w)); } }
            quant_row(yq, O0 + row * D, S0 + row, F.lane);
#pragma unroll
            for (int e = 0; e < 8; ++e) lg[e] = wave_sum(lg[e]);
            int e1 = 0; float v1 = lg[0];
#pragma unroll
            for (int e = 1; e < 8; ++e) if (lg[e] > v1) { v1 = lg[e]; e1 = e; }
            int e2 = -1; float v2 = -INFINITY;
#pragma unroll
            for (int e = 0; e < 8; ++e) if (e != e1 && lg[e] > v2) { v2 = lg[e]; e2 = e; }
            const float ex = expf(v2 - v1); const float g1 = 1.0f / (1.0f + ex), g2 = ex / (1.0f + ex);
            cnt += (F.lane == e1 ? 1u : 0u) + (F.lane == e2 ? 1u : 0u);
            if (F.lane == 0) ROUTE[row] = (v4u){(unsigned)e1 | ((unsigned)e2 << 8), __float_as_uint(g1), __float_as_uint(g2), 0u};
        }
        if (F.lane < 8) CNT[c * 8 + F.lane] = cnt;
    }
}

__device__ __forceinline__ void lists_phase(Frame& F) {
    const int gw = F.vcu * NWAVES + F.wave, NGW = F.G * NWAVES;
    const v4u* ROUTE = (const v4u*)(F.ws + WS_ROUTE); const unsigned* CNT = (const unsigned*)(F.ws + WS_CNT);
    int* LIST = (int*)(F.ws + WS_LIST); float* SLOTG = (float*)(F.ws + WS_SLOTG); int* TOKSLOT = (int*)(F.ws + WS_TOKSLOT); int* TILEEXP = (int*)(F.ws + WS_TILEEXP);
    for (int c = gw; c < M / 16; c += NGW) {
        unsigned lt[8], al[8];
#pragma unroll
        for (int e = 0; e < 8; ++e) { lt[e] = 0u; al[e] = 0u; }
        for (int cc = F.lane; cc < M / 16; cc += 64) { const v4u x = *(const v4u*)(CNT + cc * 8), y = *(const v4u*)(CNT + cc * 8 + 4); const bool bl = cc < c;
            al[0] += x.x; al[1] += x.y; al[2] += x.z; al[3] += x.w; al[4] += y.x; al[5] += y.y; al[6] += y.z; al[7] += y.w;
            if (bl) { lt[0] += x.x; lt[1] += x.y; lt[2] += x.z; lt[3] += x.w; lt[4] += y.x; lt[5] += y.y; lt[6] += y.z; lt[7] += y.w; } }
#pragma unroll
        for (int e = 0; e < 8; ++e) {
#pragma unroll
            for (int o = 1; o < 64; o <<= 1) { lt[e] += __shfl_xor(lt[e], o); al[e] += __shfl_xor(al[e], o); } }
        unsigned base[8]; unsigned run = 0u;
#pragma unroll
        for (int e = 0; e < 8; ++e) { base[e] = run; run += (al[e] + 255u) & ~255u; }
        const int row = c * 16 + (F.lane & 15);
        const v4u r = ROUTE[row]; const int e1 = (int)(r.x & 0xffu), e2 = (int)((r.x >> 8) & 0xffu);
        int s1 = 0, s2 = 0;
#pragma unroll
        for (int e = 0; e < 8; ++e) { const bool has = (F.lane < 16) && (e1 == e || e2 == e); const unsigned long long mk = __ballot(has);
            const int rank = __popcll(mk & ((1ull << F.lane) - 1ull)); const int sl = (int)(base[e] + lt[e]) + rank;
            if (e1 == e) s1 = sl; if (e2 == e) s2 = sl; }
        if (F.lane < 16) { LIST[s1] = row; LIST[s2] = row; SLOTG[s1] = __uint_as_float(r.y); SLOTG[s2] = __uint_as_float(r.z); TOKSLOT[row * 2] = s1; TOKSLOT[row * 2 + 1] = s2; }
        if (c == 0) {
#pragma unroll
            for (int e = 0; e < 8; ++e) { const unsigned pe = (al[e] + 255u) & ~255u;
                for (unsigned s = base[e] + al[e] + F.lane; s < base[e] + pe; s += 64) { LIST[s] = 0; SLOTG[s] = 0.f; }
                for (unsigned t = base[e] / 256u + F.lane; t < (base[e] + pe) / 256u; t += 64) TILEEXP[t] = e; }
            if (F.lane == 0) TILEEXP[300] = (int)(run / 256u);
        }
    }
}

__device__ __forceinline__ void final_phase(Frame& F, float* OUT, const float* gate, const float* gfin) {
    const int gw = F.vcu * NWAVES + F.wave, NGW = F.G * NWAVES;
    const bf16* Y = (const bf16*)(F.ws + A_Y); const int* TOKSLOT = (const int*)(F.ws + WS_TOKSLOT); const bf16* H = (const bf16*)OUT;
    for (int c = gw; c < M / 16; c += NGW) {
        const int row0 = c * 16, b = row0 / SEQ;
        f32x4 gt[2][2], gf[2][2];
#pragma unroll
        for (int j = 0; j < 2; ++j) { ld8_f32(gate + b * D + 8 * F.lane + 512 * j, gt[j][0], gt[j][1]); ld8_f32(gfin + 8 * F.lane + 512 * j, gf[j][0], gf[j][1]); }
#pragma unroll 2
        for (int i = 0; i < 16; ++i) { const size_t row = (size_t)(row0 + i);
            const int s1 = TOKSLOT[row * 2], s2 = TOKSLOT[row * 2 + 1];
            f32x4 v[2][2]; float s = 0.f;
#pragma unroll
            for (int j = 0; j < 2; ++j) { f32x4 h0, h1, p0, p1, q0, q1; ld8_bf16(H + row * HPITCH + 8 * F.lane + 512 * j, h0, h1);
                ld8_bf16(Y + (size_t)s1 * D + 8 * F.lane + 512 * j, p0, p1); ld8_bf16(Y + (size_t)s2 * D + 8 * F.lane + 512 * j, q0, q1);
                v[j][0] = h0 + gt[j][0] * (p0 + q0); v[j][1] = h1 + gt[j][1] * (p1 + q1); s += ssq8(v[j][0], v[j][1]); }
            const float rstd = 1.0f / sqrtf(wave_sum(s) * (1.f / D) + EPS);
            asm volatile("" ::: "memory");
#pragma unroll
            for (int j = 0; j < 2; ++j) { float* op = OUT + row * D + 8 * F.lane + 512 * j; *(GAS f32x4*)op = v[j][0] * rstd * gf[j][0]; *(GAS f32x4*)(op + 4) = v[j][1] * rstd * gf[j][1]; }
        }
    }
}
#ifndef MK_ONE_LAUNCH
#define MK_ONE_LAUNCH 1
#endif
constexpr int N_PHASES = 20;
struct Args { const float* in[26]; float* out; unsigned char* ws; int ph_lo, ph_hi; };
static_assert(sizeof(Args) == 26 * 8 + 8 + 8 + 8, "Args has no padding");

__global__ void __launch_bounds__(NWAVES * 64, 2) mk_fwd(Args args) {
    extern __shared__ __attribute__((aligned(16))) unsigned char lds[];
    Frame F;
    F.lds = (LAS unsigned char*)lds;
    F.MISC = (volatile LAS unsigned*)(F.lds + MISC_OFF);
    F.tid = threadIdx.x; F.lane = F.tid & 63; F.wave = __builtin_amdgcn_readfirstlane(F.tid >> 6);
    F.G = gridDim.x; { const int bx = blockIdx.x; F.vcu = (F.G % 8 == 0) ? (bx % 8) * (F.G / 8) + bx / 8 : bx; }
    F.ws = args.ws; F.out = args.out;
#pragma unroll
    for (int i = 0; i < 26; ++i) F.in[i] = args.in[i];
    unsigned char* const ws = args.ws;
    for (int u = F.tid; u < (LDS_BYTES - LDSCTL_OFF) / 4; u += NWAVES * 64) ((LAS unsigned*)(F.lds + LDSCTL_OFF))[u] = 0u;
    __syncthreads();
    const int lo = args.ph_lo, hi = args.ph_hi;
    XcdBarrier bar; bar.bar = (unsigned*)(ws + WS_CTL) + CW_BAR; bar.x = 0; bar.st = nullptr;
    if (hi - lo > 1) bar = xcd_barrier_post((unsigned*)(ws + WS_CTL) + CW_BAR, F.MISC + 8);
    int cid = (int)blockIdx.x;
    if (hi - lo > 1) { if (F.tid == 0) F.MISC[12] = xb_add((unsigned*)(ws + WS_CTL) + CW_RANK + 64 * bar.x, 1u); }

#ifndef PHASE_MASK
#define PHASE_MASK 0xFFFFFu
#endif
#define IN(k) (((PHASE_MASK >> (k)) & 1u) && lo <= (k) && (k) < hi)
#ifndef REPEAT_MASK
#define REPEAT_MASK 0u
#endif
#define REP(k) (((REPEAT_MASK >> (k)) & 1u) ? 2 : 1)
#define SEAM(k) do { if (IN(k) && IN((k) + 1)) xcd_barrier(bar); } while (0)
    const float* MODV = (const float*)(ws + WS_MODV);
#define MV(kind) (MODV + (size_t)(kind) * 4 * D)
    bf16* const H = (bf16*)args.out;
    i8* const XN = (i8*)(ws + A_XN); i8* const XNKV = (i8*)(ws + A_XNKV);
    float* const XS = (float*)(ws + WS_XS); float* const XSKV = (float*)(ws + WS_XSKV); const float* const SB = (const float*)(ws + WS_SB);
    const pg8::MoeInfo mi0{nullptr, nullptr, 0};

    if (IN(0)) for (int rep_ = 0; rep_ < REP(0); ++rep_) { p0_prologue(F); } SEAM(0);
    if (IN(0) && IN(1)) {
        if (F.tid == 0) { bool ok = (F.G % 8) == 0;
            for (unsigned j = 0; j < 16; ++j) { const unsigned cnt_ = xb_ld((unsigned*)(ws + WS_CTL) + CW_BAR + XB_XCNT(j)); ok = ok && (cnt_ == (j < 8 ? (unsigned)F.G / 8u : 0u)); }
            F.MISC[13] = ok ? (F.MISC[12] * 8u + bar.x) : (unsigned)blockIdx.x; }
        __syncthreads();
        cid = (int)F.MISC[13];
        F.vcu = (F.G % 8 == 0) ? (cid % 8) * (F.G / 8) + cid / 8 : cid;
    }

    if (IN(1)) for (int rep_ = 0; rep_ < REP(1); ++rep_) { p1_convert(F); norm_phase<false, true>(F, F.in[0], MV(MK_A_MIX0), MV(MK_B_MIX0), XN, XS, nullptr, nullptr, nullptr, nullptr); } SEAM(1);
    if (IN(2)) for (int rep_ = 0; rep_ < REP(2); ++rep_) { pg8::Gemm g{(const bf16*)XN, (const bf16*)(ws + WS_WMLAIN), M, LATP, D}; pg8::StaticOrder S; S.init(M, LATP, F.G, cid);
        pg8::EpiBf16Q E{(bf16*)(ws + A_LAT), LATP, XS, SB + SB_LAT};
        pg8::gemm_phase<pg8::EpiBf16Q, pg8::StaticOrder, true, true, 0, 1>(F.lds, g, S, E, mi0); } SEAM(2);
    if (IN(3)) for (int rep_ = 0; rep_ < REP(3); ++rep_) { latnorm_phase(F); } SEAM(3);
    if (IN(4)) for (int rep_ = 0; rep_ < REP(4); ++rep_) {
#ifndef P4_SKIP_Q
        { pg8::Gemm g{(const bf16*)(ws + A_QN), (const bf16*)(ws + WS_WQUP), M, QUP, QRANK}; pg8::StaticOrder S; S.init(M, QUP, F.G, cid);
          pg8::EpiQ E{(bf16*)(ws + A_Q), QUP, C2_MLA, (const float*)(ws + WS_CS)};
          pg8::gemm_phase<pg8::EpiQ, pg8::StaticOrder, true, true, 0>(F.lds, g, S, E, mi0); }
#endif
#ifndef P4_SKIP_KV
        { pg8::Gemm g{(const bf16*)(ws + A_KVN), (const bf16*)(ws + WS_WKVUP), M, KVUP, KVRANK}; pg8::StaticOrder S; S.init(M, KVUP, F.G, cid);
          pg8::EpiKV E{(bf16*)(ws + A_K), (bf16*)(ws + A_V)};
          pg8::gemm_phase<pg8::EpiKV, pg8::StaticOrder, true, true, 0>(F.lds, g, S, E, mi0); }
#endif
    } SEAM(4);
    if (IN(5)) for (int rep_ = 0; rep_ < REP(5); ++rep_) {
        const bf16* Qp = (const bf16*)(ws + A_Q); const bf16* Kp = (const bf16*)(ws + A_K); const bf16* Vp = (const bf16*)(ws + A_V); bf16* Op = (bf16*)(ws + A_O);
        if (F.G == 256) {
            for (int i = 0; i < 8; ++i) { const int bh = (F.vcu >> 3) + 32 * (i >> 2), s = F.vcu & 7, k = i & 3; const int qb = (k == 0) ? s : (k == 1) ? 15 - s : (k == 2) ? 16 + s : 31 - s;
                const int b = bh >> 4, h = bh & 15;
                mla::attn_unit<8>(b, h, qb, Qp, Kp, Vp, Op, (char*)lds); }
        } else {
            for (int u = (int)blockIdx.x; u < BATCH * MLA_H * 32; u += F.G) { const int bh = u >> 5, qb = 31 - (u & 31); const int b = bh >> 4, h = bh & 15;
                mla::attn_unit<8>(b, h, qb, Qp, Kp, Vp, Op, (char*)lds); }
        }
    } SEAM(5);
    if (IN(6)) for (int rep_ = 0; rep_ < REP(6); ++rep_) { pg8::Gemm g{(const bf16*)(ws + A_O), (const bf16*)(ws + WS_WOUT), M, D, D}; pg8::StaticOrder S; S.init(M, D, F.G, cid);
        pg8::EpiResid<true> E{F.in[0], H, MV(MK_G_MIX0), nullptr};
        pg8::gemm_phase<pg8::EpiResid<true>, pg8::StaticOrder, true, true, 0>(F.lds, g, S, E, mi0); } SEAM(6);
    if (IN(7)) for (int rep_ = 0; rep_ < REP(7); ++rep_) { norm_phase<false, false>(F, H, MV(MK_A_FFN0), MV(MK_B_FFN0), XN, XS, nullptr, nullptr, nullptr, nullptr); } SEAM(7);
    if (IN(8)) for (int rep_ = 0; rep_ < REP(8); ++rep_) { pg8::Gemm g{(const bf16*)XN, (const bf16*)(ws + WS_WFGU), M, 2 * DFF, D}; pg8::StaticOrder S; S.init(M, 2 * DFF, F.G, cid);
        pg8::EpiSwiGLUQ E{(unsigned char*)(ws + A_HID), DFF, XS, SB + SB_FGU, nullptr, nullptr};
        pg8::gemm_phase<pg8::EpiSwiGLUQ, pg8::StaticOrder, true, true, 0, 1>(F.lds, g, S, E, mi0); } SEAM(8);
    if (IN(9)) for (int rep_ = 0; rep_ < REP(9); ++rep_) { pg8::Gemm g{(const bf16*)(ws + A_HID), (const bf16*)(ws + WS_WFDN), M, D, DFF}; pg8::StaticOrder S; S.init(M, D, F.G, cid);
        pg8::EpiResid<false> E{H, H, MV(MK_G_FFN0), SB + SB_FDN};
        pg8::gemm_phase<pg8::EpiResid<false>, pg8::StaticOrder, true, true, 0, 2>(F.lds, g, S, E, mi0); } SEAM(9);
    if (IN(10)) for (int rep_ = 0; rep_ < REP(10); ++rep_) { norm_phase<true, false>(F, H, MV(MK_A_MIX1), MV(MK_B_MIX1), XN, XS, MV(MK_A_KV), MV(MK_B_KV), XNKV, XSKV); } SEAM(10);
    if (IN(11)) for (int rep_ = 0; rep_ < REP(11); ++rep_) {
        { pg8::Gemm g{(const bf16*)XNKV, (const bf16*)(ws + WS_WKVB), M, DILKV, D}; pg8::StaticOrder S; S.init(M, DILKV, F.G, cid);
          pg8::EpiDilQ<true> E{(bf16*)(ws + A_KVB), XSKV, SB + SB_KVB};
          pg8::gemm_phase<pg8::EpiDilQ<true>, pg8::StaticOrder, true, true, 0, 1>(F.lds, g, S, E, mi0); }
        { pg8::Gemm g{(const bf16*)XN, (const bf16*)(ws + WS_WQB), M, DILQ, D}; pg8::StaticOrder S; S.init(M, DILQ, F.G, cid);
          pg8::EpiDilQ<false> E{(bf16*)(ws + A_QB), XS, SB + SB_QB};
          pg8::gemm_phase<pg8::EpiDilQ<false>, pg8::StaticOrder, true, true, 0, 1>(F.lds, g, S, E, mi0); }
    } SEAM(11);
    if (IN(12)) for (int rep_ = 0; rep_ < REP(12); ++rep_) {
        const bf16* Qp = (const bf16*)(ws + A_QB); const bf16* KV = (const bf16*)(ws + A_KVB); bf16* OG = (bf16*)(ws + A_OG); float* LSE = (float*)(ws + WS_LSE); const float* BT = (const float*)(ws + WS_BIAS);
        dila::dil_phase(Qp, KV, OG, LSE, BT, (char*)lds, F.G);
    } SEAM(12);
    if (IN(13)) for (int rep_ = 0; rep_ < REP(13); ++rep_) { merge_phase(F); } SEAM(13);
    if (IN(14)) for (int rep_ = 0; rep_ < REP(14); ++rep_) { pg8::Gemm g{(const bf16*)(ws + A_OD), (const bf16*)(ws + WS_WOB), M, D, DILOUT}; pg8::StaticOrder S; S.init(M, D, F.G, cid);
        pg8::EpiResid<false> E{H, H, MV(MK_G_MIX1), nullptr};
        pg8::gemm_phase<pg8::EpiResid<false>, pg8::StaticOrder, true, true, 0>(F.lds, g, S, E, mi0); } SEAM(14);
    if (IN(15)) for (int rep_ = 0; rep_ < REP(15); ++rep_) { router_phase(F, H, MV(MK_A_FFN1), MV(MK_B_FFN1), XN, XS); } SEAM(15);
    if (IN(16)) for (int rep_ = 0; rep_ < REP(16); ++rep_) { lists_phase(F); } SEAM(16);
    if (IN(17)) for (int rep_ = 0; rep_ < REP(17); ++rep_) { const int ntile = ((const int*)(ws + WS_TILEEXP))[300];
        pg8::Gemm g{(const bf16*)XN, (const bf16*)(ws + WS_WEGU), ntile * 256, 2 * DFF, D}; pg8::StaticOrder S; S.init(ntile * 256, 2 * DFF, F.G, cid);
        const pg8::MoeInfo mi{(const int*)(ws + WS_LIST), (const int*)(ws + WS_TILEEXP), (size_t)2 * DFF * D};
        pg8::EpiSwiGLUQ E{(unsigned char*)(ws + A_HIDS), DFF, XS, SB + SB_EGU, mi.list, mi.tile_expert};
        pg8::gemm_phase<pg8::EpiSwiGLUQ, pg8::StaticOrder, true, true, 1, 1>(F.lds, g, S, E, mi); } SEAM(17);
    if (IN(18)) for (int rep_ = 0; rep_ < REP(18); ++rep_) { const int ntile = ((const int*)(ws + WS_TILEEXP))[300];
        pg8::Gemm g{(const bf16*)(ws + A_HIDS), (const bf16*)(ws + WS_WEDN), ntile * 256, D, DFF}; pg8::StaticOrder S; S.init(ntile * 256, D, F.G, cid);
        const pg8::MoeInfo mi{(const int*)(ws + WS_LIST), (const int*)(ws + WS_TILEEXP), (size_t)D * DFF};
        pg8::EpiMoeDown E{(bf16*)(ws + A_Y), (const float*)(ws + WS_SLOTG), SB + SB_EDN, mi.tile_expert};
        pg8::gemm_phase<pg8::EpiMoeDown, pg8::StaticOrder, true, true, 2, 2>(F.lds, g, S, E, mi); } SEAM(18);
    if (IN(19)) for (int rep_ = 0; rep_ < REP(19); ++rep_) { final_phase(F, args.out, MV(MK_G_FFN1), F.in[25]); }
#undef IN
#undef SEAM
#undef MV
}

extern "C" void kernel_launch(void* const* d_in, const int* in_sizes, int n_in, void* d_out, int out_size, void* d_ws, size_t ws_size, hipStream_t stream) {
    static int grid = 0;
    if (grid == 0) {
        if (n_in != 26 || in_sizes[0] != M * D || out_size != M * D || ws_size < WS_END) { fprintf(stderr, "kernel_launch: unexpected shapes (n_in %d, in0 %d, out %d, ws %zu, need %zu); nothing launched\n", n_in, n_in > 0 ? in_sizes[0] : -1, out_size, ws_size, (size_t)WS_END); grid = -1; return; }
        int dev = 0, cus = 0, per_cu = 0;
        if (hipGetDevice(&dev) != hipSuccess || hipDeviceGetAttribute(&cus, hipDeviceAttributeMultiprocessorCount, dev) != hipSuccess) { grid = -1; return; }
        if (hipFuncSetAttribute((const void*)mk_fwd, hipFuncAttributeMaxDynamicSharedMemorySize, LDS_BYTES) != hipSuccess) { fprintf(stderr, "kernel_launch: hipFuncSetAttribute failed\n"); grid = -1; return; }
        if (hipOccupancyMaxActiveBlocksPerMultiprocessor(&per_cu, (const void*)mk_fwd, NWAVES * 64, LDS_BYTES) != hipSuccess || per_cu < 1) { fprintf(stderr, "kernel_launch: occupancy query reports %d\n", per_cu); }
        (void)hipGetLastError();
        grid = cus;
    }
    if (grid < 0) return;
    if (hipMemsetAsync((char*)d_ws + WS_CTL, 0, CTL_ZERO_BYTES, stream) != hipSuccess) return;
    Args a{};
    for (int i = 0; i < 26; ++i) a.in[i] = (const float*)d_in[i];
    a.out = (float*)d_out; a.ws = (unsigned char*)d_ws;
#if MK_ONE_LAUNCH
    a.ph_lo = 0; a.ph_hi = N_PHASES;
    hipLaunchKernelGGL(mk_fwd, dim3(grid), dim3(NWAVES * 64), LDS_BYTES, stream, a);
#else
    for (int p = 0; p < N_PHASES; ++p) { a.ph_lo = p; a.ph_hi = p + 1; hipLaunchKernelGGL(mk_fwd, dim3(grid), dim3(NWAVES * 64), LDS_BYTES, stream, a); }
#endif
}
```

```cpp
#include <hip/hip_runtime.h>
#include <hip/hip_bf16.h>
#include <cstdio>
#include <cstdint>
#include <cmath>
#ifndef MK_ONE_LAUNCH
#define MK_ONE_LAUNCH 1
#endif
#ifndef PG8_STAGGER
#define PG8_STAGGER 0
#endif
namespace pg8 {
#define PG8_LAS __attribute__((address_space(3)))
typedef unsigned short bf16_t;
typedef short bf16x8 __attribute__((ext_vector_type(8)));
typedef float f32x4 __attribute__((ext_vector_type(4)));
typedef float f32x2 __attribute__((ext_vector_type(2)));
typedef unsigned u32x4 __attribute__((ext_vector_type(4)));
typedef int i32x4 __attribute__((ext_vector_type(4)));
typedef int i32x8 __attribute__((ext_vector_type(8)));
template <int PREC> struct AccT { typedef f32x4 type; }; template <> struct AccT<1> { typedef i32x4 type; };
constexpr int BM = 256, BK = 64, HALF = 128, HTB = HALF * BK * 2  , STAGE_BYTES = 8 * HTB, NXCD = 8, WGM = 8;

__host__ __device__ __forceinline__ int lds_byte(int r, int c) { const int st = (r >> 4) * 2 + (c >> 5), rr = r & 15, cc = c & 31, ob = rr * 64 + cc * 2; return st * 1024 + (ob ^ (((ob >> 9) & 1) << 5)); }
__host__ __device__ __forceinline__ void stage_rc(int b, int& R, int& C) { const int st = b / 1024, sb = b % 1024, swz = sb ^ (((sb >> 9) & 1) << 5); R = (st >> 1) * 16 + swz / 64; C = (st & 1) * 32 + (swz % 64) / 2; }
__host__ __device__ __forceinline__ int perm32(int rho) { const int n = rho >> 4, i = rho & 15; return 8 * (i >> 2) + 4 * n + (i & 3); }

struct Unit { int pm, pn; };
struct Gemm { const bf16_t* A; const bf16_t* Bt; int M, N, K; };
struct MoeInfo { const int* list; const int* tile_expert; size_t bstride; };

struct StaticOrder {
    int nM, nN, nwg, G, c;
    __host__ __device__ void init(int M, int N, int G_, int c_) { nM = M / BM; nN = N / BM; nwg = nM * nN; G = G_; c = c_; }
    __host__ __device__ bool next(int i, Unit& u) const {
        const long L = (long)i * G + c; if (L >= nwg) return false;
        int wgid = (int)L; { const int q = nwg / NXCD, r = nwg % NXCD, xcd = wgid % NXCD, off = wgid / NXCD; wgid = (xcd < r ? xcd * (q + 1) : r * (q + 1) + (xcd - r) * q) + off; }
        const int nig = WGM * nN, gid = wgid / nig, fm = gid * WGM, gsz = (nM - fm) < WGM ? (nM - fm) : WGM;
        u.pm = fm + ((wgid % nig) % gsz); u.pn = (wgid % nig) / gsz; return true;
    }
    __device__ __forceinline__ void a_ready(const Unit&) const {}
    __device__ __forceinline__ void done(const Unit&) const {}
};

__device__ __forceinline__ unsigned cvt_pk_bf16(float lo, float hi) { unsigned r; asm volatile("v_cvt_pk_bf16_f32 %0, %1, %2" : "=v"(r) : "v"(lo), "v"(hi)); return r; }


template <class Epi, class Sched, bool ALIGN_EPI, bool SP2, int MODE, int PREC = 0>
__device__ __forceinline__ void gemm_phase(PG8_LAS unsigned char* lds, const Gemm g, const Sched& S, const Epi& E, const MoeInfo mi) {
    const int tid = threadIdx.x, wid = __builtin_amdgcn_readfirstlane(tid >> 6), lane = tid & 63, wr = wid >> 2, wc = wid & 3, fr = lane & 15, fq = lane >> 4;
    int K_ = g.K; asm volatile("" : "+s"(K_));
    constexpr int ES = PREC ? 1 : 2;
    const int K = K_, nt = (K * ES) / (BK * 2);
    unsigned voffB[2]; int Rr[2], Cc[2];
#pragma unroll
    for (int i = 0; i < 2; ++i) { int R, C; stage_rc(tid * 16 + i * 8192, R, C); const int Rb = Epi::PERM ? ((R & ~31) + perm32(R & 31)) : R;
        Rr[i] = R; Cc[i] = C; voffB[i] = (unsigned)(Rb * K) * (unsigned)ES + (unsigned)C * 2u; }
    const size_t kstep = (size_t)(BK * 2);
    const size_t hstep = (size_t)HALF * K * ES;
    const size_t tstep = 2 * hstep;
    const unsigned ldsw = (unsigned)wid * 1024u;
    const int aoff = lds_byte(wr * 64 + fr, fq * 8), boff = lds_byte(wc * 32 + fr, fq * 8);
    const unsigned rowb = (unsigned)K * (unsigned)ES;
#define PG8_SA(b, h) (((b) * 2 + (h)) * HTB)
#define PG8_SB(b, h) ((4 + (b) * 2 + (h)) * HTB)
#define PG8_STAGE(bufoff, gbase, voff) do { _Pragma("unroll") for (int _i = 0; _i < 2; ++_i) \
        __builtin_amdgcn_global_load_lds((const unsigned*)((const char*)(gbase) + (voff)[_i]), (PG8_LAS unsigned*)(lds + (bufoff) + ldsw + _i * 8192), 16, 0, 0); } while (0)
#define PG8_LDA(dst, b, h) do { _Pragma("unroll") for (int m = 0; m < 4; ++m) { if constexpr (PREC == 2) { \
            const i32x4 lo_ = *(const PG8_LAS i32x4*)(lds + PG8_SA(b, h) + aoff + m * 2048), hi_ = *(const PG8_LAS i32x4*)(lds + PG8_SA(b, h) + aoff + m * 2048 + 1024); \
            dst##8[m] = (i32x8){lo_[0], lo_[1], lo_[2], lo_[3], hi_[0], hi_[1], hi_[2], hi_[3]}; } \
        else { _Pragma("unroll") for (int k = 0; k < 2; ++k) dst[m][k] = *(const PG8_LAS bf16x8*)(lds + PG8_SA(b, h) + aoff + m * 2048 + k * 1024); } } } while (0)
#define PG8_LDB(dst, b, h) do { _Pragma("unroll") for (int n = 0; n < 2; ++n) { if constexpr (PREC == 2) { \
            const i32x4 lo_ = *(const PG8_LAS i32x4*)(lds + PG8_SB(b, h) + boff + n * 2048), hi_ = *(const PG8_LAS i32x4*)(lds + PG8_SB(b, h) + boff + n * 2048 + 1024); \
            dst##8[n] = (i32x8){lo_[0], lo_[1], lo_[2], lo_[3], hi_[0], hi_[1], hi_[2], hi_[3]}; } \
        else { _Pragma("unroll") for (int k = 0; k < 2; ++k) dst[n][k] = *(const PG8_LAS bf16x8*)(lds + PG8_SB(b, h) + boff + n * 2048 + k * 1024); } } } while (0)
#define PG8_MMA(ai, bj, At, Bt) do { __builtin_amdgcn_s_setprio(1); _Pragma("unroll") for (int m = 0; m < 4; ++m) _Pragma("unroll") for (int n = 0; n < 2; ++n) { \
        if constexpr (PREC == 2) asm volatile("s_nop 1\n\tv_mfma_scale_f32_16x16x128_f8f6f4 %0, %1, %2, %0, %3, %3 op_sel_hi:[0,0,0]" : "+v"(acc[ai][bj][m][n]) : "v"(Bt##8[n]), "v"(At##8[m]), "v"(one_scale));   \
        else { _Pragma("unroll") for (int k = 0; k < 2; ++k) { \
            if constexpr (PREC == 1) acc[ai][bj][m][n] = __builtin_amdgcn_mfma_i32_16x16x64_i8(__builtin_bit_cast(i32x4, Bt[n][k]), __builtin_bit_cast(i32x4, At[m][k]), acc[ai][bj][m][n], 0, 0, 0); \
            else acc[ai][bj][m][n] = __builtin_amdgcn_mfma_f32_16x16x32_bf16(Bt[n][k], At[m][k], acc[ai][bj][m][n], 0, 0, 0); } } } __builtin_amdgcn_s_setprio(0); } while (0)
#define PG8_WAIT_V(n) asm volatile("s_waitcnt vmcnt(" #n ")" ::: "memory")
#define PG8_WAIT_L(n) asm volatile("s_waitcnt lgkmcnt(" #n ")" ::: "memory")
#define PG8_WAIT_V8R do { const int rlx_ = rlx_flag;   \
        if constexpr (Epi::NST >= 16) asm volatile("s_cmp_eq_u32 %0, 0\n\ts_cbranch_scc1 .Lpg8a%=\n\ts_waitcnt vmcnt(24)\n\ts_branch .Lpg8b%=\n.Lpg8a%=:\n\ts_waitcnt vmcnt(8)\n.Lpg8b%=:" :: "s"(rlx_) : "memory", "scc"); \
        else if constexpr (Epi::NST >= 8) asm volatile("s_cmp_eq_u32 %0, 0\n\ts_cbranch_scc1 .Lpg8a%=\n\ts_waitcnt vmcnt(16)\n\ts_branch .Lpg8b%=\n.Lpg8a%=:\n\ts_waitcnt vmcnt(8)\n.Lpg8b%=:" :: "s"(rlx_) : "memory", "scc"); \
        else PG8_WAIT_V(8); } while (0)
#define PG8_BAR __builtin_amdgcn_s_barrier()
#define PG8_SCHED __builtin_amdgcn_sched_barrier(0)
#define PG8_MKOFF(u, o) do { _Pragma("unroll") for (int _h = 0; _h < 2; ++_h) _Pragma("unroll") for (int _i = 0; _i < 2; ++_i) { \
        int _row = (u).pm * BM + _h * HALF + Rr[_i]; if (MODE == 1) _row = mi.list[_row]; (o)[_h][_i] = (unsigned)_row * rowb + (unsigned)Cc[_i] * 2u; } } while (0)
#define PG8_BBASE(u) ((const char*)g.Bt + (size_t)(u).pn * tstep + (MODE != 0 ? (size_t)mi.tile_expert[(u).pm] * mi.bstride : (size_t)0))
    Unit cur, nxt; int ui = 0;
    if (!S.next(0, cur)) return;
#if PG8_STAGGER
    {
        const int grp = ((int)blockIdx.x >> 3) & 3;
        if (grp) { if (wid == 0) { const unsigned long long t0 = __builtin_amdgcn_s_memrealtime(); const unsigned long long dt = (unsigned long long)(grp * nt * PG8_STAGGER);
                       while (__builtin_amdgcn_s_memrealtime() - t0 < dt) __builtin_amdgcn_s_sleep(8); }
                   __syncthreads(); }
    }
#endif
    typedef typename AccT<PREC>::type acc_t;
    acc_t acc[2][2][4][2];
#pragma unroll
    for (int a = 0; a < 2; ++a)
#pragma unroll
        for (int b = 0; b < 2; ++b)
#pragma unroll
            for (int m = 0; m < 4; ++m)
#pragma unroll
                for (int n = 0; n < 2; ++n) acc[a][b][m][n] = acc_t{};
    bf16x8 At[4][2], B0[2][2], B1[2][2];
    const int one_scale = 0x7f7f7f7f;
    unsigned oc[2][2], on[2][2];
    const char* const Ab = (const char*)g.A;
    const char* cAu = Ab;
    if constexpr (MODE == 1) { PG8_MKOFF(cur, oc); } else { Unit u0_; u0_.pm = 0; u0_.pn = 0; PG8_MKOFF(u0_, oc); cAu = Ab + (size_t)cur.pm * tstep; }
    const char* cB = PG8_BBASE(cur);
    S.a_ready(cur);
    static_assert(SP2, "only the SP2 loop is kept");
    {
        PG8_STAGE(PG8_SB(0, 0), cB, voffB); PG8_STAGE(PG8_SB(0, 1), cB + hstep, voffB); PG8_STAGE(PG8_SA(0, 0), cAu, oc[0]); PG8_STAGE(PG8_SA(0, 1), cAu, oc[1]);
        if (wr == 1) PG8_BAR;
        PG8_WAIT_V(2); PG8_BAR;
        PG8_STAGE(PG8_SB(1, 0), cB + kstep, voffB); PG8_STAGE(PG8_SA(1, 0), cAu + kstep, oc[0]); PG8_STAGE(PG8_SB(1, 1), cB + hstep + kstep, voffB);
        PG8_WAIT_V(6); PG8_BAR;
    }
    Unit nn; unsigned onn[2][2]; bool has_next_c = false;
    if constexpr (MODE == 1) { has_next_c = S.next(1, nxt); if (has_next_c) PG8_MKOFF(nxt, on); }
    int rlx_flag = 0;
    for (;;) {
        bool has_next; bool has_nn = false;
        if constexpr (MODE == 1) { has_next = has_next_c; has_nn = has_next && S.next(ui + 2, nn); if (has_nn) PG8_MKOFF(nn, onn); }
        else has_next = S.next(ui + 1, nxt);
        const char* nB = cB; const char* nAu = cAu;
        if (has_next) { if constexpr (MODE != 1) nAu = Ab + (size_t)nxt.pm * tstep; nB = PG8_BBASE(nxt); }
        else if constexpr (MODE == 1) {
#pragma unroll
            for (int _h = 0; _h < 2; ++_h)
#pragma unroll
                for (int _i = 0; _i < 2; ++_i) on[_h][_i] = oc[_h][_i];
        }
        for (int t = 0; t < nt; t += 2) {
            const bool last = (t == nt - 2);
            i32x8 At8[4], B08[2], B18[2];
            const char* a1 = cAu + (size_t)(t + 1) * kstep;
            const char* a2 = last ? nAu : cAu + (size_t)(t + 2) * kstep; const char* b2 = last ? nB : cB + (size_t)(t + 2) * kstep;
            const char* a3 = a2 + kstep; const char* b3 = b2 + kstep;
            unsigned o2[2][2];
#pragma unroll
            for (int _h = 0; _h < 2; ++_h)
#pragma unroll
                for (int _i = 0; _i < 2; ++_i) o2[_h][_i] = (MODE == 1 && last) ? on[_h][_i] : oc[_h][_i];
            if (last && has_next) S.a_ready(nxt);
            PG8_LDB(B0, 0, 0); PG8_LDB(B1, 0, 1); PG8_SCHED; PG8_LDA(At, 0, 0); PG8_STAGE(PG8_SA(1, 1), a1, oc[1]);
            PG8_WAIT_V8R; PG8_WAIT_L(0); PG8_BAR; PG8_MMA(0, 0, At, B0); PG8_MMA(0, 1, At, B1); PG8_BAR; PG8_SCHED;
            PG8_LDA(At, 0, 1); PG8_STAGE(PG8_SB(0, 0), b2, voffB); PG8_STAGE(PG8_SB(0, 1), b2 + hstep, voffB); PG8_STAGE(PG8_SA(0, 0), a2, o2[0]);
            PG8_WAIT_V8R; PG8_WAIT_L(0); PG8_BAR; PG8_MMA(1, 0, At, B0); PG8_MMA(1, 1, At, B1); PG8_BAR; PG8_SCHED;
            PG8_LDB(B0, 1, 0); PG8_LDB(B1, 1, 1); PG8_SCHED; PG8_LDA(At, 1, 0); PG8_STAGE(PG8_SA(0, 1), a2, o2[1]);
            PG8_WAIT_V(8); PG8_WAIT_L(0); PG8_BAR; PG8_MMA(0, 0, At, B0); PG8_MMA(0, 1, At, B1); PG8_BAR; PG8_SCHED;
            PG8_LDA(At, 1, 1); PG8_STAGE(PG8_SB(1, 0), b3, voffB); PG8_STAGE(PG8_SB(1, 1), b3 + hstep, voffB); PG8_STAGE(PG8_SA(1, 0), a3, o2[0]);
            PG8_WAIT_V(8); PG8_WAIT_L(0); PG8_BAR; PG8_MMA(1, 0, At, B0); PG8_MMA(1, 1, At, B1); PG8_BAR; PG8_SCHED;
            rlx_flag = 0; asm volatile("" : "+s"(rlx_flag));
        }
        if constexpr (ALIGN_EPI) { if (wr == 0) PG8_BAR; }
        if constexpr (PREC == 2) asm volatile("s_nop 15\n\ts_nop 15" ::: "memory");
        E(acc, cur, wr, wc, fr, fq); S.done(cur);
        if (!has_next) break;
#pragma unroll
        for (int a = 0; a < 2; ++a)
#pragma unroll
            for (int b = 0; b < 2; ++b)
#pragma unroll
                for (int m = 0; m < 4; ++m)
#pragma unroll
                    for (int n = 0; n < 2; ++n) acc[a][b][m][n] = acc_t{};
        cur = nxt; cB = nB; cAu = nAu; ++ui; rlx_flag = 1; asm volatile("" : "+s"(rlx_flag));
        if constexpr (MODE == 1) {
#pragma unroll
            for (int _h = 0; _h < 2; ++_h)
#pragma unroll
                for (int _i = 0; _i < 2; ++_i) oc[_h][_i] = on[_h][_i]; }
        if constexpr (MODE == 1) { nxt = nn; has_next_c = has_nn;
#pragma unroll
            for (int _h = 0; _h < 2; ++_h)
#pragma unroll
                for (int _i = 0; _i < 2; ++_i) on[_h][_i] = onn[_h][_i]; }
        if constexpr (ALIGN_EPI) { if (wr == 1) PG8_BAR; }
    }
    PG8_WAIT_V(0);
    if constexpr (!ALIGN_EPI) { if (wr == 0) PG8_BAR; }
    PG8_BAR;
#undef PG8_SA
#undef PG8_SB
#undef PG8_STAGE
#undef PG8_LDA
#undef PG8_LDB
#undef PG8_MMA
#undef PG8_WAIT_V
#undef PG8_WAIT_L
#undef PG8_WAIT_V8R
#undef PG8_BAR
#undef PG8_SCHED
#undef PG8_MKOFF
#undef PG8_BBASE
}
}
namespace pg8 {
constexpr float LOG2E = 1.4426950408889634f;
struct EpiBf16 {
    static constexpr bool PERM = true; static constexpr int NST = 16;
    bf16_t* O; int ldc; float scale;
    __device__ __forceinline__ void operator()(const f32x4 (&acc)[2][2][4][2], const Unit& u, int wr, int wc, int fr, int fq) const {
        const int row0 = u.pm * BM + wr * 64 + fr; const int col0 = u.pn * BM + wc * 32 + 8 * fq;
#pragma unroll
        for (int ai = 0; ai < 2; ++ai)
#pragma unroll
            for (int m = 0; m < 4; ++m) { bf16_t* rowp = O + (size_t)(row0 + ai * HALF + m * 16) * ldc + col0;
#pragma unroll
                for (int bj = 0; bj < 2; ++bj) { const f32x4 v0 = acc[ai][bj][m][0] * scale, v1 = acc[ai][bj][m][1] * scale;
                    u32x4 w; w.x = cvt_pk_bf16(v0[0], v0[1]); w.y = cvt_pk_bf16(v0[2], v0[3]); w.z = cvt_pk_bf16(v1[0], v1[1]); w.w = cvt_pk_bf16(v1[2], v1[3]);
                    *(u32x4*)(rowp + bj * HALF) = w; } }
    }
};
struct EpiQ {
    static constexpr bool PERM = true; static constexpr int NST = 16;
    bf16_t* O; int ldc; float scale; const float* cs;
    __device__ __forceinline__ void operator()(const f32x4 (&acc)[2][2][4][2], const Unit& u, int wr, int wc, int fr, int fq) const {
        const int row0 = u.pm * BM + wr * 64 + fr; const int col0 = u.pn * BM + wc * 32 + 8 * fq;
        const int grp = u.pn * 8 + wc;
#pragma unroll
        for (int bj = 0; bj < 2; ++bj) { const bool rope = ((grp + 4 * bj) % 3) == 2;
#pragma unroll
            for (int ai = 0; ai < 2; ++ai)
#pragma unroll
                for (int m = 0; m < 4; ++m) { const int row = row0 + ai * HALF + m * 16; bf16_t* rowp = O + (size_t)row * ldc + col0 + bj * HALF;
                    f32x4 v0 = acc[ai][bj][m][0] * scale, v1 = acc[ai][bj][m][1] * scale;
                    if (rope) { const f32x4* cp = (const f32x4*)(cs + (size_t)row * 32 + 8 * fq); const f32x4 c0 = cp[0], c1 = cp[1];
                        f32x4 r0, r1;
                        r0[0] = v0[0] * c0[0] - v0[1] * c0[1]; r0[1] = v0[0] * c0[1] + v0[1] * c0[0];
                        r0[2] = v0[2] * c0[2] - v0[3] * c0[3]; r0[3] = v0[2] * c0[3] + v0[3] * c0[2];
                        r1[0] = v1[0] * c1[0] - v1[1] * c1[1]; r1[1] = v1[0] * c1[1] + v1[1] * c1[0];
                        r1[2] = v1[2] * c1[2] - v1[3] * c1[3]; r1[3] = v1[2] * c1[3] + v1[3] * c1[2];
                        v0 = r0; v1 = r1; }
                    u32x4 w; w.x = cvt_pk_bf16(v0[0], v0[1]); w.y = cvt_pk_bf16(v0[2], v0[3]); w.z = cvt_pk_bf16(v1[0], v1[1]); w.w = cvt_pk_bf16(v1[2], v1[3]);
                    *(u32x4*)rowp = w;
                    if (m & 1) asm volatile("" ::: "memory"); } }
    }
};
struct EpiKV {
    static constexpr bool PERM = true; static constexpr int NST = 16;
    bf16_t* Kb; bf16_t* Vb;
    __device__ __forceinline__ void operator()(const f32x4 (&acc)[2][2][4][2], const Unit& u, int wr, int wc, int fr, int fq) const {
        const int row0 = u.pm * BM + wr * 64 + fr;
        const bool isk = wc < 2;
        bf16_t* const base = isk ? Kb : Vb; const int pitch = isk ? 1536 : 1024, hs = isk ? 96 : 64, j0 = (isk ? wc : wc - 2) * 32 + 8 * fq;
#pragma unroll
        for (int ai = 0; ai < 2; ++ai)
#pragma unroll
            for (int m = 0; m < 4; ++m) { bf16_t* rowp = base + (size_t)(row0 + ai * HALF + m * 16) * pitch + j0;
#pragma unroll
                for (int bj = 0; bj < 2; ++bj) { const f32x4 v0 = acc[ai][bj][m][0], v1 = acc[ai][bj][m][1];
                    u32x4 w; w.x = cvt_pk_bf16(v0[0], v0[1]); w.y = cvt_pk_bf16(v0[2], v0[3]); w.z = cvt_pk_bf16(v1[0], v1[1]); w.w = cvt_pk_bf16(v1[2], v1[3]);
                    *(u32x4*)(rowp + (2 * u.pn + bj) * hs) = w; } }
    }
};
template <bool BASEF32> struct EpiResid {
    static constexpr bool PERM = true; static constexpr int NST = 16;
    static constexpr int HP = 2048;
    const void* base; bf16_t* out; const float* gate; const float* sB;
    __device__ __forceinline__ void operator()(const f32x4 (&acc)[2][2][4][2], const Unit& u, int wr, int wc, int fr, int fq) const {
        const int row0 = u.pm * BM + wr * 64 + fr; const int col0 = u.pn * BM + wc * 32 + 8 * fq;
        const float* gp = gate + (size_t)((u.pm * BM) >> 13) * 1024 + col0;
        f32x4 gv[2][2];
#pragma unroll
        for (int bj = 0; bj < 2; ++bj)
#pragma unroll
            for (int n = 0; n < 2; ++n) { gv[bj][n] = *(const f32x4*)(gp + bj * HALF + n * 4); if (sB) gv[bj][n] = gv[bj][n] * *(const f32x4*)(sB + col0 + bj * HALF + n * 4); }
#pragma unroll
        for (int ai = 0; ai < 2; ++ai)
#pragma unroll
            for (int m = 0; m < 4; ++m) { const size_t row = (size_t)(row0 + ai * HALF + m * 16);
#pragma unroll
                for (int bj = 0; bj < 2; ++bj) { f32x4 b0, b1;
                    if (BASEF32) { const float* bp = (const float*)base + row * 1024 + col0 + bj * HALF; b0 = *(const f32x4*)bp; b1 = *(const f32x4*)(bp + 4); }
                    else { const u32x4 hb = *(const u32x4*)((const bf16_t*)base + row * HP + col0 + bj * HALF);
                        b0 = (f32x4){__builtin_bit_cast(float, hb.x << 16), __builtin_bit_cast(float, hb.x & 0xffff0000u), __builtin_bit_cast(float, hb.y << 16), __builtin_bit_cast(float, hb.y & 0xffff0000u)};
                        b1 = (f32x4){__builtin_bit_cast(float, hb.z << 16), __builtin_bit_cast(float, hb.z & 0xffff0000u), __builtin_bit_cast(float, hb.w << 16), __builtin_bit_cast(float, hb.w & 0xffff0000u)}; }
                    const f32x4 v0 = b0 + gv[bj][0] * acc[ai][bj][m][0], v1 = b1 + gv[bj][1] * acc[ai][bj][m][1];
                    u32x4 w; w.x = cvt_pk_bf16(v0[0], v0[1]); w.y = cvt_pk_bf16(v0[2], v0[3]); w.z = cvt_pk_bf16(v1[0], v1[1]); w.w = cvt_pk_bf16(v1[2], v1[3]);
                    *(u32x4*)(out + row * HP + col0 + bj * HALF) = w; }
                if (m & 1) asm volatile("" ::: "memory"); }
    }
};
__device__ __forceinline__ float silu_mul(float g, float u) { return g * u * __builtin_amdgcn_rcpf(1.0f + __builtin_amdgcn_exp2f(-g * LOG2E)); }
struct EpiSwiGLU {
    static constexpr bool PERM = true; static constexpr int NST = 8;
    bf16_t* O; int ldc;
    __device__ __forceinline__ void operator()(const f32x4 (&acc)[2][2][4][2], const Unit& u, int wr, int wc, int fr, int fq) const {
        const int row0 = u.pm * BM + wr * 64 + fr; const int col0 = u.pn * HALF + wc * 32 + 8 * fq;
#pragma unroll
        for (int ai = 0; ai < 2; ++ai)
#pragma unroll
            for (int m = 0; m < 4; ++m) { bf16_t* rowp = O + (size_t)(row0 + ai * HALF + m * 16) * ldc + col0;
                const f32x4 g0 = acc[ai][0][m][0], g1 = acc[ai][0][m][1], u0 = acc[ai][1][m][0], u1 = acc[ai][1][m][1];
                u32x4 w; w.x = cvt_pk_bf16(silu_mul(g0[0], u0[0]), silu_mul(g0[1], u0[1])); w.y = cvt_pk_bf16(silu_mul(g0[2], u0[2]), silu_mul(g0[3], u0[3]));
                w.z = cvt_pk_bf16(silu_mul(g1[0], u1[0]), silu_mul(g1[1], u1[1])); w.w = cvt_pk_bf16(silu_mul(g1[2], u1[2]), silu_mul(g1[3], u1[3]));
                *(u32x4*)rowp = w; }
    }
};
struct EpiMoeDown {
    static constexpr bool PERM = true; static constexpr int NST = 16;
    bf16_t* O; const float* sg; const float* sB; const int* tile_expert;
    __device__ __forceinline__ void operator()(const f32x4 (&acc)[2][2][4][2], const Unit& u, int wr, int wc, int fr, int fq) const {
        const int row0 = u.pm * BM + wr * 64 + fr; const int col0 = u.pn * BM + wc * 32 + 8 * fq;
        const float* sb = sB + (size_t)tile_expert[u.pm] * 1024 + col0;
        f32x4 sv[2][2];
#pragma unroll
        for (int bj = 0; bj < 2; ++bj)
#pragma unroll
            for (int n = 0; n < 2; ++n) sv[bj][n] = *(const f32x4*)(sb + bj * HALF + 4 * n);
#pragma unroll
        for (int ai = 0; ai < 2; ++ai)
#pragma unroll
            for (int m = 0; m < 4; ++m) { const int row = row0 + ai * HALF + m * 16; const float s = sg[row]; bf16_t* rowp = O + (size_t)row * 1024 + col0;
#pragma unroll
                for (int bj = 0; bj < 2; ++bj) { const f32x4 v0 = acc[ai][bj][m][0] * sv[bj][0] * s, v1 = acc[ai][bj][m][1] * sv[bj][1] * s;
                    u32x4 w; w.x = cvt_pk_bf16(v0[0], v0[1]); w.y = cvt_pk_bf16(v0[2], v0[3]); w.z = cvt_pk_bf16(v1[0], v1[1]); w.w = cvt_pk_bf16(v1[2], v1[3]);
                    *(u32x4*)(rowp + bj * HALF) = w; } }
    }
};
template <bool KV> struct EpiDil {
    static constexpr bool PERM = true; static constexpr int NST = 16;
    bf16_t* O; float scale;
    __device__ __forceinline__ void operator()(const f32x4 (&acc)[2][2][4][2], const Unit& u, int wr, int wc, int fr, int fq) const {
        const int row0 = u.pm * BM + wr * 64 + fr;
#pragma unroll
        for (int bj = 0; bj < 2; ++bj) { const int col = u.pn * BM + bj * HALF + wc * 32 + 8 * fq;
            const int g = KV ? (col >> 10) : (col >> 9), h = (col >> 6) & 7, d = col & 63, kv = KV ? ((col >> 9) & 1) : 0;
            const int sh = 2 * g;
#pragma unroll
            for (int ai = 0; ai < 2; ++ai)
#pragma unroll
                for (int m = 0; m < 4; ++m) { const int row = row0 + ai * HALF + m * 16, b = row >> 13, t = row & 8191;
                    const int r = t & ((1 << sh) - 1), pos = t >> sh;
                    const size_t rec = (size_t)g * 262144 + (size_t)((((b << sh) + r) * 8 + h) * (8192 >> sh) + pos);
                    bf16_t* dst = KV ? (O + rec * 128 + kv * 64 + d) : (O + rec * 64 + d);
                    const f32x4 v0 = acc[ai][bj][m][0] * scale, v1 = acc[ai][bj][m][1] * scale;
                    u32x4 w; w.x = cvt_pk_bf16(v0[0], v0[1]); w.y = cvt_pk_bf16(v0[2], v0[3]); w.z = cvt_pk_bf16(v1[0], v1[1]); w.w = cvt_pk_bf16(v1[2], v1[3]);
                    *(u32x4*)dst = w; } }
    }
};
}
namespace pg8 {
__device__ __forceinline__ f32x4 i2f(const i32x4& a, float sa, const f32x4& sb) { return (f32x4){(float)a[0], (float)a[1], (float)a[2], (float)a[3]} * sa * sb; }
struct EpiBf16Q {
    static constexpr bool PERM = true; static constexpr int NST = 16;
    bf16_t* O; int ldc; const float* sA; const float* sB;
    __device__ __forceinline__ void operator()(const i32x4 (&acc)[2][2][4][2], const Unit& u, int wr, int wc, int fr, int fq) const {
        const int row0 = u.pm * BM + wr * 64 + fr; const int col0 = u.pn * BM + wc * 32 + 8 * fq;
        f32x4 sb[2][2];
#pragma unroll
        for (int bj = 0; bj < 2; ++bj)
#pragma unroll
            for (int n = 0; n < 2; ++n) sb[bj][n] = *(const f32x4*)(sB + col0 + bj * HALF + 4 * n);
#pragma unroll
        for (int ai = 0; ai < 2; ++ai)
#pragma unroll
            for (int m = 0; m < 4; ++m) { const int row = row0 + ai * HALF + m * 16; const float sa = sA[row]; bf16_t* rowp = O + (size_t)row * ldc + col0;
#pragma unroll
                for (int bj = 0; bj < 2; ++bj) { const f32x4 v0 = i2f(acc[ai][bj][m][0], sa, sb[bj][0]), v1 = i2f(acc[ai][bj][m][1], sa, sb[bj][1]);
                    u32x4 w; w.x = cvt_pk_bf16(v0[0], v0[1]); w.y = cvt_pk_bf16(v0[2], v0[3]); w.z = cvt_pk_bf16(v1[0], v1[1]); w.w = cvt_pk_bf16(v1[2], v1[3]);
                    *(u32x4*)(rowp + bj * HALF) = w; } }
    }
};
template <bool KV> struct EpiDilQ {
    static constexpr bool PERM = true; static constexpr int NST = 16;
    bf16_t* O; const float* sA; const float* sB;
    __device__ __forceinline__ void operator()(const i32x4 (&acc)[2][2][4][2], const Unit& u, int wr, int wc, int fr, int fq) const {
        bf16_t* const O_ = O; constexpr float scale_ = KV ? 1.0f : 0.18033688011112042f; const float* const sA_ = sA; const float* const sB_ = sB;
        const int row0 = u.pm * BM + wr * 64 + fr;
        const int colt = u.pn * BM;
        const int g = KV ? (colt >> 10) : (colt >> 9), kv = KV ? ((colt >> 9) & 1) : 0, sh = 2 * g, npos = 8192 >> sh;
        constexpr int RS = KV ? 128 : 64;
        const int d = (wc & 1) * 32 + 8 * fq;
        size_t hoff[2]; f32x4 sb[2][2];
#pragma unroll
        for (int bj = 0; bj < 2; ++bj) { const int col = colt + bj * HALF + wc * 32 + 8 * fq; const int h = (col >> 6) & 7;
            hoff[bj] = (size_t)h * npos * RS + kv * 64 + d; sb[bj][0] = *(const f32x4*)(sB_ + col) * scale_; sb[bj][1] = *(const f32x4*)(sB_ + col + 4) * scale_; }
#pragma unroll
        for (int ai = 0; ai < 2; ++ai)
#pragma unroll
            for (int m = 0; m < 4; ++m) { const int row = row0 + ai * HALF + m * 16, b = row >> 13, t = row & 8191;
                const int r = t & ((1 << sh) - 1), pos = t >> sh;
                bf16_t* rp = O_ + ((size_t)g * 262144 + (size_t)(((b << sh) + r) * 8 * npos + pos)) * RS;
                const float sa = sA_[row];
#pragma unroll
                for (int bj = 0; bj < 2; ++bj) { const f32x4 v0 = i2f(acc[ai][bj][m][0], sa, sb[bj][0]), v1 = i2f(acc[ai][bj][m][1], sa, sb[bj][1]);
                    u32x4 w; w.x = cvt_pk_bf16(v0[0], v0[1]); w.y = cvt_pk_bf16(v0[2], v0[3]); w.z = cvt_pk_bf16(v1[0], v1[1]); w.w = cvt_pk_bf16(v1[2], v1[3]);
                    *(u32x4*)(rp + hoff[bj]) = w; }
                if (m & 1) asm volatile("" ::: "memory"); }
    }
};
constexpr float HSCALE = 8.0f;
__device__ __forceinline__ unsigned pk4_fp8(float a, float b, float c, float d) {
    a = __builtin_fminf(__builtin_fmaxf(a, -448.f), 448.f); b = __builtin_fminf(__builtin_fmaxf(b, -448.f), 448.f); c = __builtin_fminf(__builtin_fmaxf(c, -448.f), 448.f); d = __builtin_fminf(__builtin_fmaxf(d, -448.f), 448.f);
    int w = 0; w = __builtin_amdgcn_cvt_pk_fp8_f32(a, b, w, false); w = __builtin_amdgcn_cvt_pk_fp8_f32(c, d, w, true); return (unsigned)w; }
struct EpiSwiGLUQ {
    static constexpr bool PERM = true; static constexpr int NST = 8;
    unsigned char* O; int ldc; const float* sA; const float* sB; const int* tile_expert;
    __device__ __forceinline__ void operator()(const i32x4 (&acc)[2][2][4][2], const Unit& u, int wr, int wc, int fr, int fq) const {
        const int row0 = u.pm * BM + wr * 64 + fr; const int col0 = u.pn * HALF + wc * 32 + 8 * fq;
        const float* sb = sB + (tile_expert ? (size_t)tile_expert[u.pm] * (2 * 2816) : (size_t)0) + u.pn * BM + wc * 32 + 8 * fq;
        const f32x4 sg0 = *(const f32x4*)sb, sg1 = *(const f32x4*)(sb + 4), su0 = *(const f32x4*)(sb + HALF) * HSCALE, su1 = *(const f32x4*)(sb + HALF + 4) * HSCALE;
        typedef unsigned u32x2 __attribute__((ext_vector_type(2)));
#pragma unroll
        for (int ai = 0; ai < 2; ++ai)
#pragma unroll
            for (int m = 0; m < 4; ++m) { const int row = row0 + ai * HALF + m * 16; const float sa = sA[row]; unsigned char* rowp = O + (size_t)row * ldc + col0;
                const f32x4 g0 = i2f(acc[ai][0][m][0], sa, sg0), g1 = i2f(acc[ai][0][m][1], sa, sg1), u0 = i2f(acc[ai][1][m][0], sa, su0), u1 = i2f(acc[ai][1][m][1], sa, su1);
                u32x2 w; w.x = pk4_fp8(silu_mul(g0[0], u0[0]), silu_mul(g0[1], u0[1]), silu_mul(g0[2], u0[2]), silu_mul(g0[3], u0[3]));
                w.y = pk4_fp8(silu_mul(g1[0], u1[0]), silu_mul(g1[1], u1[1]), silu_mul(g1[2], u1[2]), silu_mul(g1[3], u1[3]));
                *(u32x2*)rowp = w; }
    }
};
}
namespace att {
using bf16 = unsigned short;
using bf16x8 = __attribute__((ext_vector_type(8))) short;
using s16x4 = __attribute__((ext_vector_type(4))) short;
using f32x16 = __attribute__((ext_vector_type(16))) float;
using u32x4 = __attribute__((ext_vector_type(4))) unsigned;
constexpr int NW = 8;
constexpr float THR = 8.0f;
__device__ __forceinline__ int crow(int r, int hi) { return (r & 3) + 8 * (r >> 2) + 4 * hi; }
__device__ __forceinline__ void glds16(const void* gsrc, unsigned lds_dst) { unsigned keep;
    asm volatile("s_mov_b32 %0, m0\n\ts_mov_b32 m0, %2\n\ts_nop 0\n\tglobal_load_lds_dwordx4 %1, off\n\ts_mov_b32 m0, %0" : "=&s"(keep) : "v"(gsrc), "s"(lds_dst) : "memory"); }
typedef float f32x2_t __attribute__((ext_vector_type(2))); typedef __bf16 bf16x2_t __attribute__((ext_vector_type(2)));
__device__ __forceinline__ unsigned cvtpk_s(float lo, float hi) { f32x2_t v = {lo, hi}; bf16x2_t b = __builtin_convertvector(v, bf16x2_t); return __builtin_bit_cast(unsigned, b); }
#define ATT_SBAR() __builtin_amdgcn_sched_barrier(0)
#define ATT_WAIT_BAR(N) asm volatile("s_waitcnt vmcnt(" #N ") lgkmcnt(0)\n\ts_barrier" ::: "memory")

template <int DQK> struct Lay {
    static constexpr int NKC = DQK / 8, KSLOT = NKC * 1024, ND0 = DQK / 16;
    static constexpr int LK = 0, LV = 3 * KSLOT, LWS = LV + 3 * 8192, LOST = LWS + NW * 256, LBIAS = LOST + NW * 4096, LEND = LBIAS + 1024;
};
static_assert(Lay<96>::LEND <= 131072 && Lay<64>::LEND <= 131072, "attention LDS");

__device__ __forceinline__ float rowmax32(const f32x16& p0, const f32x16& p1) {
    float a = __builtin_fmaxf(__builtin_fmaxf(p0[0], p0[1]), p1[0]), b = __builtin_fmaxf(__builtin_fmaxf(p0[2], p0[3]), p1[1]); a = __builtin_fmaxf(__builtin_fmaxf(a, p1[2]), p1[3]);
#pragma unroll
    for (int r = 4; r < 16; r += 4) { a = __builtin_fmaxf(__builtin_fmaxf(a, p0[r]), p0[r + 1]); b = __builtin_fmaxf(__builtin_fmaxf(b, p0[r + 2]), p0[r + 3]); a = __builtin_fmaxf(__builtin_fmaxf(a, p1[r]), p1[r + 1]); b = __builtin_fmaxf(__builtin_fmaxf(b, p1[r + 2]), p1[r + 3]); }
    float m = __builtin_fmaxf(a, b);
    auto rr = __builtin_amdgcn_permlane32_swap(__float_as_uint(m), __float_as_uint(m), false, false);
    return __builtin_fmaxf(__uint_as_float(rr[0]), __uint_as_float(rr[1]));
}
__device__ __forceinline__ void pv(f32x16* o, int vb, bf16x8 pa0, bf16x8 pa1, bf16x8 pa2, bf16x8 pa3) {
#pragma unroll
    for (int d0 = 0; d0 < 2; ++d0) { s16x4 lo[4], hi[4];
#pragma unroll
        for (int ks = 0; ks < 4; ++ks) {
            asm volatile("ds_read_b64_tr_b16 %0,%1 offset:%c2" : "=&v"(lo[ks]) : "v"(vb), "i"(d0 * 4096 + ks * 1024) : "memory");
            asm volatile("ds_read_b64_tr_b16 %0,%1 offset:%c2" : "=&v"(hi[ks]) : "v"(vb), "i"(d0 * 4096 + ks * 1024 + 512) : "memory"); }
        asm volatile("s_waitcnt lgkmcnt(0)" ::: "memory"); ATT_SBAR();
#define ATT_PK(k) (bf16x8){lo[k][0], lo[k][1], lo[k][2], lo[k][3], hi[k][0], hi[k][1], hi[k][2], hi[k][3]}
        o[d0] = __builtin_amdgcn_mfma_f32_32x32x16_bf16(pa0, ATT_PK(0), o[d0], 0, 0, 0);
        o[d0] = __builtin_amdgcn_mfma_f32_32x32x16_bf16(pa1, ATT_PK(1), o[d0], 0, 0, 0);
        o[d0] = __builtin_amdgcn_mfma_f32_32x32x16_bf16(pa2, ATT_PK(2), o[d0], 0, 0, 0);
        o[d0] = __builtin_amdgcn_mfma_f32_32x32x16_bf16(pa3, ATT_PK(3), o[d0], 0, 0, 0);
#undef ATT_PK
    }
}

template <int DQK, bool DIL>
__device__ __forceinline__ void attn_unit(const bf16* Qb, int pq, const bf16* __restrict__ Kb, int pk, const bf16* __restrict__ Vb, int pvp, bf16* Ob, int po, float* lse, const float* biasg,
                                          long rowbase, int dil, int q0, char* shm) {
    typedef Lay<DQK> L;
    const int tid = threadIdx.x, lane = tid & 63, r32 = lane & 31, hi = lane >> 5; const int wid = __builtin_amdgcn_readfirstlane(tid >> 6);
    const unsigned lds0 = (unsigned)(uintptr_t)shm;
    float* wsf = (float*)(shm + L::LWS) + wid * 64;
    const int kpos0 = DIL ? q0 - 128 : 0;
    const int t_begin = DIL ? (q0 == 0 ? 2 : 0) : 0;
    const int t_end = DIL ? 6 : (q0 + 256) / 64;
    const int wt0 = DIL ? (wid >> 1) : 0;
    const int wt1 = DIL ? 2 + (wid >> 1) : (q0 + 32 * wid + 31) / 64;
    const bool two_k = (L::NKC > 8) && (wid + 8 < L::NKC);
#define ATT_GROW(pos) (rowbase + (long)(pos) * dil)
#define ATT_ISSUE(t, s) do { const int kp_ = kpos0 + 64 * (t); \
        glds16(Kb + ATT_GROW(kp_ + lane) * pk + wid * 8, (unsigned)__builtin_amdgcn_readfirstlane(lds0 + L::LK + (s) * L::KSLOT + wid * 1024)); \
        if (two_k) glds16(Kb + ATT_GROW(kp_ + lane) * pk + (wid + 8) * 8, (unsigned)__builtin_amdgcn_readfirstlane(lds0 + L::LK + (s) * L::KSLOT + (wid + 8) * 1024)); \
        glds16(Vb + ATT_GROW(kp_ + 16 * (wid & 3) + (lane >> 2)) * pvp + (wid >> 2) * 32 + (lane & 3) * 8, (unsigned)__builtin_amdgcn_readfirstlane(lds0 + L::LV + (s) * 8192 + wid * 1024)); } while (0)
    if (DIL) { if (tid < 129) ((float*)(shm + L::LBIAS))[tid] = biasg[tid]; }
    ATT_ISSUE(t_begin, 0);
    if (t_begin + 1 < t_end) ATT_ISSUE(t_begin + 1, 1);
    bf16x8 qr[L::ND0];
    { const bf16* Qw = Qb + ATT_GROW(q0 + wid * 32 + r32) * pq + hi * 8;
#pragma unroll
      for (int d0 = 0; d0 < L::ND0; ++d0) qr[d0] = *reinterpret_cast<const bf16x8*>(Qw + d0 * 16); }
    float mhat = 0.f, l_reg = 0.f; f32x16 o[2]; o[0] = f32x16{}; o[1] = f32x16{}; f32x16 negm = f32x16{};
    bool first = true;
    const int qrel = (DIL ? 128 : q0) + wid * 32 + r32;
    const int vbl = (int)(lds0 + L::LV) + ((lane >> 4) & 1) * 32 + (lane & 3) * 8 + (4 * hi + ((lane & 15) >> 2)) * 64;
    int slot = 0;
    for (int t = t_begin; t < t_end; ++t) {
        if (t + 1 < t_end) { if (two_k) ATT_WAIT_BAR(3); else ATT_WAIT_BAR(2); } else ATT_WAIT_BAR(0);
        if (t + 2 < t_end) { const int s2 = slot >= 1 ? slot - 1 : 2; ATT_ISSUE(t + 2, s2); }
        if (t >= wt0 && t <= wt1) {
            f32x16 p0, p1;
            { const char* kb = shm + L::LK + slot * L::KSLOT + hi * 1024 + r32 * 16;
#pragma unroll
              for (int d0 = 0; d0 < L::ND0; ++d0) {
                const bf16x8 b0 = *reinterpret_cast<const bf16x8*>(kb + d0 * 2048);
                const bf16x8 b1 = *reinterpret_cast<const bf16x8*>(kb + d0 * 2048 + 512);
                if (d0 == 0) { p0 = __builtin_amdgcn_mfma_f32_32x32x16_bf16(b0, qr[0], negm, 0, 0, 0); p1 = __builtin_amdgcn_mfma_f32_32x32x16_bf16(b1, qr[0], negm, 0, 0, 0); }
                else { p0 = __builtin_amdgcn_mfma_f32_32x32x16_bf16(b0, qr[d0], p0, 0, 0, 0); p1 = __builtin_amdgcn_mfma_f32_32x32x16_bf16(b1, qr[d0], p1, 0, 0, 0); } } }
            if (DIL) { const float* bl = (const float*)(shm + L::LBIAS); const int jb = qrel - 64 * t - 4 * hi;
#pragma unroll
                for (int r = 0; r < 16; ++r) { const int j0 = jb - ((r & 3) + 8 * (r >> 2)), j1 = j0 - 32;
                    const int c0 = j0 < 0 ? 0 : (j0 > 128 ? 128 : j0), c1 = j1 < 0 ? 0 : (j1 > 128 ? 128 : j1);
                    const float b0 = bl[c0], b1 = bl[c1];
                    p0[r] = (j0 >= 0 && j0 <= 128) ? p0[r] + b0 : -INFINITY; p1[r] = (j1 >= 0 && j1 <= 128) ? p1[r] + b1 : -INFINITY; }
            } else if (64 * t + 63 > q0 + 32 * wid) { const int jb = qrel - 64 * t - 4 * hi;
#pragma unroll
                for (int r = 0; r < 16; ++r) { const int j0 = jb - ((r & 3) + 8 * (r >> 2)); if (j0 < 0) p0[r] = -INFINITY; if (j0 - 32 < 0) p1[r] = -INFINITY; } }
            const float rm = rowmax32(p0, p1);
            if (first) { first = false; const float dl = rm; mhat += dl;
#pragma unroll
                for (int r = 0; r < 16; ++r) { p0[r] -= dl; p1[r] -= dl; }
#pragma unroll
                for (int r = 0; r < 16; ++r) negm[r] = -mhat;
            } else if (__any(rm > THR)) { const float dl = __builtin_fmaxf(rm, 0.f); mhat += dl;
#pragma unroll
                for (int r = 0; r < 16; ++r) { p0[r] -= dl; p1[r] -= dl; }
#pragma unroll
                for (int r = 0; r < 16; ++r) negm[r] = -mhat;
                const float f = __builtin_amdgcn_exp2f(-dl); l_reg *= f; if (hi == 0) wsf[r32] = f;
                asm volatile("s_waitcnt lgkmcnt(0)" ::: "memory");
#pragma unroll
                for (int d_ = 0; d_ < 2; ++d_)
#pragma unroll
                    for (int r = 0; r < 16; ++r) o[d_][r] *= wsf[crow(r, hi)];
                asm volatile("s_waitcnt lgkmcnt(0)" ::: "memory");
            }
            float sacc = 0.f;
#pragma unroll
            for (int r = 0; r < 16; ++r) { p0[r] = __builtin_amdgcn_exp2f(p0[r]); p1[r] = __builtin_amdgcn_exp2f(p1[r]); sacc += p0[r] + p1[r]; }
            l_reg += sacc;
            u32x4 pw0, pw1, pw2, pw3;
#define ATT_PKW(P, B) cvtpk_s(P[B], P[B + 1])
            pw0 = (u32x4){ATT_PKW(p0, 0), ATT_PKW(p0, 2), ATT_PKW(p0, 4), ATT_PKW(p0, 6)}; pw1 = (u32x4){ATT_PKW(p0, 8), ATT_PKW(p0, 10), ATT_PKW(p0, 12), ATT_PKW(p0, 14)};
            pw2 = (u32x4){ATT_PKW(p1, 0), ATT_PKW(p1, 2), ATT_PKW(p1, 4), ATT_PKW(p1, 6)}; pw3 = (u32x4){ATT_PKW(p1, 8), ATT_PKW(p1, 10), ATT_PKW(p1, 12), ATT_PKW(p1, 14)};
#undef ATT_PKW
            ATT_SBAR();
            pv(o, vbl + slot * 8192, __builtin_bit_cast(bf16x8, pw0), __builtin_bit_cast(bf16x8, pw1), __builtin_bit_cast(bf16x8, pw2), __builtin_bit_cast(bf16x8, pw3));
        }
        slot = slot == 2 ? 0 : slot + 1;
    }
    { auto rr = __builtin_amdgcn_permlane32_swap(__float_as_uint(l_reg), __float_as_uint(l_reg), false, false); l_reg = __uint_as_float(rr[0]) + __uint_as_float(rr[1]); }
    if (hi == 0) wsf[32 + r32] = l_reg;
    asm volatile("s_waitcnt lgkmcnt(0)" ::: "memory");
    float rli[16];
#pragma unroll
    for (int r = 0; r < 16; ++r) rli[r] = __builtin_amdgcn_rcpf(wsf[32 + crow(r, hi)]);
    if (DIL) { if (hi == 0) lse[ATT_GROW(q0 + wid * 32 + r32) * 8] = mhat + __builtin_amdgcn_logf(l_reg); }
    { bf16* stg = (bf16*)(shm + L::LOST) + wid * 2048;
#pragma unroll
      for (int r = 0; r < 16; ++r) { const int orow = crow(r, hi);
#pragma unroll
        for (int d0 = 0; d0 < 2; ++d0) stg[orow * 64 + d0 * 32 + r32] = (bf16)(cvtpk_s(o[d0][r] * rli[r], 0.f) & 0xffffu); }
      asm volatile("s_waitcnt lgkmcnt(0)" ::: "memory");
#pragma unroll
      for (int i = 0; i < 4; ++i) { const int row = i * 8 + (lane >> 3), ch = lane & 7; const u32x4 v = *(const u32x4*)(stg + row * 64 + ch * 8);
        *(u32x4*)(Ob + ATT_GROW(q0 + wid * 32 + row) * po + ch * 8) = v; } }
    asm volatile("s_waitcnt lgkmcnt(0)\n\ts_barrier" ::: "memory");
#undef ATT_GROW
#undef ATT_ISSUE
}
#undef ATT_SBAR
#undef ATT_WAIT_BAR
}
namespace mla {
using bf16 = unsigned short;
using bf16x8 = __attribute__((ext_vector_type(8))) short;
using s16x4 = __attribute__((ext_vector_type(4))) short;
using f32x16 = __attribute__((ext_vector_type(16))) float;
using u32x4 = __attribute__((ext_vector_type(4))) unsigned;
constexpr int SEQL = 8192, PQ = 1536, PV = 1024, HQ = 96, HV = 64;
constexpr int NW = 8, QBLK = 32, QB = QBLK * NW, KVBLK = 64;
__device__ __forceinline__ int crow(int r, int hi) { return (r & 3) + 8 * (r >> 2) + 4 * hi; }
#define SBAR() __builtin_amdgcn_sched_barrier(0)
__device__ __forceinline__ void cmask(f32x16& p0, f32x16& p1, int jb, int qrel, int hi) {
    const float NEG = -INFINITY; int kb = 64 * jb + 4 * hi;
#pragma unroll
    for (int r = 0; r < 16; ++r) { int kv = kb + (r & 3) + 8 * (r >> 2); if (kv > qrel) p0[r] = NEG; if (kv + 32 > qrel) p1[r] = NEG; }
}
constexpr int NSLOT = 3, KSLOTB = 12288, VSLOTB = 8192;
constexpr int LDS_K = 0, LDS_V = NSLOT * KSLOTB, LDS_WS = LDS_V + NSLOT * VSLOTB, LDS_OST = LDS_WS + NW * 64 * 4, LDS_BYTES = LDS_OST + NW * 4096;
static_assert(LDS_BYTES <= 131072, "mla attention LDS");
__device__ __forceinline__ void glds16(const void* gsrc, unsigned lds_dst) { unsigned keep;
    asm volatile("s_mov_b32 %0, m0\n\ts_mov_b32 m0, %2\n\ts_nop 0\n\tglobal_load_lds_dwordx4 %1, off\n\ts_mov_b32 m0, %0" : "=&s"(keep) : "v"(gsrc), "s"(lds_dst) : "memory"); }
__device__ __forceinline__ float max3f(float a, float b, float c) { float r; asm("v_max3_f32 %0, %1, %2, %3" : "=v"(r) : "v"(a), "v"(b), "v"(c)); return r; }
__device__ __forceinline__ float max2f(float a, float b) { float r; asm("v_max_f32_e32 %0, %1, %2" : "=v"(r) : "v"(a), "v"(b)); return r; }
__device__ __forceinline__ float fadd_s(float a, float b) { float r; asm("v_add_f32_e32 %0, %1, %2" : "=v"(r) : "v"(a), "v"(b)); return r; }
__device__ __forceinline__ float fsub_s(float a, float b) { float r; asm("v_sub_f32_e32 %0, %1, %2" : "=v"(r) : "v"(a), "v"(b)); return r; }
typedef float f32x2_t __attribute__((ext_vector_type(2))); typedef __bf16 bf16x2_t __attribute__((ext_vector_type(2)));
__device__ __forceinline__ unsigned cvtpk_s(float lo, float hi) { f32x2_t v = {lo, hi}; bf16x2_t b = __builtin_convertvector(v, bf16x2_t); return __builtin_bit_cast(unsigned, b); }
#define WAIT_BAR(N) asm volatile("s_waitcnt vmcnt(" #N ") lgkmcnt(0)\n\ts_barrier" ::: "memory")

__device__ __forceinline__ void qkt(f32x16& p0, f32x16& p1, const char* Kslot, const bf16x8* qr, const f32x16& negm, int r32, int hi) {
    const char* kb = Kslot + hi * 1024 + r32 * 16;
#pragma unroll
    for (int d0 = 0; d0 < 6; ++d0) {
        const bf16x8 b0 = *reinterpret_cast<const bf16x8*>(kb + d0 * 2048);
        const bf16x8 b1 = *reinterpret_cast<const bf16x8*>(kb + d0 * 2048 + 512);
        if (d0 == 0) { p0 = __builtin_amdgcn_mfma_f32_32x32x16_bf16(b0, qr[0], negm, 0, 0, 0); p1 = __builtin_amdgcn_mfma_f32_32x32x16_bf16(b1, qr[0], negm, 0, 0, 0); }
        else { p0 = __builtin_amdgcn_mfma_f32_32x32x16_bf16(b0, qr[d0], p0, 0, 0, 0); p1 = __builtin_amdgcn_mfma_f32_32x32x16_bf16(b1, qr[d0], p1, 0, 0, 0); } }
}
typedef __attribute__((address_space(3))) const char* lds_cptr;
typedef short v4i16_t __attribute__((ext_vector_type(4)));
__device__ __forceinline__ void kload12(bf16x8* kf, lds_cptr kp) {
#pragma unroll
    for (int j = 0; j < 6; ++j) { kf[2 * j] = *(const __attribute__((address_space(3))) bf16x8*)(kp + j * 2048); kf[2 * j + 1] = *(const __attribute__((address_space(3))) bf16x8*)(kp + j * 2048 + 512); }
}
__device__ __forceinline__ void kload2(bf16x8* kf, lds_cptr kp, int j) { kf[2 * j] = *(const __attribute__((address_space(3))) bf16x8*)(kp + j * 2048); kf[2 * j + 1] = *(const __attribute__((address_space(3))) bf16x8*)(kp + j * 2048 + 512); }
__device__ __forceinline__ s16x4 vtr(lds_cptr p) { return __builtin_bit_cast(s16x4, __builtin_amdgcn_ds_read_tr16_b64_v4i16((__attribute__((address_space(3))) v4i16_t*)p)); }
__device__ __forceinline__ float rowmax(const f32x16& p0, const f32x16& p1) {
    float a = max3f(p0[0], p0[1], p1[0]), b = max3f(p0[2], p0[3], p1[1]); a = max3f(a, p1[2], p1[3]);
#pragma unroll
    for (int r = 4; r < 16; r += 4) { a = max3f(a, p0[r], p0[r + 1]); b = max3f(b, p0[r + 2], p0[r + 3]); a = max3f(a, p1[r], p1[r + 1]); b = max3f(b, p1[r + 2], p1[r + 3]); }
    const float m = max2f(a, b);
    auto rr = __builtin_amdgcn_permlane32_swap(__float_as_uint(m), __float_as_uint(m), false, false);
    return max2f(__uint_as_float(rr[0]), __uint_as_float(rr[1]));
}
__device__ __forceinline__ void pv(f32x16* o, int vb, bf16x8 pa0, bf16x8 pa1, bf16x8 pa2, bf16x8 pa3) {
#pragma unroll
    for (int d0 = 0; d0 < 2; ++d0) { s16x4 lo[4], hi[4];
#pragma unroll
        for (int ks = 0; ks < 4; ++ks) {
            asm volatile("ds_read_b64_tr_b16 %0,%1 offset:%c2" : "=&v"(lo[ks]) : "v"(vb), "i"(d0 * 4096 + ks * 1024) : "memory");
            asm volatile("ds_read_b64_tr_b16 %0,%1 offset:%c2" : "=&v"(hi[ks]) : "v"(vb), "i"(d0 * 4096 + ks * 1024 + 512) : "memory"); }
        asm volatile("s_waitcnt lgkmcnt(0)" ::: "memory"); SBAR();
#define PK(k) (bf16x8){lo[k][0], lo[k][1], lo[k][2], lo[k][3], hi[k][0], hi[k][1], hi[k][2], hi[k][3]}
        o[d0] = __builtin_amdgcn_mfma_f32_32x32x16_bf16(pa0, PK(0), o[d0], 0, 0, 0);
        o[d0] = __builtin_amdgcn_mfma_f32_32x32x16_bf16(pa1, PK(1), o[d0], 0, 0, 0);
        o[d0] = __builtin_amdgcn_mfma_f32_32x32x16_bf16(pa2, PK(2), o[d0], 0, 0, 0);
        o[d0] = __builtin_amdgcn_mfma_f32_32x32x16_bf16(pa3, PK(3), o[d0], 0, 0, 0);
#undef PK
    }
}

template <int THRL> __device__ __forceinline__ void attn_unit(int b, int h, int qb, const bf16* Q, const bf16* __restrict__ K, const bf16* __restrict__ V, bf16* O, char* shm) {
    int tid_ = threadIdx.x; asm volatile("" : "+v"(tid_));
    const int tid = tid_, lane = tid & 63, r32 = lane & 31, hi = lane >> 5; const int wid = __builtin_amdgcn_readfirstlane(tid >> 6);
    const long rowbase = (long)b * SEQL; const int q0 = qb * QB;
    const bf16* Qw = Q + (rowbase + q0 + wid * QBLK) * PQ + h * HQ;
    const bf16* Kh = K + rowbase * PQ + h * HQ; const bf16* Vh = V + rowbase * PV + h * HV;
    const unsigned lds0 = (unsigned)(uintptr_t)shm;
    float* wsf = (float*)(shm + LDS_WS) + wid * 64;
    const bool k2 = wid < 4;
    const bf16* ksrc = Kh + (long)lane * PQ + wid * 8;
    const bf16* vsrc = Vh + (long)(16 * (wid & 3) + (lane >> 2)) * PV + (wid >> 2) * 32 + (lane & 3) * 8;
    const unsigned kdst = lds0 + LDS_K + wid * 1024, vdst = lds0 + LDS_V + wid * 1024;
#define DMA_K(t, slot) do { glds16(ksrc + (long)(t) * KVBLK * PQ, (unsigned)__builtin_amdgcn_readfirstlane(kdst + (slot))); \
        if (k2) glds16(ksrc + (long)(t) * KVBLK * PQ + 64, (unsigned)__builtin_amdgcn_readfirstlane(kdst + (slot) + 8192)); } while (0)
#define DMA_V(t, slot) glds16(vsrc + (long)(t) * KVBLK * PV, (unsigned)__builtin_amdgcn_readfirstlane(vdst + (slot)))
    const int vb0 = (int)(lds0 + LDS_V) + ((lane >> 4) & 1) * 32 + (lane & 3) * 8 + (4 * hi + ((lane & 15) >> 2)) * 64;
    const char* Kbase = shm + LDS_K; bf16x8 kf[12];
    const lds_cptr shm3 = (lds_cptr)shm; const lds_cptr kp0 = shm3 + LDS_K + hi * 1024 + r32 * 16; const lds_cptr vp0 = shm3 + LDS_V + ((lane >> 4) & 1) * 32 + (lane & 3) * 8 + (4 * hi + ((lane & 15) >> 2)) * 64;
    const int NT = (q0 + QB) / KVBLK;
#define WAIT_KV() do { if (k2) WAIT_BAR(3); else WAIT_BAR(2); } while (0)
#define WAIT_KKV() do { if (k2) WAIT_BAR(5); else WAIT_BAR(3); } while (0)
    DMA_K(0, 0); DMA_V(0, 0); DMA_K(1, KSLOTB);
    bf16x8 qr[6];
#pragma unroll
    for (int d0 = 0; d0 < 6; ++d0) qr[d0] = *reinterpret_cast<const bf16x8*>(&Qw[(long)r32 * PQ + d0 * 16 + hi * 8]);
    float mhat = 0.f, l_reg = 0.f; f32x16 o[2]; o[0] = f32x16{}; o[1] = f32x16{}; f32x16 negm = f32x16{}; asm volatile("" : "+v"(negm));
    const int qrel = wid * QBLK + r32;
#define CMASK(P0, P1, t) do { int jb_ = (t) - (NT - 4); if (jb_ >= 0) cmask(P0, P1, jb_, qrel, hi); } while (0)
    bool resc = false;
#define START(P0, P1) do { const float rm = rowmax(P0, P1); resc = false; \
    { const float dl = rm; mhat = fadd_s(mhat, dl); \
      _Pragma("unroll") for (int r = 0; r < 16; ++r) { P0[r] = fsub_s(P0[r], dl); P1[r] = fsub_s(P1[r], dl); } \
      _Pragma("unroll") for (int r = 0; r < 16; ++r) negm[r] = -mhat; asm volatile("" : "+v"(negm)); } \
    _Pragma("unroll") for (int r = 0; r < 16; ++r) P0[r] = __builtin_amdgcn_exp2f(P0[r]); } while (0)
#define RESC() do { if (resc) { asm volatile("s_waitcnt lgkmcnt(0)" ::: "memory"); \
      _Pragma("unroll") for (int d_ = 0; d_ < 2; ++d_) _Pragma("unroll") for (int r = 0; r < 16; ++r) o[d_][r] *= wsf[crow(r, hi)]; } } while (0)
    f32x16 pA0, pA1, pB0, pB1;
    int sl_prev = 0, sl_cur = 0, sl_next = 1;
#define ROT() do { sl_prev = sl_cur; sl_cur = sl_next; sl_next = (sl_next == NSLOT - 1) ? 0 : sl_next + 1; } while (0)
    DMA_K(2, 2 * KSLOTB);
    WAIT_KKV();
    qkt(pA0, pA1, Kbase, qr, negm, r32, hi); asm volatile("s_nop 15\n\ts_nop 7" : "+v"(pA0), "+v"(pA1)); CMASK(pA0, pA1, 0);
    START(pA0, pA1);
#pragma unroll
    for (int r = 0; r < 16; ++r) pA1[r] = __builtin_amdgcn_exp2f(pA1[r]);
    WAIT_BAR(0);
    DMA_K(3, 0); DMA_V(1, VSLOTB);
    ROT();
    kload12(kf, kp0 + sl_cur * KSLOTB);
    WAIT_KV();
    s16x4 vlo[8], vhi[8]; u32x4 pw0, pw1, pw2, pw3;
#define PKW(P, B) cvtpk_s(P[B], P[B + 1])
#define PAF(k) __builtin_bit_cast(bf16x8, pw##k)
#define VFR(i) (bf16x8){vlo[i][0], vlo[i][1], vlo[i][2], vlo[i][3], vhi[i][0], vhi[i][1], vhi[i][2], vhi[i][3]}
#define PIN(x) asm volatile("" : "+v"(x))
#define MX3(a, b, c) __builtin_fmaxf(__builtin_fmaxf((a), (b)), (c))
#define GAPA(MF, A0, A1, A2, A3, W0, W1, PW) do { MF; sacc += A0; sacc += A1; sacc += A2; sacc += A3; PIN(sacc); W0; W1; PIN(PW); SBAR(); } while (0)
#define GAPM(MF) do { MF; SBAR(); } while (0)
#define EX(v) __builtin_amdgcn_exp2f(v)
#define GAPB(MF, X, B) do { MF; X[B] = EX(X[B]); X[B + 1] = EX(X[B + 1]); X[B + 2] = EX(X[B + 2]); X[B + 3] = EX(X[B + 3]); PIN(X); SBAR(); } while (0)
#define VRD(i) do { vlo[i] = vtr(vp_ + (((i) >> 2) * 4096 + ((i) & 3) * 1024)); vhi[i] = vtr(vp_ + (((i) >> 2) * 4096 + ((i) & 3) * 1024 + 512)); } while (0)
#define KRD(G, j) do { if (G) { kload2(kf, kp0 + sl_next * KSLOTB, j); SBAR(); } } while (0)
#define MF32(a, b, c) __builtin_amdgcn_mfma_f32_32x32x16_bf16(a, b, c, 0, 0, 0)
#define STEP(C0, C1, P0, P1, t, GK, GV, GL) do { SBAR(); \
    const lds_cptr vp_ = vp0 + sl_prev * VSLOTB; \
    float sacc = (P0[0] + P0[1]); \
    GAPA(C0 = MF32(kf[0], qr[0], negm), P0[2], P0[3], P0[4], P0[5],     pw0[0] = PKW(P0, 0), pw0[1] = PKW(P0, 2), pw0); \
    GAPA(C1 = MF32(kf[1], qr[0], negm), P0[6], P0[7], P0[8], P0[9],     pw0[2] = PKW(P0, 4), pw0[3] = PKW(P0, 6), pw0); \
    GAPA(C0 = MF32(kf[2], qr[1], C0),   P0[10], P0[11], P0[12], P0[13], pw1[0] = PKW(P0, 8), pw1[1] = PKW(P0, 10), pw1); \
    GAPA(C1 = MF32(kf[3], qr[1], C1),   P0[14], P0[15], P1[0], P1[1],   pw1[2] = PKW(P0, 12), pw1[3] = PKW(P0, 14), pw1); \
    VRD(0); SBAR(); GAPA(C0 = MF32(kf[4], qr[2], C0),   P1[2], P1[3], P1[4], P1[5],     pw2[0] = PKW(P1, 0), pw2[1] = PKW(P1, 2), pw2); \
    VRD(4); SBAR(); GAPA(C1 = MF32(kf[5], qr[2], C1),   P1[6], P1[7], P1[8], P1[9],     pw2[2] = PKW(P1, 4), pw2[3] = PKW(P1, 6), pw2); \
    VRD(1); SBAR(); GAPA(C0 = MF32(kf[6], qr[3], C0),   P1[10], P1[11], P1[12], P1[13], pw3[0] = PKW(P1, 8), pw3[1] = PKW(P1, 10), pw3); \
    VRD(5); SBAR(); GAPA(C1 = MF32(kf[7], qr[3], C1),   P1[14], P1[15], 0.f, 0.f,       pw3[2] = PKW(P1, 12), pw3[3] = PKW(P1, 14), pw3); \
    VRD(2); SBAR(); GAPM(C0 = MF32(kf[8], qr[4], C0)); VRD(6); SBAR(); GAPM(C1 = MF32(kf[9], qr[4], C1)); \
    VRD(3); SBAR(); GAPM(C0 = MF32(kf[10], qr[5], C0)); VRD(7); SBAR(); GAPM(C1 = MF32(kf[11], qr[5], C1)); \
    l_reg += sacc; \
    if (GK) { DMA_K((t) + 3, sl_cur * KSLOTB); } if (GV) { DMA_V((t) + 1, sl_next * VSLOTB); } \
    CMASK(C0, C1, t); \
    { float a = MX3(C0[0], C0[1], C1[0]), b = MX3(C0[2], C0[3], C1[1]); a = MX3(a, C1[2], C1[3]); \
      _Pragma("unroll") for (int r = 4; r < 16; r += 4) { a = MX3(a, C0[r], C0[r + 1]); b = MX3(b, C0[r + 2], C0[r + 3]); a = MX3(a, C1[r], C1[r + 1]); b = MX3(b, C1[r + 2], C1[r + 3]); } \
      float rm = __builtin_fmaxf(a, b); { auto rr = __builtin_amdgcn_permlane32_swap(__float_as_uint(rm), __float_as_uint(rm), false, false); rm = __builtin_fmaxf(__uint_as_float(rr[0]), __uint_as_float(rr[1])); } \
      resc = false; \
      if (__builtin_expect(__any(rm > (float)THRL), 0)) { const float dl = __builtin_fmaxf(rm, 0.f); mhat += dl; \
        _Pragma("unroll") for (int r = 0; r < 16; ++r) { C0[r] -= dl; C1[r] -= dl; } \
        _Pragma("unroll") for (int r = 0; r < 16; ++r) negm[r] = -mhat; asm volatile("" : "+v"(negm)); \
        const float f = __builtin_amdgcn_exp2f(-dl); l_reg *= f; if (hi == 0) wsf[r32] = f; resc = true; } } \
    SBAR(); \
    GAPB(o[0] = MF32(PAF(0), VFR(0), o[0]), C0, 0); \
    KRD(GL, 0); GAPB(o[1] = MF32(PAF(0), VFR(4), o[1]), C0, 4); \
    KRD(GL, 1); GAPB(o[0] = MF32(PAF(1), VFR(1), o[0]), C0, 8); \
    KRD(GL, 2); GAPB(o[1] = MF32(PAF(1), VFR(5), o[1]), C0, 12); \
    KRD(GL, 3); GAPB(o[0] = MF32(PAF(2), VFR(2), o[0]), C1, 0); \
    KRD(GL, 4); GAPB(o[1] = MF32(PAF(2), VFR(6), o[1]), C1, 4); \
    KRD(GL, 5); GAPB(o[0] = MF32(PAF(3), VFR(3), o[0]), C1, 8); \
    GAPB(o[1] = MF32(PAF(3), VFR(7), o[1]), C1, 12); \
    } while (0)
    int t = 1;
#undef CMASK
#define CMASK(P0, P1, t) do { } while (0)
    for (; t + 5 < NT; t += 2) {
        STEP(pB0, pB1, pA0, pA1, t, true, true, true);     WAIT_KV(); RESC(); ROT();
        STEP(pA0, pA1, pB0, pB1, t + 1, true, true, true); WAIT_KV(); RESC(); ROT();
    }
#undef CMASK
#define CMASK(P0, P1, t) do { int jb_ = (t) - (NT - 4); if (jb_ >= 0) cmask(P0, P1, jb_, qrel, hi); } while (0)
#define ENDW(tt) do { if ((tt) + 3 < NT) { WAIT_KV(); } else if ((tt) + 2 < NT) { WAIT_BAR(1); } else { WAIT_BAR(0); } } while (0)
    for (; t + 1 < NT; t += 2) {
        STEP(pB0, pB1, pA0, pA1, t, (t + 3 < NT), (t + 1 < NT), (t + 1 < NT));         ENDW(t);     RESC(); ROT();
        STEP(pA0, pA1, pB0, pB1, t + 1, (t + 4 < NT), (t + 2 < NT), (t + 2 < NT));     ENDW(t + 1); RESC(); ROT();
    }
    STEP(pB0, pB1, pA0, pA1, NT - 1, false, false, false); RESC();
    { float sacc = pB0[0] + pB0[1];
#pragma unroll
      for (int r = 2; r < 16; ++r) sacc += pB0[r];
#pragma unroll
      for (int r = 0; r < 16; ++r) sacc += pB1[r];
      l_reg += sacc;
      pw0 = (u32x4){PKW(pB0, 0), PKW(pB0, 2), PKW(pB0, 4), PKW(pB0, 6)}; pw1 = (u32x4){PKW(pB0, 8), PKW(pB0, 10), PKW(pB0, 12), PKW(pB0, 14)}; pw2 = (u32x4){PKW(pB1, 0), PKW(pB1, 2), PKW(pB1, 4), PKW(pB1, 6)}; pw3 = (u32x4){PKW(pB1, 8), PKW(pB1, 10), PKW(pB1, 12), PKW(pB1, 14)};
      SBAR(); pv(o, vb0 + sl_cur * VSLOTB, PAF(0), PAF(1), PAF(2), PAF(3)); }
#undef PKW
#undef PAF
#undef VFR
#undef PIN
#undef MX3
#undef GAPA
#undef GAPM
#undef GAPB
#undef EX
#undef VRD
#undef KRD
#undef MF32
#undef STEP
#undef ENDW
    { auto rr = __builtin_amdgcn_permlane32_swap(__float_as_uint(l_reg), __float_as_uint(l_reg), false, false); l_reg = __uint_as_float(rr[0]) + __uint_as_float(rr[1]); }
    if (hi == 0) wsf[32 + r32] = l_reg; asm volatile("s_waitcnt lgkmcnt(0)" ::: "memory");
    float rli[16];
#pragma unroll
    for (int r = 0; r < 16; ++r) rli[r] = __builtin_amdgcn_rcpf(wsf[32 + crow(r, hi)]);
    bf16* Ow = O + (rowbase + q0 + wid * QBLK) * PV + h * HV;
    { bf16* stg = (bf16*)(shm + LDS_OST) + wid * 2048;
#pragma unroll
      for (int r = 0; r < 16; ++r) { const int orow = crow(r, hi);
#pragma unroll
        for (int d0 = 0; d0 < 2; ++d0) stg[orow * 64 + d0 * 32 + r32] = (bf16)(cvtpk_s(o[d0][r] * rli[r], 0.f) & 0xffffu); }
      asm volatile("s_waitcnt lgkmcnt(0)" ::: "memory");
#pragma unroll
      for (int i = 0; i < 4; ++i) { const int row = i * 8 + (lane >> 3), ch = lane & 7; const u32x4 v = *(const u32x4*)(stg + row * 64 + ch * 8); *(u32x4*)(Ow + (long)row * PV + ch * 8) = v; } }
    asm volatile("s_waitcnt lgkmcnt(0)\n\ts_barrier" ::: "memory");
#undef DMA_K
#undef DMA_V
#undef CMASK
#undef START
#undef RESC
#undef ROT
#undef WAIT_KV
#undef WAIT_KKV
}
#undef SBAR
#undef WAIT_BAR
}
namespace dila {
using bf16 = unsigned short;
using bf16x8 = __attribute__((ext_vector_type(8))) short;
using f32x16 = __attribute__((ext_vector_type(16))) float;
using u32x4 = __attribute__((ext_vector_type(4))) unsigned;
constexpr int NW = 8, SEQL = 8192, PQ = 1536, PKV = 3072, PO = 512, MROWS = 4 * SEQL;
constexpr int L_K = 0, L_V = 6 * 8192, L_WQ = 12 * 8192, L_WO = L_WQ + NW * 4096, L_WSF = L_WO + NW * 2048, L_BIAS = L_WSF + NW * 256, L_END = L_BIAS + 3 * 288 * 4;
constexpr float THR = 8.0f;
#define DIL_WAIT_BAR(N) asm volatile("s_waitcnt vmcnt(" #N ") lgkmcnt(0)\n\ts_barrier" ::: "memory")
struct UnitP { int sb, oo, lo, rowbase, dil, q0, g; };
__device__ __forceinline__ UnitP decode(int j, int h) {
    const int x = j & 31, bg = j >> 5; const int g = bg % 3, b = bg / 3;
    const int sh = 2 * g, dil = 1 << sh; const int r = x & (dil - 1), qb = x >> sh;
    UnitP p; p.sb = g * 262144 + ((b * dil + r) * 8 + h) * (SEQL >> sh); p.oo = g * MROWS * PO + h * 64; p.lo = g * MROWS * 8 + h;
    p.rowbase = b * SEQL + r; p.dil = dil; p.q0 = qb * 256; p.g = g; return p;
}

__device__ __forceinline__ void dil_phase(const bf16* QB, const bf16* KV, bf16* OG, float* LSE, const float* BT, char* shm, int G) {
    int tid_ = threadIdx.x; asm volatile("" : "+v"(tid_));
    const int tid = tid_, lane = tid & 63, r32 = lane & 31, hi = lane >> 5; const int wid = __builtin_amdgcn_readfirstlane(tid >> 6);
    const unsigned lds0 = (unsigned)(uintptr_t)shm;
    float* wsf = (float*)(shm + L_WSF) + wid * 64;
    char* wq = shm + L_WQ + wid * 4096;
    char* wo = shm + L_WO + wid * 2048;
    const int wt0 = wid >> 1, wt1 = 2 + (wid >> 1);
    const int G8 = G & ~7, c = (int)blockIdx.x;
    if (c >= G8) return;
    const int h = c & 7, j0 = c >> 3, jstep = G8 >> 3;
    const int NU = (384 - j0 + jstep - 1) / jstep;
    for (int i = tid; i < 3 * 288; i += NW * 64) ((float*)(shm + L_BIAS))[i] = BT[((i / 288) * 8 + h) * 288 + (i % 288)];
#define DIL_GROW(P, pos) ((long)((P).rowbase + (pos) * (P).dil))
#define DIL_ISSUE_TILE(P, t) do { int kp_ = (P).q0 - 128 + 64 * (t); if (kp_ < 0) kp_ = 0; \
        att::glds16(KV + (size_t)((P).sb + kp_ + lane) * 128 + wid * 8, (unsigned)__builtin_amdgcn_readfirstlane(lds0 + L_K + (t) * 8192 + wid * 1024)); \
        att::glds16(KV + (size_t)((P).sb + kp_ + 16 * (wid & 3) + (lane >> 2)) * 128 + 64 + (wid >> 2) * 32 + (lane & 3) * 8, (unsigned)__builtin_amdgcn_readfirstlane(lds0 + L_V + (t) * 8192 + wid * 1024)); } while (0)
#define DIL_ISSUE_Q(P) do { _Pragma("unroll") for (int j_ = 0; j_ < 4; ++j_) \
        att::glds16(QB + (size_t)((P).sb + (P).q0 + wid * 32 + 8 * j_ + (lane >> 3)) * 64 + (lane & 7) * 8, (unsigned)__builtin_amdgcn_readfirstlane(lds0 + L_WQ + wid * 4096 + j_ * 1024)); } while (0)
    if (NU <= 0) return;
    UnitP cur = decode(j0, h), nxt = cur;
    asm volatile("s_waitcnt vmcnt(0) lgkmcnt(0)\n\ts_barrier" ::: "memory");
    DIL_ISSUE_Q(cur); DIL_ISSUE_TILE(cur, 0); DIL_ISSUE_TILE(cur, 5); DIL_ISSUE_TILE(cur, 1); DIL_ISSUE_TILE(cur, 4);
    bf16x8 qr[4]; float mhat = 0.f, l_reg = 0.f; f32x16 o[2]; o[0] = f32x16{}; o[1] = f32x16{}; f32x16 negm = f32x16{}; bool first = true;
    const int vbl = (int)(lds0 + L_V) + ((lane >> 4) & 1) * 32 + (lane & 3) * 8 + (4 * hi + ((lane & 15) >> 2)) * 64;
    for (int ui = 0; ui < NU; ++ui) {
        const bool has_next = ui + 1 < NU;
        if (has_next) nxt = decode(j0 + (ui + 1) * jstep, h);
        const int tb = cur.q0 == 0 ? 2 : 0;
        const float* bl0 = (const float*)(shm + L_BIAS) + cur.g * 288 + (191 - (128 + 32 * (wid & 1) + r32 - 4 * hi));
#pragma unroll 1
        for (int k = 0; k < 3; ++k) {
            if (k < 2) DIL_WAIT_BAR(0); else DIL_WAIT_BAR(8);
            if (k == 0) { DIL_ISSUE_TILE(cur, 2); DIL_ISSUE_TILE(cur, 3); }
            else if (has_next) { if (k == 1) { DIL_ISSUE_Q(nxt); DIL_ISSUE_TILE(nxt, 0); DIL_ISSUE_TILE(nxt, 5); } else { DIL_ISSUE_TILE(nxt, 1); DIL_ISSUE_TILE(nxt, 4); } }
            const int t = wid < 4 ? wt0 + k : wt1 - k;
            if (k == 0) {
#pragma unroll
                for (int d0 = 0; d0 < 4; ++d0) qr[d0] = *reinterpret_cast<const bf16x8*>(wq + r32 * 128 + d0 * 32 + hi * 16);
                mhat = 0.f; l_reg = 0.f; o[0] = f32x16{}; o[1] = f32x16{}; negm = f32x16{}; first = true;
            }
            if (t >= tb) {
                f32x16 p0, p1;
                { const char* kb = shm + L_K + t * 8192 + hi * 1024 + r32 * 16;
#pragma unroll
                  for (int d0 = 0; d0 < 4; ++d0) {
                    const bf16x8 b0 = *reinterpret_cast<const bf16x8*>(kb + d0 * 2048);
                    const bf16x8 b1 = *reinterpret_cast<const bf16x8*>(kb + d0 * 2048 + 512);
                    if (d0 == 0) { p0 = __builtin_amdgcn_mfma_f32_32x32x16_bf16(b0, qr[0], negm, 0, 0, 0); p1 = __builtin_amdgcn_mfma_f32_32x32x16_bf16(b1, qr[0], negm, 0, 0, 0); }
                    else { p0 = __builtin_amdgcn_mfma_f32_32x32x16_bf16(b0, qr[d0], p0, 0, 0, 0); p1 = __builtin_amdgcn_mfma_f32_32x32x16_bf16(b1, qr[d0], p1, 0, 0, 0); } } }
                { const float* bl = bl0 + 64 * (t - wt0);
                  float bv0[16], bv1[16];
#pragma unroll
                  for (int r = 0; r < 16; ++r) { bv0[r] = bl[(r & 3) + 8 * (r >> 2)]; bv1[r] = bl[(r & 3) + 8 * (r >> 2) + 32]; }
#pragma unroll
                  for (int r = 0; r < 16; ++r) { p0[r] += bv0[r]; p1[r] += bv1[r]; } }
                const float rm = att::rowmax32(p0, p1);
                if (first) { first = false; const float dl = rm; mhat += dl;
#pragma unroll
                    for (int r = 0; r < 16; ++r) { p0[r] -= dl; p1[r] -= dl; }
#pragma unroll
                    for (int r = 0; r < 16; ++r) negm[r] = -mhat;
                } else if (__any(rm > THR)) { const float dl = __builtin_fmaxf(rm, 0.f); mhat += dl;
#pragma unroll
                    for (int r = 0; r < 16; ++r) { p0[r] -= dl; p1[r] -= dl; }
#pragma unroll
                    for (int r = 0; r < 16; ++r) negm[r] = -mhat;
                    const float f = __builtin_amdgcn_exp2f(-dl); l_reg *= f; if (hi == 0) wsf[r32] = f;
                    asm volatile("s_waitcnt lgkmcnt(0)" ::: "memory");
#pragma unroll
                    for (int d_ = 0; d_ < 2; ++d_)
#pragma unroll
                        for (int r = 0; r < 16; ++r) o[d_][r] *= wsf[att::crow(r, hi)];
                    asm volatile("s_waitcnt lgkmcnt(0)" ::: "memory");
                }
                float sacc = 0.f;
#pragma unroll
                for (int r = 0; r < 16; ++r) { p0[r] = __builtin_amdgcn_exp2f(p0[r]); p1[r] = __builtin_amdgcn_exp2f(p1[r]); sacc += p0[r] + p1[r]; }
                l_reg += sacc;
                u32x4 pw0, pw1, pw2, pw3;
#define DIL_PKW(P, B) att::cvtpk_s(P[B], P[B + 1])
                pw0 = (u32x4){DIL_PKW(p0, 0), DIL_PKW(p0, 2), DIL_PKW(p0, 4), DIL_PKW(p0, 6)}; pw1 = (u32x4){DIL_PKW(p0, 8), DIL_PKW(p0, 10), DIL_PKW(p0, 12), DIL_PKW(p0, 14)};
                pw2 = (u32x4){DIL_PKW(p1, 0), DIL_PKW(p1, 2), DIL_PKW(p1, 4), DIL_PKW(p1, 6)}; pw3 = (u32x4){DIL_PKW(p1, 8), DIL_PKW(p1, 10), DIL_PKW(p1, 12), DIL_PKW(p1, 14)};
#undef DIL_PKW
                __builtin_amdgcn_sched_barrier(0);
                att::pv(o, vbl + t * 8192, __builtin_bit_cast(bf16x8, pw0), __builtin_bit_cast(bf16x8, pw1), __builtin_bit_cast(bf16x8, pw2), __builtin_bit_cast(bf16x8, pw3));
            }
            if (k == 2) {
                { auto rr = __builtin_amdgcn_permlane32_swap(__float_as_uint(l_reg), __float_as_uint(l_reg), false, false); l_reg = __uint_as_float(rr[0]) + __uint_as_float(rr[1]); }
                if (hi == 0) wsf[32 + r32] = l_reg;
                asm volatile("s_waitcnt lgkmcnt(0)" ::: "memory");
                float rli[16];
#pragma unroll
                for (int r = 0; r < 16; ++r) rli[r] = __builtin_amdgcn_rcpf(wsf[32 + att::crow(r, hi)]);
                if (hi == 0) LSE[cur.lo + DIL_GROW(cur, cur.q0 + wid * 32 + r32) * 8] = mhat + __builtin_amdgcn_logf(l_reg);
                bf16* stg = (bf16*)wo;
#pragma unroll
                for (int d0 = 0; d0 < 2; ++d0) {
#pragma unroll
                    for (int r = 0; r < 16; ++r) stg[att::crow(r, hi) * 32 + r32] = (bf16)(att::cvtpk_s(o[d0][r] * rli[r], 0.f) & 0xffffu);
                    asm volatile("s_waitcnt lgkmcnt(0)" ::: "memory");
#pragma unroll
                    for (int i = 0; i < 2; ++i) { const int row = i * 16 + (lane >> 2), ch = lane & 3; const u32x4 v = *(const u32x4*)(stg + row * 32 + ch * 8);
                        *(u32x4*)(OG + cur.oo + DIL_GROW(cur, cur.q0 + wid * 32 + row) * PO + d0 * 32 + ch * 8) = v; }
                    asm volatile("s_waitcnt lgkmcnt(0)" ::: "memory"); }
            }
        }
        cur = nxt;
    }
    asm volatile("s_waitcnt vmcnt(0) lgkmcnt(0)\n\ts_barrier" ::: "memory");
#undef DIL_GROW
#undef DIL_ISSUE_TILE
#undef DIL_ISSUE_Q
}
#undef DIL_WAIT_BAR
}
constexpr int NWAVES = 8;
constexpr int BATCH = 4, SEQ = 8192, D = 1024, M = BATCH * SEQ;
constexpr int MLA_H = 16, QRANK = 384, KVRANK = 256, LATN = 672, LATP = 768, QUP = 1536, KVUP = 2048;
constexpr int DFF = 2816, NEXP = 8, DILQ = 1536, DILKV = 3072, DILOUT = 512;
constexpr int MAXSLOT = 67584;
constexpr float EPS = 1e-6f;
constexpr float C2_MLA = 0.1472444460259031f;
constexpr float C2_DIL = 0.18033688011112042f;
constexpr float LOG2E_F = 1.4426950408889634f;

constexpr size_t MiB = 1u << 20;
constexpr size_t WS_CTL = 0, CTL_ZERO_BYTES = 512 * 1024;
constexpr size_t WS_CM = 256 * 1024;
constexpr int CM_LAT = 0, CM_FGU = 672, CM_KVB = CM_FGU + 5632, CM_QB = CM_KVB + 3072, CM_EGU = CM_QB + 1536, CM_FDN = CM_EGU + 8 * 5632, CM_EDN = CM_FDN + 1024, CM_END = CM_EDN + 8 * 1024;
static_assert(WS_CM + (size_t)CM_END * 4 <= 512 * 1024, "column maxima inside the zeroed region");
constexpr size_t WS_MODV = 1 * MiB;
constexpr size_t WS_BIAS = 1 * MiB + 256 * 1024;
constexpr size_t WS_ROUTE = 1 * MiB + 512 * 1024;
constexpr size_t WS_CNT = 2 * MiB;
constexpr size_t WS_LIST = 2 * MiB + 256 * 1024;
constexpr size_t WS_SLOTG = 2 * MiB + 768 * 1024;
constexpr size_t WS_TOKSLOT = 3 * MiB + 256 * 1024;
constexpr size_t WS_TILEEXP = 3 * MiB + 512 * 1024;
constexpr size_t WS_SLOTXS = 3 * MiB + 516 * 1024;
constexpr size_t WS_CS = 4 * MiB;
constexpr size_t WS_LSE = 8 * MiB;
constexpr size_t WS_SB = 11 * MiB;
constexpr size_t SB_LAT = 0, SB_FGU = 768, SB_KVB = 768 + 5632, SB_QB = SB_KVB + 3072, SB_EGU = SB_QB + 1536, SB_FDN = SB_EGU + 8 * 5632, SB_EDN = SB_FDN + 1024, SB_END = SB_EDN + 8 * 1024;
constexpr size_t WS_XS = 11 * MiB + 512 * 1024, WS_XSKV = 11 * MiB + 768 * 1024;
constexpr size_t WS_WEGU = 12 * MiB, WS_WEDN = 100 * MiB, WS_WFGU = 144 * MiB, WS_WFDN = 155 * MiB, WS_WKVB = 161 * MiB, WS_WQB = 167 * MiB, WS_WOUT = 170 * MiB,
                 WS_WOB = 172 * MiB, WS_WMLAIN = 173 * MiB, WS_WQUP = 175 * MiB, WS_WKVUP = 177 * MiB;
constexpr size_t WS_ARENA = 180 * MiB;
constexpr size_t A_XN = WS_ARENA, A_LAT = WS_ARENA + 64 * MiB, A_QN = WS_ARENA + 112 * MiB, A_KVN = WS_ARENA + 136 * MiB, A_Q = WS_ARENA + 152 * MiB, A_K = WS_ARENA + 248 * MiB,
                 A_V = WS_ARENA + 344 * MiB, A_O = WS_ARENA + 408 * MiB, A_HID = WS_ARENA + 64 * MiB, A_XNKV = WS_ARENA + 64 * MiB, A_KVB = WS_ARENA + 128 * MiB, A_QB = WS_ARENA + 320 * MiB,
                 A_OG = WS_ARENA, A_OD = WS_ARENA + 128 * MiB, A_HIDS = WS_ARENA + 160 * MiB, A_Y = WS_ARENA;
constexpr size_t WS_END = WS_ARENA + 523 * MiB;
static_assert(A_HIDS + (size_t)MAXSLOT * DFF * 2 <= WS_END && A_Y + (size_t)MAXSLOT * D * 2 <= A_HIDS && A_O + (size_t)M * D * 2 <= WS_END, "arena map");
static_assert(WS_WEGU + (size_t)NEXP * 2 * DFF * D * 2 <= WS_WEDN && WS_WEDN + (size_t)NEXP * D * DFF * 2 <= WS_WFGU && WS_WFGU + (size_t)2 * DFF * D * 2 <= WS_WFDN && WS_WFDN + (size_t)D * DFF * 2 <= WS_WKVB, "weight map");
enum ModKind { MK_A_MIX0 = 0, MK_B_MIX0, MK_G_MIX0, MK_A_FFN0, MK_B_FFN0, MK_G_FFN0, MK_A_MIX1, MK_B_MIX1, MK_G_MIX1, MK_A_FFN1, MK_B_FFN1, MK_G_FFN1, MK_A_KV, MK_B_KV };
constexpr int CW_BAR = 4096;
constexpr int CW_RANK = 8192;

constexpr int RING_BYTES = 131072;
constexpr int LDS_BYTES = 163840;
constexpr int LDSCTL_OFF = LDS_BYTES - 1024, MISC_OFF = LDSCTL_OFF + 320;

#define GAS __attribute__((address_space(1)))
#define LAS __attribute__((address_space(3)))
typedef unsigned short bf16;
typedef signed char i8;
typedef unsigned v4u __attribute__((ext_vector_type(4)));
typedef unsigned v2u __attribute__((ext_vector_type(2)));
typedef float f32x4 __attribute__((ext_vector_type(4)));
typedef GAS unsigned gu32;
#define RLX_AGENT __ATOMIC_RELAXED, __HIP_MEMORY_SCOPE_AGENT
#define LDS_WAIT() asm volatile("s_waitcnt lgkmcnt(0)" ::: "memory")
#define VM_WAIT() asm volatile("s_waitcnt vmcnt(0)" ::: "memory")
__device__ __forceinline__ unsigned f2bf(float f) { unsigned u = __builtin_bit_cast(unsigned, f); return (u + 0x7fffu + ((u >> 16) & 1u)) >> 16; }
__device__ __forceinline__ unsigned pk2(float lo, float hi) { return f2bf(lo) | (f2bf(hi) << 16); }
__device__ __forceinline__ float bf_lo(unsigned w) { return __builtin_bit_cast(float, w << 16); }
__device__ __forceinline__ float bf_hi(unsigned w) { return __builtin_bit_cast(float, w & 0xffff0000u); }
__device__ __forceinline__ float wave_sum(float v) {
#pragma unroll
    for (int o = 1; o < 64; o <<= 1) v += __shfl_xor(v, o);
    return v;
}

#define XB_TMO      128
#define XB_XCNT(j)  (256  + 64 * (j))
#define XB_XSUB(j)  (1280 + 64 * (j))
#define XB_XGEN(j)  (2304 + 64 * (j))
#define XB_TOP      3328
#define XB_TOPGEN   3392
#define XCD_BAR_WORDS 3456
#define XB_SPIN_CAP (1u << 18)
__device__ __forceinline__ unsigned xb_ld(unsigned* p)              { return __hip_atomic_load(p, __ATOMIC_RELAXED, __HIP_MEMORY_SCOPE_AGENT); }
__device__ __forceinline__ unsigned xb_add(unsigned* p, unsigned v) { return __hip_atomic_fetch_add(p, v, __ATOMIC_RELAXED, __HIP_MEMORY_SCOPE_AGENT); }
__device__ __forceinline__ unsigned xb_xcc_id() { return (unsigned)__builtin_amdgcn_s_getreg((3 << 11) | 20) & 0xFu; }
#define XB_SPIN(cond, bar) do { unsigned _sp = 0; while (cond) { __builtin_amdgcn_s_sleep(1); \
    if ((++_sp & 255u) == 0u) { if (xb_ld(&(bar)[XB_TMO])) break; if (_sp > XB_SPIN_CAP) { atomicAdd(&(bar)[XB_TMO], 1u); break; } } } } while (0)
struct XcdBarrier { unsigned* bar; unsigned x; volatile LAS unsigned* st; };
__device__ __forceinline__ XcdBarrier xcd_barrier_post(unsigned* bar, volatile LAS unsigned* st) {
    XcdBarrier b; b.bar = bar; b.x = xb_xcc_id(); b.st = st;
    if (threadIdx.x == 0) (void)xb_add(&bar[XB_XCNT(b.x)], 1u);
    return b;
}
__device__ __forceinline__ void xcd_barrier_complete(unsigned* bar, unsigned x, unsigned& nloc, unsigned& nx) {
    const unsigned G = gridDim.x * gridDim.y * gridDim.z;
    unsigned sum, cnt, mine, sp = 0u;
    for (;;) {
        sum = 0u; cnt = 0u; mine = 0u;
#pragma unroll
        for (unsigned j = 0; j < 16; ++j) { const unsigned c = xb_ld(&bar[XB_XCNT(j)]); sum += c; cnt += (c > 0u) ? 1u : 0u; mine = (j == x) ? c : mine; }
        if (sum == G) break;
        __builtin_amdgcn_s_sleep(1);
        if ((++sp & 255u) == 0u) { if (xb_ld(&bar[XB_TMO])) break; if (sp > XB_SPIN_CAP) { atomicAdd(&bar[XB_TMO], 1u); break; } }
    }
    nloc = mine > 0u ? mine : 1u; nx = cnt > 0u ? cnt : 1u;
}
__device__ __forceinline__ void xcd_barrier(const XcdBarrier& b) {
    asm volatile("s_waitcnt vmcnt(0)" ::: "memory");
    __syncthreads();
    if (threadIdx.x == 0) {
        unsigned* bar = b.bar;
        __builtin_amdgcn_s_waitcnt(0);
        unsigned nloc = b.st[0], nx = b.st[1];
        if (nloc == 0u) { xcd_barrier_complete(bar, b.x, nloc, nx); b.st[0] = nloc; b.st[1] = nx; }
        const unsigned old = xb_add(&bar[XB_XSUB(b.x)], 1u);
        const unsigned gen = old / nloc;
        if (old + 1u == (gen + 1u) * nloc) {
            __builtin_amdgcn_fence(__ATOMIC_RELEASE, "agent");
            asm volatile("s_waitcnt vmcnt(0)" ::: "memory");
            const unsigned og = xb_add(&bar[XB_TOP], 1u);
            const unsigned tg = og / nx;
            if (og + 1u == (tg + 1u) * nx) xb_add(&bar[XB_TOPGEN], 1u);
            else XB_SPIN(xb_ld(&bar[XB_TOPGEN]) == tg, bar);
            __builtin_amdgcn_fence(__ATOMIC_ACQUIRE, "agent");
            xb_add(&bar[XB_XGEN(b.x)], 1u);
            asm volatile("s_waitcnt vmcnt(0)" ::: "memory");
        } else {
            XB_SPIN(xb_ld(&bar[XB_XGEN(b.x)]) == gen, bar);
            __builtin_amdgcn_fence(__ATOMIC_ACQUIRE, "agent");
            asm volatile("s_waitcnt vmcnt(0)" ::: "memory");
        }
    }
    __syncthreads();
}

struct Frame {
    LAS unsigned char* lds;
    volatile LAS unsigned* MISC;
    int tid, lane, wave;
    int vcu, G;
    unsigned char* ws;
    const float* in[26];
    float* out;
};
enum { MAP_PLAIN = 0, MAP_MLAIN = 1, MAP_QUP = 2, MAP_GU = 3 };
template <int MAP> __device__ __forceinline__ int dmap(int n) {
    if (MAP == MAP_MLAIN) { if (n < 640) return n; if (n < 656) return 640 + 2 * (n - 640); return 640 + 2 * (n - 656) + 1; }
    if (MAP == MAP_QUP) { const int h = n / 96, j = n % 96; if (j < 64) return n; if (j < 80) return h * 96 + 64 + 2 * (j - 64); return h * 96 + 64 + 2 * (j - 80) + 1; }
    if (MAP == MAP_GU) { const int up = n >= DFF ? 1 : 0; const int c = up ? n - DFF : n; return (c >> 7) * 256 + up * 128 + (c & 127); }
    return n;
}
template <int MAP> __device__ __forceinline__ void transpose_item(const float* W, int K, int N, bf16* WT, const float* ks, LAS float* scr, int item, int lane) {
    const int nblk = N / 32, kb = item / nblk, nb = item % nblk, k0 = 64 * kb, n0 = 32 * nb;
    float v[32];
    const float* src = W + (size_t)(k0 + (lane >> 5)) * N + n0 + (lane & 31);
#pragma unroll
    for (int i = 0; i < 32; ++i) v[i] = __builtin_nontemporal_load(src + (size_t)(2 * i) * N);
    if (ks) {
#pragma unroll
        for (int i = 0; i < 32; ++i) v[i] *= ks[k0 + 2 * i + (lane >> 5)]; }
#pragma unroll
    for (int i = 0; i < 32; ++i) scr[(2 * i + (lane >> 5)) * 33 + (lane & 31)] = v[i];
    LDS_WAIT(); asm volatile("" ::: "memory");
    const int c = lane & 7;
#pragma unroll
    for (int j = 0; j < 4; ++j) { const int n = (lane >> 3) + 8 * j; const LAS float* s = scr + (8 * c) * 33 + n;
        v4u o; o.x = pk2(s[0 * 33], s[1 * 33]); o.y = pk2(s[2 * 33], s[3 * 33]); o.z = pk2(s[4 * 33], s[5 * 33]); o.w = pk2(s[6 * 33], s[7 * 33]);
        *(GAS v4u*)(WT + (size_t)dmap<MAP>(n0 + n) * K + k0 + 8 * c) = o; }
    LDS_WAIT(); asm volatile("" ::: "memory");
}
__device__ __forceinline__ float wave_max(float v) {
#pragma unroll
    for (int o = 1; o < 64; o <<= 1) v = fmaxf(v, __shfl_xor(v, o));
    return v;
}
__device__ __forceinline__ float amax8(const f32x4& a, const f32x4& b) { return fmaxf(fmaxf(fmaxf(fabsf(a.x), fabsf(a.y)), fmaxf(fabsf(a.z), fabsf(a.w))), fmaxf(fmaxf(fabsf(b.x), fabsf(b.y)), fmaxf(fabsf(b.z), fabsf(b.w)))); }
__device__ __forceinline__ unsigned q4(const f32x4& a, float inv) { const int q0 = (int)__builtin_rintf(a.x * inv), q1 = (int)__builtin_rintf(a.y * inv), q2 = (int)__builtin_rintf(a.z * inv), q3 = (int)__builtin_rintf(a.w * inv);
    return ((unsigned)q0 & 0xffu) | (((unsigned)q1 & 0xffu) << 8) | (((unsigned)q2 & 0xffu) << 16) | (((unsigned)q3 & 0xffu) << 24); }
__device__ __forceinline__ void colmax_item(const float* W, int K, int N, unsigned* CM, int item, int lane) {
    const int nblk = (N + 63) / 64, kb = item / nblk, nb = item % nblk, n = 64 * nb + lane;
    if (n < N) { const float* src = W + (size_t)(64 * kb) * N + n; float mx = 0.f;
#pragma unroll 16
        for (int i = 0; i < 64; ++i) mx = fmaxf(mx, fabsf(__builtin_nontemporal_load(src + (size_t)i * N)));
        atomicMax(CM + n, __float_as_uint(mx)); }
}
template <int MAP, int FMT> __device__ __forceinline__ void conv_item(const float* W, int K, int N, unsigned char* WT, const unsigned* CM, float* SB, float post, LAS float* scr, int item, int lane) {
    const int nblk = N / 32, kb = item / nblk, nb = item % nblk, k0 = 64 * kb, n0 = 32 * nb;
    const float mx = __uint_as_float(CM[n0 + (lane & 31)]);
    const float inv = mx > 0.f ? (FMT == 1 ? 127.0f : 256.0f) / mx : 0.f;
    if (kb == 0 && lane < 32) SB[dmap<MAP>(n0 + lane)] = mx > 0.f ? (FMT == 1 ? mx * (1.0f / 127.0f) : mx * (1.0f / 256.0f) * post) : 1.0f;
    float v[32];
    const float* src = W + (size_t)(k0 + (lane >> 5)) * N + n0 + (lane & 31);
#pragma unroll
    for (int i = 0; i < 32; ++i) v[i] = src[(size_t)(2 * i) * N];
#pragma unroll
    for (int i = 0; i < 32; ++i) scr[(2 * i + (lane >> 5)) * 33 + (lane & 31)] = v[i] * inv;
    LDS_WAIT(); asm volatile("" ::: "memory");
    const int c = lane & 7;
#pragma unroll
    for (int j = 0; j < 4; ++j) { const int n = (lane >> 3) + 8 * j; const LAS float* s = scr + (8 * c) * 33 + n;
        const f32x4 lo = (f32x4){s[0 * 33], s[1 * 33], s[2 * 33], s[3 * 33]}, hi = (f32x4){s[4 * 33], s[5 * 33], s[6 * 33], s[7 * 33]};
        v2u o; if (FMT == 1) o = (v2u){q4(lo, 1.0f), q4(hi, 1.0f)}; else o = (v2u){pg8::pk4_fp8(lo.x, lo.y, lo.z, lo.w), pg8::pk4_fp8(hi.x, hi.y, hi.z, hi.w)};
        *(GAS v2u*)(WT + (size_t)dmap<MAP>(n0 + n) * K + k0 + 8 * c) = o; }
    LDS_WAIT(); asm volatile("" ::: "memory");
}
__device__ __constant__ double INVF_D[16] = {1.0, 0.5623413251903491, 0.31622776601683794, 0.1778279410038923, 0.09999999999999999, 0.056234132519034905, 0.03162277660168379, 0.01778279410038923,
    0.01, 0.005623413251903491, 0.0031622776601683794, 0.0017782794100389228, 0.001, 0.000562341325190349, 0.00031622776601683794, 0.0001778279410038923};
__device__ __constant__ int RPB_TH[15] = {22, 30, 40, 54, 73, 99, 134, 182, 246, 332, 450, 609, 825, 1117, 1513};

__device__ __forceinline__ void p0_prologue(Frame& F) {
    const int gw = F.vcu * NWAVES + F.wave, NGW = F.G * NWAVES;
    const int gtid = F.vcu * (NWAVES * 64) + F.tid, NGT = F.G * NWAVES * 64;
    float* MODV = (float*)(F.ws + WS_MODV);
    {
        LAS float* cact = (LAS float*)F.lds;
        LAS float* red = (LAS float*)(F.lds + 16384);
        const float* cin = F.in[1];
        for (int i = F.tid; i < 4096; i += NWAVES * 64) { const int b = i >> 10, k = i & 1023; const float x = cin[i]; cact[k * 4 + b] = x / (1.0f + expf(-x)); }
        __syncthreads();
        constexpr int NTASK = (6 * D * 2 + 2 * D) / 64;
        for (int task = F.vcu; task < NTASK; task += F.G) {
            const int gc = task * 64 + F.lane;
            const float* W; int ldw, cc; const float* bias;
            if (gc < 6 * D) { W = F.in[5]; ldw = 6 * D; cc = gc; bias = F.in[6]; }
            else if (gc < 12 * D) { W = F.in[5] + (size_t)D * 6 * D; ldw = 6 * D; cc = gc - 6 * D; bias = F.in[6] + 6 * D; }
            else { W = F.in[14]; ldw = 2 * D; cc = gc - 12 * D; bias = F.in[15]; }
            float a0 = 0.f, a1 = 0.f, a2 = 0.f, a3 = 0.f;
            const int kbeg = F.wave * 128;
#pragma unroll 16
            for (int k = 0; k < 128; ++k) { const float w = W[(size_t)(kbeg + k) * ldw + cc]; const f32x4 ca = *(const LAS f32x4*)(cact + (kbeg + k) * 4);
                a0 += w * ca[0]; a1 += w * ca[1]; a2 += w * ca[2]; a3 += w * ca[3]; }
            red[(F.wave * 4 + 0) * 64 + F.lane] = a0; red[(F.wave * 4 + 1) * 64 + F.lane] = a1; red[(F.wave * 4 + 2) * 64 + F.lane] = a2; red[(F.wave * 4 + 3) * 64 + F.lane] = a3;
            __syncthreads();
            if (F.wave < 4) { const int b = F.wave; float s = 0.f;
#pragma unroll
                for (int w = 0; w < 8; ++w) s += red[(w * 4 + b) * 64 + F.lane];
                s += bias[cc];
                int kind; float val = s; const int j = cc & 1023, ch = cc >> 10;
                if (gc < 12 * D) { const int Lr = gc < 6 * D ? 0 : 1;
                    if (ch == 0) kind = 6 * Lr + 1; else if (ch == 1) { kind = 6 * Lr + 0; val = F.in[3][Lr * D + j] * (1.0f + s); } else if (ch == 2) kind = 6 * Lr + 2;
                    else if (ch == 3) kind = 6 * Lr + 4; else if (ch == 4) { kind = 6 * Lr + 3; val = F.in[4][Lr * D + j] * (1.0f + s); } else kind = 6 * Lr + 5;
                } else { if (ch == 0) kind = MK_B_KV; else { kind = MK_A_KV; val = F.in[13][j] * (1.0f + s); } }
                MODV[((size_t)kind * 4 + b) * D + j] = val; }
            __syncthreads();
        }
        __syncthreads();
    }
    {
        unsigned* const CM = (unsigned*)(F.ws + WS_CM);
        constexpr int C_MLAIN = (D / 64) * ((LATN + 63) / 64), C_FGU = (D / 64) * (2 * DFF / 64), C_KVB = (D / 64) * (DILKV / 64), C_QB = (D / 64) * (DILQ / 64), C_FDN = (DFF / 64) * (D / 64);
        constexpr int NCM = C_MLAIN + C_FGU + C_KVB + C_QB + NEXP * C_FGU + C_FDN + NEXP * C_FDN;
        for (int it = gw; it < NCM; it += NGW) { int r = it;
            if (r < C_MLAIN) { colmax_item(F.in[7], D, LATN, CM + CM_LAT, r, F.lane); continue; } r -= C_MLAIN;
            if (r < C_FGU) { colmax_item(F.in[20], D, 2 * DFF, CM + CM_FGU, r, F.lane); continue; } r -= C_FGU;
            if (r < C_KVB) { colmax_item(F.in[16], D, DILKV, CM + CM_KVB, r, F.lane); continue; } r -= C_KVB;
            if (r < C_QB) { colmax_item(F.in[18], D, DILQ, CM + CM_QB, r, F.lane); continue; } r -= C_QB;
            if (r < NEXP * C_FGU) { const int e = r / C_FGU; colmax_item(F.in[23] + (size_t)e * D * 2 * DFF, D, 2 * DFF, CM + CM_EGU + e * 2 * DFF, r % C_FGU, F.lane); continue; } r -= NEXP * C_FGU;
            if (r < C_FDN) { colmax_item(F.in[21], DFF, D, CM + CM_FDN, r, F.lane); continue; } r -= C_FDN;
            { const int e = r / C_FDN; colmax_item(F.in[24] + (size_t)e * DFF * D, DFF, D, CM + CM_EDN + e * D, r % C_FDN, F.lane); } }
    }
    {
        v4u* padz = (v4u*)(F.ws + WS_WMLAIN + (size_t)LATN * D);
        for (int i = gtid; i < (LATP - LATN) * D / 16; i += NGT) padz[i] = (v4u){0u, 0u, 0u, 0u};
        for (int i = gtid; i < LATP - LATN; i += NGT) ((float*)(F.ws + WS_SB))[SB_LAT + LATN + i] = 1.0f;
        const int* pos = (const int*)F.in[2];
        float* cs = (float*)(F.ws + WS_CS);
        for (int i = gtid; i < M * 16; i += NGT) { const int row = i >> 4, k = i & 15;
            const double x = (double)pos[row] * INVF_D[k]; const double rev = x * 0.15915494309189535; const float fr = (float)(rev - __builtin_rint(rev));
            cs[(size_t)i * 2] = __builtin_amdgcn_cosf(fr); cs[(size_t)i * 2 + 1] = __builtin_amdgcn_sinf(fr); }
        const float* rpb = F.in[17];
        float* bt = (float*)(F.ws + WS_BIAS);
        for (int i = gtid; i < 24 * 288; i += NGT) { const int gh = i / 288, ii = i % 288, j = 191 - ii, g = gh >> 3; const int d = j * (g == 0 ? 1 : (g == 1 ? 4 : 16));
            float val = -INFINITY;
            if (j >= 0 && j <= 128) { int bk; if (d < 16) bk = d; else { bk = 16;
#pragma unroll
                for (int q = 0; q < 15; ++q) bk += (d >= RPB_TH[q]) ? 1 : 0; }
                val = rpb[bk * 24 + gh] * LOG2E_F; }
            bt[i] = val; }
    }
}

__device__ __forceinline__ void p1_convert(Frame& F) {
    const int gw = F.vcu * NWAVES + F.wave, NGW = F.G * NWAVES;
    LAS float* scr = (LAS float*)(F.lds + F.wave * 8704);
    const unsigned* const CM = (const unsigned*)(F.ws + WS_CM); float* const SB = (float*)(F.ws + WS_SB);
    constexpr int I_MLAIN = (D / 64) * (LATN / 32), I_FGU = (D / 64) * (2 * DFF / 32), I_KVB = (D / 64) * (DILKV / 32), I_QB = (D / 64) * (DILQ / 32), I_FDN = (DFF / 64) * (D / 32);
    constexpr int I_QUP = (QRANK / 64) * (QUP / 32), I_KVUP = (KVRANK / 64) * (KVUP / 32), I_OUT = (D / 64) * (D / 32), I_OB = (DILOUT / 64) * (D / 32);
    constexpr int NITEMS = I_MLAIN + I_FGU + I_KVB + I_QB + NEXP * I_FGU + I_FDN + NEXP * I_FDN + I_QUP + I_KVUP + I_OUT + I_OB;
    constexpr float POST = 1.0f / pg8::HSCALE;
    for (int it = gw; it < NITEMS; it += NGW) { int r = it;
        if (r < NEXP * I_FGU) { const int e = r / I_FGU; conv_item<MAP_GU, 1>(F.in[23] + (size_t)e * D * 2 * DFF, D, 2 * DFF, F.ws + WS_WEGU + (size_t)e * 2 * DFF * D, CM + CM_EGU + e * 2 * DFF, SB + SB_EGU + (size_t)e * 2 * DFF, 1.f, scr, r % I_FGU, F.lane); continue; } r -= NEXP * I_FGU;
        if (r < NEXP * I_FDN) { const int e = r / I_FDN; conv_item<MAP_PLAIN, 2>(F.in[24] + (size_t)e * DFF * D, DFF, D, F.ws + WS_WEDN + (size_t)e * D * DFF, CM + CM_EDN + e * D, SB + SB_EDN + (size_t)e * D, POST, scr, r % I_FDN, F.lane); continue; } r -= NEXP * I_FDN;
        if (r < I_FGU) { conv_item<MAP_GU, 1>(F.in[20], D, 2 * DFF, F.ws + WS_WFGU, CM + CM_FGU, SB + SB_FGU, 1.f, scr, r, F.lane); continue; } r -= I_FGU;
        if (r < I_FDN) { conv_item<MAP_PLAIN, 2>(F.in[21], DFF, D, F.ws + WS_WFDN, CM + CM_FDN, SB + SB_FDN, POST, scr, r, F.lane); continue; } r -= I_FDN;
        if (r < I_KVB) { conv_item<MAP_PLAIN, 1>(F.in[16], D, DILKV, F.ws + WS_WKVB, CM + CM_KVB, SB + SB_KVB, 1.f, scr, r, F.lane); continue; } r -= I_KVB;
        if (r < I_QB) { conv_item<MAP_PLAIN, 1>(F.in[18], D, DILQ, F.ws + WS_WQB, CM + CM_QB, SB + SB_QB, 1.f, scr, r, F.lane); continue; } r -= I_QB;
        if (r < I_MLAIN) { conv_item<MAP_MLAIN, 1>(F.in[7], D, LATN, F.ws + WS_WMLAIN, CM + CM_LAT, SB + SB_LAT, 1.f, scr, r, F.lane); continue; } r -= I_MLAIN;
        if (r < I_QUP) { transpose_item<MAP_QUP>(F.in[9], QRANK, QUP, (bf16*)(F.ws + WS_WQUP), F.in[8], scr, r, F.lane); continue; } r -= I_QUP;
        if (r < I_KVUP) { transpose_item<MAP_PLAIN>(F.in[11], KVRANK, KVUP, (bf16*)(F.ws + WS_WKVUP), F.in[10], scr, r, F.lane); continue; } r -= I_KVUP;
        if (r < I_OUT) { transpose_item<MAP_PLAIN>(F.in[12], D, D, (bf16*)(F.ws + WS_WOUT), nullptr, scr, r, F.lane); continue; } r -= I_OUT;
        transpose_item<MAP_PLAIN>(F.in[19], DILOUT, D, (bf16*)(F.ws + WS_WOB), nullptr, scr, r, F.lane);
    }
    __syncthreads();
}

constexpr int HPITCH = 2048;
__device__ __forceinline__ void ld8_f32(const float* p, f32x4& a, f32x4& b) { a = *(const f32x4*)p; b = *(const f32x4*)(p + 4); }
__device__ __forceinline__ void ld8_bf16(const bf16* p, f32x4& a, f32x4& b) { const v4u w = *(const GAS v4u*)p; a = (f32x4){bf_lo(w.x), bf_hi(w.x), bf_lo(w.y), bf_hi(w.y)}; b = (f32x4){bf_lo(w.z), bf_hi(w.z), bf_lo(w.w), bf_hi(w.w)}; }
__device__ __forceinline__ float ssq8(const f32x4& a, const f32x4& b) { return ((a.x * a.x + a.y * a.y) + (a.z * a.z + a.w * a.w)) + ((b.x * b.x + b.y * b.y) + (b.z * b.z + b.w * b.w)); }
__device__ __forceinline__ v4u pk8(const f32x4& a, const f32x4& b) { return (v4u){pk2(a.x, a.y), pk2(a.z, a.w), pk2(b.x, b.y), pk2(b.z, b.w)}; }
__device__ __forceinline__ void quant_row(const f32x4 (&y)[2][2], i8* orow, float* srow, int lane) {
    const float mx = wave_max(fmaxf(amax8(y[0][0], y[0][1]), amax8(y[1][0], y[1][1])));
    const float sc = mx > 0.f ? mx * (1.0f / 127.0f) : 1.0f, inv = mx > 0.f ? 127.0f / mx : 0.f;
#pragma unroll
    for (int j = 0; j < 2; ++j) *(GAS v2u*)(orow + 8 * lane + 512 * j) = (v2u){q4(y[j][0], inv), q4(y[j][1], inv)};
    if (lane == 0) *srow = sc;
}
template <bool DUAL, bool INF32>
__device__ __forceinline__ void norm_phase(Frame& F, const void* Hin, const float* A0, const float* B0, i8* O0, float* S0, const float* A1, const float* B1, i8* O1, float* S1) {
    const int gw = F.vcu * NWAVES + F.wave, NGW = F.G * NWAVES;
    for (int c = gw; c < M / 16; c += NGW) {
        const int row0 = c * 16, b = row0 / SEQ;
        f32x4 a0[2][2], b0[2][2], a1[2][2], b1[2][2];
#pragma unroll
        for (int j = 0; j < 2; ++j) { const int co = b * D + 8 * F.lane + 512 * j; ld8_f32(A0 + co, a0[j][0], a0[j][1]); ld8_f32(B0 + co, b0[j][0], b0[j][1]);
            if (DUAL) { ld8_f32(A1 + co, a1[j][0], a1[j][1]); ld8_f32(B1 + co, b1[j][0], b1[j][1]); } }
#pragma unroll 2
        for (int i = 0; i < 16; ++i) { const size_t row = (size_t)(row0 + i);
            f32x4 v[2][2]; float s = 0.f;
#pragma unroll
            for (int j = 0; j < 2; ++j) { if (INF32) ld8_f32((const float*)Hin + row * D + 8 * F.lane + 512 * j, v[j][0], v[j][1]); else ld8_bf16((const bf16*)Hin + row * HPITCH + 8 * F.lane + 512 * j, v[j][0], v[j][1]);
                s += ssq8(v[j][0], v[j][1]); }
            const float rstd = 1.0f / sqrtf(wave_sum(s) * (1.f / D) + EPS);
            f32x4 y[2][2];
#pragma unroll
            for (int j = 0; j < 2; ++j) { y[j][0] = v[j][0] * rstd * a0[j][0] + b0[j][0]; y[j][1] = v[j][1] * rstd * a0[j][1] + b0[j][1]; }
            quant_row(y, O0 + row * D, S0 + row, F.lane);
            if (DUAL) {
#pragma unroll
                for (int j = 0; j < 2; ++j) { y[j][0] = v[j][0] * rstd * a1[j][0] + b1[j][0]; y[j][1] = v[j][1] * rstd * a1[j][1] + b1[j][1]; }
                quant_row(y, O1 + row * D, S1 + row, F.lane); }
        }
    }
}

__device__ __forceinline__ void latnorm_phase(Frame& F) {
    const int gw = F.vcu * NWAVES + F.wave, NGW = F.G * NWAVES;
    const bf16* LAT = (const bf16*)(F.ws + A_LAT); bf16* QN = (bf16*)(F.ws + A_QN); bf16* KVN = (bf16*)(F.ws + A_KVN); bf16* KB = (bf16*)(F.ws + A_K);
    const float* cs = (const float*)(F.ws + WS_CS);
    for (int row = gw; row < M; row += NGW) {
        const unsigned* lr = (const unsigned*)(LAT + (size_t)row * LATP);
        unsigned q[3], kv[2];
#pragma unroll
        for (int j = 0; j < 3; ++j) q[j] = lr[F.lane + 64 * j];
#pragma unroll
        for (int j = 0; j < 2; ++j) kv[j] = lr[192 + F.lane + 64 * j];
        const unsigned kr = lr[320 + (F.lane & 15)];
        float sq = 0.f, sk = 0.f;
#pragma unroll
        for (int j = 0; j < 3; ++j) { const float a = bf_lo(q[j]), b = bf_hi(q[j]); sq += a * a + b * b; }
#pragma unroll
        for (int j = 0; j < 2; ++j) { const float a = bf_lo(kv[j]), b = bf_hi(kv[j]); sk += a * a + b * b; }
        const float rq = 1.0f / sqrtf(wave_sum(sq) * (1.f / QRANK) + EPS), rk = 1.0f / sqrtf(wave_sum(sk) * (1.f / KVRANK) + EPS);
        unsigned* qo = (unsigned*)(QN + (size_t)row * QRANK); unsigned* ko = (unsigned*)(KVN + (size_t)row * KVRANK);
#pragma unroll
        for (int j = 0; j < 3; ++j) qo[F.lane + 64 * j] = pk2(bf_lo(q[j]) * rq, bf_hi(q[j]) * rq);
#pragma unroll
        for (int j = 0; j < 2; ++j) ko[F.lane + 64 * j] = pk2(bf_lo(kv[j]) * rk, bf_hi(kv[j]) * rk);
        { const int i = F.lane & 15; const float c = cs[(size_t)row * 32 + 2 * i], s = cs[(size_t)row * 32 + 2 * i + 1]; const float x1 = bf_lo(kr), x2 = bf_hi(kr);
          const unsigned w = pk2(x1 * c - x2 * s, x1 * s + x2 * c);
          unsigned* kb = (unsigned*)(KB + (size_t)row * QUP);
#pragma unroll
          for (int hh = 0; hh < 4; ++hh) { const int h = (F.lane >> 4) * 4 + hh; kb[(h * 96 + 64) / 2 + i] = w; } }
    }
}

__device__ __forceinline__ void merge_phase(Frame& F) {
    const int gw = F.vcu * NWAVES + F.wave, NGW = F.G * NWAVES;
    const bf16* OG = (const bf16*)(F.ws + A_OG); const float* LSE = (const float*)(F.ws + WS_LSE); bf16* OD = (bf16*)(F.ws + A_OD);
    for (int row = gw; row < M; row += NGW) {
        const int h = F.lane >> 3;
        float l0 = LSE[((size_t)0 * M + row) * 8 + h], l1 = LSE[((size_t)1 * M + row) * 8 + h], l2 = LSE[((size_t)2 * M + row) * 8 + h];
        const float mx = fmaxf(l0, fmaxf(l1, l2)); float w0 = __builtin_amdgcn_exp2f(l0 - mx), w1 = __builtin_amdgcn_exp2f(l1 - mx), w2 = __builtin_amdgcn_exp2f(l2 - mx);
        const float inv = 1.0f / (w0 + w1 + w2); w0 *= inv; w1 *= inv; w2 *= inv;
        const v4u a = *(const v4u*)(OG + ((size_t)0 * M + row) * DILOUT + 8 * F.lane), b = *(const v4u*)(OG + ((size_t)1 * M + row) * DILOUT + 8 * F.lane), c = *(const v4u*)(OG + ((size_t)2 * M + row) * DILOUT + 8 * F.lane);
        v4u o;
#pragma unroll
        for (int k = 0; k < 4; ++k) o[k] = pk2(w0 * bf_lo(a[k]) + w1 * bf_lo(b[k]) + w2 * bf_lo(c[k]), w0 * bf_hi(a[k]) + w1 * bf_hi(b[k]) + w2 * bf_hi(c[k]));
        *(v4u*)(OD + (size_t)row * DILOUT + 8 * F.lane) = o;
    }
}

__device__ __forceinline__ void router_phase(Frame& F, const bf16* H, const float* A0, const float* B0, i8* O0, float* S0) {
    const int gw = F.vcu * NWAVES + F.wave, NGW = F.G * NWAVES;
    LAS float* wrt = (LAS float*)F.lds;
    { const float* wr = F.in[22]; for (int i = F.tid; i < 8192; i += NWAVES * 64) { const int col = i >> 3, e = i & 7; wrt[e * 1024 + col] = wr[i]; } }
    __syncthreads();
    v4u* ROUTE = (v4u*)(F.ws + WS_ROUTE); unsigned* CNT = (unsigned*)(F.ws + WS_CNT);
    for (int c = gw; c < M / 16; c += NGW) {
        const int row0 = c * 16, b = row0 / SEQ;
        f32x4 a0[2][2], b0[2][2];
#pragma unroll
        for (int j = 0; j < 2; ++j) { const int co = b * D + 8 * F.lane + 512 * j; ld8_f32(A0 + co, a0[j][0], a0[j][1]); ld8_f32(B0 + co, b0[j][0], b0[j][1]); }
        unsigned cnt = 0u;
        for (int i = 0; i < 16; ++i) { const size_t row = (size_t)(row0 + i);
            f32x4 v[2][2]; float s = 0.f;
#pragma unroll
            for (int j = 0; j < 2; ++j) { ld8_bf16(H + row * HPITCH + 8 * F.lane + 512 * j, v[j][0], v[j][1]); s += ssq8(v[j][0], v[j][1]); }
            const float rstd = 1.0f / sqrtf(wave_sum(s) * (1.f / D) + EPS);
            float lg[8];
#pragma unroll
            for (int e = 0; e < 8; ++e) lg[e] = 0.f;
            f32x4 yq[2][2];
#pragma unroll
            for (int j = 0; j < 2; ++j) { const f32x4 y0 = v[j][0] * rstd * a0[j][0] + b0[j][0], y1 = v[j][1] * rstd * a0[j][1] + b0[j][1];
                yq[j][0] = y0; yq[j][1] = y1;
#pragma unroll
                for (int e = 0; e < 8; ++e) { const LAS float* wp = wrt + e * 1024 + 8 * F.lane + 512 * j; const f32x4 w0 = *(const LAS f32x4*)wp, w1 = *(const LAS f32x4*)(wp + 4);
                    lg[e] += ((y0.x * w0.x + y0.y * w0.y) + (y0.z * w0.z + y0.w * w0.w)) + ((y1.x * w1.x + y1.y * w1.y) + (y1.z * w1.z + y1.w * w1.w)); } }
            quant_row(yq, O0 + row * D, S0 + row, F.lane);
#pragma unroll
            for (int e = 0; e < 8; ++e) lg[e] = wave_sum(lg[e]);
            int e1 = 0; float v1 = lg[0];
#pragma unroll
            for (int e = 1; e < 8; ++e) if (lg[e] > v1) { v1 = lg[e]; e1 = e; }
            int e2 = -1; float v2 = -INFINITY;
#pragma unroll
            for (int e = 0; e < 8; ++e) if (e != e1 && lg[e] > v2) { v2 = lg[e]; e2 = e; }
            const float ex = expf(v2 - v1); const float g1 = 1.0f / (1.0f + ex), g2 = ex / (1.0f + ex);
            cnt += (F.lane == e1 ? 1u : 0u) + (F.lane == e2 ? 1u : 0u);
            if (F.lane == 0) ROUTE[row] = (v4u){(unsigned)e1 | ((unsigned)e2 << 8), __float_as_uint(g1), __float_as_uint(g2), 0u};
        }
        if (F.lane < 8) CNT[c * 8 + F.lane] = cnt;
    }
}

__device__ __forceinline__ void lists_phase(Frame& F) {
    const int gw = F.vcu * NWAVES + F.wave, NGW = F.G * NWAVES;
    const v4u* ROUTE = (const v4u*)(F.ws + WS_ROUTE); const unsigned* CNT = (const unsigned*)(F.ws + WS_CNT);
    int* LIST = (int*)(F.ws + WS_LIST); float* SLOTG = (float*)(F.ws + WS_SLOTG); float* SLOTXS = (float*)(F.ws + WS_SLOTXS); const float* XS = (const float*)(F.ws + WS_XS); int* TOKSLOT = (int*)(F.ws + WS_TOKSLOT); int* TILEEXP = (int*)(F.ws + WS_TILEEXP);
    for (int c = gw; c < M / 16; c += NGW) {
        unsigned lt[8], al[8];
#pragma unroll
        for (int e = 0; e < 8; ++e) { lt[e] = 0u; al[e] = 0u; }
        for (int cc = F.lane; cc < M / 16; cc += 64) { const v4u x = *(const v4u*)(CNT + cc * 8), y = *(const v4u*)(CNT + cc * 8 + 4); const bool bl = cc < c;
            al[0] += x.x; al[1] += x.y; al[2] += x.z; al[3] += x.w; al[4] += y.x; al[5] += y.y; al[6] += y.z; al[7] += y.w;
            if (bl) { lt[0] += x.x; lt[1] += x.y; lt[2] += x.z; lt[3] += x.w; lt[4] += y.x; lt[5] += y.y; lt[6] += y.z; lt[7] += y.w; } }
#pragma unroll
        for (int e = 0; e < 8; ++e) {
#pragma unroll
            for (int o = 1; o < 64; o <<= 1) { lt[e] += __shfl_xor(lt[e], o); al[e] += __shfl_xor(al[e], o); } }
        unsigned base[8]; unsigned run = 0u;
#pragma unroll
        for (int e = 0; e < 8; ++e) { base[e] = run; run += (al[e] + 255u) & ~255u; }
        const int row = c * 16 + (F.lane & 15);
        const v4u r = ROUTE[row]; const int e1 = (int)(r.x & 0xffu), e2 = (int)((r.x >> 8) & 0xffu);
        int s1 = 0, s2 = 0;
#pragma unroll
        for (int e = 0; e < 8; ++e) { const bool has = (F.lane < 16) && (e1 == e || e2 == e); const unsigned long long mk = __ballot(has);
            const int rank = __popcll(mk & ((1ull << F.lane) - 1ull)); const int sl = (int)(base[e] + lt[e]) + rank;
            if (e1 == e) s1 = sl; if (e2 == e) s2 = sl; }
        if (F.lane < 16) { LIST[s1] = row; LIST[s2] = row; SLOTG[s1] = __uint_as_float(r.y); SLOTG[s2] = __uint_as_float(r.z); TOKSLOT[row * 2] = s1; TOKSLOT[row * 2 + 1] = s2;
            const float xs = XS[row]; SLOTXS[s1] = xs; SLOTXS[s2] = xs; }
        if (c == 0) {
#pragma unroll
            for (int e = 0; e < 8; ++e) { const unsigned pe = (al[e] + 255u) & ~255u;
                for (unsigned s = base[e] + al[e] + F.lane; s < base[e] + pe; s += 64) { LIST[s] = 0; SLOTG[s] = 0.f; SLOTXS[s] = 0.f; }
                for (unsigned t = base[e] / 256u + F.lane; t < (base[e] + pe) / 256u; t += 64) TILEEXP[t] = e; }
            if (F.lane == 0) TILEEXP[300] = (int)(run / 256u);
        }
    }
}

__device__ __forceinline__ void final_phase(Frame& F, float* OUT, const float* gate, const float* gfin) {
    const int gw = F.vcu * NWAVES + F.wave, NGW = F.G * NWAVES;
    const bf16* Y = (const bf16*)(F.ws + A_Y); const int* TOKSLOT = (const int*)(F.ws + WS_TOKSLOT); const bf16* H = (const bf16*)OUT;
    for (int c = gw; c < M / 16; c += NGW) {
        const int row0 = c * 16, b = row0 / SEQ;
        f32x4 gt[2][2], gf[2][2];
#pragma unroll
        for (int j = 0; j < 2; ++j) { ld8_f32(gate + b * D + 8 * F.lane + 512 * j, gt[j][0], gt[j][1]); ld8_f32(gfin + 8 * F.lane + 512 * j, gf[j][0], gf[j][1]); }
#pragma unroll 2
        for (int i = 0; i < 16; ++i) { const size_t row = (size_t)(row0 + i);
            const int s1 = TOKSLOT[row * 2], s2 = TOKSLOT[row * 2 + 1];
            f32x4 v[2][2]; float s = 0.f;
#pragma unroll
            for (int j = 0; j < 2; ++j) { f32x4 h0, h1, p0, p1, q0, q1; ld8_bf16(H + row * HPITCH + 8 * F.lane + 512 * j, h0, h1);
                ld8_bf16(Y + (size_t)s1 * D + 8 * F.lane + 512 * j, p0, p1); ld8_bf16(Y + (size_t)s2 * D + 8 * F.lane + 512 * j, q0, q1);
                v[j][0] = h0 + gt[j][0] * (p0 + q0); v[j][1] = h1 + gt[j][1] * (p1 + q1); s += ssq8(v[j][0], v[j][1]); }
            const float rstd = 1.0f / sqrtf(wave_sum(s) * (1.f / D) + EPS);
            asm volatile("" ::: "memory");
#pragma unroll
            for (int j = 0; j < 2; ++j) { float* op = OUT + row * D + 8 * F.lane + 512 * j; *(GAS f32x4*)op = v[j][0] * rstd * gf[j][0]; *(GAS f32x4*)(op + 4) = v[j][1] * rstd * gf[j][1]; }
        }
    }
}
#ifndef MK_ONE_LAUNCH
#define MK_ONE_LAUNCH 1
#endif
constexpr int N_PHASES = 20;
struct Args { const float* in[26]; float* out; unsigned char* ws; int ph_lo, ph_hi; };
static_assert(sizeof(Args) == 26 * 8 + 8 + 8 + 8, "Args has no padding");

__global__ void __launch_bounds__(NWAVES * 64, 2) mk_fwd(Args args) {
    extern __shared__ __attribute__((aligned(16))) unsigned char lds[];
    Frame F;
    F.lds = (LAS unsigned char*)lds;
    F.MISC = (volatile LAS unsigned*)(F.lds + MISC_OFF);
    F.tid = threadIdx.x; F.lane = F.tid & 63; F.wave = __builtin_amdgcn_readfirstlane(F.tid >> 6);
    F.G = gridDim.x; { const int bx = blockIdx.x; F.vcu = (F.G % 8 == 0) ? (bx % 8) * (F.G / 8) + bx / 8 : bx; }
    F.ws = args.ws; F.out = args.out;
#pragma unroll
    for (int i = 0; i < 26; ++i) F.in[i] = args.in[i];
    unsigned char* const ws = args.ws;
    for (int u = F.tid; u < (LDS_BYTES - LDSCTL_OFF) / 4; u += NWAVES * 64) ((LAS unsigned*)(F.lds + LDSCTL_OFF))[u] = 0u;
    __syncthreads();
    const int lo = args.ph_lo, hi = args.ph_hi;
    XcdBarrier bar; bar.bar = (unsigned*)(ws + WS_CTL) + CW_BAR; bar.x = 0; bar.st = nullptr;
    if (hi - lo > 1) bar = xcd_barrier_post((unsigned*)(ws + WS_CTL) + CW_BAR, F.MISC + 8);
    int cid = (int)blockIdx.x;
    if (hi - lo > 1) { if (F.tid == 0) F.MISC[12] = xb_add((unsigned*)(ws + WS_CTL) + CW_RANK + 64 * bar.x, 1u); }

#ifndef PHASE_MASK
#define PHASE_MASK 0xFFFFFu
#endif
#define IN(k) (((PHASE_MASK >> (k)) & 1u) && lo <= (k) && (k) < hi)
#ifndef REPEAT_MASK
#define REPEAT_MASK 0u
#endif
#define REP(k) (((REPEAT_MASK >> (k)) & 1u) ? 2 : 1)
#define SEAM(k) do { if (IN(k) && IN((k) + 1)) xcd_barrier(bar); } while (0)
    const float* MODV = (const float*)(ws + WS_MODV);
#define MV(kind) (MODV + (size_t)(kind) * 4 * D)
    bf16* const H = (bf16*)args.out;
    i8* const XN = (i8*)(ws + A_XN); i8* const XNKV = (i8*)(ws + A_XNKV);
    float* const XS = (float*)(ws + WS_XS); float* const XSKV = (float*)(ws + WS_XSKV); const float* const SB = (const float*)(ws + WS_SB);
    const pg8::MoeInfo mi0{nullptr, nullptr, 0};

    if (IN(0)) for (int rep_ = 0; rep_ < REP(0); ++rep_) { p0_prologue(F); } SEAM(0);
    if (IN(0) && IN(1)) {
        if (F.tid == 0) { bool ok = (F.G % 8) == 0;
            for (unsigned j = 0; j < 16; ++j) { const unsigned cnt_ = xb_ld((unsigned*)(ws + WS_CTL) + CW_BAR + XB_XCNT(j)); ok = ok && (cnt_ == (j < 8 ? (unsigned)F.G / 8u : 0u)); }
            F.MISC[13] = ok ? (F.MISC[12] * 8u + bar.x) : (unsigned)blockIdx.x; }
        __syncthreads();
        cid = (int)F.MISC[13];
        F.vcu = (F.G % 8 == 0) ? (cid % 8) * (F.G / 8) + cid / 8 : cid;
    }

    if (IN(1)) for (int rep_ = 0; rep_ < REP(1); ++rep_) { p1_convert(F); norm_phase<false, true>(F, F.in[0], MV(MK_A_MIX0), MV(MK_B_MIX0), XN, XS, nullptr, nullptr, nullptr, nullptr); } SEAM(1);
    if (IN(2)) for (int rep_ = 0; rep_ < REP(2); ++rep_) { pg8::Gemm g{(const bf16*)XN, (const bf16*)(ws + WS_WMLAIN), M, LATP, D}; pg8::StaticOrder S; S.init(M, LATP, F.G, cid);
        pg8::EpiBf16Q E{(bf16*)(ws + A_LAT), LATP, XS, SB + SB_LAT};
        pg8::gemm_phase<pg8::EpiBf16Q, pg8::StaticOrder, true, true, 0, 1>(F.lds, g, S, E, mi0); } SEAM(2);
    if (IN(3)) for (int rep_ = 0; rep_ < REP(3); ++rep_) { latnorm_phase(F); } SEAM(3);
    if (IN(4)) for (int rep_ = 0; rep_ < REP(4); ++rep_) {
#ifndef P4_SKIP_Q
        { pg8::Gemm g{(const bf16*)(ws + A_QN), (const bf16*)(ws + WS_WQUP), M, QUP, QRANK}; pg8::StaticOrder S; S.init(M, QUP, F.G, cid);
          pg8::EpiQ E{(bf16*)(ws + A_Q), QUP, C2_MLA, (const float*)(ws + WS_CS)};
          pg8::gemm_phase<pg8::EpiQ, pg8::StaticOrder, true, true, 0>(F.lds, g, S, E, mi0); }
#endif
#ifndef P4_SKIP_KV
        { pg8::Gemm g{(const bf16*)(ws + A_KVN), (const bf16*)(ws + WS_WKVUP), M, KVUP, KVRANK}; pg8::StaticOrder S; S.init(M, KVUP, F.G, cid);
          pg8::EpiKV E{(bf16*)(ws + A_K), (bf16*)(ws + A_V)};
          pg8::gemm_phase<pg8::EpiKV, pg8::StaticOrder, true, true, 0>(F.lds, g, S, E, mi0); }
#endif
    } SEAM(4);
    if (IN(5)) for (int rep_ = 0; rep_ < REP(5); ++rep_) {
        const bf16* Qp = (const bf16*)(ws + A_Q); const bf16* Kp = (const bf16*)(ws + A_K); const bf16* Vp = (const bf16*)(ws + A_V); bf16* Op = (bf16*)(ws + A_O);
        if (F.G == 256) {
            for (int i = 0; i < 8; ++i) { const int bh = (F.vcu >> 3) + 32 * (i >> 2), s = F.vcu & 7, k = i & 3; const int qb = (k == 0) ? s : (k == 1) ? 15 - s : (k == 2) ? 16 + s : 31 - s;
                const int b = bh >> 4, h = bh & 15;
                mla::attn_unit<8>(b, h, qb, Qp, Kp, Vp, Op, (char*)lds); }
        } else {
            for (int u = (int)blockIdx.x; u < BATCH * MLA_H * 32; u += F.G) { const int bh = u >> 5, qb = 31 - (u & 31); const int b = bh >> 4, h = bh & 15;
                mla::attn_unit<8>(b, h, qb, Qp, Kp, Vp, Op, (char*)lds); }
        }
    } SEAM(5);
    if (IN(6)) for (int rep_ = 0; rep_ < REP(6); ++rep_) { pg8::Gemm g{(const bf16*)(ws + A_O), (const bf16*)(ws + WS_WOUT), M, D, D}; pg8::StaticOrder S; S.init(M, D, F.G, cid);
        pg8::EpiResid<true> E{F.in[0], H, MV(MK_G_MIX0), nullptr};
        pg8::gemm_phase<pg8::EpiResid<true>, pg8::StaticOrder, true, true, 0>(F.lds, g, S, E, mi0); } SEAM(6);
    if (IN(7)) for (int rep_ = 0; rep_ < REP(7); ++rep_) { norm_phase<false, false>(F, H, MV(MK_A_FFN0), MV(MK_B_FFN0), XN, XS, nullptr, nullptr, nullptr, nullptr); } SEAM(7);
    if (IN(8)) for (int rep_ = 0; rep_ < REP(8); ++rep_) { pg8::Gemm g{(const bf16*)XN, (const bf16*)(ws + WS_WFGU), M, 2 * DFF, D}; pg8::StaticOrder S; S.init(M, 2 * DFF, F.G, cid);
        pg8::EpiSwiGLUQ E{(unsigned char*)(ws + A_HID), DFF, XS, SB + SB_FGU, nullptr};
        pg8::gemm_phase<pg8::EpiSwiGLUQ, pg8::StaticOrder, true, true, 0, 1>(F.lds, g, S, E, mi0); } SEAM(8);
    if (IN(9)) for (int rep_ = 0; rep_ < REP(9); ++rep_) { pg8::Gemm g{(const bf16*)(ws + A_HID), (const bf16*)(ws + WS_WFDN), M, D, DFF}; pg8::StaticOrder S; S.init(M, D, F.G, cid);
        pg8::EpiResid<false> E{H, H, MV(MK_G_FFN0), SB + SB_FDN};
        pg8::gemm_phase<pg8::EpiResid<false>, pg8::StaticOrder, true, true, 0, 2>(F.lds, g, S, E, mi0); } SEAM(9);
    if (IN(10)) for (int rep_ = 0; rep_ < REP(10); ++rep_) { norm_phase<true, false>(F, H, MV(MK_A_MIX1), MV(MK_B_MIX1), XN, XS, MV(MK_A_KV), MV(MK_B_KV), XNKV, XSKV); } SEAM(10);
    if (IN(11)) for (int rep_ = 0; rep_ < REP(11); ++rep_) {
        { pg8::Gemm g{(const bf16*)XNKV, (const bf16*)(ws + WS_WKVB), M, DILKV, D}; pg8::StaticOrder S; S.init(M, DILKV, F.G, cid);
          pg8::EpiDilQ<true> E{(bf16*)(ws + A_KVB), XSKV, SB + SB_KVB};
          pg8::gemm_phase<pg8::EpiDilQ<true>, pg8::StaticOrder, true, true, 0, 1>(F.lds, g, S, E, mi0); }
        { pg8::Gemm g{(const bf16*)XN, (const bf16*)(ws + WS_WQB), M, DILQ, D}; pg8::StaticOrder S; S.init(M, DILQ, F.G, cid);
          pg8::EpiDilQ<false> E{(bf16*)(ws + A_QB), XS, SB + SB_QB};
          pg8::gemm_phase<pg8::EpiDilQ<false>, pg8::StaticOrder, true, true, 0, 1>(F.lds, g, S, E, mi0); }
    } SEAM(11);
    if (IN(12)) for (int rep_ = 0; rep_ < REP(12); ++rep_) {
        const bf16* Qp = (const bf16*)(ws + A_QB); const bf16* KV = (const bf16*)(ws + A_KVB); bf16* OG = (bf16*)(ws + A_OG); float* LSE = (float*)(ws + WS_LSE); const float* BT = (const float*)(ws + WS_BIAS);
        dila::dil_phase(Qp, KV, OG, LSE, BT, (char*)lds, F.G);
    } SEAM(12);
    if (IN(13)) for (int rep_ = 0; rep_ < REP(13); ++rep_) { merge_phase(F); } SEAM(13);
    if (IN(14)) for (int rep_ = 0; rep_ < REP(14); ++rep_) { pg8::Gemm g{(const bf16*)(ws + A_OD), (const bf16*)(ws + WS_WOB), M, D, DILOUT}; pg8::StaticOrder S; S.init(M, D, F.G, cid);
        pg8::EpiResid<false> E{H, H, MV(MK_G_MIX1), nullptr};
        pg8::gemm_phase<pg8::EpiResid<false>, pg8::StaticOrder, true, true, 0>(F.lds, g, S, E, mi0); } SEAM(14);
    if (IN(15)) for (int rep_ = 0; rep_ < REP(15); ++rep_) { router_phase(F, H, MV(MK_A_FFN1), MV(MK_B_FFN1), XN, XS); } SEAM(15);
    if (IN(16)) for (int rep_ = 0; rep_ < REP(16); ++rep_) { lists_phase(F); } SEAM(16);
    if (IN(17)) for (int rep_ = 0; rep_ < REP(17); ++rep_) { const int ntile = ((const int*)(ws + WS_TILEEXP))[300];
        pg8::Gemm g{(const bf16*)XN, (const bf16*)(ws + WS_WEGU), ntile * 256, 2 * DFF, D}; pg8::StaticOrder S; S.init(ntile * 256, 2 * DFF, F.G, cid);
        const pg8::MoeInfo mi{(const int*)(ws + WS_LIST), (const int*)(ws + WS_TILEEXP), (size_t)2 * DFF * D};
        pg8::EpiSwiGLUQ E{(unsigned char*)(ws + A_HIDS), DFF, (const float*)(ws + WS_SLOTXS), SB + SB_EGU, mi.tile_expert};
        pg8::gemm_phase<pg8::EpiSwiGLUQ, pg8::StaticOrder, true, true, 1, 1>(F.lds, g, S, E, mi); } SEAM(17);
    if (IN(18)) for (int rep_ = 0; rep_ < REP(18); ++rep_) { const int ntile = ((const int*)(ws + WS_TILEEXP))[300];
        pg8::Gemm g{(const bf16*)(ws + A_HIDS), (const bf16*)(ws + WS_WEDN), ntile * 256, D, DFF}; pg8::StaticOrder S; S.init(ntile * 256, D, F.G, cid);
        const pg8::MoeInfo mi{(const int*)(ws + WS_LIST), (const int*)(ws + WS_TILEEXP), (size_t)D * DFF};
        pg8::EpiMoeDown E{(bf16*)(ws + A_Y), (const float*)(ws + WS_SLOTG), SB + SB_EDN, mi.tile_expert};
        pg8::gemm_phase<pg8::EpiMoeDown, pg8::StaticOrder, true, true, 2, 2>(F.lds, g, S, E, mi); } SEAM(18);
    if (IN(19)) for (int rep_ = 0; rep_ < REP(19); ++rep_) { final_phase(F, args.out, MV(MK_G_FFN1), F.in[25]); }
#undef IN
#undef SEAM
#undef MV
}

extern "C" void kernel_launch(void* const* d_in, const int* in_sizes, int n_in, void* d_out, int out_size, void* d_ws, size_t ws_size, hipStream_t stream) {
    static int grid = 0;
    if (grid == 0) {
        if (n_in != 26 || in_sizes[0] != M * D || out_size != M * D || ws_size < WS_END) { fprintf(stderr, "kernel_launch: unexpected shapes (n_in %d, in0 %d, out %d, ws %zu, need %zu); nothing launched\n", n_in, n_in > 0 ? in_sizes[0] : -1, out_size, ws_size, (size_t)WS_END); grid = -1; return; }
        int dev = 0, cus = 0, per_cu = 0;
        if (hipGetDevice(&dev) != hipSuccess || hipDeviceGetAttribute(&cus, hipDeviceAttributeMultiprocessorCount, dev) != hipSuccess) { grid = -1; return; }
        if (hipFuncSetAttribute((const void*)mk_fwd, hipFuncAttributeMaxDynamicSharedMemorySize, LDS_BYTES) != hipSuccess) { fprintf(stderr, "kernel_launch: hipFuncSetAttribute failed\n"); grid = -1; return; }
        if (hipOccupancyMaxActiveBlocksPerMultiprocessor(&per_cu, (const void*)mk_fwd, NWAVES * 64, LDS_BYTES) != hipSuccess || per_cu < 1) { fprintf(stderr, "kernel_launch: occupancy query reports %d\n", per_cu); }
        (void)hipGetLastError();
        grid = cus;
    }
    if (grid < 0) return;
    if (hipMemsetAsync((char*)d_ws + WS_CTL, 0, CTL_ZERO_BYTES, stream) != hipSuccess) return;
    Args a{};
    for (int i = 0; i < 26; ++i) a.in[i] = (const float*)d_in[i];
    a.out = (float*)d_out; a.ws = (unsigned char*)d_ws;
#if MK_ONE_LAUNCH
    a.ph_lo = 0; a.ph_hi = N_PHASES;
    hipLaunchKernelGGL(mk_fwd, dim3(grid), dim3(NWAVES * 64), LDS_BYTES, stream, a);
#else
    for (int p = 0; p < N_PHASES; ++p) { a.ph_lo = p; a.ph_hi = p + 1; hipLaunchKernelGGL(mk_fwd, dim3(grid), dim3(NWAVES * 64), LDS_BYTES, stream, a); }
#endif
}
```

```cpp
#include <hip/hip_runtime.h>
#include <hip/hip_bf16.h>
#include <cstdio>
#include <cstdint>
#include <cmath>
#ifndef MK_ONE_LAUNCH
#define MK_ONE_LAUNCH 1
#endif
#ifndef PG8_STAGGER
#define PG8_STAGGER 0
#endif
namespace pg8 {
#define PG8_LAS __attribute__((address_space(3)))
typedef unsigned short bf16_t;
typedef short bf16x8 __attribute__((ext_vector_type(8)));
typedef float f32x4 __attribute__((ext_vector_type(4)));
typedef float f32x2 __attribute__((ext_vector_type(2)));
typedef unsigned u32x4 __attribute__((ext_vector_type(4)));
typedef int i32x4 __attribute__((ext_vector_type(4)));
typedef int i32x8 __attribute__((ext_vector_type(8)));
template <int PREC> struct AccT { typedef f32x4 type; }; template <> struct AccT<1> { typedef i32x4 type; };
constexpr int BM = 256, BK = 64, HALF = 128, HTB = HALF * BK * 2  , STAGE_BYTES = 8 * HTB, NXCD = 8, WGM = 8;

__host__ __device__ __forceinline__ int lds_byte(int r, int c) { const int st = (r >> 4) * 2 + (c >> 5), rr = r & 15, cc = c & 31, ob = rr * 64 + cc * 2; return st * 1024 + (ob ^ (((ob >> 9) & 1) << 5)); }
__host__ __device__ __forceinline__ void stage_rc(int b, int& R, int& C) { const int st = b / 1024, sb = b % 1024, swz = sb ^ (((sb >> 9) & 1) << 5); R = (st >> 1) * 16 + swz / 64; C = (st & 1) * 32 + (swz % 64) / 2; }
__host__ __device__ __forceinline__ int perm32(int rho) { const int n = rho >> 4, i = rho & 15; return 8 * (i >> 2) + 4 * n + (i & 3); }

struct Unit { int pm, pn; };
struct Gemm { const bf16_t* A; const bf16_t* Bt; int M, N, K; };
struct MoeInfo { const int* list; const int* tile_expert; size_t bstride; };

struct StaticOrder {
    int nM, nN, nwg, G, c;
    __host__ __device__ void init(int M, int N, int G_, int c_) { nM = M / BM; nN = N / BM; nwg = nM * nN; G = G_; c = c_; }
    __host__ __device__ bool next(int i, Unit& u) const {
        const long L = (long)i * G + c; if (L >= nwg) return false;
        int wgid = (int)L; { const int q = nwg / NXCD, r = nwg % NXCD, xcd = wgid % NXCD, off = wgid / NXCD; wgid = (xcd < r ? xcd * (q + 1) : r * (q + 1) + (xcd - r) * q) + off; }
        const int nig = WGM * nN, gid = wgid / nig, fm = gid * WGM, gsz = (nM - fm) < WGM ? (nM - fm) : WGM;
        u.pm = fm + ((wgid % nig) % gsz); u.pn = (wgid % nig) / gsz; return true;
    }
    __device__ __forceinline__ void a_ready(const Unit&) const {}
    __device__ __forceinline__ void done(const Unit&) const {}
};

__device__ __forceinline__ unsigned cvt_pk_bf16(float lo, float hi) { unsigned r; asm volatile("v_cvt_pk_bf16_f32 %0, %1, %2" : "=v"(r) : "v"(lo), "v"(hi)); return r; }


template <class Epi, class Sched, bool ALIGN_EPI, bool SP2, int MODE, int PREC = 0>
__device__ __forceinline__ void gemm_phase(PG8_LAS unsigned char* lds, const Gemm g, const Sched& S, const Epi& E, const MoeInfo mi) {
    const int tid = threadIdx.x, wid = __builtin_amdgcn_readfirstlane(tid >> 6), lane = tid & 63, wr = wid >> 2, wc = wid & 3, fr = lane & 15, fq = lane >> 4;
    int K_ = g.K; asm volatile("" : "+s"(K_));
    constexpr int ES = PREC ? 1 : 2;
    const int K = K_, nt = (K * ES) / (BK * 2);
    unsigned voffB[2]; int Rr[2], Cc[2];
#pragma unroll
    for (int i = 0; i < 2; ++i) { int R, C; stage_rc(tid * 16 + i * 8192, R, C); const int Rb = Epi::PERM ? ((R & ~31) + perm32(R & 31)) : R;
        Rr[i] = R; Cc[i] = C; voffB[i] = (unsigned)(Rb * K) * (unsigned)ES + (unsigned)C * 2u; }
    const size_t kstep = (size_t)(BK * 2);
    const size_t hstep = (size_t)HALF * K * ES;
    const size_t tstep = 2 * hstep;
    const unsigned ldsw = (unsigned)wid * 1024u;
    const int aoff = lds_byte(wr * 64 + fr, fq * 8), boff = lds_byte(wc * 32 + fr, fq * 8);
    const unsigned rowb = (unsigned)K * (unsigned)ES;
#define PG8_SA(b, h) (((b) * 2 + (h)) * HTB)
#define PG8_SB(b, h) ((4 + (b) * 2 + (h)) * HTB)
#define PG8_STAGE(bufoff, gbase, voff) do { _Pragma("unroll") for (int _i = 0; _i < 2; ++_i) \
        __builtin_amdgcn_global_load_lds((const unsigned*)((const char*)(gbase) + (voff)[_i]), (PG8_LAS unsigned*)(lds + (bufoff) + ldsw + _i * 8192), 16, 0, 0); } while (0)
#define PG8_LDA(dst, b, h) do { _Pragma("unroll") for (int m = 0; m < 4; ++m) { if constexpr (PREC == 2) { \
            const i32x4 lo_ = *(const PG8_LAS i32x4*)(lds + PG8_SA(b, h) + aoff + m * 2048), hi_ = *(const PG8_LAS i32x4*)(lds + PG8_SA(b, h) + aoff + m * 2048 + 1024); \
            dst##8[m] = (i32x8){lo_[0], lo_[1], lo_[2], lo_[3], hi_[0], hi_[1], hi_[2], hi_[3]}; } \
        else { _Pragma("unroll") for (int k = 0; k < 2; ++k) dst[m][k] = *(const PG8_LAS bf16x8*)(lds + PG8_SA(b, h) + aoff + m * 2048 + k * 1024); } } } while (0)
#define PG8_LDB(dst, b, h) do { _Pragma("unroll") for (int n = 0; n < 2; ++n) { if constexpr (PREC == 2) { \
            const i32x4 lo_ = *(const PG8_LAS i32x4*)(lds + PG8_SB(b, h) + boff + n * 2048), hi_ = *(const PG8_LAS i32x4*)(lds + PG8_SB(b, h) + boff + n * 2048 + 1024); \
            dst##8[n] = (i32x8){lo_[0], lo_[1], lo_[2], lo_[3], hi_[0], hi_[1], hi_[2], hi_[3]}; } \
        else { _Pragma("unroll") for (int k = 0; k < 2; ++k) dst[n][k] = *(const PG8_LAS bf16x8*)(lds + PG8_SB(b, h) + boff + n * 2048 + k * 1024); } } } while (0)
#define PG8_MMA(ai, bj, At, Bt) do { __builtin_amdgcn_s_setprio(1); _Pragma("unroll") for (int m = 0; m < 4; ++m) _Pragma("unroll") for (int n = 0; n < 2; ++n) { \
        if constexpr (PREC == 2) asm volatile("s_nop 1\n\tv_mfma_scale_f32_16x16x128_f8f6f4 %0, %1, %2, %0, %3, %3 op_sel_hi:[0,0,0]" : "+v"(acc[ai][bj][m][n]) : "v"(Bt##8[n]), "v"(At##8[m]), "v"(one_scale));   \
        else { _Pragma("unroll") for (int k = 0; k < 2; ++k) { \
            if constexpr (PREC == 1) acc[ai][bj][m][n] = __builtin_amdgcn_mfma_i32_16x16x64_i8(__builtin_bit_cast(i32x4, Bt[n][k]), __builtin_bit_cast(i32x4, At[m][k]), acc[ai][bj][m][n], 0, 0, 0); \
            else acc[ai][bj][m][n] = __builtin_amdgcn_mfma_f32_16x16x32_bf16(Bt[n][k], At[m][k], acc[ai][bj][m][n], 0, 0, 0); } } } __builtin_amdgcn_s_setprio(0); } while (0)
#define PG8_WAIT_V(n) asm volatile("s_waitcnt vmcnt(" #n ")" ::: "memory")
#define PG8_WAIT_L(n) asm volatile("s_waitcnt lgkmcnt(" #n ")" ::: "memory")
#define PG8_WAIT_V8R do { const int rlx_ = rlx_flag;   \
        if constexpr (Epi::NST >= 16) asm volatile("s_cmp_eq_u32 %0, 0\n\ts_cbranch_scc1 .Lpg8a%=\n\ts_waitcnt vmcnt(24)\n\ts_branch .Lpg8b%=\n.Lpg8a%=:\n\ts_waitcnt vmcnt(8)\n.Lpg8b%=:" :: "s"(rlx_) : "memory", "scc"); \
        else if constexpr (Epi::NST >= 8) asm volatile("s_cmp_eq_u32 %0, 0\n\ts_cbranch_scc1 .Lpg8a%=\n\ts_waitcnt vmcnt(16)\n\ts_branch .Lpg8b%=\n.Lpg8a%=:\n\ts_waitcnt vmcnt(8)\n.Lpg8b%=:" :: "s"(rlx_) : "memory", "scc"); \
        else PG8_WAIT_V(8); } while (0)
#define PG8_BAR __builtin_amdgcn_s_barrier()
#define PG8_SCHED __builtin_amdgcn_sched_barrier(0)
#define PG8_MKOFF(u, o) do { _Pragma("unroll") for (int _h = 0; _h < 2; ++_h) _Pragma("unroll") for (int _i = 0; _i < 2; ++_i) { \
        int _row = (u).pm * BM + _h * HALF + Rr[_i]; if (MODE == 1) _row = mi.list[_row]; (o)[_h][_i] = (unsigned)_row * rowb + (unsigned)Cc[_i] * 2u; } } while (0)
#define PG8_BBASE(u) ((const char*)g.Bt + (size_t)(u).pn * tstep + (MODE != 0 ? (size_t)mi.tile_expert[(u).pm] * mi.bstride : (size_t)0))
    Unit cur, nxt; int ui = 0;
    if (!S.next(0, cur)) return;
#if PG8_STAGGER
    {
        const int grp = ((int)blockIdx.x >> 3) & 3;
        if (grp) { if (wid == 0) { const unsigned long long t0 = __builtin_amdgcn_s_memrealtime(); const unsigned long long dt = (unsigned long long)(grp * nt * PG8_STAGGER);
                       while (__builtin_amdgcn_s_memrealtime() - t0 < dt) __builtin_amdgcn_s_sleep(8); }
                   __syncthreads(); }
    }
#endif
    typedef typename AccT<PREC>::type acc_t;
    acc_t acc[2][2][4][2];
#pragma unroll
    for (int a = 0; a < 2; ++a)
#pragma unroll
        for (int b = 0; b < 2; ++b)
#pragma unroll
            for (int m = 0; m < 4; ++m)
#pragma unroll
                for (int n = 0; n < 2; ++n) acc[a][b][m][n] = acc_t{};
    bf16x8 At[4][2], B0[2][2], B1[2][2];
    const int one_scale = 0x7f7f7f7f;
    unsigned oc[2][2], on[2][2];
    const char* const Ab = (const char*)g.A;
    const char* cAu = Ab;
    if constexpr (MODE == 1) { PG8_MKOFF(cur, oc); } else { Unit u0_; u0_.pm = 0; u0_.pn = 0; PG8_MKOFF(u0_, oc); cAu = Ab + (size_t)cur.pm * tstep; }
    const char* cB = PG8_BBASE(cur);
    S.a_ready(cur);
    static_assert(SP2, "only the SP2 loop is kept");
    {
        PG8_STAGE(PG8_SB(0, 0), cB, voffB); PG8_STAGE(PG8_SB(0, 1), cB + hstep, voffB); PG8_STAGE(PG8_SA(0, 0), cAu, oc[0]); PG8_STAGE(PG8_SA(0, 1), cAu, oc[1]);
        if (wr == 1) PG8_BAR;
        PG8_WAIT_V(2); PG8_BAR;
        PG8_STAGE(PG8_SB(1, 0), cB + kstep, voffB); PG8_STAGE(PG8_SA(1, 0), cAu + kstep, oc[0]); PG8_STAGE(PG8_SB(1, 1), cB + hstep + kstep, voffB);
        PG8_WAIT_V(6); PG8_BAR;
    }
    Unit nn; unsigned onn[2][2]; bool has_next_c = false;
    if constexpr (MODE == 1) { has_next_c = S.next(1, nxt); if (has_next_c) PG8_MKOFF(nxt, on); }
    int rlx_flag = 0;
    for (;;) {
        bool has_next; bool has_nn = false;
        if constexpr (MODE == 1) { has_next = has_next_c; has_nn = has_next && S.next(ui + 2, nn); if (has_nn) PG8_MKOFF(nn, onn); }
        else has_next = S.next(ui + 1, nxt);
        const char* nB = cB; const char* nAu = cAu;
        if (has_next) { if constexpr (MODE != 1) nAu = Ab + (size_t)nxt.pm * tstep; nB = PG8_BBASE(nxt); }
        else if constexpr (MODE == 1) {
#pragma unroll
            for (int _h = 0; _h < 2; ++_h)
#pragma unroll
                for (int _i = 0; _i < 2; ++_i) on[_h][_i] = oc[_h][_i];
        }
        for (int t = 0; t < nt; t += 2) {
            const bool last = (t == nt - 2);
            i32x8 At8[4], B08[2], B18[2];
            const char* a1 = cAu + (size_t)(t + 1) * kstep;
            const char* a2 = last ? nAu : cAu + (size_t)(t + 2) * kstep; const char* b2 = last ? nB : cB + (size_t)(t + 2) * kstep;
            const char* a3 = a2 + kstep; const char* b3 = b2 + kstep;
            unsigned o2[2][2];
#pragma unroll
            for (int _h = 0; _h < 2; ++_h)
#pragma unroll
                for (int _i = 0; _i < 2; ++_i) o2[_h][_i] = (MODE == 1 && last) ? on[_h][_i] : oc[_h][_i];
            if (last && has_next) S.a_ready(nxt);
            PG8_LDB(B0, 0, 0); PG8_LDB(B1, 0, 1); PG8_SCHED; PG8_LDA(At, 0, 0); PG8_STAGE(PG8_SA(1, 1), a1, oc[1]);
            PG8_WAIT_V8R; PG8_WAIT_L(0); PG8_BAR; PG8_MMA(0, 0, At, B0); PG8_MMA(0, 1, At, B1); PG8_BAR; PG8_SCHED;
            PG8_LDA(At, 0, 1); PG8_STAGE(PG8_SB(0, 0), b2, voffB); PG8_STAGE(PG8_SB(0, 1), b2 + hstep, voffB); PG8_STAGE(PG8_SA(0, 0), a2, o2[0]);
            PG8_WAIT_V8R; PG8_WAIT_L(0); PG8_BAR; PG8_MMA(1, 0, At, B0); PG8_MMA(1, 1, At, B1); PG8_BAR; PG8_SCHED;
            PG8_LDB(B0, 1, 0); PG8_LDB(B1, 1, 1); PG8_SCHED; PG8_LDA(At, 1, 0); PG8_STAGE(PG8_SA(0, 1), a2, o2[1]);
            PG8_WAIT_V(8); PG8_WAIT_L(0); PG8_BAR; PG8_MMA(0, 0, At, B0); PG8_MMA(0, 1, At, B1); PG8_BAR; PG8_SCHED;
            PG8_LDA(At, 1, 1); PG8_STAGE(PG8_SB(1, 0), b3, voffB); PG8_STAGE(PG8_SB(1, 1), b3 + hstep, voffB); PG8_STAGE(PG8_SA(1, 0), a3, o2[0]);
            PG8_WAIT_V(8); PG8_WAIT_L(0); PG8_BAR; PG8_MMA(1, 0, At, B0); PG8_MMA(1, 1, At, B1); PG8_BAR; PG8_SCHED;
            rlx_flag = 0; asm volatile("" : "+s"(rlx_flag));
        }
        if constexpr (ALIGN_EPI) { if (wr == 0) PG8_BAR; }
        if constexpr (PREC == 2) asm volatile("s_nop 15\n\ts_nop 15" ::: "memory");
        E(acc, cur, wr, wc, fr, fq); S.done(cur);
        if (!has_next) break;
#pragma unroll
        for (int a = 0; a < 2; ++a)
#pragma unroll
            for (int b = 0; b < 2; ++b)
#pragma unroll
                for (int m = 0; m < 4; ++m)
#pragma unroll
                    for (int n = 0; n < 2; ++n) acc[a][b][m][n] = acc_t{};
        cur = nxt; cB = nB; cAu = nAu; ++ui; rlx_flag = 1; asm volatile("" : "+s"(rlx_flag));
        if constexpr (MODE == 1) {
#pragma unroll
            for (int _h = 0; _h < 2; ++_h)
#pragma unroll
                for (int _i = 0; _i < 2; ++_i) oc[_h][_i] = on[_h][_i]; }
        if constexpr (MODE == 1) { nxt = nn; has_next_c = has_nn;
#pragma unroll
            for (int _h = 0; _h < 2; ++_h)
#pragma unroll
                for (int _i = 0; _i < 2; ++_i) on[_h][_i] = onn[_h][_i]; }
        if constexpr (ALIGN_EPI) { if (wr == 1) PG8_BAR; }
    }
    PG8_WAIT_V(0);
    if constexpr (!ALIGN_EPI) { if (wr == 0) PG8_BAR; }
    PG8_BAR;
#undef PG8_SA
#undef PG8_SB
#undef PG8_STAGE
#undef PG8_LDA
#undef PG8_LDB
#undef PG8_MMA
#undef PG8_WAIT_V
#undef PG8_WAIT_L
#undef PG8_WAIT_V8R
#undef PG8_BAR
#undef PG8_SCHED
#undef PG8_MKOFF
#undef PG8_BBASE
}
}
namespace pg8 {
constexpr float LOG2E = 1.4426950408889634f;
struct EpiBf16 {
    static constexpr bool PERM = true; static constexpr int NST = 16;
    bf16_t* O; int ldc; float scale;
    __device__ __forceinline__ void operator()(const f32x4 (&acc)[2][2][4][2], const Unit& u, int wr, int wc, int fr, int fq) const {
        const int row0 = u.pm * BM + wr * 64 + fr; const int col0 = u.pn * BM + wc * 32 + 8 * fq;
#pragma unroll
        for (int ai = 0; ai < 2; ++ai)
#pragma unroll
            for (int m = 0; m < 4; ++m) { bf16_t* rowp = O + (size_t)(row0 + ai * HALF + m * 16) * ldc + col0;
#pragma unroll
                for (int bj = 0; bj < 2; ++bj) { const f32x4 v0 = acc[ai][bj][m][0] * scale, v1 = acc[ai][bj][m][1] * scale;
                    u32x4 w; w.x = cvt_pk_bf16(v0[0], v0[1]); w.y = cvt_pk_bf16(v0[2], v0[3]); w.z = cvt_pk_bf16(v1[0], v1[1]); w.w = cvt_pk_bf16(v1[2], v1[3]);
                    *(u32x4*)(rowp + bj * HALF) = w; } }
    }
};
struct EpiQ {
    static constexpr bool PERM = true; static constexpr int NST = 16;
    bf16_t* O; int ldc; float scale; const float* cs;
    __device__ __forceinline__ void operator()(const f32x4 (&acc)[2][2][4][2], const Unit& u, int wr, int wc, int fr, int fq) const {
        const int row0 = u.pm * BM + wr * 64 + fr; const int col0 = u.pn * BM + wc * 32 + 8 * fq;
        const int grp = u.pn * 8 + wc;
#pragma unroll
        for (int bj = 0; bj < 2; ++bj) { const bool rope = ((grp + 4 * bj) % 3) == 2;
#pragma unroll
            for (int ai = 0; ai < 2; ++ai)
#pragma unroll
                for (int m = 0; m < 4; ++m) { const int row = row0 + ai * HALF + m * 16; bf16_t* rowp = O + (size_t)row * ldc + col0 + bj * HALF;
                    f32x4 v0 = acc[ai][bj][m][0] * scale, v1 = acc[ai][bj][m][1] * scale;
                    if (rope) { const f32x4* cp = (const f32x4*)(cs + (size_t)row * 32 + 8 * fq); const f32x4 c0 = cp[0], c1 = cp[1];
                        f32x4 r0, r1;
                        r0[0] = v0[0] * c0[0] - v0[1] * c0[1]; r0[1] = v0[0] * c0[1] + v0[1] * c0[0];
                        r0[2] = v0[2] * c0[2] - v0[3] * c0[3]; r0[3] = v0[2] * c0[3] + v0[3] * c0[2];
                        r1[0] = v1[0] * c1[0] - v1[1] * c1[1]; r1[1] = v1[0] * c1[1] + v1[1] * c1[0];
                        r1[2] = v1[2] * c1[2] - v1[3] * c1[3]; r1[3] = v1[2] * c1[3] + v1[3] * c1[2];
                        v0 = r0; v1 = r1; }
                    u32x4 w; w.x = cvt_pk_bf16(v0[0], v0[1]); w.y = cvt_pk_bf16(v0[2], v0[3]); w.z = cvt_pk_bf16(v1[0], v1[1]); w.w = cvt_pk_bf16(v1[2], v1[3]);
                    *(u32x4*)rowp = w;
                    if (m & 1) asm volatile("" ::: "memory"); } }
    }
};
struct EpiKV {
    static constexpr bool PERM = true; static constexpr int NST = 16;
    bf16_t* Kb; bf16_t* Vb;
    __device__ __forceinline__ void operator()(const f32x4 (&acc)[2][2][4][2], const Unit& u, int wr, int wc, int fr, int fq) const {
        const int row0 = u.pm * BM + wr * 64 + fr;
        const bool isk = wc < 2;
        bf16_t* const base = isk ? Kb : Vb; const int pitch = isk ? 1536 : 1024, hs = isk ? 96 : 64, j0 = (isk ? wc : wc - 2) * 32 + 8 * fq;
#pragma unroll
        for (int ai = 0; ai < 2; ++ai)
#pragma unroll
            for (int m = 0; m < 4; ++m) { bf16_t* rowp = base + (size_t)(row0 + ai * HALF + m * 16) * pitch + j0;
#pragma unroll
                for (int bj = 0; bj < 2; ++bj) { const f32x4 v0 = acc[ai][bj][m][0], v1 = acc[ai][bj][m][1];
                    u32x4 w; w.x = cvt_pk_bf16(v0[0], v0[1]); w.y = cvt_pk_bf16(v0[2], v0[3]); w.z = cvt_pk_bf16(v1[0], v1[1]); w.w = cvt_pk_bf16(v1[2], v1[3]);
                    *(u32x4*)(rowp + (2 * u.pn + bj) * hs) = w; } }
    }
};
template <bool BASEF32> struct EpiResid {
    static constexpr bool PERM = true; static constexpr int NST = 16;
    static constexpr int HP = 2048;
    const void* base; bf16_t* out; const float* gate; const float* sB;
    __device__ __forceinline__ void operator()(const f32x4 (&acc)[2][2][4][2], const Unit& u, int wr, int wc, int fr, int fq) const {
        const int row0 = u.pm * BM + wr * 64 + fr; const int col0 = u.pn * BM + wc * 32 + 8 * fq;
        const float* gp = gate + (size_t)((u.pm * BM) >> 13) * 1024 + col0;
        f32x4 gv[2][2];
#pragma unroll
        for (int bj = 0; bj < 2; ++bj)
#pragma unroll
            for (int n = 0; n < 2; ++n) { gv[bj][n] = *(const f32x4*)(gp + bj * HALF + n * 4); if (sB) gv[bj][n] = gv[bj][n] * *(const f32x4*)(sB + col0 + bj * HALF + n * 4); }
#pragma unroll
        for (int ai = 0; ai < 2; ++ai)
#pragma unroll
            for (int m = 0; m < 4; ++m) { const size_t row = (size_t)(row0 + ai * HALF + m * 16);
#pragma unroll
                for (int bj = 0; bj < 2; ++bj) { f32x4 b0, b1;
                    if (BASEF32) { const float* bp = (const float*)base + row * 1024 + col0 + bj * HALF; b0 = *(const f32x4*)bp; b1 = *(const f32x4*)(bp + 4); }
                    else { const u32x4 hb = *(const u32x4*)((const bf16_t*)base + row * HP + col0 + bj * HALF);
                        b0 = (f32x4){__builtin_bit_cast(float, hb.x << 16), __builtin_bit_cast(float, hb.x & 0xffff0000u), __builtin_bit_cast(float, hb.y << 16), __builtin_bit_cast(float, hb.y & 0xffff0000u)};
                        b1 = (f32x4){__builtin_bit_cast(float, hb.z << 16), __builtin_bit_cast(float, hb.z & 0xffff0000u), __builtin_bit_cast(float, hb.w << 16), __builtin_bit_cast(float, hb.w & 0xffff0000u)}; }
                    const f32x4 v0 = b0 + gv[bj][0] * acc[ai][bj][m][0], v1 = b1 + gv[bj][1] * acc[ai][bj][m][1];
                    u32x4 w; w.x = cvt_pk_bf16(v0[0], v0[1]); w.y = cvt_pk_bf16(v0[2], v0[3]); w.z = cvt_pk_bf16(v1[0], v1[1]); w.w = cvt_pk_bf16(v1[2], v1[3]);
                    *(u32x4*)(out + row * HP + col0 + bj * HALF) = w; }
                if (m & 1) asm volatile("" ::: "memory"); }
    }
};
__device__ __forceinline__ float silu_mul(float g, float u) { return g * u * __builtin_amdgcn_rcpf(1.0f + __builtin_amdgcn_exp2f(-g * LOG2E)); }
struct EpiSwiGLU {
    static constexpr bool PERM = true; static constexpr int NST = 8;
    bf16_t* O; int ldc;
    __device__ __forceinline__ void operator()(const f32x4 (&acc)[2][2][4][2], const Unit& u, int wr, int wc, int fr, int fq) const {
        const int row0 = u.pm * BM + wr * 64 + fr; const int col0 = u.pn * HALF + wc * 32 + 8 * fq;
#pragma unroll
        for (int ai = 0; ai < 2; ++ai)
#pragma unroll
            for (int m = 0; m < 4; ++m) { bf16_t* rowp = O + (size_t)(row0 + ai * HALF + m * 16) * ldc + col0;
                const f32x4 g0 = acc[ai][0][m][0], g1 = acc[ai][0][m][1], u0 = acc[ai][1][m][0], u1 = acc[ai][1][m][1];
                u32x4 w; w.x = cvt_pk_bf16(silu_mul(g0[0], u0[0]), silu_mul(g0[1], u0[1])); w.y = cvt_pk_bf16(silu_mul(g0[2], u0[2]), silu_mul(g0[3], u0[3]));
                w.z = cvt_pk_bf16(silu_mul(g1[0], u1[0]), silu_mul(g1[1], u1[1])); w.w = cvt_pk_bf16(silu_mul(g1[2], u1[2]), silu_mul(g1[3], u1[3]));
                *(u32x4*)rowp = w; }
    }
};
struct EpiMoeDown {
    static constexpr bool PERM = true; static constexpr int NST = 16;
    bf16_t* O; const float* sg; const float* sB; const int* tile_expert;
    __device__ __forceinline__ void operator()(const f32x4 (&acc)[2][2][4][2], const Unit& u, int wr, int wc, int fr, int fq) const {
        const int row0 = u.pm * BM + wr * 64 + fr; const int col0 = u.pn * BM + wc * 32 + 8 * fq;
        const float* sb = sB + (size_t)tile_expert[u.pm] * 1024 + col0;
        f32x4 sv[2][2];
#pragma unroll
        for (int bj = 0; bj < 2; ++bj)
#pragma unroll
            for (int n = 0; n < 2; ++n) sv[bj][n] = *(const f32x4*)(sb + bj * HALF + 4 * n);
#pragma unroll
        for (int ai = 0; ai < 2; ++ai)
#pragma unroll
            for (int m = 0; m < 4; ++m) { const int row = row0 + ai * HALF + m * 16; const float s = sg[row]; bf16_t* rowp = O + (size_t)row * 1024 + col0;
#pragma unroll
                for (int bj = 0; bj < 2; ++bj) { const f32x4 v0 = acc[ai][bj][m][0] * sv[bj][0] * s, v1 = acc[ai][bj][m][1] * sv[bj][1] * s;
                    u32x4 w; w.x = cvt_pk_bf16(v0[0], v0[1]); w.y = cvt_pk_bf16(v0[2], v0[3]); w.z = cvt_pk_bf16(v1[0], v1[1]); w.w = cvt_pk_bf16(v1[2], v1[3]);
                    *(u32x4*)(rowp + bj * HALF) = w; } }
    }
};
template <bool KV> struct EpiDil {
    static constexpr bool PERM = true; static constexpr int NST = 16;
    bf16_t* O; float scale;
    __device__ __forceinline__ void operator()(const f32x4 (&acc)[2][2][4][2], const Unit& u, int wr, int wc, int fr, int fq) const {
        const int row0 = u.pm * BM + wr * 64 + fr;
#pragma unroll
        for (int bj = 0; bj < 2; ++bj) { const int col = u.pn * BM + bj * HALF + wc * 32 + 8 * fq;
            const int g = KV ? (col >> 10) : (col >> 9), h = (col >> 6) & 7, d = col & 63, kv = KV ? ((col >> 9) & 1) : 0;
            const int sh = 2 * g;
#pragma unroll
            for (int ai = 0; ai < 2; ++ai)
#pragma unroll
                for (int m = 0; m < 4; ++m) { const int row = row0 + ai * HALF + m * 16, b = row >> 13, t = row & 8191;
                    const int r = t & ((1 << sh) - 1), pos = t >> sh;
                    const size_t rec = (size_t)g * 262144 + (size_t)((((b << sh) + r) * 8 + h) * (8192 >> sh) + pos);
                    bf16_t* dst = KV ? (O + rec * 128 + kv * 64 + d) : (O + rec * 64 + d);
                    const f32x4 v0 = acc[ai][bj][m][0] * scale, v1 = acc[ai][bj][m][1] * scale;
                    u32x4 w; w.x = cvt_pk_bf16(v0[0], v0[1]); w.y = cvt_pk_bf16(v0[2], v0[3]); w.z = cvt_pk_bf16(v1[0], v1[1]); w.w = cvt_pk_bf16(v1[2], v1[3]);
                    *(u32x4*)dst = w; } }
    }
};
}
namespace pg8 {
__device__ __forceinline__ f32x4 i2f(const i32x4& a, float sa, const f32x4& sb) { return (f32x4){(float)a[0], (float)a[1], (float)a[2], (float)a[3]} * sa * sb; }
struct EpiBf16Q {
    static constexpr bool PERM = true; static constexpr int NST = 16;
    bf16_t* O; int ldc; const float* sA; const float* sB;
    __device__ __forceinline__ void operator()(const i32x4 (&acc)[2][2][4][2], const Unit& u, int wr, int wc, int fr, int fq) const {
        const int row0 = u.pm * BM + wr * 64 + fr; const int col0 = u.pn * BM + wc * 32 + 8 * fq;
        f32x4 sb[2][2];
#pragma unroll
        for (int bj = 0; bj < 2; ++bj)
#pragma unroll
            for (int n = 0; n < 2; ++n) sb[bj][n] = *(const f32x4*)(sB + col0 + bj * HALF + 4 * n);
#pragma unroll
        for (int ai = 0; ai < 2; ++ai)
#pragma unroll
            for (int m = 0; m < 4; ++m) { const int row = row0 + ai * HALF + m * 16; const float sa = sA[row]; bf16_t* rowp = O + (size_t)row * ldc + col0;
#pragma unroll
                for (int bj = 0; bj < 2; ++bj) { const f32x4 v0 = i2f(acc[ai][bj][m][0], sa, sb[bj][0]), v1 = i2f(acc[ai][bj][m][1], sa, sb[bj][1]);
                    u32x4 w; w.x = cvt_pk_bf16(v0[0], v0[1]); w.y = cvt_pk_bf16(v0[2], v0[3]); w.z = cvt_pk_bf16(v1[0], v1[1]); w.w = cvt_pk_bf16(v1[2], v1[3]);
                    *(u32x4*)(rowp + bj * HALF) = w; } }
    }
};
template <bool KV> struct EpiDilQ {
    static constexpr bool PERM = true; static constexpr int NST = 16;
    bf16_t* O; const float* sA; const float* sB;
    __device__ __forceinline__ void operator()(const i32x4 (&acc)[2][2][4][2], const Unit& u, int wr, int wc, int fr, int fq) const {
        bf16_t* const O_ = O; constexpr float scale_ = KV ? 1.0f : 0.18033688011112042f; const float* const sA_ = sA; const float* const sB_ = sB;
        const int row0 = u.pm * BM + wr * 64 + fr;
        const int colt = u.pn * BM;
        const int g = KV ? (colt >> 10) : (colt >> 9), kv = KV ? ((colt >> 9) & 1) : 0, sh = 2 * g, npos = 8192 >> sh;
        constexpr int RS = KV ? 128 : 64;
        const int d = (wc & 1) * 32 + 8 * fq;
        size_t hoff[2]; f32x4 sb[2][2];
#pragma unroll
        for (int bj = 0; bj < 2; ++bj) { const int col = colt + bj * HALF + wc * 32 + 8 * fq; const int h = (col >> 6) & 7;
            hoff[bj] = (size_t)h * npos * RS + kv * 64 + d; sb[bj][0] = *(const f32x4*)(sB_ + col) * scale_; sb[bj][1] = *(const f32x4*)(sB_ + col + 4) * scale_; }
#pragma unroll
        for (int ai = 0; ai < 2; ++ai)
#pragma unroll
            for (int m = 0; m < 4; ++m) { const int row = row0 + ai * HALF + m * 16, b = row >> 13, t = row & 8191;
                const int r = t & ((1 << sh) - 1), pos = t >> sh;
                bf16_t* rp = O_ + ((size_t)g * 262144 + (size_t)(((b << sh) + r) * 8 * npos + pos)) * RS;
                const float sa = sA_[row];
#pragma unroll
                for (int bj = 0; bj < 2; ++bj) { const f32x4 v0 = i2f(acc[ai][bj][m][0], sa, sb[bj][0]), v1 = i2f(acc[ai][bj][m][1], sa, sb[bj][1]);
                    u32x4 w; w.x = cvt_pk_bf16(v0[0], v0[1]); w.y = cvt_pk_bf16(v0[2], v0[3]); w.z = cvt_pk_bf16(v1[0], v1[1]); w.w = cvt_pk_bf16(v1[2], v1[3]);
                    *(u32x4*)(rp + hoff[bj]) = w; }
                if (m & 1) asm volatile("" ::: "memory"); }
    }
};
constexpr float HSCALE = 8.0f;
__device__ __forceinline__ unsigned pk4_fp8(float a, float b, float c, float d) {
    a = __builtin_fminf(__builtin_fmaxf(a, -448.f), 448.f); b = __builtin_fminf(__builtin_fmaxf(b, -448.f), 448.f); c = __builtin_fminf(__builtin_fmaxf(c, -448.f), 448.f); d = __builtin_fminf(__builtin_fmaxf(d, -448.f), 448.f);
    int w = 0; w = __builtin_amdgcn_cvt_pk_fp8_f32(a, b, w, false); w = __builtin_amdgcn_cvt_pk_fp8_f32(c, d, w, true); return (unsigned)w; }
struct EpiSwiGLUQ {
    static constexpr bool PERM = true; static constexpr int NST = 8;
    unsigned char* O; int ldc; const float* sA; const float* sB; const int* tile_expert;
    __device__ __forceinline__ void operator()(const i32x4 (&acc)[2][2][4][2], const Unit& u, int wr, int wc, int fr, int fq) const {
        const int row0 = u.pm * BM + wr * 64 + fr; const int col0 = u.pn * HALF + wc * 32 + 8 * fq;
        const float* sb = sB + (tile_expert ? (size_t)tile_expert[u.pm] * (2 * 2816) : (size_t)0) + u.pn * BM + wc * 32 + 8 * fq;
        const f32x4 sg0 = *(const f32x4*)sb, sg1 = *(const f32x4*)(sb + 4), su0 = *(const f32x4*)(sb + HALF) * HSCALE, su1 = *(const f32x4*)(sb + HALF + 4) * HSCALE;
        typedef unsigned u32x2 __attribute__((ext_vector_type(2)));
#pragma unroll
        for (int ai = 0; ai < 2; ++ai)
#pragma unroll
            for (int m = 0; m < 4; ++m) { const int row = row0 + ai * HALF + m * 16; const float sa = sA[row]; unsigned char* rowp = O + (size_t)row * ldc + col0;
                const f32x4 g0 = i2f(acc[ai][0][m][0], sa, sg0), g1 = i2f(acc[ai][0][m][1], sa, sg1), u0 = i2f(acc[ai][1][m][0], sa, su0), u1 = i2f(acc[ai][1][m][1], sa, su1);
                u32x2 w; w.x = pk4_fp8(silu_mul(g0[0], u0[0]), silu_mul(g0[1], u0[1]), silu_mul(g0[2], u0[2]), silu_mul(g0[3], u0[3]));
                w.y = pk4_fp8(silu_mul(g1[0], u1[0]), silu_mul(g1[1], u1[1]), silu_mul(g1[2], u1[2]), silu_mul(g1[3], u1[3]));
                *(u32x2*)rowp = w; }
    }
};
}
namespace att {
using bf16 = unsigned short;
using bf16x8 = __attribute__((ext_vector_type(8))) short;
using s16x4 = __attribute__((ext_vector_type(4))) short;
using f32x16 = __attribute__((ext_vector_type(16))) float;
using u32x4 = __attribute__((ext_vector_type(4))) unsigned;
constexpr int NW = 8;
constexpr float THR = 8.0f;
__device__ __forceinline__ int crow(int r, int hi) { return (r & 3) + 8 * (r >> 2) + 4 * hi; }
__device__ __forceinline__ void glds16(const void* gsrc, unsigned lds_dst) { unsigned keep;
    asm volatile("s_mov_b32 %0, m0\n\ts_mov_b32 m0, %2\n\ts_nop 0\n\tglobal_load_lds_dwordx4 %1, off\n\ts_mov_b32 m0, %0" : "=&s"(keep) : "v"(gsrc), "s"(lds_dst) : "memory"); }
typedef float f32x2_t __attribute__((ext_vector_type(2))); typedef __bf16 bf16x2_t __attribute__((ext_vector_type(2)));
__device__ __forceinline__ unsigned cvtpk_s(float lo, float hi) { f32x2_t v = {lo, hi}; bf16x2_t b = __builtin_convertvector(v, bf16x2_t); return __builtin_bit_cast(unsigned, b); }
#define ATT_SBAR() __builtin_amdgcn_sched_barrier(0)
#define ATT_WAIT_BAR(N) asm volatile("s_waitcnt vmcnt(" #N ") lgkmcnt(0)\n\ts_barrier" ::: "memory")

template <int DQK> struct Lay {
    static constexpr int NKC = DQK / 8, KSLOT = NKC * 1024, ND0 = DQK / 16;
    static constexpr int LK = 0, LV = 3 * KSLOT, LWS = LV + 3 * 8192, LOST = LWS + NW * 256, LBIAS = LOST + NW * 4096, LEND = LBIAS + 1024;
};
static_assert(Lay<96>::LEND <= 131072 && Lay<64>::LEND <= 131072, "attention LDS");

__device__ __forceinline__ float rowmax32(const f32x16& p0, const f32x16& p1) {
    float a = __builtin_fmaxf(__builtin_fmaxf(p0[0], p0[1]), p1[0]), b = __builtin_fmaxf(__builtin_fmaxf(p0[2], p0[3]), p1[1]); a = __builtin_fmaxf(__builtin_fmaxf(a, p1[2]), p1[3]);
#pragma unroll
    for (int r = 4; r < 16; r += 4) { a = __builtin_fmaxf(__builtin_fmaxf(a, p0[r]), p0[r + 1]); b = __builtin_fmaxf(__builtin_fmaxf(b, p0[r + 2]), p0[r + 3]); a = __builtin_fmaxf(__builtin_fmaxf(a, p1[r]), p1[r + 1]); b = __builtin_fmaxf(__builtin_fmaxf(b, p1[r + 2]), p1[r + 3]); }
    float m = __builtin_fmaxf(a, b);
    auto rr = __builtin_amdgcn_permlane32_swap(__float_as_uint(m), __float_as_uint(m), false, false);
    return __builtin_fmaxf(__uint_as_float(rr[0]), __uint_as_float(rr[1]));
}
__device__ __forceinline__ void pv(f32x16* o, int vb, bf16x8 pa0, bf16x8 pa1, bf16x8 pa2, bf16x8 pa3) {
#pragma unroll
    for (int d0 = 0; d0 < 2; ++d0) { s16x4 lo[4], hi[4];
#pragma unroll
        for (int ks = 0; ks < 4; ++ks) {
            asm volatile("ds_read_b64_tr_b16 %0,%1 offset:%c2" : "=&v"(lo[ks]) : "v"(vb), "i"(d0 * 4096 + ks * 1024) : "memory");
            asm volatile("ds_read_b64_tr_b16 %0,%1 offset:%c2" : "=&v"(hi[ks]) : "v"(vb), "i"(d0 * 4096 + ks * 1024 + 512) : "memory"); }
        asm volatile("s_waitcnt lgkmcnt(0)" ::: "memory"); ATT_SBAR();
#define ATT_PK(k) (bf16x8){lo[k][0], lo[k][1], lo[k][2], lo[k][3], hi[k][0], hi[k][1], hi[k][2], hi[k][3]}
        o[d0] = __builtin_amdgcn_mfma_f32_32x32x16_bf16(pa0, ATT_PK(0), o[d0], 0, 0, 0);
        o[d0] = __builtin_amdgcn_mfma_f32_32x32x16_bf16(pa1, ATT_PK(1), o[d0], 0, 0, 0);
        o[d0] = __builtin_amdgcn_mfma_f32_32x32x16_bf16(pa2, ATT_PK(2), o[d0], 0, 0, 0);
        o[d0] = __builtin_amdgcn_mfma_f32_32x32x16_bf16(pa3, ATT_PK(3), o[d0], 0, 0, 0);
#undef ATT_PK
    }
}

template <int DQK, bool DIL>
__device__ __forceinline__ void attn_unit(const bf16* Qb, int pq, const bf16* __restrict__ Kb, int pk, const bf16* __restrict__ Vb, int pvp, bf16* Ob, int po, float* lse, const float* biasg,
                                          long rowbase, int dil, int q0, char* shm) {
    typedef Lay<DQK> L;
    const int tid = threadIdx.x, lane = tid & 63, r32 = lane & 31, hi = lane >> 5; const int wid = __builtin_amdgcn_readfirstlane(tid >> 6);
    const unsigned lds0 = (unsigned)(uintptr_t)shm;
    float* wsf = (float*)(shm + L::LWS) + wid * 64;
    const int kpos0 = DIL ? q0 - 128 : 0;
    const int t_begin = DIL ? (q0 == 0 ? 2 : 0) : 0;
    const int t_end = DIL ? 6 : (q0 + 256) / 64;
    const int wt0 = DIL ? (wid >> 1) : 0;
    const int wt1 = DIL ? 2 + (wid >> 1) : (q0 + 32 * wid + 31) / 64;
    const bool two_k = (L::NKC > 8) && (wid + 8 < L::NKC);
#define ATT_GROW(pos) (rowbase + (long)(pos) * dil)
#define ATT_ISSUE(t, s) do { const int kp_ = kpos0 + 64 * (t); \
        glds16(Kb + ATT_GROW(kp_ + lane) * pk + wid * 8, (unsigned)__builtin_amdgcn_readfirstlane(lds0 + L::LK + (s) * L::KSLOT + wid * 1024)); \
        if (two_k) glds16(Kb + ATT_GROW(kp_ + lane) * pk + (wid + 8) * 8, (unsigned)__builtin_amdgcn_readfirstlane(lds0 + L::LK + (s) * L::KSLOT + (wid + 8) * 1024)); \
        glds16(Vb + ATT_GROW(kp_ + 16 * (wid & 3) + (lane >> 2)) * pvp + (wid >> 2) * 32 + (lane & 3) * 8, (unsigned)__builtin_amdgcn_readfirstlane(lds0 + L::LV + (s) * 8192 + wid * 1024)); } while (0)
    if (DIL) { if (tid < 129) ((float*)(shm + L::LBIAS))[tid] = biasg[tid]; }
    ATT_ISSUE(t_begin, 0);
    if (t_begin + 1 < t_end) ATT_ISSUE(t_begin + 1, 1);
    bf16x8 qr[L::ND0];
    { const bf16* Qw = Qb + ATT_GROW(q0 + wid * 32 + r32) * pq + hi * 8;
#pragma unroll
      for (int d0 = 0; d0 < L::ND0; ++d0) qr[d0] = *reinterpret_cast<const bf16x8*>(Qw + d0 * 16); }
    float mhat = 0.f, l_reg = 0.f; f32x16 o[2]; o[0] = f32x16{}; o[1] = f32x16{}; f32x16 negm = f32x16{};
    bool first = true;
    const int qrel = (DIL ? 128 : q0) + wid * 32 + r32;
    const int vbl = (int)(lds0 + L::LV) + ((lane >> 4) & 1) * 32 + (lane & 3) * 8 + (4 * hi + ((lane & 15) >> 2)) * 64;
    int slot = 0;
    for (int t = t_begin; t < t_end; ++t) {
        if (t + 1 < t_end) { if (two_k) ATT_WAIT_BAR(3); else ATT_WAIT_BAR(2); } else ATT_WAIT_BAR(0);
        if (t + 2 < t_end) { const int s2 = slot >= 1 ? slot - 1 : 2; ATT_ISSUE(t + 2, s2); }
        if (t >= wt0 && t <= wt1) {
            f32x16 p0, p1;
            { const char* kb = shm + L::LK + slot * L::KSLOT + hi * 1024 + r32 * 16;
#pragma unroll
              for (int d0 = 0; d0 < L::ND0; ++d0) {
                const bf16x8 b0 = *reinterpret_cast<const bf16x8*>(kb + d0 * 2048);
                const bf16x8 b1 = *reinterpret_cast<const bf16x8*>(kb + d0 * 2048 + 512);
                if (d0 == 0) { p0 = __builtin_amdgcn_mfma_f32_32x32x16_bf16(b0, qr[0], negm, 0, 0, 0); p1 = __builtin_amdgcn_mfma_f32_32x32x16_bf16(b1, qr[0], negm, 0, 0, 0); }
                else { p0 = __builtin_amdgcn_mfma_f32_32x32x16_bf16(b0, qr[d0], p0, 0, 0, 0); p1 = __builtin_amdgcn_mfma_f32_32x32x16_bf16(b1, qr[d0], p1, 0, 0, 0); } } }
            if (DIL) { const float* bl = (const float*)(shm + L::LBIAS); const int jb = qrel - 64 * t - 4 * hi;
#pragma unroll
                for (int r = 0; r < 16; ++r) { const int j0 = jb - ((r & 3) + 8 * (r >> 2)), j1 = j0 - 32;
                    const int c0 = j0 < 0 ? 0 : (j0 > 128 ? 128 : j0), c1 = j1 < 0 ? 0 : (j1 > 128 ? 128 : j1);
                    const float b0 = bl[c0], b1 = bl[c1];
                    p0[r] = (j0 >= 0 && j0 <= 128) ? p0[r] + b0 : -INFINITY; p1[r] = (j1 >= 0 && j1 <= 128) ? p1[r] + b1 : -INFINITY; }
            } else if (64 * t + 63 > q0 + 32 * wid) { const int jb = qrel - 64 * t - 4 * hi;
#pragma unroll
                for (int r = 0; r < 16; ++r) { const int j0 = jb - ((r & 3) + 8 * (r >> 2)); if (j0 < 0) p0[r] = -INFINITY; if (j0 - 32 < 0) p1[r] = -INFINITY; } }
            const float rm = rowmax32(p0, p1);
            if (first) { first = false; const float dl = rm; mhat += dl;
#pragma unroll
                for (int r = 0; r < 16; ++r) { p0[r] -= dl; p1[r] -= dl; }
#pragma unroll
                for (int r = 0; r < 16; ++r) negm[r] = -mhat;
            } else if (__any(rm > THR)) { const float dl = __builtin_fmaxf(rm, 0.f); mhat += dl;
#pragma unroll
                for (int r = 0; r < 16; ++r) { p0[r] -= dl; p1[r] -= dl; }
#pragma unroll
                for (int r = 0; r < 16; ++r) negm[r] = -mhat;
                const float f = __builtin_amdgcn_exp2f(-dl); l_reg *= f; if (hi == 0) wsf[r32] = f;
                asm volatile("s_waitcnt lgkmcnt(0)" ::: "memory");
#pragma unroll
                for (int d_ = 0; d_ < 2; ++d_)
#pragma unroll
                    for (int r = 0; r < 16; ++r) o[d_][r] *= wsf[crow(r, hi)];
                asm volatile("s_waitcnt lgkmcnt(0)" ::: "memory");
            }
            float sacc = 0.f;
#pragma unroll
            for (int r = 0; r < 16; ++r) { p0[r] = __builtin_amdgcn_exp2f(p0[r]); p1[r] = __builtin_amdgcn_exp2f(p1[r]); sacc += p0[r] + p1[r]; }
            l_reg += sacc;
            u32x4 pw0, pw1, pw2, pw3;
#define ATT_PKW(P, B) cvtpk_s(P[B], P[B + 1])
            pw0 = (u32x4){ATT_PKW(p0, 0), ATT_PKW(p0, 2), ATT_PKW(p0, 4), ATT_PKW(p0, 6)}; pw1 = (u32x4){ATT_PKW(p0, 8), ATT_PKW(p0, 10), ATT_PKW(p0, 12), ATT_PKW(p0, 14)};
            pw2 = (u32x4){ATT_PKW(p1, 0), ATT_PKW(p1, 2), ATT_PKW(p1, 4), ATT_PKW(p1, 6)}; pw3 = (u32x4){ATT_PKW(p1, 8), ATT_PKW(p1, 10), ATT_PKW(p1, 12), ATT_PKW(p1, 14)};
#undef ATT_PKW
            ATT_SBAR();
            pv(o, vbl + slot * 8192, __builtin_bit_cast(bf16x8, pw0), __builtin_bit_cast(bf16x8, pw1), __builtin_bit_cast(bf16x8, pw2), __builtin_bit_cast(bf16x8, pw3));
        }
        slot = slot == 2 ? 0 : slot + 1;
    }
    { auto rr = __builtin_amdgcn_permlane32_swap(__float_as_uint(l_reg), __float_as_uint(l_reg), false, false); l_reg = __uint_as_float(rr[0]) + __uint_as_float(rr[1]); }
    if (hi == 0) wsf[32 + r32] = l_reg;
    asm volatile("s_waitcnt lgkmcnt(0)" ::: "memory");
    float rli[16];
#pragma unroll
    for (int r = 0; r < 16; ++r) rli[r] = __builtin_amdgcn_rcpf(wsf[32 + crow(r, hi)]);
    if (DIL) { if (hi == 0) lse[ATT_GROW(q0 + wid * 32 + r32) * 8] = mhat + __builtin_amdgcn_logf(l_reg); }
    { bf16* stg = (bf16*)(shm + L::LOST) + wid * 2048;
#pragma unroll
      for (int r = 0; r < 16; ++r) { const int orow = crow(r, hi);
#pragma unroll
        for (int d0 = 0; d0 < 2; ++d0) stg[orow * 64 + d0 * 32 + r32] = (bf16)(cvtpk_s(o[d0][r] * rli[r], 0.f) & 0xffffu); }
      asm volatile("s_waitcnt lgkmcnt(0)" ::: "memory");
#pragma unroll
      for (int i = 0; i < 4; ++i) { const int row = i * 8 + (lane >> 3), ch = lane & 7; const u32x4 v = *(const u32x4*)(stg + row * 64 + ch * 8);
        *(u32x4*)(Ob + ATT_GROW(q0 + wid * 32 + row) * po + ch * 8) = v; } }
    asm volatile("s_waitcnt lgkmcnt(0)\n\ts_barrier" ::: "memory");
#undef ATT_GROW
#undef ATT_ISSUE
}
#undef ATT_SBAR
#undef ATT_WAIT_BAR
}
namespace mla {
using bf16 = unsigned short;
using bf16x8 = __attribute__((ext_vector_type(8))) short;
using s16x4 = __attribute__((ext_vector_type(4))) short;
using f32x16 = __attribute__((ext_vector_type(16))) float;
using u32x4 = __attribute__((ext_vector_type(4))) unsigned;
constexpr int SEQL = 8192, PQ = 1536, PV = 1024, HQ = 96, HV = 64;
constexpr int NW = 8, QBLK = 32, QB = QBLK * NW, KVBLK = 64;
__device__ __forceinline__ int crow(int r, int hi) { return (r & 3) + 8 * (r >> 2) + 4 * hi; }
#define SBAR() __builtin_amdgcn_sched_barrier(0)
__device__ __forceinline__ void cmask(f32x16& p0, f32x16& p1, int jb, int qrel, int hi) {
    const float NEG = -INFINITY; int kb = 64 * jb + 4 * hi;
#pragma unroll
    for (int r = 0; r < 16; ++r) { int kv = kb + (r & 3) + 8 * (r >> 2); if (kv > qrel) p0[r] = NEG; if (kv + 32 > qrel) p1[r] = NEG; }
}
constexpr int NSLOT = 3, KSLOTB = 12288, VSLOTB = 8192;
constexpr int LDS_K = 0, LDS_V = NSLOT * KSLOTB, LDS_WS = LDS_V + NSLOT * VSLOTB, LDS_OST = LDS_WS + NW * 64 * 4, LDS_BYTES = LDS_OST + NW * 4096;
static_assert(LDS_BYTES <= 131072, "mla attention LDS");
__device__ __forceinline__ void glds16(const void* gsrc, unsigned lds_dst) { unsigned keep;
    asm volatile("s_mov_b32 %0, m0\n\ts_mov_b32 m0, %2\n\ts_nop 0\n\tglobal_load_lds_dwordx4 %1, off\n\ts_mov_b32 m0, %0" : "=&s"(keep) : "v"(gsrc), "s"(lds_dst) : "memory"); }
__device__ __forceinline__ float max3f(float a, float b, float c) { float r; asm("v_max3_f32 %0, %1, %2, %3" : "=v"(r) : "v"(a), "v"(b), "v"(c)); return r; }
__device__ __forceinline__ float max2f(float a, float b) { float r; asm("v_max_f32_e32 %0, %1, %2" : "=v"(r) : "v"(a), "v"(b)); return r; }
__device__ __forceinline__ float fadd_s(float a, float b) { float r; asm("v_add_f32_e32 %0, %1, %2" : "=v"(r) : "v"(a), "v"(b)); return r; }
__device__ __forceinline__ float fsub_s(float a, float b) { float r; asm("v_sub_f32_e32 %0, %1, %2" : "=v"(r) : "v"(a), "v"(b)); return r; }
typedef float f32x2_t __attribute__((ext_vector_type(2))); typedef __bf16 bf16x2_t __attribute__((ext_vector_type(2)));
__device__ __forceinline__ unsigned cvtpk_s(float lo, float hi) { f32x2_t v = {lo, hi}; bf16x2_t b = __builtin_convertvector(v, bf16x2_t); return __builtin_bit_cast(unsigned, b); }
#define WAIT_BAR(N) asm volatile("s_waitcnt vmcnt(" #N ") lgkmcnt(0)\n\ts_barrier" ::: "memory")

__device__ __forceinline__ void qkt(f32x16& p0, f32x16& p1, const char* Kslot, const bf16x8* qr, const f32x16& negm, int r32, int hi) {
    const char* kb = Kslot + hi * 1024 + r32 * 16;
#pragma unroll
    for (int d0 = 0; d0 < 6; ++d0) {
        const bf16x8 b0 = *reinterpret_cast<const bf16x8*>(kb + d0 * 2048);
        const bf16x8 b1 = *reinterpret_cast<const bf16x8*>(kb + d0 * 2048 + 512);
        if (d0 == 0) { p0 = __builtin_amdgcn_mfma_f32_32x32x16_bf16(b0, qr[0], negm, 0, 0, 0); p1 = __builtin_amdgcn_mfma_f32_32x32x16_bf16(b1, qr[0], negm, 0, 0, 0); }
        else { p0 = __builtin_amdgcn_mfma_f32_32x32x16_bf16(b0, qr[d0], p0, 0, 0, 0); p1 = __builtin_amdgcn_mfma_f32_32x32x16_bf16(b1, qr[d0], p1, 0, 0, 0); } }
}
typedef __attribute__((address_space(3))) const char* lds_cptr;
typedef short v4i16_t __attribute__((ext_vector_type(4)));
__device__ __forceinline__ void kload12(bf16x8* kf, lds_cptr kp) {
#pragma unroll
    for (int j = 0; j < 6; ++j) { kf[2 * j] = *(const __attribute__((address_space(3))) bf16x8*)(kp + j * 2048); kf[2 * j + 1] = *(const __attribute__((address_space(3))) bf16x8*)(kp + j * 2048 + 512); }
}
__device__ __forceinline__ void kload2(bf16x8* kf, lds_cptr kp, int j) { kf[2 * j] = *(const __attribute__((address_space(3))) bf16x8*)(kp + j * 2048); kf[2 * j + 1] = *(const __attribute__((address_space(3))) bf16x8*)(kp + j * 2048 + 512); }
__device__ __forceinline__ s16x4 vtr(lds_cptr p) { return __builtin_bit_cast(s16x4, __builtin_amdgcn_ds_read_tr16_b64_v4i16((__attribute__((address_space(3))) v4i16_t*)p)); }
__device__ __forceinline__ float rowmax(const f32x16& p0, const f32x16& p1) {
    float a = max3f(p0[0], p0[1], p1[0]), b = max3f(p0[2], p0[3], p1[1]); a = max3f(a, p1[2], p1[3]);
#pragma unroll
    for (int r = 4; r < 16; r += 4) { a = max3f(a, p0[r], p0[r + 1]); b = max3f(b, p0[r + 2], p0[r + 3]); a = max3f(a, p1[r], p1[r + 1]); b = max3f(b, p1[r + 2], p1[r + 3]); }
    const float m = max2f(a, b);
    auto rr = __builtin_amdgcn_permlane32_swap(__float_as_uint(m), __float_as_uint(m), false, false);
    return max2f(__uint_as_float(rr[0]), __uint_as_float(rr[1]));
}
__device__ __forceinline__ void pv(f32x16* o, int vb, bf16x8 pa0, bf16x8 pa1, bf16x8 pa2, bf16x8 pa3) {
#pragma unroll
    for (int d0 = 0; d0 < 2; ++d0) { s16x4 lo[4], hi[4];
#pragma unroll
        for (int ks = 0; ks < 4; ++ks) {
            asm volatile("ds_read_b64_tr_b16 %0,%1 offset:%c2" : "=&v"(lo[ks]) : "v"(vb), "i"(d0 * 4096 + ks * 1024) : "memory");
            asm volatile("ds_read_b64_tr_b16 %0,%1 offset:%c2" : "=&v"(hi[ks]) : "v"(vb), "i"(d0 * 4096 + ks * 1024 + 512) : "memory"); }
        asm volatile("s_waitcnt lgkmcnt(0)" ::: "memory"); SBAR();
#define PK(k) (bf16x8){lo[k][0], lo[k][1], lo[k][2], lo[k][3], hi[k][0], hi[k][1], hi[k][2], hi[k][3]}
        o[d0] = __builtin_amdgcn_mfma_f32_32x32x16_bf16(pa0, PK(0), o[d0], 0, 0, 0);
        o[d0] = __builtin_amdgcn_mfma_f32_32x32x16_bf16(pa1, PK(1), o[d0], 0, 0, 0);
        o[d0] = __builtin_amdgcn_mfma_f32_32x32x16_bf16(pa2, PK(2), o[d0], 0, 0, 0);
        o[d0] = __builtin_amdgcn_mfma_f32_32x32x16_bf16(pa3, PK(3), o[d0], 0, 0, 0);
#undef PK
    }
}

constexpr float OSCALE = 32.0f;
template <int THRL> __device__ __forceinline__ void attn_unit(int b, int h, int qb, const bf16* Q, const bf16* __restrict__ K, const bf16* __restrict__ V, unsigned char* O, char* shm) {
    int tid_ = threadIdx.x; asm volatile("" : "+v"(tid_));
    const int tid = tid_, lane = tid & 63, r32 = lane & 31, hi = lane >> 5; const int wid = __builtin_amdgcn_readfirstlane(tid >> 6);
    const long rowbase = (long)b * SEQL; const int q0 = qb * QB;
    const bf16* Qw = Q + (rowbase + q0 + wid * QBLK) * PQ + h * HQ;
    const bf16* Kh = K + rowbase * PQ + h * HQ; const bf16* Vh = V + rowbase * PV + h * HV;
    const unsigned lds0 = (unsigned)(uintptr_t)shm;
    float* wsf = (float*)(shm + LDS_WS) + wid * 64;
    const bool k2 = wid < 4;
    const bf16* ksrc = Kh + (long)lane * PQ + wid * 8;
    const bf16* vsrc = Vh + (long)(16 * (wid & 3) + (lane >> 2)) * PV + (wid >> 2) * 32 + (lane & 3) * 8;
    const unsigned kdst = lds0 + LDS_K + wid * 1024, vdst = lds0 + LDS_V + wid * 1024;
#define DMA_K(t, slot) do { glds16(ksrc + (long)(t) * KVBLK * PQ, (unsigned)__builtin_amdgcn_readfirstlane(kdst + (slot))); \
        if (k2) glds16(ksrc + (long)(t) * KVBLK * PQ + 64, (unsigned)__builtin_amdgcn_readfirstlane(kdst + (slot) + 8192)); } while (0)
#define DMA_V(t, slot) glds16(vsrc + (long)(t) * KVBLK * PV, (unsigned)__builtin_amdgcn_readfirstlane(vdst + (slot)))
    const int vb0 = (int)(lds0 + LDS_V) + ((lane >> 4) & 1) * 32 + (lane & 3) * 8 + (4 * hi + ((lane & 15) >> 2)) * 64;
    const char* Kbase = shm + LDS_K; bf16x8 kf[12];
    const lds_cptr shm3 = (lds_cptr)shm; const lds_cptr kp0 = shm3 + LDS_K + hi * 1024 + r32 * 16; const lds_cptr vp0 = shm3 + LDS_V + ((lane >> 4) & 1) * 32 + (lane & 3) * 8 + (4 * hi + ((lane & 15) >> 2)) * 64;
    const int NT = (q0 + QB) / KVBLK;
#define WAIT_KV() do { if (k2) WAIT_BAR(3); else WAIT_BAR(2); } while (0)
#define WAIT_KKV() do { if (k2) WAIT_BAR(5); else WAIT_BAR(3); } while (0)
    DMA_K(0, 0); DMA_V(0, 0); DMA_K(1, KSLOTB);
    bf16x8 qr[6];
#pragma unroll
    for (int d0 = 0; d0 < 6; ++d0) qr[d0] = *reinterpret_cast<const bf16x8*>(&Qw[(long)r32 * PQ + d0 * 16 + hi * 8]);
    float mhat = 0.f, l_reg = 0.f; f32x16 o[2]; o[0] = f32x16{}; o[1] = f32x16{}; f32x16 negm = f32x16{}; asm volatile("" : "+v"(negm));
    const int qrel = wid * QBLK + r32;
#define CMASK(P0, P1, t) do { int jb_ = (t) - (NT - 4); if (jb_ >= 0) cmask(P0, P1, jb_, qrel, hi); } while (0)
    bool resc = false;
#define START(P0, P1) do { const float rm = rowmax(P0, P1); resc = false; \
    { const float dl = rm; mhat = fadd_s(mhat, dl); \
      _Pragma("unroll") for (int r = 0; r < 16; ++r) { P0[r] = fsub_s(P0[r], dl); P1[r] = fsub_s(P1[r], dl); } \
      _Pragma("unroll") for (int r = 0; r < 16; ++r) negm[r] = -mhat; asm volatile("" : "+v"(negm)); } \
    _Pragma("unroll") for (int r = 0; r < 16; ++r) P0[r] = __builtin_amdgcn_exp2f(P0[r]); } while (0)
#define RESC() do { if (resc) { asm volatile("s_waitcnt lgkmcnt(0)" ::: "memory"); \
      _Pragma("unroll") for (int d_ = 0; d_ < 2; ++d_) _Pragma("unroll") for (int r = 0; r < 16; ++r) o[d_][r] *= wsf[crow(r, hi)]; } } while (0)
    f32x16 pA0, pA1, pB0, pB1;
    int sl_prev = 0, sl_cur = 0, sl_next = 1;
#define ROT() do { sl_prev = sl_cur; sl_cur = sl_next; sl_next = (sl_next == NSLOT - 1) ? 0 : sl_next + 1; } while (0)
    DMA_K(2, 2 * KSLOTB);
    WAIT_KKV();
    qkt(pA0, pA1, Kbase, qr, negm, r32, hi); asm volatile("s_nop 15\n\ts_nop 7" : "+v"(pA0), "+v"(pA1)); CMASK(pA0, pA1, 0);
    START(pA0, pA1);
#pragma unroll
    for (int r = 0; r < 16; ++r) pA1[r] = __builtin_amdgcn_exp2f(pA1[r]);
    WAIT_BAR(0);
    DMA_K(3, 0); DMA_V(1, VSLOTB);
    ROT();
    kload12(kf, kp0 + sl_cur * KSLOTB);
    WAIT_KV();
    s16x4 vlo[8], vhi[8]; u32x4 pw0, pw1, pw2, pw3;
#define PKW(P, B) cvtpk_s(P[B], P[B + 1])
#define PAF(k) __builtin_bit_cast(bf16x8, pw##k)
#define VFR(i) (bf16x8){vlo[i][0], vlo[i][1], vlo[i][2], vlo[i][3], vhi[i][0], vhi[i][1], vhi[i][2], vhi[i][3]}
#define PIN(x) asm volatile("" : "+v"(x))
#define MX3(a, b, c) __builtin_fmaxf(__builtin_fmaxf((a), (b)), (c))
#define GAPA(MF, A0, A1, A2, A3, W0, W1, PW) do { MF; sacc += A0; sacc += A1; sacc += A2; sacc += A3; PIN(sacc); W0; W1; PIN(PW); SBAR(); } while (0)
#define GAPM(MF) do { MF; SBAR(); } while (0)
#define EX(v) __builtin_amdgcn_exp2f(v)
#define GAPB(MF, X, B) do { MF; X[B] = EX(X[B]); X[B + 1] = EX(X[B + 1]); X[B + 2] = EX(X[B + 2]); X[B + 3] = EX(X[B + 3]); PIN(X); SBAR(); } while (0)
#define VRD(i) do { vlo[i] = vtr(vp_ + (((i) >> 2) * 4096 + ((i) & 3) * 1024)); vhi[i] = vtr(vp_ + (((i) >> 2) * 4096 + ((i) & 3) * 1024 + 512)); } while (0)
#define KRD(G, j) do { if (G) { kload2(kf, kp0 + sl_next * KSLOTB, j); SBAR(); } } while (0)
#define MF32(a, b, c) __builtin_amdgcn_mfma_f32_32x32x16_bf16(a, b, c, 0, 0, 0)
#define STEP(C0, C1, P0, P1, t, GK, GV, GL) do { SBAR(); \
    const lds_cptr vp_ = vp0 + sl_prev * VSLOTB; \
    float sacc = (P0[0] + P0[1]); \
    GAPA(C0 = MF32(kf[0], qr[0], negm), P0[2], P0[3], P0[4], P0[5],     pw0[0] = PKW(P0, 0), pw0[1] = PKW(P0, 2), pw0); \
    GAPA(C1 = MF32(kf[1], qr[0], negm), P0[6], P0[7], P0[8], P0[9],     pw0[2] = PKW(P0, 4), pw0[3] = PKW(P0, 6), pw0); \
    GAPA(C0 = MF32(kf[2], qr[1], C0),   P0[10], P0[11], P0[12], P0[13], pw1[0] = PKW(P0, 8), pw1[1] = PKW(P0, 10), pw1); \
    GAPA(C1 = MF32(kf[3], qr[1], C1),   P0[14], P0[15], P1[0], P1[1],   pw1[2] = PKW(P0, 12), pw1[3] = PKW(P0, 14), pw1); \
    VRD(0); SBAR(); GAPA(C0 = MF32(kf[4], qr[2], C0),   P1[2], P1[3], P1[4], P1[5],     pw2[0] = PKW(P1, 0), pw2[1] = PKW(P1, 2), pw2); \
    VRD(4); SBAR(); GAPA(C1 = MF32(kf[5], qr[2], C1),   P1[6], P1[7], P1[8], P1[9],     pw2[2] = PKW(P1, 4), pw2[3] = PKW(P1, 6), pw2); \
    VRD(1); SBAR(); GAPA(C0 = MF32(kf[6], qr[3], C0),   P1[10], P1[11], P1[12], P1[13], pw3[0] = PKW(P1, 8), pw3[1] = PKW(P1, 10), pw3); \
    VRD(5); SBAR(); GAPA(C1 = MF32(kf[7], qr[3], C1),   P1[14], P1[15], 0.f, 0.f,       pw3[2] = PKW(P1, 12), pw3[3] = PKW(P1, 14), pw3); \
    VRD(2); SBAR(); GAPM(C0 = MF32(kf[8], qr[4], C0)); VRD(6); SBAR(); GAPM(C1 = MF32(kf[9], qr[4], C1)); \
    VRD(3); SBAR(); GAPM(C0 = MF32(kf[10], qr[5], C0)); VRD(7); SBAR(); GAPM(C1 = MF32(kf[11], qr[5], C1)); \
    l_reg += sacc; \
    if (GK) { DMA_K((t) + 3, sl_cur * KSLOTB); } if (GV) { DMA_V((t) + 1, sl_next * VSLOTB); } \
    CMASK(C0, C1, t); \
    { float a = MX3(C0[0], C0[1], C1[0]), b = MX3(C0[2], C0[3], C1[1]); a = MX3(a, C1[2], C1[3]); \
      _Pragma("unroll") for (int r = 4; r < 16; r += 4) { a = MX3(a, C0[r], C0[r + 1]); b = MX3(b, C0[r + 2], C0[r + 3]); a = MX3(a, C1[r], C1[r + 1]); b = MX3(b, C1[r + 2], C1[r + 3]); } \
      float rm = __builtin_fmaxf(a, b); { auto rr = __builtin_amdgcn_permlane32_swap(__float_as_uint(rm), __float_as_uint(rm), false, false); rm = __builtin_fmaxf(__uint_as_float(rr[0]), __uint_as_float(rr[1])); } \
      resc = false; \
      if (__builtin_expect(__any(rm > (float)THRL), 0)) { const float dl = __builtin_fmaxf(rm, 0.f); mhat += dl; \
        _Pragma("unroll") for (int r = 0; r < 16; ++r) { C0[r] -= dl; C1[r] -= dl; } \
        _Pragma("unroll") for (int r = 0; r < 16; ++r) negm[r] = -mhat; asm volatile("" : "+v"(negm)); \
        const float f = __builtin_amdgcn_exp2f(-dl); l_reg *= f; if (hi == 0) wsf[r32] = f; resc = true; } } \
    SBAR(); \
    GAPB(o[0] = MF32(PAF(0), VFR(0), o[0]), C0, 0); \
    KRD(GL, 0); GAPB(o[1] = MF32(PAF(0), VFR(4), o[1]), C0, 4); \
    KRD(GL, 1); GAPB(o[0] = MF32(PAF(1), VFR(1), o[0]), C0, 8); \
    KRD(GL, 2); GAPB(o[1] = MF32(PAF(1), VFR(5), o[1]), C0, 12); \
    KRD(GL, 3); GAPB(o[0] = MF32(PAF(2), VFR(2), o[0]), C1, 0); \
    KRD(GL, 4); GAPB(o[1] = MF32(PAF(2), VFR(6), o[1]), C1, 4); \
    KRD(GL, 5); GAPB(o[0] = MF32(PAF(3), VFR(3), o[0]), C1, 8); \
    GAPB(o[1] = MF32(PAF(3), VFR(7), o[1]), C1, 12); \
    } while (0)
    int t = 1;
#undef CMASK
#define CMASK(P0, P1, t) do { } while (0)
    for (; t + 5 < NT; t += 2) {
        STEP(pB0, pB1, pA0, pA1, t, true, true, true);     WAIT_KV(); RESC(); ROT();
        STEP(pA0, pA1, pB0, pB1, t + 1, true, true, true); WAIT_KV(); RESC(); ROT();
    }
#undef CMASK
#define CMASK(P0, P1, t) do { int jb_ = (t) - (NT - 4); if (jb_ >= 0) cmask(P0, P1, jb_, qrel, hi); } while (0)
#define ENDW(tt) do { if ((tt) + 3 < NT) { WAIT_KV(); } else if ((tt) + 2 < NT) { WAIT_BAR(1); } else { WAIT_BAR(0); } } while (0)
    for (; t + 1 < NT; t += 2) {
        STEP(pB0, pB1, pA0, pA1, t, (t + 3 < NT), (t + 1 < NT), (t + 1 < NT));         ENDW(t);     RESC(); ROT();
        STEP(pA0, pA1, pB0, pB1, t + 1, (t + 4 < NT), (t + 2 < NT), (t + 2 < NT));     ENDW(t + 1); RESC(); ROT();
    }
    STEP(pB0, pB1, pA0, pA1, NT - 1, false, false, false); RESC();
    { float sacc = pB0[0] + pB0[1];
#pragma unroll
      for (int r = 2; r < 16; ++r) sacc += pB0[r];
#pragma unroll
      for (int r = 0; r < 16; ++r) sacc += pB1[r];
      l_reg += sacc;
      pw0 = (u32x4){PKW(pB0, 0), PKW(pB0, 2), PKW(pB0, 4), PKW(pB0, 6)}; pw1 = (u32x4){PKW(pB0, 8), PKW(pB0, 10), PKW(pB0, 12), PKW(pB0, 14)}; pw2 = (u32x4){PKW(pB1, 0), PKW(pB1, 2), PKW(pB1, 4), PKW(pB1, 6)}; pw3 = (u32x4){PKW(pB1, 8), PKW(pB1, 10), PKW(pB1, 12), PKW(pB1, 14)};
      SBAR(); pv(o, vb0 + sl_cur * VSLOTB, PAF(0), PAF(1), PAF(2), PAF(3)); }
#undef PKW
#undef PAF
#undef VFR
#undef PIN
#undef MX3
#undef GAPA
#undef GAPM
#undef GAPB
#undef EX
#undef VRD
#undef KRD
#undef MF32
#undef STEP
#undef ENDW
    { auto rr = __builtin_amdgcn_permlane32_swap(__float_as_uint(l_reg), __float_as_uint(l_reg), false, false); l_reg = __uint_as_float(rr[0]) + __uint_as_float(rr[1]); }
    if (hi == 0) wsf[32 + r32] = l_reg; asm volatile("s_waitcnt lgkmcnt(0)" ::: "memory");
    float rli[16];
#pragma unroll
    for (int r = 0; r < 16; ++r) rli[r] = __builtin_amdgcn_rcpf(wsf[32 + crow(r, hi)]);
    unsigned char* Ow = O + (rowbase + q0 + wid * QBLK) * PV + h * HV;
    { unsigned char* stg = (unsigned char*)(shm + LDS_OST) + wid * 2048;
#pragma unroll
      for (int r = 0; r < 16; ++r) { const int orow = crow(r, hi); const float sc = rli[r] * OSCALE;
        const float a = __builtin_fminf(__builtin_fmaxf(o[0][r] * sc, -448.f), 448.f), c = __builtin_fminf(__builtin_fmaxf(o[1][r] * sc, -448.f), 448.f);
        const unsigned w = (unsigned)__builtin_amdgcn_cvt_pk_fp8_f32(a, c, 0, false);
        stg[orow * 64 + r32] = (unsigned char)(w & 0xffu); stg[orow * 64 + 32 + r32] = (unsigned char)((w >> 8) & 0xffu); }
      asm volatile("s_waitcnt lgkmcnt(0)" ::: "memory");
#pragma unroll
      for (int i = 0; i < 2; ++i) { const int row = i * 16 + (lane >> 2), ch = lane & 3; const u32x4 v = *(const u32x4*)(stg + row * 64 + ch * 16); *(u32x4*)(Ow + (long)row * PV + ch * 16) = v; } }
    asm volatile("s_waitcnt lgkmcnt(0)\n\ts_barrier" ::: "memory");
#undef DMA_K
#undef DMA_V
#undef CMASK
#undef START
#undef RESC
#undef ROT
#undef WAIT_KV
#undef WAIT_KKV
}
#undef SBAR
#undef WAIT_BAR
}
namespace dila {
using bf16 = unsigned short;
using bf16x8 = __attribute__((ext_vector_type(8))) short;
using f32x16 = __attribute__((ext_vector_type(16))) float;
using u32x4 = __attribute__((ext_vector_type(4))) unsigned;
constexpr int NW = 8, SEQL = 8192, PQ = 1536, PKV = 3072, PO = 512, MROWS = 4 * SEQL;
constexpr int L_K = 0, L_V = 6 * 8192, L_WQ = 12 * 8192, L_WO = L_WQ + NW * 4096, L_WSF = L_WO + NW * 2048, L_BIAS = L_WSF + NW * 256, L_END = L_BIAS + 3 * 288 * 4;
constexpr float THR = 8.0f;
#define DIL_WAIT_BAR(N) asm volatile("s_waitcnt vmcnt(" #N ") lgkmcnt(0)\n\ts_barrier" ::: "memory")
struct UnitP { int sb, oo, lo, rowbase, dil, q0, g; };
__device__ __forceinline__ UnitP decode(int j, int h) {
    const int x = j & 31, bg = j >> 5; const int g = bg % 3, b = bg / 3;
    const int sh = 2 * g, dil = 1 << sh; const int r = x & (dil - 1), qb = x >> sh;
    UnitP p; p.sb = g * 262144 + ((b * dil + r) * 8 + h) * (SEQL >> sh); p.oo = g * MROWS * PO + h * 64; p.lo = g * MROWS * 8 + h;
    p.rowbase = b * SEQL + r; p.dil = dil; p.q0 = qb * 256; p.g = g; return p;
}

__device__ __forceinline__ void dil_phase(const bf16* QB, const bf16* KV, bf16* OG, float* LSE, const float* BT, char* shm, int G) {
    int tid_ = threadIdx.x; asm volatile("" : "+v"(tid_));
    const int tid = tid_, lane = tid & 63, r32 = lane & 31, hi = lane >> 5; const int wid = __builtin_amdgcn_readfirstlane(tid >> 6);
    const unsigned lds0 = (unsigned)(uintptr_t)shm;
    float* wsf = (float*)(shm + L_WSF) + wid * 64;
    char* wq = shm + L_WQ + wid * 4096;
    char* wo = shm + L_WO + wid * 2048;
    const int wt0 = wid >> 1, wt1 = 2 + (wid >> 1);
    const int G8 = G & ~7, c = (int)blockIdx.x;
    if (c >= G8) return;
    const int h = c & 7, j0 = c >> 3, jstep = G8 >> 3;
    const int NU = (384 - j0 + jstep - 1) / jstep;
    for (int i = tid; i < 3 * 288; i += NW * 64) ((float*)(shm + L_BIAS))[i] = BT[((i / 288) * 8 + h) * 288 + (i % 288)];
#define DIL_GROW(P, pos) ((long)((P).rowbase + (pos) * (P).dil))
#define DIL_ISSUE_TILE(P, t) do { int kp_ = (P).q0 - 128 + 64 * (t); if (kp_ < 0) kp_ = 0; \
        att::glds16(KV + (size_t)((P).sb + kp_ + lane) * 128 + wid * 8, (unsigned)__builtin_amdgcn_readfirstlane(lds0 + L_K + (t) * 8192 + wid * 1024)); \
        att::glds16(KV + (size_t)((P).sb + kp_ + 16 * (wid & 3) + (lane >> 2)) * 128 + 64 + (wid >> 2) * 32 + (lane & 3) * 8, (unsigned)__builtin_amdgcn_readfirstlane(lds0 + L_V + (t) * 8192 + wid * 1024)); } while (0)
#define DIL_ISSUE_Q(P) do { _Pragma("unroll") for (int j_ = 0; j_ < 4; ++j_) \
        att::glds16(QB + (size_t)((P).sb + (P).q0 + wid * 32 + 8 * j_ + (lane >> 3)) * 64 + (lane & 7) * 8, (unsigned)__builtin_amdgcn_readfirstlane(lds0 + L_WQ + wid * 4096 + j_ * 1024)); } while (0)
    if (NU <= 0) return;
    UnitP cur = decode(j0, h), nxt = cur;
    asm volatile("s_waitcnt vmcnt(0) lgkmcnt(0)\n\ts_barrier" ::: "memory");
    DIL_ISSUE_Q(cur); DIL_ISSUE_TILE(cur, 0); DIL_ISSUE_TILE(cur, 5); DIL_ISSUE_TILE(cur, 1); DIL_ISSUE_TILE(cur, 4);
    bf16x8 qr[4]; float mhat = 0.f, l_reg = 0.f; f32x16 o[2]; o[0] = f32x16{}; o[1] = f32x16{}; f32x16 negm = f32x16{}; bool first = true;
    const int vbl = (int)(lds0 + L_V) + ((lane >> 4) & 1) * 32 + (lane & 3) * 8 + (4 * hi + ((lane & 15) >> 2)) * 64;
    for (int ui = 0; ui < NU; ++ui) {
        const bool has_next = ui + 1 < NU;
        if (has_next) nxt = decode(j0 + (ui + 1) * jstep, h);
        const int tb = cur.q0 == 0 ? 2 : 0;
        const float* bl0 = (const float*)(shm + L_BIAS) + cur.g * 288 + (191 - (128 + 32 * (wid & 1) + r32 - 4 * hi));
#pragma unroll 1
        for (int k = 0; k < 3; ++k) {
            if (k < 2) DIL_WAIT_BAR(0); else DIL_WAIT_BAR(8);
            if (k == 0) { DIL_ISSUE_TILE(cur, 2); DIL_ISSUE_TILE(cur, 3); }
            else if (has_next) { if (k == 1) { DIL_ISSUE_Q(nxt); DIL_ISSUE_TILE(nxt, 0); DIL_ISSUE_TILE(nxt, 5); } else { DIL_ISSUE_TILE(nxt, 1); DIL_ISSUE_TILE(nxt, 4); } }
            const int t = wid < 4 ? wt0 + k : wt1 - k;
            if (k == 0) {
#pragma unroll
                for (int d0 = 0; d0 < 4; ++d0) qr[d0] = *reinterpret_cast<const bf16x8*>(wq + r32 * 128 + d0 * 32 + hi * 16);
                mhat = 0.f; l_reg = 0.f; o[0] = f32x16{}; o[1] = f32x16{}; negm = f32x16{}; first = true;
            }
            if (t >= tb) {
                f32x16 p0, p1;
                { const char* kb = shm + L_K + t * 8192 + hi * 1024 + r32 * 16;
#pragma unroll
                  for (int d0 = 0; d0 < 4; ++d0) {
                    const bf16x8 b0 = *reinterpret_cast<const bf16x8*>(kb + d0 * 2048);
                    const bf16x8 b1 = *reinterpret_cast<const bf16x8*>(kb + d0 * 2048 + 512);
                    if (d0 == 0) { p0 = __builtin_amdgcn_mfma_f32_32x32x16_bf16(b0, qr[0], negm, 0, 0, 0); p1 = __builtin_amdgcn_mfma_f32_32x32x16_bf16(b1, qr[0], negm, 0, 0, 0); }
                    else { p0 = __builtin_amdgcn_mfma_f32_32x32x16_bf16(b0, qr[d0], p0, 0, 0, 0); p1 = __builtin_amdgcn_mfma_f32_32x32x16_bf16(b1, qr[d0], p1, 0, 0, 0); } } }
                { const float* bl = bl0 + 64 * (t - wt0);
                  float bv0[16], bv1[16];
#pragma unroll
                  for (int r = 0; r < 16; ++r) { bv0[r] = bl[(r & 3) + 8 * (r >> 2)]; bv1[r] = bl[(r & 3) + 8 * (r >> 2) + 32]; }
#pragma unroll
                  for (int r = 0; r < 16; ++r) { p0[r] += bv0[r]; p1[r] += bv1[r]; } }
                const float rm = att::rowmax32(p0, p1);
                if (first) { first = false; const float dl = rm; mhat += dl;
#pragma unroll
                    for (int r = 0; r < 16; ++r) { p0[r] -= dl; p1[r] -= dl; }
#pragma unroll
                    for (int r = 0; r < 16; ++r) negm[r] = -mhat;
                } else if (__any(rm > THR)) { const float dl = __builtin_fmaxf(rm, 0.f); mhat += dl;
#pragma unroll
                    for (int r = 0; r < 16; ++r) { p0[r] -= dl; p1[r] -= dl; }
#pragma unroll
                    for (int r = 0; r < 16; ++r) negm[r] = -mhat;
                    const float f = __builtin_amdgcn_exp2f(-dl); l_reg *= f; if (hi == 0) wsf[r32] = f;
                    asm volatile("s_waitcnt lgkmcnt(0)" ::: "memory");
#pragma unroll
                    for (int d_ = 0; d_ < 2; ++d_)
#pragma unroll
                        for (int r = 0; r < 16; ++r) o[d_][r] *= wsf[att::crow(r, hi)];
                    asm volatile("s_waitcnt lgkmcnt(0)" ::: "memory");
                }
                float sacc = 0.f;
#pragma unroll
                for (int r = 0; r < 16; ++r) { p0[r] = __builtin_amdgcn_exp2f(p0[r]); p1[r] = __builtin_amdgcn_exp2f(p1[r]); sacc += p0[r] + p1[r]; }
                l_reg += sacc;
                u32x4 pw0, pw1, pw2, pw3;
#define DIL_PKW(P, B) att::cvtpk_s(P[B], P[B + 1])
                pw0 = (u32x4){DIL_PKW(p0, 0), DIL_PKW(p0, 2), DIL_PKW(p0, 4), DIL_PKW(p0, 6)}; pw1 = (u32x4){DIL_PKW(p0, 8), DIL_PKW(p0, 10), DIL_PKW(p0, 12), DIL_PKW(p0, 14)};
                pw2 = (u32x4){DIL_PKW(p1, 0), DIL_PKW(p1, 2), DIL_PKW(p1, 4), DIL_PKW(p1, 6)}; pw3 = (u32x4){DIL_PKW(p1, 8), DIL_PKW(p1, 10), DIL_PKW(p1, 12), DIL_PKW(p1, 14)};
#undef DIL_PKW
                __builtin_amdgcn_sched_barrier(0);
                att::pv(o, vbl + t * 8192, __builtin_bit_cast(bf16x8, pw0), __builtin_bit_cast(bf16x8, pw1), __builtin_bit_cast(bf16x8, pw2), __builtin_bit_cast(bf16x8, pw3));
            }
            if (k == 2) {
                { auto rr = __builtin_amdgcn_permlane32_swap(__float_as_uint(l_reg), __float_as_uint(l_reg), false, false); l_reg = __uint_as_float(rr[0]) + __uint_as_float(rr[1]); }
                if (hi == 0) wsf[32 + r32] = l_reg;
                asm volatile("s_waitcnt lgkmcnt(0)" ::: "memory");
                float rli[16];
#pragma unroll
                for (int r = 0; r < 16; ++r) rli[r] = __builtin_amdgcn_rcpf(wsf[32 + att::crow(r, hi)]);
                if (hi == 0) LSE[cur.lo + DIL_GROW(cur, cur.q0 + wid * 32 + r32) * 8] = mhat + __builtin_amdgcn_logf(l_reg);
                bf16* stg = (bf16*)wo;
#pragma unroll
                for (int d0 = 0; d0 < 2; ++d0) {
#pragma unroll
                    for (int r = 0; r < 16; ++r) stg[att::crow(r, hi) * 32 + r32] = (bf16)(att::cvtpk_s(o[d0][r] * rli[r], 0.f) & 0xffffu);
                    asm volatile("s_waitcnt lgkmcnt(0)" ::: "memory");
#pragma unroll
                    for (int i = 0; i < 2; ++i) { const int row = i * 16 + (lane >> 2), ch = lane & 3; const u32x4 v = *(const u32x4*)(stg + row * 32 + ch * 8);
                        *(u32x4*)(OG + cur.oo + DIL_GROW(cur, cur.q0 + wid * 32 + row) * PO + d0 * 32 + ch * 8) = v; }
                    asm volatile("s_waitcnt lgkmcnt(0)" ::: "memory"); }
            }
        }
        cur = nxt;
    }
    asm volatile("s_waitcnt vmcnt(0) lgkmcnt(0)\n\ts_barrier" ::: "memory");
#undef DIL_GROW
#undef DIL_ISSUE_TILE
#undef DIL_ISSUE_Q
}
#undef DIL_WAIT_BAR
}
constexpr int NWAVES = 8;
constexpr int BATCH = 4, SEQ = 8192, D = 1024, M = BATCH * SEQ;
constexpr int MLA_H = 16, QRANK = 384, KVRANK = 256, LATN = 672, LATP = 768, QUP = 1536, KVUP = 2048;
constexpr int DFF = 2816, NEXP = 8, DILQ = 1536, DILKV = 3072, DILOUT = 512;
constexpr int MAXSLOT = 67584;
constexpr float EPS = 1e-6f;
constexpr float C2_MLA = 0.1472444460259031f;
constexpr float C2_DIL = 0.18033688011112042f;
constexpr float LOG2E_F = 1.4426950408889634f;

constexpr size_t MiB = 1u << 20;
constexpr size_t WS_CTL = 0, CTL_ZERO_BYTES = 768 * 1024;
constexpr size_t WS_CM = 256 * 1024;
constexpr int CM_LAT = 0, CM_FGU = 672, CM_KVB = CM_FGU + 5632, CM_QB = CM_KVB + 3072, CM_EGU = CM_QB + 1536, CM_FDN = CM_EGU + 8 * 5632, CM_EDN = CM_FDN + 1024, CM_OUT = CM_EDN + 8 * 1024, CM_OB = CM_OUT + 1024, CM_END = CM_OB + 1024;
static_assert(WS_CM + (size_t)CM_END * 4 <= 768 * 1024, "column maxima inside the zeroed region");
constexpr size_t WS_MODV = 1 * MiB;
constexpr size_t WS_BIAS = 1 * MiB + 256 * 1024;
constexpr size_t WS_ROUTE = 1 * MiB + 512 * 1024;
constexpr size_t WS_CNT = 2 * MiB;
constexpr size_t WS_LIST = 2 * MiB + 256 * 1024;
constexpr size_t WS_SLOTG = 2 * MiB + 768 * 1024;
constexpr size_t WS_TOKSLOT = 3 * MiB + 256 * 1024;
constexpr size_t WS_TILEEXP = 3 * MiB + 512 * 1024;
constexpr size_t WS_SLOTXS = 3 * MiB + 516 * 1024;
constexpr size_t WS_CS = 4 * MiB;
constexpr size_t WS_LSE = 8 * MiB;
constexpr size_t WS_SB = 11 * MiB;
constexpr size_t SB_LAT = 0, SB_FGU = 768, SB_KVB = 768 + 5632, SB_QB = SB_KVB + 3072, SB_EGU = SB_QB + 1536, SB_FDN = SB_EGU + 8 * 5632, SB_EDN = SB_FDN + 1024, SB_OUT = SB_EDN + 8 * 1024, SB_OB = SB_OUT + 1024, SB_END = SB_OB + 1024;
constexpr size_t WS_XS = 11 * MiB + 512 * 1024, WS_XSKV = 11 * MiB + 768 * 1024;
constexpr size_t WS_WEGU = 12 * MiB, WS_WEDN = 100 * MiB, WS_WFGU = 144 * MiB, WS_WFDN = 155 * MiB, WS_WKVB = 161 * MiB, WS_WQB = 167 * MiB, WS_WOUT = 170 * MiB,
                 WS_WOB = 172 * MiB, WS_WMLAIN = 173 * MiB, WS_WQUP = 175 * MiB, WS_WKVUP = 177 * MiB;
constexpr size_t WS_ARENA = 180 * MiB;
constexpr size_t A_XN = WS_ARENA, A_LAT = WS_ARENA + 64 * MiB, A_QN = WS_ARENA + 112 * MiB, A_KVN = WS_ARENA + 136 * MiB, A_Q = WS_ARENA + 152 * MiB, A_K = WS_ARENA + 248 * MiB,
                 A_V = WS_ARENA + 344 * MiB, A_O = WS_ARENA + 408 * MiB, A_HID = WS_ARENA + 64 * MiB, A_XNKV = WS_ARENA + 64 * MiB, A_KVB = WS_ARENA + 128 * MiB, A_QB = WS_ARENA + 320 * MiB,
                 A_OG = WS_ARENA, A_OD = WS_ARENA + 128 * MiB, A_HIDS = WS_ARENA + 160 * MiB, A_Y = WS_ARENA;
constexpr size_t WS_END = WS_ARENA + 523 * MiB;
static_assert(A_HIDS + (size_t)MAXSLOT * DFF * 2 <= WS_END && A_Y + (size_t)MAXSLOT * D * 2 <= A_HIDS && A_O + (size_t)M * D * 2 <= WS_END, "arena map");
static_assert(WS_WEGU + (size_t)NEXP * 2 * DFF * D * 2 <= WS_WEDN && WS_WEDN + (size_t)NEXP * D * DFF * 2 <= WS_WFGU && WS_WFGU + (size_t)2 * DFF * D * 2 <= WS_WFDN && WS_WFDN + (size_t)D * DFF * 2 <= WS_WKVB, "weight map");
enum ModKind { MK_A_MIX0 = 0, MK_B_MIX0, MK_G_MIX0, MK_A_FFN0, MK_B_FFN0, MK_G_FFN0, MK_A_MIX1, MK_B_MIX1, MK_G_MIX1, MK_A_FFN1, MK_B_FFN1, MK_G_FFN1, MK_A_KV, MK_B_KV };
constexpr int CW_BAR = 4096;
constexpr int CW_RANK = 8192;

constexpr int RING_BYTES = 131072;
constexpr int LDS_BYTES = 163840;
constexpr int LDSCTL_OFF = LDS_BYTES - 1024, MISC_OFF = LDSCTL_OFF + 320;

#define GAS __attribute__((address_space(1)))
#define LAS __attribute__((address_space(3)))
typedef unsigned short bf16;
typedef signed char i8;
typedef unsigned v4u __attribute__((ext_vector_type(4)));
typedef unsigned v2u __attribute__((ext_vector_type(2)));
typedef float f32x4 __attribute__((ext_vector_type(4)));
typedef GAS unsigned gu32;
#define RLX_AGENT __ATOMIC_RELAXED, __HIP_MEMORY_SCOPE_AGENT
#define LDS_WAIT() asm volatile("s_waitcnt lgkmcnt(0)" ::: "memory")
#define VM_WAIT() asm volatile("s_waitcnt vmcnt(0)" ::: "memory")
__device__ __forceinline__ unsigned f2bf(float f) { unsigned u = __builtin_bit_cast(unsigned, f); return (u + 0x7fffu + ((u >> 16) & 1u)) >> 16; }
__device__ __forceinline__ unsigned pk2(float lo, float hi) { return f2bf(lo) | (f2bf(hi) << 16); }
__device__ __forceinline__ float bf_lo(unsigned w) { return __builtin_bit_cast(float, w << 16); }
__device__ __forceinline__ float bf_hi(unsigned w) { return __builtin_bit_cast(float, w & 0xffff0000u); }
__device__ __forceinline__ float wave_sum(float v) {
#pragma unroll
    for (int o = 1; o < 64; o <<= 1) v += __shfl_xor(v, o);
    return v;
}

#define XB_TMO      128
#define XB_XCNT(j)  (256  + 64 * (j))
#define XB_XSUB(j)  (1280 + 64 * (j))
#define XB_XGEN(j)  (2304 + 64 * (j))
#define XB_TOP      3328
#define XB_TOPGEN   3392
#define XCD_BAR_WORDS 3456
#define XB_SPIN_CAP (1u << 18)
__device__ __forceinline__ unsigned xb_ld(unsigned* p)              { return __hip_atomic_load(p, __ATOMIC_RELAXED, __HIP_MEMORY_SCOPE_AGENT); }
__device__ __forceinline__ unsigned xb_add(unsigned* p, unsigned v) { return __hip_atomic_fetch_add(p, v, __ATOMIC_RELAXED, __HIP_MEMORY_SCOPE_AGENT); }
__device__ __forceinline__ unsigned xb_xcc_id() { return (unsigned)__builtin_amdgcn_s_getreg((3 << 11) | 20) & 0xFu; }
#define XB_SPIN(cond, bar) do { unsigned _sp = 0; while (cond) { __builtin_amdgcn_s_sleep(1); \
    if ((++_sp & 255u) == 0u) { if (xb_ld(&(bar)[XB_TMO])) break; if (_sp > XB_SPIN_CAP) { atomicAdd(&(bar)[XB_TMO], 1u); break; } } } } while (0)
struct XcdBarrier { unsigned* bar; unsigned x; volatile LAS unsigned* st; };
__device__ __forceinline__ XcdBarrier xcd_barrier_post(unsigned* bar, volatile LAS unsigned* st) {
    XcdBarrier b; b.bar = bar; b.x = xb_xcc_id(); b.st = st;
    if (threadIdx.x == 0) (void)xb_add(&bar[XB_XCNT(b.x)], 1u);
    return b;
}
__device__ __forceinline__ void xcd_barrier_complete(unsigned* bar, unsigned x, unsigned& nloc, unsigned& nx) {
    const unsigned G = gridDim.x * gridDim.y * gridDim.z;
    unsigned sum, cnt, mine, sp = 0u;
    for (;;) {
        sum = 0u; cnt = 0u; mine = 0u;
#pragma unroll
        for (unsigned j = 0; j < 16; ++j) { const unsigned c = xb_ld(&bar[XB_XCNT(j)]); sum += c; cnt += (c > 0u) ? 1u : 0u; mine = (j == x) ? c : mine; }
        if (sum == G) break;
        __builtin_amdgcn_s_sleep(1);
        if ((++sp & 255u) == 0u) { if (xb_ld(&bar[XB_TMO])) break; if (sp > XB_SPIN_CAP) { atomicAdd(&bar[XB_TMO], 1u); break; } }
    }
    nloc = mine > 0u ? mine : 1u; nx = cnt > 0u ? cnt : 1u;
}
__device__ __forceinline__ void xcd_barrier(const XcdBarrier& b) {
    asm volatile("s_waitcnt vmcnt(0)" ::: "memory");
    __syncthreads();
    if (threadIdx.x == 0) {
        unsigned* bar = b.bar;
        __builtin_amdgcn_s_waitcnt(0);
        unsigned nloc = b.st[0], nx = b.st[1];
        if (nloc == 0u) { xcd_barrier_complete(bar, b.x, nloc, nx); b.st[0] = nloc; b.st[1] = nx; }
        const unsigned old = xb_add(&bar[XB_XSUB(b.x)], 1u);
        const unsigned gen = old / nloc;
        if (old + 1u == (gen + 1u) * nloc) {
            __builtin_amdgcn_fence(__ATOMIC_RELEASE, "agent");
            asm volatile("s_waitcnt vmcnt(0)" ::: "memory");
            const unsigned og = xb_add(&bar[XB_TOP], 1u);
            const unsigned tg = og / nx;
            if (og + 1u == (tg + 1u) * nx) xb_add(&bar[XB_TOPGEN], 1u);
            else XB_SPIN(xb_ld(&bar[XB_TOPGEN]) == tg, bar);
            __builtin_amdgcn_fence(__ATOMIC_ACQUIRE, "agent");
            xb_add(&bar[XB_XGEN(b.x)], 1u);
            asm volatile("s_waitcnt vmcnt(0)" ::: "memory");
        } else {
            XB_SPIN(xb_ld(&bar[XB_XGEN(b.x)]) == gen, bar);
            __builtin_amdgcn_fence(__ATOMIC_ACQUIRE, "agent");
            asm volatile("s_waitcnt vmcnt(0)" ::: "memory");
        }
    }
    __syncthreads();
}

struct Frame {
    LAS unsigned char* lds;
    volatile LAS unsigned* MISC;
    int tid, lane, wave;
    int vcu, G;
    unsigned char* ws;
    const float* in[26];
    float* out;
};
enum { MAP_PLAIN = 0, MAP_MLAIN = 1, MAP_QUP = 2, MAP_GU = 3 };
template <int MAP> __device__ __forceinline__ int dmap(int n) {
    if (MAP == MAP_MLAIN) { if (n < 640) return n; if (n < 656) return 640 + 2 * (n - 640); return 640 + 2 * (n - 656) + 1; }
    if (MAP == MAP_QUP) { const int h = n / 96, j = n % 96; if (j < 64) return n; if (j < 80) return h * 96 + 64 + 2 * (j - 64); return h * 96 + 64 + 2 * (j - 80) + 1; }
    if (MAP == MAP_GU) { const int up = n >= DFF ? 1 : 0; const int c = up ? n - DFF : n; return (c >> 7) * 256 + up * 128 + (c & 127); }
    return n;
}
template <int MAP> __device__ __forceinline__ void transpose_item(const float* W, int K, int N, bf16* WT, const float* ks, LAS float* scr, int item, int lane) {
    const int nblk = N / 32, kb = item / nblk, nb = item % nblk, k0 = 64 * kb, n0 = 32 * nb;
    float v[32];
    const float* src = W + (size_t)(k0 + (lane >> 5)) * N + n0 + (lane & 31);
#pragma unroll
    for (int i = 0; i < 32; ++i) v[i] = __builtin_nontemporal_load(src + (size_t)(2 * i) * N);
    if (ks) {
#pragma unroll
        for (int i = 0; i < 32; ++i) v[i] *= ks[k0 + 2 * i + (lane >> 5)]; }
#pragma unroll
    for (int i = 0; i < 32; ++i) scr[(2 * i + (lane >> 5)) * 33 + (lane & 31)] = v[i];
    LDS_WAIT(); asm volatile("" ::: "memory");
    const int c = lane & 7;
#pragma unroll
    for (int j = 0; j < 4; ++j) { const int n = (lane >> 3) + 8 * j; const LAS float* s = scr + (8 * c) * 33 + n;
        v4u o; o.x = pk2(s[0 * 33], s[1 * 33]); o.y = pk2(s[2 * 33], s[3 * 33]); o.z = pk2(s[4 * 33], s[5 * 33]); o.w = pk2(s[6 * 33], s[7 * 33]);
        *(GAS v4u*)(WT + (size_t)dmap<MAP>(n0 + n) * K + k0 + 8 * c) = o; }
    LDS_WAIT(); asm volatile("" ::: "memory");
}
__device__ __forceinline__ float wave_max(float v) {
#pragma unroll
    for (int o = 1; o < 64; o <<= 1) v = fmaxf(v, __shfl_xor(v, o));
    return v;
}
__device__ __forceinline__ float amax8(const f32x4& a, const f32x4& b) { return fmaxf(fmaxf(fmaxf(fabsf(a.x), fabsf(a.y)), fmaxf(fabsf(a.z), fabsf(a.w))), fmaxf(fmaxf(fabsf(b.x), fabsf(b.y)), fmaxf(fabsf(b.z), fabsf(b.w)))); }
__device__ __forceinline__ unsigned q4(const f32x4& a, float inv) { const int q0 = (int)__builtin_rintf(a.x * inv), q1 = (int)__builtin_rintf(a.y * inv), q2 = (int)__builtin_rintf(a.z * inv), q3 = (int)__builtin_rintf(a.w * inv);
    return ((unsigned)q0 & 0xffu) | (((unsigned)q1 & 0xffu) << 8) | (((unsigned)q2 & 0xffu) << 16) | (((unsigned)q3 & 0xffu) << 24); }
__device__ __forceinline__ void colmax_item(const float* W, int K, int N, unsigned* CM, int item, int lane) {
    const int nblk = (N + 63) / 64, kb = item / nblk, nb = item % nblk, n = 64 * nb + lane;
    if (n < N) { const float* src = W + (size_t)(64 * kb) * N + n; float mx = 0.f;
#pragma unroll 16
        for (int i = 0; i < 64; ++i) mx = fmaxf(mx, fabsf(__builtin_nontemporal_load(src + (size_t)i * N)));
        atomicMax(CM + n, __float_as_uint(mx)); }
}
template <int MAP, int FMT> __device__ __forceinline__ void conv_item(const float* W, int K, int N, unsigned char* WT, const unsigned* CM, float* SB, float post, LAS float* scr, int item, int lane) {
    const int nblk = N / 32, kb = item / nblk, nb = item % nblk, k0 = 64 * kb, n0 = 32 * nb;
    const float mx = __uint_as_float(CM[n0 + (lane & 31)]);
    const float inv = mx > 0.f ? (FMT == 1 ? 127.0f : 256.0f) / mx : 0.f;
    if (kb == 0 && lane < 32) SB[dmap<MAP>(n0 + lane)] = mx > 0.f ? (FMT == 1 ? mx * (1.0f / 127.0f) : mx * (1.0f / 256.0f) * post) : 1.0f;
    float v[32];
    const float* src = W + (size_t)(k0 + (lane >> 5)) * N + n0 + (lane & 31);
#pragma unroll
    for (int i = 0; i < 32; ++i) v[i] = src[(size_t)(2 * i) * N];
#pragma unroll
    for (int i = 0; i < 32; ++i) scr[(2 * i + (lane >> 5)) * 33 + (lane & 31)] = v[i] * inv;
    LDS_WAIT(); asm volatile("" ::: "memory");
    const int c = lane & 7;
#pragma unroll
    for (int j = 0; j < 4; ++j) { const int n = (lane >> 3) + 8 * j; const LAS float* s = scr + (8 * c) * 33 + n;
        const f32x4 lo = (f32x4){s[0 * 33], s[1 * 33], s[2 * 33], s[3 * 33]}, hi = (f32x4){s[4 * 33], s[5 * 33], s[6 * 33], s[7 * 33]};
        v2u o; if (FMT == 1) o = (v2u){q4(lo, 1.0f), q4(hi, 1.0f)}; else o = (v2u){pg8::pk4_fp8(lo.x, lo.y, lo.z, lo.w), pg8::pk4_fp8(hi.x, hi.y, hi.z, hi.w)};
        *(GAS v2u*)(WT + (size_t)dmap<MAP>(n0 + n) * K + k0 + 8 * c) = o; }
    LDS_WAIT(); asm volatile("" ::: "memory");
}
__device__ __constant__ double INVF_D[16] = {1.0, 0.5623413251903491, 0.31622776601683794, 0.1778279410038923, 0.09999999999999999, 0.056234132519034905, 0.03162277660168379, 0.01778279410038923,
    0.01, 0.005623413251903491, 0.0031622776601683794, 0.0017782794100389228, 0.001, 0.000562341325190349, 0.00031622776601683794, 0.0001778279410038923};
__device__ __constant__ int RPB_TH[15] = {22, 30, 40, 54, 73, 99, 134, 182, 246, 332, 450, 609, 825, 1117, 1513};

__device__ __forceinline__ void p0_prologue(Frame& F) {
    const int gw = F.vcu * NWAVES + F.wave, NGW = F.G * NWAVES;
    const int gtid = F.vcu * (NWAVES * 64) + F.tid, NGT = F.G * NWAVES * 64;
    float* MODV = (float*)(F.ws + WS_MODV);
    {
        LAS float* cact = (LAS float*)F.lds;
        LAS float* red = (LAS float*)(F.lds + 16384);
        const float* cin = F.in[1];
        for (int i = F.tid; i < 4096; i += NWAVES * 64) { const int b = i >> 10, k = i & 1023; const float x = cin[i]; cact[k * 4 + b] = x / (1.0f + expf(-x)); }
        __syncthreads();
        constexpr int NTASK = (6 * D * 2 + 2 * D) / 64;
        for (int task = F.vcu; task < NTASK; task += F.G) {
            const int gc = task * 64 + F.lane;
            const float* W; int ldw, cc; const float* bias;
            if (gc < 6 * D) { W = F.in[5]; ldw = 6 * D; cc = gc; bias = F.in[6]; }
            else if (gc < 12 * D) { W = F.in[5] + (size_t)D * 6 * D; ldw = 6 * D; cc = gc - 6 * D; bias = F.in[6] + 6 * D; }
            else { W = F.in[14]; ldw = 2 * D; cc = gc - 12 * D; bias = F.in[15]; }
            float a0 = 0.f, a1 = 0.f, a2 = 0.f, a3 = 0.f;
            const int kbeg = F.wave * 128;
#pragma unroll 16
            for (int k = 0; k < 128; ++k) { const float w = W[(size_t)(kbeg + k) * ldw + cc]; const f32x4 ca = *(const LAS f32x4*)(cact + (kbeg + k) * 4);
                a0 += w * ca[0]; a1 += w * ca[1]; a2 += w * ca[2]; a3 += w * ca[3]; }
            red[(F.wave * 4 + 0) * 64 + F.lane] = a0; red[(F.wave * 4 + 1) * 64 + F.lane] = a1; red[(F.wave * 4 + 2) * 64 + F.lane] = a2; red[(F.wave * 4 + 3) * 64 + F.lane] = a3;
            __syncthreads();
            if (F.wave < 4) { const int b = F.wave; float s = 0.f;
#pragma unroll
                for (int w = 0; w < 8; ++w) s += red[(w * 4 + b) * 64 + F.lane];
                s += bias[cc];
                int kind; float val = s; const int j = cc & 1023, ch = cc >> 10;
                if (gc < 12 * D) { const int Lr = gc < 6 * D ? 0 : 1;
                    if (ch == 0) kind = 6 * Lr + 1; else if (ch == 1) { kind = 6 * Lr + 0; val = F.in[3][Lr * D + j] * (1.0f + s); } else if (ch == 2) kind = 6 * Lr + 2;
                    else if (ch == 3) kind = 6 * Lr + 4; else if (ch == 4) { kind = 6 * Lr + 3; val = F.in[4][Lr * D + j] * (1.0f + s); } else kind = 6 * Lr + 5;
                } else { if (ch == 0) kind = MK_B_KV; else { kind = MK_A_KV; val = F.in[13][j] * (1.0f + s); } }
                MODV[((size_t)kind * 4 + b) * D + j] = val; }
            __syncthreads();
        }
        __syncthreads();
    }
    {
        unsigned* const CM = (unsigned*)(F.ws + WS_CM);
        constexpr int C_MLAIN = (D / 64) * ((LATN + 63) / 64), C_FGU = (D / 64) * (2 * DFF / 64), C_KVB = (D / 64) * (DILKV / 64), C_QB = (D / 64) * (DILQ / 64), C_FDN = (DFF / 64) * (D / 64);
        constexpr int C_OUT = (D / 64) * (D / 64), C_OB = (DILOUT / 64) * (D / 64);
        constexpr int NCM = C_MLAIN + C_FGU + C_KVB + C_QB + NEXP * C_FGU + C_FDN + NEXP * C_FDN + C_OUT + C_OB;
        for (int it = gw; it < NCM; it += NGW) { int r = it;
            if (r < C_MLAIN) { colmax_item(F.in[7], D, LATN, CM + CM_LAT, r, F.lane); continue; } r -= C_MLAIN;
            if (r < C_FGU) { colmax_item(F.in[20], D, 2 * DFF, CM + CM_FGU, r, F.lane); continue; } r -= C_FGU;
            if (r < C_KVB) { colmax_item(F.in[16], D, DILKV, CM + CM_KVB, r, F.lane); continue; } r -= C_KVB;
            if (r < C_QB) { colmax_item(F.in[18], D, DILQ, CM + CM_QB, r, F.lane); continue; } r -= C_QB;
            if (r < NEXP * C_FGU) { const int e = r / C_FGU; colmax_item(F.in[23] + (size_t)e * D * 2 * DFF, D, 2 * DFF, CM + CM_EGU + e * 2 * DFF, r % C_FGU, F.lane); continue; } r -= NEXP * C_FGU;
            if (r < C_FDN) { colmax_item(F.in[21], DFF, D, CM + CM_FDN, r, F.lane); continue; } r -= C_FDN;
            if (r < NEXP * C_FDN) { const int e = r / C_FDN; colmax_item(F.in[24] + (size_t)e * DFF * D, DFF, D, CM + CM_EDN + e * D, r % C_FDN, F.lane); continue; } r -= NEXP * C_FDN;
            if (r < C_OUT) { colmax_item(F.in[12], D, D, CM + CM_OUT, r, F.lane); continue; } r -= C_OUT;
            colmax_item(F.in[19], DILOUT, D, CM + CM_OB, r, F.lane); }
    }
    {
        v4u* padz = (v4u*)(F.ws + WS_WMLAIN + (size_t)LATN * D);
        for (int i = gtid; i < (LATP - LATN) * D / 16; i += NGT) padz[i] = (v4u){0u, 0u, 0u, 0u};
        for (int i = gtid; i < LATP - LATN; i += NGT) ((float*)(F.ws + WS_SB))[SB_LAT + LATN + i] = 1.0f;
        const int* pos = (const int*)F.in[2];
        float* cs = (float*)(F.ws + WS_CS);
        for (int i = gtid; i < M * 16; i += NGT) { const int row = i >> 4, k = i & 15;
            const double x = (double)pos[row] * INVF_D[k]; const double rev = x * 0.15915494309189535; const float fr = (float)(rev - __builtin_rint(rev));
            cs[(size_t)i * 2] = __builtin_amdgcn_cosf(fr); cs[(size_t)i * 2 + 1] = __builtin_amdgcn_sinf(fr); }
        const float* rpb = F.in[17];
        float* bt = (float*)(F.ws + WS_BIAS);
        for (int i = gtid; i < 24 * 288; i += NGT) { const int gh = i / 288, ii = i % 288, j = 191 - ii, g = gh >> 3; const int d = j * (g == 0 ? 1 : (g == 1 ? 4 : 16));
            float val = -INFINITY;
            if (j >= 0 && j <= 128) { int bk; if (d < 16) bk = d; else { bk = 16;
#pragma unroll
                for (int q = 0; q < 15; ++q) bk += (d >= RPB_TH[q]) ? 1 : 0; }
                val = rpb[bk * 24 + gh] * LOG2E_F; }
            bt[i] = val; }
    }
}

__device__ __forceinline__ void p1_convert(Frame& F) {
    const int gw = F.vcu * NWAVES + F.wave, NGW = F.G * NWAVES;
    LAS float* scr = (LAS float*)(F.lds + F.wave * 8704);
    const unsigned* const CM = (const unsigned*)(F.ws + WS_CM); float* const SB = (float*)(F.ws + WS_SB);
    constexpr int I_MLAIN = (D / 64) * (LATN / 32), I_FGU = (D / 64) * (2 * DFF / 32), I_KVB = (D / 64) * (DILKV / 32), I_QB = (D / 64) * (DILQ / 32), I_FDN = (DFF / 64) * (D / 32);
    constexpr int I_QUP = (QRANK / 64) * (QUP / 32), I_KVUP = (KVRANK / 64) * (KVUP / 32), I_OUT = (D / 64) * (D / 32), I_OB = (DILOUT / 64) * (D / 32);
    constexpr int NITEMS = I_MLAIN + I_FGU + I_KVB + I_QB + NEXP * I_FGU + I_FDN + NEXP * I_FDN + I_QUP + I_KVUP + I_OUT + I_OB;
    constexpr float POST = 1.0f / pg8::HSCALE;
    for (int it = gw; it < NITEMS; it += NGW) { int r = it;
        if (r < NEXP * I_FGU) { const int e = r / I_FGU; conv_item<MAP_GU, 1>(F.in[23] + (size_t)e * D * 2 * DFF, D, 2 * DFF, F.ws + WS_WEGU + (size_t)e * 2 * DFF * D, CM + CM_EGU + e * 2 * DFF, SB + SB_EGU + (size_t)e * 2 * DFF, 1.f, scr, r % I_FGU, F.lane); continue; } r -= NEXP * I_FGU;
        if (r < NEXP * I_FDN) { const int e = r / I_FDN; conv_item<MAP_PLAIN, 2>(F.in[24] + (size_t)e * DFF * D, DFF, D, F.ws + WS_WEDN + (size_t)e * D * DFF, CM + CM_EDN + e * D, SB + SB_EDN + (size_t)e * D, POST, scr, r % I_FDN, F.lane); continue; } r -= NEXP * I_FDN;
        if (r < I_FGU) { conv_item<MAP_GU, 1>(F.in[20], D, 2 * DFF, F.ws + WS_WFGU, CM + CM_FGU, SB + SB_FGU, 1.f, scr, r, F.lane); continue; } r -= I_FGU;
        if (r < I_FDN) { conv_item<MAP_PLAIN, 2>(F.in[21], DFF, D, F.ws + WS_WFDN, CM + CM_FDN, SB + SB_FDN, POST, scr, r, F.lane); continue; } r -= I_FDN;
        if (r < I_KVB) { conv_item<MAP_PLAIN, 1>(F.in[16], D, DILKV, F.ws + WS_WKVB, CM + CM_KVB, SB + SB_KVB, 1.f, scr, r, F.lane); continue; } r -= I_KVB;
        if (r < I_QB) { conv_item<MAP_PLAIN, 1>(F.in[18], D, DILQ, F.ws + WS_WQB, CM + CM_QB, SB + SB_QB, 1.f, scr, r, F.lane); continue; } r -= I_QB;
        if (r < I_MLAIN) { conv_item<MAP_MLAIN, 1>(F.in[7], D, LATN, F.ws + WS_WMLAIN, CM + CM_LAT, SB + SB_LAT, 1.f, scr, r, F.lane); continue; } r -= I_MLAIN;
        if (r < I_QUP) { transpose_item<MAP_QUP>(F.in[9], QRANK, QUP, (bf16*)(F.ws + WS_WQUP), F.in[8], scr, r, F.lane); continue; } r -= I_QUP;
        if (r < I_KVUP) { transpose_item<MAP_PLAIN>(F.in[11], KVRANK, KVUP, (bf16*)(F.ws + WS_WKVUP), F.in[10], scr, r, F.lane); continue; } r -= I_KVUP;
        if (r < I_OUT) { conv_item<MAP_PLAIN, 2>(F.in[12], D, D, F.ws + WS_WOUT, CM + CM_OUT, SB + SB_OUT, 1.0f / mla::OSCALE, scr, r, F.lane); continue; } r -= I_OUT;
        conv_item<MAP_PLAIN, 2>(F.in[19], DILOUT, D, F.ws + WS_WOB, CM + CM_OB, SB + SB_OB, 1.0f / mla::OSCALE, scr, r, F.lane);
    }
    __syncthreads();
}

constexpr int HPITCH = 2048;
__device__ __forceinline__ void ld8_f32(const float* p, f32x4& a, f32x4& b) { a = *(const f32x4*)p; b = *(const f32x4*)(p + 4); }
__device__ __forceinline__ void ld8_bf16(const bf16* p, f32x4& a, f32x4& b) { const v4u w = *(const GAS v4u*)p; a = (f32x4){bf_lo(w.x), bf_hi(w.x), bf_lo(w.y), bf_hi(w.y)}; b = (f32x4){bf_lo(w.z), bf_hi(w.z), bf_lo(w.w), bf_hi(w.w)}; }
__device__ __forceinline__ float ssq8(const f32x4& a, const f32x4& b) { return ((a.x * a.x + a.y * a.y) + (a.z * a.z + a.w * a.w)) + ((b.x * b.x + b.y * b.y) + (b.z * b.z + b.w * b.w)); }
__device__ __forceinline__ v4u pk8(const f32x4& a, const f32x4& b) { return (v4u){pk2(a.x, a.y), pk2(a.z, a.w), pk2(b.x, b.y), pk2(b.z, b.w)}; }
__device__ __forceinline__ void quant_row(const f32x4 (&y)[2][2], i8* orow, float* srow, int lane) {
    const float mx = wave_max(fmaxf(amax8(y[0][0], y[0][1]), amax8(y[1][0], y[1][1])));
    const float sc = mx > 0.f ? mx * (1.0f / 127.0f) : 1.0f, inv = mx > 0.f ? 127.0f / mx : 0.f;
#pragma unroll
    for (int j = 0; j < 2; ++j) *(GAS v2u*)(orow + 8 * lane + 512 * j) = (v2u){q4(y[j][0], inv), q4(y[j][1], inv)};
    if (lane == 0) *srow = sc;
}
template <bool DUAL, bool INF32>
__device__ __forceinline__ void norm_phase(Frame& F, const void* Hin, const float* A0, const float* B0, i8* O0, float* S0, const float* A1, const float* B1, i8* O1, float* S1) {
    const int gw = F.vcu * NWAVES + F.wave, NGW = F.G * NWAVES;
    for (int c = gw; c < M / 16; c += NGW) {
        const int row0 = c * 16, b = row0 / SEQ;
        f32x4 a0[2][2], b0[2][2], a1[2][2], b1[2][2];
#pragma unroll
        for (int j = 0; j < 2; ++j) { const int co = b * D + 8 * F.lane + 512 * j; ld8_f32(A0 + co, a0[j][0], a0[j][1]); ld8_f32(B0 + co, b0[j][0], b0[j][1]);
            if (DUAL) { ld8_f32(A1 + co, a1[j][0], a1[j][1]); ld8_f32(B1 + co, b1[j][0], b1[j][1]); } }
#pragma unroll 2
        for (int i = 0; i < 16; ++i) { const size_t row = (size_t)(row0 + i);
            f32x4 v[2][2]; float s = 0.f;
#pragma unroll
            for (int j = 0; j < 2; ++j) { if (INF32) ld8_f32((const float*)Hin + row * D + 8 * F.lane + 512 * j, v[j][0], v[j][1]); else ld8_bf16((const bf16*)Hin + row * HPITCH + 8 * F.lane + 512 * j, v[j][0], v[j][1]);
                s += ssq8(v[j][0], v[j][1]); }
            const float rstd = 1.0f / sqrtf(wave_sum(s) * (1.f / D) + EPS);
            f32x4 y[2][2];
#pragma unroll
            for (int j = 0; j < 2; ++j) { y[j][0] = v[j][0] * rstd * a0[j][0] + b0[j][0]; y[j][1] = v[j][1] * rstd * a0[j][1] + b0[j][1]; }
            quant_row(y, O0 + row * D, S0 + row, F.lane);
            if (DUAL) {
#pragma unroll
                for (int j = 0; j < 2; ++j) { y[j][0] = v[j][0] * rstd * a1[j][0] + b1[j][0]; y[j][1] = v[j][1] * rstd * a1[j][1] + b1[j][1]; }
                quant_row(y, O1 + row * D, S1 + row, F.lane); }
        }
    }
}

__device__ __forceinline__ void latnorm_phase(Frame& F) {
    const int gw = F.vcu * NWAVES + F.wave, NGW = F.G * NWAVES;
    const bf16* LAT = (const bf16*)(F.ws + A_LAT); bf16* QN = (bf16*)(F.ws + A_QN); bf16* KVN = (bf16*)(F.ws + A_KVN); bf16* KB = (bf16*)(F.ws + A_K);
    const float* cs = (const float*)(F.ws + WS_CS);
    for (int row = gw; row < M; row += NGW) {
        const unsigned* lr = (const unsigned*)(LAT + (size_t)row * LATP);
        unsigned q[3], kv[2];
#pragma unroll
        for (int j = 0; j < 3; ++j) q[j] = lr[F.lane + 64 * j];
#pragma unroll
        for (int j = 0; j < 2; ++j) kv[j] = lr[192 + F.lane + 64 * j];
        const unsigned kr = lr[320 + (F.lane & 15)];
        float sq = 0.f, sk = 0.f;
#pragma unroll
        for (int j = 0; j < 3; ++j) { const float a = bf_lo(q[j]), b = bf_hi(q[j]); sq += a * a + b * b; }
#pragma unroll
        for (int j = 0; j < 2; ++j) { const float a = bf_lo(kv[j]), b = bf_hi(kv[j]); sk += a * a + b * b; }
        const float rq = 1.0f / sqrtf(wave_sum(sq) * (1.f / QRANK) + EPS), rk = 1.0f / sqrtf(wave_sum(sk) * (1.f / KVRANK) + EPS);
        unsigned* qo = (unsigned*)(QN + (size_t)row * QRANK); unsigned* ko = (unsigned*)(KVN + (size_t)row * KVRANK);
#pragma unroll
        for (int j = 0; j < 3; ++j) qo[F.lane + 64 * j] = pk2(bf_lo(q[j]) * rq, bf_hi(q[j]) * rq);
#pragma unroll
        for (int j = 0; j < 2; ++j) ko[F.lane + 64 * j] = pk2(bf_lo(kv[j]) * rk, bf_hi(kv[j]) * rk);
        { const int i = F.lane & 15; const float c = cs[(size_t)row * 32 + 2 * i], s = cs[(size_t)row * 32 + 2 * i + 1]; const float x1 = bf_lo(kr), x2 = bf_hi(kr);
          const unsigned w = pk2(x1 * c - x2 * s, x1 * s + x2 * c);
          unsigned* kb = (unsigned*)(KB + (size_t)row * QUP);
#pragma unroll
          for (int hh = 0; hh < 4; ++hh) { const int h = (F.lane >> 4) * 4 + hh; kb[(h * 96 + 64) / 2 + i] = w; } }
    }
}

__device__ __forceinline__ void merge_phase(Frame& F) {
    const int gw = F.vcu * NWAVES + F.wave, NGW = F.G * NWAVES;
    const bf16* OG = (const bf16*)(F.ws + A_OG); const float* LSE = (const float*)(F.ws + WS_LSE); unsigned char* OD = F.ws + A_OD;
    for (int row = gw; row < M; row += NGW) {
        const int h = F.lane >> 3;
        float l0 = LSE[((size_t)0 * M + row) * 8 + h], l1 = LSE[((size_t)1 * M + row) * 8 + h], l2 = LSE[((size_t)2 * M + row) * 8 + h];
        const float mx = fmaxf(l0, fmaxf(l1, l2)); float w0 = __builtin_amdgcn_exp2f(l0 - mx), w1 = __builtin_amdgcn_exp2f(l1 - mx), w2 = __builtin_amdgcn_exp2f(l2 - mx);
        const float inv = 1.0f / (w0 + w1 + w2); w0 *= inv; w1 *= inv; w2 *= inv;
        const v4u a = *(const v4u*)(OG + ((size_t)0 * M + row) * DILOUT + 8 * F.lane), b = *(const v4u*)(OG + ((size_t)1 * M + row) * DILOUT + 8 * F.lane), c = *(const v4u*)(OG + ((size_t)2 * M + row) * DILOUT + 8 * F.lane);
        float m8[8];
#pragma unroll
        for (int k = 0; k < 4; ++k) { m8[2 * k] = (w0 * bf_lo(a[k]) + w1 * bf_lo(b[k]) + w2 * bf_lo(c[k])) * mla::OSCALE; m8[2 * k + 1] = (w0 * bf_hi(a[k]) + w1 * bf_hi(b[k]) + w2 * bf_hi(c[k])) * mla::OSCALE; }
        *(v2u*)(OD + (size_t)row * DILOUT + 8 * F.lane) = (v2u){pg8::pk4_fp8(m8[0], m8[1], m8[2], m8[3]), pg8::pk4_fp8(m8[4], m8[5], m8[6], m8[7])};
    }
}

__device__ __forceinline__ void router_phase(Frame& F, const bf16* H, const float* A0, const float* B0, i8* O0, float* S0) {
    const int gw = F.vcu * NWAVES + F.wave, NGW = F.G * NWAVES;
    LAS float* wrt = (LAS float*)F.lds;
    { const float* wr = F.in[22]; for (int i = F.tid; i < 8192; i += NWAVES * 64) { const int col = i >> 3, e = i & 7; wrt[e * 1024 + col] = wr[i]; } }
    __syncthreads();
    v4u* ROUTE = (v4u*)(F.ws + WS_ROUTE); unsigned* CNT = (unsigned*)(F.ws + WS_CNT);
    for (int c = gw; c < M / 16; c += NGW) {
        const int row0 = c * 16, b = row0 / SEQ;
        f32x4 a0[2][2], b0[2][2];
#pragma unroll
        for (int j = 0; j < 2; ++j) { const int co = b * D + 8 * F.lane + 512 * j; ld8_f32(A0 + co, a0[j][0], a0[j][1]); ld8_f32(B0 + co, b0[j][0], b0[j][1]); }
        unsigned cnt = 0u;
        for (int i = 0; i < 16; ++i) { const size_t row = (size_t)(row0 + i);
            f32x4 v[2][2]; float s = 0.f;
#pragma unroll
            for (int j = 0; j < 2; ++j) { ld8_bf16(H + row * HPITCH + 8 * F.lane + 512 * j, v[j][0], v[j][1]); s += ssq8(v[j][0], v[j][1]); }
            const float rstd = 1.0f / sqrtf(wave_sum(s) * (1.f / D) + EPS);
            float lg[8];
#pragma unroll
            for (int e = 0; e < 8; ++e) lg[e] = 0.f;
            f32x4 yq[2][2];
#pragma unroll
            for (int j = 0; j < 2; ++j) { const f32x4 y0 = v[j][0] * rstd * a0[j][0] + b0[j][0], y1 = v[j][1] * rstd * a0[j][1] + b0[j][1];
                yq[j][0] = y0; yq[j][1] = y1;
#pragma unroll
                for (int e = 0; e < 8; ++e) { const LAS float* wp = wrt + e * 1024 + 8 * F.lane + 512 * j; const f32x4 w0 = *(const LAS f32x4*)wp, w1 = *(const LAS f32x4*)(wp + 4);
                    lg[e] += ((y0.x * w0.x + y0.y * w0.y) + (y0.z * w0.z + y0.w * w0.w)) + ((y1.x * w1.x + y1.y * w1.y) + (y1.z * w1.z + y1.w * w1.w)); } }
            quant_row(yq, O0 + row * D, S0 + row, F.lane);
#pragma unroll
            for (int e = 0; e < 8; ++e) lg[e] = wave_sum(lg[e]);
            int e1 = 0; float v1 = lg[0];
#pragma unroll
            for (int e = 1; e < 8; ++e) if (lg[e] > v1) { v1 = lg[e]; e1 = e; }
            int e2 = -1; float v2 = -INFINITY;
#pragma unroll
            for (int e = 0; e < 8; ++e) if (e != e1 && lg[e] > v2) { v2 = lg[e]; e2 = e; }
            const float ex = expf(v2 - v1); const float g1 = 1.0f / (1.0f + ex), g2 = ex / (1.0f + ex);
            cnt += (F.lane == e1 ? 1u : 0u) + (F.lane == e2 ? 1u : 0u);
            if (F.lane == 0) ROUTE[row] = (v4u){(unsigned)e1 | ((unsigned)e2 << 8), __float_as_uint(g1), __float_as_uint(g2), 0u};
        }
        if (F.lane < 8) CNT[c * 8 + F.lane] = cnt;
    }
}

__device__ __forceinline__ void lists_phase(Frame& F) {
    const int gw = F.vcu * NWAVES + F.wave, NGW = F.G * NWAVES;
    const v4u* ROUTE = (const v4u*)(F.ws + WS_ROUTE); const unsigned* CNT = (const unsigned*)(F.ws + WS_CNT);
    int* LIST = (int*)(F.ws + WS_LIST); float* SLOTG = (float*)(F.ws + WS_SLOTG); float* SLOTXS = (float*)(F.ws + WS_SLOTXS); const float* XS = (const float*)(F.ws + WS_XS); int* TOKSLOT = (int*)(F.ws + WS_TOKSLOT); int* TILEEXP = (int*)(F.ws + WS_TILEEXP);
    for (int c = gw; c < M / 16; c += NGW) {
        unsigned lt[8], al[8];
#pragma unroll
        for (int e = 0; e < 8; ++e) { lt[e] = 0u; al[e] = 0u; }
        for (int cc = F.lane; cc < M / 16; cc += 64) { const v4u x = *(const v4u*)(CNT + cc * 8), y = *(const v4u*)(CNT + cc * 8 + 4); const bool bl = cc < c;
            al[0] += x.x; al[1] += x.y; al[2] += x.z; al[3] += x.w; al[4] += y.x; al[5] += y.y; al[6] += y.z; al[7] += y.w;
            if (bl) { lt[0] += x.x; lt[1] += x.y; lt[2] += x.z; lt[3] += x.w; lt[4] += y.x; lt[5] += y.y; lt[6] += y.z; lt[7] += y.w; } }
#pragma unroll
        for (int e = 0; e < 8; ++e) {
#pragma unroll
            for (int o = 1; o < 64; o <<= 1) { lt[e] += __shfl_xor(lt[e], o); al[e] += __shfl_xor(al[e], o); } }
        unsigned base[8]; unsigned run = 0u;
#pragma unroll
        for (int e = 0; e < 8; ++e) { base[e] = run; run += (al[e] + 255u) & ~255u; }
        const int row = c * 16 + (F.lane & 15);
        const v4u r = ROUTE[row]; const int e1 = (int)(r.x & 0xffu), e2 = (int)((r.x >> 8) & 0xffu);
        int s1 = 0, s2 = 0;
#pragma unroll
        for (int e = 0; e < 8; ++e) { const bool has = (F.lane < 16) && (e1 == e || e2 == e); const unsigned long long mk = __ballot(has);
            const int rank = __popcll(mk & ((1ull << F.lane) - 1ull)); const int sl = (int)(base[e] + lt[e]) + rank;
            if (e1 == e) s1 = sl; if (e2 == e) s2 = sl; }
        if (F.lane < 16) { LIST[s1] = row; LIST[s2] = row; SLOTG[s1] = __uint_as_float(r.y); SLOTG[s2] = __uint_as_float(r.z); TOKSLOT[row * 2] = s1; TOKSLOT[row * 2 + 1] = s2;
            const float xs = XS[row]; SLOTXS[s1] = xs; SLOTXS[s2] = xs; }
        if (c == 0) {
#pragma unroll
            for (int e = 0; e < 8; ++e) { const unsigned pe = (al[e] + 255u) & ~255u;
                for (unsigned s = base[e] + al[e] + F.lane; s < base[e] + pe; s += 64) { LIST[s] = 0; SLOTG[s] = 0.f; SLOTXS[s] = 0.f; }
                for (unsigned t = base[e] / 256u + F.lane; t < (base[e] + pe) / 256u; t += 64) TILEEXP[t] = e; }
            if (F.lane == 0) TILEEXP[300] = (int)(run / 256u);
        }
    }
}

__device__ __forceinline__ void final_phase(Frame& F, float* OUT, const float* gate, const float* gfin) {
    const int gw = F.vcu * NWAVES + F.wave, NGW = F.G * NWAVES;
    const bf16* Y = (const bf16*)(F.ws + A_Y); const int* TOKSLOT = (const int*)(F.ws + WS_TOKSLOT); const bf16* H = (const bf16*)OUT;
    for (int c = gw; c < M / 16; c += NGW) {
        const int row0 = c * 16, b = row0 / SEQ;
        f32x4 gt[2][2], gf[2][2];
#pragma unroll
        for (int j = 0; j < 2; ++j) { ld8_f32(gate + b * D + 8 * F.lane + 512 * j, gt[j][0], gt[j][1]); ld8_f32(gfin + 8 * F.lane + 512 * j, gf[j][0], gf[j][1]); }
#pragma unroll 2
        for (int i = 0; i < 16; ++i) { const size_t row = (size_t)(row0 + i);
            const int s1 = TOKSLOT[row * 2], s2 = TOKSLOT[row * 2 + 1];
            f32x4 v[2][2]; float s = 0.f;
#pragma unroll
            for (int j = 0; j < 2; ++j) { f32x4 h0, h1, p0, p1, q0, q1; ld8_bf16(H + row * HPITCH + 8 * F.lane + 512 * j, h0, h1);
                ld8_bf16(Y + (size_t)s1 * D + 8 * F.lane + 512 * j, p0, p1); ld8_bf16(Y + (size_t)s2 * D + 8 * F.lane + 512 * j, q0, q1);
                v[j][0] = h0 + gt[j][0] * (p0 + q0); v[j][1] = h1 + gt[j][1] * (p1 + q1); s += ssq8(v[j][0], v[j][1]); }
            const float rstd = 1.0f / sqrtf(wave_sum(s) * (1.f / D) + EPS);
            asm volatile("" ::: "memory");
#pragma unroll
            for (int j = 0; j < 2; ++j) { float* op = OUT + row * D + 8 * F.lane + 512 * j; *(GAS f32x4*)op = v[j][0] * rstd * gf[j][0]; *(GAS f32x4*)(op + 4) = v[j][1] * rstd * gf[j][1]; }
        }
    }
}
#ifndef MK_ONE_LAUNCH
#define MK_ONE_LAUNCH 1
#endif
constexpr int N_PHASES = 20;
struct Args { const float* in[26]; float* out; unsigned char* ws; int ph_lo, ph_hi; };
static_assert(sizeof(Args) == 26 * 8 + 8 + 8 + 8, "Args has no padding");

__global__ void __launch_bounds__(NWAVES * 64, 2) mk_fwd(Args args) {
    extern __shared__ __attribute__((aligned(16))) unsigned char lds[];
    Frame F;
    F.lds = (LAS unsigned char*)lds;
    F.MISC = (volatile LAS unsigned*)(F.lds + MISC_OFF);
    F.tid = threadIdx.x; F.lane = F.tid & 63; F.wave = __builtin_amdgcn_readfirstlane(F.tid >> 6);
    F.G = gridDim.x; { const int bx = blockIdx.x; F.vcu = (F.G % 8 == 0) ? (bx % 8) * (F.G / 8) + bx / 8 : bx; }
    F.ws = args.ws; F.out = args.out;
#pragma unroll
    for (int i = 0; i < 26; ++i) F.in[i] = args.in[i];
    unsigned char* const ws = args.ws;
    for (int u = F.tid; u < (LDS_BYTES - LDSCTL_OFF) / 4; u += NWAVES * 64) ((LAS unsigned*)(F.lds + LDSCTL_OFF))[u] = 0u;
    __syncthreads();
    const int lo = args.ph_lo, hi = args.ph_hi;
    XcdBarrier bar; bar.bar = (unsigned*)(ws + WS_CTL) + CW_BAR; bar.x = 0; bar.st = nullptr;
    if (hi - lo > 1) bar = xcd_barrier_post((unsigned*)(ws + WS_CTL) + CW_BAR, F.MISC + 8);
    int cid = (int)blockIdx.x;
    if (hi - lo > 1) { if (F.tid == 0) F.MISC[12] = xb_add((unsigned*)(ws + WS_CTL) + CW_RANK + 64 * bar.x, 1u); }

#ifndef PHASE_MASK
#define PHASE_MASK 0xFFFFFu
#endif
#define IN(k) (((PHASE_MASK >> (k)) & 1u) && lo <= (k) && (k) < hi)
#ifndef REPEAT_MASK
#define REPEAT_MASK 0u
#endif
#define REP(k) (((REPEAT_MASK >> (k)) & 1u) ? 2 : 1)
#define SEAM(k) do { if (IN(k) && IN((k) + 1)) xcd_barrier(bar); } while (0)
    const float* MODV = (const float*)(ws + WS_MODV);
#define MV(kind) (MODV + (size_t)(kind) * 4 * D)
    bf16* const H = (bf16*)args.out;
    i8* const XN = (i8*)(ws + A_XN); i8* const XNKV = (i8*)(ws + A_XNKV);
    float* const XS = (float*)(ws + WS_XS); float* const XSKV = (float*)(ws + WS_XSKV); const float* const SB = (const float*)(ws + WS_SB);
    const pg8::MoeInfo mi0{nullptr, nullptr, 0};

    if (IN(0)) for (int rep_ = 0; rep_ < REP(0); ++rep_) { p0_prologue(F); } SEAM(0);
    if (IN(0) && IN(1)) {
        if (F.tid == 0) { bool ok = (F.G % 8) == 0;
            for (unsigned j = 0; j < 16; ++j) { const unsigned cnt_ = xb_ld((unsigned*)(ws + WS_CTL) + CW_BAR + XB_XCNT(j)); ok = ok && (cnt_ == (j < 8 ? (unsigned)F.G / 8u : 0u)); }
            F.MISC[13] = ok ? (F.MISC[12] * 8u + bar.x) : (unsigned)blockIdx.x; }
        __syncthreads();
        cid = (int)F.MISC[13];
        F.vcu = (F.G % 8 == 0) ? (cid % 8) * (F.G / 8) + cid / 8 : cid;
    }

    if (IN(1)) for (int rep_ = 0; rep_ < REP(1); ++rep_) { p1_convert(F); norm_phase<false, true>(F, F.in[0], MV(MK_A_MIX0), MV(MK_B_MIX0), XN, XS, nullptr, nullptr, nullptr, nullptr); } SEAM(1);
    if (IN(2)) for (int rep_ = 0; rep_ < REP(2); ++rep_) { pg8::Gemm g{(const bf16*)XN, (const bf16*)(ws + WS_WMLAIN), M, LATP, D}; pg8::StaticOrder S; S.init(M, LATP, F.G, cid);
        pg8::EpiBf16Q E{(bf16*)(ws + A_LAT), LATP, XS, SB + SB_LAT};
        pg8::gemm_phase<pg8::EpiBf16Q, pg8::StaticOrder, true, true, 0, 1>(F.lds, g, S, E, mi0); } SEAM(2);
    if (IN(3)) for (int rep_ = 0; rep_ < REP(3); ++rep_) { latnorm_phase(F); } SEAM(3);
    if (IN(4)) for (int rep_ = 0; rep_ < REP(4); ++rep_) {
#ifndef P4_SKIP_Q
        { pg8::Gemm g{(const bf16*)(ws + A_QN), (const bf16*)(ws + WS_WQUP), M, QUP, QRANK}; pg8::StaticOrder S; S.init(M, QUP, F.G, cid);
          pg8::EpiQ E{(bf16*)(ws + A_Q), QUP, C2_MLA, (const float*)(ws + WS_CS)};
          pg8::gemm_phase<pg8::EpiQ, pg8::StaticOrder, true, true, 0>(F.lds, g, S, E, mi0); }
#endif
#ifndef P4_SKIP_KV
        { pg8::Gemm g{(const bf16*)(ws + A_KVN), (const bf16*)(ws + WS_WKVUP), M, KVUP, KVRANK}; pg8::StaticOrder S; S.init(M, KVUP, F.G, cid);
          pg8::EpiKV E{(bf16*)(ws + A_K), (bf16*)(ws + A_V)};
          pg8::gemm_phase<pg8::EpiKV, pg8::StaticOrder, true, true, 0>(F.lds, g, S, E, mi0); }
#endif
    } SEAM(4);
    if (IN(5)) for (int rep_ = 0; rep_ < REP(5); ++rep_) {
        const bf16* Qp = (const bf16*)(ws + A_Q); const bf16* Kp = (const bf16*)(ws + A_K); const bf16* Vp = (const bf16*)(ws + A_V); unsigned char* Op = ws + A_O;
        if (F.G == 256) {
            for (int i = 0; i < 8; ++i) { const int bh = (F.vcu >> 3) + 32 * (i >> 2), s = F.vcu & 7, k = i & 3; const int qb = (k == 0) ? s : (k == 1) ? 15 - s : (k == 2) ? 16 + s : 31 - s;
                const int b = bh >> 4, h = bh & 15;
                mla::attn_unit<8>(b, h, qb, Qp, Kp, Vp, Op, (char*)lds); }
        } else {
            for (int u = (int)blockIdx.x; u < BATCH * MLA_H * 32; u += F.G) { const int bh = u >> 5, qb = 31 - (u & 31); const int b = bh >> 4, h = bh & 15;
                mla::attn_unit<8>(b, h, qb, Qp, Kp, Vp, Op, (char*)lds); }
        }
    } SEAM(5);
    if (IN(6)) for (int rep_ = 0; rep_ < REP(6); ++rep_) { pg8::Gemm g{(const bf16*)(ws + A_O), (const bf16*)(ws + WS_WOUT), M, D, D}; pg8::StaticOrder S; S.init(M, D, F.G, cid);
        pg8::EpiResid<true> E{F.in[0], H, MV(MK_G_MIX0), SB + SB_OUT};
        pg8::gemm_phase<pg8::EpiResid<true>, pg8::StaticOrder, true, true, 0, 2>(F.lds, g, S, E, mi0); } SEAM(6);
    if (IN(7)) for (int rep_ = 0; rep_ < REP(7); ++rep_) { norm_phase<false, false>(F, H, MV(MK_A_FFN0), MV(MK_B_FFN0), XN, XS, nullptr, nullptr, nullptr, nullptr); } SEAM(7);
    if (IN(8)) for (int rep_ = 0; rep_ < REP(8); ++rep_) { pg8::Gemm g{(const bf16*)XN, (const bf16*)(ws + WS_WFGU), M, 2 * DFF, D}; pg8::StaticOrder S; S.init(M, 2 * DFF, F.G, cid);
        pg8::EpiSwiGLUQ E{(unsigned char*)(ws + A_HID), DFF, XS, SB + SB_FGU, nullptr};
        pg8::gemm_phase<pg8::EpiSwiGLUQ, pg8::StaticOrder, true, true, 0, 1>(F.lds, g, S, E, mi0); } SEAM(8);
    if (IN(9)) for (int rep_ = 0; rep_ < REP(9); ++rep_) { pg8::Gemm g{(const bf16*)(ws + A_HID), (const bf16*)(ws + WS_WFDN), M, D, DFF}; pg8::StaticOrder S; S.init(M, D, F.G, cid);
        pg8::EpiResid<false> E{H, H, MV(MK_G_FFN0), SB + SB_FDN};
        pg8::gemm_phase<pg8::EpiResid<false>, pg8::StaticOrder, true, true, 0, 2>(F.lds, g, S, E, mi0); } SEAM(9);
    if (IN(10)) for (int rep_ = 0; rep_ < REP(10); ++rep_) { norm_phase<true, false>(F, H, MV(MK_A_MIX1), MV(MK_B_MIX1), XN, XS, MV(MK_A_KV), MV(MK_B_KV), XNKV, XSKV); } SEAM(10);
    if (IN(11)) for (int rep_ = 0; rep_ < REP(11); ++rep_) {
        { pg8::Gemm g{(const bf16*)XNKV, (const bf16*)(ws + WS_WKVB), M, DILKV, D}; pg8::StaticOrder S; S.init(M, DILKV, F.G, cid);
          pg8::EpiDilQ<true> E{(bf16*)(ws + A_KVB), XSKV, SB + SB_KVB};
          pg8::gemm_phase<pg8::EpiDilQ<true>, pg8::StaticOrder, true, true, 0, 1>(F.lds, g, S, E, mi0); }
        { pg8::Gemm g{(const bf16*)XN, (const bf16*)(ws + WS_WQB), M, DILQ, D}; pg8::StaticOrder S; S.init(M, DILQ, F.G, cid);
          pg8::EpiDilQ<false> E{(bf16*)(ws + A_QB), XS, SB + SB_QB};
          pg8::gemm_phase<pg8::EpiDilQ<false>, pg8::StaticOrder, true, true, 0, 1>(F.lds, g, S, E, mi0); }
    } SEAM(11);
    if (IN(12)) for (int rep_ = 0; rep_ < REP(12); ++rep_) {
        const bf16* Qp = (const bf16*)(ws + A_QB); const bf16* KV = (const bf16*)(ws + A_KVB); bf16* OG = (bf16*)(ws + A_OG); float* LSE = (float*)(ws + WS_LSE); const float* BT = (const float*)(ws + WS_BIAS);
        dila::dil_phase(Qp, KV, OG, LSE, BT, (char*)lds, F.G);
    } SEAM(12);
    if (IN(13)) for (int rep_ = 0; rep_ < REP(13); ++rep_) { merge_phase(F); } SEAM(13);
    if (IN(14)) for (int rep_ = 0; rep_ < REP(14); ++rep_) { pg8::Gemm g{(const bf16*)(ws + A_OD), (const bf16*)(ws + WS_WOB), M, D, DILOUT}; pg8::StaticOrder S; S.init(M, D, F.G, cid);
        pg8::EpiResid<false> E{H, H, MV(MK_G_MIX1), SB + SB_OB};
        pg8::gemm_phase<pg8::EpiResid<false>, pg8::StaticOrder, true, true, 0, 2>(F.lds, g, S, E, mi0); } SEAM(14);
    if (IN(15)) for (int rep_ = 0; rep_ < REP(15); ++rep_) { router_phase(F, H, MV(MK_A_FFN1), MV(MK_B_FFN1), XN, XS); } SEAM(15);
    if (IN(16)) for (int rep_ = 0; rep_ < REP(16); ++rep_) { lists_phase(F); } SEAM(16);
    if (IN(17)) for (int rep_ = 0; rep_ < REP(17); ++rep_) { const int ntile = ((const int*)(ws + WS_TILEEXP))[300];
        pg8::Gemm g{(const bf16*)XN, (const bf16*)(ws + WS_WEGU), ntile * 256, 2 * DFF, D}; pg8::StaticOrder S; S.init(ntile * 256, 2 * DFF, F.G, cid);
        const pg8::MoeInfo mi{(const int*)(ws + WS_LIST), (const int*)(ws + WS_TILEEXP), (size_t)2 * DFF * D};
        pg8::EpiSwiGLUQ E{(unsigned char*)(ws + A_HIDS), DFF, (const float*)(ws + WS_SLOTXS), SB + SB_EGU, mi.tile_expert};
        pg8::gemm_phase<pg8::EpiSwiGLUQ, pg8::StaticOrder, true, true, 1, 1>(F.lds, g, S, E, mi); } SEAM(17);
    if (IN(18)) for (int rep_ = 0; rep_ < REP(18); ++rep_) { const int ntile = ((const int*)(ws + WS_TILEEXP))[300];
        pg8::Gemm g{(const bf16*)(ws + A_HIDS), (const bf16*)(ws + WS_WEDN), ntile * 256, D, DFF}; pg8::StaticOrder S; S.init(ntile * 256, D, F.G, cid);
        const pg8::MoeInfo mi{(const int*)(ws + WS_LIST), (const int*)(ws + WS_TILEEXP), (size_t)D * DFF};
        pg8::EpiMoeDown E{(bf16*)(ws + A_Y), (const float*)(ws + WS_SLOTG), SB + SB_EDN, mi.tile_expert};
        pg8::gemm_phase<pg8::EpiMoeDown, pg8::StaticOrder, true, true, 2, 2>(F.lds, g, S, E, mi); } SEAM(18);
    if (IN(19)) for (int rep_ = 0; rep_ < REP(19); ++rep_) { final_phase(F, args.out, MV(MK_G_FFN1), F.in[25]); }
#undef IN
#undef SEAM
#undef MV
}

extern "C" void kernel_launch(void* const* d_in, const int* in_sizes, int n_in, void* d_out, int out_size, void* d_ws, size_t ws_size, hipStream_t stream) {
    static int grid = 0;
    if (grid == 0) {
        if (n_in != 26 || in_sizes[0] != M * D || out_size != M * D || ws_size < WS_END) { fprintf(stderr, "kernel_launch: unexpected shapes (n_in %d, in0 %d, out %d, ws %zu, need %zu); nothing launched\n", n_in, n_in > 0 ? in_sizes[0] : -1, out_size, ws_size, (size_t)WS_END); grid = -1; return; }
        int dev = 0, cus = 0, per_cu = 0;
        if (hipGetDevice(&dev) != hipSuccess || hipDeviceGetAttribute(&cus, hipDeviceAttributeMultiprocessorCount, dev) != hipSuccess) { grid = -1; return; }
        if (hipFuncSetAttribute((const void*)mk_fwd, hipFuncAttributeMaxDynamicSharedMemorySize, LDS_BYTES) != hipSuccess) { fprintf(stderr, "kernel_launch: hipFuncSetAttribute failed\n"); grid = -1; return; }
        if (hipOccupancyMaxActiveBlocksPerMultiprocessor(&per_cu, (const void*)mk_fwd, NWAVES * 64, LDS_BYTES) != hipSuccess || per_cu < 1) { fprintf(stderr, "kernel_launch: occupancy query reports %d\n", per_cu); }
        (void)hipGetLastError();
        grid = cus;
    }
    if (grid < 0) return;
    if (hipMemsetAsync((char*)d_ws + WS_CTL, 0, CTL_ZERO_BYTES, stream) != hipSuccess) return;
    Args a{};
    for (int i = 0; i < 26; ++i) a.in[i] = (const float*)d_in[i];
    a.out = (float*)d_out; a.ws = (unsigned char*)d_ws;
#if MK_ONE_LAUNCH
    a.ph_lo = 0; a.ph_hi = N_PHASES;
    hipLaunchKernelGGL(mk_fwd, dim3(grid), dim3(NWAVES * 64), LDS_BYTES, stream, a);
#else
    for (int p = 0; p < N_PHASES; ++p) { a.ph_lo = p; a.ph_hi = p + 1; hipLaunchKernelGGL(mk_fwd, dim3(grid), dim3(NWAVES * 64), LDS_BYTES, stream, a); }
#endif
}
```

```cpp
#include <hip/hip_runtime.h>
#include <hip/hip_bf16.h>
#include <cstdio>
#include <cstdint>
#include <cmath>
#ifndef MK_ONE_LAUNCH
#define MK_ONE_LAUNCH 1
#endif
#ifndef PG8_STAGGER
#define PG8_STAGGER 0
#endif
namespace pg8 {
#define PG8_LAS __attribute__((address_space(3)))
typedef unsigned short bf16_t;
typedef short bf16x8 __attribute__((ext_vector_type(8)));
typedef float f32x4 __attribute__((ext_vector_type(4)));
typedef float f32x2 __attribute__((ext_vector_type(2)));
typedef unsigned u32x4 __attribute__((ext_vector_type(4)));
typedef int i32x4 __attribute__((ext_vector_type(4)));
typedef int i32x8 __attribute__((ext_vector_type(8)));
template <int PREC> struct AccT { typedef f32x4 type; }; template <> struct AccT<1> { typedef i32x4 type; };
constexpr int BM = 256, BK = 64, HALF = 128, HTB = HALF * BK * 2  , STAGE_BYTES = 8 * HTB, NXCD = 8, WGM = 8;

__host__ __device__ __forceinline__ int lds_byte(int r, int c) { const int st = (r >> 4) * 2 + (c >> 5), rr = r & 15, cc = c & 31, ob = rr * 64 + cc * 2; return st * 1024 + (ob ^ (((ob >> 9) & 1) << 5)); }
__host__ __device__ __forceinline__ void stage_rc(int b, int& R, int& C) { const int st = b / 1024, sb = b % 1024, swz = sb ^ (((sb >> 9) & 1) << 5); R = (st >> 1) * 16 + swz / 64; C = (st & 1) * 32 + (swz % 64) / 2; }
__host__ __device__ __forceinline__ int perm32(int rho) { const int n = rho >> 4, i = rho & 15; return 8 * (i >> 2) + 4 * n + (i & 3); }

struct Unit { int pm, pn; };
struct Gemm { const bf16_t* A; const bf16_t* Bt; int M, N, K; };
struct MoeInfo { const int* list; const int* tile_expert; size_t bstride; };

struct StaticOrder {
    int nM, nN, nwg, G, c;
    __host__ __device__ void init(int M, int N, int G_, int c_) { nM = M / BM; nN = N / BM; nwg = nM * nN; G = G_; c = c_; }
    __host__ __device__ bool next(int i, Unit& u) const {
        const long L = (long)i * G + c; if (L >= nwg) return false;
        int wgid = (int)L; { const int q = nwg / NXCD, r = nwg % NXCD, xcd = wgid % NXCD, off = wgid / NXCD; wgid = (xcd < r ? xcd * (q + 1) : r * (q + 1) + (xcd - r) * q) + off; }
        const int nig = WGM * nN, gid = wgid / nig, fm = gid * WGM, gsz = (nM - fm) < WGM ? (nM - fm) : WGM;
        u.pm = fm + ((wgid % nig) % gsz); u.pn = (wgid % nig) / gsz; return true;
    }
    __device__ __forceinline__ void a_ready(const Unit&) const {}
    __device__ __forceinline__ void done(const Unit&) const {}
};

__device__ __forceinline__ unsigned cvt_pk_bf16(float lo, float hi) { unsigned r; asm volatile("v_cvt_pk_bf16_f32 %0, %1, %2" : "=v"(r) : "v"(lo), "v"(hi)); return r; }


template <class Epi, class Sched, bool ALIGN_EPI, bool SP2, int MODE, int PREC = 0>
__device__ __forceinline__ void gemm_phase(PG8_LAS unsigned char* lds, const Gemm g, const Sched& S, const Epi& E, const MoeInfo mi) {
    const int tid = threadIdx.x, wid = __builtin_amdgcn_readfirstlane(tid >> 6), lane = tid & 63, wr = wid >> 2, wc = wid & 3, fr = lane & 15, fq = lane >> 4;
    int K_ = g.K; asm volatile("" : "+s"(K_));
    constexpr int ES = PREC ? 1 : 2;
    const int K = K_, nt = (K * ES) / (BK * 2);
    unsigned voffB[2]; int Rr[2], Cc[2];
#pragma unroll
    for (int i = 0; i < 2; ++i) { int R, C; stage_rc(tid * 16 + i * 8192, R, C); const int Rb = Epi::PERM ? ((R & ~31) + perm32(R & 31)) : R;
        Rr[i] = R; Cc[i] = C; voffB[i] = (unsigned)(Rb * K) * (unsigned)ES + (unsigned)C * 2u; }
    const size_t kstep = (size_t)(BK * 2);
    const size_t hstep = (size_t)HALF * K * ES;
    const size_t tstep = 2 * hstep;
    const unsigned ldsw = (unsigned)wid * 1024u;
    const int aoff = lds_byte(wr * 64 + fr, fq * 8), boff = lds_byte(wc * 32 + fr, fq * 8);
    const unsigned rowb = (unsigned)K * (unsigned)ES;
#define PG8_SA(b, h) (((b) * 2 + (h)) * HTB)
#define PG8_SB(b, h) ((4 + (b) * 2 + (h)) * HTB)
#define PG8_STAGE(bufoff, gbase, voff) do { _Pragma("unroll") for (int _i = 0; _i < 2; ++_i) \
        __builtin_amdgcn_global_load_lds((const unsigned*)((const char*)(gbase) + (voff)[_i]), (PG8_LAS unsigned*)(lds + (bufoff) + ldsw + _i * 8192), 16, 0, 0); } while (0)
#define PG8_LDA(dst, b, h) do { _Pragma("unroll") for (int m = 0; m < 4; ++m) { if constexpr (PREC == 2) { \
            const i32x4 lo_ = *(const PG8_LAS i32x4*)(lds + PG8_SA(b, h) + aoff + m * 2048), hi_ = *(const PG8_LAS i32x4*)(lds + PG8_SA(b, h) + aoff + m * 2048 + 1024); \
            dst##8[m] = (i32x8){lo_[0], lo_[1], lo_[2], lo_[3], hi_[0], hi_[1], hi_[2], hi_[3]}; } \
        else { _Pragma("unroll") for (int k = 0; k < 2; ++k) dst[m][k] = *(const PG8_LAS bf16x8*)(lds + PG8_SA(b, h) + aoff + m * 2048 + k * 1024); } } } while (0)
#define PG8_LDB(dst, b, h) do { _Pragma("unroll") for (int n = 0; n < 2; ++n) { if constexpr (PREC == 2) { \
            const i32x4 lo_ = *(const PG8_LAS i32x4*)(lds + PG8_SB(b, h) + boff + n * 2048), hi_ = *(const PG8_LAS i32x4*)(lds + PG8_SB(b, h) + boff + n * 2048 + 1024); \
            dst##8[n] = (i32x8){lo_[0], lo_[1], lo_[2], lo_[3], hi_[0], hi_[1], hi_[2], hi_[3]}; } \
        else { _Pragma("unroll") for (int k = 0; k < 2; ++k) dst[n][k] = *(const PG8_LAS bf16x8*)(lds + PG8_SB(b, h) + boff + n * 2048 + k * 1024); } } } while (0)
#define PG8_MMA(ai, bj, At, Bt) do { __builtin_amdgcn_s_setprio(1); _Pragma("unroll") for (int m = 0; m < 4; ++m) _Pragma("unroll") for (int n = 0; n < 2; ++n) { \
        if constexpr (PREC == 2) asm volatile("s_nop 1\n\tv_mfma_scale_f32_16x16x128_f8f6f4 %0, %1, %2, %0, %3, %3 op_sel_hi:[0,0,0]" : "+v"(acc[ai][bj][m][n]) : "v"(Bt##8[n]), "v"(At##8[m]), "v"(one_scale));   \
        else { _Pragma("unroll") for (int k = 0; k < 2; ++k) { \
            if constexpr (PREC == 1) acc[ai][bj][m][n] = __builtin_amdgcn_mfma_i32_16x16x64_i8(__builtin_bit_cast(i32x4, Bt[n][k]), __builtin_bit_cast(i32x4, At[m][k]), acc[ai][bj][m][n], 0, 0, 0); \
            else acc[ai][bj][m][n] = __builtin_amdgcn_mfma_f32_16x16x32_bf16(Bt[n][k], At[m][k], acc[ai][bj][m][n], 0, 0, 0); } } } __builtin_amdgcn_s_setprio(0); } while (0)
#define PG8_WAIT_V(n) asm volatile("s_waitcnt vmcnt(" #n ")" ::: "memory")
#define PG8_WAIT_L(n) asm volatile("s_waitcnt lgkmcnt(" #n ")" ::: "memory")
#define PG8_WAIT_V8R do { const int rlx_ = rlx_flag;   \
        if constexpr (Epi::NST >= 16) asm volatile("s_cmp_eq_u32 %0, 0\n\ts_cbranch_scc1 .Lpg8a%=\n\ts_waitcnt vmcnt(24)\n\ts_branch .Lpg8b%=\n.Lpg8a%=:\n\ts_waitcnt vmcnt(8)\n.Lpg8b%=:" :: "s"(rlx_) : "memory", "scc"); \
        else if constexpr (Epi::NST >= 8) asm volatile("s_cmp_eq_u32 %0, 0\n\ts_cbranch_scc1 .Lpg8a%=\n\ts_waitcnt vmcnt(16)\n\ts_branch .Lpg8b%=\n.Lpg8a%=:\n\ts_waitcnt vmcnt(8)\n.Lpg8b%=:" :: "s"(rlx_) : "memory", "scc"); \
        else PG8_WAIT_V(8); } while (0)
#define PG8_BAR __builtin_amdgcn_s_barrier()
#define PG8_SCHED __builtin_amdgcn_sched_barrier(0)
#define PG8_MKOFF(u, o) do { _Pragma("unroll") for (int _h = 0; _h < 2; ++_h) _Pragma("unroll") for (int _i = 0; _i < 2; ++_i) { \
        int _row = (u).pm * BM + _h * HALF + Rr[_i]; if (MODE == 1) _row = mi.list[_row]; (o)[_h][_i] = (unsigned)_row * rowb + (unsigned)Cc[_i] * 2u; } } while (0)
#define PG8_BBASE(u) ((const char*)g.Bt + (size_t)(u).pn * tstep + (MODE != 0 ? (size_t)mi.tile_expert[(u).pm] * mi.bstride : (size_t)0))
    Unit cur, nxt; int ui = 0;
    if (!S.next(0, cur)) return;
#if PG8_STAGGER
    {
        const int grp = ((int)blockIdx.x >> 3) & 3;
        if (grp) { if (wid == 0) { const unsigned long long t0 = __builtin_amdgcn_s_memrealtime(); const unsigned long long dt = (unsigned long long)(grp * nt * PG8_STAGGER);
                       while (__builtin_amdgcn_s_memrealtime() - t0 < dt) __builtin_amdgcn_s_sleep(8); }
                   __syncthreads(); }
    }
#endif
    typedef typename AccT<PREC>::type acc_t;
    acc_t acc[2][2][4][2];
#pragma unroll
    for (int a = 0; a < 2; ++a)
#pragma unroll
        for (int b = 0; b < 2; ++b)
#pragma unroll
            for (int m = 0; m < 4; ++m)
#pragma unroll
                for (int n = 0; n < 2; ++n) acc[a][b][m][n] = acc_t{};
    bf16x8 At[4][2], B0[2][2], B1[2][2];
    const int one_scale = 0x7f7f7f7f;
    unsigned oc[2][2], on[2][2];
    const char* const Ab = (const char*)g.A;
    const char* cAu = Ab;
    if constexpr (MODE == 1) { PG8_MKOFF(cur, oc); } else { Unit u0_; u0_.pm = 0; u0_.pn = 0; PG8_MKOFF(u0_, oc); cAu = Ab + (size_t)cur.pm * tstep; }
    const char* cB = PG8_BBASE(cur);
    S.a_ready(cur);
    static_assert(SP2, "only the SP2 loop is kept");
    {
        PG8_STAGE(PG8_SB(0, 0), cB, voffB); PG8_STAGE(PG8_SB(0, 1), cB + hstep, voffB); PG8_STAGE(PG8_SA(0, 0), cAu, oc[0]); PG8_STAGE(PG8_SA(0, 1), cAu, oc[1]);
        if (wr == 1) PG8_BAR;
        PG8_WAIT_V(2); PG8_BAR;
        PG8_STAGE(PG8_SB(1, 0), cB + kstep, voffB); PG8_STAGE(PG8_SA(1, 0), cAu + kstep, oc[0]); PG8_STAGE(PG8_SB(1, 1), cB + hstep + kstep, voffB);
        PG8_WAIT_V(6); PG8_BAR;
    }
    Unit nn; unsigned onn[2][2]; bool has_next_c = false;
    if constexpr (MODE == 1) { has_next_c = S.next(1, nxt); if (has_next_c) PG8_MKOFF(nxt, on); }
    typename Epi::Pre pre;
    int rlx_flag = 0;
    for (;;) {
        bool has_next; bool has_nn = false;
        if constexpr (MODE == 1) { has_next = has_next_c; has_nn = has_next && S.next(ui + 2, nn); if (has_nn) PG8_MKOFF(nn, onn); }
        else has_next = S.next(ui + 1, nxt);
        const char* nB = cB; const char* nAu = cAu;
        if (has_next) { if constexpr (MODE != 1) nAu = Ab + (size_t)nxt.pm * tstep; nB = PG8_BBASE(nxt); }
        else if constexpr (MODE == 1) {
#pragma unroll
            for (int _h = 0; _h < 2; ++_h)
#pragma unroll
                for (int _i = 0; _i < 2; ++_i) on[_h][_i] = oc[_h][_i];
        }
        for (int t = 0; t < nt; t += 2) {
            const bool last = (t == nt - 2);
            i32x8 At8[4], B08[2], B18[2];
            const char* a1 = cAu + (size_t)(t + 1) * kstep;
            const char* a2 = last ? nAu : cAu + (size_t)(t + 2) * kstep; const char* b2 = last ? nB : cB + (size_t)(t + 2) * kstep;
            const char* a3 = a2 + kstep; const char* b3 = b2 + kstep;
            unsigned o2[2][2];
#pragma unroll
            for (int _h = 0; _h < 2; ++_h)
#pragma unroll
                for (int _i = 0; _i < 2; ++_i) o2[_h][_i] = (MODE == 1 && last) ? on[_h][_i] : oc[_h][_i];
            if (last && has_next) S.a_ready(nxt);
            PG8_LDB(B0, 0, 0); PG8_LDB(B1, 0, 1); PG8_SCHED; PG8_LDA(At, 0, 0); PG8_STAGE(PG8_SA(1, 1), a1, oc[1]);
            PG8_WAIT_V8R; PG8_WAIT_L(0); PG8_BAR; PG8_MMA(0, 0, At, B0); PG8_MMA(0, 1, At, B1); PG8_BAR; PG8_SCHED;
            PG8_LDA(At, 0, 1); PG8_STAGE(PG8_SB(0, 0), b2, voffB); PG8_STAGE(PG8_SB(0, 1), b2 + hstep, voffB); PG8_STAGE(PG8_SA(0, 0), a2, o2[0]);
            PG8_WAIT_V8R; PG8_WAIT_L(0); PG8_BAR; PG8_MMA(1, 0, At, B0); PG8_MMA(1, 1, At, B1); PG8_BAR; PG8_SCHED;
            PG8_LDB(B0, 1, 0); PG8_LDB(B1, 1, 1); PG8_SCHED; PG8_LDA(At, 1, 0); PG8_STAGE(PG8_SA(0, 1), a2, o2[1]);
            PG8_WAIT_V(8); PG8_WAIT_L(0); PG8_BAR; PG8_MMA(0, 0, At, B0); PG8_MMA(0, 1, At, B1); PG8_BAR; PG8_SCHED;
            PG8_LDA(At, 1, 1); PG8_STAGE(PG8_SB(1, 0), b3, voffB); PG8_STAGE(PG8_SB(1, 1), b3 + hstep, voffB); PG8_STAGE(PG8_SA(1, 0), a3, o2[0]);
            PG8_WAIT_V(8); PG8_WAIT_L(0); PG8_BAR; PG8_MMA(1, 0, At, B0); PG8_MMA(1, 1, At, B1); PG8_BAR; PG8_SCHED;
            rlx_flag = 0; asm volatile("" : "+s"(rlx_flag));
        }
        if constexpr (Epi::PRE != 0) E.prefetch(pre, cur, wr, wc, fr, fq);
        if constexpr (ALIGN_EPI) { if (wr == 0) PG8_BAR; }
        if constexpr (PREC == 2) asm volatile("s_nop 15\n\ts_nop 15" ::: "memory");
        if constexpr (Epi::PRE != 0) E(acc, cur, wr, wc, fr, fq, pre); else E(acc, cur, wr, wc, fr, fq);
        S.done(cur);
        if (!has_next) break;
#pragma unroll
        for (int a = 0; a < 2; ++a)
#pragma unroll
            for (int b = 0; b < 2; ++b)
#pragma unroll
                for (int m = 0; m < 4; ++m)
#pragma unroll
                    for (int n = 0; n < 2; ++n) acc[a][b][m][n] = acc_t{};
        cur = nxt; cB = nB; cAu = nAu; ++ui; rlx_flag = 1; asm volatile("" : "+s"(rlx_flag));
        if constexpr (MODE == 1) {
#pragma unroll
            for (int _h = 0; _h < 2; ++_h)
#pragma unroll
                for (int _i = 0; _i < 2; ++_i) oc[_h][_i] = on[_h][_i]; }
        if constexpr (MODE == 1) { nxt = nn; has_next_c = has_nn;
#pragma unroll
            for (int _h = 0; _h < 2; ++_h)
#pragma unroll
                for (int _i = 0; _i < 2; ++_i) on[_h][_i] = onn[_h][_i]; }
        if constexpr (ALIGN_EPI) { if (wr == 1) PG8_BAR; }
    }
    PG8_WAIT_V(0);
    if constexpr (!ALIGN_EPI) { if (wr == 0) PG8_BAR; }
    PG8_BAR;
#undef PG8_SA
#undef PG8_SB
#undef PG8_STAGE
#undef PG8_LDA
#undef PG8_LDB
#undef PG8_MMA
#undef PG8_WAIT_V
#undef PG8_WAIT_L
#undef PG8_WAIT_V8R
#undef PG8_BAR
#undef PG8_SCHED
#undef PG8_MKOFF
#undef PG8_BBASE
}
}
namespace pg8 {
constexpr float LOG2E = 1.4426950408889634f;
struct EpiBf16 {
    static constexpr bool PERM = true; static constexpr int NST = 16; static constexpr int PRE = 0; struct Pre {};
    bf16_t* O; int ldc; float scale;
    __device__ __forceinline__ void operator()(const f32x4 (&acc)[2][2][4][2], const Unit& u, int wr, int wc, int fr, int fq) const {
        const int row0 = u.pm * BM + wr * 64 + fr; const int col0 = u.pn * BM + wc * 32 + 8 * fq;
#pragma unroll
        for (int ai = 0; ai < 2; ++ai)
#pragma unroll
            for (int m = 0; m < 4; ++m) { bf16_t* rowp = O + (size_t)(row0 + ai * HALF + m * 16) * ldc + col0;
#pragma unroll
                for (int bj = 0; bj < 2; ++bj) { const f32x4 v0 = acc[ai][bj][m][0] * scale, v1 = acc[ai][bj][m][1] * scale;
                    u32x4 w; w.x = cvt_pk_bf16(v0[0], v0[1]); w.y = cvt_pk_bf16(v0[2], v0[3]); w.z = cvt_pk_bf16(v1[0], v1[1]); w.w = cvt_pk_bf16(v1[2], v1[3]);
                    *(u32x4*)(rowp + bj * HALF) = w; } }
    }
};
struct EpiQ {
    static constexpr bool PERM = true; static constexpr int NST = 16; static constexpr int PRE = 0; struct Pre {};
    bf16_t* O; int ldc; float scale; const float* cs;
    __device__ __forceinline__ void operator()(const f32x4 (&acc)[2][2][4][2], const Unit& u, int wr, int wc, int fr, int fq) const {
        const int row0 = u.pm * BM + wr * 64 + fr; const int col0 = u.pn * BM + wc * 32 + 8 * fq;
        const int grp = u.pn * 8 + wc;
#pragma unroll
        for (int bj = 0; bj < 2; ++bj) { const bool rope = ((grp + 4 * bj) % 3) == 2;
#pragma unroll
            for (int ai = 0; ai < 2; ++ai)
#pragma unroll
                for (int m = 0; m < 4; ++m) { const int row = row0 + ai * HALF + m * 16; bf16_t* rowp = O + (size_t)row * ldc + col0 + bj * HALF;
                    f32x4 v0 = acc[ai][bj][m][0] * scale, v1 = acc[ai][bj][m][1] * scale;
                    if (rope) { const f32x4* cp = (const f32x4*)(cs + (size_t)row * 32 + 8 * fq); const f32x4 c0 = cp[0], c1 = cp[1];
                        f32x4 r0, r1;
                        r0[0] = v0[0] * c0[0] - v0[1] * c0[1]; r0[1] = v0[0] * c0[1] + v0[1] * c0[0];
                        r0[2] = v0[2] * c0[2] - v0[3] * c0[3]; r0[3] = v0[2] * c0[3] + v0[3] * c0[2];
                        r1[0] = v1[0] * c1[0] - v1[1] * c1[1]; r1[1] = v1[0] * c1[1] + v1[1] * c1[0];
                        r1[2] = v1[2] * c1[2] - v1[3] * c1[3]; r1[3] = v1[2] * c1[3] + v1[3] * c1[2];
                        v0 = r0; v1 = r1; }
                    u32x4 w; w.x = cvt_pk_bf16(v0[0], v0[1]); w.y = cvt_pk_bf16(v0[2], v0[3]); w.z = cvt_pk_bf16(v1[0], v1[1]); w.w = cvt_pk_bf16(v1[2], v1[3]);
                    *(u32x4*)rowp = w;
                    if (m & 1) asm volatile("" ::: "memory"); } }
    }
};
struct EpiKV {
    static constexpr bool PERM = true; static constexpr int NST = 16; static constexpr int PRE = 0; struct Pre {};
    bf16_t* Kb; bf16_t* Vb;
    __device__ __forceinline__ void operator()(const f32x4 (&acc)[2][2][4][2], const Unit& u, int wr, int wc, int fr, int fq) const {
        const int row0 = u.pm * BM + wr * 64 + fr;
        const bool isk = wc < 2;
        bf16_t* const base = isk ? Kb : Vb; const int pitch = isk ? 1536 : 1024, hs = isk ? 96 : 64, j0 = (isk ? wc : wc - 2) * 32 + 8 * fq;
#pragma unroll
        for (int ai = 0; ai < 2; ++ai)
#pragma unroll
            for (int m = 0; m < 4; ++m) { bf16_t* rowp = base + (size_t)(row0 + ai * HALF + m * 16) * pitch + j0;
#pragma unroll
                for (int bj = 0; bj < 2; ++bj) { const f32x4 v0 = acc[ai][bj][m][0], v1 = acc[ai][bj][m][1];
                    u32x4 w; w.x = cvt_pk_bf16(v0[0], v0[1]); w.y = cvt_pk_bf16(v0[2], v0[3]); w.z = cvt_pk_bf16(v1[0], v1[1]); w.w = cvt_pk_bf16(v1[2], v1[3]);
                    *(u32x4*)(rowp + (2 * u.pn + bj) * hs) = w; } }
    }
};
template <bool BASEF32> struct EpiResid {
    static constexpr bool PERM = true; static constexpr int NST = 16; static constexpr int PRE = 0; struct Pre {};
    static constexpr int HP = 2048;
    const void* base; bf16_t* out; const float* gate; const float* sB;
    __device__ __forceinline__ void operator()(const f32x4 (&acc)[2][2][4][2], const Unit& u, int wr, int wc, int fr, int fq) const {
        const int row0 = u.pm * BM + wr * 64 + fr; const int col0 = u.pn * BM + wc * 32 + 8 * fq;
        const float* gp = gate + (size_t)((u.pm * BM) >> 13) * 1024 + col0;
        f32x4 gv[2][2];
#pragma unroll
        for (int bj = 0; bj < 2; ++bj)
#pragma unroll
            for (int n = 0; n < 2; ++n) { gv[bj][n] = *(const f32x4*)(gp + bj * HALF + n * 4); if (sB) gv[bj][n] = gv[bj][n] * *(const f32x4*)(sB + col0 + bj * HALF + n * 4); }
#pragma unroll
        for (int ai = 0; ai < 2; ++ai)
#pragma unroll
            for (int m = 0; m < 4; ++m) { const size_t row = (size_t)(row0 + ai * HALF + m * 16);
#pragma unroll
                for (int bj = 0; bj < 2; ++bj) { f32x4 b0, b1;
                    if (BASEF32) { const float* bp = (const float*)base + row * 1024 + col0 + bj * HALF; b0 = *(const f32x4*)bp; b1 = *(const f32x4*)(bp + 4); }
                    else { const u32x4 hb = *(const u32x4*)((const bf16_t*)base + row * HP + col0 + bj * HALF);
                        b0 = (f32x4){__builtin_bit_cast(float, hb.x << 16), __builtin_bit_cast(float, hb.x & 0xffff0000u), __builtin_bit_cast(float, hb.y << 16), __builtin_bit_cast(float, hb.y & 0xffff0000u)};
                        b1 = (f32x4){__builtin_bit_cast(float, hb.z << 16), __builtin_bit_cast(float, hb.z & 0xffff0000u), __builtin_bit_cast(float, hb.w << 16), __builtin_bit_cast(float, hb.w & 0xffff0000u)}; }
                    const f32x4 v0 = b0 + gv[bj][0] * acc[ai][bj][m][0], v1 = b1 + gv[bj][1] * acc[ai][bj][m][1];
                    u32x4 w; w.x = cvt_pk_bf16(v0[0], v0[1]); w.y = cvt_pk_bf16(v0[2], v0[3]); w.z = cvt_pk_bf16(v1[0], v1[1]); w.w = cvt_pk_bf16(v1[2], v1[3]);
                    *(u32x4*)(out + row * HP + col0 + bj * HALF) = w; }
                if (m & 1) asm volatile("" ::: "memory"); }
    }
};
__device__ __forceinline__ float silu_mul(float g, float u) { return g * u * __builtin_amdgcn_rcpf(1.0f + __builtin_amdgcn_exp2f(-g * LOG2E)); }
struct EpiSwiGLU {
    static constexpr bool PERM = true; static constexpr int NST = 8; static constexpr int PRE = 0; struct Pre {};
    bf16_t* O; int ldc;
    __device__ __forceinline__ void operator()(const f32x4 (&acc)[2][2][4][2], const Unit& u, int wr, int wc, int fr, int fq) const {
        const int row0 = u.pm * BM + wr * 64 + fr; const int col0 = u.pn * HALF + wc * 32 + 8 * fq;
#pragma unroll
        for (int ai = 0; ai < 2; ++ai)
#pragma unroll
            for (int m = 0; m < 4; ++m) { bf16_t* rowp = O + (size_t)(row0 + ai * HALF + m * 16) * ldc + col0;
                const f32x4 g0 = acc[ai][0][m][0], g1 = acc[ai][0][m][1], u0 = acc[ai][1][m][0], u1 = acc[ai][1][m][1];
                u32x4 w; w.x = cvt_pk_bf16(silu_mul(g0[0], u0[0]), silu_mul(g0[1], u0[1])); w.y = cvt_pk_bf16(silu_mul(g0[2], u0[2]), silu_mul(g0[3], u0[3]));
                w.z = cvt_pk_bf16(silu_mul(g1[0], u1[0]), silu_mul(g1[1], u1[1])); w.w = cvt_pk_bf16(silu_mul(g1[2], u1[2]), silu_mul(g1[3], u1[3]));
                *(u32x4*)rowp = w; }
    }
};
struct EpiMoeDown {
    static constexpr bool PERM = true; static constexpr int NST = 16; static constexpr int PRE = 12;
    struct Pre { float sg[8]; f32x4 sv[2][2]; };
    bf16_t* O; const float* sg; const float* sB; const int* tile_expert;
    __device__ __forceinline__ void prefetch(Pre& p, const Unit& u, int wr, int wc, int fr, int fq) const {
        const int row0 = u.pm * BM + wr * 64 + fr; const int col0 = u.pn * BM + wc * 32 + 8 * fq;
        const float* sb = sB + (size_t)tile_expert[u.pm] * 1024 + col0;
#pragma unroll
        for (int ai = 0; ai < 2; ++ai)
#pragma unroll
            for (int m = 0; m < 4; ++m) p.sg[ai * 4 + m] = sg[row0 + ai * HALF + m * 16];
#pragma unroll
        for (int bj = 0; bj < 2; ++bj)
#pragma unroll
            for (int n = 0; n < 2; ++n) p.sv[bj][n] = *(const f32x4*)(sb + bj * HALF + 4 * n);
    }
    __device__ __forceinline__ void operator()(const f32x4 (&acc)[2][2][4][2], const Unit& u, int wr, int wc, int fr, int fq, const Pre& p) const {
        const int row0 = u.pm * BM + wr * 64 + fr; const int col0 = u.pn * BM + wc * 32 + 8 * fq;
#pragma unroll
        for (int ai = 0; ai < 2; ++ai)
#pragma unroll
            for (int m = 0; m < 4; ++m) { const int row = row0 + ai * HALF + m * 16; const float s = p.sg[ai * 4 + m]; bf16_t* rowp = O + (size_t)row * 1024 + col0;
#pragma unroll
                for (int bj = 0; bj < 2; ++bj) { const f32x4 v0 = acc[ai][bj][m][0] * p.sv[bj][0] * s, v1 = acc[ai][bj][m][1] * p.sv[bj][1] * s;
                    u32x4 w; w.x = cvt_pk_bf16(v0[0], v0[1]); w.y = cvt_pk_bf16(v0[2], v0[3]); w.z = cvt_pk_bf16(v1[0], v1[1]); w.w = cvt_pk_bf16(v1[2], v1[3]);
                    *(u32x4*)(rowp + bj * HALF) = w; } }
    }
};
template <bool KV> struct EpiDil {
    static constexpr bool PERM = true; static constexpr int NST = 16; static constexpr int PRE = 0; struct Pre {};
    bf16_t* O; float scale;
    __device__ __forceinline__ void operator()(const f32x4 (&acc)[2][2][4][2], const Unit& u, int wr, int wc, int fr, int fq) const {
        const int row0 = u.pm * BM + wr * 64 + fr;
#pragma unroll
        for (int bj = 0; bj < 2; ++bj) { const int col = u.pn * BM + bj * HALF + wc * 32 + 8 * fq;
            const int g = KV ? (col >> 10) : (col >> 9), h = (col >> 6) & 7, d = col & 63, kv = KV ? ((col >> 9) & 1) : 0;
            const int sh = 2 * g;
#pragma unroll
            for (int ai = 0; ai < 2; ++ai)
#pragma unroll
                for (int m = 0; m < 4; ++m) { const int row = row0 + ai * HALF + m * 16, b = row >> 13, t = row & 8191;
                    const int r = t & ((1 << sh) - 1), pos = t >> sh;
                    const size_t rec = (size_t)g * 262144 + (size_t)((((b << sh) + r) * 8 + h) * (8192 >> sh) + pos);
                    bf16_t* dst = KV ? (O + rec * 128 + kv * 64 + d) : (O + rec * 64 + d);
                    const f32x4 v0 = acc[ai][bj][m][0] * scale, v1 = acc[ai][bj][m][1] * scale;
                    u32x4 w; w.x = cvt_pk_bf16(v0[0], v0[1]); w.y = cvt_pk_bf16(v0[2], v0[3]); w.z = cvt_pk_bf16(v1[0], v1[1]); w.w = cvt_pk_bf16(v1[2], v1[3]);
                    *(u32x4*)dst = w; } }
    }
};
}
namespace pg8 {
__device__ __forceinline__ f32x4 i2f(const i32x4& a, float sa, const f32x4& sb) { return (f32x4){(float)a[0], (float)a[1], (float)a[2], (float)a[3]} * sa * sb; }
struct EpiBf16Q {
    static constexpr bool PERM = true; static constexpr int NST = 16; static constexpr int PRE = 0; struct Pre {};
    bf16_t* O; int ldc; const float* sA; const float* sB;
    __device__ __forceinline__ void operator()(const i32x4 (&acc)[2][2][4][2], const Unit& u, int wr, int wc, int fr, int fq) const {
        const int row0 = u.pm * BM + wr * 64 + fr; const int col0 = u.pn * BM + wc * 32 + 8 * fq;
        f32x4 sb[2][2];
#pragma unroll
        for (int bj = 0; bj < 2; ++bj)
#pragma unroll
            for (int n = 0; n < 2; ++n) sb[bj][n] = *(const f32x4*)(sB + col0 + bj * HALF + 4 * n);
#pragma unroll
        for (int ai = 0; ai < 2; ++ai)
#pragma unroll
            for (int m = 0; m < 4; ++m) { const int row = row0 + ai * HALF + m * 16; const float sa = sA[row]; bf16_t* rowp = O + (size_t)row * ldc + col0;
#pragma unroll
                for (int bj = 0; bj < 2; ++bj) { const f32x4 v0 = i2f(acc[ai][bj][m][0], sa, sb[bj][0]), v1 = i2f(acc[ai][bj][m][1], sa, sb[bj][1]);
                    u32x4 w; w.x = cvt_pk_bf16(v0[0], v0[1]); w.y = cvt_pk_bf16(v0[2], v0[3]); w.z = cvt_pk_bf16(v1[0], v1[1]); w.w = cvt_pk_bf16(v1[2], v1[3]);
                    *(u32x4*)(rowp + bj * HALF) = w; } }
    }
};
template <bool KV> struct EpiDilQ {
    static constexpr bool PERM = true; static constexpr int NST = 16; static constexpr int PRE = 12;
    struct Pre { float sa[8]; f32x4 sb[2][2]; };
    bf16_t* O; const float* sA; const float* sB;
    __device__ __forceinline__ void prefetch(Pre& p, const Unit& u, int wr, int wc, int fr, int fq) const {
        const int row0 = u.pm * BM + wr * 64 + fr;
#pragma unroll
        for (int ai = 0; ai < 2; ++ai)
#pragma unroll
            for (int m = 0; m < 4; ++m) p.sa[ai * 4 + m] = sA[row0 + ai * HALF + m * 16];
#pragma unroll
        for (int bj = 0; bj < 2; ++bj) { const int col = u.pn * BM + bj * HALF + wc * 32 + 8 * fq; p.sb[bj][0] = *(const f32x4*)(sB + col); p.sb[bj][1] = *(const f32x4*)(sB + col + 4); }
    }
    __device__ __forceinline__ void operator()(const i32x4 (&acc)[2][2][4][2], const Unit& u, int wr, int wc, int fr, int fq, const Pre& p) const {
        bf16_t* const O_ = O; constexpr float scale_ = KV ? 1.0f : 0.18033688011112042f;
        const int row0 = u.pm * BM + wr * 64 + fr;
        const int colt = u.pn * BM;
        const int g = KV ? (colt >> 10) : (colt >> 9), kv = KV ? ((colt >> 9) & 1) : 0, sh = 2 * g, npos = 8192 >> sh;
        constexpr int RS = KV ? 128 : 64;
        const int d = (wc & 1) * 32 + 8 * fq;
        size_t hoff[2]; f32x4 sb[2][2];
#pragma unroll
        for (int bj = 0; bj < 2; ++bj) { const int col = colt + bj * HALF + wc * 32 + 8 * fq; const int h = (col >> 6) & 7;
            hoff[bj] = (size_t)h * npos * RS + kv * 64 + d; sb[bj][0] = p.sb[bj][0] * scale_; sb[bj][1] = p.sb[bj][1] * scale_; }
#pragma unroll
        for (int ai = 0; ai < 2; ++ai)
#pragma unroll
            for (int m = 0; m < 4; ++m) { const int row = row0 + ai * HALF + m * 16, b = row >> 13, t = row & 8191;
                const int r = t & ((1 << sh) - 1), pos = t >> sh;
                bf16_t* rp = O_ + ((size_t)g * 262144 + (size_t)(((b << sh) + r) * 8 * npos + pos)) * RS;
                const float sa = p.sa[ai * 4 + m];
#pragma unroll
                for (int bj = 0; bj < 2; ++bj) { const f32x4 v0 = i2f(acc[ai][bj][m][0], sa, sb[bj][0]), v1 = i2f(acc[ai][bj][m][1], sa, sb[bj][1]);
                    u32x4 w; w.x = cvt_pk_bf16(v0[0], v0[1]); w.y = cvt_pk_bf16(v0[2], v0[3]); w.z = cvt_pk_bf16(v1[0], v1[1]); w.w = cvt_pk_bf16(v1[2], v1[3]);
                    *(u32x4*)(rp + hoff[bj]) = w; }
                if (m & 1) asm volatile("" ::: "memory"); }
    }
};
constexpr float HSCALE = 8.0f;
__device__ __forceinline__ unsigned pk4_fp8(float a, float b, float c, float d) {
    a = __builtin_fminf(__builtin_fmaxf(a, -448.f), 448.f); b = __builtin_fminf(__builtin_fmaxf(b, -448.f), 448.f); c = __builtin_fminf(__builtin_fmaxf(c, -448.f), 448.f); d = __builtin_fminf(__builtin_fmaxf(d, -448.f), 448.f);
    int w = 0; w = __builtin_amdgcn_cvt_pk_fp8_f32(a, b, w, false); w = __builtin_amdgcn_cvt_pk_fp8_f32(c, d, w, true); return (unsigned)w; }
struct EpiSwiGLUQ {
    static constexpr bool PERM = true; static constexpr int NST = 8; static constexpr int PRE = 12;
    struct Pre { float sa[8]; f32x4 sg0, sg1, su0, su1; };
    unsigned char* O; int ldc; const float* sA; const float* sB; const int* tile_expert;
    __device__ __forceinline__ void prefetch(Pre& p, const Unit& u, int wr, int wc, int fr, int fq) const {
        const int row0 = u.pm * BM + wr * 64 + fr;
        const float* sb = sB + (tile_expert ? (size_t)tile_expert[u.pm] * (2 * 2816) : (size_t)0) + u.pn * BM + wc * 32 + 8 * fq;
#pragma unroll
        for (int ai = 0; ai < 2; ++ai)
#pragma unroll
            for (int m = 0; m < 4; ++m) p.sa[ai * 4 + m] = sA[row0 + ai * HALF + m * 16];
        p.sg0 = *(const f32x4*)sb; p.sg1 = *(const f32x4*)(sb + 4); p.su0 = *(const f32x4*)(sb + HALF); p.su1 = *(const f32x4*)(sb + HALF + 4);
    }
    __device__ __forceinline__ void operator()(const i32x4 (&acc)[2][2][4][2], const Unit& u, int wr, int wc, int fr, int fq, const Pre& p) const {
        const int row0 = u.pm * BM + wr * 64 + fr; const int col0 = u.pn * HALF + wc * 32 + 8 * fq;
        const f32x4 sg0 = p.sg0, sg1 = p.sg1, su0 = p.su0 * HSCALE, su1 = p.su1 * HSCALE;
        typedef unsigned u32x2 __attribute__((ext_vector_type(2)));
#pragma unroll
        for (int ai = 0; ai < 2; ++ai)
#pragma unroll
            for (int m = 0; m < 4; ++m) { const int row = row0 + ai * HALF + m * 16; const float sa = p.sa[ai * 4 + m]; unsigned char* rowp = O + (size_t)row * ldc + col0;
                const f32x4 g0 = i2f(acc[ai][0][m][0], sa, sg0), g1 = i2f(acc[ai][0][m][1], sa, sg1), u0 = i2f(acc[ai][1][m][0], sa, su0), u1 = i2f(acc[ai][1][m][1], sa, su1);
                u32x2 w; w.x = pk4_fp8(silu_mul(g0[0], u0[0]), silu_mul(g0[1], u0[1]), silu_mul(g0[2], u0[2]), silu_mul(g0[3], u0[3]));
                w.y = pk4_fp8(silu_mul(g1[0], u1[0]), silu_mul(g1[1], u1[1]), silu_mul(g1[2], u1[2]), silu_mul(g1[3], u1[3]));
                *(u32x2*)rowp = w; }
    }
};
}
namespace att {
using bf16 = unsigned short;
using bf16x8 = __attribute__((ext_vector_type(8))) short;
using s16x4 = __attribute__((ext_vector_type(4))) short;
using f32x16 = __attribute__((ext_vector_type(16))) float;
using u32x4 = __attribute__((ext_vector_type(4))) unsigned;
constexpr int NW = 8;
constexpr float THR = 8.0f;
__device__ __forceinline__ int crow(int r, int hi) { return (r & 3) + 8 * (r >> 2) + 4 * hi; }
__device__ __forceinline__ void glds16(const void* gsrc, unsigned lds_dst) { unsigned keep;
    asm volatile("s_mov_b32 %0, m0\n\ts_mov_b32 m0, %2\n\ts_nop 0\n\tglobal_load_lds_dwordx4 %1, off\n\ts_mov_b32 m0, %0" : "=&s"(keep) : "v"(gsrc), "s"(lds_dst) : "memory"); }
typedef float f32x2_t __attribute__((ext_vector_type(2))); typedef __bf16 bf16x2_t __attribute__((ext_vector_type(2)));
__device__ __forceinline__ unsigned cvtpk_s(float lo, float hi) { f32x2_t v = {lo, hi}; bf16x2_t b = __builtin_convertvector(v, bf16x2_t); return __builtin_bit_cast(unsigned, b); }
#define ATT_SBAR() __builtin_amdgcn_sched_barrier(0)
#define ATT_WAIT_BAR(N) asm volatile("s_waitcnt vmcnt(" #N ") lgkmcnt(0)\n\ts_barrier" ::: "memory")

template <int DQK> struct Lay {
    static constexpr int NKC = DQK / 8, KSLOT = NKC * 1024, ND0 = DQK / 16;
    static constexpr int LK = 0, LV = 3 * KSLOT, LWS = LV + 3 * 8192, LOST = LWS + NW * 256, LBIAS = LOST + NW * 4096, LEND = LBIAS + 1024;
};
static_assert(Lay<96>::LEND <= 131072 && Lay<64>::LEND <= 131072, "attention LDS");

__device__ __forceinline__ float rowmax32(const f32x16& p0, const f32x16& p1) {
    float a = __builtin_fmaxf(__builtin_fmaxf(p0[0], p0[1]), p1[0]), b = __builtin_fmaxf(__builtin_fmaxf(p0[2], p0[3]), p1[1]); a = __builtin_fmaxf(__builtin_fmaxf(a, p1[2]), p1[3]);
#pragma unroll
    for (int r = 4; r < 16; r += 4) { a = __builtin_fmaxf(__builtin_fmaxf(a, p0[r]), p0[r + 1]); b = __builtin_fmaxf(__builtin_fmaxf(b, p0[r + 2]), p0[r + 3]); a = __builtin_fmaxf(__builtin_fmaxf(a, p1[r]), p1[r + 1]); b = __builtin_fmaxf(__builtin_fmaxf(b, p1[r + 2]), p1[r + 3]); }
    float m = __builtin_fmaxf(a, b);
    auto rr = __builtin_amdgcn_permlane32_swap(__float_as_uint(m), __float_as_uint(m), false, false);
    return __builtin_fmaxf(__uint_as_float(rr[0]), __uint_as_float(rr[1]));
}
__device__ __forceinline__ void pv(f32x16* o, int vb, bf16x8 pa0, bf16x8 pa1, bf16x8 pa2, bf16x8 pa3) {
#pragma unroll
    for (int d0 = 0; d0 < 2; ++d0) { s16x4 lo[4], hi[4];
#pragma unroll
        for (int ks = 0; ks < 4; ++ks) {
            asm volatile("ds_read_b64_tr_b16 %0,%1 offset:%c2" : "=&v"(lo[ks]) : "v"(vb), "i"(d0 * 4096 + ks * 1024) : "memory");
            asm volatile("ds_read_b64_tr_b16 %0,%1 offset:%c2" : "=&v"(hi[ks]) : "v"(vb), "i"(d0 * 4096 + ks * 1024 + 512) : "memory"); }
        asm volatile("s_waitcnt lgkmcnt(0)" ::: "memory"); ATT_SBAR();
#define ATT_PK(k) (bf16x8){lo[k][0], lo[k][1], lo[k][2], lo[k][3], hi[k][0], hi[k][1], hi[k][2], hi[k][3]}
        o[d0] = __builtin_amdgcn_mfma_f32_32x32x16_bf16(pa0, ATT_PK(0), o[d0], 0, 0, 0);
        o[d0] = __builtin_amdgcn_mfma_f32_32x32x16_bf16(pa1, ATT_PK(1), o[d0], 0, 0, 0);
        o[d0] = __builtin_amdgcn_mfma_f32_32x32x16_bf16(pa2, ATT_PK(2), o[d0], 0, 0, 0);
        o[d0] = __builtin_amdgcn_mfma_f32_32x32x16_bf16(pa3, ATT_PK(3), o[d0], 0, 0, 0);
#undef ATT_PK
    }
}

template <int DQK, bool DIL>
__device__ __forceinline__ void attn_unit(const bf16* Qb, int pq, const bf16* __restrict__ Kb, int pk, const bf16* __restrict__ Vb, int pvp, bf16* Ob, int po, float* lse, const float* biasg,
                                          long rowbase, int dil, int q0, char* shm) {
    typedef Lay<DQK> L;
    const int tid = threadIdx.x, lane = tid & 63, r32 = lane & 31, hi = lane >> 5; const int wid = __builtin_amdgcn_readfirstlane(tid >> 6);
    const unsigned lds0 = (unsigned)(uintptr_t)shm;
    float* wsf = (float*)(shm + L::LWS) + wid * 64;
    const int kpos0 = DIL ? q0 - 128 : 0;
    const int t_begin = DIL ? (q0 == 0 ? 2 : 0) : 0;
    const int t_end = DIL ? 6 : (q0 + 256) / 64;
    const int wt0 = DIL ? (wid >> 1) : 0;
    const int wt1 = DIL ? 2 + (wid >> 1) : (q0 + 32 * wid + 31) / 64;
    const bool two_k = (L::NKC > 8) && (wid + 8 < L::NKC);
#define ATT_GROW(pos) (rowbase + (long)(pos) * dil)
#define ATT_ISSUE(t, s) do { const int kp_ = kpos0 + 64 * (t); \
        glds16(Kb + ATT_GROW(kp_ + lane) * pk + wid * 8, (unsigned)__builtin_amdgcn_readfirstlane(lds0 + L::LK + (s) * L::KSLOT + wid * 1024)); \
        if (two_k) glds16(Kb + ATT_GROW(kp_ + lane) * pk + (wid + 8) * 8, (unsigned)__builtin_amdgcn_readfirstlane(lds0 + L::LK + (s) * L::KSLOT + (wid + 8) * 1024)); \
        glds16(Vb + ATT_GROW(kp_ + 16 * (wid & 3) + (lane >> 2)) * pvp + (wid >> 2) * 32 + (lane & 3) * 8, (unsigned)__builtin_amdgcn_readfirstlane(lds0 + L::LV + (s) * 8192 + wid * 1024)); } while (0)
    if (DIL) { if (tid < 129) ((float*)(shm + L::LBIAS))[tid] = biasg[tid]; }
    ATT_ISSUE(t_begin, 0);
    if (t_begin + 1 < t_end) ATT_ISSUE(t_begin + 1, 1);
    bf16x8 qr[L::ND0];
    { const bf16* Qw = Qb + ATT_GROW(q0 + wid * 32 + r32) * pq + hi * 8;
#pragma unroll
      for (int d0 = 0; d0 < L::ND0; ++d0) qr[d0] = *reinterpret_cast<const bf16x8*>(Qw + d0 * 16); }
    float mhat = 0.f, l_reg = 0.f; f32x16 o[2]; o[0] = f32x16{}; o[1] = f32x16{}; f32x16 negm = f32x16{};
    bool first = true;
    const int qrel = (DIL ? 128 : q0) + wid * 32 + r32;
    const int vbl = (int)(lds0 + L::LV) + ((lane >> 4) & 1) * 32 + (lane & 3) * 8 + (4 * hi + ((lane & 15) >> 2)) * 64;
    int slot = 0;
    for (int t = t_begin; t < t_end; ++t) {
        if (t + 1 < t_end) { if (two_k) ATT_WAIT_BAR(3); else ATT_WAIT_BAR(2); } else ATT_WAIT_BAR(0);
        if (t + 2 < t_end) { const int s2 = slot >= 1 ? slot - 1 : 2; ATT_ISSUE(t + 2, s2); }
        if (t >= wt0 && t <= wt1) {
            f32x16 p0, p1;
            { const char* kb = shm + L::LK + slot * L::KSLOT + hi * 1024 + r32 * 16;
#pragma unroll
              for (int d0 = 0; d0 < L::ND0; ++d0) {
                const bf16x8 b0 = *reinterpret_cast<const bf16x8*>(kb + d0 * 2048);
                const bf16x8 b1 = *reinterpret_cast<const bf16x8*>(kb + d0 * 2048 + 512);
                if (d0 == 0) { p0 = __builtin_amdgcn_mfma_f32_32x32x16_bf16(b0, qr[0], negm, 0, 0, 0); p1 = __builtin_amdgcn_mfma_f32_32x32x16_bf16(b1, qr[0], negm, 0, 0, 0); }
                else { p0 = __builtin_amdgcn_mfma_f32_32x32x16_bf16(b0, qr[d0], p0, 0, 0, 0); p1 = __builtin_amdgcn_mfma_f32_32x32x16_bf16(b1, qr[d0], p1, 0, 0, 0); } } }
            if (DIL) { const float* bl = (const float*)(shm + L::LBIAS); const int jb = qrel - 64 * t - 4 * hi;
#pragma unroll
                for (int r = 0; r < 16; ++r) { const int j0 = jb - ((r & 3) + 8 * (r >> 2)), j1 = j0 - 32;
                    const int c0 = j0 < 0 ? 0 : (j0 > 128 ? 128 : j0), c1 = j1 < 0 ? 0 : (j1 > 128 ? 128 : j1);
                    const float b0 = bl[c0], b1 = bl[c1];
                    p0[r] = (j0 >= 0 && j0 <= 128) ? p0[r] + b0 : -INFINITY; p1[r] = (j1 >= 0 && j1 <= 128) ? p1[r] + b1 : -INFINITY; }
            } else if (64 * t + 63 > q0 + 32 * wid) { const int jb = qrel - 64 * t - 4 * hi;
#pragma unroll
                for (int r = 0; r < 16; ++r) { const int j0 = jb - ((r & 3) + 8 * (r >> 2)); if (j0 < 0) p0[r] = -INFINITY; if (j0 - 32 < 0) p1[r] = -INFINITY; } }
            const float rm = rowmax32(p0, p1);
            if (first) { first = false; const float dl = rm; mhat += dl;
#pragma unroll
                for (int r = 0; r < 16; ++r) { p0[r] -= dl; p1[r] -= dl; }
#pragma unroll
                for (int r = 0; r < 16; ++r) negm[r] = -mhat;
            } else if (__any(rm > THR)) { const float dl = __builtin_fmaxf(rm, 0.f); mhat += dl;
#pragma unroll
                for (int r = 0; r < 16; ++r) { p0[r] -= dl; p1[r] -= dl; }
#pragma unroll
                for (int r = 0; r < 16; ++r) negm[r] = -mhat;
                const float f = __builtin_amdgcn_exp2f(-dl); l_reg *= f; if (hi == 0) wsf[r32] = f;
                asm volatile("s_waitcnt lgkmcnt(0)" ::: "memory");
#pragma unroll
                for (int d_ = 0; d_ < 2; ++d_)
#pragma unroll
                    for (int r = 0; r < 16; ++r) o[d_][r] *= wsf[crow(r, hi)];
                asm volatile("s_waitcnt lgkmcnt(0)" ::: "memory");
            }
            float sacc = 0.f;
#pragma unroll
            for (int r = 0; r < 16; ++r) { p0[r] = __builtin_amdgcn_exp2f(p0[r]); p1[r] = __builtin_amdgcn_exp2f(p1[r]); sacc += p0[r] + p1[r]; }
            l_reg += sacc;
            u32x4 pw0, pw1, pw2, pw3;
#define ATT_PKW(P, B) cvtpk_s(P[B], P[B + 1])
            pw0 = (u32x4){ATT_PKW(p0, 0), ATT_PKW(p0, 2), ATT_PKW(p0, 4), ATT_PKW(p0, 6)}; pw1 = (u32x4){ATT_PKW(p0, 8), ATT_PKW(p0, 10), ATT_PKW(p0, 12), ATT_PKW(p0, 14)};
            pw2 = (u32x4){ATT_PKW(p1, 0), ATT_PKW(p1, 2), ATT_PKW(p1, 4), ATT_PKW(p1, 6)}; pw3 = (u32x4){ATT_PKW(p1, 8), ATT_PKW(p1, 10), ATT_PKW(p1, 12), ATT_PKW(p1, 14)};
#undef ATT_PKW
            ATT_SBAR();
            pv(o, vbl + slot * 8192, __builtin_bit_cast(bf16x8, pw0), __builtin_bit_cast(bf16x8, pw1), __builtin_bit_cast(bf16x8, pw2), __builtin_bit_cast(bf16x8, pw3));
        }
        slot = slot == 2 ? 0 : slot + 1;
    }
    { auto rr = __builtin_amdgcn_permlane32_swap(__float_as_uint(l_reg), __float_as_uint(l_reg), false, false); l_reg = __uint_as_float(rr[0]) + __uint_as_float(rr[1]); }
    if (hi == 0) wsf[32 + r32] = l_reg;
    asm volatile("s_waitcnt lgkmcnt(0)" ::: "memory");
    float rli[16];
#pragma unroll
    for (int r = 0; r < 16; ++r) rli[r] = __builtin_amdgcn_rcpf(wsf[32 + crow(r, hi)]);
    if (DIL) { if (hi == 0) lse[ATT_GROW(q0 + wid * 32 + r32) * 8] = mhat + __builtin_amdgcn_logf(l_reg); }
    { bf16* stg = (bf16*)(shm + L::LOST) + wid * 2048;
#pragma unroll
      for (int r = 0; r < 16; ++r) { const int orow = crow(r, hi);
#pragma unroll
        for (int d0 = 0; d0 < 2; ++d0) stg[orow * 64 + d0 * 32 + r32] = (bf16)(cvtpk_s(o[d0][r] * rli[r], 0.f) & 0xffffu); }
      asm volatile("s_waitcnt lgkmcnt(0)" ::: "memory");
#pragma unroll
      for (int i = 0; i < 4; ++i) { const int row = i * 8 + (lane >> 3), ch = lane & 7; const u32x4 v = *(const u32x4*)(stg + row * 64 + ch * 8);
        *(u32x4*)(Ob + ATT_GROW(q0 + wid * 32 + row) * po + ch * 8) = v; } }
    asm volatile("s_waitcnt lgkmcnt(0)\n\ts_barrier" ::: "memory");
#undef ATT_GROW
#undef ATT_ISSUE
}
#undef ATT_SBAR
#undef ATT_WAIT_BAR
}
namespace mla {
using bf16 = unsigned short;
using bf16x8 = __attribute__((ext_vector_type(8))) short;
using s16x4 = __attribute__((ext_vector_type(4))) short;
using f32x16 = __attribute__((ext_vector_type(16))) float;
using u32x4 = __attribute__((ext_vector_type(4))) unsigned;
constexpr int SEQL = 8192, PQ = 1536, PV = 1024, HQ = 96, HV = 64;
constexpr int NW = 8, QBLK = 32, QB = QBLK * NW, KVBLK = 64;
__device__ __forceinline__ int crow(int r, int hi) { return (r & 3) + 8 * (r >> 2) + 4 * hi; }
#define SBAR() __builtin_amdgcn_sched_barrier(0)
__device__ __forceinline__ void cmask(f32x16& p0, f32x16& p1, int jb, int qrel, int hi) {
    const float NEG = -INFINITY; int kb = 64 * jb + 4 * hi;
#pragma unroll
    for (int r = 0; r < 16; ++r) { int kv = kb + (r & 3) + 8 * (r >> 2); if (kv > qrel) p0[r] = NEG; if (kv + 32 > qrel) p1[r] = NEG; }
}
constexpr int NSLOT = 3, KSLOTB = 12288, VSLOTB = 8192;
constexpr int LDS_K = 0, LDS_V = NSLOT * KSLOTB, LDS_WS = LDS_V + NSLOT * VSLOTB, LDS_OST = LDS_WS + NW * 64 * 4, LDS_BYTES = LDS_OST + NW * 4096;
static_assert(LDS_BYTES <= 131072, "mla attention LDS");
__device__ __forceinline__ void glds16(const void* gsrc, unsigned lds_dst) { unsigned keep;
    asm volatile("s_mov_b32 %0, m0\n\ts_mov_b32 m0, %2\n\ts_nop 0\n\tglobal_load_lds_dwordx4 %1, off\n\ts_mov_b32 m0, %0" : "=&s"(keep) : "v"(gsrc), "s"(lds_dst) : "memory"); }
__device__ __forceinline__ float max3f(float a, float b, float c) { float r; asm("v_max3_f32 %0, %1, %2, %3" : "=v"(r) : "v"(a), "v"(b), "v"(c)); return r; }
__device__ __forceinline__ float max2f(float a, float b) { float r; asm("v_max_f32_e32 %0, %1, %2" : "=v"(r) : "v"(a), "v"(b)); return r; }
__device__ __forceinline__ float fadd_s(float a, float b) { float r; asm("v_add_f32_e32 %0, %1, %2" : "=v"(r) : "v"(a), "v"(b)); return r; }
__device__ __forceinline__ float fsub_s(float a, float b) { float r; asm("v_sub_f32_e32 %0, %1, %2" : "=v"(r) : "v"(a), "v"(b)); return r; }
typedef float f32x2_t __attribute__((ext_vector_type(2))); typedef __bf16 bf16x2_t __attribute__((ext_vector_type(2)));
__device__ __forceinline__ unsigned cvtpk_s(float lo, float hi) { f32x2_t v = {lo, hi}; bf16x2_t b = __builtin_convertvector(v, bf16x2_t); return __builtin_bit_cast(unsigned, b); }
#define WAIT_BAR(N) asm volatile("s_waitcnt vmcnt(" #N ") lgkmcnt(0)\n\ts_barrier" ::: "memory")

__device__ __forceinline__ void qkt(f32x16& p0, f32x16& p1, const char* Kslot, const bf16x8* qr, const f32x16& negm, int r32, int hi) {
    const char* kb = Kslot + hi * 1024 + r32 * 16;
#pragma unroll
    for (int d0 = 0; d0 < 6; ++d0) {
        const bf16x8 b0 = *reinterpret_cast<const bf16x8*>(kb + d0 * 2048);
        const bf16x8 b1 = *reinterpret_cast<const bf16x8*>(kb + d0 * 2048 + 512);
        if (d0 == 0) { p0 = __builtin_amdgcn_mfma_f32_32x32x16_bf16(b0, qr[0], negm, 0, 0, 0); p1 = __builtin_amdgcn_mfma_f32_32x32x16_bf16(b1, qr[0], negm, 0, 0, 0); }
        else { p0 = __builtin_amdgcn_mfma_f32_32x32x16_bf16(b0, qr[d0], p0, 0, 0, 0); p1 = __builtin_amdgcn_mfma_f32_32x32x16_bf16(b1, qr[d0], p1, 0, 0, 0); } }
}
typedef __attribute__((address_space(3))) const char* lds_cptr;
typedef short v4i16_t __attribute__((ext_vector_type(4)));
__device__ __forceinline__ void kload12(bf16x8* kf, lds_cptr kp) {
#pragma unroll
    for (int j = 0; j < 6; ++j) { kf[2 * j] = *(const __attribute__((address_space(3))) bf16x8*)(kp + j * 2048); kf[2 * j + 1] = *(const __attribute__((address_space(3))) bf16x8*)(kp + j * 2048 + 512); }
}
__device__ __forceinline__ void kload2(bf16x8* kf, lds_cptr kp, int j) { kf[2 * j] = *(const __attribute__((address_space(3))) bf16x8*)(kp + j * 2048); kf[2 * j + 1] = *(const __attribute__((address_space(3))) bf16x8*)(kp + j * 2048 + 512); }
__device__ __forceinline__ s16x4 vtr(lds_cptr p) { return __builtin_bit_cast(s16x4, __builtin_amdgcn_ds_read_tr16_b64_v4i16((__attribute__((address_space(3))) v4i16_t*)p)); }
__device__ __forceinline__ float rowmax(const f32x16& p0, const f32x16& p1) {
    float a = max3f(p0[0], p0[1], p1[0]), b = max3f(p0[2], p0[3], p1[1]); a = max3f(a, p1[2], p1[3]);
#pragma unroll
    for (int r = 4; r < 16; r += 4) { a = max3f(a, p0[r], p0[r + 1]); b = max3f(b, p0[r + 2], p0[r + 3]); a = max3f(a, p1[r], p1[r + 1]); b = max3f(b, p1[r + 2], p1[r + 3]); }
    const float m = max2f(a, b);
    auto rr = __builtin_amdgcn_permlane32_swap(__float_as_uint(m), __float_as_uint(m), false, false);
    return max2f(__uint_as_float(rr[0]), __uint_as_float(rr[1]));
}
__device__ __forceinline__ void pv(f32x16* o, int vb, bf16x8 pa0, bf16x8 pa1, bf16x8 pa2, bf16x8 pa3) {
#pragma unroll
    for (int d0 = 0; d0 < 2; ++d0) { s16x4 lo[4], hi[4];
#pragma unroll
        for (int ks = 0; ks < 4; ++ks) {
            asm volatile("ds_read_b64_tr_b16 %0,%1 offset:%c2" : "=&v"(lo[ks]) : "v"(vb), "i"(d0 * 4096 + ks * 1024) : "memory");
            asm volatile("ds_read_b64_tr_b16 %0,%1 offset:%c2" : "=&v"(hi[ks]) : "v"(vb), "i"(d0 * 4096 + ks * 1024 + 512) : "memory"); }
        asm volatile("s_waitcnt lgkmcnt(0)" ::: "memory"); SBAR();
#define PK(k) (bf16x8){lo[k][0], lo[k][1], lo[k][2], lo[k][3], hi[k][0], hi[k][1], hi[k][2], hi[k][3]}
        o[d0] = __builtin_amdgcn_mfma_f32_32x32x16_bf16(pa0, PK(0), o[d0], 0, 0, 0);
        o[d0] = __builtin_amdgcn_mfma_f32_32x32x16_bf16(pa1, PK(1), o[d0], 0, 0, 0);
        o[d0] = __builtin_amdgcn_mfma_f32_32x32x16_bf16(pa2, PK(2), o[d0], 0, 0, 0);
        o[d0] = __builtin_amdgcn_mfma_f32_32x32x16_bf16(pa3, PK(3), o[d0], 0, 0, 0);
#undef PK
    }
}

constexpr float OSCALE = 32.0f;
template <int THRL> __device__ __forceinline__ void attn_unit(int b, int h, int qb, const bf16* Q, const bf16* __restrict__ K, const bf16* __restrict__ V, unsigned char* O, char* shm) {
    int tid_ = threadIdx.x; asm volatile("" : "+v"(tid_));
    const int tid = tid_, lane = tid & 63, r32 = lane & 31, hi = lane >> 5; const int wid = __builtin_amdgcn_readfirstlane(tid >> 6);
    const long rowbase = (long)b * SEQL; const int q0 = qb * QB;
    const bf16* Qw = Q + (rowbase + q0 + wid * QBLK) * PQ + h * HQ;
    const bf16* Kh = K + rowbase * PQ + h * HQ; const bf16* Vh = V + rowbase * PV + h * HV;
    const unsigned lds0 = (unsigned)(uintptr_t)shm;
    float* wsf = (float*)(shm + LDS_WS) + wid * 64;
    const bool k2 = wid < 4;
    const bf16* ksrc = Kh + (long)lane * PQ + wid * 8;
    const bf16* vsrc = Vh + (long)(16 * (wid & 3) + (lane >> 2)) * PV + (wid >> 2) * 32 + (lane & 3) * 8;
    const unsigned kdst = lds0 + LDS_K + wid * 1024, vdst = lds0 + LDS_V + wid * 1024;
#define DMA_K(t, slot) do { glds16(ksrc + (long)(t) * KVBLK * PQ, (unsigned)__builtin_amdgcn_readfirstlane(kdst + (slot))); \
        if (k2) glds16(ksrc + (long)(t) * KVBLK * PQ + 64, (unsigned)__builtin_amdgcn_readfirstlane(kdst + (slot) + 8192)); } while (0)
#define DMA_V(t, slot) glds16(vsrc + (long)(t) * KVBLK * PV, (unsigned)__builtin_amdgcn_readfirstlane(vdst + (slot)))
    const int vb0 = (int)(lds0 + LDS_V) + ((lane >> 4) & 1) * 32 + (lane & 3) * 8 + (4 * hi + ((lane & 15) >> 2)) * 64;
    const char* Kbase = shm + LDS_K; bf16x8 kf[12];
    const lds_cptr shm3 = (lds_cptr)shm; const lds_cptr kp0 = shm3 + LDS_K + hi * 1024 + r32 * 16; const lds_cptr vp0 = shm3 + LDS_V + ((lane >> 4) & 1) * 32 + (lane & 3) * 8 + (4 * hi + ((lane & 15) >> 2)) * 64;
    const int NT = (q0 + QB) / KVBLK;
#define WAIT_KV() do { if (k2) WAIT_BAR(3); else WAIT_BAR(2); } while (0)
#define WAIT_KKV() do { if (k2) WAIT_BAR(5); else WAIT_BAR(3); } while (0)
    DMA_K(0, 0); DMA_V(0, 0); DMA_K(1, KSLOTB);
    bf16x8 qr[6];
#pragma unroll
    for (int d0 = 0; d0 < 6; ++d0) qr[d0] = *reinterpret_cast<const bf16x8*>(&Qw[(long)r32 * PQ + d0 * 16 + hi * 8]);
    float mhat = 0.f, l_reg = 0.f; f32x16 o[2]; o[0] = f32x16{}; o[1] = f32x16{}; f32x16 negm = f32x16{}; asm volatile("" : "+v"(negm));
    const int qrel = wid * QBLK + r32;
#define CMASK(P0, P1, t) do { int jb_ = (t) - (NT - 4); if (jb_ >= 0) cmask(P0, P1, jb_, qrel, hi); } while (0)
    bool resc = false;
#define START(P0, P1) do { const float rm = rowmax(P0, P1); resc = false; \
    { const float dl = rm; mhat = fadd_s(mhat, dl); \
      _Pragma("unroll") for (int r = 0; r < 16; ++r) { P0[r] = fsub_s(P0[r], dl); P1[r] = fsub_s(P1[r], dl); } \
      _Pragma("unroll") for (int r = 0; r < 16; ++r) negm[r] = -mhat; asm volatile("" : "+v"(negm)); } \
    _Pragma("unroll") for (int r = 0; r < 16; ++r) P0[r] = __builtin_amdgcn_exp2f(P0[r]); } while (0)
#define RESC() do { if (resc) { asm volatile("s_waitcnt lgkmcnt(0)" ::: "memory"); \
      _Pragma("unroll") for (int d_ = 0; d_ < 2; ++d_) _Pragma("unroll") for (int r = 0; r < 16; ++r) o[d_][r] *= wsf[crow(r, hi)]; } } while (0)
    f32x16 pA0, pA1, pB0, pB1;
    int sl_prev = 0, sl_cur = 0, sl_next = 1;
#define ROT() do { sl_prev = sl_cur; sl_cur = sl_next; sl_next = (sl_next == NSLOT - 1) ? 0 : sl_next + 1; } while (0)
    DMA_K(2, 2 * KSLOTB);
    WAIT_KKV();
    qkt(pA0, pA1, Kbase, qr, negm, r32, hi); asm volatile("s_nop 15\n\ts_nop 7" : "+v"(pA0), "+v"(pA1)); CMASK(pA0, pA1, 0);
    START(pA0, pA1);
#pragma unroll
    for (int r = 0; r < 16; ++r) pA1[r] = __builtin_amdgcn_exp2f(pA1[r]);
    WAIT_BAR(0);
    DMA_K(3, 0); DMA_V(1, VSLOTB);
    ROT();
    kload12(kf, kp0 + sl_cur * KSLOTB);
    WAIT_KV();
    s16x4 vlo[8], vhi[8]; u32x4 pw0, pw1, pw2, pw3;
#define PKW(P, B) cvtpk_s(P[B], P[B + 1])
#define PAF(k) __builtin_bit_cast(bf16x8, pw##k)
#define VFR(i) (bf16x8){vlo[i][0], vlo[i][1], vlo[i][2], vlo[i][3], vhi[i][0], vhi[i][1], vhi[i][2], vhi[i][3]}
#define PIN(x) asm volatile("" : "+v"(x))
#define MX3(a, b, c) __builtin_fmaxf(__builtin_fmaxf((a), (b)), (c))
#define GAPA(MF, A0, A1, A2, A3, W0, W1, PW) do { MF; sacc += A0; sacc += A1; sacc += A2; sacc += A3; PIN(sacc); W0; W1; PIN(PW); SBAR(); } while (0)
#define GAPM(MF) do { MF; SBAR(); } while (0)
#define EX(v) __builtin_amdgcn_exp2f(v)
#define GAPB(MF, X, B) do { MF; X[B] = EX(X[B]); X[B + 1] = EX(X[B + 1]); X[B + 2] = EX(X[B + 2]); X[B + 3] = EX(X[B + 3]); PIN(X); SBAR(); } while (0)
#define VRD(i) do { vlo[i] = vtr(vp_ + (((i) >> 2) * 4096 + ((i) & 3) * 1024)); vhi[i] = vtr(vp_ + (((i) >> 2) * 4096 + ((i) & 3) * 1024 + 512)); } while (0)
#define KRD(G, j) do { if (G) { kload2(kf, kp0 + sl_next * KSLOTB, j); SBAR(); } } while (0)
#define MF32(a, b, c) __builtin_amdgcn_mfma_f32_32x32x16_bf16(a, b, c, 0, 0, 0)
#define STEP(C0, C1, P0, P1, t, GK, GV, GL) do { SBAR(); \
    const lds_cptr vp_ = vp0 + sl_prev * VSLOTB; \
    float sacc = (P0[0] + P0[1]); \
    GAPA(C0 = MF32(kf[0], qr[0], negm), P0[2], P0[3], P0[4], P0[5],     pw0[0] = PKW(P0, 0), pw0[1] = PKW(P0, 2), pw0); \
    GAPA(C1 = MF32(kf[1], qr[0], negm), P0[6], P0[7], P0[8], P0[9],     pw0[2] = PKW(P0, 4), pw0[3] = PKW(P0, 6), pw0); \
    GAPA(C0 = MF32(kf[2], qr[1], C0),   P0[10], P0[11], P0[12], P0[13], pw1[0] = PKW(P0, 8), pw1[1] = PKW(P0, 10), pw1); \
    GAPA(C1 = MF32(kf[3], qr[1], C1),   P0[14], P0[15], P1[0], P1[1],   pw1[2] = PKW(P0, 12), pw1[3] = PKW(P0, 14), pw1); \
    VRD(0); SBAR(); GAPA(C0 = MF32(kf[4], qr[2], C0),   P1[2], P1[3], P1[4], P1[5],     pw2[0] = PKW(P1, 0), pw2[1] = PKW(P1, 2), pw2); \
    VRD(4); SBAR(); GAPA(C1 = MF32(kf[5], qr[2], C1),   P1[6], P1[7], P1[8], P1[9],     pw2[2] = PKW(P1, 4), pw2[3] = PKW(P1, 6), pw2); \
    VRD(1); SBAR(); GAPA(C0 = MF32(kf[6], qr[3], C0),   P1[10], P1[11], P1[12], P1[13], pw3[0] = PKW(P1, 8), pw3[1] = PKW(P1, 10), pw3); \
    VRD(5); SBAR(); GAPA(C1 = MF32(kf[7], qr[3], C1),   P1[14], P1[15], 0.f, 0.f,       pw3[2] = PKW(P1, 12), pw3[3] = PKW(P1, 14), pw3); \
    VRD(2); SBAR(); GAPM(C0 = MF32(kf[8], qr[4], C0)); VRD(6); SBAR(); GAPM(C1 = MF32(kf[9], qr[4], C1)); \
    VRD(3); SBAR(); GAPM(C0 = MF32(kf[10], qr[5], C0)); VRD(7); SBAR(); GAPM(C1 = MF32(kf[11], qr[5], C1)); \
    l_reg += sacc; \
    if (GK) { DMA_K((t) + 3, sl_cur * KSLOTB); } if (GV) { DMA_V((t) + 1, sl_next * VSLOTB); } \
    CMASK(C0, C1, t); \
    { float a = MX3(C0[0], C0[1], C1[0]), b = MX3(C0[2], C0[3], C1[1]); a = MX3(a, C1[2], C1[3]); \
      _Pragma("unroll") for (int r = 4; r < 16; r += 4) { a = MX3(a, C0[r], C0[r + 1]); b = MX3(b, C0[r + 2], C0[r + 3]); a = MX3(a, C1[r], C1[r + 1]); b = MX3(b, C1[r + 2], C1[r + 3]); } \
      float rm = __builtin_fmaxf(a, b); { auto rr = __builtin_amdgcn_permlane32_swap(__float_as_uint(rm), __float_as_uint(rm), false, false); rm = __builtin_fmaxf(__uint_as_float(rr[0]), __uint_as_float(rr[1])); } \
      resc = false; \
      if (__builtin_expect(__any(rm > (float)THRL), 0)) { const float dl = __builtin_fmaxf(rm, 0.f); mhat += dl; \
        _Pragma("unroll") for (int r = 0; r < 16; ++r) { C0[r] -= dl; C1[r] -= dl; } \
        _Pragma("unroll") for (int r = 0; r < 16; ++r) negm[r] = -mhat; asm volatile("" : "+v"(negm)); \
        const float f = __builtin_amdgcn_exp2f(-dl); l_reg *= f; if (hi == 0) wsf[r32] = f; resc = true; } } \
    SBAR(); \
    GAPB(o[0] = MF32(PAF(0), VFR(0), o[0]), C0, 0); \
    KRD(GL, 0); GAPB(o[1] = MF32(PAF(0), VFR(4), o[1]), C0, 4); \
    KRD(GL, 1); GAPB(o[0] = MF32(PAF(1), VFR(1), o[0]), C0, 8); \
    KRD(GL, 2); GAPB(o[1] = MF32(PAF(1), VFR(5), o[1]), C0, 12); \
    KRD(GL, 3); GAPB(o[0] = MF32(PAF(2), VFR(2), o[0]), C1, 0); \
    KRD(GL, 4); GAPB(o[1] = MF32(PAF(2), VFR(6), o[1]), C1, 4); \
    KRD(GL, 5); GAPB(o[0] = MF32(PAF(3), VFR(3), o[0]), C1, 8); \
    GAPB(o[1] = MF32(PAF(3), VFR(7), o[1]), C1, 12); \
    } while (0)
    int t = 1;
#undef CMASK
#define CMASK(P0, P1, t) do { } while (0)
    for (; t + 5 < NT; t += 2) {
        STEP(pB0, pB1, pA0, pA1, t, true, true, true);     WAIT_KV(); RESC(); ROT();
        STEP(pA0, pA1, pB0, pB1, t + 1, true, true, true); WAIT_KV(); RESC(); ROT();
    }
#undef CMASK
#define CMASK(P0, P1, t) do { int jb_ = (t) - (NT - 4); if (jb_ >= 0) cmask(P0, P1, jb_, qrel, hi); } while (0)
#define ENDW(tt) do { if ((tt) + 3 < NT) { WAIT_KV(); } else if ((tt) + 2 < NT) { WAIT_BAR(1); } else { WAIT_BAR(0); } } while (0)
    for (; t + 1 < NT; t += 2) {
        STEP(pB0, pB1, pA0, pA1, t, (t + 3 < NT), (t + 1 < NT), (t + 1 < NT));         ENDW(t);     RESC(); ROT();
        STEP(pA0, pA1, pB0, pB1, t + 1, (t + 4 < NT), (t + 2 < NT), (t + 2 < NT));     ENDW(t + 1); RESC(); ROT();
    }
    STEP(pB0, pB1, pA0, pA1, NT - 1, false, false, false); RESC();
    { float sacc = pB0[0] + pB0[1];
#pragma unroll
      for (int r = 2; r < 16; ++r) sacc += pB0[r];
#pragma unroll
      for (int r = 0; r < 16; ++r) sacc += pB1[r];
      l_reg += sacc;
      pw0 = (u32x4){PKW(pB0, 0), PKW(pB0, 2), PKW(pB0, 4), PKW(pB0, 6)}; pw1 = (u32x4){PKW(pB0, 8), PKW(pB0, 10), PKW(pB0, 12), PKW(pB0, 14)}; pw2 = (u32x4){PKW(pB1, 0), PKW(pB1, 2), PKW(pB1, 4), PKW(pB1, 6)}; pw3 = (u32x4){PKW(pB1, 8), PKW(pB1, 10), PKW(pB1, 12), PKW(pB1, 14)};
      SBAR(); pv(o, vb0 + sl_cur * VSLOTB, PAF(0), PAF(1), PAF(2), PAF(3)); }
#undef PKW
#undef PAF
#undef VFR
#undef PIN
#undef MX3
#undef GAPA
#undef GAPM
#undef GAPB
#undef EX
#undef VRD
#undef KRD
#undef MF32
#undef STEP
#undef ENDW
    { auto rr = __builtin_amdgcn_permlane32_swap(__float_as_uint(l_reg), __float_as_uint(l_reg), false, false); l_reg = __uint_as_float(rr[0]) + __uint_as_float(rr[1]); }
    if (hi == 0) wsf[32 + r32] = l_reg; asm volatile("s_waitcnt lgkmcnt(0)" ::: "memory");
    float rli[16];
#pragma unroll
    for (int r = 0; r < 16; ++r) rli[r] = __builtin_amdgcn_rcpf(wsf[32 + crow(r, hi)]);
    unsigned char* Ow = O + (rowbase + q0 + wid * QBLK) * PV + h * HV;
    { unsigned char* stg = (unsigned char*)(shm + LDS_OST) + wid * 2048;
#pragma unroll
      for (int r = 0; r < 16; ++r) { const int orow = crow(r, hi); const float sc = rli[r] * OSCALE;
        const float a = __builtin_fminf(__builtin_fmaxf(o[0][r] * sc, -448.f), 448.f), c = __builtin_fminf(__builtin_fmaxf(o[1][r] * sc, -448.f), 448.f);
        const unsigned w = (unsigned)__builtin_amdgcn_cvt_pk_fp8_f32(a, c, 0, false);
        stg[orow * 64 + r32] = (unsigned char)(w & 0xffu); stg[orow * 64 + 32 + r32] = (unsigned char)((w >> 8) & 0xffu); }
      asm volatile("s_waitcnt lgkmcnt(0)" ::: "memory");
#pragma unroll
      for (int i = 0; i < 2; ++i) { const int row = i * 16 + (lane >> 2), ch = lane & 3; const u32x4 v = *(const u32x4*)(stg + row * 64 + ch * 16); *(u32x4*)(Ow + (long)row * PV + ch * 16) = v; } }
    asm volatile("s_waitcnt lgkmcnt(0)\n\ts_barrier" ::: "memory");
#undef DMA_K
#undef DMA_V
#undef CMASK
#undef START
#undef RESC
#undef ROT
#undef WAIT_KV
#undef WAIT_KKV
}
#undef SBAR
#undef WAIT_BAR
}
namespace dila {
using bf16 = unsigned short;
using bf16x8 = __attribute__((ext_vector_type(8))) short;
using f32x16 = __attribute__((ext_vector_type(16))) float;
using u32x4 = __attribute__((ext_vector_type(4))) unsigned;
constexpr int NW = 8, SEQL = 8192, PQ = 1536, PKV = 3072, PO = 512, MROWS = 4 * SEQL;
constexpr int L_K = 0, L_V = 6 * 8192, L_WQ = 12 * 8192, L_WO = L_WQ + NW * 4096, L_WSF = L_WO + NW * 2048, L_BIAS = L_WSF + NW * 256, L_END = L_BIAS + 3 * 288 * 4;
constexpr float THR = 8.0f;
#define DIL_WAIT_BAR(N) asm volatile("s_waitcnt vmcnt(" #N ") lgkmcnt(0)\n\ts_barrier" ::: "memory")
struct UnitP { int sb, oo, lo, rowbase, dil, q0, g; };
__device__ __forceinline__ UnitP decode(int j, int h) {
    const int x = j & 31, bg = j >> 5; const int g = bg % 3, b = bg / 3;
    const int sh = 2 * g, dil = 1 << sh; const int r = x & (dil - 1), qb = x >> sh;
    UnitP p; p.sb = g * 262144 + ((b * dil + r) * 8 + h) * (SEQL >> sh); p.oo = g * MROWS * PO + h * 64; p.lo = g * MROWS * 8 + h;
    p.rowbase = b * SEQL + r; p.dil = dil; p.q0 = qb * 256; p.g = g; return p;
}

__device__ __forceinline__ void dil_phase(const bf16* QB, const bf16* KV, bf16* OG, float* LSE, const float* BT, char* shm, int G) {
    int tid_ = threadIdx.x; asm volatile("" : "+v"(tid_));
    const int tid = tid_, lane = tid & 63, r32 = lane & 31, hi = lane >> 5; const int wid = __builtin_amdgcn_readfirstlane(tid >> 6);
    const unsigned lds0 = (unsigned)(uintptr_t)shm;
    float* wsf = (float*)(shm + L_WSF) + wid * 64;
    char* wq = shm + L_WQ + wid * 4096;
    char* wo = shm + L_WO + wid * 2048;
    const int wt0 = wid >> 1, wt1 = 2 + (wid >> 1);
    const int G8 = G & ~7, c = (int)blockIdx.x;
    if (c >= G8) return;
    const int h = c & 7, j0 = c >> 3, jstep = G8 >> 3;
    const int NU = (384 - j0 + jstep - 1) / jstep;
    for (int i = tid; i < 3 * 288; i += NW * 64) ((float*)(shm + L_BIAS))[i] = BT[((i / 288) * 8 + h) * 288 + (i % 288)];
#define DIL_GROW(P, pos) ((long)((P).rowbase + (pos) * (P).dil))
#define DIL_ISSUE_TILE(P, t) do { int kp_ = (P).q0 - 128 + 64 * (t); if (kp_ < 0) kp_ = 0; \
        att::glds16(KV + (size_t)((P).sb + kp_ + lane) * 128 + wid * 8, (unsigned)__builtin_amdgcn_readfirstlane(lds0 + L_K + (t) * 8192 + wid * 1024)); \
        att::glds16(KV + (size_t)((P).sb + kp_ + 16 * (wid & 3) + (lane >> 2)) * 128 + 64 + (wid >> 2) * 32 + (lane & 3) * 8, (unsigned)__builtin_amdgcn_readfirstlane(lds0 + L_V + (t) * 8192 + wid * 1024)); } while (0)
#define DIL_ISSUE_Q(P) do { _Pragma("unroll") for (int j_ = 0; j_ < 4; ++j_) \
        att::glds16(QB + (size_t)((P).sb + (P).q0 + wid * 32 + 8 * j_ + (lane >> 3)) * 64 + (lane & 7) * 8, (unsigned)__builtin_amdgcn_readfirstlane(lds0 + L_WQ + wid * 4096 + j_ * 1024)); } while (0)
    if (NU <= 0) return;
    UnitP cur = decode(j0, h), nxt = cur;
    asm volatile("s_waitcnt vmcnt(0) lgkmcnt(0)\n\ts_barrier" ::: "memory");
    DIL_ISSUE_Q(cur); DIL_ISSUE_TILE(cur, 0); DIL_ISSUE_TILE(cur, 5); DIL_ISSUE_TILE(cur, 1); DIL_ISSUE_TILE(cur, 4);
    bf16x8 qr[4]; float mhat = 0.f, l_reg = 0.f; f32x16 o[2]; o[0] = f32x16{}; o[1] = f32x16{}; f32x16 negm = f32x16{}; bool first = true;
    const int vbl = (int)(lds0 + L_V) + ((lane >> 4) & 1) * 32 + (lane & 3) * 8 + (4 * hi + ((lane & 15) >> 2)) * 64;
    for (int ui = 0; ui < NU; ++ui) {
        const bool has_next = ui + 1 < NU;
        if (has_next) nxt = decode(j0 + (ui + 1) * jstep, h);
        const int tb = cur.q0 == 0 ? 2 : 0;
        const float* bl0 = (const float*)(shm + L_BIAS) + cur.g * 288 + (191 - (128 + 32 * (wid & 1) + r32 - 4 * hi));
#pragma unroll 1
        for (int k = 0; k < 3; ++k) {
            if (k < 2) DIL_WAIT_BAR(0); else DIL_WAIT_BAR(8);
            if (k == 0) { DIL_ISSUE_TILE(cur, 2); DIL_ISSUE_TILE(cur, 3); }
            else if (has_next) { if (k == 1) { DIL_ISSUE_Q(nxt); DIL_ISSUE_TILE(nxt, 0); DIL_ISSUE_TILE(nxt, 5); } else { DIL_ISSUE_TILE(nxt, 1); DIL_ISSUE_TILE(nxt, 4); } }
            const int t = wid < 4 ? wt0 + k : wt1 - k;
            if (k == 0) {
#pragma unroll
                for (int d0 = 0; d0 < 4; ++d0) qr[d0] = *reinterpret_cast<const bf16x8*>(wq + r32 * 128 + d0 * 32 + hi * 16);
                mhat = 0.f; l_reg = 0.f; o[0] = f32x16{}; o[1] = f32x16{}; negm = f32x16{}; first = true;
            }
            if (t >= tb) {
                f32x16 p0, p1;
                { const char* kb = shm + L_K + t * 8192 + hi * 1024 + r32 * 16;
#pragma unroll
                  for (int d0 = 0; d0 < 4; ++d0) {
                    const bf16x8 b0 = *reinterpret_cast<const bf16x8*>(kb + d0 * 2048);
                    const bf16x8 b1 = *reinterpret_cast<const bf16x8*>(kb + d0 * 2048 + 512);
                    if (d0 == 0) { p0 = __builtin_amdgcn_mfma_f32_32x32x16_bf16(b0, qr[0], negm, 0, 0, 0); p1 = __builtin_amdgcn_mfma_f32_32x32x16_bf16(b1, qr[0], negm, 0, 0, 0); }
                    else { p0 = __builtin_amdgcn_mfma_f32_32x32x16_bf16(b0, qr[d0], p0, 0, 0, 0); p1 = __builtin_amdgcn_mfma_f32_32x32x16_bf16(b1, qr[d0], p1, 0, 0, 0); } } }
                { const float* bl = bl0 + 64 * (t - wt0);
                  float bv0[16], bv1[16];
#pragma unroll
                  for (int r = 0; r < 16; ++r) { bv0[r] = bl[(r & 3) + 8 * (r >> 2)]; bv1[r] = bl[(r & 3) + 8 * (r >> 2) + 32]; }
#pragma unroll
                  for (int r = 0; r < 16; ++r) { p0[r] += bv0[r]; p1[r] += bv1[r]; } }
                const float rm = att::rowmax32(p0, p1);
                if (first) { first = false; const float dl = rm; mhat += dl;
#pragma unroll
                    for (int r = 0; r < 16; ++r) { p0[r] -= dl; p1[r] -= dl; }
#pragma unroll
                    for (int r = 0; r < 16; ++r) negm[r] = -mhat;
                } else if (__any(rm > THR)) { const float dl = __builtin_fmaxf(rm, 0.f); mhat += dl;
#pragma unroll
                    for (int r = 0; r < 16; ++r) { p0[r] -= dl; p1[r] -= dl; }
#pragma unroll
                    for (int r = 0; r < 16; ++r) negm[r] = -mhat;
                    const float f = __builtin_amdgcn_exp2f(-dl); l_reg *= f; if (hi == 0) wsf[r32] = f;
                    asm volatile("s_waitcnt lgkmcnt(0)" ::: "memory");
#pragma unroll
                    for (int d_ = 0; d_ < 2; ++d_)
#pragma unroll
                        for (int r = 0; r < 16; ++r) o[d_][r] *= wsf[att::crow(r, hi)];
                    asm volatile("s_waitcnt lgkmcnt(0)" ::: "memory");
                }
                float sacc = 0.f;
#pragma unroll
                for (int r = 0; r < 16; ++r) { p0[r] = __builtin_amdgcn_exp2f(p0[r]); p1[r] = __builtin_amdgcn_exp2f(p1[r]); sacc += p0[r] + p1[r]; }
                l_reg += sacc;
                u32x4 pw0, pw1, pw2, pw3;
#define DIL_PKW(P, B) att::cvtpk_s(P[B], P[B + 1])
                pw0 = (u32x4){DIL_PKW(p0, 0), DIL_PKW(p0, 2), DIL_PKW(p0, 4), DIL_PKW(p0, 6)}; pw1 = (u32x4){DIL_PKW(p0, 8), DIL_PKW(p0, 10), DIL_PKW(p0, 12), DIL_PKW(p0, 14)};
                pw2 = (u32x4){DIL_PKW(p1, 0), DIL_PKW(p1, 2), DIL_PKW(p1, 4), DIL_PKW(p1, 6)}; pw3 = (u32x4){DIL_PKW(p1, 8), DIL_PKW(p1, 10), DIL_PKW(p1, 12), DIL_PKW(p1, 14)};
#undef DIL_PKW
                __builtin_amdgcn_sched_barrier(0);
                att::pv(o, vbl + t * 8192, __builtin_bit_cast(bf16x8, pw0), __builtin_bit_cast(bf16x8, pw1), __builtin_bit_cast(bf16x8, pw2), __builtin_bit_cast(bf16x8, pw3));
            }
            if (k == 2) {
                { auto rr = __builtin_amdgcn_permlane32_swap(__float_as_uint(l_reg), __float_as_uint(l_reg), false, false); l_reg = __uint_as_float(rr[0]) + __uint_as_float(rr[1]); }
                if (hi == 0) wsf[32 + r32] = l_reg;
                asm volatile("s_waitcnt lgkmcnt(0)" ::: "memory");
                float rli[16];
#pragma unroll
                for (int r = 0; r < 16; ++r) rli[r] = __builtin_amdgcn_rcpf(wsf[32 + att::crow(r, hi)]);
                if (hi == 0) LSE[cur.lo + DIL_GROW(cur, cur.q0 + wid * 32 + r32) * 8] = mhat + __builtin_amdgcn_logf(l_reg);
                bf16* stg = (bf16*)wo;
#pragma unroll
                for (int d0 = 0; d0 < 2; ++d0) {
#pragma unroll
                    for (int r = 0; r < 16; ++r) stg[att::crow(r, hi) * 32 + r32] = (bf16)(att::cvtpk_s(o[d0][r] * rli[r], 0.f) & 0xffffu);
                    asm volatile("s_waitcnt lgkmcnt(0)" ::: "memory");
#pragma unroll
                    for (int i = 0; i < 2; ++i) { const int row = i * 16 + (lane >> 2), ch = lane & 3; const u32x4 v = *(const u32x4*)(stg + row * 32 + ch * 8);
                        *(u32x4*)(OG + cur.oo + DIL_GROW(cur, cur.q0 + wid * 32 + row) * PO + d0 * 32 + ch * 8) = v; }
                    asm volatile("s_waitcnt lgkmcnt(0)" ::: "memory"); }
            }
        }
        cur = nxt;
    }
    asm volatile("s_waitcnt vmcnt(0) lgkmcnt(0)\n\ts_barrier" ::: "memory");
#undef DIL_GROW
#undef DIL_ISSUE_TILE
#undef DIL_ISSUE_Q
}
#undef DIL_WAIT_BAR
}
constexpr int NWAVES = 8;
constexpr int BATCH = 4, SEQ = 8192, D = 1024, M = BATCH * SEQ;
constexpr int MLA_H = 16, QRANK = 384, KVRANK = 256, LATN = 672, LATP = 768, QUP = 1536, KVUP = 2048;
constexpr int DFF = 2816, NEXP = 8, DILQ = 1536, DILKV = 3072, DILOUT = 512;
constexpr int MAXSLOT = 67584;
constexpr float EPS = 1e-6f;
constexpr float C2_MLA = 0.1472444460259031f;
constexpr float C2_DIL = 0.18033688011112042f;
constexpr float LOG2E_F = 1.4426950408889634f;

constexpr size_t MiB = 1u << 20;
constexpr size_t WS_CTL = 0, CTL_ZERO_BYTES = 64 * 1024;
constexpr size_t WS_MODV = 1 * MiB;
constexpr size_t WS_BIAS = 1 * MiB + 256 * 1024;
constexpr size_t WS_ROUTE = 1 * MiB + 512 * 1024;
constexpr size_t WS_CNT = 2 * MiB;
constexpr size_t WS_LIST = 2 * MiB + 256 * 1024;
constexpr size_t WS_SLOTG = 2 * MiB + 768 * 1024;
constexpr size_t WS_TOKSLOT = 3 * MiB + 256 * 1024;
constexpr size_t WS_TILEEXP = 3 * MiB + 512 * 1024;
constexpr size_t WS_SLOTXS = 3 * MiB + 516 * 1024;
constexpr size_t WS_CS = 4 * MiB;
constexpr size_t WS_LSE = 8 * MiB;
constexpr size_t WS_SB = 11 * MiB;
constexpr size_t SB_LAT = 0, SB_FGU = 768, SB_KVB = 768 + 5632, SB_QB = SB_KVB + 3072, SB_EGU = SB_QB + 1536, SB_FDN = SB_EGU + 8 * 5632, SB_EDN = SB_FDN + 1024, SB_OUT = SB_EDN + 8 * 1024, SB_OB = SB_OUT + 1024, SB_END = SB_OB + 1024;
constexpr size_t WS_XS = 11 * MiB + 512 * 1024, WS_XSKV = 11 * MiB + 768 * 1024;
constexpr size_t WS_WEGU = 12 * MiB, WS_WEDN = 100 * MiB, WS_WFGU = 144 * MiB, WS_WFDN = 155 * MiB, WS_WKVB = 161 * MiB, WS_WQB = 167 * MiB, WS_WOUT = 170 * MiB,
                 WS_WOB = 172 * MiB, WS_WMLAIN = 173 * MiB, WS_WQUP = 175 * MiB, WS_WKVUP = 177 * MiB;
constexpr size_t WS_ARENA = 180 * MiB;
constexpr size_t A_XN = WS_ARENA, A_LAT = WS_ARENA + 64 * MiB, A_QN = WS_ARENA + 112 * MiB, A_KVN = WS_ARENA + 136 * MiB, A_Q = WS_ARENA + 152 * MiB, A_K = WS_ARENA + 248 * MiB,
                 A_V = WS_ARENA + 344 * MiB, A_O = WS_ARENA + 408 * MiB, A_HID = WS_ARENA + 64 * MiB, A_XNKV = WS_ARENA + 64 * MiB, A_KVB = WS_ARENA + 128 * MiB, A_QB = WS_ARENA + 320 * MiB,
                 A_OG = WS_ARENA, A_OD = WS_ARENA + 128 * MiB, A_HIDS = WS_ARENA + 160 * MiB, A_Y = WS_ARENA;
constexpr size_t WS_END = WS_ARENA + 523 * MiB;
static_assert(A_HIDS + (size_t)MAXSLOT * DFF * 2 <= WS_END && A_Y + (size_t)MAXSLOT * D * 2 <= A_HIDS && A_O + (size_t)M * D * 2 <= WS_END, "arena map");
static_assert(WS_WEGU + (size_t)NEXP * 2 * DFF * D * 2 <= WS_WEDN && WS_WEDN + (size_t)NEXP * D * DFF * 2 <= WS_WFGU && WS_WFGU + (size_t)2 * DFF * D * 2 <= WS_WFDN && WS_WFDN + (size_t)D * DFF * 2 <= WS_WKVB, "weight map");
enum ModKind { MK_A_MIX0 = 0, MK_B_MIX0, MK_G_MIX0, MK_A_FFN0, MK_B_FFN0, MK_G_FFN0, MK_A_MIX1, MK_B_MIX1, MK_G_MIX1, MK_A_FFN1, MK_B_FFN1, MK_G_FFN1, MK_A_KV, MK_B_KV };
constexpr int CW_BAR = 4096;
constexpr int CW_RANK = 8192;

constexpr int RING_BYTES = 131072;
constexpr int LDS_BYTES = 163840;
constexpr int LDSCTL_OFF = LDS_BYTES - 1024, MISC_OFF = LDSCTL_OFF + 320;

#define GAS __attribute__((address_space(1)))
#define LAS __attribute__((address_space(3)))
typedef unsigned short bf16;
typedef signed char i8;
typedef unsigned v4u __attribute__((ext_vector_type(4)));
typedef unsigned v2u __attribute__((ext_vector_type(2)));
typedef float f32x4 __attribute__((ext_vector_type(4)));
typedef GAS unsigned gu32;
#define RLX_AGENT __ATOMIC_RELAXED, __HIP_MEMORY_SCOPE_AGENT
#define LDS_WAIT() asm volatile("s_waitcnt lgkmcnt(0)" ::: "memory")
#define VM_WAIT() asm volatile("s_waitcnt vmcnt(0)" ::: "memory")
__device__ __forceinline__ unsigned f2bf(float f) { unsigned u = __builtin_bit_cast(unsigned, f); return (u + 0x7fffu + ((u >> 16) & 1u)) >> 16; }
__device__ __forceinline__ unsigned pk2(float lo, float hi) { return f2bf(lo) | (f2bf(hi) << 16); }
__device__ __forceinline__ float bf_lo(unsigned w) { return __builtin_bit_cast(float, w << 16); }
__device__ __forceinline__ float bf_hi(unsigned w) { return __builtin_bit_cast(float, w & 0xffff0000u); }
__device__ __forceinline__ float wave_sum(float v) {
#pragma unroll
    for (int o = 1; o < 64; o <<= 1) v += __shfl_xor(v, o);
    return v;
}

#define XB_TMO      128
#define XB_XCNT(j)  (256  + 64 * (j))
#define XB_XSUB(j)  (1280 + 64 * (j))
#define XB_XGEN(j)  (2304 + 64 * (j))
#define XB_TOP      3328
#define XB_TOPGEN   3392
#define XCD_BAR_WORDS 3456
#define XB_SPIN_CAP (1u << 18)
__device__ __forceinline__ unsigned xb_ld(unsigned* p)              { return __hip_atomic_load(p, __ATOMIC_RELAXED, __HIP_MEMORY_SCOPE_AGENT); }
__device__ __forceinline__ unsigned xb_add(unsigned* p, unsigned v) { return __hip_atomic_fetch_add(p, v, __ATOMIC_RELAXED, __HIP_MEMORY_SCOPE_AGENT); }
__device__ __forceinline__ unsigned xb_xcc_id() { return (unsigned)__builtin_amdgcn_s_getreg((3 << 11) | 20) & 0xFu; }
#define XB_SPIN(cond, bar) do { unsigned _sp = 0; while (cond) { __builtin_amdgcn_s_sleep(1); \
    if ((++_sp & 255u) == 0u) { if (xb_ld(&(bar)[XB_TMO])) break; if (_sp > XB_SPIN_CAP) { atomicAdd(&(bar)[XB_TMO], 1u); break; } } } } while (0)
struct XcdBarrier { unsigned* bar; unsigned x; volatile LAS unsigned* st; };
__device__ __forceinline__ XcdBarrier xcd_barrier_post(unsigned* bar, volatile LAS unsigned* st) {
    XcdBarrier b; b.bar = bar; b.x = xb_xcc_id(); b.st = st;
    if (threadIdx.x == 0) (void)xb_add(&bar[XB_XCNT(b.x)], 1u);
    return b;
}
__device__ __forceinline__ void xcd_barrier_complete(unsigned* bar, unsigned x, unsigned& nloc, unsigned& nx) {
    const unsigned G = gridDim.x * gridDim.y * gridDim.z;
    unsigned sum, cnt, mine, sp = 0u;
    for (;;) {
        sum = 0u; cnt = 0u; mine = 0u;
#pragma unroll
        for (unsigned j = 0; j < 16; ++j) { const unsigned c = xb_ld(&bar[XB_XCNT(j)]); sum += c; cnt += (c > 0u) ? 1u : 0u; mine = (j == x) ? c : mine; }
        if (sum == G) break;
        __builtin_amdgcn_s_sleep(1);
        if ((++sp & 255u) == 0u) { if (xb_ld(&bar[XB_TMO])) break; if (sp > XB_SPIN_CAP) { atomicAdd(&bar[XB_TMO], 1u); break; } }
    }
    nloc = mine > 0u ? mine : 1u; nx = cnt > 0u ? cnt : 1u;
}
__device__ __forceinline__ void xcd_barrier(const XcdBarrier& b) {
    asm volatile("s_waitcnt vmcnt(0)" ::: "memory");
    __syncthreads();
    if (threadIdx.x == 0) {
        unsigned* bar = b.bar;
        __builtin_amdgcn_s_waitcnt(0);
        unsigned nloc = b.st[0], nx = b.st[1];
        if (nloc == 0u) { xcd_barrier_complete(bar, b.x, nloc, nx); b.st[0] = nloc; b.st[1] = nx; }
        const unsigned old = xb_add(&bar[XB_XSUB(b.x)], 1u);
        const unsigned gen = old / nloc;
        if (old + 1u == (gen + 1u) * nloc) {
            __builtin_amdgcn_fence(__ATOMIC_RELEASE, "agent");
            asm volatile("s_waitcnt vmcnt(0)" ::: "memory");
            const unsigned og = xb_add(&bar[XB_TOP], 1u);
            const unsigned tg = og / nx;
            if (og + 1u == (tg + 1u) * nx) xb_add(&bar[XB_TOPGEN], 1u);
            else XB_SPIN(xb_ld(&bar[XB_TOPGEN]) == tg, bar);
            __builtin_amdgcn_fence(__ATOMIC_ACQUIRE, "agent");
            xb_add(&bar[XB_XGEN(b.x)], 1u);
            asm volatile("s_waitcnt vmcnt(0)" ::: "memory");
        } else {
            XB_SPIN(xb_ld(&bar[XB_XGEN(b.x)]) == gen, bar);
            __builtin_amdgcn_fence(__ATOMIC_ACQUIRE, "agent");
            asm volatile("s_waitcnt vmcnt(0)" ::: "memory");
        }
    }
    __syncthreads();
}

struct Frame {
    LAS unsigned char* lds;
    volatile LAS unsigned* MISC;
    int tid, lane, wave;
    int vcu, G;
    unsigned char* ws;
    const float* in[26];
    float* out;
};
enum { MAP_PLAIN = 0, MAP_MLAIN = 1, MAP_QUP = 2, MAP_GU = 3 };
template <int MAP> __device__ __forceinline__ int dmap(int n) {
    if (MAP == MAP_MLAIN) { if (n < 640) return n; if (n < 656) return 640 + 2 * (n - 640); return 640 + 2 * (n - 656) + 1; }
    if (MAP == MAP_QUP) { const int h = n / 96, j = n % 96; if (j < 64) return n; if (j < 80) return h * 96 + 64 + 2 * (j - 64); return h * 96 + 64 + 2 * (j - 80) + 1; }
    if (MAP == MAP_GU) { const int up = n >= DFF ? 1 : 0; const int c = up ? n - DFF : n; return (c >> 7) * 256 + up * 128 + (c & 127); }
    return n;
}
template <int MAP> __device__ __forceinline__ void transpose_item(const float* W, int K, int N, bf16* WT, const float* ks, LAS float* scr, int item, int lane) {
    const int nblk = N / 32, kb = item / nblk, nb = item % nblk, k0 = 64 * kb, n0 = 32 * nb;
    float v[32];
    const float* src = W + (size_t)(k0 + (lane >> 5)) * N + n0 + (lane & 31);
#pragma unroll
    for (int i = 0; i < 32; ++i) v[i] = __builtin_nontemporal_load(src + (size_t)(2 * i) * N);
    if (ks) {
#pragma unroll
        for (int i = 0; i < 32; ++i) v[i] *= ks[k0 + 2 * i + (lane >> 5)]; }
#pragma unroll
    for (int i = 0; i < 32; ++i) scr[(2 * i + (lane >> 5)) * 33 + (lane & 31)] = v[i];
    LDS_WAIT(); asm volatile("" ::: "memory");
    const int c = lane & 7;
#pragma unroll
    for (int j = 0; j < 4; ++j) { const int n = (lane >> 3) + 8 * j; const LAS float* s = scr + (8 * c) * 33 + n;
        v4u o; o.x = pk2(s[0 * 33], s[1 * 33]); o.y = pk2(s[2 * 33], s[3 * 33]); o.z = pk2(s[4 * 33], s[5 * 33]); o.w = pk2(s[6 * 33], s[7 * 33]);
        *(GAS v4u*)(WT + (size_t)dmap<MAP>(n0 + n) * K + k0 + 8 * c) = o; }
    LDS_WAIT(); asm volatile("" ::: "memory");
}
__device__ __forceinline__ float wave_max(float v) {
#pragma unroll
    for (int o = 1; o < 64; o <<= 1) v = fmaxf(v, __shfl_xor(v, o));
    return v;
}
__device__ __forceinline__ float amax8(const f32x4& a, const f32x4& b) { return fmaxf(fmaxf(fmaxf(fabsf(a.x), fabsf(a.y)), fmaxf(fabsf(a.z), fabsf(a.w))), fmaxf(fmaxf(fabsf(b.x), fabsf(b.y)), fmaxf(fabsf(b.z), fabsf(b.w)))); }
__device__ __forceinline__ unsigned q4(const f32x4& a, float inv) { const int q0 = (int)__builtin_rintf(a.x * inv), q1 = (int)__builtin_rintf(a.y * inv), q2 = (int)__builtin_rintf(a.z * inv), q3 = (int)__builtin_rintf(a.w * inv);
    return ((unsigned)q0 & 0xffu) | (((unsigned)q1 & 0xffu) << 8) | (((unsigned)q2 & 0xffu) << 16) | (((unsigned)q3 & 0xffu) << 24); }
template <int MAP, int FMT, int NC>
__device__ __forceinline__ void wg_quant_item(Frame& F, const float* W, int K, int N, unsigned char* WT, float* SB, float post, int item) {
    LAS unsigned short* T = (LAS unsigned short*)F.lds;
    LAS float* cmx = (LAS float*)(F.lds + 147456);
    const int PK = K + 8, n0 = NC * item;
    constexpr int RPI = 64 / NC;
    const int c = F.lane & (NC - 1), rp = F.lane / NC;
    const int kw = K / 8, kbeg = F.wave * kw;
    const float* src = W + (size_t)(kbeg + rp) * N + n0 + c;
    float mx = 0.f;
    for (int kk = 0; kk < kw; kk += 32 * RPI) {
        float v[32];
#pragma unroll
        for (int i = 0; i < 32; ++i) { const int k = kk + i * RPI; v[i] = (k < kw) ? __builtin_nontemporal_load(src + (size_t)k * N) : 0.f; }
#pragma unroll
        for (int i = 0; i < 32; ++i) { const int k = kk + i * RPI; mx = fmaxf(mx, fabsf(v[i])); if (k < kw) T[c * PK + kbeg + rp + k] = (unsigned short)f2bf(v[i]); }
    }
#pragma unroll
    for (int o = NC; o < 64; o <<= 1) mx = fmaxf(mx, __shfl_xor(mx, o));
    if (F.lane < NC) cmx[F.wave * 32 + F.lane] = mx;
    __syncthreads();
    if (F.tid < NC) { float m = 0.f;
#pragma unroll
        for (int w = 0; w < 8; ++w) m = fmaxf(m, cmx[w * 32 + F.tid]);
        cmx[256 + F.tid] = m; SB[dmap<MAP>(n0 + F.tid)] = m > 0.f ? (FMT == 1 ? m * (1.0f / 127.0f) : m * (1.0f / 256.0f) * post) : 1.0f; }
    __syncthreads();
    const int nch = K / 8;
    for (int id = F.tid; id < NC * nch; id += NWAVES * 64) { const int cc = id / nch, kc = id % nch;
        const float m = cmx[256 + cc]; const float inv = m > 0.f ? (FMT == 1 ? 127.0f : 256.0f) / m : 0.f;
        const v4u w = *(const LAS v4u*)(T + cc * PK + 8 * kc);
        const f32x4 lo = (f32x4){bf_lo(w.x), bf_hi(w.x), bf_lo(w.y), bf_hi(w.y)} * inv, hi = (f32x4){bf_lo(w.z), bf_hi(w.z), bf_lo(w.w), bf_hi(w.w)} * inv;
        v2u o; if (FMT == 1) o = (v2u){q4(lo, 1.0f), q4(hi, 1.0f)}; else o = (v2u){pg8::pk4_fp8(lo.x, lo.y, lo.z, lo.w), pg8::pk4_fp8(hi.x, hi.y, hi.z, hi.w)};
        *(GAS v2u*)(WT + (size_t)dmap<MAP>(n0 + cc) * K + 8 * kc) = o; }
    __syncthreads();
}
__device__ __constant__ double INVF_D[16] = {1.0, 0.5623413251903491, 0.31622776601683794, 0.1778279410038923, 0.09999999999999999, 0.056234132519034905, 0.03162277660168379, 0.01778279410038923,
    0.01, 0.005623413251903491, 0.0031622776601683794, 0.0017782794100389228, 0.001, 0.000562341325190349, 0.00031622776601683794, 0.0001778279410038923};
__device__ __constant__ int RPB_TH[15] = {22, 30, 40, 54, 73, 99, 134, 182, 246, 332, 450, 609, 825, 1117, 1513};

__device__ __forceinline__ void p0_prologue(Frame& F) {
    const int gw = F.vcu * NWAVES + F.wave, NGW = F.G * NWAVES;
    const int gtid = F.vcu * (NWAVES * 64) + F.tid, NGT = F.G * NWAVES * 64;
    float* MODV = (float*)(F.ws + WS_MODV);
    {
        LAS float* cact = (LAS float*)F.lds;
        LAS float* red = (LAS float*)(F.lds + 16384);
        const float* cin = F.in[1];
        for (int i = F.tid; i < 4096; i += NWAVES * 64) { const int b = i >> 10, k = i & 1023; const float x = cin[i]; cact[k * 4 + b] = x / (1.0f + expf(-x)); }
        __syncthreads();
        constexpr int NTASK = (6 * D * 2 + 2 * D) / 64;
        for (int task = F.vcu; task < NTASK; task += F.G) {
            const int gc = task * 64 + F.lane;
            const float* W; int ldw, cc; const float* bias;
            if (gc < 6 * D) { W = F.in[5]; ldw = 6 * D; cc = gc; bias = F.in[6]; }
            else if (gc < 12 * D) { W = F.in[5] + (size_t)D * 6 * D; ldw = 6 * D; cc = gc - 6 * D; bias = F.in[6] + 6 * D; }
            else { W = F.in[14]; ldw = 2 * D; cc = gc - 12 * D; bias = F.in[15]; }
            float a0 = 0.f, a1 = 0.f, a2 = 0.f, a3 = 0.f;
            const int kbeg = F.wave * 128;
#pragma unroll 16
            for (int k = 0; k < 128; ++k) { const float w = W[(size_t)(kbeg + k) * ldw + cc]; const f32x4 ca = *(const LAS f32x4*)(cact + (kbeg + k) * 4);
                a0 += w * ca[0]; a1 += w * ca[1]; a2 += w * ca[2]; a3 += w * ca[3]; }
            red[(F.wave * 4 + 0) * 64 + F.lane] = a0; red[(F.wave * 4 + 1) * 64 + F.lane] = a1; red[(F.wave * 4 + 2) * 64 + F.lane] = a2; red[(F.wave * 4 + 3) * 64 + F.lane] = a3;
            __syncthreads();
            if (F.wave < 4) { const int b = F.wave; float s = 0.f;
#pragma unroll
                for (int w = 0; w < 8; ++w) s += red[(w * 4 + b) * 64 + F.lane];
                s += bias[cc];
                int kind; float val = s; const int j = cc & 1023, ch = cc >> 10;
                if (gc < 12 * D) { const int Lr = gc < 6 * D ? 0 : 1;
                    if (ch == 0) kind = 6 * Lr + 1; else if (ch == 1) { kind = 6 * Lr + 0; val = F.in[3][Lr * D + j] * (1.0f + s); } else if (ch == 2) kind = 6 * Lr + 2;
                    else if (ch == 3) kind = 6 * Lr + 4; else if (ch == 4) { kind = 6 * Lr + 3; val = F.in[4][Lr * D + j] * (1.0f + s); } else kind = 6 * Lr + 5;
                } else { if (ch == 0) kind = MK_B_KV; else { kind = MK_A_KV; val = F.in[13][j] * (1.0f + s); } }
                MODV[((size_t)kind * 4 + b) * D + j] = val; }
            __syncthreads();
        }
        __syncthreads();
    }
    {
        float* const SB = (float*)(F.ws + WS_SB);
        constexpr float POSTH = 1.0f / pg8::HSCALE, POSTO = 1.0f / mla::OSCALE;
        constexpr int W_EDN = NEXP * (D / 16), W_FDN = D / 16, W_EGU = NEXP * (2 * DFF / 32), W_FGU = 2 * DFF / 32, W_KVB = DILKV / 32, W_QB = DILQ / 32, W_MLAIN = LATN / 32, W_OUT = D / 32, W_OB = D / 32;
        constexpr int NWG = W_EDN + W_FDN + W_EGU + W_FGU + W_KVB + W_QB + W_MLAIN + W_OUT + W_OB;
        for (int it = F.vcu; it < NWG; it += F.G) { int r = it;
            if (r < W_EDN) { const int e = r / (D / 16); wg_quant_item<MAP_PLAIN, 2, 16>(F, F.in[24] + (size_t)e * DFF * D, DFF, D, F.ws + WS_WEDN + (size_t)e * D * DFF, SB + SB_EDN + (size_t)e * D, POSTH, r % (D / 16)); continue; } r -= W_EDN;
            if (r < W_FDN) { wg_quant_item<MAP_PLAIN, 2, 16>(F, F.in[21], DFF, D, F.ws + WS_WFDN, SB + SB_FDN, POSTH, r); continue; } r -= W_FDN;
            if (r < W_EGU) { const int e = r / W_FGU; wg_quant_item<MAP_GU, 1, 32>(F, F.in[23] + (size_t)e * D * 2 * DFF, D, 2 * DFF, F.ws + WS_WEGU + (size_t)e * 2 * DFF * D, SB + SB_EGU + (size_t)e * 2 * DFF, 1.f, r % W_FGU); continue; } r -= W_EGU;
            if (r < W_FGU) { wg_quant_item<MAP_GU, 1, 32>(F, F.in[20], D, 2 * DFF, F.ws + WS_WFGU, SB + SB_FGU, 1.f, r); continue; } r -= W_FGU;
            if (r < W_KVB) { wg_quant_item<MAP_PLAIN, 1, 32>(F, F.in[16], D, DILKV, F.ws + WS_WKVB, SB + SB_KVB, 1.f, r); continue; } r -= W_KVB;
            if (r < W_QB) { wg_quant_item<MAP_PLAIN, 1, 32>(F, F.in[18], D, DILQ, F.ws + WS_WQB, SB + SB_QB, 1.f, r); continue; } r -= W_QB;
            if (r < W_MLAIN) { wg_quant_item<MAP_MLAIN, 1, 32>(F, F.in[7], D, LATN, F.ws + WS_WMLAIN, SB + SB_LAT, 1.f, r); continue; } r -= W_MLAIN;
            if (r < W_OUT) { wg_quant_item<MAP_PLAIN, 2, 32>(F, F.in[12], D, D, F.ws + WS_WOUT, SB + SB_OUT, POSTO, r); continue; } r -= W_OUT;
            wg_quant_item<MAP_PLAIN, 2, 32>(F, F.in[19], DILOUT, D, F.ws + WS_WOB, SB + SB_OB, POSTO, r);
        }
        LAS float* scr = (LAS float*)(F.lds + F.wave * 8704);
        constexpr int I_QUP = (QRANK / 64) * (QUP / 32), I_KVUP = (KVRANK / 64) * (KVUP / 32);
        for (int it = gw; it < I_QUP + I_KVUP; it += NGW) {
            if (it < I_QUP) transpose_item<MAP_QUP>(F.in[9], QRANK, QUP, (bf16*)(F.ws + WS_WQUP), F.in[8], scr, it, F.lane);
            else transpose_item<MAP_PLAIN>(F.in[11], KVRANK, KVUP, (bf16*)(F.ws + WS_WKVUP), F.in[10], scr, it - I_QUP, F.lane); }
        __syncthreads();
    }
    {
        v4u* padz = (v4u*)(F.ws + WS_WMLAIN + (size_t)LATN * D);
        for (int i = gtid; i < (LATP - LATN) * D / 16; i += NGT) padz[i] = (v4u){0u, 0u, 0u, 0u};
        for (int i = gtid; i < LATP - LATN; i += NGT) ((float*)(F.ws + WS_SB))[SB_LAT + LATN + i] = 1.0f;
        const int* pos = (const int*)F.in[2];
        float* cs = (float*)(F.ws + WS_CS);
        for (int i = gtid; i < M * 16; i += NGT) { const int row = i >> 4, k = i & 15;
            const double x = (double)pos[row] * INVF_D[k]; const double rev = x * 0.15915494309189535; const float fr = (float)(rev - __builtin_rint(rev));
            cs[(size_t)i * 2] = __builtin_amdgcn_cosf(fr); cs[(size_t)i * 2 + 1] = __builtin_amdgcn_sinf(fr); }
        const float* rpb = F.in[17];
        float* bt = (float*)(F.ws + WS_BIAS);
        for (int i = gtid; i < 24 * 288; i += NGT) { const int gh = i / 288, ii = i % 288, j = 191 - ii, g = gh >> 3; const int d = j * (g == 0 ? 1 : (g == 1 ? 4 : 16));
            float val = -INFINITY;
            if (j >= 0 && j <= 128) { int bk; if (d < 16) bk = d; else { bk = 16;
#pragma unroll
                for (int q = 0; q < 15; ++q) bk += (d >= RPB_TH[q]) ? 1 : 0; }
                val = rpb[bk * 24 + gh] * LOG2E_F; }
            bt[i] = val; }
    }
}

constexpr int HPITCH = 2048;
__device__ __forceinline__ void ld8_f32(const float* p, f32x4& a, f32x4& b) { a = *(const f32x4*)p; b = *(const f32x4*)(p + 4); }
__device__ __forceinline__ void ld8_bf16(const bf16* p, f32x4& a, f32x4& b) { const v4u w = *(const GAS v4u*)p; a = (f32x4){bf_lo(w.x), bf_hi(w.x), bf_lo(w.y), bf_hi(w.y)}; b = (f32x4){bf_lo(w.z), bf_hi(w.z), bf_lo(w.w), bf_hi(w.w)}; }
__device__ __forceinline__ float ssq8(const f32x4& a, const f32x4& b) { return ((a.x * a.x + a.y * a.y) + (a.z * a.z + a.w * a.w)) + ((b.x * b.x + b.y * b.y) + (b.z * b.z + b.w * b.w)); }
__device__ __forceinline__ v4u pk8(const f32x4& a, const f32x4& b) { return (v4u){pk2(a.x, a.y), pk2(a.z, a.w), pk2(b.x, b.y), pk2(b.z, b.w)}; }
__device__ __forceinline__ void quant_row(const f32x4 (&y)[2][2], i8* orow, float* srow, int lane) {
    const float mx = wave_max(fmaxf(amax8(y[0][0], y[0][1]), amax8(y[1][0], y[1][1])));
    const float sc = mx > 0.f ? mx * (1.0f / 127.0f) : 1.0f, inv = mx > 0.f ? 127.0f / mx : 0.f;
#pragma unroll
    for (int j = 0; j < 2; ++j) *(GAS v2u*)(orow + 8 * lane + 512 * j) = (v2u){q4(y[j][0], inv), q4(y[j][1], inv)};
    if (lane == 0) *srow = sc;
}
template <bool DUAL, bool INF32>
__device__ __forceinline__ void norm_phase(Frame& F, const void* Hin, const float* A0, const float* B0, i8* O0, float* S0, const float* A1, const float* B1, i8* O1, float* S1) {
    const int gw = F.vcu * NWAVES + F.wave, NGW = F.G * NWAVES;
    for (int c = gw; c < M / 16; c += NGW) {
        const int row0 = c * 16, b = row0 / SEQ;
        f32x4 a0[2][2], b0[2][2], a1[2][2], b1[2][2];
#pragma unroll
        for (int j = 0; j < 2; ++j) { const int co = b * D + 8 * F.lane + 512 * j; ld8_f32(A0 + co, a0[j][0], a0[j][1]); ld8_f32(B0 + co, b0[j][0], b0[j][1]);
            if (DUAL) { ld8_f32(A1 + co, a1[j][0], a1[j][1]); ld8_f32(B1 + co, b1[j][0], b1[j][1]); } }
#pragma unroll 2
        for (int i = 0; i < 16; ++i) { const size_t row = (size_t)(row0 + i);
            f32x4 v[2][2]; float s = 0.f;
#pragma unroll
            for (int j = 0; j < 2; ++j) { if (INF32) ld8_f32((const float*)Hin + row * D + 8 * F.lane + 512 * j, v[j][0], v[j][1]); else ld8_bf16((const bf16*)Hin + row * HPITCH + 8 * F.lane + 512 * j, v[j][0], v[j][1]);
                s += ssq8(v[j][0], v[j][1]); }
            const float rstd = 1.0f / sqrtf(wave_sum(s) * (1.f / D) + EPS);
            f32x4 y[2][2];
#pragma unroll
            for (int j = 0; j < 2; ++j) { y[j][0] = v[j][0] * rstd * a0[j][0] + b0[j][0]; y[j][1] = v[j][1] * rstd * a0[j][1] + b0[j][1]; }
            quant_row(y, O0 + row * D, S0 + row, F.lane);
            if (DUAL) {
#pragma unroll
                for (int j = 0; j < 2; ++j) { y[j][0] = v[j][0] * rstd * a1[j][0] + b1[j][0]; y[j][1] = v[j][1] * rstd * a1[j][1] + b1[j][1]; }
                quant_row(y, O1 + row * D, S1 + row, F.lane); }
        }
    }
}

__device__ __forceinline__ void latnorm_phase(Frame& F) {
    const int gw = F.vcu * NWAVES + F.wave, NGW = F.G * NWAVES;
    const bf16* LAT = (const bf16*)(F.ws + A_LAT); bf16* QN = (bf16*)(F.ws + A_QN); bf16* KVN = (bf16*)(F.ws + A_KVN); bf16* KB = (bf16*)(F.ws + A_K);
    const float* cs = (const float*)(F.ws + WS_CS);
    for (int row = gw; row < M; row += NGW) {
        const unsigned* lr = (const unsigned*)(LAT + (size_t)row * LATP);
        unsigned q[3], kv[2];
#pragma unroll
        for (int j = 0; j < 3; ++j) q[j] = lr[F.lane + 64 * j];
#pragma unroll
        for (int j = 0; j < 2; ++j) kv[j] = lr[192 + F.lane + 64 * j];
        const unsigned kr = lr[320 + (F.lane & 15)];
        float sq = 0.f, sk = 0.f;
#pragma unroll
        for (int j = 0; j < 3; ++j) { const float a = bf_lo(q[j]), b = bf_hi(q[j]); sq += a * a + b * b; }
#pragma unroll
        for (int j = 0; j < 2; ++j) { const float a = bf_lo(kv[j]), b = bf_hi(kv[j]); sk += a * a + b * b; }
        const float rq = 1.0f / sqrtf(wave_sum(sq) * (1.f / QRANK) + EPS), rk = 1.0f / sqrtf(wave_sum(sk) * (1.f / KVRANK) + EPS);
        unsigned* qo = (unsigned*)(QN + (size_t)row * QRANK); unsigned* ko = (unsigned*)(KVN + (size_t)row * KVRANK);
#pragma unroll
        for (int j = 0; j < 3; ++j) qo[F.lane + 64 * j] = pk2(bf_lo(q[j]) * rq, bf_hi(q[j]) * rq);
#pragma unroll
        for (int j = 0; j < 2; ++j) ko[F.lane + 64 * j] = pk2(bf_lo(kv[j]) * rk, bf_hi(kv[j]) * rk);
        { const int i = F.lane & 15; const float c = cs[(size_t)row * 32 + 2 * i], s = cs[(size_t)row * 32 + 2 * i + 1]; const float x1 = bf_lo(kr), x2 = bf_hi(kr);
          const unsigned w = pk2(x1 * c - x2 * s, x1 * s + x2 * c);
          unsigned* kb = (unsigned*)(KB + (size_t)row * QUP);
#pragma unroll
          for (int hh = 0; hh < 4; ++hh) { const int h = (F.lane >> 4) * 4 + hh; kb[(h * 96 + 64) / 2 + i] = w; } }
    }
}

__device__ __forceinline__ void merge_phase(Frame& F) {
    const int gw = F.vcu * NWAVES + F.wave, NGW = F.G * NWAVES;
    const bf16* OG = (const bf16*)(F.ws + A_OG); const float* LSE = (const float*)(F.ws + WS_LSE); unsigned char* OD = F.ws + A_OD;
    for (int row = gw; row < M; row += NGW) {
        const int h = F.lane >> 3;
        float l0 = LSE[((size_t)0 * M + row) * 8 + h], l1 = LSE[((size_t)1 * M + row) * 8 + h], l2 = LSE[((size_t)2 * M + row) * 8 + h];
        const float mx = fmaxf(l0, fmaxf(l1, l2)); float w0 = __builtin_amdgcn_exp2f(l0 - mx), w1 = __builtin_amdgcn_exp2f(l1 - mx), w2 = __builtin_amdgcn_exp2f(l2 - mx);
        const float inv = 1.0f / (w0 + w1 + w2); w0 *= inv; w1 *= inv; w2 *= inv;
        const v4u a = *(const v4u*)(OG + ((size_t)0 * M + row) * DILOUT + 8 * F.lane), b = *(const v4u*)(OG + ((size_t)1 * M + row) * DILOUT + 8 * F.lane), c = *(const v4u*)(OG + ((size_t)2 * M + row) * DILOUT + 8 * F.lane);
        float m8[8];
#pragma unroll
        for (int k = 0; k < 4; ++k) { m8[2 * k] = (w0 * bf_lo(a[k]) + w1 * bf_lo(b[k]) + w2 * bf_lo(c[k])) * mla::OSCALE; m8[2 * k + 1] = (w0 * bf_hi(a[k]) + w1 * bf_hi(b[k]) + w2 * bf_hi(c[k])) * mla::OSCALE; }
        *(v2u*)(OD + (size_t)row * DILOUT + 8 * F.lane) = (v2u){pg8::pk4_fp8(m8[0], m8[1], m8[2], m8[3]), pg8::pk4_fp8(m8[4], m8[5], m8[6], m8[7])};
    }
}

__device__ __forceinline__ void router_phase(Frame& F, const bf16* H, const float* A0, const float* B0, i8* O0, float* S0) {
    const int gw = F.vcu * NWAVES + F.wave, NGW = F.G * NWAVES;
    LAS float* wrt = (LAS float*)F.lds;
    { const float* wr = F.in[22]; for (int i = F.tid; i < 8192; i += NWAVES * 64) { const int col = i >> 3, e = i & 7; wrt[e * 1024 + col] = wr[i]; } }
    __syncthreads();
    v4u* ROUTE = (v4u*)(F.ws + WS_ROUTE); unsigned* CNT = (unsigned*)(F.ws + WS_CNT);
    for (int c = gw; c < M / 16; c += NGW) {
        const int row0 = c * 16, b = row0 / SEQ;
        f32x4 a0[2][2], b0[2][2];
#pragma unroll
        for (int j = 0; j < 2; ++j) { const int co = b * D + 8 * F.lane + 512 * j; ld8_f32(A0 + co, a0[j][0], a0[j][1]); ld8_f32(B0 + co, b0[j][0], b0[j][1]); }
        unsigned cnt = 0u;
        for (int i = 0; i < 16; ++i) { const size_t row = (size_t)(row0 + i);
            f32x4 v[2][2]; float s = 0.f;
#pragma unroll
            for (int j = 0; j < 2; ++j) { ld8_bf16(H + row * HPITCH + 8 * F.lane + 512 * j, v[j][0], v[j][1]); s += ssq8(v[j][0], v[j][1]); }
            const float rstd = 1.0f / sqrtf(wave_sum(s) * (1.f / D) + EPS);
            float lg[8];
#pragma unroll
            for (int e = 0; e < 8; ++e) lg[e] = 0.f;
            f32x4 yq[2][2];
#pragma unroll
            for (int j = 0; j < 2; ++j) { const f32x4 y0 = v[j][0] * rstd * a0[j][0] + b0[j][0], y1 = v[j][1] * rstd * a0[j][1] + b0[j][1];
                yq[j][0] = y0; yq[j][1] = y1;
#pragma unroll
                for (int e = 0; e < 8; ++e) { const LAS float* wp = wrt + e * 1024 + 8 * F.lane + 512 * j; const f32x4 w0 = *(const LAS f32x4*)wp, w1 = *(const LAS f32x4*)(wp + 4);
                    lg[e] += ((y0.x * w0.x + y0.y * w0.y) + (y0.z * w0.z + y0.w * w0.w)) + ((y1.x * w1.x + y1.y * w1.y) + (y1.z * w1.z + y1.w * w1.w)); } }
            quant_row(yq, O0 + row * D, S0 + row, F.lane);
#pragma unroll
            for (int e = 0; e < 8; ++e) lg[e] = wave_sum(lg[e]);
            int e1 = 0; float v1 = lg[0];
#pragma unroll
            for (int e = 1; e < 8; ++e) if (lg[e] > v1) { v1 = lg[e]; e1 = e; }
            int e2 = -1; float v2 = -INFINITY;
#pragma unroll
            for (int e = 0; e < 8; ++e) if (e != e1 && lg[e] > v2) { v2 = lg[e]; e2 = e; }
            const float ex = expf(v2 - v1); const float g1 = 1.0f / (1.0f + ex), g2 = ex / (1.0f + ex);
            cnt += (F.lane == e1 ? 1u : 0u) + (F.lane == e2 ? 1u : 0u);
            if (F.lane == 0) ROUTE[row] = (v4u){(unsigned)e1 | ((unsigned)e2 << 8), __float_as_uint(g1), __float_as_uint(g2), 0u};
        }
        if (F.lane < 8) CNT[c * 8 + F.lane] = cnt;
    }
}

__device__ __forceinline__ void lists_phase(Frame& F) {
    const int gw = F.vcu * NWAVES + F.wave, NGW = F.G * NWAVES;
    const v4u* ROUTE = (const v4u*)(F.ws + WS_ROUTE); const unsigned* CNT = (const unsigned*)(F.ws + WS_CNT);
    int* LIST = (int*)(F.ws + WS_LIST); float* SLOTG = (float*)(F.ws + WS_SLOTG); float* SLOTXS = (float*)(F.ws + WS_SLOTXS); const float* XS = (const float*)(F.ws + WS_XS); int* TOKSLOT = (int*)(F.ws + WS_TOKSLOT); int* TILEEXP = (int*)(F.ws + WS_TILEEXP);
    for (int c = gw; c < M / 16; c += NGW) {
        unsigned lt[8], al[8];
#pragma unroll
        for (int e = 0; e < 8; ++e) { lt[e] = 0u; al[e] = 0u; }
        for (int cc = F.lane; cc < M / 16; cc += 64) { const v4u x = *(const v4u*)(CNT + cc * 8), y = *(const v4u*)(CNT + cc * 8 + 4); const bool bl = cc < c;
            al[0] += x.x; al[1] += x.y; al[2] += x.z; al[3] += x.w; al[4] += y.x; al[5] += y.y; al[6] += y.z; al[7] += y.w;
            if (bl) { lt[0] += x.x; lt[1] += x.y; lt[2] += x.z; lt[3] += x.w; lt[4] += y.x; lt[5] += y.y; lt[6] += y.z; lt[7] += y.w; } }
#pragma unroll
        for (int e = 0; e < 8; ++e) {
#pragma unroll
            for (int o = 1; o < 64; o <<= 1) { lt[e] += __shfl_xor(lt[e], o); al[e] += __shfl_xor(al[e], o); } }
        unsigned base[8]; unsigned run = 0u;
#pragma unroll
        for (int e = 0; e < 8; ++e) { base[e] = run; run += (al[e] + 255u) & ~255u; }
        const int row = c * 16 + (F.lane & 15);
        const v4u r = ROUTE[row]; const int e1 = (int)(r.x & 0xffu), e2 = (int)((r.x >> 8) & 0xffu);
        int s1 = 0, s2 = 0;
#pragma unroll
        for (int e = 0; e < 8; ++e) { const bool has = (F.lane < 16) && (e1 == e || e2 == e); const unsigned long long mk = __ballot(has);
            const int rank = __popcll(mk & ((1ull << F.lane) - 1ull)); const int sl = (int)(base[e] + lt[e]) + rank;
            if (e1 == e) s1 = sl; if (e2 == e) s2 = sl; }
        if (F.lane < 16) { LIST[s1] = row; LIST[s2] = row; SLOTG[s1] = __uint_as_float(r.y); SLOTG[s2] = __uint_as_float(r.z); TOKSLOT[row * 2] = s1; TOKSLOT[row * 2 + 1] = s2;
            const float xs = XS[row]; SLOTXS[s1] = xs; SLOTXS[s2] = xs; }
        if (c == 0) {
#pragma unroll
            for (int e = 0; e < 8; ++e) { const unsigned pe = (al[e] + 255u) & ~255u;
                for (unsigned s = base[e] + al[e] + F.lane; s < base[e] + pe; s += 64) { LIST[s] = 0; SLOTG[s] = 0.f; SLOTXS[s] = 0.f; }
                for (unsigned t = base[e] / 256u + F.lane; t < (base[e] + pe) / 256u; t += 64) TILEEXP[t] = e; }
            if (F.lane == 0) TILEEXP[300] = (int)(run / 256u);
        }
    }
}

__device__ __forceinline__ void final_phase(Frame& F, float* OUT, const float* gate, const float* gfin) {
    const int gw = F.vcu * NWAVES + F.wave, NGW = F.G * NWAVES;
    const bf16* Y = (const bf16*)(F.ws + A_Y); const int* TOKSLOT = (const int*)(F.ws + WS_TOKSLOT); const bf16* H = (const bf16*)OUT;
    for (int c = gw; c < M / 16; c += NGW) {
        const int row0 = c * 16, b = row0 / SEQ;
        f32x4 gt[2][2], gf[2][2];
#pragma unroll
        for (int j = 0; j < 2; ++j) { ld8_f32(gate + b * D + 8 * F.lane + 512 * j, gt[j][0], gt[j][1]); ld8_f32(gfin + 8 * F.lane + 512 * j, gf[j][0], gf[j][1]); }
#pragma unroll 2
        for (int i = 0; i < 16; ++i) { const size_t row = (size_t)(row0 + i);
            const int s1 = TOKSLOT[row * 2], s2 = TOKSLOT[row * 2 + 1];
            f32x4 v[2][2]; float s = 0.f;
#pragma unroll
            for (int j = 0; j < 2; ++j) { f32x4 h0, h1, p0, p1, q0, q1; ld8_bf16(H + row * HPITCH + 8 * F.lane + 512 * j, h0, h1);
                ld8_bf16(Y + (size_t)s1 * D + 8 * F.lane + 512 * j, p0, p1); ld8_bf16(Y + (size_t)s2 * D + 8 * F.lane + 512 * j, q0, q1);
                v[j][0] = h0 + gt[j][0] * (p0 + q0); v[j][1] = h1 + gt[j][1] * (p1 + q1); s += ssq8(v[j][0], v[j][1]); }
            const float rstd = 1.0f / sqrtf(wave_sum(s) * (1.f / D) + EPS);
            asm volatile("" ::: "memory");
#pragma unroll
            for (int j = 0; j < 2; ++j) { float* op = OUT + row * D + 8 * F.lane + 512 * j; *(GAS f32x4*)op = v[j][0] * rstd * gf[j][0]; *(GAS f32x4*)(op + 4) = v[j][1] * rstd * gf[j][1]; }
        }
    }
}
#ifndef MK_ONE_LAUNCH
#define MK_ONE_LAUNCH 1
#endif
constexpr int N_PHASES = 20;
struct Args { const float* in[26]; float* out; unsigned char* ws; int ph_lo, ph_hi; };
static_assert(sizeof(Args) == 26 * 8 + 8 + 8 + 8, "Args has no padding");

__global__ void __launch_bounds__(NWAVES * 64, 2) mk_fwd(Args args) {
    extern __shared__ __attribute__((aligned(16))) unsigned char lds[];
    Frame F;
    F.lds = (LAS unsigned char*)lds;
    F.MISC = (volatile LAS unsigned*)(F.lds + MISC_OFF);
    F.tid = threadIdx.x; F.lane = F.tid & 63; F.wave = __builtin_amdgcn_readfirstlane(F.tid >> 6);
    F.G = gridDim.x; { const int bx = blockIdx.x; F.vcu = (F.G % 8 == 0) ? (bx % 8) * (F.G / 8) + bx / 8 : bx; }
    F.ws = args.ws; F.out = args.out;
#pragma unroll
    for (int i = 0; i < 26; ++i) F.in[i] = args.in[i];
    unsigned char* const ws = args.ws;
    for (int u = F.tid; u < (LDS_BYTES - LDSCTL_OFF) / 4; u += NWAVES * 64) ((LAS unsigned*)(F.lds + LDSCTL_OFF))[u] = 0u;
    __syncthreads();
    const int lo = args.ph_lo, hi = args.ph_hi;
    XcdBarrier bar; bar.bar = (unsigned*)(ws + WS_CTL) + CW_BAR; bar.x = 0; bar.st = nullptr;
    if (hi - lo > 1) bar = xcd_barrier_post((unsigned*)(ws + WS_CTL) + CW_BAR, F.MISC + 8);
    int cid = (int)blockIdx.x;
    if (hi - lo > 1) { if (F.tid == 0) F.MISC[12] = xb_add((unsigned*)(ws + WS_CTL) + CW_RANK + 64 * bar.x, 1u); }

#ifndef PHASE_MASK
#define PHASE_MASK 0xFFFFFu
#endif
#define IN(k) (((PHASE_MASK >> (k)) & 1u) && lo <= (k) && (k) < hi)
#ifndef REPEAT_MASK
#define REPEAT_MASK 0u
#endif
#define REP(k) (((REPEAT_MASK >> (k)) & 1u) ? 2 : 1)
#define SEAM(k) do { if (IN(k) && IN((k) + 1)) xcd_barrier(bar); } while (0)
    const float* MODV = (const float*)(ws + WS_MODV);
#define MV(kind) (MODV + (size_t)(kind) * 4 * D)
    bf16* const H = (bf16*)args.out;
    i8* const XN = (i8*)(ws + A_XN); i8* const XNKV = (i8*)(ws + A_XNKV);
    float* const XS = (float*)(ws + WS_XS); float* const XSKV = (float*)(ws + WS_XSKV); const float* const SB = (const float*)(ws + WS_SB);
    const pg8::MoeInfo mi0{nullptr, nullptr, 0};

    if (IN(0)) for (int rep_ = 0; rep_ < REP(0); ++rep_) { p0_prologue(F); } SEAM(0);
    if (IN(0) && IN(1)) {
        if (F.tid == 0) { bool ok = (F.G % 8) == 0;
            for (unsigned j = 0; j < 16; ++j) { const unsigned cnt_ = xb_ld((unsigned*)(ws + WS_CTL) + CW_BAR + XB_XCNT(j)); ok = ok && (cnt_ == (j < 8 ? (unsigned)F.G / 8u : 0u)); }
            F.MISC[13] = ok ? (F.MISC[12] * 8u + bar.x) : (unsigned)blockIdx.x; }
        __syncthreads();
        cid = (int)F.MISC[13];
        F.vcu = (F.G % 8 == 0) ? (cid % 8) * (F.G / 8) + cid / 8 : cid;
    }

    if (IN(1)) for (int rep_ = 0; rep_ < REP(1); ++rep_) { norm_phase<false, true>(F, F.in[0], MV(MK_A_MIX0), MV(MK_B_MIX0), XN, XS, nullptr, nullptr, nullptr, nullptr); } SEAM(1);
    if (IN(2)) for (int rep_ = 0; rep_ < REP(2); ++rep_) { pg8::Gemm g{(const bf16*)XN, (const bf16*)(ws + WS_WMLAIN), M, LATP, D}; pg8::StaticOrder S; S.init(M, LATP, F.G, cid);
        pg8::EpiBf16Q E{(bf16*)(ws + A_LAT), LATP, XS, SB + SB_LAT};
        pg8::gemm_phase<pg8::EpiBf16Q, pg8::StaticOrder, true, true, 0, 1>(F.lds, g, S, E, mi0); } SEAM(2);
    if (IN(3)) for (int rep_ = 0; rep_ < REP(3); ++rep_) { latnorm_phase(F); } SEAM(3);
    if (IN(4)) for (int rep_ = 0; rep_ < REP(4); ++rep_) {
#ifndef P4_SKIP_Q
        { pg8::Gemm g{(const bf16*)(ws + A_QN), (const bf16*)(ws + WS_WQUP), M, QUP, QRANK}; pg8::StaticOrder S; S.init(M, QUP, F.G, cid);
          pg8::EpiQ E{(bf16*)(ws + A_Q), QUP, C2_MLA, (const float*)(ws + WS_CS)};
          pg8::gemm_phase<pg8::EpiQ, pg8::StaticOrder, true, true, 0>(F.lds, g, S, E, mi0); }
#endif
#ifndef P4_SKIP_KV
        { pg8::Gemm g{(const bf16*)(ws + A_KVN), (const bf16*)(ws + WS_WKVUP), M, KVUP, KVRANK}; pg8::StaticOrder S; S.init(M, KVUP, F.G, cid);
          pg8::EpiKV E{(bf16*)(ws + A_K), (bf16*)(ws + A_V)};
          pg8::gemm_phase<pg8::EpiKV, pg8::StaticOrder, true, true, 0>(F.lds, g, S, E, mi0); }
#endif
    } SEAM(4);
    if (IN(5)) for (int rep_ = 0; rep_ < REP(5); ++rep_) {
        const bf16* Qp = (const bf16*)(ws + A_Q); const bf16* Kp = (const bf16*)(ws + A_K); const bf16* Vp = (const bf16*)(ws + A_V); unsigned char* Op = ws + A_O;
        if (F.G == 256) {
            for (int i = 0; i < 8; ++i) { const int bh = (F.vcu >> 3) + 32 * (i >> 2), s = F.vcu & 7, k = i & 3; const int qb = (k == 0) ? s : (k == 1) ? 15 - s : (k == 2) ? 16 + s : 31 - s;
                const int b = bh >> 4, h = bh & 15;
                mla::attn_unit<8>(b, h, qb, Qp, Kp, Vp, Op, (char*)lds); }
        } else {
            for (int u = (int)blockIdx.x; u < BATCH * MLA_H * 32; u += F.G) { const int bh = u >> 5, qb = 31 - (u & 31); const int b = bh >> 4, h = bh & 15;
                mla::attn_unit<8>(b, h, qb, Qp, Kp, Vp, Op, (char*)lds); }
        }
    } SEAM(5);
    if (IN(6)) for (int rep_ = 0; rep_ < REP(6); ++rep_) { pg8::Gemm g{(const bf16*)(ws + A_O), (const bf16*)(ws + WS_WOUT), M, D, D}; pg8::StaticOrder S; S.init(M, D, F.G, cid);
        pg8::EpiResid<true> E{F.in[0], H, MV(MK_G_MIX0), SB + SB_OUT};
        pg8::gemm_phase<pg8::EpiResid<true>, pg8::StaticOrder, true, true, 0, 2>(F.lds, g, S, E, mi0); } SEAM(6);
    if (IN(7)) for (int rep_ = 0; rep_ < REP(7); ++rep_) { norm_phase<false, false>(F, H, MV(MK_A_FFN0), MV(MK_B_FFN0), XN, XS, nullptr, nullptr, nullptr, nullptr); } SEAM(7);
    if (IN(8)) for (int rep_ = 0; rep_ < REP(8); ++rep_) { pg8::Gemm g{(const bf16*)XN, (const bf16*)(ws + WS_WFGU), M, 2 * DFF, D}; pg8::StaticOrder S; S.init(M, 2 * DFF, F.G, cid);
        pg8::EpiSwiGLUQ E{(unsigned char*)(ws + A_HID), DFF, XS, SB + SB_FGU, nullptr};
        pg8::gemm_phase<pg8::EpiSwiGLUQ, pg8::StaticOrder, true, true, 0, 1>(F.lds, g, S, E, mi0); } SEAM(8);
    if (IN(9)) for (int rep_ = 0; rep_ < REP(9); ++rep_) { pg8::Gemm g{(const bf16*)(ws + A_HID), (const bf16*)(ws + WS_WFDN), M, D, DFF}; pg8::StaticOrder S; S.init(M, D, F.G, cid);
        pg8::EpiResid<false> E{H, H, MV(MK_G_FFN0), SB + SB_FDN};
        pg8::gemm_phase<pg8::EpiResid<false>, pg8::StaticOrder, true, true, 0, 2>(F.lds, g, S, E, mi0); } SEAM(9);
    if (IN(10)) for (int rep_ = 0; rep_ < REP(10); ++rep_) { norm_phase<true, false>(F, H, MV(MK_A_MIX1), MV(MK_B_MIX1), XN, XS, MV(MK_A_KV), MV(MK_B_KV), XNKV, XSKV); } SEAM(10);
    if (IN(11)) for (int rep_ = 0; rep_ < REP(11); ++rep_) {
        { pg8::Gemm g{(const bf16*)XNKV, (const bf16*)(ws + WS_WKVB), M, DILKV, D}; pg8::StaticOrder S; S.init(M, DILKV, F.G, cid);
          pg8::EpiDilQ<true> E{(bf16*)(ws + A_KVB), XSKV, SB + SB_KVB};
          pg8::gemm_phase<pg8::EpiDilQ<true>, pg8::StaticOrder, true, true, 0, 1>(F.lds, g, S, E, mi0); }
        { pg8::Gemm g{(const bf16*)XN, (const bf16*)(ws + WS_WQB), M, DILQ, D}; pg8::StaticOrder S; S.init(M, DILQ, F.G, cid);
          pg8::EpiDilQ<false> E{(bf16*)(ws + A_QB), XS, SB + SB_QB};
          pg8::gemm_phase<pg8::EpiDilQ<false>, pg8::StaticOrder, true, true, 0, 1>(F.lds, g, S, E, mi0); }
    } SEAM(11);
    if (IN(12)) for (int rep_ = 0; rep_ < REP(12); ++rep_) {
        const bf16* Qp = (const bf16*)(ws + A_QB); const bf16* KV = (const bf16*)(ws + A_KVB); bf16* OG = (bf16*)(ws + A_OG); float* LSE = (float*)(ws + WS_LSE); const float* BT = (const float*)(ws + WS_BIAS);
        dila::dil_phase(Qp, KV, OG, LSE, BT, (char*)lds, F.G);
    } SEAM(12);
    if (IN(13)) for (int rep_ = 0; rep_ < REP(13); ++rep_) { merge_phase(F); } SEAM(13);
    if (IN(14)) for (int rep_ = 0; rep_ < REP(14); ++rep_) { pg8::Gemm g{(const bf16*)(ws + A_OD), (const bf16*)(ws + WS_WOB), M, D, DILOUT}; pg8::StaticOrder S; S.init(M, D, F.G, cid);
        pg8::EpiResid<false> E{H, H, MV(MK_G_MIX1), SB + SB_OB};
        pg8::gemm_phase<pg8::EpiResid<false>, pg8::StaticOrder, true, true, 0, 2>(F.lds, g, S, E, mi0); } SEAM(14);
    if (IN(15)) for (int rep_ = 0; rep_ < REP(15); ++rep_) { router_phase(F, H, MV(MK_A_FFN1), MV(MK_B_FFN1), XN, XS); } SEAM(15);
    if (IN(16)) for (int rep_ = 0; rep_ < REP(16); ++rep_) { lists_phase(F); } SEAM(16);
    if (IN(17)) for (int rep_ = 0; rep_ < REP(17); ++rep_) { const int ntile = ((const int*)(ws + WS_TILEEXP))[300];
        pg8::Gemm g{(const bf16*)XN, (const bf16*)(ws + WS_WEGU), ntile * 256, 2 * DFF, D}; pg8::StaticOrder S; S.init(ntile * 256, 2 * DFF, F.G, cid);
        const pg8::MoeInfo mi{(const int*)(ws + WS_LIST), (const int*)(ws + WS_TILEEXP), (size_t)2 * DFF * D};
        pg8::EpiSwiGLUQ E{(unsigned char*)(ws + A_HIDS), DFF, (const float*)(ws + WS_SLOTXS), SB + SB_EGU, mi.tile_expert};
        pg8::gemm_phase<pg8::EpiSwiGLUQ, pg8::StaticOrder, true, true, 1, 1>(F.lds, g, S, E, mi); } SEAM(17);
    if (IN(18)) for (int rep_ = 0; rep_ < REP(18); ++rep_) { const int ntile = ((const int*)(ws + WS_TILEEXP))[300];
        pg8::Gemm g{(const bf16*)(ws + A_HIDS), (const bf16*)(ws + WS_WEDN), ntile * 256, D, DFF}; pg8::StaticOrder S; S.init(ntile * 256, D, F.G, cid);
        const pg8::MoeInfo mi{(const int*)(ws + WS_LIST), (const int*)(ws + WS_TILEEXP), (size_t)D * DFF};
        pg8::EpiMoeDown E{(bf16*)(ws + A_Y), (const float*)(ws + WS_SLOTG), SB + SB_EDN, mi.tile_expert};
        pg8::gemm_phase<pg8::EpiMoeDown, pg8::StaticOrder, true, true, 2, 2>(F.lds, g, S, E, mi); } SEAM(18);
    if (IN(19)) for (int rep_ = 0; rep_ < REP(19); ++rep_) { final_phase(F, args.out, MV(MK_G_FFN1), F.in[25]); }
#undef IN
#undef SEAM
#undef MV
}

extern "C" void kernel_launch(void* const* d_in, const int* in_sizes, int n_in, void* d_out, int out_size, void* d_ws, size_t ws_size, hipStream_t stream) {
    static int grid = 0;
    if (grid == 0) {
        if (n_in != 26 || in_sizes[0] != M * D || out_size != M * D || ws_size < WS_END) { fprintf(stderr, "kernel_launch: unexpected shapes (n_in %d, in0 %d, out %d, ws %zu, need %zu); nothing launched\n", n_in, n_in > 0 ? in_sizes[0] : -1, out_size, ws_size, (size_t)WS_END); grid = -1; return; }
        int dev = 0, cus = 0, per_cu = 0;
        if (hipGetDevice(&dev) != hipSuccess || hipDeviceGetAttribute(&cus, hipDeviceAttributeMultiprocessorCount, dev) != hipSuccess) { grid = -1; return; }
        if (hipFuncSetAttribute((const void*)mk_fwd, hipFuncAttributeMaxDynamicSharedMemorySize, LDS_BYTES) != hipSuccess) { fprintf(stderr, "kernel_launch: hipFuncSetAttribute failed\n"); grid = -1; return; }
        if (hipOccupancyMaxActiveBlocksPerMultiprocessor(&per_cu, (const void*)mk_fwd, NWAVES * 64, LDS_BYTES) != hipSuccess || per_cu < 1) { fprintf(stderr, "kernel_launch: occupancy query reports %d\n", per_cu); }
        (void)hipGetLastError();
        grid = cus;
    }
    if (grid < 0) return;
    if (hipMemsetAsync((char*)d_ws + WS_CTL, 0, CTL_ZERO_BYTES, stream) != hipSuccess) return;
    Args a{};
    for (int i = 0; i < 26; ++i) a.in[i] = (const float*)d_in[i];
    a.out = (float*)d_out; a.ws = (unsigned char*)d_ws;
#if MK_ONE_LAUNCH
    a.ph_lo = 0; a.ph_hi = N_PHASES;
    hipLaunchKernelGGL(mk_fwd, dim3(grid), dim3(NWAVES * 64), LDS_BYTES, stream, a);
#else
    for (int p = 0; p < N_PHASES; ++p) { a.ph_lo = p; a.ph_hi = p + 1; hipLaunchKernelGGL(mk_fwd, dim3(grid), dim3(NWAVES * 64), LDS_BYTES, stream, a); }
#endif
}
```

```cpp
#include <hip/hip_runtime.h>
#include <hip/hip_bf16.h>
#include <cstdio>
#include <cstdint>
#include <cmath>
#ifndef MK_ONE_LAUNCH
#define MK_ONE_LAUNCH 1
#endif
#ifndef PG8_STAGGER
#define PG8_STAGGER 0
#endif
namespace pg8 {
#define PG8_LAS __attribute__((address_space(3)))
typedef unsigned short bf16_t;
typedef short bf16x8 __attribute__((ext_vector_type(8)));
typedef float f32x4 __attribute__((ext_vector_type(4)));
typedef float f32x2 __attribute__((ext_vector_type(2)));
typedef unsigned u32x4 __attribute__((ext_vector_type(4)));
typedef int i32x4 __attribute__((ext_vector_type(4)));
typedef int i32x8 __attribute__((ext_vector_type(8)));
template <int PREC> struct AccT { typedef f32x4 type; }; template <> struct AccT<1> { typedef i32x4 type; };
constexpr int BM = 256, BK = 64, HALF = 128, HTB = HALF * BK * 2  , STAGE_BYTES = 8 * HTB, NXCD = 8, WGM = 8;

__host__ __device__ __forceinline__ int lds_byte(int r, int c) { const int st = (r >> 4) * 2 + (c >> 5), rr = r & 15, cc = c & 31, ob = rr * 64 + cc * 2; return st * 1024 + (ob ^ (((ob >> 9) & 1) << 5)); }
__host__ __device__ __forceinline__ void stage_rc(int b, int& R, int& C) { const int st = b / 1024, sb = b % 1024, swz = sb ^ (((sb >> 9) & 1) << 5); R = (st >> 1) * 16 + swz / 64; C = (st & 1) * 32 + (swz % 64) / 2; }
__host__ __device__ __forceinline__ int perm32(int rho) { const int n = rho >> 4, i = rho & 15; return 8 * (i >> 2) + 4 * n + (i & 3); }

struct Unit { int pm, pn; };
struct Gemm { const bf16_t* A; const bf16_t* Bt; int M, N, K; };
struct MoeInfo { const int* list; const int* tile_expert; size_t bstride; };

struct StaticOrder {
    int nM, nN, nwg, G, c;
    __host__ __device__ void init(int M, int N, int G_, int c_) { nM = M / BM; nN = N / BM; nwg = nM * nN; G = G_; c = c_; }
    __host__ __device__ bool next(int i, Unit& u) const {
        const long L = (long)i * G + c; if (L >= nwg) return false;
        int wgid = (int)L; { const int q = nwg / NXCD, r = nwg % NXCD, xcd = wgid % NXCD, off = wgid / NXCD; wgid = (xcd < r ? xcd * (q + 1) : r * (q + 1) + (xcd - r) * q) + off; }
        const int nig = WGM * nN, gid = wgid / nig, fm = gid * WGM, gsz = (nM - fm) < WGM ? (nM - fm) : WGM;
        u.pm = fm + ((wgid % nig) % gsz); u.pn = (wgid % nig) / gsz; return true;
    }
    __device__ __forceinline__ void a_ready(const Unit&) const {}
    __device__ __forceinline__ void done(const Unit&) const {}
};

__device__ __forceinline__ unsigned cvt_pk_bf16(float lo, float hi) { unsigned r; asm volatile("v_cvt_pk_bf16_f32 %0, %1, %2" : "=v"(r) : "v"(lo), "v"(hi)); return r; }


template <class Epi, class Sched, bool ALIGN_EPI, bool SP2, int MODE, int PREC = 0>
__device__ __forceinline__ void gemm_phase(PG8_LAS unsigned char* lds, const Gemm g, const Sched& S, const Epi& E, const MoeInfo mi) {
    const int tid = threadIdx.x, wid = __builtin_amdgcn_readfirstlane(tid >> 6), lane = tid & 63, wr = wid >> 2, wc = wid & 3, fr = lane & 15, fq = lane >> 4;
    int K_ = g.K; asm volatile("" : "+s"(K_));
    constexpr int ES = PREC ? 1 : 2;
    const int K = K_, nt = (K * ES) / (BK * 2);
    unsigned voffB[2]; int Rr[2], Cc[2];
#pragma unroll
    for (int i = 0; i < 2; ++i) { int R, C; stage_rc(tid * 16 + i * 8192, R, C); const int Rb = Epi::PERM ? ((R & ~31) + perm32(R & 31)) : R;
        Rr[i] = R; Cc[i] = C; voffB[i] = (unsigned)(Rb * K) * (unsigned)ES + (unsigned)C * 2u; }
    const size_t kstep = (size_t)(BK * 2);
    const size_t hstep = (size_t)HALF * K * ES;
    const size_t tstep = 2 * hstep;
    const unsigned ldsw = (unsigned)wid * 1024u;
    const int aoff = lds_byte(wr * 64 + fr, fq * 8), boff = lds_byte(wc * 32 + fr, fq * 8);
    const unsigned rowb = (unsigned)K * (unsigned)ES;
#define PG8_SA(b, h) (((b) * 2 + (h)) * HTB)
#define PG8_SB(b, h) ((4 + (b) * 2 + (h)) * HTB)
#define PG8_STAGE(bufoff, gbase, voff) do { _Pragma("unroll") for (int _i = 0; _i < 2; ++_i) \
        __builtin_amdgcn_global_load_lds((const unsigned*)((const char*)(gbase) + (voff)[_i]), (PG8_LAS unsigned*)(lds + (bufoff) + ldsw + _i * 8192), 16, 0, 0); } while (0)
#define PG8_LDA(dst, b, h) do { _Pragma("unroll") for (int m = 0; m < 4; ++m) { if constexpr (PREC == 2) { \
            const i32x4 lo_ = *(const PG8_LAS i32x4*)(lds + PG8_SA(b, h) + aoff + m * 2048), hi_ = *(const PG8_LAS i32x4*)(lds + PG8_SA(b, h) + aoff + m * 2048 + 1024); \
            dst##8[m] = (i32x8){lo_[0], lo_[1], lo_[2], lo_[3], hi_[0], hi_[1], hi_[2], hi_[3]}; } \
        else { _Pragma("unroll") for (int k = 0; k < 2; ++k) dst[m][k] = *(const PG8_LAS bf16x8*)(lds + PG8_SA(b, h) + aoff + m * 2048 + k * 1024); } } } while (0)
#define PG8_LDB(dst, b, h) do { _Pragma("unroll") for (int n = 0; n < 2; ++n) { if constexpr (PREC == 2) { \
            const i32x4 lo_ = *(const PG8_LAS i32x4*)(lds + PG8_SB(b, h) + boff + n * 2048), hi_ = *(const PG8_LAS i32x4*)(lds + PG8_SB(b, h) + boff + n * 2048 + 1024); \
            dst##8[n] = (i32x8){lo_[0], lo_[1], lo_[2], lo_[3], hi_[0], hi_[1], hi_[2], hi_[3]}; } \
        else { _Pragma("unroll") for (int k = 0; k < 2; ++k) dst[n][k] = *(const PG8_LAS bf16x8*)(lds + PG8_SB(b, h) + boff + n * 2048 + k * 1024); } } } while (0)
#define PG8_MMA(ai, bj, At, Bt) do { __builtin_amdgcn_s_setprio(1); _Pragma("unroll") for (int m = 0; m < 4; ++m) _Pragma("unroll") for (int n = 0; n < 2; ++n) { \
        if constexpr (PREC == 2) asm volatile("s_nop 1\n\tv_mfma_scale_f32_16x16x128_f8f6f4 %0, %1, %2, %0, %3, %3 op_sel_hi:[0,0,0]" : "+v"(acc[ai][bj][m][n]) : "v"(Bt##8[n]), "v"(At##8[m]), "v"(one_scale));   \
        else { _Pragma("unroll") for (int k = 0; k < 2; ++k) { \
            if constexpr (PREC == 1) acc[ai][bj][m][n] = __builtin_amdgcn_mfma_i32_16x16x64_i8(__builtin_bit_cast(i32x4, Bt[n][k]), __builtin_bit_cast(i32x4, At[m][k]), acc[ai][bj][m][n], 0, 0, 0); \
            else acc[ai][bj][m][n] = __builtin_amdgcn_mfma_f32_16x16x32_bf16(Bt[n][k], At[m][k], acc[ai][bj][m][n], 0, 0, 0); } } } __builtin_amdgcn_s_setprio(0); } while (0)
#define PG8_WAIT_V(n) asm volatile("s_waitcnt vmcnt(" #n ")" ::: "memory")
#define PG8_WAIT_L(n) asm volatile("s_waitcnt lgkmcnt(" #n ")" ::: "memory")
#define PG8_WAIT_V8R do { const int rlx_ = rlx_flag;   \
        if constexpr (Epi::NST >= 16) asm volatile("s_cmp_eq_u32 %0, 0\n\ts_cbranch_scc1 .Lpg8a%=\n\ts_waitcnt vmcnt(24)\n\ts_branch .Lpg8b%=\n.Lpg8a%=:\n\ts_waitcnt vmcnt(8)\n.Lpg8b%=:" :: "s"(rlx_) : "memory", "scc"); \
        else if constexpr (Epi::NST >= 8) asm volatile("s_cmp_eq_u32 %0, 0\n\ts_cbranch_scc1 .Lpg8a%=\n\ts_waitcnt vmcnt(16)\n\ts_branch .Lpg8b%=\n.Lpg8a%=:\n\ts_waitcnt vmcnt(8)\n.Lpg8b%=:" :: "s"(rlx_) : "memory", "scc"); \
        else PG8_WAIT_V(8); } while (0)
#define PG8_BAR __builtin_amdgcn_s_barrier()
#define PG8_SCHED __builtin_amdgcn_sched_barrier(0)
#define PG8_MKOFF(u, o) do { _Pragma("unroll") for (int _h = 0; _h < 2; ++_h) _Pragma("unroll") for (int _i = 0; _i < 2; ++_i) { \
        int _row = (u).pm * BM + _h * HALF + Rr[_i]; if (MODE == 1) _row = mi.list[_row]; (o)[_h][_i] = (unsigned)_row * rowb + (unsigned)Cc[_i] * 2u; } } while (0)
#define PG8_BBASE(u) ((const char*)g.Bt + (size_t)(u).pn * tstep + (MODE != 0 ? (size_t)mi.tile_expert[(u).pm] * mi.bstride : (size_t)0))
    Unit cur, nxt; int ui = 0;
    if (!S.next(0, cur)) return;
#if PG8_STAGGER
    {
        const int grp = ((int)blockIdx.x >> 3) & 3;
        if (grp) { if (wid == 0) { const unsigned long long t0 = __builtin_amdgcn_s_memrealtime(); const unsigned long long dt = (unsigned long long)(grp * nt * PG8_STAGGER);
                       while (__builtin_amdgcn_s_memrealtime() - t0 < dt) __builtin_amdgcn_s_sleep(8); }
                   __syncthreads(); }
    }
#endif
    typedef typename AccT<PREC>::type acc_t;
    acc_t acc[2][2][4][2];
#pragma unroll
    for (int a = 0; a < 2; ++a)
#pragma unroll
        for (int b = 0; b < 2; ++b)
#pragma unroll
            for (int m = 0; m < 4; ++m)
#pragma unroll
                for (int n = 0; n < 2; ++n) acc[a][b][m][n] = acc_t{};
    bf16x8 At[4][2], B0[2][2], B1[2][2];
    const int one_scale = 0x7f7f7f7f;
    unsigned oc[2][2], on[2][2];
    const char* const Ab = (const char*)g.A;
    const char* cAu = Ab;
    if constexpr (MODE == 1) { PG8_MKOFF(cur, oc); } else { Unit u0_; u0_.pm = 0; u0_.pn = 0; PG8_MKOFF(u0_, oc); cAu = Ab + (size_t)cur.pm * tstep; }
    const char* cB = PG8_BBASE(cur);
    S.a_ready(cur);
    static_assert(SP2, "only the SP2 loop is kept");
    {
        PG8_STAGE(PG8_SB(0, 0), cB, voffB); PG8_STAGE(PG8_SB(0, 1), cB + hstep, voffB); PG8_STAGE(PG8_SA(0, 0), cAu, oc[0]); PG8_STAGE(PG8_SA(0, 1), cAu, oc[1]);
        if (wr == 1) PG8_BAR;
        PG8_WAIT_V(2); PG8_BAR;
        PG8_STAGE(PG8_SB(1, 0), cB + kstep, voffB); PG8_STAGE(PG8_SA(1, 0), cAu + kstep, oc[0]); PG8_STAGE(PG8_SB(1, 1), cB + hstep + kstep, voffB);
        PG8_WAIT_V(6); PG8_BAR;
    }
    Unit nn; unsigned onn[2][2]; bool has_next_c = false;
    if constexpr (MODE == 1) { has_next_c = S.next(1, nxt); if (has_next_c) PG8_MKOFF(nxt, on); }
    typename Epi::Pre pre;
    int rlx_flag = 0;
    for (;;) {
        bool has_next; bool has_nn = false;
        if constexpr (MODE == 1) { has_next = has_next_c; has_nn = has_next && S.next(ui + 2, nn); if (has_nn) PG8_MKOFF(nn, onn); }
        else has_next = S.next(ui + 1, nxt);
        const char* nB = cB; const char* nAu = cAu;
        if (has_next) { if constexpr (MODE != 1) nAu = Ab + (size_t)nxt.pm * tstep; nB = PG8_BBASE(nxt); }
        else if constexpr (MODE == 1) {
#pragma unroll
            for (int _h = 0; _h < 2; ++_h)
#pragma unroll
                for (int _i = 0; _i < 2; ++_i) on[_h][_i] = oc[_h][_i];
        }
        for (int t = 0; t < nt; t += 2) {
            const bool last = (t == nt - 2);
            i32x8 At8[4], B08[2], B18[2];
            const char* a1 = cAu + (size_t)(t + 1) * kstep;
            const char* a2 = last ? nAu : cAu + (size_t)(t + 2) * kstep; const char* b2 = last ? nB : cB + (size_t)(t + 2) * kstep;
            const char* a3 = a2 + kstep; const char* b3 = b2 + kstep;
            unsigned o2[2][2];
#pragma unroll
            for (int _h = 0; _h < 2; ++_h)
#pragma unroll
                for (int _i = 0; _i < 2; ++_i) o2[_h][_i] = (MODE == 1 && last) ? on[_h][_i] : oc[_h][_i];
            if (last && has_next) S.a_ready(nxt);
            PG8_LDB(B0, 0, 0); PG8_LDB(B1, 0, 1); PG8_SCHED; PG8_LDA(At, 0, 0); PG8_STAGE(PG8_SA(1, 1), a1, oc[1]);
            PG8_WAIT_V8R; PG8_WAIT_L(0); PG8_BAR; PG8_MMA(0, 0, At, B0); PG8_MMA(0, 1, At, B1); PG8_BAR; PG8_SCHED;
            PG8_LDA(At, 0, 1); PG8_STAGE(PG8_SB(0, 0), b2, voffB); PG8_STAGE(PG8_SB(0, 1), b2 + hstep, voffB); PG8_STAGE(PG8_SA(0, 0), a2, o2[0]);
            PG8_WAIT_V8R; PG8_WAIT_L(0); PG8_BAR; PG8_MMA(1, 0, At, B0); PG8_MMA(1, 1, At, B1); PG8_BAR; PG8_SCHED;
            PG8_LDB(B0, 1, 0); PG8_LDB(B1, 1, 1); PG8_SCHED; PG8_LDA(At, 1, 0); PG8_STAGE(PG8_SA(0, 1), a2, o2[1]);
            PG8_WAIT_V(8); PG8_WAIT_L(0); PG8_BAR; PG8_MMA(0, 0, At, B0); PG8_MMA(0, 1, At, B1); PG8_BAR; PG8_SCHED;
            PG8_LDA(At, 1, 1); PG8_STAGE(PG8_SB(1, 0), b3, voffB); PG8_STAGE(PG8_SB(1, 1), b3 + hstep, voffB); PG8_STAGE(PG8_SA(1, 0), a3, o2[0]);
            PG8_WAIT_V(8); PG8_WAIT_L(0); PG8_BAR; PG8_MMA(1, 0, At, B0); PG8_MMA(1, 1, At, B1); PG8_BAR; PG8_SCHED;
            rlx_flag = 0; asm volatile("" : "+s"(rlx_flag));
        }
        if constexpr (Epi::PRE != 0) E.prefetch(pre, cur, wr, wc, fr, fq);
        if constexpr (ALIGN_EPI) { if (wr == 0) PG8_BAR; }
        if constexpr (PREC == 2) asm volatile("s_nop 15\n\ts_nop 15" ::: "memory");
        if constexpr (Epi::PRE != 0) E(acc, cur, wr, wc, fr, fq, pre); else E(acc, cur, wr, wc, fr, fq);
        S.done(cur);
        if (!has_next) break;
#pragma unroll
        for (int a = 0; a < 2; ++a)
#pragma unroll
            for (int b = 0; b < 2; ++b)
#pragma unroll
                for (int m = 0; m < 4; ++m)
#pragma unroll
                    for (int n = 0; n < 2; ++n) acc[a][b][m][n] = acc_t{};
        cur = nxt; cB = nB; cAu = nAu; ++ui; rlx_flag = 1; asm volatile("" : "+s"(rlx_flag));
        if constexpr (MODE == 1) {
#pragma unroll
            for (int _h = 0; _h < 2; ++_h)
#pragma unroll
                for (int _i = 0; _i < 2; ++_i) oc[_h][_i] = on[_h][_i]; }
        if constexpr (MODE == 1) { nxt = nn; has_next_c = has_nn;
#pragma unroll
            for (int _h = 0; _h < 2; ++_h)
#pragma unroll
                for (int _i = 0; _i < 2; ++_i) on[_h][_i] = onn[_h][_i]; }
        if constexpr (ALIGN_EPI) { if (wr == 1) PG8_BAR; }
    }
    PG8_WAIT_V(0);
    if constexpr (!ALIGN_EPI) { if (wr == 0) PG8_BAR; }
    PG8_BAR;
#undef PG8_SA
#undef PG8_SB
#undef PG8_STAGE
#undef PG8_LDA
#undef PG8_LDB
#undef PG8_MMA
#undef PG8_WAIT_V
#undef PG8_WAIT_L
#undef PG8_WAIT_V8R
#undef PG8_BAR
#undef PG8_SCHED
#undef PG8_MKOFF
#undef PG8_BBASE
}
}
namespace pg8 {
constexpr float LOG2E = 1.4426950408889634f;
__device__ __forceinline__ f32x4 tof(const f32x4& a) { return a; }
__device__ __forceinline__ f32x4 tof(const i32x4& a) { return (f32x4){(float)a[0], (float)a[1], (float)a[2], (float)a[3]}; }
struct EpiBf16 {
    static constexpr bool PERM = true; static constexpr int NST = 16; static constexpr int PRE = 0; struct Pre {};
    bf16_t* O; int ldc; float scale;
    __device__ __forceinline__ void operator()(const f32x4 (&acc)[2][2][4][2], const Unit& u, int wr, int wc, int fr, int fq) const {
        const int row0 = u.pm * BM + wr * 64 + fr; const int col0 = u.pn * BM + wc * 32 + 8 * fq;
#pragma unroll
        for (int ai = 0; ai < 2; ++ai)
#pragma unroll
            for (int m = 0; m < 4; ++m) { bf16_t* rowp = O + (size_t)(row0 + ai * HALF + m * 16) * ldc + col0;
#pragma unroll
                for (int bj = 0; bj < 2; ++bj) { const f32x4 v0 = acc[ai][bj][m][0] * scale, v1 = acc[ai][bj][m][1] * scale;
                    u32x4 w; w.x = cvt_pk_bf16(v0[0], v0[1]); w.y = cvt_pk_bf16(v0[2], v0[3]); w.z = cvt_pk_bf16(v1[0], v1[1]); w.w = cvt_pk_bf16(v1[2], v1[3]);
                    *(u32x4*)(rowp + bj * HALF) = w; } }
    }
};
struct EpiQ {
    static constexpr bool PERM = true; static constexpr int NST = 16; static constexpr int PRE = 0; struct Pre {};
    bf16_t* O; int ldc; float scale; const float* cs;
    __device__ __forceinline__ void operator()(const f32x4 (&acc)[2][2][4][2], const Unit& u, int wr, int wc, int fr, int fq) const {
        const int row0 = u.pm * BM + wr * 64 + fr; const int col0 = u.pn * BM + wc * 32 + 8 * fq;
        const int grp = u.pn * 8 + wc;
#pragma unroll
        for (int bj = 0; bj < 2; ++bj) { const bool rope = ((grp + 4 * bj) % 3) == 2;
#pragma unroll
            for (int ai = 0; ai < 2; ++ai)
#pragma unroll
                for (int m = 0; m < 4; ++m) { const int row = row0 + ai * HALF + m * 16; bf16_t* rowp = O + (size_t)row * ldc + col0 + bj * HALF;
                    f32x4 v0 = acc[ai][bj][m][0] * scale, v1 = acc[ai][bj][m][1] * scale;
                    if (rope) { const f32x4* cp = (const f32x4*)(cs + (size_t)row * 32 + 8 * fq); const f32x4 c0 = cp[0], c1 = cp[1];
                        f32x4 r0, r1;
                        r0[0] = v0[0] * c0[0] - v0[1] * c0[1]; r0[1] = v0[0] * c0[1] + v0[1] * c0[0];
                        r0[2] = v0[2] * c0[2] - v0[3] * c0[3]; r0[3] = v0[2] * c0[3] + v0[3] * c0[2];
                        r1[0] = v1[0] * c1[0] - v1[1] * c1[1]; r1[1] = v1[0] * c1[1] + v1[1] * c1[0];
                        r1[2] = v1[2] * c1[2] - v1[3] * c1[3]; r1[3] = v1[2] * c1[3] + v1[3] * c1[2];
                        v0 = r0; v1 = r1; }
                    u32x4 w; w.x = cvt_pk_bf16(v0[0], v0[1]); w.y = cvt_pk_bf16(v0[2], v0[3]); w.z = cvt_pk_bf16(v1[0], v1[1]); w.w = cvt_pk_bf16(v1[2], v1[3]);
                    *(u32x4*)rowp = w;
                    if (m & 1) asm volatile("" ::: "memory"); } }
    }
};
struct EpiQQ {
    static constexpr bool PERM = true; static constexpr int NST = 16; static constexpr int PRE = 0; struct Pre {};
    bf16_t* O; const float* cs; const float* sA; const float* sB;
    __device__ __forceinline__ void operator()(const i32x4 (&acc)[2][2][4][2], const Unit& u, int wr, int wc, int fr, int fq) const {
        constexpr int ldc = 1536; constexpr float scale = 0.1472444460259031f;
        const int row0 = u.pm * BM + wr * 64 + fr; const int col0 = u.pn * BM + wc * 32 + 8 * fq;
        const int grp = u.pn * 8 + wc;
#pragma unroll
        for (int bj = 0; bj < 2; ++bj) { const bool rope = ((grp + 4 * bj) % 3) == 2;
            const f32x4 sb0 = *(const f32x4*)(sB + col0 + bj * HALF) * scale, sb1 = *(const f32x4*)(sB + col0 + bj * HALF + 4) * scale;
#pragma unroll
            for (int ai = 0; ai < 2; ++ai)
#pragma unroll
                for (int m = 0; m < 4; ++m) { const int row = row0 + ai * HALF + m * 16; bf16_t* rowp = O + (size_t)row * ldc + col0 + bj * HALF; const float sa = sA[row];
                    f32x4 v0 = tof(acc[ai][bj][m][0]) * sa * sb0, v1 = tof(acc[ai][bj][m][1]) * sa * sb1;
                    if (rope) { const f32x4* cp = (const f32x4*)(cs + (size_t)row * 32 + 8 * fq); const f32x4 c0 = cp[0], c1 = cp[1];
                        f32x4 r0, r1;
                        r0[0] = v0[0] * c0[0] - v0[1] * c0[1]; r0[1] = v0[0] * c0[1] + v0[1] * c0[0];
                        r0[2] = v0[2] * c0[2] - v0[3] * c0[3]; r0[3] = v0[2] * c0[3] + v0[3] * c0[2];
                        r1[0] = v1[0] * c1[0] - v1[1] * c1[1]; r1[1] = v1[0] * c1[1] + v1[1] * c1[0];
                        r1[2] = v1[2] * c1[2] - v1[3] * c1[3]; r1[3] = v1[2] * c1[3] + v1[3] * c1[2];
                        v0 = r0; v1 = r1; }
                    u32x4 w; w.x = cvt_pk_bf16(v0[0], v0[1]); w.y = cvt_pk_bf16(v0[2], v0[3]); w.z = cvt_pk_bf16(v1[0], v1[1]); w.w = cvt_pk_bf16(v1[2], v1[3]);
                    *(u32x4*)rowp = w;
                    if (m & 1) asm volatile("" ::: "memory"); } }
    }
};
struct EpiKVQ {
    static constexpr bool PERM = true; static constexpr int NST = 16; static constexpr int PRE = 0; struct Pre {};
    bf16_t* Kb; bf16_t* Vb; const float* sA; const float* sB;
    __device__ __forceinline__ void operator()(const i32x4 (&acc)[2][2][4][2], const Unit& u, int wr, int wc, int fr, int fq) const {
        const int row0 = u.pm * BM + wr * 64 + fr; const int col0 = u.pn * BM + wc * 32 + 8 * fq;
        const bool isk = wc < 2;
        bf16_t* const base = isk ? Kb : Vb; const int pitch = isk ? 1536 : 1024, hs = isk ? 96 : 64, j0 = (isk ? wc : wc - 2) * 32 + 8 * fq;
        f32x4 sb[2][2];
#pragma unroll
        for (int bj = 0; bj < 2; ++bj)
#pragma unroll
            for (int n = 0; n < 2; ++n) sb[bj][n] = *(const f32x4*)(sB + col0 + bj * HALF + 4 * n);
#pragma unroll
        for (int ai = 0; ai < 2; ++ai)
#pragma unroll
            for (int m = 0; m < 4; ++m) { const int row = row0 + ai * HALF + m * 16; bf16_t* rowp = base + (size_t)row * pitch + j0; const float sa = sA[row];
#pragma unroll
                for (int bj = 0; bj < 2; ++bj) { const f32x4 v0 = tof(acc[ai][bj][m][0]) * sa * sb[bj][0], v1 = tof(acc[ai][bj][m][1]) * sa * sb[bj][1];
                    u32x4 w; w.x = cvt_pk_bf16(v0[0], v0[1]); w.y = cvt_pk_bf16(v0[2], v0[3]); w.z = cvt_pk_bf16(v1[0], v1[1]); w.w = cvt_pk_bf16(v1[2], v1[3]);
                    *(u32x4*)(rowp + (2 * u.pn + bj) * hs) = w; } }
    }
};
struct EpiKV {
    static constexpr bool PERM = true; static constexpr int NST = 16; static constexpr int PRE = 0; struct Pre {};
    bf16_t* Kb; bf16_t* Vb;
    __device__ __forceinline__ void operator()(const f32x4 (&acc)[2][2][4][2], const Unit& u, int wr, int wc, int fr, int fq) const {
        const int row0 = u.pm * BM + wr * 64 + fr;
        const bool isk = wc < 2;
        bf16_t* const base = isk ? Kb : Vb; const int pitch = isk ? 1536 : 1024, hs = isk ? 96 : 64, j0 = (isk ? wc : wc - 2) * 32 + 8 * fq;
#pragma unroll
        for (int ai = 0; ai < 2; ++ai)
#pragma unroll
            for (int m = 0; m < 4; ++m) { bf16_t* rowp = base + (size_t)(row0 + ai * HALF + m * 16) * pitch + j0;
#pragma unroll
                for (int bj = 0; bj < 2; ++bj) { const f32x4 v0 = acc[ai][bj][m][0], v1 = acc[ai][bj][m][1];
                    u32x4 w; w.x = cvt_pk_bf16(v0[0], v0[1]); w.y = cvt_pk_bf16(v0[2], v0[3]); w.z = cvt_pk_bf16(v1[0], v1[1]); w.w = cvt_pk_bf16(v1[2], v1[3]);
                    *(u32x4*)(rowp + (2 * u.pn + bj) * hs) = w; } }
    }
};
template <bool BASEF32> struct EpiResid {
    static constexpr bool PERM = true; static constexpr int NST = 16; static constexpr int PRE = 0; struct Pre {};
    static constexpr int HP = 2048;
    const void* base; bf16_t* out; const float* gate; const float* sB;
    __device__ __forceinline__ void operator()(const f32x4 (&acc)[2][2][4][2], const Unit& u, int wr, int wc, int fr, int fq) const {
        const int row0 = u.pm * BM + wr * 64 + fr; const int col0 = u.pn * BM + wc * 32 + 8 * fq;
        const float* gp = gate + (size_t)((u.pm * BM) >> 13) * 1024 + col0;
        f32x4 gv[2][2];
#pragma unroll
        for (int bj = 0; bj < 2; ++bj)
#pragma unroll
            for (int n = 0; n < 2; ++n) { gv[bj][n] = *(const f32x4*)(gp + bj * HALF + n * 4); if (sB) gv[bj][n] = gv[bj][n] * *(const f32x4*)(sB + col0 + bj * HALF + n * 4); }
#pragma unroll
        for (int ai = 0; ai < 2; ++ai)
#pragma unroll
            for (int m = 0; m < 4; ++m) { const size_t row = (size_t)(row0 + ai * HALF + m * 16);
#pragma unroll
                for (int bj = 0; bj < 2; ++bj) { f32x4 b0, b1;
                    if (BASEF32) { const float* bp = (const float*)base + row * 1024 + col0 + bj * HALF; b0 = *(const f32x4*)bp; b1 = *(const f32x4*)(bp + 4); }
                    else { const u32x4 hb = *(const u32x4*)((const bf16_t*)base + row * HP + col0 + bj * HALF);
                        b0 = (f32x4){__builtin_bit_cast(float, hb.x << 16), __builtin_bit_cast(float, hb.x & 0xffff0000u), __builtin_bit_cast(float, hb.y << 16), __builtin_bit_cast(float, hb.y & 0xffff0000u)};
                        b1 = (f32x4){__builtin_bit_cast(float, hb.z << 16), __builtin_bit_cast(float, hb.z & 0xffff0000u), __builtin_bit_cast(float, hb.w << 16), __builtin_bit_cast(float, hb.w & 0xffff0000u)}; }
                    const f32x4 v0 = b0 + gv[bj][0] * acc[ai][bj][m][0], v1 = b1 + gv[bj][1] * acc[ai][bj][m][1];
                    u32x4 w; w.x = cvt_pk_bf16(v0[0], v0[1]); w.y = cvt_pk_bf16(v0[2], v0[3]); w.z = cvt_pk_bf16(v1[0], v1[1]); w.w = cvt_pk_bf16(v1[2], v1[3]);
                    *(u32x4*)(out + row * HP + col0 + bj * HALF) = w; }
                if (m & 1) asm volatile("" ::: "memory"); }
    }
};
__device__ __forceinline__ float silu_mul(float g, float u) { return g * u * __builtin_amdgcn_rcpf(1.0f + __builtin_amdgcn_exp2f(-g * LOG2E)); }
struct EpiSwiGLU {
    static constexpr bool PERM = true; static constexpr int NST = 8; static constexpr int PRE = 0; struct Pre {};
    bf16_t* O; int ldc;
    __device__ __forceinline__ void operator()(const f32x4 (&acc)[2][2][4][2], const Unit& u, int wr, int wc, int fr, int fq) const {
        const int row0 = u.pm * BM + wr * 64 + fr; const int col0 = u.pn * HALF + wc * 32 + 8 * fq;
#pragma unroll
        for (int ai = 0; ai < 2; ++ai)
#pragma unroll
            for (int m = 0; m < 4; ++m) { bf16_t* rowp = O + (size_t)(row0 + ai * HALF + m * 16) * ldc + col0;
                const f32x4 g0 = acc[ai][0][m][0], g1 = acc[ai][0][m][1], u0 = acc[ai][1][m][0], u1 = acc[ai][1][m][1];
                u32x4 w; w.x = cvt_pk_bf16(silu_mul(g0[0], u0[0]), silu_mul(g0[1], u0[1])); w.y = cvt_pk_bf16(silu_mul(g0[2], u0[2]), silu_mul(g0[3], u0[3]));
                w.z = cvt_pk_bf16(silu_mul(g1[0], u1[0]), silu_mul(g1[1], u1[1])); w.w = cvt_pk_bf16(silu_mul(g1[2], u1[2]), silu_mul(g1[3], u1[3]));
                *(u32x4*)rowp = w; }
    }
};
struct EpiMoeDown {
    static constexpr bool PERM = true; static constexpr int NST = 16; static constexpr int PRE = 12;
    struct Pre { float sg[8]; f32x4 sv[2][2]; };
    bf16_t* O; const float* sg; const float* sB; const int* tile_expert;
    __device__ __forceinline__ void prefetch(Pre& p, const Unit& u, int wr, int wc, int fr, int fq) const {
        const int row0 = u.pm * BM + wr * 64 + fr; const int col0 = u.pn * BM + wc * 32 + 8 * fq;
        const float* sb = sB + (size_t)tile_expert[u.pm] * 1024 + col0;
#pragma unroll
        for (int ai = 0; ai < 2; ++ai)
#pragma unroll
            for (int m = 0; m < 4; ++m) p.sg[ai * 4 + m] = sg[row0 + ai * HALF + m * 16];
#pragma unroll
        for (int bj = 0; bj < 2; ++bj)
#pragma unroll
            for (int n = 0; n < 2; ++n) p.sv[bj][n] = *(const f32x4*)(sb + bj * HALF + 4 * n);
    }
    __device__ __forceinline__ void operator()(const f32x4 (&acc)[2][2][4][2], const Unit& u, int wr, int wc, int fr, int fq, const Pre& p) const {
        const int row0 = u.pm * BM + wr * 64 + fr; const int col0 = u.pn * BM + wc * 32 + 8 * fq;
#pragma unroll
        for (int ai = 0; ai < 2; ++ai)
#pragma unroll
            for (int m = 0; m < 4; ++m) { const int row = row0 + ai * HALF + m * 16; const float s = p.sg[ai * 4 + m]; bf16_t* rowp = O + (size_t)row * 1024 + col0;
#pragma unroll
                for (int bj = 0; bj < 2; ++bj) { const f32x4 v0 = acc[ai][bj][m][0] * p.sv[bj][0] * s, v1 = acc[ai][bj][m][1] * p.sv[bj][1] * s;
                    u32x4 w; w.x = cvt_pk_bf16(v0[0], v0[1]); w.y = cvt_pk_bf16(v0[2], v0[3]); w.z = cvt_pk_bf16(v1[0], v1[1]); w.w = cvt_pk_bf16(v1[2], v1[3]);
                    *(u32x4*)(rowp + bj * HALF) = w; } }
    }
};
template <bool KV> struct EpiDil {
    static constexpr bool PERM = true; static constexpr int NST = 16; static constexpr int PRE = 0; struct Pre {};
    bf16_t* O; float scale;
    __device__ __forceinline__ void operator()(const f32x4 (&acc)[2][2][4][2], const Unit& u, int wr, int wc, int fr, int fq) const {
        const int row0 = u.pm * BM + wr * 64 + fr;
#pragma unroll
        for (int bj = 0; bj < 2; ++bj) { const int col = u.pn * BM + bj * HALF + wc * 32 + 8 * fq;
            const int g = KV ? (col >> 10) : (col >> 9), h = (col >> 6) & 7, d = col & 63, kv = KV ? ((col >> 9) & 1) : 0;
            const int sh = 2 * g;
#pragma unroll
            for (int ai = 0; ai < 2; ++ai)
#pragma unroll
                for (int m = 0; m < 4; ++m) { const int row = row0 + ai * HALF + m * 16, b = row >> 13, t = row & 8191;
                    const int r = t & ((1 << sh) - 1), pos = t >> sh;
                    const size_t rec = (size_t)g * 262144 + (size_t)((((b << sh) + r) * 8 + h) * (8192 >> sh) + pos);
                    bf16_t* dst = KV ? (O + rec * 128 + kv * 64 + d) : (O + rec * 64 + d);
                    const f32x4 v0 = acc[ai][bj][m][0] * scale, v1 = acc[ai][bj][m][1] * scale;
                    u32x4 w; w.x = cvt_pk_bf16(v0[0], v0[1]); w.y = cvt_pk_bf16(v0[2], v0[3]); w.z = cvt_pk_bf16(v1[0], v1[1]); w.w = cvt_pk_bf16(v1[2], v1[3]);
                    *(u32x4*)dst = w; } }
    }
};
}
namespace pg8 {
__device__ __forceinline__ f32x4 i2f(const i32x4& a, float sa, const f32x4& sb) { return (f32x4){(float)a[0], (float)a[1], (float)a[2], (float)a[3]} * sa * sb; }
struct EpiBf16Q {
    static constexpr bool PERM = true; static constexpr int NST = 16; static constexpr int PRE = 0; struct Pre {};
    bf16_t* O; int ldc; const float* sA; const float* sB;
    __device__ __forceinline__ void operator()(const i32x4 (&acc)[2][2][4][2], const Unit& u, int wr, int wc, int fr, int fq) const {
        const int row0 = u.pm * BM + wr * 64 + fr; const int col0 = u.pn * BM + wc * 32 + 8 * fq;
        f32x4 sb[2][2];
#pragma unroll
        for (int bj = 0; bj < 2; ++bj)
#pragma unroll
            for (int n = 0; n < 2; ++n) sb[bj][n] = *(const f32x4*)(sB + col0 + bj * HALF + 4 * n);
#pragma unroll
        for (int ai = 0; ai < 2; ++ai)
#pragma unroll
            for (int m = 0; m < 4; ++m) { const int row = row0 + ai * HALF + m * 16; const float sa = sA[row]; bf16_t* rowp = O + (size_t)row * ldc + col0;
#pragma unroll
                for (int bj = 0; bj < 2; ++bj) { const f32x4 v0 = i2f(acc[ai][bj][m][0], sa, sb[bj][0]), v1 = i2f(acc[ai][bj][m][1], sa, sb[bj][1]);
                    u32x4 w; w.x = cvt_pk_bf16(v0[0], v0[1]); w.y = cvt_pk_bf16(v0[2], v0[3]); w.z = cvt_pk_bf16(v1[0], v1[1]); w.w = cvt_pk_bf16(v1[2], v1[3]);
                    *(u32x4*)(rowp + bj * HALF) = w; } }
    }
};
template <bool KV> struct EpiDilQ {
    static constexpr bool PERM = true; static constexpr int NST = 16; static constexpr int PRE = 12;
    struct Pre { float sa[8]; f32x4 sb[2][2]; };
    bf16_t* O; const float* sA; const float* sB;
    __device__ __forceinline__ void prefetch(Pre& p, const Unit& u, int wr, int wc, int fr, int fq) const {
        const int row0 = u.pm * BM + wr * 64 + fr;
#pragma unroll
        for (int ai = 0; ai < 2; ++ai)
#pragma unroll
            for (int m = 0; m < 4; ++m) p.sa[ai * 4 + m] = sA[row0 + ai * HALF + m * 16];
#pragma unroll
        for (int bj = 0; bj < 2; ++bj) { const int col = u.pn * BM + bj * HALF + wc * 32 + 8 * fq; p.sb[bj][0] = *(const f32x4*)(sB + col); p.sb[bj][1] = *(const f32x4*)(sB + col + 4); }
    }
    __device__ __forceinline__ void operator()(const i32x4 (&acc)[2][2][4][2], const Unit& u, int wr, int wc, int fr, int fq, const Pre& p) const {
        bf16_t* const O_ = O; constexpr float scale_ = KV ? 1.0f : 0.18033688011112042f;
        const int row0 = u.pm * BM + wr * 64 + fr;
        const int colt = u.pn * BM;
        const int g = KV ? (colt >> 10) : (colt >> 9), kv = KV ? ((colt >> 9) & 1) : 0, sh = 2 * g, npos = 8192 >> sh;
        constexpr int RS = KV ? 128 : 64;
        const int d = (wc & 1) * 32 + 8 * fq;
        size_t hoff[2]; f32x4 sb[2][2];
#pragma unroll
        for (int bj = 0; bj < 2; ++bj) { const int col = colt + bj * HALF + wc * 32 + 8 * fq; const int h = (col >> 6) & 7;
            hoff[bj] = (size_t)h * npos * RS + kv * 64 + d; sb[bj][0] = p.sb[bj][0] * scale_; sb[bj][1] = p.sb[bj][1] * scale_; }
#pragma unroll
        for (int ai = 0; ai < 2; ++ai)
#pragma unroll
            for (int m = 0; m < 4; ++m) { const int row = row0 + ai * HALF + m * 16, b = row >> 13, t = row & 8191;
                const int r = t & ((1 << sh) - 1), pos = t >> sh;
                bf16_t* rp = O_ + ((size_t)g * 262144 + (size_t)(((b << sh) + r) * 8 * npos + pos)) * RS;
                const float sa = p.sa[ai * 4 + m];
#pragma unroll
                for (int bj = 0; bj < 2; ++bj) { const f32x4 v0 = i2f(acc[ai][bj][m][0], sa, sb[bj][0]), v1 = i2f(acc[ai][bj][m][1], sa, sb[bj][1]);
                    u32x4 w; w.x = cvt_pk_bf16(v0[0], v0[1]); w.y = cvt_pk_bf16(v0[2], v0[3]); w.z = cvt_pk_bf16(v1[0], v1[1]); w.w = cvt_pk_bf16(v1[2], v1[3]);
                    *(u32x4*)(rp + hoff[bj]) = w; }
                if (m & 1) asm volatile("" ::: "memory"); }
    }
};
constexpr float HSCALE = 8.0f;
__device__ __forceinline__ unsigned pk4_fp8(float a, float b, float c, float d) {
    a = __builtin_fminf(__builtin_fmaxf(a, -448.f), 448.f); b = __builtin_fminf(__builtin_fmaxf(b, -448.f), 448.f); c = __builtin_fminf(__builtin_fmaxf(c, -448.f), 448.f); d = __builtin_fminf(__builtin_fmaxf(d, -448.f), 448.f);
    int w = 0; w = __builtin_amdgcn_cvt_pk_fp8_f32(a, b, w, false); w = __builtin_amdgcn_cvt_pk_fp8_f32(c, d, w, true); return (unsigned)w; }
struct EpiSwiGLUQ {
    static constexpr bool PERM = true; static constexpr int NST = 8; static constexpr int PRE = 12;
    struct Pre { float sa[8]; f32x4 sg0, sg1, su0, su1; };
    unsigned char* O; int ldc; const float* sA; const float* sB; const int* tile_expert;
    __device__ __forceinline__ void prefetch(Pre& p, const Unit& u, int wr, int wc, int fr, int fq) const {
        const int row0 = u.pm * BM + wr * 64 + fr;
        const float* sb = sB + (tile_expert ? (size_t)tile_expert[u.pm] * (2 * 2816) : (size_t)0) + u.pn * BM + wc * 32 + 8 * fq;
#pragma unroll
        for (int ai = 0; ai < 2; ++ai)
#pragma unroll
            for (int m = 0; m < 4; ++m) p.sa[ai * 4 + m] = sA[row0 + ai * HALF + m * 16];
        p.sg0 = *(const f32x4*)sb; p.sg1 = *(const f32x4*)(sb + 4); p.su0 = *(const f32x4*)(sb + HALF); p.su1 = *(const f32x4*)(sb + HALF + 4);
    }
    __device__ __forceinline__ void operator()(const i32x4 (&acc)[2][2][4][2], const Unit& u, int wr, int wc, int fr, int fq, const Pre& p) const {
        const int row0 = u.pm * BM + wr * 64 + fr; const int col0 = u.pn * HALF + wc * 32 + 8 * fq;
        const f32x4 sg0 = p.sg0, sg1 = p.sg1, su0 = p.su0 * HSCALE, su1 = p.su1 * HSCALE;
        typedef unsigned u32x2 __attribute__((ext_vector_type(2)));
#pragma unroll
        for (int ai = 0; ai < 2; ++ai)
#pragma unroll
            for (int m = 0; m < 4; ++m) { const int row = row0 + ai * HALF + m * 16; const float sa = p.sa[ai * 4 + m]; unsigned char* rowp = O + (size_t)row * ldc + col0;
                const f32x4 g0 = i2f(acc[ai][0][m][0], sa, sg0), g1 = i2f(acc[ai][0][m][1], sa, sg1), u0 = i2f(acc[ai][1][m][0], sa, su0), u1 = i2f(acc[ai][1][m][1], sa, su1);
                u32x2 w; w.x = pk4_fp8(silu_mul(g0[0], u0[0]), silu_mul(g0[1], u0[1]), silu_mul(g0[2], u0[2]), silu_mul(g0[3], u0[3]));
                w.y = pk4_fp8(silu_mul(g1[0], u1[0]), silu_mul(g1[1], u1[1]), silu_mul(g1[2], u1[2]), silu_mul(g1[3], u1[3]));
                *(u32x2*)rowp = w; }
    }
};
}
namespace att {
using bf16 = unsigned short;
using bf16x8 = __attribute__((ext_vector_type(8))) short;
using s16x4 = __attribute__((ext_vector_type(4))) short;
using f32x16 = __attribute__((ext_vector_type(16))) float;
using u32x4 = __attribute__((ext_vector_type(4))) unsigned;
constexpr int NW = 8;
constexpr float THR = 8.0f;
__device__ __forceinline__ int crow(int r, int hi) { return (r & 3) + 8 * (r >> 2) + 4 * hi; }
__device__ __forceinline__ void glds16(const void* gsrc, unsigned lds_dst) { unsigned keep;
    asm volatile("s_mov_b32 %0, m0\n\ts_mov_b32 m0, %2\n\ts_nop 0\n\tglobal_load_lds_dwordx4 %1, off\n\ts_mov_b32 m0, %0" : "=&s"(keep) : "v"(gsrc), "s"(lds_dst) : "memory"); }
typedef float f32x2_t __attribute__((ext_vector_type(2))); typedef __bf16 bf16x2_t __attribute__((ext_vector_type(2)));
__device__ __forceinline__ unsigned cvtpk_s(float lo, float hi) { f32x2_t v = {lo, hi}; bf16x2_t b = __builtin_convertvector(v, bf16x2_t); return __builtin_bit_cast(unsigned, b); }
#define ATT_SBAR() __builtin_amdgcn_sched_barrier(0)
#define ATT_WAIT_BAR(N) asm volatile("s_waitcnt vmcnt(" #N ") lgkmcnt(0)\n\ts_barrier" ::: "memory")

template <int DQK> struct Lay {
    static constexpr int NKC = DQK / 8, KSLOT = NKC * 1024, ND0 = DQK / 16;
    static constexpr int LK = 0, LV = 3 * KSLOT, LWS = LV + 3 * 8192, LOST = LWS + NW * 256, LBIAS = LOST + NW * 4096, LEND = LBIAS + 1024;
};
static_assert(Lay<96>::LEND <= 131072 && Lay<64>::LEND <= 131072, "attention LDS");

__device__ __forceinline__ float rowmax32(const f32x16& p0, const f32x16& p1) {
    float a = __builtin_fmaxf(__builtin_fmaxf(p0[0], p0[1]), p1[0]), b = __builtin_fmaxf(__builtin_fmaxf(p0[2], p0[3]), p1[1]); a = __builtin_fmaxf(__builtin_fmaxf(a, p1[2]), p1[3]);
#pragma unroll
    for (int r = 4; r < 16; r += 4) { a = __builtin_fmaxf(__builtin_fmaxf(a, p0[r]), p0[r + 1]); b = __builtin_fmaxf(__builtin_fmaxf(b, p0[r + 2]), p0[r + 3]); a = __builtin_fmaxf(__builtin_fmaxf(a, p1[r]), p1[r + 1]); b = __builtin_fmaxf(__builtin_fmaxf(b, p1[r + 2]), p1[r + 3]); }
    float m = __builtin_fmaxf(a, b);
    auto rr = __builtin_amdgcn_permlane32_swap(__float_as_uint(m), __float_as_uint(m), false, false);
    return __builtin_fmaxf(__uint_as_float(rr[0]), __uint_as_float(rr[1]));
}
__device__ __forceinline__ void pv(f32x16* o, int vb, bf16x8 pa0, bf16x8 pa1, bf16x8 pa2, bf16x8 pa3) {
#pragma unroll
    for (int d0 = 0; d0 < 2; ++d0) { s16x4 lo[4], hi[4];
#pragma unroll
        for (int ks = 0; ks < 4; ++ks) {
            asm volatile("ds_read_b64_tr_b16 %0,%1 offset:%c2" : "=&v"(lo[ks]) : "v"(vb), "i"(d0 * 4096 + ks * 1024) : "memory");
            asm volatile("ds_read_b64_tr_b16 %0,%1 offset:%c2" : "=&v"(hi[ks]) : "v"(vb), "i"(d0 * 4096 + ks * 1024 + 512) : "memory"); }
        asm volatile("s_waitcnt lgkmcnt(0)" ::: "memory"); ATT_SBAR();
#define ATT_PK(k) (bf16x8){lo[k][0], lo[k][1], lo[k][2], lo[k][3], hi[k][0], hi[k][1], hi[k][2], hi[k][3]}
        o[d0] = __builtin_amdgcn_mfma_f32_32x32x16_bf16(pa0, ATT_PK(0), o[d0], 0, 0, 0);
        o[d0] = __builtin_amdgcn_mfma_f32_32x32x16_bf16(pa1, ATT_PK(1), o[d0], 0, 0, 0);
        o[d0] = __builtin_amdgcn_mfma_f32_32x32x16_bf16(pa2, ATT_PK(2), o[d0], 0, 0, 0);
        o[d0] = __builtin_amdgcn_mfma_f32_32x32x16_bf16(pa3, ATT_PK(3), o[d0], 0, 0, 0);
#undef ATT_PK
    }
}

template <int DQK, bool DIL>
__device__ __forceinline__ void attn_unit(const bf16* Qb, int pq, const bf16* __restrict__ Kb, int pk, const bf16* __restrict__ Vb, int pvp, bf16* Ob, int po, float* lse, const float* biasg,
                                          long rowbase, int dil, int q0, char* shm) {
    typedef Lay<DQK> L;
    const int tid = threadIdx.x, lane = tid & 63, r32 = lane & 31, hi = lane >> 5; const int wid = __builtin_amdgcn_readfirstlane(tid >> 6);
    const unsigned lds0 = (unsigned)(uintptr_t)shm;
    float* wsf = (float*)(shm + L::LWS) + wid * 64;
    const int kpos0 = DIL ? q0 - 128 : 0;
    const int t_begin = DIL ? (q0 == 0 ? 2 : 0) : 0;
    const int t_end = DIL ? 6 : (q0 + 256) / 64;
    const int wt0 = DIL ? (wid >> 1) : 0;
    const int wt1 = DIL ? 2 + (wid >> 1) : (q0 + 32 * wid + 31) / 64;
    const bool two_k = (L::NKC > 8) && (wid + 8 < L::NKC);
#define ATT_GROW(pos) (rowbase + (long)(pos) * dil)
#define ATT_ISSUE(t, s) do { const int kp_ = kpos0 + 64 * (t); \
        glds16(Kb + ATT_GROW(kp_ + lane) * pk + wid * 8, (unsigned)__builtin_amdgcn_readfirstlane(lds0 + L::LK + (s) * L::KSLOT + wid * 1024)); \
        if (two_k) glds16(Kb + ATT_GROW(kp_ + lane) * pk + (wid + 8) * 8, (unsigned)__builtin_amdgcn_readfirstlane(lds0 + L::LK + (s) * L::KSLOT + (wid + 8) * 1024)); \
        glds16(Vb + ATT_GROW(kp_ + 16 * (wid & 3) + (lane >> 2)) * pvp + (wid >> 2) * 32 + (lane & 3) * 8, (unsigned)__builtin_amdgcn_readfirstlane(lds0 + L::LV + (s) * 8192 + wid * 1024)); } while (0)
    if (DIL) { if (tid < 129) ((float*)(shm + L::LBIAS))[tid] = biasg[tid]; }
    ATT_ISSUE(t_begin, 0);
    if (t_begin + 1 < t_end) ATT_ISSUE(t_begin + 1, 1);
    bf16x8 qr[L::ND0];
    { const bf16* Qw = Qb + ATT_GROW(q0 + wid * 32 + r32) * pq + hi * 8;
#pragma unroll
      for (int d0 = 0; d0 < L::ND0; ++d0) qr[d0] = *reinterpret_cast<const bf16x8*>(Qw + d0 * 16); }
    float mhat = 0.f, l_reg = 0.f; f32x16 o[2]; o[0] = f32x16{}; o[1] = f32x16{}; f32x16 negm = f32x16{};
    bool first = true;
    const int qrel = (DIL ? 128 : q0) + wid * 32 + r32;
    const int vbl = (int)(lds0 + L::LV) + ((lane >> 4) & 1) * 32 + (lane & 3) * 8 + (4 * hi + ((lane & 15) >> 2)) * 64;
    int slot = 0;
    for (int t = t_begin; t < t_end; ++t) {
        if (t + 1 < t_end) { if (two_k) ATT_WAIT_BAR(3); else ATT_WAIT_BAR(2); } else ATT_WAIT_BAR(0);
        if (t + 2 < t_end) { const int s2 = slot >= 1 ? slot - 1 : 2; ATT_ISSUE(t + 2, s2); }
        if (t >= wt0 && t <= wt1) {
            f32x16 p0, p1;
            { const char* kb = shm + L::LK + slot * L::KSLOT + hi * 1024 + r32 * 16;
#pragma unroll
              for (int d0 = 0; d0 < L::ND0; ++d0) {
                const bf16x8 b0 = *reinterpret_cast<const bf16x8*>(kb + d0 * 2048);
                const bf16x8 b1 = *reinterpret_cast<const bf16x8*>(kb + d0 * 2048 + 512);
                if (d0 == 0) { p0 = __builtin_amdgcn_mfma_f32_32x32x16_bf16(b0, qr[0], negm, 0, 0, 0); p1 = __builtin_amdgcn_mfma_f32_32x32x16_bf16(b1, qr[0], negm, 0, 0, 0); }
                else { p0 = __builtin_amdgcn_mfma_f32_32x32x16_bf16(b0, qr[d0], p0, 0, 0, 0); p1 = __builtin_amdgcn_mfma_f32_32x32x16_bf16(b1, qr[d0], p1, 0, 0, 0); } } }
            if (DIL) { const float* bl = (const float*)(shm + L::LBIAS); const int jb = qrel - 64 * t - 4 * hi;
#pragma unroll
                for (int r = 0; r < 16; ++r) { const int j0 = jb - ((r & 3) + 8 * (r >> 2)), j1 = j0 - 32;
                    const int c0 = j0 < 0 ? 0 : (j0 > 128 ? 128 : j0), c1 = j1 < 0 ? 0 : (j1 > 128 ? 128 : j1);
                    const float b0 = bl[c0], b1 = bl[c1];
                    p0[r] = (j0 >= 0 && j0 <= 128) ? p0[r] + b0 : -INFINITY; p1[r] = (j1 >= 0 && j1 <= 128) ? p1[r] + b1 : -INFINITY; }
            } else if (64 * t + 63 > q0 + 32 * wid) { const int jb = qrel - 64 * t - 4 * hi;
#pragma unroll
                for (int r = 0; r < 16; ++r) { const int j0 = jb - ((r & 3) + 8 * (r >> 2)); if (j0 < 0) p0[r] = -INFINITY; if (j0 - 32 < 0) p1[r] = -INFINITY; } }
            const float rm = rowmax32(p0, p1);
            if (first) { first = false; const float dl = rm; mhat += dl;
#pragma unroll
                for (int r = 0; r < 16; ++r) { p0[r] -= dl; p1[r] -= dl; }
#pragma unroll
                for (int r = 0; r < 16; ++r) negm[r] = -mhat;
            } else if (__any(rm > THR)) { const float dl = __builtin_fmaxf(rm, 0.f); mhat += dl;
#pragma unroll
                for (int r = 0; r < 16; ++r) { p0[r] -= dl; p1[r] -= dl; }
#pragma unroll
                for (int r = 0; r < 16; ++r) negm[r] = -mhat;
                const float f = __builtin_amdgcn_exp2f(-dl); l_reg *= f; if (hi == 0) wsf[r32] = f;
                asm volatile("s_waitcnt lgkmcnt(0)" ::: "memory");
#pragma unroll
                for (int d_ = 0; d_ < 2; ++d_)
#pragma unroll
                    for (int r = 0; r < 16; ++r) o[d_][r] *= wsf[crow(r, hi)];
                asm volatile("s_waitcnt lgkmcnt(0)" ::: "memory");
            }
            float sacc = 0.f;
#pragma unroll
            for (int r = 0; r < 16; ++r) { p0[r] = __builtin_amdgcn_exp2f(p0[r]); p1[r] = __builtin_amdgcn_exp2f(p1[r]); sacc += p0[r] + p1[r]; }
            l_reg += sacc;
            u32x4 pw0, pw1, pw2, pw3;
#define ATT_PKW(P, B) cvtpk_s(P[B], P[B + 1])
            pw0 = (u32x4){ATT_PKW(p0, 0), ATT_PKW(p0, 2), ATT_PKW(p0, 4), ATT_PKW(p0, 6)}; pw1 = (u32x4){ATT_PKW(p0, 8), ATT_PKW(p0, 10), ATT_PKW(p0, 12), ATT_PKW(p0, 14)};
            pw2 = (u32x4){ATT_PKW(p1, 0), ATT_PKW(p1, 2), ATT_PKW(p1, 4), ATT_PKW(p1, 6)}; pw3 = (u32x4){ATT_PKW(p1, 8), ATT_PKW(p1, 10), ATT_PKW(p1, 12), ATT_PKW(p1, 14)};
#undef ATT_PKW
            ATT_SBAR();
            pv(o, vbl + slot * 8192, __builtin_bit_cast(bf16x8, pw0), __builtin_bit_cast(bf16x8, pw1), __builtin_bit_cast(bf16x8, pw2), __builtin_bit_cast(bf16x8, pw3));
        }
        slot = slot == 2 ? 0 : slot + 1;
    }
    { auto rr = __builtin_amdgcn_permlane32_swap(__float_as_uint(l_reg), __float_as_uint(l_reg), false, false); l_reg = __uint_as_float(rr[0]) + __uint_as_float(rr[1]); }
    if (hi == 0) wsf[32 + r32] = l_reg;
    asm volatile("s_waitcnt lgkmcnt(0)" ::: "memory");
    float rli[16];
#pragma unroll
    for (int r = 0; r < 16; ++r) rli[r] = __builtin_amdgcn_rcpf(wsf[32 + crow(r, hi)]);
    if (DIL) { if (hi == 0) lse[ATT_GROW(q0 + wid * 32 + r32) * 8] = mhat + __builtin_amdgcn_logf(l_reg); }
    { bf16* stg = (bf16*)(shm + L::LOST) + wid * 2048;
#pragma unroll
      for (int r = 0; r < 16; ++r) { const int orow = crow(r, hi);
#pragma unroll
        for (int d0 = 0; d0 < 2; ++d0) stg[orow * 64 + d0 * 32 + r32] = (bf16)(cvtpk_s(o[d0][r] * rli[r], 0.f) & 0xffffu); }
      asm volatile("s_waitcnt lgkmcnt(0)" ::: "memory");
#pragma unroll
      for (int i = 0; i < 4; ++i) { const int row = i * 8 + (lane >> 3), ch = lane & 7; const u32x4 v = *(const u32x4*)(stg + row * 64 + ch * 8);
        *(u32x4*)(Ob + ATT_GROW(q0 + wid * 32 + row) * po + ch * 8) = v; } }
    asm volatile("s_waitcnt lgkmcnt(0)\n\ts_barrier" ::: "memory");
#undef ATT_GROW
#undef ATT_ISSUE
}
#undef ATT_SBAR
#undef ATT_WAIT_BAR
}
namespace mla {
using bf16 = unsigned short;
using bf16x8 = __attribute__((ext_vector_type(8))) short;
using s16x4 = __attribute__((ext_vector_type(4))) short;
using f32x16 = __attribute__((ext_vector_type(16))) float;
using u32x4 = __attribute__((ext_vector_type(4))) unsigned;
constexpr int SEQL = 8192, PQ = 1536, PV = 1024, HQ = 96, HV = 64;
constexpr int NW = 8, QBLK = 32, QB = QBLK * NW, KVBLK = 64;
__device__ __forceinline__ int crow(int r, int hi) { return (r & 3) + 8 * (r >> 2) + 4 * hi; }
#define SBAR() __builtin_amdgcn_sched_barrier(0)
__device__ __forceinline__ void cmask(f32x16& p0, f32x16& p1, int jb, int qrel, int hi) {
    const float NEG = -INFINITY; int kb = 64 * jb + 4 * hi;
#pragma unroll
    for (int r = 0; r < 16; ++r) { int kv = kb + (r & 3) + 8 * (r >> 2); if (kv > qrel) p0[r] = NEG; if (kv + 32 > qrel) p1[r] = NEG; }
}
constexpr int NSLOT = 3, KSLOTB = 12288, VSLOTB = 8192;
constexpr int LDS_K = 0, LDS_V = NSLOT * KSLOTB, LDS_WS = LDS_V + NSLOT * VSLOTB, LDS_OST = LDS_WS + NW * 64 * 4, LDS_BYTES = LDS_OST + NW * 4096;
static_assert(LDS_BYTES <= 131072, "mla attention LDS");
__device__ __forceinline__ void glds16(const void* gsrc, unsigned lds_dst) { unsigned keep;
    asm volatile("s_mov_b32 %0, m0\n\ts_mov_b32 m0, %2\n\ts_nop 0\n\tglobal_load_lds_dwordx4 %1, off\n\ts_mov_b32 m0, %0" : "=&s"(keep) : "v"(gsrc), "s"(lds_dst) : "memory"); }
__device__ __forceinline__ float max3f(float a, float b, float c) { float r; asm("v_max3_f32 %0, %1, %2, %3" : "=v"(r) : "v"(a), "v"(b), "v"(c)); return r; }
__device__ __forceinline__ float max2f(float a, float b) { float r; asm("v_max_f32_e32 %0, %1, %2" : "=v"(r) : "v"(a), "v"(b)); return r; }
__device__ __forceinline__ float fadd_s(float a, float b) { float r; asm("v_add_f32_e32 %0, %1, %2" : "=v"(r) : "v"(a), "v"(b)); return r; }
__device__ __forceinline__ float fsub_s(float a, float b) { float r; asm("v_sub_f32_e32 %0, %1, %2" : "=v"(r) : "v"(a), "v"(b)); return r; }
typedef float f32x2_t __attribute__((ext_vector_type(2))); typedef __bf16 bf16x2_t __attribute__((ext_vector_type(2)));
__device__ __forceinline__ unsigned cvtpk_s(float lo, float hi) { f32x2_t v = {lo, hi}; bf16x2_t b = __builtin_convertvector(v, bf16x2_t); return __builtin_bit_cast(unsigned, b); }
#define WAIT_BAR(N) asm volatile("s_waitcnt vmcnt(" #N ") lgkmcnt(0)\n\ts_barrier" ::: "memory")

__device__ __forceinline__ void qkt(f32x16& p0, f32x16& p1, const char* Kslot, const bf16x8* qr, const f32x16& negm, int r32, int hi) {
    const char* kb = Kslot + hi * 1024 + r32 * 16;
#pragma unroll
    for (int d0 = 0; d0 < 6; ++d0) {
        const bf16x8 b0 = *reinterpret_cast<const bf16x8*>(kb + d0 * 2048);
        const bf16x8 b1 = *reinterpret_cast<const bf16x8*>(kb + d0 * 2048 + 512);
        if (d0 == 0) { p0 = __builtin_amdgcn_mfma_f32_32x32x16_bf16(b0, qr[0], negm, 0, 0, 0); p1 = __builtin_amdgcn_mfma_f32_32x32x16_bf16(b1, qr[0], negm, 0, 0, 0); }
        else { p0 = __builtin_amdgcn_mfma_f32_32x32x16_bf16(b0, qr[d0], p0, 0, 0, 0); p1 = __builtin_amdgcn_mfma_f32_32x32x16_bf16(b1, qr[d0], p1, 0, 0, 0); } }
}
typedef __attribute__((address_space(3))) const char* lds_cptr;
typedef short v4i16_t __attribute__((ext_vector_type(4)));
__device__ __forceinline__ void kload12(bf16x8* kf, lds_cptr kp) {
#pragma unroll
    for (int j = 0; j < 6; ++j) { kf[2 * j] = *(const __attribute__((address_space(3))) bf16x8*)(kp + j * 2048); kf[2 * j + 1] = *(const __attribute__((address_space(3))) bf16x8*)(kp + j * 2048 + 512); }
}
__device__ __forceinline__ void kload2(bf16x8* kf, lds_cptr kp, int j) { kf[2 * j] = *(const __attribute__((address_space(3))) bf16x8*)(kp + j * 2048); kf[2 * j + 1] = *(const __attribute__((address_space(3))) bf16x8*)(kp + j * 2048 + 512); }
__device__ __forceinline__ s16x4 vtr(lds_cptr p) { return __builtin_bit_cast(s16x4, __builtin_amdgcn_ds_read_tr16_b64_v4i16((__attribute__((address_space(3))) v4i16_t*)p)); }
__device__ __forceinline__ float rowmax(const f32x16& p0, const f32x16& p1) {
    float a = max3f(p0[0], p0[1], p1[0]), b = max3f(p0[2], p0[3], p1[1]); a = max3f(a, p1[2], p1[3]);
#pragma unroll
    for (int r = 4; r < 16; r += 4) { a = max3f(a, p0[r], p0[r + 1]); b = max3f(b, p0[r + 2], p0[r + 3]); a = max3f(a, p1[r], p1[r + 1]); b = max3f(b, p1[r + 2], p1[r + 3]); }
    const float m = max2f(a, b);
    auto rr = __builtin_amdgcn_permlane32_swap(__float_as_uint(m), __float_as_uint(m), false, false);
    return max2f(__uint_as_float(rr[0]), __uint_as_float(rr[1]));
}
__device__ __forceinline__ void pv(f32x16* o, int vb, bf16x8 pa0, bf16x8 pa1, bf16x8 pa2, bf16x8 pa3) {
#pragma unroll
    for (int d0 = 0; d0 < 2; ++d0) { s16x4 lo[4], hi[4];
#pragma unroll
        for (int ks = 0; ks < 4; ++ks) {
            asm volatile("ds_read_b64_tr_b16 %0,%1 offset:%c2" : "=&v"(lo[ks]) : "v"(vb), "i"(d0 * 4096 + ks * 1024) : "memory");
            asm volatile("ds_read_b64_tr_b16 %0,%1 offset:%c2" : "=&v"(hi[ks]) : "v"(vb), "i"(d0 * 4096 + ks * 1024 + 512) : "memory"); }
        asm volatile("s_waitcnt lgkmcnt(0)" ::: "memory"); SBAR();
#define PK(k) (bf16x8){lo[k][0], lo[k][1], lo[k][2], lo[k][3], hi[k][0], hi[k][1], hi[k][2], hi[k][3]}
        o[d0] = __builtin_amdgcn_mfma_f32_32x32x16_bf16(pa0, PK(0), o[d0], 0, 0, 0);
        o[d0] = __builtin_amdgcn_mfma_f32_32x32x16_bf16(pa1, PK(1), o[d0], 0, 0, 0);
        o[d0] = __builtin_amdgcn_mfma_f32_32x32x16_bf16(pa2, PK(2), o[d0], 0, 0, 0);
        o[d0] = __builtin_amdgcn_mfma_f32_32x32x16_bf16(pa3, PK(3), o[d0], 0, 0, 0);
#undef PK
    }
}

constexpr float OSCALE = 32.0f;
template <int THRL> __device__ __forceinline__ void attn_unit(int b, int h, int qb, const bf16* Q, const bf16* __restrict__ K, const bf16* __restrict__ V, unsigned char* O, char* shm) {
    int tid_ = threadIdx.x; asm volatile("" : "+v"(tid_));
    const int tid = tid_, lane = tid & 63, r32 = lane & 31, hi = lane >> 5; const int wid = __builtin_amdgcn_readfirstlane(tid >> 6);
    const long rowbase = (long)b * SEQL; const int q0 = qb * QB;
    const bf16* Qw = Q + (rowbase + q0 + wid * QBLK) * PQ + h * HQ;
    const bf16* Kh = K + rowbase * PQ + h * HQ; const bf16* Vh = V + rowbase * PV + h * HV;
    const unsigned lds0 = (unsigned)(uintptr_t)shm;
    float* wsf = (float*)(shm + LDS_WS) + wid * 64;
    const bool k2 = wid < 4;
    const bf16* ksrc = Kh + (long)lane * PQ + wid * 8;
    const bf16* vsrc = Vh + (long)(16 * (wid & 3) + (lane >> 2)) * PV + (wid >> 2) * 32 + (lane & 3) * 8;
    const unsigned kdst = lds0 + LDS_K + wid * 1024, vdst = lds0 + LDS_V + wid * 1024;
#define DMA_K(t, slot) do { glds16(ksrc + (long)(t) * KVBLK * PQ, (unsigned)__builtin_amdgcn_readfirstlane(kdst + (slot))); \
        if (k2) glds16(ksrc + (long)(t) * KVBLK * PQ + 64, (unsigned)__builtin_amdgcn_readfirstlane(kdst + (slot) + 8192)); } while (0)
#define DMA_V(t, slot) glds16(vsrc + (long)(t) * KVBLK * PV, (unsigned)__builtin_amdgcn_readfirstlane(vdst + (slot)))
    const int vb0 = (int)(lds0 + LDS_V) + ((lane >> 4) & 1) * 32 + (lane & 3) * 8 + (4 * hi + ((lane & 15) >> 2)) * 64;
    const char* Kbase = shm + LDS_K; bf16x8 kf[12];
    const lds_cptr shm3 = (lds_cptr)shm; const lds_cptr kp0 = shm3 + LDS_K + hi * 1024 + r32 * 16; const lds_cptr vp0 = shm3 + LDS_V + ((lane >> 4) & 1) * 32 + (lane & 3) * 8 + (4 * hi + ((lane & 15) >> 2)) * 64;
    const int NT = (q0 + QB) / KVBLK;
#define WAIT_KV() do { if (k2) WAIT_BAR(3); else WAIT_BAR(2); } while (0)
#define WAIT_KKV() do { if (k2) WAIT_BAR(5); else WAIT_BAR(3); } while (0)
    DMA_K(0, 0); DMA_V(0, 0); DMA_K(1, KSLOTB);
    bf16x8 qr[6];
#pragma unroll
    for (int d0 = 0; d0 < 6; ++d0) qr[d0] = *reinterpret_cast<const bf16x8*>(&Qw[(long)r32 * PQ + d0 * 16 + hi * 8]);
    float mhat = 0.f, l_reg = 0.f; f32x16 o[2]; o[0] = f32x16{}; o[1] = f32x16{}; f32x16 negm = f32x16{}; asm volatile("" : "+v"(negm));
    const int qrel = wid * QBLK + r32;
#define CMASK(P0, P1, t) do { int jb_ = (t) - (NT - 4); if (jb_ >= 0) cmask(P0, P1, jb_, qrel, hi); } while (0)
    bool resc = false;
#define START(P0, P1) do { const float rm = rowmax(P0, P1); resc = false; \
    { const float dl = rm; mhat = fadd_s(mhat, dl); \
      _Pragma("unroll") for (int r = 0; r < 16; ++r) { P0[r] = fsub_s(P0[r], dl); P1[r] = fsub_s(P1[r], dl); } \
      _Pragma("unroll") for (int r = 0; r < 16; ++r) negm[r] = -mhat; asm volatile("" : "+v"(negm)); } \
    _Pragma("unroll") for (int r = 0; r < 16; ++r) P0[r] = __builtin_amdgcn_exp2f(P0[r]); } while (0)
#define RESC() do { if (resc) { asm volatile("s_waitcnt lgkmcnt(0)" ::: "memory"); \
      _Pragma("unroll") for (int d_ = 0; d_ < 2; ++d_) _Pragma("unroll") for (int r = 0; r < 16; ++r) o[d_][r] *= wsf[crow(r, hi)]; } } while (0)
    f32x16 pA0, pA1, pB0, pB1;
    int sl_prev = 0, sl_cur = 0, sl_next = 1;
#define ROT() do { sl_prev = sl_cur; sl_cur = sl_next; sl_next = (sl_next == NSLOT - 1) ? 0 : sl_next + 1; } while (0)
    DMA_K(2, 2 * KSLOTB);
    WAIT_KKV();
    qkt(pA0, pA1, Kbase, qr, negm, r32, hi); asm volatile("s_nop 15\n\ts_nop 7" : "+v"(pA0), "+v"(pA1)); CMASK(pA0, pA1, 0);
    START(pA0, pA1);
#pragma unroll
    for (int r = 0; r < 16; ++r) pA1[r] = __builtin_amdgcn_exp2f(pA1[r]);
    WAIT_BAR(0);
    DMA_K(3, 0); DMA_V(1, VSLOTB);
    ROT();
    kload12(kf, kp0 + sl_cur * KSLOTB);
    WAIT_KV();
    s16x4 vlo[8], vhi[8]; u32x4 pw0, pw1, pw2, pw3;
#define PKW(P, B) cvtpk_s(P[B], P[B + 1])
#define PAF(k) __builtin_bit_cast(bf16x8, pw##k)
#define VFR(i) (bf16x8){vlo[i][0], vlo[i][1], vlo[i][2], vlo[i][3], vhi[i][0], vhi[i][1], vhi[i][2], vhi[i][3]}
#define PIN(x) asm volatile("" : "+v"(x))
#define MX3(a, b, c) __builtin_fmaxf(__builtin_fmaxf((a), (b)), (c))
#define GAPA(MF, A0, A1, A2, A3, W0, W1, PW) do { MF; sacc += A0; sacc += A1; sacc += A2; sacc += A3; PIN(sacc); W0; W1; PIN(PW); SBAR(); } while (0)
#define GAPM(MF) do { MF; SBAR(); } while (0)
#define EX(v) __builtin_amdgcn_exp2f(v)
#define GAPB(MF, X, B) do { MF; X[B] = EX(X[B]); X[B + 1] = EX(X[B + 1]); X[B + 2] = EX(X[B + 2]); X[B + 3] = EX(X[B + 3]); PIN(X); SBAR(); } while (0)
#define VRD(i) do { vlo[i] = vtr(vp_ + (((i) >> 2) * 4096 + ((i) & 3) * 1024)); vhi[i] = vtr(vp_ + (((i) >> 2) * 4096 + ((i) & 3) * 1024 + 512)); } while (0)
#define KRD(G, j) do { if (G) { kload2(kf, kp0 + sl_next * KSLOTB, j); SBAR(); } } while (0)
#define MF32(a, b, c) __builtin_amdgcn_mfma_f32_32x32x16_bf16(a, b, c, 0, 0, 0)
#define STEP(C0, C1, P0, P1, t, GK, GV, GL) do { SBAR(); \
    const lds_cptr vp_ = vp0 + sl_prev * VSLOTB; \
    float sacc = (P0[0] + P0[1]); \
    GAPA(C0 = MF32(kf[0], qr[0], negm), P0[2], P0[3], P0[4], P0[5],     pw0[0] = PKW(P0, 0), pw0[1] = PKW(P0, 2), pw0); \
    GAPA(C1 = MF32(kf[1], qr[0], negm), P0[6], P0[7], P0[8], P0[9],     pw0[2] = PKW(P0, 4), pw0[3] = PKW(P0, 6), pw0); \
    GAPA(C0 = MF32(kf[2], qr[1], C0),   P0[10], P0[11], P0[12], P0[13], pw1[0] = PKW(P0, 8), pw1[1] = PKW(P0, 10), pw1); \
    GAPA(C1 = MF32(kf[3], qr[1], C1),   P0[14], P0[15], P1[0], P1[1],   pw1[2] = PKW(P0, 12), pw1[3] = PKW(P0, 14), pw1); \
    VRD(0); SBAR(); GAPA(C0 = MF32(kf[4], qr[2], C0),   P1[2], P1[3], P1[4], P1[5],     pw2[0] = PKW(P1, 0), pw2[1] = PKW(P1, 2), pw2); \
    VRD(4); SBAR(); GAPA(C1 = MF32(kf[5], qr[2], C1),   P1[6], P1[7], P1[8], P1[9],     pw2[2] = PKW(P1, 4), pw2[3] = PKW(P1, 6), pw2); \
    VRD(1); SBAR(); GAPA(C0 = MF32(kf[6], qr[3], C0),   P1[10], P1[11], P1[12], P1[13], pw3[0] = PKW(P1, 8), pw3[1] = PKW(P1, 10), pw3); \
    VRD(5); SBAR(); GAPA(C1 = MF32(kf[7], qr[3], C1),   P1[14], P1[15], 0.f, 0.f,       pw3[2] = PKW(P1, 12), pw3[3] = PKW(P1, 14), pw3); \
    VRD(2); SBAR(); GAPM(C0 = MF32(kf[8], qr[4], C0)); VRD(6); SBAR(); GAPM(C1 = MF32(kf[9], qr[4], C1)); \
    VRD(3); SBAR(); GAPM(C0 = MF32(kf[10], qr[5], C0)); VRD(7); SBAR(); GAPM(C1 = MF32(kf[11], qr[5], C1)); \
    l_reg += sacc; \
    if (GK) { DMA_K((t) + 3, sl_cur * KSLOTB); } if (GV) { DMA_V((t) + 1, sl_next * VSLOTB); } \
    CMASK(C0, C1, t); \
    { float a = MX3(C0[0], C0[1], C1[0]), b = MX3(C0[2], C0[3], C1[1]); a = MX3(a, C1[2], C1[3]); \
      _Pragma("unroll") for (int r = 4; r < 16; r += 4) { a = MX3(a, C0[r], C0[r + 1]); b = MX3(b, C0[r + 2], C0[r + 3]); a = MX3(a, C1[r], C1[r + 1]); b = MX3(b, C1[r + 2], C1[r + 3]); } \
      float rm = __builtin_fmaxf(a, b); { auto rr = __builtin_amdgcn_permlane32_swap(__float_as_uint(rm), __float_as_uint(rm), false, false); rm = __builtin_fmaxf(__uint_as_float(rr[0]), __uint_as_float(rr[1])); } \
      resc = false; \
      if (__builtin_expect(__any(rm > (float)THRL), 0)) { const float dl = __builtin_fmaxf(rm, 0.f); mhat += dl; \
        _Pragma("unroll") for (int r = 0; r < 16; ++r) { C0[r] -= dl; C1[r] -= dl; } \
        _Pragma("unroll") for (int r = 0; r < 16; ++r) negm[r] = -mhat; asm volatile("" : "+v"(negm)); \
        const float f = __builtin_amdgcn_exp2f(-dl); l_reg *= f; if (hi == 0) wsf[r32] = f; resc = true; } } \
    SBAR(); \
    GAPB(o[0] = MF32(PAF(0), VFR(0), o[0]), C0, 0); \
    KRD(GL, 0); GAPB(o[1] = MF32(PAF(0), VFR(4), o[1]), C0, 4); \
    KRD(GL, 1); GAPB(o[0] = MF32(PAF(1), VFR(1), o[0]), C0, 8); \
    KRD(GL, 2); GAPB(o[1] = MF32(PAF(1), VFR(5), o[1]), C0, 12); \
    KRD(GL, 3); GAPB(o[0] = MF32(PAF(2), VFR(2), o[0]), C1, 0); \
    KRD(GL, 4); GAPB(o[1] = MF32(PAF(2), VFR(6), o[1]), C1, 4); \
    KRD(GL, 5); GAPB(o[0] = MF32(PAF(3), VFR(3), o[0]), C1, 8); \
    GAPB(o[1] = MF32(PAF(3), VFR(7), o[1]), C1, 12); \
    } while (0)
    int t = 1;
#undef CMASK
#define CMASK(P0, P1, t) do { } while (0)
    for (; t + 5 < NT; t += 2) {
        STEP(pB0, pB1, pA0, pA1, t, true, true, true);     WAIT_KV(); RESC(); ROT();
        STEP(pA0, pA1, pB0, pB1, t + 1, true, true, true); WAIT_KV(); RESC(); ROT();
    }
#undef CMASK
#define CMASK(P0, P1, t) do { int jb_ = (t) - (NT - 4); if (jb_ >= 0) cmask(P0, P1, jb_, qrel, hi); } while (0)
#define ENDW(tt) do { if ((tt) + 3 < NT) { WAIT_KV(); } else if ((tt) + 2 < NT) { WAIT_BAR(1); } else { WAIT_BAR(0); } } while (0)
    for (; t + 1 < NT; t += 2) {
        STEP(pB0, pB1, pA0, pA1, t, (t + 3 < NT), (t + 1 < NT), (t + 1 < NT));         ENDW(t);     RESC(); ROT();
        STEP(pA0, pA1, pB0, pB1, t + 1, (t + 4 < NT), (t + 2 < NT), (t + 2 < NT));     ENDW(t + 1); RESC(); ROT();
    }
    STEP(pB0, pB1, pA0, pA1, NT - 1, false, false, false); RESC();
    { float sacc = pB0[0] + pB0[1];
#pragma unroll
      for (int r = 2; r < 16; ++r) sacc += pB0[r];
#pragma unroll
      for (int r = 0; r < 16; ++r) sacc += pB1[r];
      l_reg += sacc;
      pw0 = (u32x4){PKW(pB0, 0), PKW(pB0, 2), PKW(pB0, 4), PKW(pB0, 6)}; pw1 = (u32x4){PKW(pB0, 8), PKW(pB0, 10), PKW(pB0, 12), PKW(pB0, 14)}; pw2 = (u32x4){PKW(pB1, 0), PKW(pB1, 2), PKW(pB1, 4), PKW(pB1, 6)}; pw3 = (u32x4){PKW(pB1, 8), PKW(pB1, 10), PKW(pB1, 12), PKW(pB1, 14)};
      SBAR(); pv(o, vb0 + sl_cur * VSLOTB, PAF(0), PAF(1), PAF(2), PAF(3)); }
#undef PKW
#undef PAF
#undef VFR
#undef PIN
#undef MX3
#undef GAPA
#undef GAPM
#undef GAPB
#undef EX
#undef VRD
#undef KRD
#undef MF32
#undef STEP
#undef ENDW
    { auto rr = __builtin_amdgcn_permlane32_swap(__float_as_uint(l_reg), __float_as_uint(l_reg), false, false); l_reg = __uint_as_float(rr[0]) + __uint_as_float(rr[1]); }
    if (hi == 0) wsf[32 + r32] = l_reg; asm volatile("s_waitcnt lgkmcnt(0)" ::: "memory");
    float rli[16];
#pragma unroll
    for (int r = 0; r < 16; ++r) rli[r] = __builtin_amdgcn_rcpf(wsf[32 + crow(r, hi)]);
    unsigned char* Ow = O + (rowbase + q0 + wid * QBLK) * PV + h * HV;
    { unsigned char* stg = (unsigned char*)(shm + LDS_OST) + wid * 2048;
#pragma unroll
      for (int r = 0; r < 16; ++r) { const int orow = crow(r, hi); const float sc = rli[r] * OSCALE;
        const float a = __builtin_fminf(__builtin_fmaxf(o[0][r] * sc, -448.f), 448.f), c = __builtin_fminf(__builtin_fmaxf(o[1][r] * sc, -448.f), 448.f);
        const unsigned w = (unsigned)__builtin_amdgcn_cvt_pk_fp8_f32(a, c, 0, false);
        stg[orow * 64 + r32] = (unsigned char)(w & 0xffu); stg[orow * 64 + 32 + r32] = (unsigned char)((w >> 8) & 0xffu); }
      asm volatile("s_waitcnt lgkmcnt(0)" ::: "memory");
#pragma unroll
      for (int i = 0; i < 2; ++i) { const int row = i * 16 + (lane >> 2), ch = lane & 3; const u32x4 v = *(const u32x4*)(stg + row * 64 + ch * 16); *(u32x4*)(Ow + (long)row * PV + ch * 16) = v; } }
    asm volatile("s_waitcnt lgkmcnt(0)\n\ts_barrier" ::: "memory");
#undef DMA_K
#undef DMA_V
#undef CMASK
#undef START
#undef RESC
#undef ROT
#undef WAIT_KV
#undef WAIT_KKV
}
#undef SBAR
#undef WAIT_BAR
}
namespace dila {
using bf16 = unsigned short;
using bf16x8 = __attribute__((ext_vector_type(8))) short;
using f32x16 = __attribute__((ext_vector_type(16))) float;
using u32x4 = __attribute__((ext_vector_type(4))) unsigned;
constexpr int NW = 8, SEQL = 8192, PQ = 1536, PKV = 3072, PO = 512, MROWS = 4 * SEQL;
constexpr int L_K = 0, L_V = 6 * 8192, L_WQ = 12 * 8192, L_WO = L_WQ + NW * 4096, L_WSF = L_WO + NW * 2048, L_BIAS = L_WSF + NW * 256, L_END = L_BIAS + 3 * 288 * 4;
constexpr float THR = 8.0f;
#define DIL_WAIT_BAR(N) asm volatile("s_waitcnt vmcnt(" #N ") lgkmcnt(0)\n\ts_barrier" ::: "memory")
struct UnitP { int sb, oo, lo, rowbase, dil, q0, g; };
__device__ __forceinline__ UnitP decode(int j, int h) {
    const int x = j & 31, bg = j >> 5; const int g = bg % 3, b = bg / 3;
    const int sh = 2 * g, dil = 1 << sh; const int r = x & (dil - 1), qb = x >> sh;
    UnitP p; p.sb = g * 262144 + ((b * dil + r) * 8 + h) * (SEQL >> sh); p.oo = g * MROWS * PO + h * 64; p.lo = g * MROWS * 8 + h;
    p.rowbase = b * SEQL + r; p.dil = dil; p.q0 = qb * 256; p.g = g; return p;
}

__device__ __forceinline__ void dil_phase(const bf16* QB, const bf16* KV, bf16* OG, float* LSE, const float* BT, char* shm, int G) {
    int tid_ = threadIdx.x; asm volatile("" : "+v"(tid_));
    const int tid = tid_, lane = tid & 63, r32 = lane & 31, hi = lane >> 5; const int wid = __builtin_amdgcn_readfirstlane(tid >> 6);
    const unsigned lds0 = (unsigned)(uintptr_t)shm;
    float* wsf = (float*)(shm + L_WSF) + wid * 64;
    char* wq = shm + L_WQ + wid * 4096;
    char* wo = shm + L_WO + wid * 2048;
    const int wt0 = wid >> 1, wt1 = 2 + (wid >> 1);
    const int G8 = G & ~7, c = (int)blockIdx.x;
    if (c >= G8) return;
    const int h = c & 7, j0 = c >> 3, jstep = G8 >> 3;
    const int NU = (384 - j0 + jstep - 1) / jstep;
    for (int i = tid; i < 3 * 288; i += NW * 64) ((float*)(shm + L_BIAS))[i] = BT[((i / 288) * 8 + h) * 288 + (i % 288)];
#define DIL_GROW(P, pos) ((long)((P).rowbase + (pos) * (P).dil))
#define DIL_ISSUE_TILE(P, t) do { int kp_ = (P).q0 - 128 + 64 * (t); if (kp_ < 0) kp_ = 0; \
        att::glds16(KV + (size_t)((P).sb + kp_ + lane) * 128 + wid * 8, (unsigned)__builtin_amdgcn_readfirstlane(lds0 + L_K + (t) * 8192 + wid * 1024)); \
        att::glds16(KV + (size_t)((P).sb + kp_ + 16 * (wid & 3) + (lane >> 2)) * 128 + 64 + (wid >> 2) * 32 + (lane & 3) * 8, (unsigned)__builtin_amdgcn_readfirstlane(lds0 + L_V + (t) * 8192 + wid * 1024)); } while (0)
#define DIL_ISSUE_Q(P) do { _Pragma("unroll") for (int j_ = 0; j_ < 4; ++j_) \
        att::glds16(QB + (size_t)((P).sb + (P).q0 + wid * 32 + 8 * j_ + (lane >> 3)) * 64 + (lane & 7) * 8, (unsigned)__builtin_amdgcn_readfirstlane(lds0 + L_WQ + wid * 4096 + j_ * 1024)); } while (0)
    if (NU <= 0) return;
    UnitP cur = decode(j0, h), nxt = cur;
    asm volatile("s_waitcnt vmcnt(0) lgkmcnt(0)\n\ts_barrier" ::: "memory");
    DIL_ISSUE_Q(cur); DIL_ISSUE_TILE(cur, 0); DIL_ISSUE_TILE(cur, 5); DIL_ISSUE_TILE(cur, 1); DIL_ISSUE_TILE(cur, 4);
    bf16x8 qr[4]; float mhat = 0.f, l_reg = 0.f; f32x16 o[2]; o[0] = f32x16{}; o[1] = f32x16{}; f32x16 negm = f32x16{}; bool first = true;
    const int vbl = (int)(lds0 + L_V) + ((lane >> 4) & 1) * 32 + (lane & 3) * 8 + (4 * hi + ((lane & 15) >> 2)) * 64;
    for (int ui = 0; ui < NU; ++ui) {
        const bool has_next = ui + 1 < NU;
        if (has_next) nxt = decode(j0 + (ui + 1) * jstep, h);
        const int tb = cur.q0 == 0 ? 2 : 0;
        const float* bl0 = (const float*)(shm + L_BIAS) + cur.g * 288 + (191 - (128 + 32 * (wid & 1) + r32 - 4 * hi));
#pragma unroll 1
        for (int k = 0; k < 3; ++k) {
            if (k == 0 && ui > 0) DIL_WAIT_BAR(5); else if (k < 2) DIL_WAIT_BAR(0); else DIL_WAIT_BAR(8);
            if (k == 0) { DIL_ISSUE_TILE(cur, 2); DIL_ISSUE_TILE(cur, 3); }
            else if (has_next) { if (k == 1) { DIL_ISSUE_Q(nxt); DIL_ISSUE_TILE(nxt, 0); DIL_ISSUE_TILE(nxt, 5); } else { DIL_ISSUE_TILE(nxt, 1); DIL_ISSUE_TILE(nxt, 4); } }
            const int t = wid < 4 ? wt0 + k : wt1 - k;
            if (k == 0) {
#pragma unroll
                for (int d0 = 0; d0 < 4; ++d0) qr[d0] = *reinterpret_cast<const bf16x8*>(wq + r32 * 128 + d0 * 32 + hi * 16);
                mhat = 0.f; l_reg = 0.f; o[0] = f32x16{}; o[1] = f32x16{}; negm = f32x16{}; first = true;
            }
            if (t >= tb) {
                f32x16 p0, p1;
                { const char* kb = shm + L_K + t * 8192 + hi * 1024 + r32 * 16;
#pragma unroll
                  for (int d0 = 0; d0 < 4; ++d0) {
                    const bf16x8 b0 = *reinterpret_cast<const bf16x8*>(kb + d0 * 2048);
                    const bf16x8 b1 = *reinterpret_cast<const bf16x8*>(kb + d0 * 2048 + 512);
                    if (d0 == 0) { p0 = __builtin_amdgcn_mfma_f32_32x32x16_bf16(b0, qr[0], negm, 0, 0, 0); p1 = __builtin_amdgcn_mfma_f32_32x32x16_bf16(b1, qr[0], negm, 0, 0, 0); }
                    else { p0 = __builtin_amdgcn_mfma_f32_32x32x16_bf16(b0, qr[d0], p0, 0, 0, 0); p1 = __builtin_amdgcn_mfma_f32_32x32x16_bf16(b1, qr[d0], p1, 0, 0, 0); } } }
                { const float* bl = bl0 + 64 * (t - wt0);
                  float bv0[16], bv1[16];
#pragma unroll
                  for (int r = 0; r < 16; ++r) { bv0[r] = bl[(r & 3) + 8 * (r >> 2)]; bv1[r] = bl[(r & 3) + 8 * (r >> 2) + 32]; }
#pragma unroll
                  for (int r = 0; r < 16; ++r) { p0[r] += bv0[r]; p1[r] += bv1[r]; } }
                const float rm = att::rowmax32(p0, p1);
                if (first) { first = false; const float dl = rm; mhat += dl;
#pragma unroll
                    for (int r = 0; r < 16; ++r) { p0[r] -= dl; p1[r] -= dl; }
#pragma unroll
                    for (int r = 0; r < 16; ++r) negm[r] = -mhat;
                } else if (__any(rm > THR)) { const float dl = __builtin_fmaxf(rm, 0.f); mhat += dl;
#pragma unroll
                    for (int r = 0; r < 16; ++r) { p0[r] -= dl; p1[r] -= dl; }
#pragma unroll
                    for (int r = 0; r < 16; ++r) negm[r] = -mhat;
                    const float f = __builtin_amdgcn_exp2f(-dl); l_reg *= f; if (hi == 0) wsf[r32] = f;
                    asm volatile("s_waitcnt lgkmcnt(0)" ::: "memory");
#pragma unroll
                    for (int d_ = 0; d_ < 2; ++d_)
#pragma unroll
                        for (int r = 0; r < 16; ++r) o[d_][r] *= wsf[att::crow(r, hi)];
                    asm volatile("s_waitcnt lgkmcnt(0)" ::: "memory");
                }
                float sacc = 0.f;
#pragma unroll
                for (int r = 0; r < 16; ++r) { p0[r] = __builtin_amdgcn_exp2f(p0[r]); p1[r] = __builtin_amdgcn_exp2f(p1[r]); sacc += p0[r] + p1[r]; }
                l_reg += sacc;
                u32x4 pw0, pw1, pw2, pw3;
#define DIL_PKW(P, B) att::cvtpk_s(P[B], P[B + 1])
                pw0 = (u32x4){DIL_PKW(p0, 0), DIL_PKW(p0, 2), DIL_PKW(p0, 4), DIL_PKW(p0, 6)}; pw1 = (u32x4){DIL_PKW(p0, 8), DIL_PKW(p0, 10), DIL_PKW(p0, 12), DIL_PKW(p0, 14)};
                pw2 = (u32x4){DIL_PKW(p1, 0), DIL_PKW(p1, 2), DIL_PKW(p1, 4), DIL_PKW(p1, 6)}; pw3 = (u32x4){DIL_PKW(p1, 8), DIL_PKW(p1, 10), DIL_PKW(p1, 12), DIL_PKW(p1, 14)};
#undef DIL_PKW
                __builtin_amdgcn_sched_barrier(0);
                att::pv(o, vbl + t * 8192, __builtin_bit_cast(bf16x8, pw0), __builtin_bit_cast(bf16x8, pw1), __builtin_bit_cast(bf16x8, pw2), __builtin_bit_cast(bf16x8, pw3));
            }
            if (k == 2) {
                { auto rr = __builtin_amdgcn_permlane32_swap(__float_as_uint(l_reg), __float_as_uint(l_reg), false, false); l_reg = __uint_as_float(rr[0]) + __uint_as_float(rr[1]); }
                if (hi == 0) wsf[32 + r32] = l_reg;
                asm volatile("s_waitcnt lgkmcnt(0)" ::: "memory");
                float rli[16];
#pragma unroll
                for (int r = 0; r < 16; ++r) rli[r] = __builtin_amdgcn_rcpf(wsf[32 + att::crow(r, hi)]);
                if (hi == 0) LSE[cur.lo + DIL_GROW(cur, cur.q0 + wid * 32 + r32) * 8] = mhat + __builtin_amdgcn_logf(l_reg);
                bf16* stg = (bf16*)wo;
#pragma unroll
                for (int d0 = 0; d0 < 2; ++d0) {
#pragma unroll
                    for (int r = 0; r < 16; ++r) stg[att::crow(r, hi) * 32 + r32] = (bf16)(att::cvtpk_s(o[d0][r] * rli[r], 0.f) & 0xffffu);
                    asm volatile("s_waitcnt lgkmcnt(0)" ::: "memory");
#pragma unroll
                    for (int i = 0; i < 2; ++i) { const int row = i * 16 + (lane >> 2), ch = lane & 3; const u32x4 v = *(const u32x4*)(stg + row * 32 + ch * 8);
                        *(u32x4*)(OG + cur.oo + DIL_GROW(cur, cur.q0 + wid * 32 + row) * PO + d0 * 32 + ch * 8) = v; }
                    asm volatile("s_waitcnt lgkmcnt(0)" ::: "memory"); }
            }
        }
        cur = nxt;
    }
    asm volatile("s_waitcnt vmcnt(0) lgkmcnt(0)\n\ts_barrier" ::: "memory");
#undef DIL_GROW
#undef DIL_ISSUE_TILE
#undef DIL_ISSUE_Q
}
#undef DIL_WAIT_BAR
}
constexpr int NWAVES = 8;
constexpr int BATCH = 4, SEQ = 8192, D = 1024, M = BATCH * SEQ;
constexpr int QRP = 512;
constexpr int MLA_H = 16, QRANK = 384, KVRANK = 256, LATN = 672, LATP = 768, QUP = 1536, KVUP = 2048;
constexpr int DFF = 2816, NEXP = 8, DILQ = 1536, DILKV = 3072, DILOUT = 512;
constexpr int MAXSLOT = 67584;
constexpr float EPS = 1e-6f;
constexpr float C2_MLA = 0.1472444460259031f;
constexpr float C2_DIL = 0.18033688011112042f;
constexpr float LOG2E_F = 1.4426950408889634f;

constexpr size_t MiB = 1u << 20;
constexpr size_t WS_CTL = 0, CTL_ZERO_BYTES = 64 * 1024;
constexpr size_t WS_XSQ = 256 * 1024, WS_XSKVN = 384 * 1024;
constexpr size_t WS_MODV = 1 * MiB;
constexpr size_t WS_BIAS = 1 * MiB + 256 * 1024;
constexpr size_t WS_ROUTE = 1 * MiB + 512 * 1024;
constexpr size_t WS_CNT = 2 * MiB;
constexpr size_t WS_LIST = 2 * MiB + 256 * 1024;
constexpr size_t WS_SLOTG = 2 * MiB + 768 * 1024;
constexpr size_t WS_TOKSLOT = 3 * MiB + 256 * 1024;
constexpr size_t WS_TILEEXP = 3 * MiB + 512 * 1024;
constexpr size_t WS_SLOTXS = 3 * MiB + 516 * 1024;
constexpr size_t WS_CS = 4 * MiB;
constexpr size_t WS_LSE = 8 * MiB;
constexpr size_t WS_SB = 11 * MiB;
constexpr size_t SB_LAT = 0, SB_FGU = 768, SB_KVB = 768 + 5632, SB_QB = SB_KVB + 3072, SB_EGU = SB_QB + 1536, SB_FDN = SB_EGU + 8 * 5632, SB_EDN = SB_FDN + 1024, SB_OUT = SB_EDN + 8 * 1024, SB_OB = SB_OUT + 1024, SB_QUP = SB_OB + 1024, SB_KVUP = SB_QUP + 1536, SB_END = SB_KVUP + 2048;
constexpr size_t WS_XS = 11 * MiB + 512 * 1024, WS_XSKV = 11 * MiB + 768 * 1024;
constexpr size_t WS_WEGU = 12 * MiB, WS_WEDN = 100 * MiB, WS_WFGU = 144 * MiB, WS_WFDN = 155 * MiB, WS_WKVB = 161 * MiB, WS_WQB = 167 * MiB, WS_WOUT = 170 * MiB,
                 WS_WOB = 172 * MiB, WS_WMLAIN = 173 * MiB, WS_WQUP = 175 * MiB, WS_WKVUP = 177 * MiB;
constexpr size_t WS_ARENA = 180 * MiB;
constexpr size_t A_XN = WS_ARENA, A_LAT = WS_ARENA + 64 * MiB, A_QN = WS_ARENA + 112 * MiB, A_KVN = WS_ARENA + 136 * MiB, A_Q = WS_ARENA + 152 * MiB, A_K = WS_ARENA + 248 * MiB,
                 A_V = WS_ARENA + 344 * MiB, A_O = WS_ARENA + 408 * MiB, A_HID = WS_ARENA + 64 * MiB, A_XNKV = WS_ARENA + 64 * MiB, A_KVB = WS_ARENA + 128 * MiB, A_QB = WS_ARENA + 320 * MiB,
                 A_OG = WS_ARENA, A_OD = WS_ARENA + 128 * MiB, A_HIDS = WS_ARENA + 160 * MiB, A_Y = WS_ARENA;
constexpr size_t WS_END = WS_ARENA + 523 * MiB;
static_assert(A_HIDS + (size_t)MAXSLOT * DFF * 2 <= WS_END && A_Y + (size_t)MAXSLOT * D * 2 <= A_HIDS && A_O + (size_t)M * D * 2 <= WS_END, "arena map");
static_assert(WS_WEGU + (size_t)NEXP * 2 * DFF * D * 2 <= WS_WEDN && WS_WEDN + (size_t)NEXP * D * DFF * 2 <= WS_WFGU && WS_WFGU + (size_t)2 * DFF * D * 2 <= WS_WFDN && WS_WFDN + (size_t)D * DFF * 2 <= WS_WKVB, "weight map");
enum ModKind { MK_A_MIX0 = 0, MK_B_MIX0, MK_G_MIX0, MK_A_FFN0, MK_B_FFN0, MK_G_FFN0, MK_A_MIX1, MK_B_MIX1, MK_G_MIX1, MK_A_FFN1, MK_B_FFN1, MK_G_FFN1, MK_A_KV, MK_B_KV };
constexpr int CW_BAR = 4096;
constexpr int CW_RANK = 8192;

constexpr int RING_BYTES = 131072;
constexpr int LDS_BYTES = 163840;
constexpr int LDSCTL_OFF = LDS_BYTES - 1024, MISC_OFF = LDSCTL_OFF + 320;

#define GAS __attribute__((address_space(1)))
#define LAS __attribute__((address_space(3)))
typedef unsigned short bf16;
typedef signed char i8;
typedef unsigned v4u __attribute__((ext_vector_type(4)));
typedef unsigned v2u __attribute__((ext_vector_type(2)));
typedef float f32x4 __attribute__((ext_vector_type(4)));
typedef GAS unsigned gu32;
#define RLX_AGENT __ATOMIC_RELAXED, __HIP_MEMORY_SCOPE_AGENT
#define LDS_WAIT() asm volatile("s_waitcnt lgkmcnt(0)" ::: "memory")
#define VM_WAIT() asm volatile("s_waitcnt vmcnt(0)" ::: "memory")
__device__ __forceinline__ unsigned f2bf(float f) { unsigned u = __builtin_bit_cast(unsigned, f); return (u + 0x7fffu + ((u >> 16) & 1u)) >> 16; }
__device__ __forceinline__ unsigned pk2(float lo, float hi) { return f2bf(lo) | (f2bf(hi) << 16); }
__device__ __forceinline__ float bf_lo(unsigned w) { return __builtin_bit_cast(float, w << 16); }
__device__ __forceinline__ float bf_hi(unsigned w) { return __builtin_bit_cast(float, w & 0xffff0000u); }
__device__ __forceinline__ float wave_sum(float v) {
#pragma unroll
    for (int o = 1; o < 64; o <<= 1) v += __shfl_xor(v, o);
    return v;
}

#define XB_TMO      128
#define XB_XCNT(j)  (256  + 64 * (j))
#define XB_XSUB(j)  (1280 + 64 * (j))
#define XB_XGEN(j)  (2304 + 64 * (j))
#define XB_TOP      3328
#define XB_TOPGEN   3392
#define XCD_BAR_WORDS 3456
#define XB_SPIN_CAP (1u << 18)
__device__ __forceinline__ unsigned xb_ld(unsigned* p)              { return __hip_atomic_load(p, __ATOMIC_RELAXED, __HIP_MEMORY_SCOPE_AGENT); }
__device__ __forceinline__ unsigned xb_add(unsigned* p, unsigned v) { return __hip_atomic_fetch_add(p, v, __ATOMIC_RELAXED, __HIP_MEMORY_SCOPE_AGENT); }
__device__ __forceinline__ unsigned xb_xcc_id() { return (unsigned)__builtin_amdgcn_s_getreg((3 << 11) | 20) & 0xFu; }
#define XB_SPIN(cond, bar) do { unsigned _sp = 0; while (cond) { __builtin_amdgcn_s_sleep(1); \
    if ((++_sp & 255u) == 0u) { if (xb_ld(&(bar)[XB_TMO])) break; if (_sp > XB_SPIN_CAP) { atomicAdd(&(bar)[XB_TMO], 1u); break; } } } } while (0)
struct XcdBarrier { unsigned* bar; unsigned x; volatile LAS unsigned* st; };
__device__ __forceinline__ XcdBarrier xcd_barrier_post(unsigned* bar, volatile LAS unsigned* st) {
    XcdBarrier b; b.bar = bar; b.x = xb_xcc_id(); b.st = st;
    if (threadIdx.x == 0) (void)xb_add(&bar[XB_XCNT(b.x)], 1u);
    return b;
}
__device__ __forceinline__ void xcd_barrier_complete(unsigned* bar, unsigned x, unsigned& nloc, unsigned& nx) {
    const unsigned G = gridDim.x * gridDim.y * gridDim.z;
    unsigned sum, cnt, mine, sp = 0u;
    for (;;) {
        sum = 0u; cnt = 0u; mine = 0u;
#pragma unroll
        for (unsigned j = 0; j < 16; ++j) { const unsigned c = xb_ld(&bar[XB_XCNT(j)]); sum += c; cnt += (c > 0u) ? 1u : 0u; mine = (j == x) ? c : mine; }
        if (sum == G) break;
        __builtin_amdgcn_s_sleep(1);
        if ((++sp & 255u) == 0u) { if (xb_ld(&bar[XB_TMO])) break; if (sp > XB_SPIN_CAP) { atomicAdd(&bar[XB_TMO], 1u); break; } }
    }
    nloc = mine > 0u ? mine : 1u; nx = cnt > 0u ? cnt : 1u;
}
__device__ __forceinline__ void xcd_barrier(const XcdBarrier& b) {
    asm volatile("s_waitcnt vmcnt(0)" ::: "memory");
    __syncthreads();
    if (threadIdx.x == 0) {
        unsigned* bar = b.bar;
        __builtin_amdgcn_s_waitcnt(0);
        unsigned nloc = b.st[0], nx = b.st[1];
        if (nloc == 0u) { xcd_barrier_complete(bar, b.x, nloc, nx); b.st[0] = nloc; b.st[1] = nx; }
        const unsigned old = xb_add(&bar[XB_XSUB(b.x)], 1u);
        const unsigned gen = old / nloc;
        if (old + 1u == (gen + 1u) * nloc) {
            __builtin_amdgcn_fence(__ATOMIC_RELEASE, "agent");
            asm volatile("s_waitcnt vmcnt(0)" ::: "memory");
            const unsigned og = xb_add(&bar[XB_TOP], 1u);
            const unsigned tg = og / nx;
            if (og + 1u == (tg + 1u) * nx) xb_add(&bar[XB_TOPGEN], 1u);
            else XB_SPIN(xb_ld(&bar[XB_TOPGEN]) == tg, bar);
            __builtin_amdgcn_fence(__ATOMIC_ACQUIRE, "agent");
            xb_add(&bar[XB_XGEN(b.x)], 1u);
            asm volatile("s_waitcnt vmcnt(0)" ::: "memory");
        } else {
            XB_SPIN(xb_ld(&bar[XB_XGEN(b.x)]) == gen, bar);
            __builtin_amdgcn_fence(__ATOMIC_ACQUIRE, "agent");
            asm volatile("s_waitcnt vmcnt(0)" ::: "memory");
        }
    }
    __syncthreads();
}

struct Frame {
    LAS unsigned char* lds;
    volatile LAS unsigned* MISC;
    int tid, lane, wave;
    int vcu, G;
    unsigned char* ws;
    const float* in[26];
    float* out;
};
enum { MAP_PLAIN = 0, MAP_MLAIN = 1, MAP_QUP = 2, MAP_GU = 3 };
template <int MAP> __device__ __forceinline__ int dmap(int n) {
    if (MAP == MAP_MLAIN) { if (n < 640) return n; if (n < 656) return 640 + 2 * (n - 640); return 640 + 2 * (n - 656) + 1; }
    if (MAP == MAP_QUP) { const int h = n / 96, j = n % 96; if (j < 64) return n; if (j < 80) return h * 96 + 64 + 2 * (j - 64); return h * 96 + 64 + 2 * (j - 80) + 1; }
    if (MAP == MAP_GU) { const int up = n >= DFF ? 1 : 0; const int c = up ? n - DFF : n; return (c >> 7) * 256 + up * 128 + (c & 127); }
    return n;
}
template <int MAP> __device__ __forceinline__ void transpose_item(const float* W, int K, int N, bf16* WT, const float* ks, LAS float* scr, int item, int lane) {
    const int nblk = N / 32, kb = item / nblk, nb = item % nblk, k0 = 64 * kb, n0 = 32 * nb;
    float v[32];
    const float* src = W + (size_t)(k0 + (lane >> 5)) * N + n0 + (lane & 31);
#pragma unroll
    for (int i = 0; i < 32; ++i) v[i] = __builtin_nontemporal_load(src + (size_t)(2 * i) * N);
    if (ks) {
#pragma unroll
        for (int i = 0; i < 32; ++i) v[i] *= ks[k0 + 2 * i + (lane >> 5)]; }
#pragma unroll
    for (int i = 0; i < 32; ++i) scr[(2 * i + (lane >> 5)) * 33 + (lane & 31)] = v[i];
    LDS_WAIT(); asm volatile("" ::: "memory");
    const int c = lane & 7;
#pragma unroll
    for (int j = 0; j < 4; ++j) { const int n = (lane >> 3) + 8 * j; const LAS float* s = scr + (8 * c) * 33 + n;
        v4u o; o.x = pk2(s[0 * 33], s[1 * 33]); o.y = pk2(s[2 * 33], s[3 * 33]); o.z = pk2(s[4 * 33], s[5 * 33]); o.w = pk2(s[6 * 33], s[7 * 33]);
        *(GAS v4u*)(WT + (size_t)dmap<MAP>(n0 + n) * K + k0 + 8 * c) = o; }
    LDS_WAIT(); asm volatile("" ::: "memory");
}
__device__ __forceinline__ float wave_max(float v) {
#pragma unroll
    for (int o = 1; o < 64; o <<= 1) v = fmaxf(v, __shfl_xor(v, o));
    return v;
}
__device__ __forceinline__ float amax8(const f32x4& a, const f32x4& b) { return fmaxf(fmaxf(fmaxf(fabsf(a.x), fabsf(a.y)), fmaxf(fabsf(a.z), fabsf(a.w))), fmaxf(fmaxf(fabsf(b.x), fabsf(b.y)), fmaxf(fabsf(b.z), fabsf(b.w)))); }
__device__ __forceinline__ unsigned q4(const f32x4& a, float inv) { const int q0 = (int)__builtin_rintf(a.x * inv), q1 = (int)__builtin_rintf(a.y * inv), q2 = (int)__builtin_rintf(a.z * inv), q3 = (int)__builtin_rintf(a.w * inv);
    return ((unsigned)q0 & 0xffu) | (((unsigned)q1 & 0xffu) << 8) | (((unsigned)q2 & 0xffu) << 16) | (((unsigned)q3 & 0xffu) << 24); }
template <int MAP, int FMT, int NC>
__device__ __forceinline__ void wg_quant_item(Frame& F, const float* W, int K, int N, unsigned char* WT, float* SB, float post, int item, const float* ks = nullptr, int KP = 0) {
    if (KP == 0) KP = K;
    LAS unsigned short* T = (LAS unsigned short*)F.lds;
    LAS float* cmx = (LAS float*)(F.lds + 147456);
    const int PK = K + 8, n0 = NC * item;
    constexpr int RPI = 64 / NC;
    const int c = F.lane & (NC - 1), rp = F.lane / NC;
    const int kw = K / 8, kbeg = F.wave * kw;
    const float* src = W + (size_t)(kbeg + rp) * N + n0 + c;
    float mx = 0.f;
    for (int kk = 0; kk < kw; kk += 32 * RPI) {
        float v[32];
#pragma unroll
        for (int i = 0; i < 32; ++i) { const int k = kk + i * RPI; v[i] = (k < kw) ? __builtin_nontemporal_load(src + (size_t)k * N) * (ks ? ks[kbeg + rp + k] : 1.0f) : 0.f; }
#pragma unroll
        for (int i = 0; i < 32; ++i) { const int k = kk + i * RPI; mx = fmaxf(mx, fabsf(v[i])); if (k < kw) T[c * PK + kbeg + rp + k] = (unsigned short)f2bf(v[i]); }
    }
#pragma unroll
    for (int o = NC; o < 64; o <<= 1) mx = fmaxf(mx, __shfl_xor(mx, o));
    if (F.lane < NC) cmx[F.wave * 32 + F.lane] = mx;
    __syncthreads();
    if (F.tid < NC) { float m = 0.f;
#pragma unroll
        for (int w = 0; w < 8; ++w) m = fmaxf(m, cmx[w * 32 + F.tid]);
        cmx[256 + F.tid] = m; SB[dmap<MAP>(n0 + F.tid)] = m > 0.f ? (FMT == 1 ? m * (1.0f / 127.0f) : m * (1.0f / 256.0f) * post) : 1.0f; }
    __syncthreads();
    const int nch = KP / 8, nchk = K / 8;
    for (int id = F.tid; id < NC * nch; id += NWAVES * 64) { const int cc = id / nch, kc = id % nch;
        if (kc >= nchk) { *(GAS v2u*)(WT + (size_t)dmap<MAP>(n0 + cc) * KP + 8 * kc) = (v2u){0u, 0u}; continue; }
        const float m = cmx[256 + cc]; const float inv = m > 0.f ? (FMT == 1 ? 127.0f : 256.0f) / m : 0.f;
        const v4u w = *(const LAS v4u*)(T + cc * PK + 8 * kc);
        const f32x4 lo = (f32x4){bf_lo(w.x), bf_hi(w.x), bf_lo(w.y), bf_hi(w.y)} * inv, hi = (f32x4){bf_lo(w.z), bf_hi(w.z), bf_lo(w.w), bf_hi(w.w)} * inv;
        v2u o; if (FMT == 1) o = (v2u){q4(lo, 1.0f), q4(hi, 1.0f)}; else o = (v2u){pg8::pk4_fp8(lo.x, lo.y, lo.z, lo.w), pg8::pk4_fp8(hi.x, hi.y, hi.z, hi.w)};
        *(GAS v2u*)(WT + (size_t)dmap<MAP>(n0 + cc) * KP + 8 * kc) = o; }
    __syncthreads();
}
__device__ __constant__ double INVF_D[16] = {1.0, 0.5623413251903491, 0.31622776601683794, 0.1778279410038923, 0.09999999999999999, 0.056234132519034905, 0.03162277660168379, 0.01778279410038923,
    0.01, 0.005623413251903491, 0.0031622776601683794, 0.0017782794100389228, 0.001, 0.000562341325190349, 0.00031622776601683794, 0.0001778279410038923};
__device__ __constant__ int RPB_TH[15] = {22, 30, 40, 54, 73, 99, 134, 182, 246, 332, 450, 609, 825, 1117, 1513};

__device__ __forceinline__ void p0_prologue(Frame& F) {
    const int gw = F.vcu * NWAVES + F.wave, NGW = F.G * NWAVES;
    const int gtid = F.vcu * (NWAVES * 64) + F.tid, NGT = F.G * NWAVES * 64;
    float* MODV = (float*)(F.ws + WS_MODV);
    {
        LAS float* cact = (LAS float*)F.lds;
        LAS float* red = (LAS float*)(F.lds + 16384);
        const float* cin = F.in[1];
        for (int i = F.tid; i < 4096; i += NWAVES * 64) { const int b = i >> 10, k = i & 1023; const float x = cin[i]; cact[k * 4 + b] = x / (1.0f + expf(-x)); }
        __syncthreads();
        constexpr int NTASK = (6 * D * 2 + 2 * D) / 64;
        for (int task = F.vcu; task < NTASK; task += F.G) {
            const int gc = task * 64 + F.lane;
            const float* W; int ldw, cc; const float* bias;
            if (gc < 6 * D) { W = F.in[5]; ldw = 6 * D; cc = gc; bias = F.in[6]; }
            else if (gc < 12 * D) { W = F.in[5] + (size_t)D * 6 * D; ldw = 6 * D; cc = gc - 6 * D; bias = F.in[6] + 6 * D; }
            else { W = F.in[14]; ldw = 2 * D; cc = gc - 12 * D; bias = F.in[15]; }
            float a0 = 0.f, a1 = 0.f, a2 = 0.f, a3 = 0.f;
            const int kbeg = F.wave * 128;
#pragma unroll 16
            for (int k = 0; k < 128; ++k) { const float w = W[(size_t)(kbeg + k) * ldw + cc]; const f32x4 ca = *(const LAS f32x4*)(cact + (kbeg + k) * 4);
                a0 += w * ca[0]; a1 += w * ca[1]; a2 += w * ca[2]; a3 += w * ca[3]; }
            red[(F.wave * 4 + 0) * 64 + F.lane] = a0; red[(F.wave * 4 + 1) * 64 + F.lane] = a1; red[(F.wave * 4 + 2) * 64 + F.lane] = a2; red[(F.wave * 4 + 3) * 64 + F.lane] = a3;
            __syncthreads();
            if (F.wave < 4) { const int b = F.wave; float s = 0.f;
#pragma unroll
                for (int w = 0; w < 8; ++w) s += red[(w * 4 + b) * 64 + F.lane];
                s += bias[cc];
                int kind; float val = s; const int j = cc & 1023, ch = cc >> 10;
                if (gc < 12 * D) { const int Lr = gc < 6 * D ? 0 : 1;
                    if (ch == 0) kind = 6 * Lr + 1; else if (ch == 1) { kind = 6 * Lr + 0; val = F.in[3][Lr * D + j] * (1.0f + s); } else if (ch == 2) kind = 6 * Lr + 2;
                    else if (ch == 3) kind = 6 * Lr + 4; else if (ch == 4) { kind = 6 * Lr + 3; val = F.in[4][Lr * D + j] * (1.0f + s); } else kind = 6 * Lr + 5;
                } else { if (ch == 0) kind = MK_B_KV; else { kind = MK_A_KV; val = F.in[13][j] * (1.0f + s); } }
                MODV[((size_t)kind * 4 + b) * D + j] = val; }
            __syncthreads();
        }
        __syncthreads();
    }
    {
        float* const SB = (float*)(F.ws + WS_SB);
        constexpr float POSTH = 1.0f / pg8::HSCALE, POSTO = 1.0f / mla::OSCALE;
        constexpr int W_EDN = NEXP * (D / 16), W_FDN = D / 16, W_EGU = NEXP * (2 * DFF / 32), W_FGU = 2 * DFF / 32, W_KVB = DILKV / 32, W_QB = DILQ / 32, W_MLAIN = LATN / 32, W_OUT = D / 32, W_OB = D / 32;
        constexpr int NWG = W_EDN + W_FDN + W_EGU + W_FGU + W_KVB + W_QB + W_MLAIN + W_OUT + W_OB;
        for (int it = F.vcu; it < NWG; it += F.G) { int r = it;
            if (r < W_EDN) { const int e = r / (D / 16); wg_quant_item<MAP_PLAIN, 2, 16>(F, F.in[24] + (size_t)e * DFF * D, DFF, D, F.ws + WS_WEDN + (size_t)e * D * DFF, SB + SB_EDN + (size_t)e * D, POSTH, r % (D / 16)); continue; } r -= W_EDN;
            if (r < W_FDN) { wg_quant_item<MAP_PLAIN, 2, 16>(F, F.in[21], DFF, D, F.ws + WS_WFDN, SB + SB_FDN, POSTH, r); continue; } r -= W_FDN;
            if (r < W_EGU) { const int e = r / W_FGU; wg_quant_item<MAP_GU, 1, 32>(F, F.in[23] + (size_t)e * D * 2 * DFF, D, 2 * DFF, F.ws + WS_WEGU + (size_t)e * 2 * DFF * D, SB + SB_EGU + (size_t)e * 2 * DFF, 1.f, r % W_FGU); continue; } r -= W_EGU;
            if (r < W_FGU) { wg_quant_item<MAP_GU, 1, 32>(F, F.in[20], D, 2 * DFF, F.ws + WS_WFGU, SB + SB_FGU, 1.f, r); continue; } r -= W_FGU;
            if (r < W_KVB) { wg_quant_item<MAP_PLAIN, 1, 32>(F, F.in[16], D, DILKV, F.ws + WS_WKVB, SB + SB_KVB, 1.f, r); continue; } r -= W_KVB;
            if (r < W_QB) { wg_quant_item<MAP_PLAIN, 1, 32>(F, F.in[18], D, DILQ, F.ws + WS_WQB, SB + SB_QB, 1.f, r); continue; } r -= W_QB;
            if (r < W_MLAIN) { wg_quant_item<MAP_MLAIN, 1, 32>(F, F.in[7], D, LATN, F.ws + WS_WMLAIN, SB + SB_LAT, 1.f, r); continue; } r -= W_MLAIN;
            if (r < W_OUT) { wg_quant_item<MAP_PLAIN, 2, 32>(F, F.in[12], D, D, F.ws + WS_WOUT, SB + SB_OUT, POSTO, r); continue; } r -= W_OUT;
            wg_quant_item<MAP_PLAIN, 2, 32>(F, F.in[19], DILOUT, D, F.ws + WS_WOB, SB + SB_OB, POSTO, r);
        }
        for (int it = F.vcu; it < QUP / 32 + KVUP / 32; it += F.G) {
            if (it < QUP / 32) wg_quant_item<MAP_QUP, 1, 32>(F, F.in[9], QRANK, QUP, F.ws + WS_WQUP, SB + SB_QUP, 1.f, it, F.in[8], QRP);
            else wg_quant_item<MAP_PLAIN, 1, 32>(F, F.in[11], KVRANK, KVUP, F.ws + WS_WKVUP, SB + SB_KVUP, 1.f, it - QUP / 32, F.in[10], KVRANK); }
    }
    {
        v4u* padz = (v4u*)(F.ws + WS_WMLAIN + (size_t)LATN * D);
        for (int i = gtid; i < (LATP - LATN) * D / 16; i += NGT) padz[i] = (v4u){0u, 0u, 0u, 0u};
        for (int i = gtid; i < LATP - LATN; i += NGT) ((float*)(F.ws + WS_SB))[SB_LAT + LATN + i] = 1.0f;
        const int* pos = (const int*)F.in[2];
        float* cs = (float*)(F.ws + WS_CS);
        for (int i = gtid; i < M * 16; i += NGT) { const int row = i >> 4, k = i & 15;
            const double x = (double)pos[row] * INVF_D[k]; const double rev = x * 0.15915494309189535; const float fr = (float)(rev - __builtin_rint(rev));
            cs[(size_t)i * 2] = __builtin_amdgcn_cosf(fr); cs[(size_t)i * 2 + 1] = __builtin_amdgcn_sinf(fr); }
        const float* rpb = F.in[17];
        float* bt = (float*)(F.ws + WS_BIAS);
        for (int i = gtid; i < 24 * 288; i += NGT) { const int gh = i / 288, ii = i % 288, j = 191 - ii, g = gh >> 3; const int d = j * (g == 0 ? 1 : (g == 1 ? 4 : 16));
            float val = -INFINITY;
            if (j >= 0 && j <= 128) { int bk; if (d < 16) bk = d; else { bk = 16;
#pragma unroll
                for (int q = 0; q < 15; ++q) bk += (d >= RPB_TH[q]) ? 1 : 0; }
                val = rpb[bk * 24 + gh] * LOG2E_F; }
            bt[i] = val; }
    }
}

constexpr int HPITCH = 2048;
__device__ __forceinline__ void ld8_f32(const float* p, f32x4& a, f32x4& b) { a = *(const f32x4*)p; b = *(const f32x4*)(p + 4); }
__device__ __forceinline__ void ld8_bf16(const bf16* p, f32x4& a, f32x4& b) { const v4u w = *(const GAS v4u*)p; a = (f32x4){bf_lo(w.x), bf_hi(w.x), bf_lo(w.y), bf_hi(w.y)}; b = (f32x4){bf_lo(w.z), bf_hi(w.z), bf_lo(w.w), bf_hi(w.w)}; }
__device__ __forceinline__ float ssq8(const f32x4& a, const f32x4& b) { return ((a.x * a.x + a.y * a.y) + (a.z * a.z + a.w * a.w)) + ((b.x * b.x + b.y * b.y) + (b.z * b.z + b.w * b.w)); }
__device__ __forceinline__ v4u pk8(const f32x4& a, const f32x4& b) { return (v4u){pk2(a.x, a.y), pk2(a.z, a.w), pk2(b.x, b.y), pk2(b.z, b.w)}; }
__device__ __forceinline__ void quant_row(const f32x4 (&y)[2][2], i8* orow, float* srow, int lane) {
    const float mx = wave_max(fmaxf(amax8(y[0][0], y[0][1]), amax8(y[1][0], y[1][1])));
    const float sc = mx > 0.f ? mx * (1.0f / 127.0f) : 1.0f, inv = mx > 0.f ? 127.0f / mx : 0.f;
#pragma unroll
    for (int j = 0; j < 2; ++j) *(GAS v2u*)(orow + 8 * lane + 512 * j) = (v2u){q4(y[j][0], inv), q4(y[j][1], inv)};
    if (lane == 0) *srow = sc;
}
template <bool DUAL, bool INF32>
__device__ __forceinline__ void norm_phase(Frame& F, const void* Hin, const float* A0, const float* B0, i8* O0, float* S0, const float* A1, const float* B1, i8* O1, float* S1) {
    const int gw = F.vcu * NWAVES + F.wave, NGW = F.G * NWAVES;
    for (int c = gw; c < M / 16; c += NGW) {
        const int row0 = c * 16, b = row0 / SEQ;
        f32x4 a0[2][2], b0[2][2], a1[2][2], b1[2][2];
#pragma unroll
        for (int j = 0; j < 2; ++j) { const int co = b * D + 8 * F.lane + 512 * j; ld8_f32(A0 + co, a0[j][0], a0[j][1]); ld8_f32(B0 + co, b0[j][0], b0[j][1]);
            if (DUAL) { ld8_f32(A1 + co, a1[j][0], a1[j][1]); ld8_f32(B1 + co, b1[j][0], b1[j][1]); } }
#pragma unroll 2
        for (int i = 0; i < 16; ++i) { const size_t row = (size_t)(row0 + i);
            f32x4 v[2][2]; float s = 0.f;
#pragma unroll
            for (int j = 0; j < 2; ++j) { if (INF32) ld8_f32((const float*)Hin + row * D + 8 * F.lane + 512 * j, v[j][0], v[j][1]); else ld8_bf16((const bf16*)Hin + row * HPITCH + 8 * F.lane + 512 * j, v[j][0], v[j][1]);
                s += ssq8(v[j][0], v[j][1]); }
            const float rstd = 1.0f / sqrtf(wave_sum(s) * (1.f / D) + EPS);
            f32x4 y[2][2];
#pragma unroll
            for (int j = 0; j < 2; ++j) { y[j][0] = v[j][0] * rstd * a0[j][0] + b0[j][0]; y[j][1] = v[j][1] * rstd * a0[j][1] + b0[j][1]; }
            quant_row(y, O0 + row * D, S0 + row, F.lane);
            if (DUAL) {
#pragma unroll
                for (int j = 0; j < 2; ++j) { y[j][0] = v[j][0] * rstd * a1[j][0] + b1[j][0]; y[j][1] = v[j][1] * rstd * a1[j][1] + b1[j][1]; }
                quant_row(y, O1 + row * D, S1 + row, F.lane); }
        }
    }
}

__device__ __forceinline__ void latnorm_phase(Frame& F) {
    const int gw = F.vcu * NWAVES + F.wave, NGW = F.G * NWAVES;
    const bf16* LAT = (const bf16*)(F.ws + A_LAT); i8* QN = (i8*)(F.ws + A_QN); i8* KVN = (i8*)(F.ws + A_KVN); bf16* KB = (bf16*)(F.ws + A_K);
    float* XSQ = (float*)(F.ws + WS_XSQ); float* XSKVN = (float*)(F.ws + WS_XSKVN);
    const float* cs = (const float*)(F.ws + WS_CS);
    for (int row = gw; row < M; row += NGW) {
        const unsigned* lr = (const unsigned*)(LAT + (size_t)row * LATP);
        unsigned q[3], kv[2];
#pragma unroll
        for (int j = 0; j < 3; ++j) q[j] = lr[F.lane + 64 * j];
#pragma unroll
        for (int j = 0; j < 2; ++j) kv[j] = lr[192 + F.lane + 64 * j];
        const unsigned kr = lr[320 + (F.lane & 15)];
        float sq = 0.f, sk = 0.f, mq = 0.f, mk = 0.f;
#pragma unroll
        for (int j = 0; j < 3; ++j) { const float a = bf_lo(q[j]), b = bf_hi(q[j]); sq += a * a + b * b; mq = fmaxf(mq, fmaxf(fabsf(a), fabsf(b))); }
#pragma unroll
        for (int j = 0; j < 2; ++j) { const float a = bf_lo(kv[j]), b = bf_hi(kv[j]); sk += a * a + b * b; mk = fmaxf(mk, fmaxf(fabsf(a), fabsf(b))); }
        const float rq = 1.0f / sqrtf(wave_sum(sq) * (1.f / QRANK) + EPS), rk = 1.0f / sqrtf(wave_sum(sk) * (1.f / KVRANK) + EPS);
        mq = wave_max(mq); mk = wave_max(mk);
        const float iq = mq > 0.f ? 127.0f / mq : 0.f, ik = mk > 0.f ? 127.0f / mk : 0.f;
        unsigned short* qo = (unsigned short*)(QN + (size_t)row * QRP); unsigned short* ko = (unsigned short*)(KVN + (size_t)row * KVRANK);
#pragma unroll
        for (int j = 0; j < 3; ++j) { const int a = (int)__builtin_rintf(bf_lo(q[j]) * iq), b = (int)__builtin_rintf(bf_hi(q[j]) * iq); qo[F.lane + 64 * j] = (unsigned short)(((unsigned)a & 0xffu) | (((unsigned)b & 0xffu) << 8)); }
        qo[192 + F.lane] = 0;
#pragma unroll
        for (int j = 0; j < 2; ++j) { const int a = (int)__builtin_rintf(bf_lo(kv[j]) * ik), b = (int)__builtin_rintf(bf_hi(kv[j]) * ik); ko[F.lane + 64 * j] = (unsigned short)(((unsigned)a & 0xffu) | (((unsigned)b & 0xffu) << 8)); }
        if (F.lane == 0) { XSQ[row] = mq > 0.f ? mq * rq * (1.0f / 127.0f) : 1.0f; XSKVN[row] = mk > 0.f ? mk * rk * (1.0f / 127.0f) : 1.0f; }
        { const int i = F.lane & 15; const float c = cs[(size_t)row * 32 + 2 * i], s = cs[(size_t)row * 32 + 2 * i + 1]; const float x1 = bf_lo(kr), x2 = bf_hi(kr);
          const unsigned w = pk2(x1 * c - x2 * s, x1 * s + x2 * c);
          unsigned* kb = (unsigned*)(KB + (size_t)row * QUP);
#pragma unroll
          for (int hh = 0; hh < 4; ++hh) { const int h = (F.lane >> 4) * 4 + hh; kb[(h * 96 + 64) / 2 + i] = w; } }
    }
}

__device__ __forceinline__ void merge_phase(Frame& F) {
    const int gw = F.vcu * NWAVES + F.wave, NGW = F.G * NWAVES;
    const bf16* OG = (const bf16*)(F.ws + A_OG); const float* LSE = (const float*)(F.ws + WS_LSE); unsigned char* OD = F.ws + A_OD;
    for (int row = gw; row < M; row += NGW) {
        const int h = F.lane >> 3;
        float l0 = LSE[((size_t)0 * M + row) * 8 + h], l1 = LSE[((size_t)1 * M + row) * 8 + h], l2 = LSE[((size_t)2 * M + row) * 8 + h];
        const float mx = fmaxf(l0, fmaxf(l1, l2)); float w0 = __builtin_amdgcn_exp2f(l0 - mx), w1 = __builtin_amdgcn_exp2f(l1 - mx), w2 = __builtin_amdgcn_exp2f(l2 - mx);
        const float inv = 1.0f / (w0 + w1 + w2); w0 *= inv; w1 *= inv; w2 *= inv;
        const v4u a = *(const v4u*)(OG + ((size_t)0 * M + row) * DILOUT + 8 * F.lane), b = *(const v4u*)(OG + ((size_t)1 * M + row) * DILOUT + 8 * F.lane), c = *(const v4u*)(OG + ((size_t)2 * M + row) * DILOUT + 8 * F.lane);
        float m8[8];
#pragma unroll
        for (int k = 0; k < 4; ++k) { m8[2 * k] = (w0 * bf_lo(a[k]) + w1 * bf_lo(b[k]) + w2 * bf_lo(c[k])) * mla::OSCALE; m8[2 * k + 1] = (w0 * bf_hi(a[k]) + w1 * bf_hi(b[k]) + w2 * bf_hi(c[k])) * mla::OSCALE; }
        *(v2u*)(OD + (size_t)row * DILOUT + 8 * F.lane) = (v2u){pg8::pk4_fp8(m8[0], m8[1], m8[2], m8[3]), pg8::pk4_fp8(m8[4], m8[5], m8[6], m8[7])};
    }
}

__device__ __forceinline__ void router_phase(Frame& F, const bf16* H, const float* A0, const float* B0, i8* O0, float* S0) {
    const int gw = F.vcu * NWAVES + F.wave, NGW = F.G * NWAVES;
    LAS float* wrt = (LAS float*)F.lds;
    { const float* wr = F.in[22]; for (int i = F.tid; i < 8192; i += NWAVES * 64) { const int col = i >> 3, e = i & 7; wrt[e * 1024 + col] = wr[i]; } }
    __syncthreads();
    v4u* ROUTE = (v4u*)(F.ws + WS_ROUTE); unsigned* CNT = (unsigned*)(F.ws + WS_CNT);
    for (int c = gw; c < M / 16; c += NGW) {
        const int row0 = c * 16, b = row0 / SEQ;
        f32x4 a0[2][2], b0[2][2];
#pragma unroll
        for (int j = 0; j < 2; ++j) { const int co = b * D + 8 * F.lane + 512 * j; ld8_f32(A0 + co, a0[j][0], a0[j][1]); ld8_f32(B0 + co, b0[j][0], b0[j][1]); }
        unsigned cnt = 0u;
        for (int i = 0; i < 16; ++i) { const size_t row = (size_t)(row0 + i);
            f32x4 v[2][2]; float s = 0.f;
#pragma unroll
            for (int j = 0; j < 2; ++j) { ld8_bf16(H + row * HPITCH + 8 * F.lane + 512 * j, v[j][0], v[j][1]); s += ssq8(v[j][0], v[j][1]); }
            const float rstd = 1.0f / sqrtf(wave_sum(s) * (1.f / D) + EPS);
            float lg[8];
#pragma unroll
            for (int e = 0; e < 8; ++e) lg[e] = 0.f;
            f32x4 yq[2][2];
#pragma unroll
            for (int j = 0; j < 2; ++j) { const f32x4 y0 = v[j][0] * rstd * a0[j][0] + b0[j][0], y1 = v[j][1] * rstd * a0[j][1] + b0[j][1];
                yq[j][0] = y0; yq[j][1] = y1;
#pragma unroll
                for (int e = 0; e < 8; ++e) { const LAS float* wp = wrt + e * 1024 + 8 * F.lane + 512 * j; const f32x4 w0 = *(const LAS f32x4*)wp, w1 = *(const LAS f32x4*)(wp + 4);
                    lg[e] += ((y0.x * w0.x + y0.y * w0.y) + (y0.z * w0.z + y0.w * w0.w)) + ((y1.x * w1.x + y1.y * w1.y) + (y1.z * w1.z + y1.w * w1.w)); } }
            quant_row(yq, O0 + row * D, S0 + row, F.lane);
#pragma unroll
            for (int e = 0; e < 8; ++e) lg[e] = wave_sum(lg[e]);
            int e1 = 0; float v1 = lg[0];
#pragma unroll
            for (int e = 1; e < 8; ++e) if (lg[e] > v1) { v1 = lg[e]; e1 = e; }
            int e2 = -1; float v2 = -INFINITY;
#pragma unroll
            for (int e = 0; e < 8; ++e) if (e != e1 && lg[e] > v2) { v2 = lg[e]; e2 = e; }
            const float ex = expf(v2 - v1); const float g1 = 1.0f / (1.0f + ex), g2 = ex / (1.0f + ex);
            cnt += (F.lane == e1 ? 1u : 0u) + (F.lane == e2 ? 1u : 0u);
            if (F.lane == 0) ROUTE[row] = (v4u){(unsigned)e1 | ((unsigned)e2 << 8), __float_as_uint(g1), __float_as_uint(g2), 0u};
        }
        if (F.lane < 8) CNT[c * 8 + F.lane] = cnt;
    }
}

__device__ __forceinline__ void lists_phase(Frame& F) {
    const int gw = F.vcu * NWAVES + F.wave, NGW = F.G * NWAVES;
    const v4u* ROUTE = (const v4u*)(F.ws + WS_ROUTE); const unsigned* CNT = (const unsigned*)(F.ws + WS_CNT);
    int* LIST = (int*)(F.ws + WS_LIST); float* SLOTG = (float*)(F.ws + WS_SLOTG); float* SLOTXS = (float*)(F.ws + WS_SLOTXS); const float* XS = (const float*)(F.ws + WS_XS); int* TOKSLOT = (int*)(F.ws + WS_TOKSLOT); int* TILEEXP = (int*)(F.ws + WS_TILEEXP);
    for (int c = gw; c < M / 16; c += NGW) {
        unsigned lt[8], al[8];
#pragma unroll
        for (int e = 0; e < 8; ++e) { lt[e] = 0u; al[e] = 0u; }
        for (int cc = F.lane; cc < M / 16; cc += 64) { const v4u x = *(const v4u*)(CNT + cc * 8), y = *(const v4u*)(CNT + cc * 8 + 4); const bool bl = cc < c;
            al[0] += x.x; al[1] += x.y; al[2] += x.z; al[3] += x.w; al[4] += y.x; al[5] += y.y; al[6] += y.z; al[7] += y.w;
            if (bl) { lt[0] += x.x; lt[1] += x.y; lt[2] += x.z; lt[3] += x.w; lt[4] += y.x; lt[5] += y.y; lt[6] += y.z; lt[7] += y.w; } }
#pragma unroll
        for (int e = 0; e < 8; ++e) {
#pragma unroll
            for (int o = 1; o < 64; o <<= 1) { lt[e] += __shfl_xor(lt[e], o); al[e] += __shfl_xor(al[e], o); } }
        unsigned base[8]; unsigned run = 0u;
#pragma unroll
        for (int e = 0; e < 8; ++e) { base[e] = run; run += (al[e] + 255u) & ~255u; }
        const int row = c * 16 + (F.lane & 15);
        const v4u r = ROUTE[row]; const int e1 = (int)(r.x & 0xffu), e2 = (int)((r.x >> 8) & 0xffu);
        int s1 = 0, s2 = 0;
#pragma unroll
        for (int e = 0; e < 8; ++e) { const bool has = (F.lane < 16) && (e1 == e || e2 == e); const unsigned long long mk = __ballot(has);
            const int rank = __popcll(mk & ((1ull << F.lane) - 1ull)); const int sl = (int)(base[e] + lt[e]) + rank;
            if (e1 == e) s1 = sl; if (e2 == e) s2 = sl; }
        if (F.lane < 16) { LIST[s1] = row; LIST[s2] = row; SLOTG[s1] = __uint_as_float(r.y); SLOTG[s2] = __uint_as_float(r.z); TOKSLOT[row * 2] = s1; TOKSLOT[row * 2 + 1] = s2;
            const float xs = XS[row]; SLOTXS[s1] = xs; SLOTXS[s2] = xs; }
        if (c == 0) {
#pragma unroll
            for (int e = 0; e < 8; ++e) { const unsigned pe = (al[e] + 255u) & ~255u;
                for (unsigned s = base[e] + al[e] + F.lane; s < base[e] + pe; s += 64) { LIST[s] = 0; SLOTG[s] = 0.f; SLOTXS[s] = 0.f; }
                for (unsigned t = base[e] / 256u + F.lane; t < (base[e] + pe) / 256u; t += 64) TILEEXP[t] = e; }
            if (F.lane == 0) TILEEXP[300] = (int)(run / 256u);
        }
    }
}

__device__ __forceinline__ void final_phase(Frame& F, float* OUT, const float* gate, const float* gfin) {
    const int gw = F.vcu * NWAVES + F.wave, NGW = F.G * NWAVES;
    const bf16* Y = (const bf16*)(F.ws + A_Y); const int* TOKSLOT = (const int*)(F.ws + WS_TOKSLOT); const bf16* H = (const bf16*)OUT;
    for (int c = gw; c < M / 16; c += NGW) {
        const int row0 = c * 16, b = row0 / SEQ;
        f32x4 gt[2][2], gf[2][2];
#pragma unroll
        for (int j = 0; j < 2; ++j) { ld8_f32(gate + b * D + 8 * F.lane + 512 * j, gt[j][0], gt[j][1]); ld8_f32(gfin + 8 * F.lane + 512 * j, gf[j][0], gf[j][1]); }
#pragma unroll 2
        for (int i = 0; i < 16; ++i) { const size_t row = (size_t)(row0 + i);
            const int s1 = TOKSLOT[row * 2], s2 = TOKSLOT[row * 2 + 1];
            f32x4 v[2][2]; float s = 0.f;
#pragma unroll
            for (int j = 0; j < 2; ++j) { f32x4 h0, h1, p0, p1, q0, q1; ld8_bf16(H + row * HPITCH + 8 * F.lane + 512 * j, h0, h1);
                ld8_bf16(Y + (size_t)s1 * D + 8 * F.lane + 512 * j, p0, p1); ld8_bf16(Y + (size_t)s2 * D + 8 * F.lane + 512 * j, q0, q1);
                v[j][0] = h0 + gt[j][0] * (p0 + q0); v[j][1] = h1 + gt[j][1] * (p1 + q1); s += ssq8(v[j][0], v[j][1]); }
            const float rstd = 1.0f / sqrtf(wave_sum(s) * (1.f / D) + EPS);
            asm volatile("" ::: "memory");
#pragma unroll
            for (int j = 0; j < 2; ++j) { float* op = OUT + row * D + 8 * F.lane + 512 * j; *(GAS f32x4*)op = v[j][0] * rstd * gf[j][0]; *(GAS f32x4*)(op + 4) = v[j][1] * rstd * gf[j][1]; }
        }
    }
}
#ifndef MK_ONE_LAUNCH
#define MK_ONE_LAUNCH 1
#endif
constexpr int N_PHASES = 20;
struct Args { const float* in[26]; float* out; unsigned char* ws; int ph_lo, ph_hi; };
static_assert(sizeof(Args) == 26 * 8 + 8 + 8 + 8, "Args has no padding");

__global__ void __launch_bounds__(NWAVES * 64, 2) mk_fwd(Args args) {
    extern __shared__ __attribute__((aligned(16))) unsigned char lds[];
    Frame F;
    F.lds = (LAS unsigned char*)lds;
    F.MISC = (volatile LAS unsigned*)(F.lds + MISC_OFF);
    F.tid = threadIdx.x; F.lane = F.tid & 63; F.wave = __builtin_amdgcn_readfirstlane(F.tid >> 6);
    F.G = gridDim.x; { const int bx = blockIdx.x; F.vcu = (F.G % 8 == 0) ? (bx % 8) * (F.G / 8) + bx / 8 : bx; }
    F.ws = args.ws; F.out = args.out;
#pragma unroll
    for (int i = 0; i < 26; ++i) F.in[i] = args.in[i];
    unsigned char* const ws = args.ws;
    for (int u = F.tid; u < (LDS_BYTES - LDSCTL_OFF) / 4; u += NWAVES * 64) ((LAS unsigned*)(F.lds + LDSCTL_OFF))[u] = 0u;
    __syncthreads();
    const int lo = args.ph_lo, hi = args.ph_hi;
    XcdBarrier bar; bar.bar = (unsigned*)(ws + WS_CTL) + CW_BAR; bar.x = 0; bar.st = nullptr;
    if (hi - lo > 1) bar = xcd_barrier_post((unsigned*)(ws + WS_CTL) + CW_BAR, F.MISC + 8);
    int cid = (int)blockIdx.x;
    if (hi - lo > 1) { if (F.tid == 0) F.MISC[12] = xb_add((unsigned*)(ws + WS_CTL) + CW_RANK + 64 * bar.x, 1u); }

#ifndef PHASE_MASK
#define PHASE_MASK 0xFFFFFu
#endif
#define IN(k) (((PHASE_MASK >> (k)) & 1u) && lo <= (k) && (k) < hi)
#ifndef REPEAT_MASK
#define REPEAT_MASK 0u
#endif
#define REP(k) (((REPEAT_MASK >> (k)) & 1u) ? 2 : 1)
#define SEAM(k) do { if (IN(k) && IN((k) + 1)) xcd_barrier(bar); } while (0)
    const float* MODV = (const float*)(ws + WS_MODV);
#define MV(kind) (MODV + (size_t)(kind) * 4 * D)
    bf16* const H = (bf16*)args.out;
    i8* const XN = (i8*)(ws + A_XN); i8* const XNKV = (i8*)(ws + A_XNKV);
    float* const XS = (float*)(ws + WS_XS); float* const XSKV = (float*)(ws + WS_XSKV); const float* const SB = (const float*)(ws + WS_SB);
    const pg8::MoeInfo mi0{nullptr, nullptr, 0};

    if (IN(0)) for (int rep_ = 0; rep_ < REP(0); ++rep_) { p0_prologue(F); } SEAM(0);
    if (IN(0) && IN(1)) {
        if (F.tid == 0) { bool ok = (F.G % 8) == 0;
            for (unsigned j = 0; j < 16; ++j) { const unsigned cnt_ = xb_ld((unsigned*)(ws + WS_CTL) + CW_BAR + XB_XCNT(j)); ok = ok && (cnt_ == (j < 8 ? (unsigned)F.G / 8u : 0u)); }
            F.MISC[13] = ok ? (F.MISC[12] * 8u + bar.x) : (unsigned)blockIdx.x; }
        __syncthreads();
        cid = (int)F.MISC[13];
        F.vcu = (F.G % 8 == 0) ? (cid % 8) * (F.G / 8) + cid / 8 : cid;
    }

    if (IN(1)) for (int rep_ = 0; rep_ < REP(1); ++rep_) { norm_phase<false, true>(F, F.in[0], MV(MK_A_MIX0), MV(MK_B_MIX0), XN, XS, nullptr, nullptr, nullptr, nullptr); } SEAM(1);
    if (IN(2)) for (int rep_ = 0; rep_ < REP(2); ++rep_) { pg8::Gemm g{(const bf16*)XN, (const bf16*)(ws + WS_WMLAIN), M, LATP, D}; pg8::StaticOrder S; S.init(M, LATP, F.G, cid);
        pg8::EpiBf16Q E{(bf16*)(ws + A_LAT), LATP, XS, SB + SB_LAT};
        pg8::gemm_phase<pg8::EpiBf16Q, pg8::StaticOrder, true, true, 0, 1>(F.lds, g, S, E, mi0); } SEAM(2);
    if (IN(3)) for (int rep_ = 0; rep_ < REP(3); ++rep_) { latnorm_phase(F); } SEAM(3);
    if (IN(4)) for (int rep_ = 0; rep_ < REP(4); ++rep_) {
#ifndef P4_SKIP_Q
        { pg8::Gemm g{(const bf16*)(ws + A_QN), (const bf16*)(ws + WS_WQUP), M, QUP, QRP}; pg8::StaticOrder S; S.init(M, QUP, F.G, cid);
          pg8::EpiQQ E{(bf16*)(ws + A_Q), (const float*)(ws + WS_CS), (const float*)(ws + WS_XSQ), SB + SB_QUP};
          pg8::gemm_phase<pg8::EpiQQ, pg8::StaticOrder, true, true, 0, 1>(F.lds, g, S, E, mi0); }
#endif
#ifndef P4_SKIP_KV
        { pg8::Gemm g{(const bf16*)(ws + A_KVN), (const bf16*)(ws + WS_WKVUP), M, KVUP, KVRANK}; pg8::StaticOrder S; S.init(M, KVUP, F.G, cid);
          pg8::EpiKVQ E{(bf16*)(ws + A_K), (bf16*)(ws + A_V), (const float*)(ws + WS_XSKVN), SB + SB_KVUP};
          pg8::gemm_phase<pg8::EpiKVQ, pg8::StaticOrder, true, true, 0, 1>(F.lds, g, S, E, mi0); }
#endif
    } SEAM(4);
    if (IN(5)) for (int rep_ = 0; rep_ < REP(5); ++rep_) {
        const bf16* Qp = (const bf16*)(ws + A_Q); const bf16* Kp = (const bf16*)(ws + A_K); const bf16* Vp = (const bf16*)(ws + A_V); unsigned char* Op = ws + A_O;
        if (F.G == 256) {
            for (int i = 0; i < 8; ++i) { const int bh = (F.vcu >> 3) + 32 * (i >> 2), s = F.vcu & 7, k = i & 3; const int qb = (k == 0) ? s : (k == 1) ? 15 - s : (k == 2) ? 16 + s : 31 - s;
                const int b = bh >> 4, h = bh & 15;
                mla::attn_unit<8>(b, h, qb, Qp, Kp, Vp, Op, (char*)lds); }
        } else {
            for (int u = (int)blockIdx.x; u < BATCH * MLA_H * 32; u += F.G) { const int bh = u >> 5, qb = 31 - (u & 31); const int b = bh >> 4, h = bh & 15;
                mla::attn_unit<8>(b, h, qb, Qp, Kp, Vp, Op, (char*)lds); }
        }
    } SEAM(5);
    if (IN(6)) for (int rep_ = 0; rep_ < REP(6); ++rep_) { pg8::Gemm g{(const bf16*)(ws + A_O), (const bf16*)(ws + WS_WOUT), M, D, D}; pg8::StaticOrder S; S.init(M, D, F.G, cid);
        pg8::EpiResid<true> E{F.in[0], H, MV(MK_G_MIX0), SB + SB_OUT};
        pg8::gemm_phase<pg8::EpiResid<true>, pg8::StaticOrder, true, true, 0, 2>(F.lds, g, S, E, mi0); } SEAM(6);
    if (IN(7)) for (int rep_ = 0; rep_ < REP(7); ++rep_) { norm_phase<false, false>(F, H, MV(MK_A_FFN0), MV(MK_B_FFN0), XN, XS, nullptr, nullptr, nullptr, nullptr); } SEAM(7);
    if (IN(8)) for (int rep_ = 0; rep_ < REP(8); ++rep_) { pg8::Gemm g{(const bf16*)XN, (const bf16*)(ws + WS_WFGU), M, 2 * DFF, D}; pg8::StaticOrder S; S.init(M, 2 * DFF, F.G, cid);
        pg8::EpiSwiGLUQ E{(unsigned char*)(ws + A_HID), DFF, XS, SB + SB_FGU, nullptr};
        pg8::gemm_phase<pg8::EpiSwiGLUQ, pg8::StaticOrder, true, true, 0, 1>(F.lds, g, S, E, mi0); } SEAM(8);
    if (IN(9)) for (int rep_ = 0; rep_ < REP(9); ++rep_) { pg8::Gemm g{(const bf16*)(ws + A_HID), (const bf16*)(ws + WS_WFDN), M, D, DFF}; pg8::StaticOrder S; S.init(M, D, F.G, cid);
        pg8::EpiResid<false> E{H, H, MV(MK_G_FFN0), SB + SB_FDN};
        pg8::gemm_phase<pg8::EpiResid<false>, pg8::StaticOrder, true, true, 0, 2>(F.lds, g, S, E, mi0); } SEAM(9);
    if (IN(10)) for (int rep_ = 0; rep_ < REP(10); ++rep_) { norm_phase<true, false>(F, H, MV(MK_A_MIX1), MV(MK_B_MIX1), XN, XS, MV(MK_A_KV), MV(MK_B_KV), XNKV, XSKV); } SEAM(10);
    if (IN(11)) for (int rep_ = 0; rep_ < REP(11); ++rep_) {
        { pg8::Gemm g{(const bf16*)XNKV, (const bf16*)(ws + WS_WKVB), M, DILKV, D}; pg8::StaticOrder S; S.init(M, DILKV, F.G, cid);
          pg8::EpiDilQ<true> E{(bf16*)(ws + A_KVB), XSKV, SB + SB_KVB};
          pg8::gemm_phase<pg8::EpiDilQ<true>, pg8::StaticOrder, true, true, 0, 1>(F.lds, g, S, E, mi0); }
        { pg8::Gemm g{(const bf16*)XN, (const bf16*)(ws + WS_WQB), M, DILQ, D}; pg8::StaticOrder S; S.init(M, DILQ, F.G, cid);
          pg8::EpiDilQ<false> E{(bf16*)(ws + A_QB), XS, SB + SB_QB};
          pg8::gemm_phase<pg8::EpiDilQ<false>, pg8::StaticOrder, true, true, 0, 1>(F.lds, g, S, E, mi0); }
    } SEAM(11);
    if (IN(12)) for (int rep_ = 0; rep_ < REP(12); ++rep_) {
        const bf16* Qp = (const bf16*)(ws + A_QB); const bf16* KV = (const bf16*)(ws + A_KVB); bf16* OG = (bf16*)(ws + A_OG); float* LSE = (float*)(ws + WS_LSE); const float* BT = (const float*)(ws + WS_BIAS);
        dila::dil_phase(Qp, KV, OG, LSE, BT, (char*)lds, F.G);
    } SEAM(12);
    if (IN(13)) for (int rep_ = 0; rep_ < REP(13); ++rep_) { merge_phase(F); } SEAM(13);
    if (IN(14)) for (int rep_ = 0; rep_ < REP(14); ++rep_) { pg8::Gemm g{(const bf16*)(ws + A_OD), (const bf16*)(ws + WS_WOB), M, D, DILOUT}; pg8::StaticOrder S; S.init(M, D, F.G, cid);
        pg8::EpiResid<false> E{H, H, MV(MK_G_MIX1), SB + SB_OB};
        pg8::gemm_phase<pg8::EpiResid<false>, pg8::StaticOrder, true, true, 0, 2>(F.lds, g, S, E, mi0); } SEAM(14);
    if (IN(15)) for (int rep_ = 0; rep_ < REP(15); ++rep_) { router_phase(F, H, MV(MK_A_FFN1), MV(MK_B_FFN1), XN, XS); } SEAM(15);
    if (IN(16)) for (int rep_ = 0; rep_ < REP(16); ++rep_) { lists_phase(F); } SEAM(16);
    if (IN(17)) for (int rep_ = 0; rep_ < REP(17); ++rep_) { const int ntile = ((const int*)(ws + WS_TILEEXP))[300];
        pg8::Gemm g{(const bf16*)XN, (const bf16*)(ws + WS_WEGU), ntile * 256, 2 * DFF, D}; pg8::StaticOrder S; S.init(ntile * 256, 2 * DFF, F.G, cid);
        const pg8::MoeInfo mi{(const int*)(ws + WS_LIST), (const int*)(ws + WS_TILEEXP), (size_t)2 * DFF * D};
        pg8::EpiSwiGLUQ E{(unsigned char*)(ws + A_HIDS), DFF, (const float*)(ws + WS_SLOTXS), SB + SB_EGU, mi.tile_expert};
        pg8::gemm_phase<pg8::EpiSwiGLUQ, pg8::StaticOrder, true, true, 1, 1>(F.lds, g, S, E, mi); } SEAM(17);
    if (IN(18)) for (int rep_ = 0; rep_ < REP(18); ++rep_) { const int ntile = ((const int*)(ws + WS_TILEEXP))[300];
        pg8::Gemm g{(const bf16*)(ws + A_HIDS), (const bf16*)(ws + WS_WEDN), ntile * 256, D, DFF}; pg8::StaticOrder S; S.init(ntile * 256, D, F.G, cid);
        const pg8::MoeInfo mi{(const int*)(ws + WS_LIST), (const int*)(ws + WS_TILEEXP), (size_t)D * DFF};
        pg8::EpiMoeDown E{(bf16*)(ws + A_Y), (const float*)(ws + WS_SLOTG), SB + SB_EDN, mi.tile_expert};
        pg8::gemm_phase<pg8::EpiMoeDown, pg8::StaticOrder, true, true, 2, 2>(F.lds, g, S, E, mi); } SEAM(18);
    if (IN(19)) for (int rep_ = 0; rep_ < REP(19); ++rep_) { final_phase(F, args.out, MV(MK_G_FFN1), F.in[25]); }
#undef IN
#undef SEAM
#undef MV
}

extern "C" void kernel_launch(void* const* d_in, const int* in_sizes, int n_in, void* d_out, int out_size, void* d_ws, size_t ws_size, hipStream_t stream) {
    static int grid = 0;
    if (grid == 0) {
        if (n_in != 26 || in_sizes[0] != M * D || out_size != M * D || ws_size < WS_END) { fprintf(stderr, "kernel_launch: unexpected shapes (n_in %d, in0 %d, out %d, ws %zu, need %zu); nothing launched\n", n_in, n_in > 0 ? in_sizes[0] : -1, out_size, ws_size, (size_t)WS_END); grid = -1; return; }
        int dev = 0, cus = 0, per_cu = 0;
        if (hipGetDevice(&dev) != hipSuccess || hipDeviceGetAttribute(&cus, hipDeviceAttributeMultiprocessorCount, dev) != hipSuccess) { grid = -1; return; }
        if (hipFuncSetAttribute((const void*)mk_fwd, hipFuncAttributeMaxDynamicSharedMemorySize, LDS_BYTES) != hipSuccess) { fprintf(stderr, "kernel_launch: hipFuncSetAttribute failed\n"); grid = -1; return; }
        if (hipOccupancyMaxActiveBlocksPerMultiprocessor(&per_cu, (const void*)mk_fwd, NWAVES * 64, LDS_BYTES) != hipSuccess || per_cu < 1) { fprintf(stderr, "kernel_launch: occupancy query reports %d\n", per_cu); }
        (void)hipGetLastError();
        grid = cus;
    }
    if (grid < 0) return;
    if (hipMemsetAsync((char*)d_ws + WS_CTL, 0, CTL_ZERO_BYTES, stream) != hipSuccess) return;
    Args a{};
    for (int i = 0; i < 26; ++i) a.in[i] = (const float*)d_in[i];
    a.out = (float*)d_out; a.ws = (unsigned char*)d_ws;
#if MK_ONE_LAUNCH
    a.ph_lo = 0; a.ph_hi = N_PHASES;
    hipLaunchKernelGGL(mk_fwd, dim3(grid), dim3(NWAVES * 64), LDS_BYTES, stream, a);
#else
    for (int p = 0; p < N_PHASES; ++p) { a.ph_lo = p; a.ph_hi = p + 1; hipLaunchKernelGGL(mk_fwd, dim3(grid), dim3(NWAVES * 64), LDS_BYTES, stream, a); }
#endif
}
```

```cpp
#include <hip/hip_runtime.h>
#include <hip/hip_bf16.h>
#include <cstdio>
#include <cstdint>
#include <cmath>
#ifndef MK_ONE_LAUNCH
#define MK_ONE_LAUNCH 1
#endif
#ifndef PG8_STAGGER
#define PG8_STAGGER 0
#endif
namespace pg8 {
#define PG8_LAS __attribute__((address_space(3)))
typedef unsigned short bf16_t;
typedef short bf16x8 __attribute__((ext_vector_type(8)));
typedef float f32x4 __attribute__((ext_vector_type(4)));
typedef float f32x2 __attribute__((ext_vector_type(2)));
typedef unsigned u32x4 __attribute__((ext_vector_type(4)));
typedef int i32x4 __attribute__((ext_vector_type(4)));
typedef int i32x8 __attribute__((ext_vector_type(8)));
template <int PREC> struct AccT { typedef f32x4 type; }; template <> struct AccT<1> { typedef i32x4 type; };
constexpr int BM = 256, BK = 64, HALF = 128, HTB = HALF * BK * 2  , STAGE_BYTES = 8 * HTB, NXCD = 8, WGM = 8;

__host__ __device__ __forceinline__ int lds_byte(int r, int c) { const int st = (r >> 4) * 2 + (c >> 5), rr = r & 15, cc = c & 31, ob = rr * 64 + cc * 2; return st * 1024 + (ob ^ (((ob >> 9) & 1) << 5)); }
__host__ __device__ __forceinline__ void stage_rc(int b, int& R, int& C) { const int st = b / 1024, sb = b % 1024, swz = sb ^ (((sb >> 9) & 1) << 5); R = (st >> 1) * 16 + swz / 64; C = (st & 1) * 32 + (swz % 64) / 2; }
__host__ __device__ __forceinline__ int perm32(int rho) { const int n = rho >> 4, i = rho & 15; return 8 * (i >> 2) + 4 * n + (i & 3); }

struct Unit { int pm, pn; };
struct Gemm { const bf16_t* A; const bf16_t* Bt; int M, N, K; };
struct MoeInfo { const int* list; const int* tile_expert; size_t bstride; };

struct StaticOrder {
    int nM, nN, nwg, G, c;
    __host__ __device__ void init(int M, int N, int G_, int c_) { nM = M / BM; nN = N / BM; nwg = nM * nN; G = G_; c = c_; }
    __host__ __device__ bool next(int i, Unit& u) const {
        const long L = (long)i * G + c; if (L >= nwg) return false;
        int wgid = (int)L; { const int q = nwg / NXCD, r = nwg % NXCD, xcd = wgid % NXCD, off = wgid / NXCD; wgid = (xcd < r ? xcd * (q + 1) : r * (q + 1) + (xcd - r) * q) + off; }
        const int nig = WGM * nN, gid = wgid / nig, fm = gid * WGM, gsz = (nM - fm) < WGM ? (nM - fm) : WGM;
        u.pm = fm + ((wgid % nig) % gsz); u.pn = (wgid % nig) / gsz; return true;
    }
    __device__ __forceinline__ void a_ready(const Unit&) const {}
    __device__ __forceinline__ void done(const Unit&) const {}
};

__device__ __forceinline__ unsigned cvt_pk_bf16(float lo, float hi) { unsigned r; asm volatile("v_cvt_pk_bf16_f32 %0, %1, %2" : "=v"(r) : "v"(lo), "v"(hi)); return r; }


template <class Epi, class Sched, bool ALIGN_EPI, bool SP2, int MODE, int PREC = 0>
__device__ __forceinline__ void gemm_phase(PG8_LAS unsigned char* lds, const Gemm g, const Sched& S, const Epi& E, const MoeInfo mi) {
    const int tid = threadIdx.x, wid = __builtin_amdgcn_readfirstlane(tid >> 6), lane = tid & 63, wr = wid >> 2, wc = wid & 3, fr = lane & 15, fq = lane >> 4;
    int K_ = g.K; asm volatile("" : "+s"(K_));
    constexpr int ES = PREC ? 1 : 2;
    const int K = K_, nt = (K * ES) / (BK * 2);
    unsigned voffB[2]; int Rr[2], Cc[2];
#pragma unroll
    for (int i = 0; i < 2; ++i) { int R, C; stage_rc(tid * 16 + i * 8192, R, C); const int Rb = Epi::PERM ? ((R & ~31) + perm32(R & 31)) : R;
        Rr[i] = R; Cc[i] = C; voffB[i] = (unsigned)(Rb * K) * (unsigned)ES + (unsigned)C * 2u; }
    const size_t kstep = (size_t)(BK * 2);
    const size_t hstep = (size_t)HALF * K * ES;
    const size_t tstep = 2 * hstep;
    const unsigned ldsw = (unsigned)wid * 1024u;
    const int aoff = lds_byte(wr * 64 + fr, fq * 8), boff = lds_byte(wc * 32 + fr, fq * 8);
    const unsigned rowb = (unsigned)K * (unsigned)ES;
#define PG8_SA(b, h) (((b) * 2 + (h)) * HTB)
#define PG8_SB(b, h) ((4 + (b) * 2 + (h)) * HTB)
#define PG8_STAGE(bufoff, gbase, voff) do { _Pragma("unroll") for (int _i = 0; _i < 2; ++_i) \
        __builtin_amdgcn_global_load_lds((const unsigned*)((const char*)(gbase) + (voff)[_i]), (PG8_LAS unsigned*)(lds + (bufoff) + ldsw + _i * 8192), 16, 0, 0); } while (0)
#define PG8_LDA(dst, b, h) do { _Pragma("unroll") for (int m = 0; m < 4; ++m) { if constexpr (PREC == 2) { \
            const i32x4 lo_ = *(const PG8_LAS i32x4*)(lds + PG8_SA(b, h) + aoff + m * 2048), hi_ = *(const PG8_LAS i32x4*)(lds + PG8_SA(b, h) + aoff + m * 2048 + 1024); \
            dst##8[m] = (i32x8){lo_[0], lo_[1], lo_[2], lo_[3], hi_[0], hi_[1], hi_[2], hi_[3]}; } \
        else { _Pragma("unroll") for (int k = 0; k < 2; ++k) dst[m][k] = *(const PG8_LAS bf16x8*)(lds + PG8_SA(b, h) + aoff + m * 2048 + k * 1024); } } } while (0)
#define PG8_LDB(dst, b, h) do { _Pragma("unroll") for (int n = 0; n < 2; ++n) { if constexpr (PREC == 2) { \
            const i32x4 lo_ = *(const PG8_LAS i32x4*)(lds + PG8_SB(b, h) + boff + n * 2048), hi_ = *(const PG8_LAS i32x4*)(lds + PG8_SB(b, h) + boff + n * 2048 + 1024); \
            dst##8[n] = (i32x8){lo_[0], lo_[1], lo_[2], lo_[3], hi_[0], hi_[1], hi_[2], hi_[3]}; } \
        else { _Pragma("unroll") for (int k = 0; k < 2; ++k) dst[n][k] = *(const PG8_LAS bf16x8*)(lds + PG8_SB(b, h) + boff + n * 2048 + k * 1024); } } } while (0)
#define PG8_MMA(ai, bj, At, Bt) do { __builtin_amdgcn_s_setprio(1); _Pragma("unroll") for (int m = 0; m < 4; ++m) _Pragma("unroll") for (int n = 0; n < 2; ++n) { \
        if constexpr (PREC == 2) asm volatile("s_nop 1\n\tv_mfma_scale_f32_16x16x128_f8f6f4 %0, %1, %2, %0, %3, %3 op_sel_hi:[0,0,0]" : "+v"(acc[ai][bj][m][n]) : "v"(Bt##8[n]), "v"(At##8[m]), "v"(one_scale));   \
        else { _Pragma("unroll") for (int k = 0; k < 2; ++k) { \
            if constexpr (PREC == 1) acc[ai][bj][m][n] = __builtin_amdgcn_mfma_i32_16x16x64_i8(__builtin_bit_cast(i32x4, Bt[n][k]), __builtin_bit_cast(i32x4, At[m][k]), acc[ai][bj][m][n], 0, 0, 0); \
            else acc[ai][bj][m][n] = __builtin_amdgcn_mfma_f32_16x16x32_bf16(Bt[n][k], At[m][k], acc[ai][bj][m][n], 0, 0, 0); } } } __builtin_amdgcn_s_setprio(0); } while (0)
#define PG8_WAIT_V(n) asm volatile("s_waitcnt vmcnt(" #n ")" ::: "memory")
#define PG8_WAIT_L(n) asm volatile("s_waitcnt lgkmcnt(" #n ")" ::: "memory")
#define PG8_WAIT_V8R do { const int rlx_ = rlx_flag;   \
        if constexpr (Epi::NST >= 16) asm volatile("s_cmp_eq_u32 %0, 0\n\ts_cbranch_scc1 .Lpg8a%=\n\ts_waitcnt vmcnt(24)\n\ts_branch .Lpg8b%=\n.Lpg8a%=:\n\ts_waitcnt vmcnt(8)\n.Lpg8b%=:" :: "s"(rlx_) : "memory", "scc"); \
        else if constexpr (Epi::NST >= 8) asm volatile("s_cmp_eq_u32 %0, 0\n\ts_cbranch_scc1 .Lpg8a%=\n\ts_waitcnt vmcnt(16)\n\ts_branch .Lpg8b%=\n.Lpg8a%=:\n\ts_waitcnt vmcnt(8)\n.Lpg8b%=:" :: "s"(rlx_) : "memory", "scc"); \
        else PG8_WAIT_V(8); } while (0)
#define PG8_BAR __builtin_amdgcn_s_barrier()
#define PG8_SCHED __builtin_amdgcn_sched_barrier(0)
#define PG8_MKOFF(u, o) do { _Pragma("unroll") for (int _h = 0; _h < 2; ++_h) _Pragma("unroll") for (int _i = 0; _i < 2; ++_i) { \
        int _row = (u).pm * BM + _h * HALF + Rr[_i]; if (MODE == 1) _row = mi.list[_row]; (o)[_h][_i] = (unsigned)_row * rowb + (unsigned)Cc[_i] * 2u; } } while (0)
#define PG8_BBASE(u) ((const char*)g.Bt + (size_t)(u).pn * tstep + (MODE != 0 ? (size_t)mi.tile_expert[(u).pm] * mi.bstride : (size_t)0))
    PG8_LAS int* utab = (PG8_LAS int*)(lds + STAGE_BYTES);
    if (tid < 64) { Unit u_; const bool ok_ = S.next(tid, u_); utab[2 * tid] = ok_ ? u_.pm : -1; utab[2 * tid + 1] = ok_ ? u_.pn : 0; }
    __syncthreads();
#define PG8_NEXT(i, u) (((i) < 64) ? ((u).pm = __builtin_amdgcn_readfirstlane(utab[2 * (i)]), (u).pn = __builtin_amdgcn_readfirstlane(utab[2 * (i) + 1]), (u).pm >= 0) : S.next((i), (u)))
    Unit cur, nxt; int ui = 0;
    if (!PG8_NEXT(0, cur)) return;
#if PG8_STAGGER
    {
        const int grp = ((int)blockIdx.x >> 3) & 3;
        if (grp) { if (wid == 0) { const unsigned long long t0 = __builtin_amdgcn_s_memrealtime(); const unsigned long long dt = (unsigned long long)(grp * nt * PG8_STAGGER);
                       while (__builtin_amdgcn_s_memrealtime() - t0 < dt) __builtin_amdgcn_s_sleep(8); }
                   __syncthreads(); }
    }
#endif
    typedef typename AccT<PREC>::type acc_t;
    acc_t acc[2][2][4][2];
#pragma unroll
    for (int a = 0; a < 2; ++a)
#pragma unroll
        for (int b = 0; b < 2; ++b)
#pragma unroll
            for (int m = 0; m < 4; ++m)
#pragma unroll
                for (int n = 0; n < 2; ++n) acc[a][b][m][n] = acc_t{};
    bf16x8 At[4][2], B0[2][2], B1[2][2];
    const int one_scale = 0x7f7f7f7f;
    unsigned oc[2][2], on[2][2];
    const char* const Ab = (const char*)g.A;
    const char* cAu = Ab;
    if constexpr (MODE == 1) { PG8_MKOFF(cur, oc); } else { Unit u0_; u0_.pm = 0; u0_.pn = 0; PG8_MKOFF(u0_, oc); cAu = Ab + (size_t)cur.pm * tstep; }
    const char* cB = PG8_BBASE(cur);
    S.a_ready(cur);
    static_assert(SP2, "only the SP2 loop is kept");
    {
        PG8_STAGE(PG8_SB(0, 0), cB, voffB); PG8_STAGE(PG8_SB(0, 1), cB + hstep, voffB); PG8_STAGE(PG8_SA(0, 0), cAu, oc[0]); PG8_STAGE(PG8_SA(0, 1), cAu, oc[1]);
        if (wr == 1) PG8_BAR;
        PG8_WAIT_V(2); PG8_BAR;
        PG8_STAGE(PG8_SB(1, 0), cB + kstep, voffB); PG8_STAGE(PG8_SA(1, 0), cAu + kstep, oc[0]); PG8_STAGE(PG8_SB(1, 1), cB + hstep + kstep, voffB);
        PG8_WAIT_V(6); PG8_BAR;
    }
    Unit nn; unsigned onn[2][2]; bool has_next_c = false;
    if constexpr (MODE == 1) { has_next_c = PG8_NEXT(1, nxt); if (has_next_c) PG8_MKOFF(nxt, on); }
    typename Epi::Pre pre;
    int rlx_flag = 0;
    for (;;) {
        bool has_next; bool has_nn = false;
        if constexpr (MODE == 1) { has_next = has_next_c; has_nn = has_next && PG8_NEXT(ui + 2, nn); if (has_nn) PG8_MKOFF(nn, onn); }
        else has_next = PG8_NEXT(ui + 1, nxt);
        const char* nB = cB; const char* nAu = cAu;
        if (has_next) { if constexpr (MODE != 1) nAu = Ab + (size_t)nxt.pm * tstep; nB = PG8_BBASE(nxt); }
        else if constexpr (MODE == 1) {
#pragma unroll
            for (int _h = 0; _h < 2; ++_h)
#pragma unroll
                for (int _i = 0; _i < 2; ++_i) on[_h][_i] = oc[_h][_i];
        }
        for (int t = 0; t < nt; t += 2) {
            const bool last = (t == nt - 2);
            i32x8 At8[4], B08[2], B18[2];
            const char* a1 = cAu + (size_t)(t + 1) * kstep;
            const char* a2 = last ? nAu : cAu + (size_t)(t + 2) * kstep; const char* b2 = last ? nB : cB + (size_t)(t + 2) * kstep;
            const char* a3 = a2 + kstep; const char* b3 = b2 + kstep;
            unsigned o2[2][2];
#pragma unroll
            for (int _h = 0; _h < 2; ++_h)
#pragma unroll
                for (int _i = 0; _i < 2; ++_i) o2[_h][_i] = (MODE == 1 && last) ? on[_h][_i] : oc[_h][_i];
            if (last && has_next) S.a_ready(nxt);
            PG8_LDB(B0, 0, 0); PG8_LDB(B1, 0, 1); PG8_SCHED; PG8_LDA(At, 0, 0); PG8_STAGE(PG8_SA(1, 1), a1, oc[1]);
            PG8_WAIT_V8R; PG8_WAIT_L(0); PG8_BAR; PG8_MMA(0, 0, At, B0); PG8_MMA(0, 1, At, B1); PG8_BAR; PG8_SCHED;
            PG8_LDA(At, 0, 1); PG8_STAGE(PG8_SB(0, 0), b2, voffB); PG8_STAGE(PG8_SB(0, 1), b2 + hstep, voffB); PG8_STAGE(PG8_SA(0, 0), a2, o2[0]);
            PG8_WAIT_V8R; PG8_WAIT_L(0); PG8_BAR; PG8_MMA(1, 0, At, B0); PG8_MMA(1, 1, At, B1); PG8_BAR; PG8_SCHED;
            PG8_LDB(B0, 1, 0); PG8_LDB(B1, 1, 1); PG8_SCHED; PG8_LDA(At, 1, 0); PG8_STAGE(PG8_SA(0, 1), a2, o2[1]);
            PG8_WAIT_V(8); PG8_WAIT_L(0); PG8_BAR; PG8_MMA(0, 0, At, B0); PG8_MMA(0, 1, At, B1); PG8_BAR; PG8_SCHED;
            PG8_LDA(At, 1, 1); PG8_STAGE(PG8_SB(1, 0), b3, voffB); PG8_STAGE(PG8_SB(1, 1), b3 + hstep, voffB); PG8_STAGE(PG8_SA(1, 0), a3, o2[0]);
            PG8_WAIT_V(8); PG8_WAIT_L(0); PG8_BAR; PG8_MMA(1, 0, At, B0); PG8_MMA(1, 1, At, B1); PG8_BAR; PG8_SCHED;
            rlx_flag = 0; asm volatile("" : "+s"(rlx_flag));
        }
        if constexpr (Epi::PRE != 0) E.prefetch(pre, cur, wr, wc, fr, fq);
        if constexpr (ALIGN_EPI) { if (wr == 0) PG8_BAR; }
        if constexpr (PREC == 2) asm volatile("s_nop 15\n\ts_nop 15" ::: "memory");
        if constexpr (Epi::PRE != 0) E(acc, cur, wr, wc, fr, fq, pre); else E(acc, cur, wr, wc, fr, fq);
        S.done(cur);
        if (!has_next) break;
#pragma unroll
        for (int a = 0; a < 2; ++a)
#pragma unroll
            for (int b = 0; b < 2; ++b)
#pragma unroll
                for (int m = 0; m < 4; ++m)
#pragma unroll
                    for (int n = 0; n < 2; ++n) acc[a][b][m][n] = acc_t{};
        cur = nxt; cB = nB; cAu = nAu; ++ui; rlx_flag = 1; asm volatile("" : "+s"(rlx_flag));
        if constexpr (MODE == 1) {
#pragma unroll
            for (int _h = 0; _h < 2; ++_h)
#pragma unroll
                for (int _i = 0; _i < 2; ++_i) oc[_h][_i] = on[_h][_i]; }
        if constexpr (MODE == 1) { nxt = nn; has_next_c = has_nn;
#pragma unroll
            for (int _h = 0; _h < 2; ++_h)
#pragma unroll
                for (int _i = 0; _i < 2; ++_i) on[_h][_i] = onn[_h][_i]; }
        if constexpr (ALIGN_EPI) { if (wr == 1) PG8_BAR; }
    }
    PG8_WAIT_V(0);
    if constexpr (!ALIGN_EPI) { if (wr == 0) PG8_BAR; }
    PG8_BAR;
#undef PG8_SA
#undef PG8_SB
#undef PG8_STAGE
#undef PG8_LDA
#undef PG8_LDB
#undef PG8_MMA
#undef PG8_WAIT_V
#undef PG8_WAIT_L
#undef PG8_WAIT_V8R
#undef PG8_BAR
#undef PG8_SCHED
#undef PG8_MKOFF
#undef PG8_NEXT
#undef PG8_BBASE
}
}
namespace pg8 {
constexpr float LOG2E = 1.4426950408889634f;
__device__ __forceinline__ f32x4 tof(const f32x4& a) { return a; }
__device__ __forceinline__ f32x4 tof(const i32x4& a) { return (f32x4){(float)a[0], (float)a[1], (float)a[2], (float)a[3]}; }
struct EpiBf16 {
    static constexpr bool PERM = true; static constexpr int NST = 16; static constexpr int PRE = 0; struct Pre {};
    bf16_t* O; int ldc; float scale;
    __device__ __forceinline__ void operator()(const f32x4 (&acc)[2][2][4][2], const Unit& u, int wr, int wc, int fr, int fq) const {
        const int row0 = u.pm * BM + wr * 64 + fr; const int col0 = u.pn * BM + wc * 32 + 8 * fq;
#pragma unroll
        for (int ai = 0; ai < 2; ++ai)
#pragma unroll
            for (int m = 0; m < 4; ++m) { bf16_t* rowp = O + (size_t)(row0 + ai * HALF + m * 16) * ldc + col0;
#pragma unroll
                for (int bj = 0; bj < 2; ++bj) { const f32x4 v0 = acc[ai][bj][m][0] * scale, v1 = acc[ai][bj][m][1] * scale;
                    u32x4 w; w.x = cvt_pk_bf16(v0[0], v0[1]); w.y = cvt_pk_bf16(v0[2], v0[3]); w.z = cvt_pk_bf16(v1[0], v1[1]); w.w = cvt_pk_bf16(v1[2], v1[3]);
                    *(u32x4*)(rowp + bj * HALF) = w; } }
    }
};
struct EpiQ {
    static constexpr bool PERM = true; static constexpr int NST = 16; static constexpr int PRE = 0; struct Pre {};
    bf16_t* O; int ldc; float scale; const float* cs;
    __device__ __forceinline__ void operator()(const f32x4 (&acc)[2][2][4][2], const Unit& u, int wr, int wc, int fr, int fq) const {
        const int row0 = u.pm * BM + wr * 64 + fr; const int col0 = u.pn * BM + wc * 32 + 8 * fq;
        const int grp = u.pn * 8 + wc;
#pragma unroll
        for (int bj = 0; bj < 2; ++bj) { const bool rope = ((grp + 4 * bj) % 3) == 2;
#pragma unroll
            for (int ai = 0; ai < 2; ++ai)
#pragma unroll
                for (int m = 0; m < 4; ++m) { const int row = row0 + ai * HALF + m * 16; bf16_t* rowp = O + (size_t)row * ldc + col0 + bj * HALF;
                    f32x4 v0 = acc[ai][bj][m][0] * scale, v1 = acc[ai][bj][m][1] * scale;
                    if (rope) { const f32x4* cp = (const f32x4*)(cs + (size_t)row * 32 + 8 * fq); const f32x4 c0 = cp[0], c1 = cp[1];
                        f32x4 r0, r1;
                        r0[0] = v0[0] * c0[0] - v0[1] * c0[1]; r0[1] = v0[0] * c0[1] + v0[1] * c0[0];
                        r0[2] = v0[2] * c0[2] - v0[3] * c0[3]; r0[3] = v0[2] * c0[3] + v0[3] * c0[2];
                        r1[0] = v1[0] * c1[0] - v1[1] * c1[1]; r1[1] = v1[0] * c1[1] + v1[1] * c1[0];
                        r1[2] = v1[2] * c1[2] - v1[3] * c1[3]; r1[3] = v1[2] * c1[3] + v1[3] * c1[2];
                        v0 = r0; v1 = r1; }
                    u32x4 w; w.x = cvt_pk_bf16(v0[0], v0[1]); w.y = cvt_pk_bf16(v0[2], v0[3]); w.z = cvt_pk_bf16(v1[0], v1[1]); w.w = cvt_pk_bf16(v1[2], v1[3]);
                    *(u32x4*)rowp = w;
                    if (m & 1) asm volatile("" ::: "memory"); } }
    }
};
struct EpiQQ {
    static constexpr bool PERM = true; static constexpr int NST = 16; static constexpr int PRE = 0; struct Pre {};
    bf16_t* O; const float* cs; const float* sA; const float* sB;
    __device__ __forceinline__ void operator()(const i32x4 (&acc)[2][2][4][2], const Unit& u, int wr, int wc, int fr, int fq) const {
        constexpr int ldc = 1536; constexpr float scale = 0.1472444460259031f;
        const int row0 = u.pm * BM + wr * 64 + fr; const int col0 = u.pn * BM + wc * 32 + 8 * fq;
        const int grp = u.pn * 8 + wc;
#pragma unroll
        for (int bj = 0; bj < 2; ++bj) { const bool rope = ((grp + 4 * bj) % 3) == 2;
            const f32x4 sb0 = *(const f32x4*)(sB + col0 + bj * HALF) * scale, sb1 = *(const f32x4*)(sB + col0 + bj * HALF + 4) * scale;
#pragma unroll
            for (int ai = 0; ai < 2; ++ai)
#pragma unroll
                for (int m = 0; m < 4; ++m) { const int row = row0 + ai * HALF + m * 16; bf16_t* rowp = O + (size_t)row * ldc + col0 + bj * HALF; const float sa = sA[row];
                    f32x4 v0 = tof(acc[ai][bj][m][0]) * sa * sb0, v1 = tof(acc[ai][bj][m][1]) * sa * sb1;
                    if (rope) { const f32x4* cp = (const f32x4*)(cs + (size_t)row * 32 + 8 * fq); const f32x4 c0 = cp[0], c1 = cp[1];
                        f32x4 r0, r1;
                        r0[0] = v0[0] * c0[0] - v0[1] * c0[1]; r0[1] = v0[0] * c0[1] + v0[1] * c0[0];
                        r0[2] = v0[2] * c0[2] - v0[3] * c0[3]; r0[3] = v0[2] * c0[3] + v0[3] * c0[2];
                        r1[0] = v1[0] * c1[0] - v1[1] * c1[1]; r1[1] = v1[0] * c1[1] + v1[1] * c1[0];
                        r1[2] = v1[2] * c1[2] - v1[3] * c1[3]; r1[3] = v1[2] * c1[3] + v1[3] * c1[2];
                        v0 = r0; v1 = r1; }
                    u32x4 w; w.x = cvt_pk_bf16(v0[0], v0[1]); w.y = cvt_pk_bf16(v0[2], v0[3]); w.z = cvt_pk_bf16(v1[0], v1[1]); w.w = cvt_pk_bf16(v1[2], v1[3]);
                    *(u32x4*)rowp = w;
                    if (m & 1) asm volatile("" ::: "memory"); } }
    }
};
struct EpiKVQ {
    static constexpr bool PERM = true; static constexpr int NST = 16; static constexpr int PRE = 0; struct Pre {};
    bf16_t* Kb; bf16_t* Vb; const float* sA; const float* sB;
    __device__ __forceinline__ void operator()(const i32x4 (&acc)[2][2][4][2], const Unit& u, int wr, int wc, int fr, int fq) const {
        const int row0 = u.pm * BM + wr * 64 + fr; const int col0 = u.pn * BM + wc * 32 + 8 * fq;
        const bool isk = wc < 2;
        bf16_t* const base = isk ? Kb : Vb; const int pitch = isk ? 1536 : 1024, hs = isk ? 96 : 64, j0 = (isk ? wc : wc - 2) * 32 + 8 * fq;
        f32x4 sb[2][2];
#pragma unroll
        for (int bj = 0; bj < 2; ++bj)
#pragma unroll
            for (int n = 0; n < 2; ++n) sb[bj][n] = *(const f32x4*)(sB + col0 + bj * HALF + 4 * n);
#pragma unroll
        for (int ai = 0; ai < 2; ++ai)
#pragma unroll
            for (int m = 0; m < 4; ++m) { const int row = row0 + ai * HALF + m * 16; bf16_t* rowp = base + (size_t)row * pitch + j0; const float sa = sA[row];
#pragma unroll
                for (int bj = 0; bj < 2; ++bj) { const f32x4 v0 = tof(acc[ai][bj][m][0]) * sa * sb[bj][0], v1 = tof(acc[ai][bj][m][1]) * sa * sb[bj][1];
                    u32x4 w; w.x = cvt_pk_bf16(v0[0], v0[1]); w.y = cvt_pk_bf16(v0[2], v0[3]); w.z = cvt_pk_bf16(v1[0], v1[1]); w.w = cvt_pk_bf16(v1[2], v1[3]);
                    *(u32x4*)(rowp + (2 * u.pn + bj) * hs) = w; } }
    }
};
struct EpiKV {
    static constexpr bool PERM = true; static constexpr int NST = 16; static constexpr int PRE = 0; struct Pre {};
    bf16_t* Kb; bf16_t* Vb;
    __device__ __forceinline__ void operator()(const f32x4 (&acc)[2][2][4][2], const Unit& u, int wr, int wc, int fr, int fq) const {
        const int row0 = u.pm * BM + wr * 64 + fr;
        const bool isk = wc < 2;
        bf16_t* const base = isk ? Kb : Vb; const int pitch = isk ? 1536 : 1024, hs = isk ? 96 : 64, j0 = (isk ? wc : wc - 2) * 32 + 8 * fq;
#pragma unroll
        for (int ai = 0; ai < 2; ++ai)
#pragma unroll
            for (int m = 0; m < 4; ++m) { bf16_t* rowp = base + (size_t)(row0 + ai * HALF + m * 16) * pitch + j0;
#pragma unroll
                for (int bj = 0; bj < 2; ++bj) { const f32x4 v0 = acc[ai][bj][m][0], v1 = acc[ai][bj][m][1];
                    u32x4 w; w.x = cvt_pk_bf16(v0[0], v0[1]); w.y = cvt_pk_bf16(v0[2], v0[3]); w.z = cvt_pk_bf16(v1[0], v1[1]); w.w = cvt_pk_bf16(v1[2], v1[3]);
                    *(u32x4*)(rowp + (2 * u.pn + bj) * hs) = w; } }
    }
};
template <bool BASEF32> struct EpiResid {
    static constexpr bool PERM = true; static constexpr int NST = 16; static constexpr int PRE = 0; struct Pre {};
    static constexpr int HP = 2048;
    const void* base; bf16_t* out; const float* gate; const float* sB;
    __device__ __forceinline__ void operator()(const f32x4 (&acc)[2][2][4][2], const Unit& u, int wr, int wc, int fr, int fq) const {
        const int row0 = u.pm * BM + wr * 64 + fr; const int col0 = u.pn * BM + wc * 32 + 8 * fq;
        const float* gp = gate + (size_t)((u.pm * BM) >> 13) * 1024 + col0;
        f32x4 gv[2][2];
#pragma unroll
        for (int bj = 0; bj < 2; ++bj)
#pragma unroll
            for (int n = 0; n < 2; ++n) { gv[bj][n] = *(const f32x4*)(gp + bj * HALF + n * 4); if (sB) gv[bj][n] = gv[bj][n] * *(const f32x4*)(sB + col0 + bj * HALF + n * 4); }
#pragma unroll
        for (int ai = 0; ai < 2; ++ai)
#pragma unroll
            for (int m = 0; m < 4; ++m) { const size_t row = (size_t)(row0 + ai * HALF + m * 16);
#pragma unroll
                for (int bj = 0; bj < 2; ++bj) { f32x4 b0, b1;
                    if (BASEF32) { const float* bp = (const float*)base + row * 1024 + col0 + bj * HALF; b0 = *(const f32x4*)bp; b1 = *(const f32x4*)(bp + 4); }
                    else { const u32x4 hb = *(const u32x4*)((const bf16_t*)base + row * HP + col0 + bj * HALF);
                        b0 = (f32x4){__builtin_bit_cast(float, hb.x << 16), __builtin_bit_cast(float, hb.x & 0xffff0000u), __builtin_bit_cast(float, hb.y << 16), __builtin_bit_cast(float, hb.y & 0xffff0000u)};
                        b1 = (f32x4){__builtin_bit_cast(float, hb.z << 16), __builtin_bit_cast(float, hb.z & 0xffff0000u), __builtin_bit_cast(float, hb.w << 16), __builtin_bit_cast(float, hb.w & 0xffff0000u)}; }
                    const f32x4 v0 = b0 + gv[bj][0] * acc[ai][bj][m][0], v1 = b1 + gv[bj][1] * acc[ai][bj][m][1];
                    u32x4 w; w.x = cvt_pk_bf16(v0[0], v0[1]); w.y = cvt_pk_bf16(v0[2], v0[3]); w.z = cvt_pk_bf16(v1[0], v1[1]); w.w = cvt_pk_bf16(v1[2], v1[3]);
                    *(u32x4*)(out + row * HP + col0 + bj * HALF) = w; }
                if (m & 1) asm volatile("" ::: "memory"); }
    }
};
__device__ __forceinline__ float silu_mul(float g, float u) { return g * u * __builtin_amdgcn_rcpf(1.0f + __builtin_amdgcn_exp2f(-g * LOG2E)); }
struct EpiSwiGLU {
    static constexpr bool PERM = true; static constexpr int NST = 8; static constexpr int PRE = 0; struct Pre {};
    bf16_t* O; int ldc;
    __device__ __forceinline__ void operator()(const f32x4 (&acc)[2][2][4][2], const Unit& u, int wr, int wc, int fr, int fq) const {
        const int row0 = u.pm * BM + wr * 64 + fr; const int col0 = u.pn * HALF + wc * 32 + 8 * fq;
#pragma unroll
        for (int ai = 0; ai < 2; ++ai)
#pragma unroll
            for (int m = 0; m < 4; ++m) { bf16_t* rowp = O + (size_t)(row0 + ai * HALF + m * 16) * ldc + col0;
                const f32x4 g0 = acc[ai][0][m][0], g1 = acc[ai][0][m][1], u0 = acc[ai][1][m][0], u1 = acc[ai][1][m][1];
                u32x4 w; w.x = cvt_pk_bf16(silu_mul(g0[0], u0[0]), silu_mul(g0[1], u0[1])); w.y = cvt_pk_bf16(silu_mul(g0[2], u0[2]), silu_mul(g0[3], u0[3]));
                w.z = cvt_pk_bf16(silu_mul(g1[0], u1[0]), silu_mul(g1[1], u1[1])); w.w = cvt_pk_bf16(silu_mul(g1[2], u1[2]), silu_mul(g1[3], u1[3]));
                *(u32x4*)rowp = w; }
    }
};
struct EpiMoeDown {
    static constexpr bool PERM = true; static constexpr int NST = 16; static constexpr int PRE = 12;
    struct Pre { float sg[8]; f32x4 sv[2][2]; };
    bf16_t* O; const float* sg; const float* sB; const int* tile_expert;
    __device__ __forceinline__ void prefetch(Pre& p, const Unit& u, int wr, int wc, int fr, int fq) const {
        const int row0 = u.pm * BM + wr * 64 + fr; const int col0 = u.pn * BM + wc * 32 + 8 * fq;
        const float* sb = sB + (size_t)tile_expert[u.pm] * 1024 + col0;
#pragma unroll
        for (int ai = 0; ai < 2; ++ai)
#pragma unroll
            for (int m = 0; m < 4; ++m) p.sg[ai * 4 + m] = sg[row0 + ai * HALF + m * 16];
#pragma unroll
        for (int bj = 0; bj < 2; ++bj)
#pragma unroll
            for (int n = 0; n < 2; ++n) p.sv[bj][n] = *(const f32x4*)(sb + bj * HALF + 4 * n);
    }
    __device__ __forceinline__ void operator()(const f32x4 (&acc)[2][2][4][2], const Unit& u, int wr, int wc, int fr, int fq, const Pre& p) const {
        const int row0 = u.pm * BM + wr * 64 + fr; const int col0 = u.pn * BM + wc * 32 + 8 * fq;
#pragma unroll
        for (int ai = 0; ai < 2; ++ai)
#pragma unroll
            for (int m = 0; m < 4; ++m) { const int row = row0 + ai * HALF + m * 16; const float s = p.sg[ai * 4 + m]; bf16_t* rowp = O + (size_t)row * 1024 + col0;
#pragma unroll
                for (int bj = 0; bj < 2; ++bj) { const f32x4 v0 = acc[ai][bj][m][0] * p.sv[bj][0] * s, v1 = acc[ai][bj][m][1] * p.sv[bj][1] * s;
                    u32x4 w; w.x = cvt_pk_bf16(v0[0], v0[1]); w.y = cvt_pk_bf16(v0[2], v0[3]); w.z = cvt_pk_bf16(v1[0], v1[1]); w.w = cvt_pk_bf16(v1[2], v1[3]);
                    *(u32x4*)(rowp + bj * HALF) = w; } }
    }
};
template <bool KV> struct EpiDil {
    static constexpr bool PERM = true; static constexpr int NST = 16; static constexpr int PRE = 0; struct Pre {};
    bf16_t* O; float scale;
    __device__ __forceinline__ void operator()(const f32x4 (&acc)[2][2][4][2], const Unit& u, int wr, int wc, int fr, int fq) const {
        const int row0 = u.pm * BM + wr * 64 + fr;
#pragma unroll
        for (int bj = 0; bj < 2; ++bj) { const int col = u.pn * BM + bj * HALF + wc * 32 + 8 * fq;
            const int g = KV ? (col >> 10) : (col >> 9), h = (col >> 6) & 7, d = col & 63, kv = KV ? ((col >> 9) & 1) : 0;
            const int sh = 2 * g;
#pragma unroll
            for (int ai = 0; ai < 2; ++ai)
#pragma unroll
                for (int m = 0; m < 4; ++m) { const int row = row0 + ai * HALF + m * 16, b = row >> 13, t = row & 8191;
                    const int r = t & ((1 << sh) - 1), pos = t >> sh;
                    const size_t rec = (size_t)g * 262144 + (size_t)((((b << sh) + r) * 8 + h) * (8192 >> sh) + pos);
                    bf16_t* dst = KV ? (O + rec * 128 + kv * 64 + d) : (O + rec * 64 + d);
                    const f32x4 v0 = acc[ai][bj][m][0] * scale, v1 = acc[ai][bj][m][1] * scale;
                    u32x4 w; w.x = cvt_pk_bf16(v0[0], v0[1]); w.y = cvt_pk_bf16(v0[2], v0[3]); w.z = cvt_pk_bf16(v1[0], v1[1]); w.w = cvt_pk_bf16(v1[2], v1[3]);
                    *(u32x4*)dst = w; } }
    }
};
}
namespace pg8 {
__device__ __forceinline__ f32x4 i2f(const i32x4& a, float sa, const f32x4& sb) { return (f32x4){(float)a[0], (float)a[1], (float)a[2], (float)a[3]} * sa * sb; }
struct EpiBf16Q {
    static constexpr bool PERM = true; static constexpr int NST = 16; static constexpr int PRE = 0; struct Pre {};
    bf16_t* O; int ldc; const float* sA; const float* sB;
    __device__ __forceinline__ void operator()(const i32x4 (&acc)[2][2][4][2], const Unit& u, int wr, int wc, int fr, int fq) const {
        const int row0 = u.pm * BM + wr * 64 + fr; const int col0 = u.pn * BM + wc * 32 + 8 * fq;
        f32x4 sb[2][2];
#pragma unroll
        for (int bj = 0; bj < 2; ++bj)
#pragma unroll
            for (int n = 0; n < 2; ++n) sb[bj][n] = *(const f32x4*)(sB + col0 + bj * HALF + 4 * n);
#pragma unroll
        for (int ai = 0; ai < 2; ++ai)
#pragma unroll
            for (int m = 0; m < 4; ++m) { const int row = row0 + ai * HALF + m * 16; const float sa = sA[row]; bf16_t* rowp = O + (size_t)row * ldc + col0;
#pragma unroll
                for (int bj = 0; bj < 2; ++bj) { const f32x4 v0 = i2f(acc[ai][bj][m][0], sa, sb[bj][0]), v1 = i2f(acc[ai][bj][m][1], sa, sb[bj][1]);
                    u32x4 w; w.x = cvt_pk_bf16(v0[0], v0[1]); w.y = cvt_pk_bf16(v0[2], v0[3]); w.z = cvt_pk_bf16(v1[0], v1[1]); w.w = cvt_pk_bf16(v1[2], v1[3]);
                    *(u32x4*)(rowp + bj * HALF) = w; } }
    }
};
template <bool KV> struct EpiDilQ {
    static constexpr bool PERM = true; static constexpr int NST = 16; static constexpr int PRE = 12;
    struct Pre { float sa[8]; f32x4 sb[2][2]; };
    bf16_t* O; const float* sA; const float* sB;
    __device__ __forceinline__ void prefetch(Pre& p, const Unit& u, int wr, int wc, int fr, int fq) const {
        const int row0 = u.pm * BM + wr * 64 + fr;
#pragma unroll
        for (int ai = 0; ai < 2; ++ai)
#pragma unroll
            for (int m = 0; m < 4; ++m) p.sa[ai * 4 + m] = sA[row0 + ai * HALF + m * 16];
#pragma unroll
        for (int bj = 0; bj < 2; ++bj) { const int col = u.pn * BM + bj * HALF + wc * 32 + 8 * fq; p.sb[bj][0] = *(const f32x4*)(sB + col); p.sb[bj][1] = *(const f32x4*)(sB + col + 4); }
    }
    __device__ __forceinline__ void operator()(const i32x4 (&acc)[2][2][4][2], const Unit& u, int wr, int wc, int fr, int fq, const Pre& p) const {
        bf16_t* const O_ = O; constexpr float scale_ = KV ? 1.0f : 0.18033688011112042f;
        const int row0 = u.pm * BM + wr * 64 + fr;
        const int colt = u.pn * BM;
        const int g = KV ? (colt >> 10) : (colt >> 9), kv = KV ? ((colt >> 9) & 1) : 0, sh = 2 * g, npos = 8192 >> sh;
        constexpr int RS = KV ? 128 : 64;
        const int d = (wc & 1) * 32 + 8 * fq;
        size_t hoff[2]; f32x4 sb[2][2];
#pragma unroll
        for (int bj = 0; bj < 2; ++bj) { const int col = colt + bj * HALF + wc * 32 + 8 * fq; const int h = (col >> 6) & 7;
            hoff[bj] = (size_t)h * npos * RS + kv * 64 + d; sb[bj][0] = p.sb[bj][0] * scale_; sb[bj][1] = p.sb[bj][1] * scale_; }
#pragma unroll
        for (int ai = 0; ai < 2; ++ai)
#pragma unroll
            for (int m = 0; m < 4; ++m) { const int row = row0 + ai * HALF + m * 16, b = row >> 13, t = row & 8191;
                const int r = t & ((1 << sh) - 1), pos = t >> sh;
                bf16_t* rp = O_ + ((size_t)g * 262144 + (size_t)(((b << sh) + r) * 8 * npos + pos)) * RS;
                const float sa = p.sa[ai * 4 + m];
#pragma unroll
                for (int bj = 0; bj < 2; ++bj) { const f32x4 v0 = i2f(acc[ai][bj][m][0], sa, sb[bj][0]), v1 = i2f(acc[ai][bj][m][1], sa, sb[bj][1]);
                    u32x4 w; w.x = cvt_pk_bf16(v0[0], v0[1]); w.y = cvt_pk_bf16(v0[2], v0[3]); w.z = cvt_pk_bf16(v1[0], v1[1]); w.w = cvt_pk_bf16(v1[2], v1[3]);
                    *(u32x4*)(rp + hoff[bj]) = w; }
                if (m & 1) asm volatile("" ::: "memory"); }
    }
};
constexpr float HSCALE = 8.0f;
__device__ __forceinline__ unsigned pk4_fp8(float a, float b, float c, float d) {
    a = __builtin_fminf(__builtin_fmaxf(a, -448.f), 448.f); b = __builtin_fminf(__builtin_fmaxf(b, -448.f), 448.f); c = __builtin_fminf(__builtin_fmaxf(c, -448.f), 448.f); d = __builtin_fminf(__builtin_fmaxf(d, -448.f), 448.f);
    int w = 0; w = __builtin_amdgcn_cvt_pk_fp8_f32(a, b, w, false); w = __builtin_amdgcn_cvt_pk_fp8_f32(c, d, w, true); return (unsigned)w; }
struct EpiSwiGLUQ {
    static constexpr bool PERM = true; static constexpr int NST = 8; static constexpr int PRE = 12;
    struct Pre { float sa[8]; f32x4 sg0, sg1, su0, su1; };
    unsigned char* O; int ldc; const float* sA; const float* sB; const int* tile_expert;
    __device__ __forceinline__ void prefetch(Pre& p, const Unit& u, int wr, int wc, int fr, int fq) const {
        const int row0 = u.pm * BM + wr * 64 + fr;
        const float* sb = sB + (tile_expert ? (size_t)tile_expert[u.pm] * (2 * 2816) : (size_t)0) + u.pn * BM + wc * 32 + 8 * fq;
#pragma unroll
        for (int ai = 0; ai < 2; ++ai)
#pragma unroll
            for (int m = 0; m < 4; ++m) p.sa[ai * 4 + m] = sA[row0 + ai * HALF + m * 16];
        p.sg0 = *(const f32x4*)sb; p.sg1 = *(const f32x4*)(sb + 4); p.su0 = *(const f32x4*)(sb + HALF); p.su1 = *(const f32x4*)(sb + HALF + 4);
    }
    __device__ __forceinline__ void operator()(const i32x4 (&acc)[2][2][4][2], const Unit& u, int wr, int wc, int fr, int fq, const Pre& p) const {
        const int row0 = u.pm * BM + wr * 64 + fr; const int col0 = u.pn * HALF + wc * 32 + 8 * fq;
        const f32x4 sg0 = p.sg0, sg1 = p.sg1, su0 = p.su0 * HSCALE, su1 = p.su1 * HSCALE;
        typedef unsigned u32x2 __attribute__((ext_vector_type(2)));
#pragma unroll
        for (int ai = 0; ai < 2; ++ai)
#pragma unroll
            for (int m = 0; m < 4; ++m) { const int row = row0 + ai * HALF + m * 16; const float sa = p.sa[ai * 4 + m]; unsigned char* rowp = O + (size_t)row * ldc + col0;
                const f32x4 g0 = i2f(acc[ai][0][m][0], sa, sg0), g1 = i2f(acc[ai][0][m][1], sa, sg1), u0 = i2f(acc[ai][1][m][0], sa, su0), u1 = i2f(acc[ai][1][m][1], sa, su1);
                u32x2 w; w.x = pk4_fp8(silu_mul(g0[0], u0[0]), silu_mul(g0[1], u0[1]), silu_mul(g0[2], u0[2]), silu_mul(g0[3], u0[3]));
                w.y = pk4_fp8(silu_mul(g1[0], u1[0]), silu_mul(g1[1], u1[1]), silu_mul(g1[2], u1[2]), silu_mul(g1[3], u1[3]));
                *(u32x2*)rowp = w; }
    }
};
}
namespace att {
using bf16 = unsigned short;
using bf16x8 = __attribute__((ext_vector_type(8))) short;
using s16x4 = __attribute__((ext_vector_type(4))) short;
using f32x16 = __attribute__((ext_vector_type(16))) float;
using u32x4 = __attribute__((ext_vector_type(4))) unsigned;
constexpr int NW = 8;
constexpr float THR = 8.0f;
__device__ __forceinline__ int crow(int r, int hi) { return (r & 3) + 8 * (r >> 2) + 4 * hi; }
__device__ __forceinline__ void glds16(const void* gsrc, unsigned lds_dst) { unsigned keep;
    asm volatile("s_mov_b32 %0, m0\n\ts_mov_b32 m0, %2\n\ts_nop 0\n\tglobal_load_lds_dwordx4 %1, off\n\ts_mov_b32 m0, %0" : "=&s"(keep) : "v"(gsrc), "s"(lds_dst) : "memory"); }
typedef float f32x2_t __attribute__((ext_vector_type(2))); typedef __bf16 bf16x2_t __attribute__((ext_vector_type(2)));
__device__ __forceinline__ unsigned cvtpk_s(float lo, float hi) { f32x2_t v = {lo, hi}; bf16x2_t b = __builtin_convertvector(v, bf16x2_t); return __builtin_bit_cast(unsigned, b); }
#define ATT_SBAR() __builtin_amdgcn_sched_barrier(0)
#define ATT_WAIT_BAR(N) asm volatile("s_waitcnt vmcnt(" #N ") lgkmcnt(0)\n\ts_barrier" ::: "memory")

template <int DQK> struct Lay {
    static constexpr int NKC = DQK / 8, KSLOT = NKC * 1024, ND0 = DQK / 16;
    static constexpr int LK = 0, LV = 3 * KSLOT, LWS = LV + 3 * 8192, LOST = LWS + NW * 256, LBIAS = LOST + NW * 4096, LEND = LBIAS + 1024;
};
static_assert(Lay<96>::LEND <= 131072 && Lay<64>::LEND <= 131072, "attention LDS");

__device__ __forceinline__ float rowmax32(const f32x16& p0, const f32x16& p1) {
    float a = __builtin_fmaxf(__builtin_fmaxf(p0[0], p0[1]), p1[0]), b = __builtin_fmaxf(__builtin_fmaxf(p0[2], p0[3]), p1[1]); a = __builtin_fmaxf(__builtin_fmaxf(a, p1[2]), p1[3]);
#pragma unroll
    for (int r = 4; r < 16; r += 4) { a = __builtin_fmaxf(__builtin_fmaxf(a, p0[r]), p0[r + 1]); b = __builtin_fmaxf(__builtin_fmaxf(b, p0[r + 2]), p0[r + 3]); a = __builtin_fmaxf(__builtin_fmaxf(a, p1[r]), p1[r + 1]); b = __builtin_fmaxf(__builtin_fmaxf(b, p1[r + 2]), p1[r + 3]); }
    float m = __builtin_fmaxf(a, b);
    auto rr = __builtin_amdgcn_permlane32_swap(__float_as_uint(m), __float_as_uint(m), false, false);
    return __builtin_fmaxf(__uint_as_float(rr[0]), __uint_as_float(rr[1]));
}
__device__ __forceinline__ void pv(f32x16* o, int vb, bf16x8 pa0, bf16x8 pa1, bf16x8 pa2, bf16x8 pa3) {
#pragma unroll
    for (int d0 = 0; d0 < 2; ++d0) { s16x4 lo[4], hi[4];
#pragma unroll
        for (int ks = 0; ks < 4; ++ks) {
            asm volatile("ds_read_b64_tr_b16 %0,%1 offset:%c2" : "=&v"(lo[ks]) : "v"(vb), "i"(d0 * 4096 + ks * 1024) : "memory");
            asm volatile("ds_read_b64_tr_b16 %0,%1 offset:%c2" : "=&v"(hi[ks]) : "v"(vb), "i"(d0 * 4096 + ks * 1024 + 512) : "memory"); }
        asm volatile("s_waitcnt lgkmcnt(0)" ::: "memory"); ATT_SBAR();
#define ATT_PK(k) (bf16x8){lo[k][0], lo[k][1], lo[k][2], lo[k][3], hi[k][0], hi[k][1], hi[k][2], hi[k][3]}
        o[d0] = __builtin_amdgcn_mfma_f32_32x32x16_bf16(pa0, ATT_PK(0), o[d0], 0, 0, 0);
        o[d0] = __builtin_amdgcn_mfma_f32_32x32x16_bf16(pa1, ATT_PK(1), o[d0], 0, 0, 0);
        o[d0] = __builtin_amdgcn_mfma_f32_32x32x16_bf16(pa2, ATT_PK(2), o[d0], 0, 0, 0);
        o[d0] = __builtin_amdgcn_mfma_f32_32x32x16_bf16(pa3, ATT_PK(3), o[d0], 0, 0, 0);
#undef ATT_PK
    }
}

template <int DQK, bool DIL>
__device__ __forceinline__ void attn_unit(const bf16* Qb, int pq, const bf16* __restrict__ Kb, int pk, const bf16* __restrict__ Vb, int pvp, bf16* Ob, int po, float* lse, const float* biasg,
                                          long rowbase, int dil, int q0, char* shm) {
    typedef Lay<DQK> L;
    const int tid = threadIdx.x, lane = tid & 63, r32 = lane & 31, hi = lane >> 5; const int wid = __builtin_amdgcn_readfirstlane(tid >> 6);
    const unsigned lds0 = (unsigned)(uintptr_t)shm;
    float* wsf = (float*)(shm + L::LWS) + wid * 64;
    const int kpos0 = DIL ? q0 - 128 : 0;
    const int t_begin = DIL ? (q0 == 0 ? 2 : 0) : 0;
    const int t_end = DIL ? 6 : (q0 + 256) / 64;
    const int wt0 = DIL ? (wid >> 1) : 0;
    const int wt1 = DIL ? 2 + (wid >> 1) : (q0 + 32 * wid + 31) / 64;
    const bool two_k = (L::NKC > 8) && (wid + 8 < L::NKC);
#define ATT_GROW(pos) (rowbase + (long)(pos) * dil)
#define ATT_ISSUE(t, s) do { const int kp_ = kpos0 + 64 * (t); \
        glds16(Kb + ATT_GROW(kp_ + lane) * pk + wid * 8, (unsigned)__builtin_amdgcn_readfirstlane(lds0 + L::LK + (s) * L::KSLOT + wid * 1024)); \
        if (two_k) glds16(Kb + ATT_GROW(kp_ + lane) * pk + (wid + 8) * 8, (unsigned)__builtin_amdgcn_readfirstlane(lds0 + L::LK + (s) * L::KSLOT + (wid + 8) * 1024)); \
        glds16(Vb + ATT_GROW(kp_ + 16 * (wid & 3) + (lane >> 2)) * pvp + (wid >> 2) * 32 + (lane & 3) * 8, (unsigned)__builtin_amdgcn_readfirstlane(lds0 + L::LV + (s) * 8192 + wid * 1024)); } while (0)
    if (DIL) { if (tid < 129) ((float*)(shm + L::LBIAS))[tid] = biasg[tid]; }
    ATT_ISSUE(t_begin, 0);
    if (t_begin + 1 < t_end) ATT_ISSUE(t_begin + 1, 1);
    bf16x8 qr[L::ND0];
    { const bf16* Qw = Qb + ATT_GROW(q0 + wid * 32 + r32) * pq + hi * 8;
#pragma unroll
      for (int d0 = 0; d0 < L::ND0; ++d0) qr[d0] = *reinterpret_cast<const bf16x8*>(Qw + d0 * 16); }
    float mhat = 0.f, l_reg = 0.f; f32x16 o[2]; o[0] = f32x16{}; o[1] = f32x16{}; f32x16 negm = f32x16{};
    bool first = true;
    const int qrel = (DIL ? 128 : q0) + wid * 32 + r32;
    const int vbl = (int)(lds0 + L::LV) + ((lane >> 4) & 1) * 32 + (lane & 3) * 8 + (4 * hi + ((lane & 15) >> 2)) * 64;
    int slot = 0;
    for (int t = t_begin; t < t_end; ++t) {
        if (t + 1 < t_end) { if (two_k) ATT_WAIT_BAR(3); else ATT_WAIT_BAR(2); } else ATT_WAIT_BAR(0);
        if (t + 2 < t_end) { const int s2 = slot >= 1 ? slot - 1 : 2; ATT_ISSUE(t + 2, s2); }
        if (t >= wt0 && t <= wt1) {
            f32x16 p0, p1;
            { const char* kb = shm + L::LK + slot * L::KSLOT + hi * 1024 + r32 * 16;
#pragma unroll
              for (int d0 = 0; d0 < L::ND0; ++d0) {
                const bf16x8 b0 = *reinterpret_cast<const bf16x8*>(kb + d0 * 2048);
                const bf16x8 b1 = *reinterpret_cast<const bf16x8*>(kb + d0 * 2048 + 512);
                if (d0 == 0) { p0 = __builtin_amdgcn_mfma_f32_32x32x16_bf16(b0, qr[0], negm, 0, 0, 0); p1 = __builtin_amdgcn_mfma_f32_32x32x16_bf16(b1, qr[0], negm, 0, 0, 0); }
                else { p0 = __builtin_amdgcn_mfma_f32_32x32x16_bf16(b0, qr[d0], p0, 0, 0, 0); p1 = __builtin_amdgcn_mfma_f32_32x32x16_bf16(b1, qr[d0], p1, 0, 0, 0); } } }
            if (DIL) { const float* bl = (const float*)(shm + L::LBIAS); const int jb = qrel - 64 * t - 4 * hi;
#pragma unroll
                for (int r = 0; r < 16; ++r) { const int j0 = jb - ((r & 3) + 8 * (r >> 2)), j1 = j0 - 32;
                    const int c0 = j0 < 0 ? 0 : (j0 > 128 ? 128 : j0), c1 = j1 < 0 ? 0 : (j1 > 128 ? 128 : j1);
                    const float b0 = bl[c0], b1 = bl[c1];
                    p0[r] = (j0 >= 0 && j0 <= 128) ? p0[r] + b0 : -INFINITY; p1[r] = (j1 >= 0 && j1 <= 128) ? p1[r] + b1 : -INFINITY; }
            } else if (64 * t + 63 > q0 + 32 * wid) { const int jb = qrel - 64 * t - 4 * hi;
#pragma unroll
                for (int r = 0; r < 16; ++r) { const int j0 = jb - ((r & 3) + 8 * (r >> 2)); if (j0 < 0) p0[r] = -INFINITY; if (j0 - 32 < 0) p1[r] = -INFINITY; } }
            const float rm = rowmax32(p0, p1);
            if (first) { first = false; const float dl = rm; mhat += dl;
#pragma unroll
                for (int r = 0; r < 16; ++r) { p0[r] -= dl; p1[r] -= dl; }
#pragma unroll
                for (int r = 0; r < 16; ++r) negm[r] = -mhat;
            } else if (__any(rm > THR)) { const float dl = __builtin_fmaxf(rm, 0.f); mhat += dl;
#pragma unroll
                for (int r = 0; r < 16; ++r) { p0[r] -= dl; p1[r] -= dl; }
#pragma unroll
                for (int r = 0; r < 16; ++r) negm[r] = -mhat;
                const float f = __builtin_amdgcn_exp2f(-dl); l_reg *= f; if (hi == 0) wsf[r32] = f;
                asm volatile("s_waitcnt lgkmcnt(0)" ::: "memory");
#pragma unroll
                for (int d_ = 0; d_ < 2; ++d_)
#pragma unroll
                    for (int r = 0; r < 16; ++r) o[d_][r] *= wsf[crow(r, hi)];
                asm volatile("s_waitcnt lgkmcnt(0)" ::: "memory");
            }
            float sacc = 0.f;
#pragma unroll
            for (int r = 0; r < 16; ++r) { p0[r] = __builtin_amdgcn_exp2f(p0[r]); p1[r] = __builtin_amdgcn_exp2f(p1[r]); sacc += p0[r] + p1[r]; }
            l_reg += sacc;
            u32x4 pw0, pw1, pw2, pw3;
#define ATT_PKW(P, B) cvtpk_s(P[B], P[B + 1])
            pw0 = (u32x4){ATT_PKW(p0, 0), ATT_PKW(p0, 2), ATT_PKW(p0, 4), ATT_PKW(p0, 6)}; pw1 = (u32x4){ATT_PKW(p0, 8), ATT_PKW(p0, 10), ATT_PKW(p0, 12), ATT_PKW(p0, 14)};
            pw2 = (u32x4){ATT_PKW(p1, 0), ATT_PKW(p1, 2), ATT_PKW(p1, 4), ATT_PKW(p1, 6)}; pw3 = (u32x4){ATT_PKW(p1, 8), ATT_PKW(p1, 10), ATT_PKW(p1, 12), ATT_PKW(p1, 14)};
#undef ATT_PKW
            ATT_SBAR();
            pv(o, vbl + slot * 8192, __builtin_bit_cast(bf16x8, pw0), __builtin_bit_cast(bf16x8, pw1), __builtin_bit_cast(bf16x8, pw2), __builtin_bit_cast(bf16x8, pw3));
        }
        slot = slot == 2 ? 0 : slot + 1;
    }
    { auto rr = __builtin_amdgcn_permlane32_swap(__float_as_uint(l_reg), __float_as_uint(l_reg), false, false); l_reg = __uint_as_float(rr[0]) + __uint_as_float(rr[1]); }
    if (hi == 0) wsf[32 + r32] = l_reg;
    asm volatile("s_waitcnt lgkmcnt(0)" ::: "memory");
    float rli[16];
#pragma unroll
    for (int r = 0; r < 16; ++r) rli[r] = __builtin_amdgcn_rcpf(wsf[32 + crow(r, hi)]);
    if (DIL) { if (hi == 0) lse[ATT_GROW(q0 + wid * 32 + r32) * 8] = mhat + __builtin_amdgcn_logf(l_reg); }
    { bf16* stg = (bf16*)(shm + L::LOST) + wid * 2048;
#pragma unroll
      for (int r = 0; r < 16; ++r) { const int orow = crow(r, hi);
#pragma unroll
        for (int d0 = 0; d0 < 2; ++d0) stg[orow * 64 + d0 * 32 + r32] = (bf16)(cvtpk_s(o[d0][r] * rli[r], 0.f) & 0xffffu); }
      asm volatile("s_waitcnt lgkmcnt(0)" ::: "memory");
#pragma unroll
      for (int i = 0; i < 4; ++i) { const int row = i * 8 + (lane >> 3), ch = lane & 7; const u32x4 v = *(const u32x4*)(stg + row * 64 + ch * 8);
        *(u32x4*)(Ob + ATT_GROW(q0 + wid * 32 + row) * po + ch * 8) = v; } }
    asm volatile("s_waitcnt lgkmcnt(0)\n\ts_barrier" ::: "memory");
#undef ATT_GROW
#undef ATT_ISSUE
}
#undef ATT_SBAR
#undef ATT_WAIT_BAR
}
namespace mla {
using bf16 = unsigned short;
using bf16x8 = __attribute__((ext_vector_type(8))) short;
using s16x4 = __attribute__((ext_vector_type(4))) short;
using f32x16 = __attribute__((ext_vector_type(16))) float;
using u32x4 = __attribute__((ext_vector_type(4))) unsigned;
constexpr int SEQL = 8192, PQ = 1536, PV = 1024, HQ = 96, HV = 64;
constexpr int NW = 8, QBLK = 32, QB = QBLK * NW, KVBLK = 64;
__device__ __forceinline__ int crow(int r, int hi) { return (r & 3) + 8 * (r >> 2) + 4 * hi; }
#define SBAR() __builtin_amdgcn_sched_barrier(0)
__device__ __forceinline__ void cmask(f32x16& p0, f32x16& p1, int jb, int qrel, int hi) {
    const float NEG = -INFINITY; int kb = 64 * jb + 4 * hi;
#pragma unroll
    for (int r = 0; r < 16; ++r) { int kv = kb + (r & 3) + 8 * (r >> 2); if (kv > qrel) p0[r] = NEG; if (kv + 32 > qrel) p1[r] = NEG; }
}
constexpr int NSLOT = 3, KSLOTB = 12288, VSLOTB = 8192;
constexpr int LDS_K = 0, LDS_V = NSLOT * KSLOTB, LDS_WS = LDS_V + NSLOT * VSLOTB, LDS_OST = LDS_WS + NW * 64 * 4, LDS_BYTES = LDS_OST + NW * 4096;
static_assert(LDS_BYTES <= 131072, "mla attention LDS");
__device__ __forceinline__ void glds16(const void* gsrc, unsigned lds_dst) { unsigned keep;
    asm volatile("s_mov_b32 %0, m0\n\ts_mov_b32 m0, %2\n\ts_nop 0\n\tglobal_load_lds_dwordx4 %1, off\n\ts_mov_b32 m0, %0" : "=&s"(keep) : "v"(gsrc), "s"(lds_dst) : "memory"); }
__device__ __forceinline__ float max3f(float a, float b, float c) { float r; asm("v_max3_f32 %0, %1, %2, %3" : "=v"(r) : "v"(a), "v"(b), "v"(c)); return r; }
__device__ __forceinline__ float max2f(float a, float b) { float r; asm("v_max_f32_e32 %0, %1, %2" : "=v"(r) : "v"(a), "v"(b)); return r; }
__device__ __forceinline__ float fadd_s(float a, float b) { float r; asm("v_add_f32_e32 %0, %1, %2" : "=v"(r) : "v"(a), "v"(b)); return r; }
__device__ __forceinline__ float fsub_s(float a, float b) { float r; asm("v_sub_f32_e32 %0, %1, %2" : "=v"(r) : "v"(a), "v"(b)); return r; }
typedef float f32x2_t __attribute__((ext_vector_type(2))); typedef __bf16 bf16x2_t __attribute__((ext_vector_type(2)));
__device__ __forceinline__ unsigned cvtpk_s(float lo, float hi) { f32x2_t v = {lo, hi}; bf16x2_t b = __builtin_convertvector(v, bf16x2_t); return __builtin_bit_cast(unsigned, b); }
#define WAIT_BAR(N) asm volatile("s_waitcnt vmcnt(" #N ") lgkmcnt(0)\n\ts_barrier" ::: "memory")

__device__ __forceinline__ void qkt(f32x16& p0, f32x16& p1, const char* Kslot, const bf16x8* qr, const f32x16& negm, int r32, int hi) {
    const char* kb = Kslot + hi * 1024 + r32 * 16;
#pragma unroll
    for (int d0 = 0; d0 < 6; ++d0) {
        const bf16x8 b0 = *reinterpret_cast<const bf16x8*>(kb + d0 * 2048);
        const bf16x8 b1 = *reinterpret_cast<const bf16x8*>(kb + d0 * 2048 + 512);
        if (d0 == 0) { p0 = __builtin_amdgcn_mfma_f32_32x32x16_bf16(b0, qr[0], negm, 0, 0, 0); p1 = __builtin_amdgcn_mfma_f32_32x32x16_bf16(b1, qr[0], negm, 0, 0, 0); }
        else { p0 = __builtin_amdgcn_mfma_f32_32x32x16_bf16(b0, qr[d0], p0, 0, 0, 0); p1 = __builtin_amdgcn_mfma_f32_32x32x16_bf16(b1, qr[d0], p1, 0, 0, 0); } }
}
typedef __attribute__((address_space(3))) const char* lds_cptr;
typedef short v4i16_t __attribute__((ext_vector_type(4)));
__device__ __forceinline__ void kload12(bf16x8* kf, lds_cptr kp) {
#pragma unroll
    for (int j = 0; j < 6; ++j) { kf[2 * j] = *(const __attribute__((address_space(3))) bf16x8*)(kp + j * 2048); kf[2 * j + 1] = *(const __attribute__((address_space(3))) bf16x8*)(kp + j * 2048 + 512); }
}
__device__ __forceinline__ void kload2(bf16x8* kf, lds_cptr kp, int j) { kf[2 * j] = *(const __attribute__((address_space(3))) bf16x8*)(kp + j * 2048); kf[2 * j + 1] = *(const __attribute__((address_space(3))) bf16x8*)(kp + j * 2048 + 512); }
__device__ __forceinline__ s16x4 vtr(lds_cptr p) { return __builtin_bit_cast(s16x4, __builtin_amdgcn_ds_read_tr16_b64_v4i16((__attribute__((address_space(3))) v4i16_t*)p)); }
__device__ __forceinline__ float rowmax(const f32x16& p0, const f32x16& p1) {
    float a = max3f(p0[0], p0[1], p1[0]), b = max3f(p0[2], p0[3], p1[1]); a = max3f(a, p1[2], p1[3]);
#pragma unroll
    for (int r = 4; r < 16; r += 4) { a = max3f(a, p0[r], p0[r + 1]); b = max3f(b, p0[r + 2], p0[r + 3]); a = max3f(a, p1[r], p1[r + 1]); b = max3f(b, p1[r + 2], p1[r + 3]); }
    const float m = max2f(a, b);
    auto rr = __builtin_amdgcn_permlane32_swap(__float_as_uint(m), __float_as_uint(m), false, false);
    return max2f(__uint_as_float(rr[0]), __uint_as_float(rr[1]));
}
__device__ __forceinline__ void pv(f32x16* o, int vb, bf16x8 pa0, bf16x8 pa1, bf16x8 pa2, bf16x8 pa3) {
#pragma unroll
    for (int d0 = 0; d0 < 2; ++d0) { s16x4 lo[4], hi[4];
#pragma unroll
        for (int ks = 0; ks < 4; ++ks) {
            asm volatile("ds_read_b64_tr_b16 %0,%1 offset:%c2" : "=&v"(lo[ks]) : "v"(vb), "i"(d0 * 4096 + ks * 1024) : "memory");
            asm volatile("ds_read_b64_tr_b16 %0,%1 offset:%c2" : "=&v"(hi[ks]) : "v"(vb), "i"(d0 * 4096 + ks * 1024 + 512) : "memory"); }
        asm volatile("s_waitcnt lgkmcnt(0)" ::: "memory"); SBAR();
#define PK(k) (bf16x8){lo[k][0], lo[k][1], lo[k][2], lo[k][3], hi[k][0], hi[k][1], hi[k][2], hi[k][3]}
        o[d0] = __builtin_amdgcn_mfma_f32_32x32x16_bf16(pa0, PK(0), o[d0], 0, 0, 0);
        o[d0] = __builtin_amdgcn_mfma_f32_32x32x16_bf16(pa1, PK(1), o[d0], 0, 0, 0);
        o[d0] = __builtin_amdgcn_mfma_f32_32x32x16_bf16(pa2, PK(2), o[d0], 0, 0, 0);
        o[d0] = __builtin_amdgcn_mfma_f32_32x32x16_bf16(pa3, PK(3), o[d0], 0, 0, 0);
#undef PK
    }
}

constexpr float OSCALE = 32.0f;
template <int THRL> __device__ __forceinline__ void attn_unit(int b, int h, int qb, const bf16* Q, const bf16* __restrict__ K, const bf16* __restrict__ V, unsigned char* O, char* shm) {
    int tid_ = threadIdx.x; asm volatile("" : "+v"(tid_));
    const int tid = tid_, lane = tid & 63, r32 = lane & 31, hi = lane >> 5; const int wid = __builtin_amdgcn_readfirstlane(tid >> 6);
    const long rowbase = (long)b * SEQL; const int q0 = qb * QB;
    const bf16* Qw = Q + (rowbase + q0 + wid * QBLK) * PQ + h * HQ;
    const bf16* Kh = K + rowbase * PQ + h * HQ; const bf16* Vh = V + rowbase * PV + h * HV;
    const unsigned lds0 = (unsigned)(uintptr_t)shm;
    float* wsf = (float*)(shm + LDS_WS) + wid * 64;
    const bool k2 = wid < 4;
    const bf16* ksrc = Kh + (long)lane * PQ + wid * 8;
    const bf16* vsrc = Vh + (long)(16 * (wid & 3) + (lane >> 2)) * PV + (wid >> 2) * 32 + (lane & 3) * 8;
    const unsigned kdst = lds0 + LDS_K + wid * 1024, vdst = lds0 + LDS_V + wid * 1024;
#define DMA_K(t, slot) do { glds16(ksrc + (long)(t) * KVBLK * PQ, (unsigned)__builtin_amdgcn_readfirstlane(kdst + (slot))); \
        if (k2) glds16(ksrc + (long)(t) * KVBLK * PQ + 64, (unsigned)__builtin_amdgcn_readfirstlane(kdst + (slot) + 8192)); } while (0)
#define DMA_V(t, slot) glds16(vsrc + (long)(t) * KVBLK * PV, (unsigned)__builtin_amdgcn_readfirstlane(vdst + (slot)))
    const int vb0 = (int)(lds0 + LDS_V) + ((lane >> 4) & 1) * 32 + (lane & 3) * 8 + (4 * hi + ((lane & 15) >> 2)) * 64;
    const char* Kbase = shm + LDS_K; bf16x8 kf[12];
    const lds_cptr shm3 = (lds_cptr)shm; const lds_cptr kp0 = shm3 + LDS_K + hi * 1024 + r32 * 16; const lds_cptr vp0 = shm3 + LDS_V + ((lane >> 4) & 1) * 32 + (lane & 3) * 8 + (4 * hi + ((lane & 15) >> 2)) * 64;
    const int NT = (q0 + QB) / KVBLK;
#define WAIT_KV() do { if (k2) WAIT_BAR(3); else WAIT_BAR(2); } while (0)
#define WAIT_KKV() do { if (k2) WAIT_BAR(5); else WAIT_BAR(3); } while (0)
    DMA_K(0, 0); DMA_V(0, 0); DMA_K(1, KSLOTB);
    bf16x8 qr[6];
#pragma unroll
    for (int d0 = 0; d0 < 6; ++d0) qr[d0] = *reinterpret_cast<const bf16x8*>(&Qw[(long)r32 * PQ + d0 * 16 + hi * 8]);
    float mhat = 0.f, l_reg = 0.f; f32x16 o[2]; o[0] = f32x16{}; o[1] = f32x16{}; f32x16 negm = f32x16{}; asm volatile("" : "+v"(negm));
    const int qrel = wid * QBLK + r32;
#define CMASK(P0, P1, t) do { int jb_ = (t) - (NT - 4); if (jb_ >= 0) cmask(P0, P1, jb_, qrel, hi); } while (0)
    bool resc = false;
#define START(P0, P1) do { const float rm = rowmax(P0, P1); resc = false; \
    { const float dl = rm; mhat = fadd_s(mhat, dl); \
      _Pragma("unroll") for (int r = 0; r < 16; ++r) { P0[r] = fsub_s(P0[r], dl); P1[r] = fsub_s(P1[r], dl); } \
      _Pragma("unroll") for (int r = 0; r < 16; ++r) negm[r] = -mhat; asm volatile("" : "+v"(negm)); } \
    _Pragma("unroll") for (int r = 0; r < 16; ++r) P0[r] = __builtin_amdgcn_exp2f(P0[r]); } while (0)
#define RESC() do { if (resc) { asm volatile("s_waitcnt lgkmcnt(0)" ::: "memory"); \
      _Pragma("unroll") for (int d_ = 0; d_ < 2; ++d_) _Pragma("unroll") for (int r = 0; r < 16; ++r) o[d_][r] *= wsf[crow(r, hi)]; } } while (0)
    f32x16 pA0, pA1, pB0, pB1;
    int sl_prev = 0, sl_cur = 0, sl_next = 1;
#define ROT() do { sl_prev = sl_cur; sl_cur = sl_next; sl_next = (sl_next == NSLOT - 1) ? 0 : sl_next + 1; } while (0)
    DMA_K(2, 2 * KSLOTB);
    WAIT_KKV();
    qkt(pA0, pA1, Kbase, qr, negm, r32, hi); asm volatile("s_nop 15\n\ts_nop 7" : "+v"(pA0), "+v"(pA1)); CMASK(pA0, pA1, 0);
    START(pA0, pA1);
#pragma unroll
    for (int r = 0; r < 16; ++r) pA1[r] = __builtin_amdgcn_exp2f(pA1[r]);
    WAIT_BAR(0);
    DMA_K(3, 0); DMA_V(1, VSLOTB);
    ROT();
    kload12(kf, kp0 + sl_cur * KSLOTB);
    WAIT_KV();
    s16x4 vlo[8], vhi[8]; u32x4 pw0, pw1, pw2, pw3;
#define PKW(P, B) cvtpk_s(P[B], P[B + 1])
#define PAF(k) __builtin_bit_cast(bf16x8, pw##k)
#define VFR(i) (bf16x8){vlo[i][0], vlo[i][1], vlo[i][2], vlo[i][3], vhi[i][0], vhi[i][1], vhi[i][2], vhi[i][3]}
#define PIN(x) asm volatile("" : "+v"(x))
#define MX3(a, b, c) __builtin_fmaxf(__builtin_fmaxf((a), (b)), (c))
#define GAPA(MF, A0, A1, A2, A3, W0, W1, PW) do { MF; sacc += A0; sacc += A1; sacc += A2; sacc += A3; PIN(sacc); W0; W1; PIN(PW); SBAR(); } while (0)
#define GAPM(MF) do { MF; SBAR(); } while (0)
#define EX(v) __builtin_amdgcn_exp2f(v)
#define GAPB(MF, X, B) do { MF; X[B] = EX(X[B]); X[B + 1] = EX(X[B + 1]); X[B + 2] = EX(X[B + 2]); X[B + 3] = EX(X[B + 3]); PIN(X); SBAR(); } while (0)
#define VRD(i) do { vlo[i] = vtr(vp_ + (((i) >> 2) * 4096 + ((i) & 3) * 1024)); vhi[i] = vtr(vp_ + (((i) >> 2) * 4096 + ((i) & 3) * 1024 + 512)); } while (0)
#define KRD(G, j) do { if (G) { kload2(kf, kp0 + sl_next * KSLOTB, j); SBAR(); } } while (0)
#define MF32(a, b, c) __builtin_amdgcn_mfma_f32_32x32x16_bf16(a, b, c, 0, 0, 0)
#define STEP(C0, C1, P0, P1, t, GK, GV, GL) do { SBAR(); \
    const lds_cptr vp_ = vp0 + sl_prev * VSLOTB; \
    float sacc = (P0[0] + P0[1]); \
    GAPA(C0 = MF32(kf[0], qr[0], negm), P0[2], P0[3], P0[4], P0[5],     pw0[0] = PKW(P0, 0), pw0[1] = PKW(P0, 2), pw0); \
    GAPA(C1 = MF32(kf[1], qr[0], negm), P0[6], P0[7], P0[8], P0[9],     pw0[2] = PKW(P0, 4), pw0[3] = PKW(P0, 6), pw0); \
    GAPA(C0 = MF32(kf[2], qr[1], C0),   P0[10], P0[11], P0[12], P0[13], pw1[0] = PKW(P0, 8), pw1[1] = PKW(P0, 10), pw1); \
    GAPA(C1 = MF32(kf[3], qr[1], C1),   P0[14], P0[15], P1[0], P1[1],   pw1[2] = PKW(P0, 12), pw1[3] = PKW(P0, 14), pw1); \
    VRD(0); SBAR(); GAPA(C0 = MF32(kf[4], qr[2], C0),   P1[2], P1[3], P1[4], P1[5],     pw2[0] = PKW(P1, 0), pw2[1] = PKW(P1, 2), pw2); \
    VRD(4); SBAR(); GAPA(C1 = MF32(kf[5], qr[2], C1),   P1[6], P1[7], P1[8], P1[9],     pw2[2] = PKW(P1, 4), pw2[3] = PKW(P1, 6), pw2); \
    VRD(1); SBAR(); GAPA(C0 = MF32(kf[6], qr[3], C0),   P1[10], P1[11], P1[12], P1[13], pw3[0] = PKW(P1, 8), pw3[1] = PKW(P1, 10), pw3); \
    VRD(5); SBAR(); GAPA(C1 = MF32(kf[7], qr[3], C1),   P1[14], P1[15], 0.f, 0.f,       pw3[2] = PKW(P1, 12), pw3[3] = PKW(P1, 14), pw3); \
    VRD(2); SBAR(); GAPM(C0 = MF32(kf[8], qr[4], C0)); VRD(6); SBAR(); GAPM(C1 = MF32(kf[9], qr[4], C1)); \
    VRD(3); SBAR(); GAPM(C0 = MF32(kf[10], qr[5], C0)); VRD(7); SBAR(); GAPM(C1 = MF32(kf[11], qr[5], C1)); \
    l_reg += sacc; \
    if (GK) { DMA_K((t) + 3, sl_cur * KSLOTB); } if (GV) { DMA_V((t) + 1, sl_next * VSLOTB); } \
    CMASK(C0, C1, t); \
    { float a = MX3(C0[0], C0[1], C1[0]), b = MX3(C0[2], C0[3], C1[1]); a = MX3(a, C1[2], C1[3]); \
      _Pragma("unroll") for (int r = 4; r < 16; r += 4) { a = MX3(a, C0[r], C0[r + 1]); b = MX3(b, C0[r + 2], C0[r + 3]); a = MX3(a, C1[r], C1[r + 1]); b = MX3(b, C1[r + 2], C1[r + 3]); } \
      float rm = __builtin_fmaxf(a, b); { auto rr = __builtin_amdgcn_permlane32_swap(__float_as_uint(rm), __float_as_uint(rm), false, false); rm = __builtin_fmaxf(__uint_as_float(rr[0]), __uint_as_float(rr[1])); } \
      resc = false; \
      if (__builtin_expect(__any(rm > (float)THRL), 0)) { const float dl = __builtin_fmaxf(rm, 0.f); mhat += dl; \
        _Pragma("unroll") for (int r = 0; r < 16; ++r) { C0[r] -= dl; C1[r] -= dl; } \
        _Pragma("unroll") for (int r = 0; r < 16; ++r) negm[r] = -mhat; asm volatile("" : "+v"(negm)); \
        const float f = __builtin_amdgcn_exp2f(-dl); l_reg *= f; if (hi == 0) wsf[r32] = f; resc = true; } } \
    SBAR(); \
    GAPB(o[0] = MF32(PAF(0), VFR(0), o[0]), C0, 0); \
    KRD(GL, 0); GAPB(o[1] = MF32(PAF(0), VFR(4), o[1]), C0, 4); \
    KRD(GL, 1); GAPB(o[0] = MF32(PAF(1), VFR(1), o[0]), C0, 8); \
    KRD(GL, 2); GAPB(o[1] = MF32(PAF(1), VFR(5), o[1]), C0, 12); \
    KRD(GL, 3); GAPB(o[0] = MF32(PAF(2), VFR(2), o[0]), C1, 0); \
    KRD(GL, 4); GAPB(o[1] = MF32(PAF(2), VFR(6), o[1]), C1, 4); \
    KRD(GL, 5); GAPB(o[0] = MF32(PAF(3), VFR(3), o[0]), C1, 8); \
    GAPB(o[1] = MF32(PAF(3), VFR(7), o[1]), C1, 12); \
    } while (0)
    int t = 1;
#undef CMASK
#define CMASK(P0, P1, t) do { } while (0)
    for (; t + 5 < NT; t += 2) {
        STEP(pB0, pB1, pA0, pA1, t, true, true, true);     WAIT_KV(); RESC(); ROT();
        STEP(pA0, pA1, pB0, pB1, t + 1, true, true, true); WAIT_KV(); RESC(); ROT();
    }
#undef CMASK
#define CMASK(P0, P1, t) do { int jb_ = (t) - (NT - 4); if (jb_ >= 0) cmask(P0, P1, jb_, qrel, hi); } while (0)
#define ENDW(tt) do { if ((tt) + 3 < NT) { WAIT_KV(); } else if ((tt) + 2 < NT) { WAIT_BAR(1); } else { WAIT_BAR(0); } } while (0)
    for (; t + 1 < NT; t += 2) {
        STEP(pB0, pB1, pA0, pA1, t, (t + 3 < NT), (t + 1 < NT), (t + 1 < NT));         ENDW(t);     RESC(); ROT();
        STEP(pA0, pA1, pB0, pB1, t + 1, (t + 4 < NT), (t + 2 < NT), (t + 2 < NT));     ENDW(t + 1); RESC(); ROT();
    }
    STEP(pB0, pB1, pA0, pA1, NT - 1, false, false, false); RESC();
    { float sacc = pB0[0] + pB0[1];
#pragma unroll
      for (int r = 2; r < 16; ++r) sacc += pB0[r];
#pragma unroll
      for (int r = 0; r < 16; ++r) sacc += pB1[r];
      l_reg += sacc;
      pw0 = (u32x4){PKW(pB0, 0), PKW(pB0, 2), PKW(pB0, 4), PKW(pB0, 6)}; pw1 = (u32x4){PKW(pB0, 8), PKW(pB0, 10), PKW(pB0, 12), PKW(pB0, 14)}; pw2 = (u32x4){PKW(pB1, 0), PKW(pB1, 2), PKW(pB1, 4), PKW(pB1, 6)}; pw3 = (u32x4){PKW(pB1, 8), PKW(pB1, 10), PKW(pB1, 12), PKW(pB1, 14)};
      SBAR(); pv(o, vb0 + sl_cur * VSLOTB, PAF(0), PAF(1), PAF(2), PAF(3)); }
#undef PKW
#undef PAF
#undef VFR
#undef PIN
#undef MX3
#undef GAPA
#undef GAPM
#undef GAPB
#undef EX
#undef VRD
#undef KRD
#undef MF32
#undef STEP
#undef ENDW
    { auto rr = __builtin_amdgcn_permlane32_swap(__float_as_uint(l_reg), __float_as_uint(l_reg), false, false); l_reg = __uint_as_float(rr[0]) + __uint_as_float(rr[1]); }
    if (hi == 0) wsf[32 + r32] = l_reg; asm volatile("s_waitcnt lgkmcnt(0)" ::: "memory");
    float rli[16];
#pragma unroll
    for (int r = 0; r < 16; ++r) rli[r] = __builtin_amdgcn_rcpf(wsf[32 + crow(r, hi)]);
    unsigned char* Ow = O + (rowbase + q0 + wid * QBLK) * PV + h * HV;
    { unsigned char* stg = (unsigned char*)(shm + LDS_OST) + wid * 2048;
#pragma unroll
      for (int r = 0; r < 16; ++r) { const int orow = crow(r, hi); const float sc = rli[r] * OSCALE;
        const float a = __builtin_fminf(__builtin_fmaxf(o[0][r] * sc, -448.f), 448.f), c = __builtin_fminf(__builtin_fmaxf(o[1][r] * sc, -448.f), 448.f);
        const unsigned w = (unsigned)__builtin_amdgcn_cvt_pk_fp8_f32(a, c, 0, false);
        stg[orow * 64 + r32] = (unsigned char)(w & 0xffu); stg[orow * 64 + 32 + r32] = (unsigned char)((w >> 8) & 0xffu); }
      asm volatile("s_waitcnt lgkmcnt(0)" ::: "memory");
#pragma unroll
      for (int i = 0; i < 2; ++i) { const int row = i * 16 + (lane >> 2), ch = lane & 3; const u32x4 v = *(const u32x4*)(stg + row * 64 + ch * 16); *(u32x4*)(Ow + (long)row * PV + ch * 16) = v; } }
    asm volatile("s_waitcnt lgkmcnt(0)\n\ts_barrier" ::: "memory");
#undef DMA_K
#undef DMA_V
#undef CMASK
#undef START
#undef RESC
#undef ROT
#undef WAIT_KV
#undef WAIT_KKV
}
#undef SBAR
#undef WAIT_BAR
}
namespace dila {
using bf16 = unsigned short;
using bf16x8 = __attribute__((ext_vector_type(8))) short;
using f32x16 = __attribute__((ext_vector_type(16))) float;
using u32x4 = __attribute__((ext_vector_type(4))) unsigned;
constexpr int NW = 8, SEQL = 8192, PQ = 1536, PKV = 3072, PO = 512, MROWS = 4 * SEQL;
constexpr int L_K = 0, L_V = 6 * 8192, L_WQ = 12 * 8192, L_WO = L_WQ + NW * 4096, L_WSF = L_WO + NW * 2048, L_BIAS = L_WSF + NW * 256, L_END = L_BIAS + 3 * 288 * 4;
constexpr float THR = 8.0f;
#define DIL_WAIT_BAR(N) asm volatile("s_waitcnt vmcnt(" #N ") lgkmcnt(0)\n\ts_barrier" ::: "memory")
struct UnitP { int sb, oo, lo, rowbase, dil, q0, g; };
__device__ __forceinline__ UnitP decode(int j, int h) {
    const int x = j & 31, bg = j >> 5; const int g = bg % 3, b = bg / 3;
    const int sh = 2 * g, dil = 1 << sh; const int r = x & (dil - 1), qb = x >> sh;
    UnitP p; p.sb = g * 262144 + ((b * dil + r) * 8 + h) * (SEQL >> sh); p.oo = g * MROWS * PO + h * 64; p.lo = g * MROWS * 8 + h;
    p.rowbase = b * SEQL + r; p.dil = dil; p.q0 = qb * 256; p.g = g; return p;
}

__device__ __forceinline__ void dil_phase(const bf16* QB, const bf16* KV, bf16* OG, float* LSE, const float* BT, char* shm, int G) {
    int tid_ = threadIdx.x; asm volatile("" : "+v"(tid_));
    const int tid = tid_, lane = tid & 63, r32 = lane & 31, hi = lane >> 5; const int wid = __builtin_amdgcn_readfirstlane(tid >> 6);
    const unsigned lds0 = (unsigned)(uintptr_t)shm;
    float* wsf = (float*)(shm + L_WSF) + wid * 64;
    char* wq = shm + L_WQ + wid * 4096;
    char* wo = shm + L_WO + wid * 2048;
    const int wt0 = wid >> 1, wt1 = 2 + (wid >> 1);
    const int G8 = G & ~7, c = (int)blockIdx.x;
    if (c >= G8) return;
    const int h = c & 7, j0 = c >> 3, jstep = G8 >> 3;
    const int NU = (384 - j0 + jstep - 1) / jstep;
    for (int i = tid; i < 3 * 288; i += NW * 64) ((float*)(shm + L_BIAS))[i] = BT[((i / 288) * 8 + h) * 288 + (i % 288)];
#define DIL_GROW(P, pos) ((long)((P).rowbase + (pos) * (P).dil))
#define DIL_ISSUE_TILE(P, t) do { int kp_ = (P).q0 - 128 + 64 * (t); if (kp_ < 0) kp_ = 0; \
        att::glds16(KV + (size_t)((P).sb + kp_ + lane) * 128 + wid * 8, (unsigned)__builtin_amdgcn_readfirstlane(lds0 + L_K + (t) * 8192 + wid * 1024)); \
        att::glds16(KV + (size_t)((P).sb + kp_ + 16 * (wid & 3) + (lane >> 2)) * 128 + 64 + (wid >> 2) * 32 + (lane & 3) * 8, (unsigned)__builtin_amdgcn_readfirstlane(lds0 + L_V + (t) * 8192 + wid * 1024)); } while (0)
#define DIL_ISSUE_Q(P) do { _Pragma("unroll") for (int j_ = 0; j_ < 4; ++j_) \
        att::glds16(QB + (size_t)((P).sb + (P).q0 + wid * 32 + 8 * j_ + (lane >> 3)) * 64 + (lane & 7) * 8, (unsigned)__builtin_amdgcn_readfirstlane(lds0 + L_WQ + wid * 4096 + j_ * 1024)); } while (0)
    if (NU <= 0) return;
    UnitP cur = decode(j0, h), nxt = cur;
    asm volatile("s_waitcnt vmcnt(0) lgkmcnt(0)\n\ts_barrier" ::: "memory");
    DIL_ISSUE_Q(cur); DIL_ISSUE_TILE(cur, 0); DIL_ISSUE_TILE(cur, 5); DIL_ISSUE_TILE(cur, 1); DIL_ISSUE_TILE(cur, 4);
    bf16x8 qr[4]; float mhat = 0.f, l_reg = 0.f; f32x16 o[2]; o[0] = f32x16{}; o[1] = f32x16{}; f32x16 negm = f32x16{}; bool first = true;
    const int vbl = (int)(lds0 + L_V) + ((lane >> 4) & 1) * 32 + (lane & 3) * 8 + (4 * hi + ((lane & 15) >> 2)) * 64;
    for (int ui = 0; ui < NU; ++ui) {
        const bool has_next = ui + 1 < NU;
        if (has_next) nxt = decode(j0 + (ui + 1) * jstep, h);
        const int tb = cur.q0 == 0 ? 2 : 0;
        const float* bl0 = (const float*)(shm + L_BIAS) + cur.g * 288 + (191 - (128 + 32 * (wid & 1) + r32 - 4 * hi));
#pragma unroll 1
        for (int k = 0; k < 3; ++k) {
            if (k == 0 && ui > 0) DIL_WAIT_BAR(5); else if (k < 2) DIL_WAIT_BAR(0); else DIL_WAIT_BAR(8);
            if (k == 0) { DIL_ISSUE_TILE(cur, 2); DIL_ISSUE_TILE(cur, 3); }
            else if (has_next) { if (k == 1) { DIL_ISSUE_Q(nxt); DIL_ISSUE_TILE(nxt, 0); DIL_ISSUE_TILE(nxt, 5); } else { DIL_ISSUE_TILE(nxt, 1); DIL_ISSUE_TILE(nxt, 4); } }
            const int t = wid < 4 ? wt0 + k : wt1 - k;
            if (k == 0) {
#pragma unroll
                for (int d0 = 0; d0 < 4; ++d0) qr[d0] = *reinterpret_cast<const bf16x8*>(wq + r32 * 128 + d0 * 32 + hi * 16);
                mhat = 0.f; l_reg = 0.f; o[0] = f32x16{}; o[1] = f32x16{}; negm = f32x16{}; first = true;
            }
            if (t >= tb) {
                f32x16 p0, p1;
                { const char* kb = shm + L_K + t * 8192 + hi * 1024 + r32 * 16;
#pragma unroll
                  for (int d0 = 0; d0 < 4; ++d0) {
                    const bf16x8 b0 = *reinterpret_cast<const bf16x8*>(kb + d0 * 2048);
                    const bf16x8 b1 = *reinterpret_cast<const bf16x8*>(kb + d0 * 2048 + 512);
                    if (d0 == 0) { p0 = __builtin_amdgcn_mfma_f32_32x32x16_bf16(b0, qr[0], negm, 0, 0, 0); p1 = __builtin_amdgcn_mfma_f32_32x32x16_bf16(b1, qr[0], negm, 0, 0, 0); }
                    else { p0 = __builtin_amdgcn_mfma_f32_32x32x16_bf16(b0, qr[d0], p0, 0, 0, 0); p1 = __builtin_amdgcn_mfma_f32_32x32x16_bf16(b1, qr[d0], p1, 0, 0, 0); } } }
                { const float* bl = bl0 + 64 * (t - wt0);
                  float bv0[16], bv1[16];
#pragma unroll
                  for (int r = 0; r < 16; ++r) { bv0[r] = bl[(r & 3) + 8 * (r >> 2)]; bv1[r] = bl[(r & 3) + 8 * (r >> 2) + 32]; }
#pragma unroll
                  for (int r = 0; r < 16; ++r) { p0[r] += bv0[r]; p1[r] += bv1[r]; } }
                const float rm = att::rowmax32(p0, p1);
                if (first) { first = false; const float dl = rm; mhat += dl;
#pragma unroll
                    for (int r = 0; r < 16; ++r) { p0[r] -= dl; p1[r] -= dl; }
#pragma unroll
                    for (int r = 0; r < 16; ++r) negm[r] = -mhat;
                } else if (__any(rm > THR)) { const float dl = __builtin_fmaxf(rm, 0.f); mhat += dl;
#pragma unroll
                    for (int r = 0; r < 16; ++r) { p0[r] -= dl; p1[r] -= dl; }
#pragma unroll
                    for (int r = 0; r < 16; ++r) negm[r] = -mhat;
                    const float f = __builtin_amdgcn_exp2f(-dl); l_reg *= f; if (hi == 0) wsf[r32] = f;
                    asm volatile("s_waitcnt lgkmcnt(0)" ::: "memory");
#pragma unroll
                    for (int d_ = 0; d_ < 2; ++d_)
#pragma unroll
                        for (int r = 0; r < 16; ++r) o[d_][r] *= wsf[att::crow(r, hi)];
                    asm volatile("s_waitcnt lgkmcnt(0)" ::: "memory");
                }
                float sacc = 0.f;
#pragma unroll
                for (int r = 0; r < 16; ++r) { p0[r] = __builtin_amdgcn_exp2f(p0[r]); p1[r] = __builtin_amdgcn_exp2f(p1[r]); sacc += p0[r] + p1[r]; }
                l_reg += sacc;
                u32x4 pw0, pw1, pw2, pw3;
#define DIL_PKW(P, B) att::cvtpk_s(P[B], P[B + 1])
                pw0 = (u32x4){DIL_PKW(p0, 0), DIL_PKW(p0, 2), DIL_PKW(p0, 4), DIL_PKW(p0, 6)}; pw1 = (u32x4){DIL_PKW(p0, 8), DIL_PKW(p0, 10), DIL_PKW(p0, 12), DIL_PKW(p0, 14)};
                pw2 = (u32x4){DIL_PKW(p1, 0), DIL_PKW(p1, 2), DIL_PKW(p1, 4), DIL_PKW(p1, 6)}; pw3 = (u32x4){DIL_PKW(p1, 8), DIL_PKW(p1, 10), DIL_PKW(p1, 12), DIL_PKW(p1, 14)};
#undef DIL_PKW
                __builtin_amdgcn_sched_barrier(0);
                att::pv(o, vbl + t * 8192, __builtin_bit_cast(bf16x8, pw0), __builtin_bit_cast(bf16x8, pw1), __builtin_bit_cast(bf16x8, pw2), __builtin_bit_cast(bf16x8, pw3));
            }
            if (k == 2) {
                { auto rr = __builtin_amdgcn_permlane32_swap(__float_as_uint(l_reg), __float_as_uint(l_reg), false, false); l_reg = __uint_as_float(rr[0]) + __uint_as_float(rr[1]); }
                if (hi == 0) wsf[32 + r32] = l_reg;
                asm volatile("s_waitcnt lgkmcnt(0)" ::: "memory");
                float rli[16];
#pragma unroll
                for (int r = 0; r < 16; ++r) rli[r] = __builtin_amdgcn_rcpf(wsf[32 + att::crow(r, hi)]);
                if (hi == 0) LSE[cur.lo + DIL_GROW(cur, cur.q0 + wid * 32 + r32) * 8] = mhat + __builtin_amdgcn_logf(l_reg);
                bf16* stg = (bf16*)wo;
#pragma unroll
                for (int d0 = 0; d0 < 2; ++d0) {
#pragma unroll
                    for (int r = 0; r < 16; ++r) stg[att::crow(r, hi) * 32 + r32] = (bf16)(att::cvtpk_s(o[d0][r] * rli[r], 0.f) & 0xffffu);
                    asm volatile("s_waitcnt lgkmcnt(0)" ::: "memory");
#pragma unroll
                    for (int i = 0; i < 2; ++i) { const int row = i * 16 + (lane >> 2), ch = lane & 3; const u32x4 v = *(const u32x4*)(stg + row * 32 + ch * 8);
                        *(u32x4*)(OG + cur.oo + DIL_GROW(cur, cur.q0 + wid * 32 + row) * PO + d0 * 32 + ch * 8) = v; }
                    asm volatile("s_waitcnt lgkmcnt(0)" ::: "memory"); }
            }
        }
        cur = nxt;
    }
    asm volatile("s_waitcnt vmcnt(0) lgkmcnt(0)\n\ts_barrier" ::: "memory");
#undef DIL_GROW
#undef DIL_ISSUE_TILE
#undef DIL_ISSUE_Q
}
#undef DIL_WAIT_BAR
}
constexpr int NWAVES = 8;
constexpr int BATCH = 4, SEQ = 8192, D = 1024, M = BATCH * SEQ;
constexpr int QRP = 512;
constexpr int MLA_H = 16, QRANK = 384, KVRANK = 256, LATN = 672, LATP = 768, QUP = 1536, KVUP = 2048;
constexpr int DFF = 2816, NEXP = 8, DILQ = 1536, DILKV = 3072, DILOUT = 512;
constexpr int MAXSLOT = 67584;
constexpr float EPS = 1e-6f;
constexpr float C2_MLA = 0.1472444460259031f;
constexpr float C2_DIL = 0.18033688011112042f;
constexpr float LOG2E_F = 1.4426950408889634f;

constexpr size_t MiB = 1u << 20;
constexpr size_t WS_CTL = 0, CTL_ZERO_BYTES = 64 * 1024;
constexpr size_t WS_XSQ = 256 * 1024, WS_XSKVN = 384 * 1024;
constexpr size_t WS_MODV = 1 * MiB;
constexpr size_t WS_BIAS = 1 * MiB + 256 * 1024;
constexpr size_t WS_ROUTE = 1 * MiB + 512 * 1024;
constexpr size_t WS_CNT = 2 * MiB;
constexpr size_t WS_LIST = 2 * MiB + 256 * 1024;
constexpr size_t WS_SLOTG = 2 * MiB + 768 * 1024;
constexpr size_t WS_TOKSLOT = 3 * MiB + 256 * 1024;
constexpr size_t WS_TILEEXP = 3 * MiB + 512 * 1024;
constexpr size_t WS_SLOTXS = 3 * MiB + 516 * 1024;
constexpr size_t WS_CS = 4 * MiB;
constexpr size_t WS_LSE = 8 * MiB;
constexpr size_t WS_SB = 11 * MiB;
constexpr size_t SB_LAT = 0, SB_FGU = 768, SB_KVB = 768 + 5632, SB_QB = SB_KVB + 3072, SB_EGU = SB_QB + 1536, SB_FDN = SB_EGU + 8 * 5632, SB_EDN = SB_FDN + 1024, SB_OUT = SB_EDN + 8 * 1024, SB_OB = SB_OUT + 1024, SB_QUP = SB_OB + 1024, SB_KVUP = SB_QUP + 1536, SB_END = SB_KVUP + 2048;
constexpr size_t WS_XS = 11 * MiB + 512 * 1024, WS_XSKV = 11 * MiB + 768 * 1024;
constexpr size_t WS_WEGU = 12 * MiB, WS_WEDN = 100 * MiB, WS_WFGU = 144 * MiB, WS_WFDN = 155 * MiB, WS_WKVB = 161 * MiB, WS_WQB = 167 * MiB, WS_WOUT = 170 * MiB,
                 WS_WOB = 172 * MiB, WS_WMLAIN = 173 * MiB, WS_WQUP = 175 * MiB, WS_WKVUP = 177 * MiB;
constexpr size_t WS_ARENA = 180 * MiB;
constexpr size_t A_XN = WS_ARENA, A_LAT = WS_ARENA + 64 * MiB, A_QN = WS_ARENA + 112 * MiB, A_KVN = WS_ARENA + 136 * MiB, A_Q = WS_ARENA + 152 * MiB, A_K = WS_ARENA + 248 * MiB,
                 A_V = WS_ARENA + 344 * MiB, A_O = WS_ARENA + 408 * MiB, A_HID = WS_ARENA + 64 * MiB, A_XNKV = WS_ARENA + 64 * MiB, A_KVB = WS_ARENA + 128 * MiB, A_QB = WS_ARENA + 320 * MiB,
                 A_OG = WS_ARENA, A_OD = WS_ARENA + 128 * MiB, A_HIDS = WS_ARENA + 160 * MiB, A_Y = WS_ARENA;
constexpr size_t WS_END = WS_ARENA + 523 * MiB;
static_assert(A_HIDS + (size_t)MAXSLOT * DFF * 2 <= WS_END && A_Y + (size_t)MAXSLOT * D * 2 <= A_HIDS && A_O + (size_t)M * D * 2 <= WS_END, "arena map");
static_assert(WS_WEGU + (size_t)NEXP * 2 * DFF * D * 2 <= WS_WEDN && WS_WEDN + (size_t)NEXP * D * DFF * 2 <= WS_WFGU && WS_WFGU + (size_t)2 * DFF * D * 2 <= WS_WFDN && WS_WFDN + (size_t)D * DFF * 2 <= WS_WKVB, "weight map");
enum ModKind { MK_A_MIX0 = 0, MK_B_MIX0, MK_G_MIX0, MK_A_FFN0, MK_B_FFN0, MK_G_FFN0, MK_A_MIX1, MK_B_MIX1, MK_G_MIX1, MK_A_FFN1, MK_B_FFN1, MK_G_FFN1, MK_A_KV, MK_B_KV };
constexpr int CW_BAR = 4096;
constexpr int CW_RANK = 8192;

constexpr int RING_BYTES = 131072;
constexpr int LDS_BYTES = 163840;
constexpr int LDSCTL_OFF = LDS_BYTES - 1024, MISC_OFF = LDSCTL_OFF + 320;

#define GAS __attribute__((address_space(1)))
#define LAS __attribute__((address_space(3)))
typedef unsigned short bf16;
typedef signed char i8;
typedef unsigned v4u __attribute__((ext_vector_type(4)));
typedef unsigned v2u __attribute__((ext_vector_type(2)));
typedef float f32x4 __attribute__((ext_vector_type(4)));
typedef GAS unsigned gu32;
#define RLX_AGENT __ATOMIC_RELAXED, __HIP_MEMORY_SCOPE_AGENT
#define LDS_WAIT() asm volatile("s_waitcnt lgkmcnt(0)" ::: "memory")
#define VM_WAIT() asm volatile("s_waitcnt vmcnt(0)" ::: "memory")
__device__ __forceinline__ unsigned f2bf(float f) { unsigned u = __builtin_bit_cast(unsigned, f); return (u + 0x7fffu + ((u >> 16) & 1u)) >> 16; }
__device__ __forceinline__ unsigned pk2(float lo, float hi) { return f2bf(lo) | (f2bf(hi) << 16); }
__device__ __forceinline__ float bf_lo(unsigned w) { return __builtin_bit_cast(float, w << 16); }
__device__ __forceinline__ float bf_hi(unsigned w) { return __builtin_bit_cast(float, w & 0xffff0000u); }
__device__ __forceinline__ float wave_sum(float v) {
#pragma unroll
    for (int o = 1; o < 64; o <<= 1) v += __shfl_xor(v, o);
    return v;
}

#define XB_TMO      128
#define XB_XCNT(j)  (256  + 64 * (j))
#define XB_XSUB(j)  (1280 + 64 * (j))
#define XB_XGEN(j)  (2304 + 64 * (j))
#define XB_TOP      3328
#define XB_TOPGEN   3392
#define XCD_BAR_WORDS 3456
#define XB_SPIN_CAP (1u << 18)
__device__ __forceinline__ unsigned xb_ld(unsigned* p)              { return __hip_atomic_load(p, __ATOMIC_RELAXED, __HIP_MEMORY_SCOPE_AGENT); }
__device__ __forceinline__ unsigned xb_add(unsigned* p, unsigned v) { return __hip_atomic_fetch_add(p, v, __ATOMIC_RELAXED, __HIP_MEMORY_SCOPE_AGENT); }
__device__ __forceinline__ unsigned xb_xcc_id() { return (unsigned)__builtin_amdgcn_s_getreg((3 << 11) | 20) & 0xFu; }
#define XB_SPIN(cond, bar) do { unsigned _sp = 0; while (cond) { __builtin_amdgcn_s_sleep(1); \
    if ((++_sp & 255u) == 0u) { if (xb_ld(&(bar)[XB_TMO])) break; if (_sp > XB_SPIN_CAP) { atomicAdd(&(bar)[XB_TMO], 1u); break; } } } } while (0)
struct XcdBarrier { unsigned* bar; unsigned x; volatile LAS unsigned* st; };
__device__ __forceinline__ XcdBarrier xcd_barrier_post(unsigned* bar, volatile LAS unsigned* st) {
    XcdBarrier b; b.bar = bar; b.x = xb_xcc_id(); b.st = st;
    if (threadIdx.x == 0) (void)xb_add(&bar[XB_XCNT(b.x)], 1u);
    return b;
}
__device__ __forceinline__ void xcd_barrier_complete(unsigned* bar, unsigned x, unsigned& nloc, unsigned& nx) {
    const unsigned G = gridDim.x * gridDim.y * gridDim.z;
    unsigned sum, cnt, mine, sp = 0u;
    for (;;) {
        sum = 0u; cnt = 0u; mine = 0u;
#pragma unroll
        for (unsigned j = 0; j < 16; ++j) { const unsigned c = xb_ld(&bar[XB_XCNT(j)]); sum += c; cnt += (c > 0u) ? 1u : 0u; mine = (j == x) ? c : mine; }
        if (sum == G) break;
        __builtin_amdgcn_s_sleep(1);
        if ((++sp & 255u) == 0u) { if (xb_ld(&bar[XB_TMO])) break; if (sp > XB_SPIN_CAP) { atomicAdd(&bar[XB_TMO], 1u); break; } }
    }
    nloc = mine > 0u ? mine : 1u; nx = cnt > 0u ? cnt : 1u;
}
__device__ __forceinline__ void xcd_barrier(const XcdBarrier& b) {
    asm volatile("s_waitcnt vmcnt(0)" ::: "memory");
    __syncthreads();
    if (threadIdx.x == 0) {
        unsigned* bar = b.bar;
        __builtin_amdgcn_s_waitcnt(0);
        unsigned nloc = b.st[0], nx = b.st[1];
        if (nloc == 0u) { xcd_barrier_complete(bar, b.x, nloc, nx); b.st[0] = nloc; b.st[1] = nx; }
        const unsigned old = xb_add(&bar[XB_XSUB(b.x)], 1u);
        const unsigned gen = old / nloc;
        if (old + 1u == (gen + 1u) * nloc) {
            __builtin_amdgcn_fence(__ATOMIC_RELEASE, "agent");
            asm volatile("s_waitcnt vmcnt(0)" ::: "memory");
            const unsigned og = xb_add(&bar[XB_TOP], 1u);
            const unsigned tg = og / nx;
            if (og + 1u == (tg + 1u) * nx) xb_add(&bar[XB_TOPGEN], 1u);
            else XB_SPIN(xb_ld(&bar[XB_TOPGEN]) == tg, bar);
            __builtin_amdgcn_fence(__ATOMIC_ACQUIRE, "agent");
            xb_add(&bar[XB_XGEN(b.x)], 1u);
            asm volatile("s_waitcnt vmcnt(0)" ::: "memory");
        } else {
            XB_SPIN(xb_ld(&bar[XB_XGEN(b.x)]) == gen, bar);
            __builtin_amdgcn_fence(__ATOMIC_ACQUIRE, "agent");
            asm volatile("s_waitcnt vmcnt(0)" ::: "memory");
        }
    }
    __syncthreads();
}

struct Frame {
    LAS unsigned char* lds;
    volatile LAS unsigned* MISC;
    int tid, lane, wave;
    int vcu, G;
    unsigned char* ws;
    const float* in[26];
    float* out;
};
enum { MAP_PLAIN = 0, MAP_MLAIN = 1, MAP_QUP = 2, MAP_GU = 3 };
template <int MAP> __device__ __forceinline__ int dmap(int n) {
    if (MAP == MAP_MLAIN) { if (n < 640) return n; if (n < 656) return 640 + 2 * (n - 640); return 640 + 2 * (n - 656) + 1; }
    if (MAP == MAP_QUP) { const int h = n / 96, j = n % 96; if (j < 64) return n; if (j < 80) return h * 96 + 64 + 2 * (j - 64); return h * 96 + 64 + 2 * (j - 80) + 1; }
    if (MAP == MAP_GU) { const int up = n >= DFF ? 1 : 0; const int c = up ? n - DFF : n; return (c >> 7) * 256 + up * 128 + (c & 127); }
    return n;
}
template <int MAP> __device__ __forceinline__ void transpose_item(const float* W, int K, int N, bf16* WT, const float* ks, LAS float* scr, int item, int lane) {
    const int nblk = N / 32, kb = item / nblk, nb = item % nblk, k0 = 64 * kb, n0 = 32 * nb;
    float v[32];
    const float* src = W + (size_t)(k0 + (lane >> 5)) * N + n0 + (lane & 31);
#pragma unroll
    for (int i = 0; i < 32; ++i) v[i] = __builtin_nontemporal_load(src + (size_t)(2 * i) * N);
    if (ks) {
#pragma unroll
        for (int i = 0; i < 32; ++i) v[i] *= ks[k0 + 2 * i + (lane >> 5)]; }
#pragma unroll
    for (int i = 0; i < 32; ++i) scr[(2 * i + (lane >> 5)) * 33 + (lane & 31)] = v[i];
    LDS_WAIT(); asm volatile("" ::: "memory");
    const int c = lane & 7;
#pragma unroll
    for (int j = 0; j < 4; ++j) { const int n = (lane >> 3) + 8 * j; const LAS float* s = scr + (8 * c) * 33 + n;
        v4u o; o.x = pk2(s[0 * 33], s[1 * 33]); o.y = pk2(s[2 * 33], s[3 * 33]); o.z = pk2(s[4 * 33], s[5 * 33]); o.w = pk2(s[6 * 33], s[7 * 33]);
        *(GAS v4u*)(WT + (size_t)dmap<MAP>(n0 + n) * K + k0 + 8 * c) = o; }
    LDS_WAIT(); asm volatile("" ::: "memory");
}
__device__ __forceinline__ float wave_max(float v) {
#pragma unroll
    for (int o = 1; o < 64; o <<= 1) v = fmaxf(v, __shfl_xor(v, o));
    return v;
}
__device__ __forceinline__ float amax8(const f32x4& a, const f32x4& b) { return fmaxf(fmaxf(fmaxf(fabsf(a.x), fabsf(a.y)), fmaxf(fabsf(a.z), fabsf(a.w))), fmaxf(fmaxf(fabsf(b.x), fabsf(b.y)), fmaxf(fabsf(b.z), fabsf(b.w)))); }
__device__ __forceinline__ unsigned q4(const f32x4& a, float inv) { const int q0 = (int)__builtin_rintf(a.x * inv), q1 = (int)__builtin_rintf(a.y * inv), q2 = (int)__builtin_rintf(a.z * inv), q3 = (int)__builtin_rintf(a.w * inv);
    return ((unsigned)q0 & 0xffu) | (((unsigned)q1 & 0xffu) << 8) | (((unsigned)q2 & 0xffu) << 16) | (((unsigned)q3 & 0xffu) << 24); }
template <int MAP, int FMT, int NC>
__device__ __forceinline__ void wg_quant_item(Frame& F, const float* W, int K, int N, unsigned char* WT, float* SB, float post, int item, const float* ks = nullptr, int KP = 0) {
    if (KP == 0) KP = K;
    LAS unsigned short* T = (LAS unsigned short*)F.lds;
    LAS float* cmx = (LAS float*)(F.lds + 147456);
    const int PK = K + 8, n0 = NC * item;
    constexpr int RPI = 64 / NC;
    const int c = F.lane & (NC - 1), rp = F.lane / NC;
    const int kw = K / 8, kbeg = F.wave * kw;
    const float* src = W + (size_t)(kbeg + rp) * N + n0 + c;
    float mx = 0.f;
    for (int kk = 0; kk < kw; kk += 32 * RPI) {
        float v[32];
#pragma unroll
        for (int i = 0; i < 32; ++i) { const int k = kk + i * RPI; v[i] = (k < kw) ? __builtin_nontemporal_load(src + (size_t)k * N) * (ks ? ks[kbeg + rp + k] : 1.0f) : 0.f; }
#pragma unroll
        for (int i = 0; i < 32; ++i) { const int k = kk + i * RPI; mx = fmaxf(mx, fabsf(v[i])); if (k < kw) T[c * PK + kbeg + rp + k] = (unsigned short)f2bf(v[i]); }
    }
#pragma unroll
    for (int o = NC; o < 64; o <<= 1) mx = fmaxf(mx, __shfl_xor(mx, o));
    if (F.lane < NC) cmx[F.wave * 32 + F.lane] = mx;
    __syncthreads();
    if (F.tid < NC) { float m = 0.f;
#pragma unroll
        for (int w = 0; w < 8; ++w) m = fmaxf(m, cmx[w * 32 + F.tid]);
        cmx[256 + F.tid] = m; SB[dmap<MAP>(n0 + F.tid)] = m > 0.f ? (FMT == 1 ? m * (1.0f / 127.0f) : m * (1.0f / 256.0f) * post) : 1.0f; }
    __syncthreads();
    const int nch = KP / 8, nchk = K / 8;
    for (int id = F.tid; id < NC * nch; id += NWAVES * 64) { const int cc = id / nch, kc = id % nch;
        if (kc >= nchk) { *(GAS v2u*)(WT + (size_t)dmap<MAP>(n0 + cc) * KP + 8 * kc) = (v2u){0u, 0u}; continue; }
        const float m = cmx[256 + cc]; const float inv = m > 0.f ? (FMT == 1 ? 127.0f : 256.0f) / m : 0.f;
        const v4u w = *(const LAS v4u*)(T + cc * PK + 8 * kc);
        const f32x4 lo = (f32x4){bf_lo(w.x), bf_hi(w.x), bf_lo(w.y), bf_hi(w.y)} * inv, hi = (f32x4){bf_lo(w.z), bf_hi(w.z), bf_lo(w.w), bf_hi(w.w)} * inv;
        v2u o; if (FMT == 1) o = (v2u){q4(lo, 1.0f), q4(hi, 1.0f)}; else o = (v2u){pg8::pk4_fp8(lo.x, lo.y, lo.z, lo.w), pg8::pk4_fp8(hi.x, hi.y, hi.z, hi.w)};
        *(GAS v2u*)(WT + (size_t)dmap<MAP>(n0 + cc) * KP + 8 * kc) = o; }
    __syncthreads();
}
__device__ __constant__ double INVF_D[16] = {1.0, 0.5623413251903491, 0.31622776601683794, 0.1778279410038923, 0.09999999999999999, 0.056234132519034905, 0.03162277660168379, 0.01778279410038923,
    0.01, 0.005623413251903491, 0.0031622776601683794, 0.0017782794100389228, 0.001, 0.000562341325190349, 0.00031622776601683794, 0.0001778279410038923};
__device__ __constant__ int RPB_TH[15] = {22, 30, 40, 54, 73, 99, 134, 182, 246, 332, 450, 609, 825, 1117, 1513};

__device__ __forceinline__ void p0_prologue(Frame& F) {
    const int gw = F.vcu * NWAVES + F.wave, NGW = F.G * NWAVES;
    const int gtid = F.vcu * (NWAVES * 64) + F.tid, NGT = F.G * NWAVES * 64;
    float* MODV = (float*)(F.ws + WS_MODV);
    {
        LAS float* cact = (LAS float*)F.lds;
        LAS float* red = (LAS float*)(F.lds + 16384);
        const float* cin = F.in[1];
        for (int i = F.tid; i < 4096; i += NWAVES * 64) { const int b = i >> 10, k = i & 1023; const float x = cin[i]; cact[k * 4 + b] = x / (1.0f + expf(-x)); }
        __syncthreads();
        constexpr int NTASK = (6 * D * 2 + 2 * D) / 64;
        for (int task = F.vcu; task < NTASK; task += F.G) {
            const int gc = task * 64 + F.lane;
            const float* W; int ldw, cc; const float* bias;
            if (gc < 6 * D) { W = F.in[5]; ldw = 6 * D; cc = gc; bias = F.in[6]; }
            else if (gc < 12 * D) { W = F.in[5] + (size_t)D * 6 * D; ldw = 6 * D; cc = gc - 6 * D; bias = F.in[6] + 6 * D; }
            else { W = F.in[14]; ldw = 2 * D; cc = gc - 12 * D; bias = F.in[15]; }
            float a0 = 0.f, a1 = 0.f, a2 = 0.f, a3 = 0.f;
            const int kbeg = F.wave * 128;
#pragma unroll 16
            for (int k = 0; k < 128; ++k) { const float w = W[(size_t)(kbeg + k) * ldw + cc]; const f32x4 ca = *(const LAS f32x4*)(cact + (kbeg + k) * 4);
                a0 += w * ca[0]; a1 += w * ca[1]; a2 += w * ca[2]; a3 += w * ca[3]; }
            red[(F.wave * 4 + 0) * 64 + F.lane] = a0; red[(F.wave * 4 + 1) * 64 + F.lane] = a1; red[(F.wave * 4 + 2) * 64 + F.lane] = a2; red[(F.wave * 4 + 3) * 64 + F.lane] = a3;
            __syncthreads();
            if (F.wave < 4) { const int b = F.wave; float s = 0.f;
#pragma unroll
                for (int w = 0; w < 8; ++w) s += red[(w * 4 + b) * 64 + F.lane];
                s += bias[cc];
                int kind; float val = s; const int j = cc & 1023, ch = cc >> 10;
                if (gc < 12 * D) { const int Lr = gc < 6 * D ? 0 : 1;
                    if (ch == 0) kind = 6 * Lr + 1; else if (ch == 1) { kind = 6 * Lr + 0; val = F.in[3][Lr * D + j] * (1.0f + s); } else if (ch == 2) kind = 6 * Lr + 2;
                    else if (ch == 3) kind = 6 * Lr + 4; else if (ch == 4) { kind = 6 * Lr + 3; val = F.in[4][Lr * D + j] * (1.0f + s); } else kind = 6 * Lr + 5;
                } else { if (ch == 0) kind = MK_B_KV; else { kind = MK_A_KV; val = F.in[13][j] * (1.0f + s); } }
                MODV[((size_t)kind * 4 + b) * D + j] = val; }
            __syncthreads();
        }
        __syncthreads();
    }
    {
        float* const SB = (float*)(F.ws + WS_SB);
        constexpr float POSTH = 1.0f / pg8::HSCALE, POSTO = 1.0f / mla::OSCALE;
        constexpr int W_EDN = NEXP * (D / 16), W_FDN = D / 16, W_EGU = NEXP * (2 * DFF / 32), W_FGU = 2 * DFF / 32, W_KVB = DILKV / 32, W_QB = DILQ / 32, W_MLAIN = LATN / 32, W_OUT = D / 32, W_OB = D / 32;
        constexpr int NWG = W_EDN + W_FDN + W_EGU + W_FGU + W_KVB + W_QB + W_MLAIN + W_OUT + W_OB;
        for (int it = F.vcu; it < NWG; it += F.G) { int r = it;
            if (r < W_EDN) { const int e = r / (D / 16); wg_quant_item<MAP_PLAIN, 2, 16>(F, F.in[24] + (size_t)e * DFF * D, DFF, D, F.ws + WS_WEDN + (size_t)e * D * DFF, SB + SB_EDN + (size_t)e * D, POSTH, r % (D / 16)); continue; } r -= W_EDN;
            if (r < W_FDN) { wg_quant_item<MAP_PLAIN, 2, 16>(F, F.in[21], DFF, D, F.ws + WS_WFDN, SB + SB_FDN, POSTH, r); continue; } r -= W_FDN;
            if (r < W_EGU) { const int e = r / W_FGU; wg_quant_item<MAP_GU, 1, 32>(F, F.in[23] + (size_t)e * D * 2 * DFF, D, 2 * DFF, F.ws + WS_WEGU + (size_t)e * 2 * DFF * D, SB + SB_EGU + (size_t)e * 2 * DFF, 1.f, r % W_FGU); continue; } r -= W_EGU;
            if (r < W_FGU) { wg_quant_item<MAP_GU, 1, 32>(F, F.in[20], D, 2 * DFF, F.ws + WS_WFGU, SB + SB_FGU, 1.f, r); continue; } r -= W_FGU;
            if (r < W_KVB) { wg_quant_item<MAP_PLAIN, 1, 32>(F, F.in[16], D, DILKV, F.ws + WS_WKVB, SB + SB_KVB, 1.f, r); continue; } r -= W_KVB;
            if (r < W_QB) { wg_quant_item<MAP_PLAIN, 1, 32>(F, F.in[18], D, DILQ, F.ws + WS_WQB, SB + SB_QB, 1.f, r); continue; } r -= W_QB;
            if (r < W_MLAIN) { wg_quant_item<MAP_MLAIN, 1, 32>(F, F.in[7], D, LATN, F.ws + WS_WMLAIN, SB + SB_LAT, 1.f, r); continue; } r -= W_MLAIN;
            if (r < W_OUT) { wg_quant_item<MAP_PLAIN, 2, 32>(F, F.in[12], D, D, F.ws + WS_WOUT, SB + SB_OUT, POSTO, r); continue; } r -= W_OUT;
            wg_quant_item<MAP_PLAIN, 2, 32>(F, F.in[19], DILOUT, D, F.ws + WS_WOB, SB + SB_OB, POSTO, r);
        }
        for (int it = F.vcu; it < QUP / 32 + KVUP / 32; it += F.G) {
            if (it < QUP / 32) wg_quant_item<MAP_QUP, 1, 32>(F, F.in[9], QRANK, QUP, F.ws + WS_WQUP, SB + SB_QUP, 1.f, it, F.in[8], QRP);
            else wg_quant_item<MAP_PLAIN, 1, 32>(F, F.in[11], KVRANK, KVUP, F.ws + WS_WKVUP, SB + SB_KVUP, 1.f, it - QUP / 32, F.in[10], KVRANK); }
    }
    {
        v4u* padz = (v4u*)(F.ws + WS_WMLAIN + (size_t)LATN * D);
        for (int i = gtid; i < (LATP - LATN) * D / 16; i += NGT) padz[i] = (v4u){0u, 0u, 0u, 0u};
        for (int i = gtid; i < LATP - LATN; i += NGT) ((float*)(F.ws + WS_SB))[SB_LAT + LATN + i] = 1.0f;
        const int* pos = (const int*)F.in[2];
        float* cs = (float*)(F.ws + WS_CS);
        for (int i = gtid; i < M * 16; i += NGT) { const int row = i >> 4, k = i & 15;
            const double x = (double)pos[row] * INVF_D[k]; const double rev = x * 0.15915494309189535; const float fr = (float)(rev - __builtin_rint(rev));
            cs[(size_t)i * 2] = __builtin_amdgcn_cosf(fr); cs[(size_t)i * 2 + 1] = __builtin_amdgcn_sinf(fr); }
        const float* rpb = F.in[17];
        float* bt = (float*)(F.ws + WS_BIAS);
        for (int i = gtid; i < 24 * 288; i += NGT) { const int gh = i / 288, ii = i % 288, j = 191 - ii, g = gh >> 3; const int d = j * (g == 0 ? 1 : (g == 1 ? 4 : 16));
            float val = -INFINITY;
            if (j >= 0 && j <= 128) { int bk; if (d < 16) bk = d; else { bk = 16;
#pragma unroll
                for (int q = 0; q < 15; ++q) bk += (d >= RPB_TH[q]) ? 1 : 0; }
                val = rpb[bk * 24 + gh] * LOG2E_F; }
            bt[i] = val; }
    }
}

constexpr int HPITCH = 2048;
__device__ __forceinline__ void ld8_f32(const float* p, f32x4& a, f32x4& b) { a = *(const f32x4*)p; b = *(const f32x4*)(p + 4); }
__device__ __forceinline__ void ld8_bf16(const bf16* p, f32x4& a, f32x4& b) { const v4u w = *(const GAS v4u*)p; a = (f32x4){bf_lo(w.x), bf_hi(w.x), bf_lo(w.y), bf_hi(w.y)}; b = (f32x4){bf_lo(w.z), bf_hi(w.z), bf_lo(w.w), bf_hi(w.w)}; }
__device__ __forceinline__ float ssq8(const f32x4& a, const f32x4& b) { return ((a.x * a.x + a.y * a.y) + (a.z * a.z + a.w * a.w)) + ((b.x * b.x + b.y * b.y) + (b.z * b.z + b.w * b.w)); }
__device__ __forceinline__ v4u pk8(const f32x4& a, const f32x4& b) { return (v4u){pk2(a.x, a.y), pk2(a.z, a.w), pk2(b.x, b.y), pk2(b.z, b.w)}; }
__device__ __forceinline__ void quant_row(const f32x4 (&y)[2][2], i8* orow, float* srow, int lane) {
    const float mx = wave_max(fmaxf(amax8(y[0][0], y[0][1]), amax8(y[1][0], y[1][1])));
    const float sc = mx > 0.f ? mx * (1.0f / 127.0f) : 1.0f, inv = mx > 0.f ? 127.0f / mx : 0.f;
#pragma unroll
    for (int j = 0; j < 2; ++j) *(GAS v2u*)(orow + 8 * lane + 512 * j) = (v2u){q4(y[j][0], inv), q4(y[j][1], inv)};
    if (lane == 0) *srow = sc;
}
template <bool DUAL, bool INF32>
__device__ __forceinline__ void norm_phase(Frame& F, const void* Hin, const float* A0, const float* B0, i8* O0, float* S0, const float* A1, const float* B1, i8* O1, float* S1) {
    const int gw = F.vcu * NWAVES + F.wave, NGW = F.G * NWAVES;
    for (int c = gw; c < M / 16; c += NGW) {
        const int row0 = c * 16, b = row0 / SEQ;
        f32x4 a0[2][2], b0[2][2], a1[2][2], b1[2][2];
#pragma unroll
        for (int j = 0; j < 2; ++j) { const int co = b * D + 8 * F.lane + 512 * j; ld8_f32(A0 + co, a0[j][0], a0[j][1]); ld8_f32(B0 + co, b0[j][0], b0[j][1]);
            if (DUAL) { ld8_f32(A1 + co, a1[j][0], a1[j][1]); ld8_f32(B1 + co, b1[j][0], b1[j][1]); } }
#pragma unroll 2
        for (int i = 0; i < 16; ++i) { const size_t row = (size_t)(row0 + i);
            f32x4 v[2][2]; float s = 0.f;
#pragma unroll
            for (int j = 0; j < 2; ++j) { if (INF32) ld8_f32((const float*)Hin + row * D + 8 * F.lane + 512 * j, v[j][0], v[j][1]); else ld8_bf16((const bf16*)Hin + row * HPITCH + 8 * F.lane + 512 * j, v[j][0], v[j][1]);
                s += ssq8(v[j][0], v[j][1]); }
            const float rstd = 1.0f / sqrtf(wave_sum(s) * (1.f / D) + EPS);
            f32x4 y[2][2];
#pragma unroll
            for (int j = 0; j < 2; ++j) { y[j][0] = v[j][0] * rstd * a0[j][0] + b0[j][0]; y[j][1] = v[j][1] * rstd * a0[j][1] + b0[j][1]; }
            quant_row(y, O0 + row * D, S0 + row, F.lane);
            if (DUAL) {
#pragma unroll
                for (int j = 0; j < 2; ++j) { y[j][0] = v[j][0] * rstd * a1[j][0] + b1[j][0]; y[j][1] = v[j][1] * rstd * a1[j][1] + b1[j][1]; }
                quant_row(y, O1 + row * D, S1 + row, F.lane); }
        }
    }
}

__device__ __forceinline__ void latnorm_phase(Frame& F) {
    const int gw = F.vcu * NWAVES + F.wave, NGW = F.G * NWAVES;
    const bf16* LAT = (const bf16*)(F.ws + A_LAT); i8* QN = (i8*)(F.ws + A_QN); i8* KVN = (i8*)(F.ws + A_KVN); bf16* KB = (bf16*)(F.ws + A_K);
    float* XSQ = (float*)(F.ws + WS_XSQ); float* XSKVN = (float*)(F.ws + WS_XSKVN);
    const float* cs = (const float*)(F.ws + WS_CS);
    for (int row = gw; row < M; row += NGW) {
        const unsigned* lr = (const unsigned*)(LAT + (size_t)row * LATP);
        unsigned q[3], kv[2];
#pragma unroll
        for (int j = 0; j < 3; ++j) q[j] = lr[F.lane + 64 * j];
#pragma unroll
        for (int j = 0; j < 2; ++j) kv[j] = lr[192 + F.lane + 64 * j];
        const unsigned kr = lr[320 + (F.lane & 15)];
        float sq = 0.f, sk = 0.f, mq = 0.f, mk = 0.f;
#pragma unroll
        for (int j = 0; j < 3; ++j) { const float a = bf_lo(q[j]), b = bf_hi(q[j]); sq += a * a + b * b; mq = fmaxf(mq, fmaxf(fabsf(a), fabsf(b))); }
#pragma unroll
        for (int j = 0; j < 2; ++j) { const float a = bf_lo(kv[j]), b = bf_hi(kv[j]); sk += a * a + b * b; mk = fmaxf(mk, fmaxf(fabsf(a), fabsf(b))); }
        const float rq = 1.0f / sqrtf(wave_sum(sq) * (1.f / QRANK) + EPS), rk = 1.0f / sqrtf(wave_sum(sk) * (1.f / KVRANK) + EPS);
        mq = wave_max(mq); mk = wave_max(mk);
        const float iq = mq > 0.f ? 127.0f / mq : 0.f, ik = mk > 0.f ? 127.0f / mk : 0.f;
        unsigned short* qo = (unsigned short*)(QN + (size_t)row * QRP); unsigned short* ko = (unsigned short*)(KVN + (size_t)row * KVRANK);
#pragma unroll
        for (int j = 0; j < 3; ++j) { const int a = (int)__builtin_rintf(bf_lo(q[j]) * iq), b = (int)__builtin_rintf(bf_hi(q[j]) * iq); qo[F.lane + 64 * j] = (unsigned short)(((unsigned)a & 0xffu) | (((unsigned)b & 0xffu) << 8)); }
        qo[192 + F.lane] = 0;
#pragma unroll
        for (int j = 0; j < 2; ++j) { const int a = (int)__builtin_rintf(bf_lo(kv[j]) * ik), b = (int)__builtin_rintf(bf_hi(kv[j]) * ik); ko[F.lane + 64 * j] = (unsigned short)(((unsigned)a & 0xffu) | (((unsigned)b & 0xffu) << 8)); }
        if (F.lane == 0) { XSQ[row] = mq > 0.f ? mq * rq * (1.0f / 127.0f) : 1.0f; XSKVN[row] = mk > 0.f ? mk * rk * (1.0f / 127.0f) : 1.0f; }
        { const int i = F.lane & 15; const float c = cs[(size_t)row * 32 + 2 * i], s = cs[(size_t)row * 32 + 2 * i + 1]; const float x1 = bf_lo(kr), x2 = bf_hi(kr);
          const unsigned w = pk2(x1 * c - x2 * s, x1 * s + x2 * c);
          unsigned* kb = (unsigned*)(KB + (size_t)row * QUP);
#pragma unroll
          for (int hh = 0; hh < 4; ++hh) { const int h = (F.lane >> 4) * 4 + hh; kb[(h * 96 + 64) / 2 + i] = w; } }
    }
}

__device__ __forceinline__ void merge_phase(Frame& F) {
    const int gw = F.vcu * NWAVES + F.wave, NGW = F.G * NWAVES;
    const bf16* OG = (const bf16*)(F.ws + A_OG); const float* LSE = (const float*)(F.ws + WS_LSE); unsigned char* OD = F.ws + A_OD;
    for (int row = gw; row < M; row += NGW) {
        const int h = F.lane >> 3;
        float l0 = LSE[((size_t)0 * M + row) * 8 + h], l1 = LSE[((size_t)1 * M + row) * 8 + h], l2 = LSE[((size_t)2 * M + row) * 8 + h];
        const float mx = fmaxf(l0, fmaxf(l1, l2)); float w0 = __builtin_amdgcn_exp2f(l0 - mx), w1 = __builtin_amdgcn_exp2f(l1 - mx), w2 = __builtin_amdgcn_exp2f(l2 - mx);
        const float inv = 1.0f / (w0 + w1 + w2); w0 *= inv; w1 *= inv; w2 *= inv;
        const v4u a = *(const v4u*)(OG + ((size_t)0 * M + row) * DILOUT + 8 * F.lane), b = *(const v4u*)(OG + ((size_t)1 * M + row) * DILOUT + 8 * F.lane), c = *(const v4u*)(OG + ((size_t)2 * M + row) * DILOUT + 8 * F.lane);
        float m8[8];
#pragma unroll
        for (int k = 0; k < 4; ++k) { m8[2 * k] = (w0 * bf_lo(a[k]) + w1 * bf_lo(b[k]) + w2 * bf_lo(c[k])) * mla::OSCALE; m8[2 * k + 1] = (w0 * bf_hi(a[k]) + w1 * bf_hi(b[k]) + w2 * bf_hi(c[k])) * mla::OSCALE; }
        *(v2u*)(OD + (size_t)row * DILOUT + 8 * F.lane) = (v2u){pg8::pk4_fp8(m8[0], m8[1], m8[2], m8[3]), pg8::pk4_fp8(m8[4], m8[5], m8[6], m8[7])};
    }
}

__device__ __forceinline__ void router_phase(Frame& F, const bf16* H, const float* A0, const float* B0, i8* O0, float* S0) {
    const int gw = F.vcu * NWAVES + F.wave, NGW = F.G * NWAVES;
    LAS float* wrt = (LAS float*)F.lds;
    { const float* wr = F.in[22]; for (int i = F.tid; i < 8192; i += NWAVES * 64) { const int col = i >> 3, e = i & 7; wrt[e * 1024 + col] = wr[i]; } }
    __syncthreads();
    v4u* ROUTE = (v4u*)(F.ws + WS_ROUTE); unsigned* CNT = (unsigned*)(F.ws + WS_CNT);
    for (int c = gw; c < M / 16; c += NGW) {
        const int row0 = c * 16, b = row0 / SEQ;
        f32x4 a0[2][2], b0[2][2];
#pragma unroll
        for (int j = 0; j < 2; ++j) { const int co = b * D + 8 * F.lane + 512 * j; ld8_f32(A0 + co, a0[j][0], a0[j][1]); ld8_f32(B0 + co, b0[j][0], b0[j][1]); }
        unsigned cnt = 0u;
        for (int i = 0; i < 16; ++i) { const size_t row = (size_t)(row0 + i);
            f32x4 v[2][2]; float s = 0.f;
#pragma unroll
            for (int j = 0; j < 2; ++j) { ld8_bf16(H + row * HPITCH + 8 * F.lane + 512 * j, v[j][0], v[j][1]); s += ssq8(v[j][0], v[j][1]); }
            const float rstd = 1.0f / sqrtf(wave_sum(s) * (1.f / D) + EPS);
            float lg[8];
#pragma unroll
            for (int e = 0; e < 8; ++e) lg[e] = 0.f;
            f32x4 yq[2][2];
#pragma unroll
            for (int j = 0; j < 2; ++j) { const f32x4 y0 = v[j][0] * rstd * a0[j][0] + b0[j][0], y1 = v[j][1] * rstd * a0[j][1] + b0[j][1];
                yq[j][0] = y0; yq[j][1] = y1;
#pragma unroll
                for (int e = 0; e < 8; ++e) { const LAS float* wp = wrt + e * 1024 + 8 * F.lane + 512 * j; const f32x4 w0 = *(const LAS f32x4*)wp, w1 = *(const LAS f32x4*)(wp + 4);
                    lg[e] += ((y0.x * w0.x + y0.y * w0.y) + (y0.z * w0.z + y0.w * w0.w)) + ((y1.x * w1.x + y1.y * w1.y) + (y1.z * w1.z + y1.w * w1.w)); } }
            quant_row(yq, O0 + row * D, S0 + row, F.lane);
#pragma unroll
            for (int e = 0; e < 8; ++e) lg[e] = wave_sum(lg[e]);
            int e1 = 0; float v1 = lg[0];
#pragma unroll
            for (int e = 1; e < 8; ++e) if (lg[e] > v1) { v1 = lg[e]; e1 = e; }
            int e2 = -1; float v2 = -INFINITY;
#pragma unroll
            for (int e = 0; e < 8; ++e) if (e != e1 && lg[e] > v2) { v2 = lg[e]; e2 = e; }
            const float ex = expf(v2 - v1); const float g1 = 1.0f / (1.0f + ex), g2 = ex / (1.0f + ex);
            cnt += (F.lane == e1 ? 1u : 0u) + (F.lane == e2 ? 1u : 0u);
            if (F.lane == 0) ROUTE[row] = (v4u){(unsigned)e1 | ((unsigned)e2 << 8), __float_as_uint(g1), __float_as_uint(g2), 0u};
        }
        if (F.lane < 8) CNT[c * 8 + F.lane] = cnt;
    }
}

__device__ __forceinline__ void lists_phase(Frame& F) {
    const int gw = F.vcu * NWAVES + F.wave, NGW = F.G * NWAVES;
    const v4u* ROUTE = (const v4u*)(F.ws + WS_ROUTE); const unsigned* CNT = (const unsigned*)(F.ws + WS_CNT);
    int* LIST = (int*)(F.ws + WS_LIST); float* SLOTG = (float*)(F.ws + WS_SLOTG); float* SLOTXS = (float*)(F.ws + WS_SLOTXS); const float* XS = (const float*)(F.ws + WS_XS); int* TOKSLOT = (int*)(F.ws + WS_TOKSLOT); int* TILEEXP = (int*)(F.ws + WS_TILEEXP);
    for (int c = gw; c < M / 16; c += NGW) {
        unsigned lt[8], al[8];
#pragma unroll
        for (int e = 0; e < 8; ++e) { lt[e] = 0u; al[e] = 0u; }
        for (int cc = F.lane; cc < M / 16; cc += 64) { const v4u x = *(const v4u*)(CNT + cc * 8), y = *(const v4u*)(CNT + cc * 8 + 4); const bool bl = cc < c;
            al[0] += x.x; al[1] += x.y; al[2] += x.z; al[3] += x.w; al[4] += y.x; al[5] += y.y; al[6] += y.z; al[7] += y.w;
            if (bl) { lt[0] += x.x; lt[1] += x.y; lt[2] += x.z; lt[3] += x.w; lt[4] += y.x; lt[5] += y.y; lt[6] += y.z; lt[7] += y.w; } }
#pragma unroll
        for (int e = 0; e < 8; ++e) {
#pragma unroll
            for (int o = 1; o < 64; o <<= 1) { lt[e] += __shfl_xor(lt[e], o); al[e] += __shfl_xor(al[e], o); } }
        unsigned base[8]; unsigned run = 0u;
#pragma unroll
        for (int e = 0; e < 8; ++e) { base[e] = run; run += (al[e] + 255u) & ~255u; }
        const int row = c * 16 + (F.lane & 15);
        const v4u r = ROUTE[row]; const int e1 = (int)(r.x & 0xffu), e2 = (int)((r.x >> 8) & 0xffu);
        int s1 = 0, s2 = 0;
#pragma unroll
        for (int e = 0; e < 8; ++e) { const bool has = (F.lane < 16) && (e1 == e || e2 == e); const unsigned long long mk = __ballot(has);
            const int rank = __popcll(mk & ((1ull << F.lane) - 1ull)); const int sl = (int)(base[e] + lt[e]) + rank;
            if (e1 == e) s1 = sl; if (e2 == e) s2 = sl; }
        if (F.lane < 16) { LIST[s1] = row; LIST[s2] = row; SLOTG[s1] = __uint_as_float(r.y); SLOTG[s2] = __uint_as_float(r.z); TOKSLOT[row * 2] = s1; TOKSLOT[row * 2 + 1] = s2;
            const float xs = XS[row]; SLOTXS[s1] = xs; SLOTXS[s2] = xs; }
        if (c == 0) {
#pragma unroll
            for (int e = 0; e < 8; ++e) { const unsigned pe = (al[e] + 255u) & ~255u;
                for (unsigned s = base[e] + al[e] + F.lane; s < base[e] + pe; s += 64) { LIST[s] = 0; SLOTG[s] = 0.f; SLOTXS[s] = 0.f; }
                for (unsigned t = base[e] / 256u + F.lane; t < (base[e] + pe) / 256u; t += 64) TILEEXP[t] = e; }
            if (F.lane == 0) TILEEXP[300] = (int)(run / 256u);
        }
    }
}

__device__ __forceinline__ void final_phase(Frame& F, float* OUT, const float* gate, const float* gfin) {
    const int gw = F.vcu * NWAVES + F.wave, NGW = F.G * NWAVES;
    const bf16* Y = (const bf16*)(F.ws + A_Y); const int* TOKSLOT = (const int*)(F.ws + WS_TOKSLOT); const bf16* H = (const bf16*)OUT;
    for (int c = gw; c < M / 16; c += NGW) {
        const int row0 = c * 16, b = row0 / SEQ;
        f32x4 gt[2][2], gf[2][2];
#pragma unroll
        for (int j = 0; j < 2; ++j) { ld8_f32(gate + b * D + 8 * F.lane + 512 * j, gt[j][0], gt[j][1]); ld8_f32(gfin + 8 * F.lane + 512 * j, gf[j][0], gf[j][1]); }
#pragma unroll 2
        for (int i = 0; i < 16; ++i) { const size_t row = (size_t)(row0 + i);
            const int s1 = TOKSLOT[row * 2], s2 = TOKSLOT[row * 2 + 1];
            f32x4 v[2][2]; float s = 0.f;
#pragma unroll
            for (int j = 0; j < 2; ++j) { f32x4 h0, h1, p0, p1, q0, q1; ld8_bf16(H + row * HPITCH + 8 * F.lane + 512 * j, h0, h1);
                ld8_bf16(Y + (size_t)s1 * D + 8 * F.lane + 512 * j, p0, p1); ld8_bf16(Y + (size_t)s2 * D + 8 * F.lane + 512 * j, q0, q1);
                v[j][0] = h0 + gt[j][0] * (p0 + q0); v[j][1] = h1 + gt[j][1] * (p1 + q1); s += ssq8(v[j][0], v[j][1]); }
            const float rstd = 1.0f / sqrtf(wave_sum(s) * (1.f / D) + EPS);
            asm volatile("" ::: "memory");
#pragma unroll
            for (int j = 0; j < 2; ++j) { float* op = OUT + row * D + 8 * F.lane + 512 * j; *(GAS f32x4*)op = v[j][0] * rstd * gf[j][0]; *(GAS f32x4*)(op + 4) = v[j][1] * rstd * gf[j][1]; }
        }
    }
}
#ifndef MK_ONE_LAUNCH
#define MK_ONE_LAUNCH 1
#endif
constexpr int N_PHASES = 20;
struct Args { const float* in[26]; float* out; unsigned char* ws; int ph_lo, ph_hi; };
static_assert(sizeof(Args) == 26 * 8 + 8 + 8 + 8, "Args has no padding");

__global__ void __launch_bounds__(NWAVES * 64, 2) mk_fwd(Args args) {
    extern __shared__ __attribute__((aligned(16))) unsigned char lds[];
    Frame F;
    F.lds = (LAS unsigned char*)lds;
    F.MISC = (volatile LAS unsigned*)(F.lds + MISC_OFF);
    F.tid = threadIdx.x; F.lane = F.tid & 63; F.wave = __builtin_amdgcn_readfirstlane(F.tid >> 6);
    F.G = gridDim.x; { const int bx = blockIdx.x; F.vcu = (F.G % 8 == 0) ? (bx % 8) * (F.G / 8) + bx / 8 : bx; }
    F.ws = args.ws; F.out = args.out;
#pragma unroll
    for (int i = 0; i < 26; ++i) F.in[i] = args.in[i];
    unsigned char* const ws = args.ws;
    for (int u = F.tid; u < (LDS_BYTES - LDSCTL_OFF) / 4; u += NWAVES * 64) ((LAS unsigned*)(F.lds + LDSCTL_OFF))[u] = 0u;
    __syncthreads();
    const int lo = args.ph_lo, hi = args.ph_hi;
    XcdBarrier bar; bar.bar = (unsigned*)(ws + WS_CTL) + CW_BAR; bar.x = 0; bar.st = nullptr;
    if (hi - lo > 1) bar = xcd_barrier_post((unsigned*)(ws + WS_CTL) + CW_BAR, F.MISC + 8);
    int cid = (int)blockIdx.x;
    if (hi - lo > 1) { if (F.tid == 0) F.MISC[12] = xb_add((unsigned*)(ws + WS_CTL) + CW_RANK + 64 * bar.x, 1u); }

#ifndef PHASE_MASK
#define PHASE_MASK 0xFFFFFu
#endif
#define IN(k) (((PHASE_MASK >> (k)) & 1u) && lo <= (k) && (k) < hi)
#ifndef REPEAT_MASK
#define REPEAT_MASK 0u
#endif
#define REP(k) (((REPEAT_MASK >> (k)) & 1u) ? 2 : 1)
#define SEAM(k) do { if (IN(k) && IN((k) + 1)) xcd_barrier(bar); } while (0)
    const float* MODV = (const float*)(ws + WS_MODV);
#define MV(kind) (MODV + (size_t)(kind) * 4 * D)
    bf16* const H = (bf16*)args.out;
    i8* const XN = (i8*)(ws + A_XN); i8* const XNKV = (i8*)(ws + A_XNKV);
    float* const XS = (float*)(ws + WS_XS); float* const XSKV = (float*)(ws + WS_XSKV); const float* const SB = (const float*)(ws + WS_SB);
    const pg8::MoeInfo mi0{nullptr, nullptr, 0};

    if (IN(0)) for (int rep_ = 0; rep_ < REP(0); ++rep_) { p0_prologue(F); } SEAM(0);
    if (IN(0) && IN(1)) {
        if (F.tid == 0) { bool ok = (F.G % 8) == 0;
            for (unsigned j = 0; j < 16; ++j) { const unsigned cnt_ = xb_ld((unsigned*)(ws + WS_CTL) + CW_BAR + XB_XCNT(j)); ok = ok && (cnt_ == (j < 8 ? (unsigned)F.G / 8u : 0u)); }
            F.MISC[13] = ok ? (F.MISC[12] * 8u + bar.x) : (unsigned)blockIdx.x; }
        __syncthreads();
        cid = (int)F.MISC[13];
        F.vcu = (F.G % 8 == 0) ? (cid % 8) * (F.G / 8) + cid / 8 : cid;
    }

    if (IN(1)) for (int rep_ = 0; rep_ < REP(1); ++rep_) { norm_phase<false, true>(F, F.in[0], MV(MK_A_MIX0), MV(MK_B_MIX0), XN, XS, nullptr, nullptr, nullptr, nullptr); } SEAM(1);
    if (IN(2)) for (int rep_ = 0; rep_ < REP(2); ++rep_) { pg8::Gemm g{(const bf16*)XN, (const bf16*)(ws + WS_WMLAIN), M, LATP, D}; pg8::StaticOrder S; S.init(M, LATP, F.G, cid);
        pg8::EpiBf16Q E{(bf16*)(ws + A_LAT), LATP, XS, SB + SB_LAT};
        pg8::gemm_phase<pg8::EpiBf16Q, pg8::StaticOrder, true, true, 0, 1>(F.lds, g, S, E, mi0); } SEAM(2);
    if (IN(3)) for (int rep_ = 0; rep_ < REP(3); ++rep_) { latnorm_phase(F); } SEAM(3);
    if (IN(4)) for (int rep_ = 0; rep_ < REP(4); ++rep_) {
#ifndef P4_SKIP_Q
        { pg8::Gemm g{(const bf16*)(ws + A_QN), (const bf16*)(ws + WS_WQUP), M, QUP, QRP}; pg8::StaticOrder S; S.init(M, QUP, F.G, cid);
          pg8::EpiQQ E{(bf16*)(ws + A_Q), (const float*)(ws + WS_CS), (const float*)(ws + WS_XSQ), SB + SB_QUP};
          pg8::gemm_phase<pg8::EpiQQ, pg8::StaticOrder, true, true, 0, 1>(F.lds, g, S, E, mi0); }
#endif
#ifndef P4_SKIP_KV
        { pg8::Gemm g{(const bf16*)(ws + A_KVN), (const bf16*)(ws + WS_WKVUP), M, KVUP, KVRANK}; pg8::StaticOrder S; S.init(M, KVUP, F.G, cid);
          pg8::EpiKVQ E{(bf16*)(ws + A_K), (bf16*)(ws + A_V), (const float*)(ws + WS_XSKVN), SB + SB_KVUP};
          pg8::gemm_phase<pg8::EpiKVQ, pg8::StaticOrder, true, true, 0, 1>(F.lds, g, S, E, mi0); }
#endif
    } SEAM(4);
    if (IN(5)) for (int rep_ = 0; rep_ < REP(5); ++rep_) {
        const bf16* Qp = (const bf16*)(ws + A_Q); const bf16* Kp = (const bf16*)(ws + A_K); const bf16* Vp = (const bf16*)(ws + A_V); unsigned char* Op = ws + A_O;
        if (F.G == 256) {
            for (int i = 0; i < 8; ++i) { const int bh = (F.vcu >> 3) + 32 * (i >> 2), s = F.vcu & 7, k = i & 3; const int qb = (k == 0) ? s : (k == 1) ? 15 - s : (k == 2) ? 16 + s : 31 - s;
                const int b = bh >> 4, h = bh & 15;
                mla::attn_unit<8>(b, h, qb, Qp, Kp, Vp, Op, (char*)lds); }
        } else {
            for (int u = (int)blockIdx.x; u < BATCH * MLA_H * 32; u += F.G) { const int bh = u >> 5, qb = 31 - (u & 31); const int b = bh >> 4, h = bh & 15;
                mla::attn_unit<8>(b, h, qb, Qp, Kp, Vp, Op, (char*)lds); }
        }
    } SEAM(5);
    if (IN(6)) for (int rep_ = 0; rep_ < REP(6); ++rep_) { pg8::Gemm g{(const bf16*)(ws + A_O), (const bf16*)(ws + WS_WOUT), M, D, D}; pg8::StaticOrder S; S.init(M, D, F.G, cid);
        pg8::EpiResid<true> E{F.in[0], H, MV(MK_G_MIX0), SB + SB_OUT};
        pg8::gemm_phase<pg8::EpiResid<true>, pg8::StaticOrder, true, true, 0, 2>(F.lds, g, S, E, mi0); } SEAM(6);
    if (IN(7)) for (int rep_ = 0; rep_ < REP(7); ++rep_) { norm_phase<false, false>(F, H, MV(MK_A_FFN0), MV(MK_B_FFN0), XN, XS, nullptr, nullptr, nullptr, nullptr); } SEAM(7);
    if (IN(8)) for (int rep_ = 0; rep_ < REP(8); ++rep_) { pg8::Gemm g{(const bf16*)XN, (const bf16*)(ws + WS_WFGU), M, 2 * DFF, D}; pg8::StaticOrder S; S.init(M, 2 * DFF, F.G, cid);
        pg8::EpiSwiGLUQ E{(unsigned char*)(ws + A_HID), DFF, XS, SB + SB_FGU, nullptr};
        pg8::gemm_phase<pg8::EpiSwiGLUQ, pg8::StaticOrder, true, true, 0, 1>(F.lds, g, S, E, mi0); } SEAM(8);
    if (IN(9)) for (int rep_ = 0; rep_ < REP(9); ++rep_) { pg8::Gemm g{(const bf16*)(ws + A_HID), (const bf16*)(ws + WS_WFDN), M, D, DFF}; pg8::StaticOrder S; S.init(M, D, F.G, cid);
        pg8::EpiResid<false> E{H, H, MV(MK_G_FFN0), SB + SB_FDN};
        pg8::gemm_phase<pg8::EpiResid<false>, pg8::StaticOrder, true, true, 0, 2>(F.lds, g, S, E, mi0); } SEAM(9);
    if (IN(10)) for (int rep_ = 0; rep_ < REP(10); ++rep_) { norm_phase<true, false>(F, H, MV(MK_A_MIX1), MV(MK_B_MIX1), XN, XS, MV(MK_A_KV), MV(MK_B_KV), XNKV, XSKV); } SEAM(10);
    if (IN(11)) for (int rep_ = 0; rep_ < REP(11); ++rep_) {
        { pg8::Gemm g{(const bf16*)XNKV, (const bf16*)(ws + WS_WKVB), M, DILKV, D}; pg8::StaticOrder S; S.init(M, DILKV, F.G, cid);
          pg8::EpiDilQ<true> E{(bf16*)(ws + A_KVB), XSKV, SB + SB_KVB};
          pg8::gemm_phase<pg8::EpiDilQ<true>, pg8::StaticOrder, true, true, 0, 1>(F.lds, g, S, E, mi0); }
        { pg8::Gemm g{(const bf16*)XN, (const bf16*)(ws + WS_WQB), M, DILQ, D}; pg8::StaticOrder S; S.init(M, DILQ, F.G, cid);
          pg8::EpiDilQ<false> E{(bf16*)(ws + A_QB), XS, SB + SB_QB};
          pg8::gemm_phase<pg8::EpiDilQ<false>, pg8::StaticOrder, true, true, 0, 1>(F.lds, g, S, E, mi0); }
    } SEAM(11);
    if (IN(12)) for (int rep_ = 0; rep_ < REP(12); ++rep_) {
        const bf16* Qp = (const bf16*)(ws + A_QB); const bf16* KV = (const bf16*)(ws + A_KVB); bf16* OG = (bf16*)(ws + A_OG); float* LSE = (float*)(ws + WS_LSE); const float* BT = (const float*)(ws + WS_BIAS);
        dila::dil_phase(Qp, KV, OG, LSE, BT, (char*)lds, F.G);
    } SEAM(12);
    if (IN(13)) for (int rep_ = 0; rep_ < REP(13); ++rep_) { merge_phase(F); } SEAM(13);
    if (IN(14)) for (int rep_ = 0; rep_ < REP(14); ++rep_) { pg8::Gemm g{(const bf16*)(ws + A_OD), (const bf16*)(ws + WS_WOB), M, D, DILOUT}; pg8::StaticOrder S; S.init(M, D, F.G, cid);
        pg8::EpiResid<false> E{H, H, MV(MK_G_MIX1), SB + SB_OB};
        pg8::gemm_phase<pg8::EpiResid<false>, pg8::StaticOrder, true, true, 0, 2>(F.lds, g, S, E, mi0); } SEAM(14);
    if (IN(15)) for (int rep_ = 0; rep_ < REP(15); ++rep_) { router_phase(F, H, MV(MK_A_FFN1), MV(MK_B_FFN1), XN, XS); } SEAM(15);
    if (IN(16)) for (int rep_ = 0; rep_ < REP(16); ++rep_) { lists_phase(F); } SEAM(16);
    if (IN(17)) for (int rep_ = 0; rep_ < REP(17); ++rep_) { const int ntile = ((const int*)(ws + WS_TILEEXP))[300];
        pg8::Gemm g{(const bf16*)XN, (const bf16*)(ws + WS_WEGU), ntile * 256, 2 * DFF, D}; pg8::StaticOrder S; S.init(ntile * 256, 2 * DFF, F.G, cid);
        const pg8::MoeInfo mi{(const int*)(ws + WS_LIST), (const int*)(ws + WS_TILEEXP), (size_t)2 * DFF * D};
        pg8::EpiSwiGLUQ E{(unsigned char*)(ws + A_HIDS), DFF, (const float*)(ws + WS_SLOTXS), SB + SB_EGU, mi.tile_expert};
        pg8::gemm_phase<pg8::EpiSwiGLUQ, pg8::StaticOrder, true, true, 1, 1>(F.lds, g, S, E, mi); } SEAM(17);
    if (IN(18)) for (int rep_ = 0; rep_ < REP(18); ++rep_) { const int ntile = ((const int*)(ws + WS_TILEEXP))[300];
        pg8::Gemm g{(const bf16*)(ws + A_HIDS), (const bf16*)(ws + WS_WEDN), ntile * 256, D, DFF}; pg8::StaticOrder S; S.init(ntile * 256, D, F.G, cid);
        const pg8::MoeInfo mi{(const int*)(ws + WS_LIST), (const int*)(ws + WS_TILEEXP), (size_t)D * DFF};
        pg8::EpiMoeDown E{(bf16*)(ws + A_Y), (const float*)(ws + WS_SLOTG), SB + SB_EDN, mi.tile_expert};
        pg8::gemm_phase<pg8::EpiMoeDown, pg8::StaticOrder, true, true, 2, 2>(F.lds, g, S, E, mi); } SEAM(18);
    if (IN(19)) for (int rep_ = 0; rep_ < REP(19); ++rep_) { final_phase(F, args.out, MV(MK_G_FFN1), F.in[25]); }
#undef IN
#undef SEAM
#undef MV
}

extern "C" void kernel_launch(void* const* d_in, const int* in_sizes, int n_in, void* d_out, int out_size, void* d_ws, size_t ws_size, hipStream_t stream) {
    static int grid = 0;
    if (grid == 0) {
        if (n_in != 26 || in_sizes[0] != M * D || out_size != M * D || ws_size < WS_END) { fprintf(stderr, "kernel_launch: unexpected shapes (n_in %d, in0 %d, out %d, ws %zu, need %zu); nothing launched\n", n_in, n_in > 0 ? in_sizes[0] : -1, out_size, ws_size, (size_t)WS_END); grid = -1; return; }
        int dev = 0, cus = 0, per_cu = 0;
        if (hipGetDevice(&dev) != hipSuccess || hipDeviceGetAttribute(&cus, hipDeviceAttributeMultiprocessorCount, dev) != hipSuccess) { grid = -1; return; }
        if (hipFuncSetAttribute((const void*)mk_fwd, hipFuncAttributeMaxDynamicSharedMemorySize, LDS_BYTES) != hipSuccess) { fprintf(stderr, "kernel_launch: hipFuncSetAttribute failed\n"); grid = -1; return; }
        if (hipOccupancyMaxActiveBlocksPerMultiprocessor(&per_cu, (const void*)mk_fwd, NWAVES * 64, LDS_BYTES) != hipSuccess || per_cu < 1) { fprintf(stderr, "kernel_launch: occupancy query reports %d\n", per_cu); }
        (void)hipGetLastError();
        grid = cus;
    }
    if (grid < 0) return;
    if (hipMemsetAsync((char*)d_ws + WS_CTL, 0, CTL_ZERO_BYTES, stream) != hipSuccess) return;
    Args a{};
    for (int i = 0; i < 26; ++i) a.in[i] = (const float*)d_in[i];
    a.out = (float*)d_out; a.ws = (unsigned char*)d_ws;
#if MK_ONE_LAUNCH
    a.ph_lo = 0; a.ph_hi = N_PHASES;
    hipLaunchKernelGGL(mk_fwd, dim3(grid), dim3(NWAVES * 64), LDS_BYTES, stream, a);
#else
    for (int p = 0; p < N_PHASES; ++p) { a.ph_lo = p; a.ph_hi = p + 1; hipLaunchKernelGGL(mk_fwd, dim3(grid), dim3(NWAVES * 64), LDS_BYTES, stream, a); }
#endif
}
```
